# Optimizing an MI355X kernel written in HIP

```python
import math
import jax
import jax.numpy as jnp
from jax import lax
import numpy as np

D_MODEL = 1024
BATCH = 4
SEQ = 4096
DEPTH = 2

N_MEM = 256
EPS = 1e-6
HEAD_DIM = 128
RET_HEADS = D_MODEL // (2 * HEAD_DIM)
RET_DK = HEAD_DIM
RET_DV = HEAD_DIM
RET_CHUNK = 128
ROPE_BASE = 10000.0
HG_HEADS = D_MODEL // (2 * HEAD_DIM)
HG_DK = HEAD_DIM
HG_DV = HEAD_DIM
HG_CHUNK = 64
F_FLOOR = 1e-6
DSA_HEADS = D_MODEL // HEAD_DIM
DSA_HD = HEAD_DIM
DSA_BRANCHES = ((128, 1), (512, 4), (2048, 16))
DSA_BLOCK = 128
REL_BUCKETS = 32
REL_MAX_DIST = 2048
XA_HEADS = 4
XA_HD = D_MODEL // XA_HEADS
D_FF = ((8 * D_MODEL // 3 + 127) // 128) * 128
CONV_W = 3

N_EVEN = (DEPTH + 1) // 2
N_ODD = DEPTH // 2
EV_SIZES = (RET_HEADS * RET_DK, RET_HEADS * RET_DK, RET_HEADS * RET_DV, RET_HEADS * RET_DV,
            HG_HEADS * HG_DK, HG_HEADS * HG_DK, HG_HEADS * HG_DV, HG_HEADS * HG_DV)
EV_IN = sum(EV_SIZES)
EV_OUT = RET_HEADS * RET_DV + HG_HEADS * HG_DV
OD_IN = 3 * DSA_HEADS * DSA_HD
OD_OUT = DSA_HEADS * DSA_HD

kernel_name = 'hybrid_retention_hgrn2_dilated_attention_block'


def _rms(x, g):
    xf = x.astype(jnp.float32)
    y = xf * lax.rsqrt(jnp.mean(xf * xf, axis=-1, keepdims=True) + EPS)
    return (y * g.astype(jnp.float32)).astype(x.dtype)


def _head_layer_norm(x, g):
    mu = jnp.mean(x, axis=-1, keepdims=True)
    xc = x - mu
    var = jnp.mean(xc * xc, axis=-1, keepdims=True)
    return xc * lax.rsqrt(var + EPS) * g.astype(jnp.float32)[None, :, None, :]


def _head_rms_norm(x, g):
    y = x * lax.rsqrt(jnp.mean(x * x, axis=-1, keepdims=True) + EPS)
    return y * g.astype(jnp.float32)[None, :, None, :]


def _split_heads(t, n_heads):
    b, s, _ = t.shape
    return t.reshape(b, s, n_heads, -1).transpose(0, 2, 1, 3)


def _merge_heads(t):
    b, h, s, d = t.shape
    return t.transpose(0, 2, 1, 3).reshape(b, s, h * d)


def _split_cols(t, sizes):
    parts, off = [], 0
    for n in sizes:
        parts.append(t[..., off:off + n])
        off += n
    return parts


def _rotary(x, positions):
    half = x.shape[-1] // 2
    inv = 1.0 / (ROPE_BASE ** (jnp.arange(half, dtype=jnp.float32) / half))
    ang = positions.astype(jnp.float32)[:, None] * inv[None, :]
    cos, sin = jnp.cos(ang), jnp.sin(ang)
    xf = x.astype(jnp.float32)
    x1, x2 = xf[..., :half], xf[..., half:]
    return jnp.concatenate([x1 * cos - x2 * sin, x1 * sin + x2 * cos], axis=-1)


def _retention_chunkwise(q, k, v):
    b, h, s, dk = q.shape
    dv = v.shape[-1]
    c = RET_CHUNK
    nc = s // c
    log_gamma = jnp.log(1.0 - jnp.exp2(-5.0 - jnp.arange(h, dtype=jnp.float32)))
    idx = jnp.arange(c, dtype=jnp.float32)
    diff = idx[:, None] - idx[None, :]
    decay = jnp.where(diff >= 0, jnp.exp(log_gamma[:, None, None] * jnp.maximum(diff, 0.0)), 0.0)
    xi = jnp.exp(log_gamma[:, None] * (idx + 1.0))
    zeta = jnp.exp(log_gamma[:, None] * (c - 1.0 - idx))
    chunk_decay = jnp.exp(log_gamma * c)
    qc = q.astype(jnp.float32).reshape(b, h, nc, c, dk)
    kc = k.astype(jnp.float32).reshape(b, h, nc, c, dk)
    vc = v.astype(jnp.float32).reshape(b, h, nc, c, dv)
    scores = jnp.einsum('bhnid,bhnjd->bhnij', qc, kc) * decay[None, :, None]
    inner = jnp.einsum('bhnij,bhnjv->bhniv', scores, vc)
    chunk_kv = jnp.einsum('bhnjd,bhnjv->bhndv', kc * zeta[None, :, None, :, None], vc)

    def step(state, kv):
        return kv + chunk_decay[None, :, None, None] * state, state

    _, prev = lax.scan(step, jnp.zeros((b, h, dk, dv), jnp.float32), jnp.moveaxis(chunk_kv, 2, 0))
    prev = jnp.moveaxis(prev, 0, 2)
    cross = jnp.einsum('bhnid,bhndv->bhniv', qc, prev) * xi[None, :, None, :, None]
    return (inner + cross).reshape(b, h, s, dv)


def _hgrn2_chunkwise(q, f_logit, i, lb):
    b, h, s, dk = q.shape
    dv = i.shape[-1]
    c = HG_CHUNK
    nc = s // c
    lbb = lb.astype(jnp.float32)[None, :, None, :]
    f = lbb + (1.0 - lbb) * jax.nn.sigmoid(f_logit.astype(jnp.float32))
    log_f = jnp.log(jnp.maximum(f, F_FLOOR))
    key = 1.0 - f

    def chunks(t):
        return jnp.moveaxis(t.reshape(b, h, nc, c, t.shape[-1]), 2, 0)

    causal = jnp.tril(jnp.ones((c, c), dtype=bool))[None, None, :, :, None]

    def step(state, xs):
        qn, kn, vn, lfn = xs
        cum = jnp.cumsum(lfn, axis=2)
        rel = cum[:, :, :, None, :] - cum[:, :, None, :, :]
        w = jnp.exp(jnp.where(causal, rel, -jnp.inf))
        scores = jnp.sum(qn[:, :, :, None, :] * kn[:, :, None, :, :] * w, axis=-1)
        out = (jnp.einsum('bhts,bhsv->bhtv', scores, vn)
               + jnp.einsum('bhtc,bhcv->bhtv', qn * jnp.exp(cum), state))
        last = cum[:, :, -1:, :]
        new_state = (jnp.exp(last[:, :, 0, :])[..., None] * state
                     + jnp.einsum('bhsc,bhsv->bhcv', kn * jnp.exp(last - cum), vn))
        return new_state, out

    _, outs = lax.scan(step, jnp.zeros((b, h, dk, dv), jnp.float32),
                       (chunks(q.astype(jnp.float32)), chunks(key), chunks(i.astype(jnp.float32)), chunks(log_f)))
    return jnp.moveaxis(outs, 0, 2).reshape(b, h, s, dv)


def _t5_bucket(dist):
    exact = REL_BUCKETS // 2
    d = jnp.maximum(dist, 0)
    log_ratio = jnp.log(jnp.maximum(d, 1).astype(jnp.float32) / exact) / math.log(REL_MAX_DIST / exact)
    large = jnp.minimum(exact + (log_ratio * (REL_BUCKETS - exact)).astype(jnp.int32), REL_BUCKETS - 1)
    return jnp.where(d < exact, d, large)


def _dilated_branch(q, k, v, rel_bias, window, dil):
    b, h, s, hd = q.shape
    blk = DSA_BLOCK
    n_back = window // dil
    length = s // dil
    nb = -(-length // blk)
    padded = nb * blk

    def to_blocks(t):
        t = t.reshape(b, h, length, dil, hd).transpose(0, 1, 3, 2, 4)
        t = jnp.pad(t, ((0, 0), (0, 0), (0, 0), (0, padded - length), (0, 0)))
        return t.reshape(b, h, dil, nb, blk, hd)

    def band(t):
        tp = jnp.pad(t, ((0, 0), (0, 0), (0, 0), (1, 0), (0, 0), (0, 0)))
        return jnp.concatenate([tp[:, :, :, :-1], tp[:, :, :, 1:]], axis=4)

    qb = to_blocks(q)
    kb = band(to_blocks(k))
    vb = band(to_blocks(v))
    logits = jnp.einsum('bhrnqd,bhrnkd->bhrnqk', qb, kb).astype(jnp.float32) * (hd ** -0.5)
    qi = jnp.arange(blk)
    ki = jnp.arange(2 * blk)
    delta = qi[:, None] + blk - ki[None, :]
    key_idx = jnp.arange(nb)[:, None] * blk - blk + ki[None, :]
    valid = ((delta >= 0) & (delta <= n_back))[None] & (key_idx >= 0)[:, None, :]
    bias = rel_bias[_t5_bucket(delta * dil)].transpose(2, 0, 1).astype(jnp.float32)
    logits = jnp.where(valid[None, None, None], logits + bias[None, :, None, None], -jnp.inf)
    m = jnp.max(logits, axis=-1)
    p = jnp.exp(logits - m[..., None])
    den = jnp.sum(p, axis=-1)
    num = jnp.einsum('bhrnqk,bhrnkd->bhrnqd', p, vb.astype(jnp.float32))

    def to_seq(t):
        t = t.reshape((b, h, dil, padded) + t.shape[5:])[:, :, :, :length]
        t = jnp.swapaxes(t, 2, 3)
        return t.reshape((b, h, s) + t.shape[4:])

    return to_seq(m), to_seq(den), to_seq(num)


def _dilated_attention(q, k, v, rel_bias):
    ms, dens, nums = [], [], []
    for window, dil in DSA_BRANCHES:
        m, den, num = _dilated_branch(q, k, v, rel_bias, window, dil)
        ms.append(m)
        dens.append(den)
        nums.append(num)
    m_all = jnp.max(jnp.stack(ms, axis=0), axis=0)
    w = [jnp.exp(mi - m_all) for mi in ms]
    den_all = w[0] * dens[0] + w[1] * dens[1] + w[2] * dens[2]
    num_all = w[0][..., None] * nums[0] + w[1][..., None] * nums[1] + w[2][..., None] * nums[2]
    return num_all / den_all[..., None]


def _even_mixer(h, w_in, ret_norm_g, hg_norm_g, lb, w_out):
    b, s, _ = h.shape
    rq, rk, rv, rg, gq, gf, gi, gg = _split_cols(h @ w_in, EV_SIZES)
    pos = jnp.arange(s)
    rq = _rotary(_split_heads(rq, RET_HEADS), pos)
    rk = _rotary(_split_heads(rk, RET_HEADS), pos) * (RET_DK ** -0.5)
    ret = _retention_chunkwise(rq, rk, _split_heads(rv, RET_HEADS))
    ret = _merge_heads(_head_layer_norm(ret, ret_norm_g)) * jax.nn.silu(rg.astype(jnp.float32))
    hg = _hgrn2_chunkwise(_split_heads(gq, HG_HEADS), _split_heads(gf, HG_HEADS), _split_heads(gi, HG_HEADS), lb)
    hg = _merge_heads(_head_rms_norm(hg, hg_norm_g)) * jax.nn.silu(gg.astype(jnp.float32))
    y = jnp.concatenate([ret, hg], axis=-1).astype(h.dtype)
    return y @ w_out


def _odd_mixer(h, w_in, q_norm_g, k_norm_g, rel_bias, w_out):
    q, k, v = _split_cols(h @ w_in, (OD_OUT, OD_OUT, OD_OUT))
    q = _rms(_split_heads(q, DSA_HEADS), q_norm_g)
    k = _rms(_split_heads(k, DSA_HEADS), k_norm_g)
    o = _dilated_attention(q, k, _split_heads(v, DSA_HEADS), rel_bias)
    return _merge_heads(o).astype(h.dtype) @ w_out


def _memory_cross_attention(h, mem_h, w_q, w_kv, q_norm_g, k_norm_g, w_o):
    q = _rms(_split_heads(h @ w_q, XA_HEADS), q_norm_g)
    mk, mv = _split_cols(mem_h @ w_kv, (XA_HEADS * XA_HD, XA_HEADS * XA_HD))
    mk = _rms(_split_heads(mk, XA_HEADS), k_norm_g)
    mv = _split_heads(mv, XA_HEADS)
    logits = jnp.einsum('bhqd,bhkd->bhqk', q, mk).astype(jnp.float32) * (XA_HD ** -0.5)
    p = jax.nn.softmax(logits, axis=-1)
    o = jnp.einsum('bhqk,bhkd->bhqd', p, mv.astype(jnp.float32))
    return _merge_heads(o).astype(h.dtype) @ w_o


def _causal_dwconv(u, w, bias):
    kw = w.shape[0]
    s = u.shape[1]
    up = jnp.pad(u, ((0, 0), (kw - 1, 0), (0, 0)))
    y = up[:, 0:s] * w[0]
    for j in range(1, kw):
        y = y + up[:, j:j + s] * w[j]
    return y + bias


def _conv_ffn(h, w_in, conv_w, conv_b, w_out):
    gate, up = _split_cols(h @ w_in, (D_FF, D_FF))
    gate = _causal_dwconv(gate, conv_w, conv_b)
    return (jax.nn.gelu(gate) * up) @ w_out


def setup_inputs(seed: int = 0) -> dict:
    key = jax.random.key(seed)
    ks = iter(jax.random.split(key, 32))

    def nrm(shape, scale):
        return jax.random.normal(next(ks), shape, jnp.float32) * scale

    def gain(shape):
        return 1.0 + nrm(shape, 0.05)

    out_scale = 0.5
    return {
        'x': nrm((BATCH, SEQ, D_MODEL), 1.0),
        'mem': nrm((BATCH, N_MEM, D_MODEL), 1.0),
        'mix_norm_g': gain((DEPTH, D_MODEL)),
        'ev_w_in': nrm((N_EVEN, D_MODEL, EV_IN), D_MODEL ** -0.5),
        'ev_ret_norm_g': gain((N_EVEN, RET_HEADS, RET_DV)),
        'ev_hg_norm_g': gain((N_EVEN, HG_HEADS, HG_DV)),
        'hg_lb_logits': nrm((DEPTH + 1, HG_HEADS * HG_DK), 0.5),
        'ev_w_out': nrm((N_EVEN, EV_OUT, D_MODEL), out_scale * EV_OUT ** -0.5),
        'od_w_in': nrm((N_ODD, D_MODEL, OD_IN), D_MODEL ** -0.5),
        'od_q_norm_g': gain((N_ODD, DSA_HD)),
        'od_k_norm_g': gain((N_ODD, DSA_HD)),
        'rel_bias': nrm((REL_BUCKETS, DSA_HEADS), 0.5),
        'od_w_out': nrm((N_ODD, OD_OUT, D_MODEL), out_scale * OD_OUT ** -0.5),
        'xa_norm_g': gain((DEPTH, D_MODEL)),
        'xa_mem_norm_g': gain((DEPTH, D_MODEL)),
        'xa_w_q': nrm((DEPTH, D_MODEL, XA_HEADS * XA_HD), D_MODEL ** -0.5),
        'xa_w_kv': nrm((DEPTH, D_MODEL, 2 * XA_HEADS * XA_HD), D_MODEL ** -0.5),
        'xa_q_norm_g': gain((DEPTH, XA_HD)),
        'xa_k_norm_g': gain((DEPTH, XA_HD)),
        'xa_w_o': nrm((DEPTH, XA_HEADS * XA_HD, D_MODEL), out_scale * (XA_HEADS * XA_HD) ** -0.5),
        'ffn_norm_g': gain((DEPTH, D_MODEL)),
        'ffn_w_in': nrm((DEPTH, D_MODEL, 2 * D_FF), D_MODEL ** -0.5),
        'ffn_conv_w': nrm((DEPTH, CONV_W, D_FF), CONV_W ** -0.5),
        'ffn_conv_b': nrm((DEPTH, D_FF), 0.02),
        'ffn_w_out': nrm((DEPTH, D_FF, D_MODEL), out_scale * D_FF ** -0.5),
    }


def reference(x, mem, mix_norm_g, ev_w_in, ev_ret_norm_g, ev_hg_norm_g, hg_lb_logits, ev_w_out,
              od_w_in, od_q_norm_g, od_k_norm_g, rel_bias, od_w_out,
              xa_norm_g, xa_mem_norm_g, xa_w_q, xa_w_kv, xa_q_norm_g, xa_k_norm_g, xa_w_o,
              ffn_norm_g, ffn_w_in, ffn_conv_w, ffn_conv_b, ffn_w_out):
    lb_all = jnp.cumsum(jax.nn.softmax(hg_lb_logits.astype(jnp.float32), axis=0), axis=0)
    for l in range(DEPTH):
        h = _rms(x, mix_norm_g[l])
        if l % 2 == 0:
            e = l // 2
            lb = lb_all[l].reshape(HG_HEADS, HG_DK)
            x = x + _even_mixer(h, ev_w_in[e], ev_ret_norm_g[e], ev_hg_norm_g[e], lb, ev_w_out[e])
        else:
            o = l // 2
            x = x + _odd_mixer(h, od_w_in[o], od_q_norm_g[o], od_k_norm_g[o], rel_bias, od_w_out[o])
        x = x + _memory_cross_attention(_rms(x, xa_norm_g[l]), _rms(mem, xa_mem_norm_g[l]),
                                        xa_w_q[l], xa_w_kv[l], xa_q_norm_g[l], xa_k_norm_g[l], xa_w_o[l])
        x = x + _conv_ffn(_rms(x, ffn_norm_g[l]), ffn_w_in[l], ffn_conv_w[l], ffn_conv_b[l], ffn_w_out[l])
    return x
```

```cpp
#include <hip/hip_runtime.h>
#include <cstdio>
#include <cstdint>
namespace pg8 {
#define PG8_LAS __attribute__((address_space(3)))
typedef unsigned short bf16_t;
typedef short bf16x8 __attribute__((ext_vector_type(8)));
typedef float f32x4 __attribute__((ext_vector_type(4)));
typedef unsigned u32x4 __attribute__((ext_vector_type(4)));
constexpr int BM = 256, BK = 64, HALF = 128, HTB = HALF * BK * 2  , STAGE_BYTES = 8 * HTB, NXCD = 8, WGM = 8;

__host__ __device__ __forceinline__ int lds_byte(int r, int c) { const int st = (r >> 4) * 2 + (c >> 5), rr = r & 15, cc = c & 31, ob = rr * 64 + cc * 2; return st * 1024 + (ob ^ (((ob >> 9) & 1) << 5)); }
__host__ __device__ __forceinline__ void stage_rc(int b, int& R, int& C) { const int st = b / 1024, sb = b % 1024, swz = sb ^ (((sb >> 9) & 1) << 5); R = (st >> 1) * 16 + swz / 64; C = (st & 1) * 32 + (swz % 64) / 2; }
__host__ __device__ __forceinline__ int perm32(int rho) { const int n = rho >> 4, i = rho & 15; return 8 * (i >> 2) + 4 * n + (i & 3); }

struct Unit { int pm, pn; };
struct Gemm { const bf16_t* A; const bf16_t* Bt; int M, N, K, lda; };

struct StaticOrder {
    int nM, nN, nwg, G, c;
    __host__ __device__ void init(int M, int N, int G_, int c_) { nM = M / BM; nN = N / BM; nwg = nM * nN; G = G_; c = c_; }
    __host__ __device__ bool next(int i, Unit& u) const {
        const long L = (long)i * G + c; if (L >= nwg) return false;
        int wgid = (int)L; { const int q = nwg / NXCD, r = nwg % NXCD, xcd = wgid % NXCD, off = wgid / NXCD; wgid = (xcd < r ? xcd * (q + 1) : r * (q + 1) + (xcd - r) * q) + off; }
        const int nig = WGM * nN, gid = wgid / nig, fm = gid * WGM, gsz = (nM - fm) < WGM ? (nM - fm) : WGM;
        u.pm = fm + ((wgid % nig) % gsz); u.pn = (wgid % nig) / gsz; return true;
    }
    __device__ __forceinline__ void a_ready(const Unit&) const {}
    __device__ __forceinline__ void done(const Unit&) const {}
};

__device__ __forceinline__ unsigned cvt_pk_bf16(float lo, float hi) { unsigned r; asm volatile("v_cvt_pk_bf16_f32 %0, %1, %2" : "=v"(r) : "v"(lo), "v"(hi)); return r; }
typedef float f32x2 __attribute__((ext_vector_type(2)));
struct EpiBf16S {
    static constexpr bool PERM = true, AFTER_DRAIN = false;
    bf16_t* O; const float* ssqp; int ldc; int Mtot; float eps; int pad;
    __device__ __forceinline__ void operator()(const f32x4 (&acc)[2][2][4][2], const Unit& u, int wr, int wc, int fr, int fq) const {
        const int row0 = u.pm * BM + wr * 64 + fr; const int col0 = u.pn * BM + wc * 32 + 8 * fq;
#pragma unroll
        for (int ai = 0; ai < 2; ++ai)
#pragma unroll
            for (int m = 0; m < 4; ++m) { const int row = row0 + ai * HALF + m * 16; float rs = 1.f;
                if (ssqp) { const float s = (ssqp[row] + ssqp[Mtot + row]) + (ssqp[2 * Mtot + row] + ssqp[3 * Mtot + row]); rs = 1.0f / sqrtf(s * (1.0f / 1024.0f) + eps); }
                bf16_t* rowp = O + (size_t)row * ldc + col0;
#pragma unroll
                for (int bj = 0; bj < 2; ++bj) { const f32x4 v0 = acc[ai][bj][m][0] * rs, v1 = acc[ai][bj][m][1] * rs;
                    u32x4 w; w.x = cvt_pk_bf16(v0[0], v0[1]); w.y = cvt_pk_bf16(v0[2], v0[3]); w.z = cvt_pk_bf16(v1[0], v1[1]); w.w = cvt_pk_bf16(v1[2], v1[3]);
                    *(u32x4*)(rowp + bj * HALF) = w; } }
    }
};
struct EpiResid {
    static constexpr bool PERM = false, AFTER_DRAIN = true;
    const float* base; float* out; bf16_t* xb; float* ssqp; int ldc; int Mtot;
    __device__ __forceinline__ void fused(f32x4 (&acc)[2][2][4][2], const Unit& u, int wr, int wc, int fr, int fq, PG8_LAS unsigned char* lds, int wid, int lane) const {
        typedef unsigned u32x2v __attribute__((ext_vector_type(2)));
        PG8_LAS float* P = (PG8_LAS float*)lds;
        const int col0 = u.pn * BM + wc * 32 + 4 * fq;
#pragma unroll
        for (int ai = 0; ai < 2; ++ai)
#pragma unroll
            for (int m = 0; m < 4; ++m) { const int r = ai * HALF + wr * 64 + m * 16 + fr; const size_t off = (size_t)(u.pm * BM + r) * ldc + col0; float s = 0.f;
#pragma unroll
                for (int bj = 0; bj < 2; ++bj)
#pragma unroll
                    for (int n = 0; n < 2; ++n) { const f32x4 bs = *(const f32x4*)(base + off + bj * HALF + n * 16); const f32x4 o = bs + acc[ai][bj][m][n];
                        *(f32x4*)(out + off + bj * HALF + n * 16) = o; u32x2v w; w.x = cvt_pk_bf16(o[0], o[1]); w.y = cvt_pk_bf16(o[2], o[3]); *(u32x2v*)(xb + off + bj * HALF + n * 16) = w;
                        s += (o[0] * o[0] + o[1] * o[1]) + (o[2] * o[2] + o[3] * o[3]); }
                s += __shfl_xor(s, 16); s += __shfl_xor(s, 32);
                if (fq == 0) P[r * 4 + wc] = s;
                if (m & 1) asm volatile("" ::: "memory"); }
        asm volatile("s_waitcnt lgkmcnt(0)" ::: "memory"); __builtin_amdgcn_s_barrier(); asm volatile("" ::: "memory");
        if (lane < 32) { const int row = wid * 32 + lane; ssqp[(size_t)u.pn * Mtot + u.pm * BM + row] = (P[row * 4 + 0] + P[row * 4 + 1]) + (P[row * 4 + 2] + P[row * 4 + 3]); }
        asm volatile("s_waitcnt lgkmcnt(0)" ::: "memory"); __builtin_amdgcn_s_barrier(); asm volatile("" ::: "memory");
    }
};

template <class Epi, class Sched, bool ALIGN_EPI = false, bool SP2 = false>
__device__ __forceinline__ void gemm_phase(PG8_LAS unsigned char* lds, const Gemm g, const Sched& S, const Epi& E) {
    int tid_l = threadIdx.x; asm volatile("" : "+v"(tid_l));
    const int tid = tid_l, wid = __builtin_amdgcn_readfirstlane(tid >> 6), lane = tid & 63, wr = wid >> 2, wc = wid & 3, fr = lane & 15, fq = lane >> 4;
    const int K = g.K, nt = K / BK;
    unsigned voffA[2], voffB[2];
#pragma unroll
    for (int i = 0; i < 2; ++i) { int R, C; stage_rc(tid * 16 + i * 8192, R, C); const int Rb = Epi::PERM ? ((R & ~31) + perm32(R & 31)) : R;
        voffA[i] = (unsigned)(R * g.lda + C) * 2u; voffB[i] = (unsigned)(Rb * K + C) * 2u; }
    const size_t kstep = (size_t)(BK * 2);
    const size_t hstepA = (size_t)HALF * g.lda * 2, hstepB = (size_t)HALF * K * 2;
    const size_t tstepA = 2 * hstepA, tstepB = 2 * hstepB;
    const unsigned ldsw = (unsigned)wid * 1024u;
    const int aoff = lds_byte(wr * 64 + fr, fq * 8), boff = lds_byte(wc * 32 + fr, fq * 8);
#define PG8_SA(b, h) (((b) * 2 + (h)) * HTB)
#define PG8_SB(b, h) ((4 + (b) * 2 + (h)) * HTB)
#define PG8_STAGE(bufoff, gbase, voff) do { _Pragma("unroll") for (int _i = 0; _i < 2; ++_i) \
        __builtin_amdgcn_global_load_lds((const unsigned*)((const char*)(gbase) + (voff)[_i]), (PG8_LAS unsigned*)(lds + (bufoff) + ldsw + _i * 8192), 16, 0, 0); } while (0)
#define PG8_LDA(dst, b, h) do { _Pragma("unroll") for (int m = 0; m < 4; ++m) _Pragma("unroll") for (int k = 0; k < 2; ++k) dst[m][k] = *(const PG8_LAS bf16x8*)(lds + PG8_SA(b, h) + aoff + m * 2048 + k * 1024); } while (0)
#define PG8_LDB(dst, b, h) do { _Pragma("unroll") for (int n = 0; n < 2; ++n) _Pragma("unroll") for (int k = 0; k < 2; ++k) dst[n][k] = *(const PG8_LAS bf16x8*)(lds + PG8_SB(b, h) + boff + n * 2048 + k * 1024); } while (0)
#define PG8_MMA(ai, bj, At, Bt) do { __builtin_amdgcn_s_setprio(1); _Pragma("unroll") for (int m = 0; m < 4; ++m) _Pragma("unroll") for (int n = 0; n < 2; ++n) _Pragma("unroll") for (int k = 0; k < 2; ++k) \
        acc[ai][bj][m][n] = __builtin_amdgcn_mfma_f32_16x16x32_bf16(Bt[n][k], At[m][k], acc[ai][bj][m][n], 0, 0, 0); __builtin_amdgcn_s_setprio(0); } while (0)
#define PG8_WAIT_V(n) asm volatile("s_waitcnt vmcnt(" #n ")" ::: "memory")
#define PG8_WAIT_L(n) asm volatile("s_waitcnt lgkmcnt(" #n ")" ::: "memory")
#define PG8_BAR __builtin_amdgcn_s_barrier()
#define PG8_SCHED __builtin_amdgcn_sched_barrier(0)
    Unit cur, nxt; int ui = 0;
    if (!S.next(0, cur)) return;
    f32x4 acc[2][2][4][2];
#pragma unroll
    for (int a = 0; a < 2; ++a)
#pragma unroll
        for (int b = 0; b < 2; ++b)
#pragma unroll
            for (int m = 0; m < 4; ++m)
#pragma unroll
                for (int n = 0; n < 2; ++n) acc[a][b][m][n] = (f32x4){0.f, 0.f, 0.f, 0.f};
    bf16x8 At[4][2], B0[2][2], B1[2][2];
    const char* cA = (const char*)g.A + (size_t)cur.pm * tstepA; const char* cB = (const char*)g.Bt + (size_t)cur.pn * tstepB;
    S.a_ready(cur);
    if constexpr (SP2) {
        PG8_STAGE(PG8_SB(0, 0), cB, voffB); PG8_STAGE(PG8_SB(0, 1), cB + hstepB, voffB); PG8_STAGE(PG8_SA(0, 0), cA, voffA); PG8_STAGE(PG8_SA(0, 1), cA + hstepA, voffA);
        if (wr == 1) PG8_BAR;
        PG8_WAIT_V(2); PG8_BAR;
        PG8_STAGE(PG8_SB(1, 0), cB + kstep, voffB); PG8_STAGE(PG8_SA(1, 0), cA + kstep, voffA); PG8_STAGE(PG8_SB(1, 1), cB + hstepB + kstep, voffB);
        PG8_WAIT_V(6); PG8_BAR;
    } else {
        PG8_STAGE(PG8_SB(0, 0), cB, voffB); PG8_STAGE(PG8_SA(0, 0), cA, voffA); PG8_STAGE(PG8_SB(0, 1), cB + hstepB, voffB); PG8_STAGE(PG8_SA(0, 1), cA + hstepA, voffA);
        if (wr == 1) PG8_BAR;
        PG8_WAIT_V(4); PG8_BAR;
        PG8_STAGE(PG8_SB(1, 0), cB + kstep, voffB); PG8_STAGE(PG8_SA(1, 0), cA + kstep, voffA); PG8_STAGE(PG8_SB(1, 1), cB + hstepB + kstep, voffB);
        PG8_WAIT_V(6); PG8_BAR;
    }
    for (;;) {
        const bool has_next = S.next(ui + 1, nxt);
        const char* nA = has_next ? (const char*)g.A + (size_t)nxt.pm * tstepA : cA; const char* nB = has_next ? (const char*)g.Bt + (size_t)nxt.pn * tstepB : cB;
        for (int t = 0; t < nt; t += 2) {
            const bool last = (t == nt - 2);
            const char* a1 = cA + (size_t)(t + 1) * kstep;
            const char* a2 = last ? nA : cA + (size_t)(t + 2) * kstep; const char* b2 = last ? nB : cB + (size_t)(t + 2) * kstep;
            const char* a3 = a2 + kstep; const char* b3 = b2 + kstep;
            if (last && has_next) S.a_ready(nxt);
            if constexpr (SP2) {
            PG8_LDB(B0, 0, 0); PG8_LDB(B1, 0, 1); PG8_SCHED; PG8_LDA(At, 0, 0); PG8_STAGE(PG8_SA(1, 1), a1 + hstepA, voffA);
            PG8_WAIT_V(8); PG8_WAIT_L(0); PG8_BAR; PG8_MMA(0, 0, At, B0); PG8_MMA(0, 1, At, B1); PG8_BAR; PG8_SCHED;
            PG8_LDA(At, 0, 1); PG8_STAGE(PG8_SB(0, 0), b2, voffB); PG8_STAGE(PG8_SB(0, 1), b2 + hstepB, voffB); PG8_STAGE(PG8_SA(0, 0), a2, voffA);
            PG8_WAIT_V(8); PG8_WAIT_L(0); PG8_BAR; PG8_MMA(1, 0, At, B0); PG8_MMA(1, 1, At, B1); PG8_BAR; PG8_SCHED;
            PG8_LDB(B0, 1, 0); PG8_LDB(B1, 1, 1); PG8_SCHED; PG8_LDA(At, 1, 0); PG8_STAGE(PG8_SA(0, 1), a2 + hstepA, voffA);
            PG8_WAIT_V(8); PG8_WAIT_L(0); PG8_BAR; PG8_MMA(0, 0, At, B0); PG8_MMA(0, 1, At, B1); PG8_BAR; PG8_SCHED;
            PG8_LDA(At, 1, 1); PG8_STAGE(PG8_SB(1, 0), b3, voffB); PG8_STAGE(PG8_SB(1, 1), b3 + hstepB, voffB); PG8_STAGE(PG8_SA(1, 0), a3, voffA);
            PG8_WAIT_V(8); PG8_WAIT_L(0); PG8_BAR; PG8_MMA(1, 0, At, B0); PG8_MMA(1, 1, At, B1); PG8_BAR; PG8_SCHED;
            } else {
            PG8_LDB(B0, 0, 0); PG8_SCHED; PG8_LDA(At, 0, 0); PG8_STAGE(PG8_SA(1, 1), a1 + hstepA, voffA);
            PG8_WAIT_L(8); PG8_BAR; PG8_WAIT_L(0); PG8_MMA(0, 0, At, B0); PG8_BAR; PG8_SCHED;
            PG8_LDB(B1, 0, 1); PG8_STAGE(PG8_SB(0, 0), b2, voffB);
            PG8_BAR; PG8_WAIT_L(0); PG8_MMA(0, 1, At, B1); PG8_BAR;
            PG8_LDA(At, 0, 1); PG8_STAGE(PG8_SA(0, 0), a2, voffA);
            PG8_BAR; PG8_WAIT_L(0); PG8_MMA(1, 0, At, B0); PG8_BAR; PG8_SCHED;
            PG8_STAGE(PG8_SB(0, 1), b2 + hstepB, voffB);
            PG8_WAIT_V(6); PG8_BAR; PG8_MMA(1, 1, At, B1); PG8_BAR;
            PG8_LDB(B0, 1, 0); PG8_SCHED; PG8_LDA(At, 1, 0); PG8_STAGE(PG8_SA(0, 1), a2 + hstepA, voffA);
            PG8_WAIT_L(8); PG8_BAR; PG8_WAIT_L(0); PG8_MMA(0, 0, At, B0); PG8_BAR; PG8_SCHED;
            PG8_LDB(B1, 1, 1); PG8_STAGE(PG8_SB(1, 0), b3, voffB);
            PG8_BAR; PG8_WAIT_L(0); PG8_MMA(0, 1, At, B1); PG8_BAR;
            PG8_LDA(At, 1, 1); PG8_STAGE(PG8_SA(1, 0), a3, voffA);
            PG8_BAR; PG8_WAIT_L(0); PG8_MMA(1, 0, At, B0); PG8_BAR; PG8_SCHED;
            PG8_STAGE(PG8_SB(1, 1), b3 + hstepB, voffB);
            PG8_WAIT_V(6); PG8_BAR; PG8_MMA(1, 1, At, B1); PG8_BAR;
            }
        }
        if constexpr (ALIGN_EPI) { if (wr == 0) PG8_BAR; }
        if constexpr (!Epi::AFTER_DRAIN) { E(acc, cur, wr, wc, fr, fq); S.done(cur); }
        if (!has_next) break;
#pragma unroll
        for (int a = 0; a < 2; ++a)
#pragma unroll
            for (int b = 0; b < 2; ++b)
#pragma unroll
                for (int m = 0; m < 4; ++m)
#pragma unroll
                    for (int n = 0; n < 2; ++n) acc[a][b][m][n] = (f32x4){0.f, 0.f, 0.f, 0.f};
        cur = nxt; cA = nA; cB = nB; ++ui;
        if constexpr (ALIGN_EPI) { if (wr == 1) PG8_BAR; }
    }
    PG8_WAIT_V(0);
    if constexpr (!ALIGN_EPI) { if (wr == 0) PG8_BAR; }
    PG8_BAR;
    if constexpr (Epi::AFTER_DRAIN) { E.fused(acc, cur, wr, wc, fr, fq, lds, wid, lane); S.done(cur); }
#undef PG8_SA
#undef PG8_SB
#undef PG8_STAGE
#undef PG8_LDA
#undef PG8_LDB
#undef PG8_MMA
#undef PG8_WAIT_V
#undef PG8_WAIT_L
#undef PG8_BAR
#undef PG8_SCHED
}
}


#define GAS __attribute__((address_space(1)))
#define LAS __attribute__((address_space(3)))
typedef unsigned short bf16;
typedef unsigned v4u __attribute__((ext_vector_type(4)));
typedef unsigned v2u __attribute__((ext_vector_type(2)));
typedef float f32x4 __attribute__((ext_vector_type(4)));
constexpr int BATCH = 4, SEQ = 4096, D = 1024, M = BATCH * SEQ, NMEM = 256, MM = BATCH * NMEM, DFF = 2816;
constexpr int EV_IN = 4096, OD_IN = 3072;
constexpr float EPS = 1e-6f;
constexpr int Z_RQ = 0, Z_GQ = 512, Z_RK = 1024, Z_RV = 1536, Z_RG = 2048, Z_GF = 2560, Z_GI = 3072, Z_GG = 3584;

constexpr size_t MiB = 1u << 20;
constexpr size_t WS_CTL = 0;
constexpr size_t WS_EVIN = 1 * MiB, WS_EVOUT = 9 * MiB, WS_XQ0 = 11 * MiB, WS_XKV0 = 13 * MiB, WS_XO0 = 17 * MiB, WS_FIN0 = 19 * MiB, WS_FOUT0 = 30 * MiB;
constexpr size_t WS_ODIN = 36 * MiB, WS_ODOUT = 42 * MiB, WS_XQ1 = 44 * MiB, WS_XKV1 = 46 * MiB, WS_XO1 = 50 * MiB, WS_FIN1 = 52 * MiB, WS_FOUT1 = 63 * MiB;
constexpr size_t WS_XB = 69 * MiB;
constexpr size_t WS_MKV0 = 101 * MiB, WS_MKV1 = 105 * MiB;
constexpr size_t WS_MEMH0 = 109 * MiB, WS_MEMH1 = 111 * MiB;
constexpr size_t WS_SSQP = 113 * MiB;
constexpr size_t WS_LB = 113 * MiB + 512 * 1024;
constexpr size_t WS_BIAST = 113 * MiB + 516 * 1024;
constexpr size_t WS_GXA = 113 * MiB + 600 * 1024, WS_GOD = 113 * MiB + 604 * 1024;
constexpr size_t WS_DEN23 = 114 * MiB;
constexpr size_t WS_N2 = 1 * MiB;
constexpr size_t WS_N3 = 69 * MiB;
constexpr size_t WS_ACT = 115 * MiB;
constexpr size_t WS_DECA = 243 * MiB, WS_DECB = 243 * MiB + 512 * 1024;
constexpr size_t WS_END = 256 * MiB;

__device__ __forceinline__ float bf2f(bf16 u) { return __uint_as_float((unsigned)u << 16); }
__device__ __forceinline__ unsigned f2bf(float f) { unsigned u = __builtin_bit_cast(unsigned, f); return (u + 0x7fffu + ((u >> 16) & 1u)) >> 16; }
__device__ __forceinline__ unsigned pk2(float lo, float hi) { return f2bf(lo) | (f2bf(hi) << 16); }
__device__ __forceinline__ float wave_sum(float v) {
#pragma unroll
    for (int o = 1; o < 64; o <<= 1) v += __shfl_xor(v, o);
    return v;
}
__device__ __forceinline__ float wave_max(float v) {
#pragma unroll
    for (int o = 1; o < 64; o <<= 1) v = fmaxf(v, __shfl_xor(v, o));
    return v;
}
__device__ __forceinline__ void unpack8(const v4u w, float (&f)[8]) {
    f[0] = __uint_as_float(w.x << 16); f[1] = __uint_as_float(w.x & 0xffff0000u); f[2] = __uint_as_float(w.y << 16); f[3] = __uint_as_float(w.y & 0xffff0000u);
    f[4] = __uint_as_float(w.z << 16); f[5] = __uint_as_float(w.z & 0xffff0000u); f[6] = __uint_as_float(w.w << 16); f[7] = __uint_as_float(w.w & 0xffff0000u);
}
__device__ __forceinline__ void rope_sincos(float a, float& s, float& c) {
    const float n = rintf(a * 0.15915494309189535f);
    float r = fmaf(-n, 6.2831854820251465f, a); r = fmaf(-n, -1.7484555e-7f, r);
    const float rev = r * 0.15915494309189535f;
    s = __builtin_amdgcn_sinf(rev); c = __builtin_amdgcn_cosf(rev);
}

__device__ __forceinline__ int dst_row_map(int mode, int n0) {
    if (mode == 1) { const int seg = n0 >> 9, within = n0 & 511; const int dseg = (seg == 0) ? 0 : (seg == 4 ? 1 : (seg < 4 ? seg + 1 : seg)); return dseg * 512 + within; }
    if (mode == 2) { return n0 < DFF ? (n0 >> 7) * 256 + (n0 & 127) : ((n0 - DFF) >> 7) * 256 + 128 + ((n0 - DFF) & 127); }
    return n0;
}
__device__ __forceinline__ void transpose_item(const float* W, int K, int N, const float* g, bf16* WT, int mode, LAS float* scr, int item, int lane) {
    const int nblk = N / 32, kb = item / nblk, nb = item % nblk, k0 = 64 * kb, n0 = 32 * nb;
#pragma unroll 8
    for (int i = 0; i < 32; ++i) { const int kk = 2 * i + (lane >> 5); float w = W[(size_t)(k0 + kk) * N + n0 + (lane & 31)]; if (g) w *= g[k0 + kk]; scr[kk * 33 + (lane & 31)] = w; }
    asm volatile("s_waitcnt lgkmcnt(0)" ::: "memory");
    const int c = lane & 7; const int d0 = dst_row_map(mode, n0);
#pragma unroll
    for (int j = 0; j < 4; ++j) { const int n = (lane >> 3) + 8 * j; const LAS float* s = scr + (8 * c) * 33 + n;
        v4u o; o.x = pk2(s[0 * 33], s[1 * 33]); o.y = pk2(s[2 * 33], s[3 * 33]); o.z = pk2(s[4 * 33], s[5 * 33]); o.w = pk2(s[6 * 33], s[7 * 33]);
        *(v4u*)(WT + (size_t)(d0 + n) * K + k0 + 8 * c) = o; }
    asm volatile("s_waitcnt lgkmcnt(0)" ::: "memory");
}
struct ProArgs { const float* in[25]; unsigned char* ws; int layer_mask; int ffn_mode; };
#define CONVERT_JOB(Wp, K_, N_, gp, dst, mode) do { const int nitems = ((K_) / 64) * ((N_) / 32); for (int it = gw; it < nitems; it += NGW) transpose_item((Wp), (K_), (N_), (gp), (bf16*)(ws + (dst)), (mode), scr, it, lane); } while (0)
__device__ __forceinline__ void prologue_body(const ProArgs& a, int gw, int NGW, int lane, LAS float* scr) {
    unsigned char* ws = a.ws;
    const float* x = a.in[0]; const float* mem = a.in[1];
    if (a.layer_mask & 1) {
        CONVERT_JOB(a.in[3], D, EV_IN, a.in[2], WS_EVIN, 1);
        CONVERT_JOB(a.in[7], D, D, (const float*)nullptr, WS_EVOUT, 0);
        CONVERT_JOB(a.in[15], D, D, a.in[13], WS_XQ0, 0);
        CONVERT_JOB(a.in[16], D, 2 * D, (const float*)nullptr, WS_XKV0, 0);
        CONVERT_JOB(a.in[19], D, D, (const float*)nullptr, WS_XO0, 0);
        CONVERT_JOB(a.in[21], D, 2 * DFF, a.in[20], WS_FIN0, a.ffn_mode);
        CONVERT_JOB(a.in[24], DFF, D, (const float*)nullptr, WS_FOUT0, 0);
        for (int m = gw; m < M; m += NGW) {
            const f32x4* xr = (const f32x4*)(x + (size_t)m * D) + lane; v2u* o8 = (v2u*)((bf16*)(ws + WS_XB) + (size_t)m * D) + lane; float* sp = (float*)(ws + WS_SSQP);
#pragma unroll
            for (int j = 0; j < 4; ++j) { const f32x4 v = xr[64 * j]; v2u w; w.x = pk2(v[0], v[1]); w.y = pk2(v[2], v[3]); o8[64 * j] = w;
                const float s = wave_sum((v[0] * v[0] + v[1] * v[1]) + (v[2] * v[2] + v[3] * v[3])); if (lane == 0) sp[(size_t)j * M + m] = s; }
        }
        for (int r = gw; r < 2 * MM; r += NGW) { const int l = r / MM, m = r % MM;
            const f32x4* xr = (const f32x4*)(mem + (size_t)m * D) + lane; const f32x4* gr = (const f32x4*)(a.in[14] + (size_t)l * D) + lane;
            f32x4 v[4]; float s = 0.f;
#pragma unroll
            for (int j = 0; j < 4; ++j) { v[j] = xr[64 * j]; s += (v[j][0] * v[j][0] + v[j][1] * v[j][1]) + (v[j][2] * v[j][2] + v[j][3] * v[j][3]); }
            const float rs = 1.0f / sqrtf(wave_sum(s) * (1.0f / D) + EPS);
            v2u* o8 = (v2u*)((bf16*)(ws + (l ? WS_MEMH1 : WS_MEMH0)) + (size_t)m * D) + lane;
#pragma unroll
            for (int j = 0; j < 4; ++j) { const f32x4 g = gr[64 * j]; v2u w; w.x = pk2(v[j][0] * rs * g[0], v[j][1] * rs * g[1]); w.y = pk2(v[j][2] * rs * g[2], v[j][3] * rs * g[3]); o8[64 * j] = w; }
        }
        if (gw == 0) {
            const float* lg = a.in[6]; float* lb = (float*)(ws + WS_LB);
            for (int c = lane; c < 512; c += 64) { const float a0 = lg[c], a1 = lg[512 + c], a2 = lg[1024 + c]; const float mx = fmaxf(a0, fmaxf(a1, a2));
                const float e0 = expf(a0 - mx), e1 = expf(a1 - mx), e2 = expf(a2 - mx); lb[c] = e0 / (e0 + e1 + e2); }
        }
        if (gw == 2) {
            float* gx = (float*)(ws + WS_GXA); float* go = (float*)(ws + WS_GOD);
            for (int i = lane; i < 512; i += 64) gx[i] = a.in[18][i] * a.in[17][i];
            for (int i = lane; i < 128; i += 64) go[i] = a.in[10][i] * a.in[9][i];
        }
        if (gw == 1) {
            const float* rb = a.in[11]; float* bt = (float*)(ws + WS_BIAST);
            for (int i = lane; i < 3 * 8 * 132; i += 64) { const int br = i / (8 * 132), h = (i / 132) % 8, dl = i % 132; const int d = dl * (1 << (2 * br));
                int bucket; if (d < 16) bucket = d; else { const float lr = logf((float)d / 16.0f) / 4.852030263919617f; int lg2 = 16 + (int)(lr * 16.0f); bucket = lg2 < 31 ? lg2 : 31; }
                bt[i] = (dl <= 128) ? rb[bucket * 8 + h] : 0.f; }
        }
    }
    if (a.layer_mask & 2) {
        CONVERT_JOB(a.in[8], D, OD_IN, a.in[2] + D, WS_ODIN, 0);
        CONVERT_JOB(a.in[12], D, D, (const float*)nullptr, WS_ODOUT, 0);
        CONVERT_JOB(a.in[15] + (size_t)D * D, D, D, a.in[13] + D, WS_XQ1, 0);
        CONVERT_JOB(a.in[16] + (size_t)D * 2 * D, D, 2 * D, (const float*)nullptr, WS_XKV1, 0);
        CONVERT_JOB(a.in[19] + (size_t)D * D, D, D, (const float*)nullptr, WS_XO1, 0);
        CONVERT_JOB(a.in[21] + (size_t)D * 2 * DFF, D, 2 * DFF, a.in[20] + D, WS_FIN1, a.ffn_mode);
        CONVERT_JOB(a.in[24] + (size_t)DFF * D, DFF, D, (const float*)nullptr, WS_FOUT1, 0);
    }
}


typedef short bf16x8 __attribute__((ext_vector_type(8)));
typedef short s16x4 __attribute__((ext_vector_type(4)));
typedef float f32x16 __attribute__((ext_vector_type(16)));
typedef float f32x2_t __attribute__((ext_vector_type(2))); typedef __bf16 bf16x2_t __attribute__((ext_vector_type(2)));
typedef short v4i16_t __attribute__((ext_vector_type(4)));
#define MFMA32(a, b, c) __builtin_amdgcn_mfma_f32_32x32x16_bf16((a), (b), (c), 0, 0, 0)
__device__ __forceinline__ unsigned cvtpk(float lo, float hi) { f32x2_t v = {lo, hi}; bf16x2_t b = __builtin_convertvector(v, bf16x2_t); return __builtin_bit_cast(unsigned, b); }
__device__ __forceinline__ bf16x8 pack8(float a0, float a1, float a2, float a3, float a4, float a5, float a6, float a7) {
    v4u p; p.x = cvtpk(a0, a1); p.y = cvtpk(a2, a3); p.z = cvtpk(a4, a5); p.w = cvtpk(a6, a7); return __builtin_bit_cast(bf16x8, p); }
__device__ __forceinline__ s16x4 vtr(const LAS char* p) { return __builtin_bit_cast(s16x4, __builtin_amdgcn_ds_read_tr16_b64_v4i16((LAS v4i16_t*)p)); }
__device__ __forceinline__ int tr_lane_base(int lane, int stride) { const int g = lane >> 4, i = lane & 15, q = i >> 2, p = i & 3, h2 = g >> 1; return (4 * h2 + q) * stride + (16 * (g & 1) + 4 * p) * 2; }
__device__ __forceinline__ bf16x8 tr_frag_perm(const LAS char* img, int stride, int lbase, int k0, int n0) {
    const LAS char* p = img + lbase + k0 * stride + n0 * 2;
    const s16x4 lo = vtr(p), hi = vtr(p + 8 * stride);
    return (bf16x8){lo[0], lo[1], lo[2], lo[3], hi[0], hi[1], hi[2], hi[3]};
}
__device__ __forceinline__ int tr_lane_base_nat(int lane, int stride) { const int g = lane >> 4, i = lane & 15, q = i >> 2, p = i & 3, h2 = g >> 1; return (8 * h2 + q) * stride + (16 * (g & 1) + 4 * p) * 2; }
__device__ __forceinline__ bf16x8 tr_frag_nat(const LAS char* img, int stride, int lbase, int k0, int n0) {
    const LAS char* p = img + lbase + k0 * stride + n0 * 2;
    const s16x4 lo = vtr(p), hi = vtr(p + 4 * stride);
    return (bf16x8){lo[0], lo[1], lo[2], lo[3], hi[0], hi[1], hi[2], hi[3]};
}

constexpr int XA_STRIDE = 528;
constexpr int XA_LDS = 256 * XA_STRIDE;
__device__ __forceinline__ void xattn_unit(LAS char* lds, const bf16* __restrict__ Q, const bf16* __restrict__ MKV, const float* __restrict__ gkq, bf16* __restrict__ O, int unit, int tid) {
    const int lane = tid & 63, w = __builtin_amdgcn_readfirstlane(tid >> 6), r = lane & 31, h2 = lane >> 5;
    const int rb = unit >> 2, h = unit & 3, row0 = rb * 256, b = row0 / SEQ;
    const bf16* Kg = MKV + (size_t)(b * NMEM) * 2048 + h * 256; const bf16* Vg = Kg + 1024;
    v4u st[16];
#pragma unroll
    for (int i = 0; i < 16; ++i) { const int id = tid + 512 * i; st[i] = *(const v4u*)(Kg + (size_t)(id >> 5) * 2048 + (id & 31) * 8); }
    const size_t qoff = (size_t)(row0 + 32 * w + r) * D + h * 256;
    bf16x8 qf[16];
#pragma unroll
    for (int s = 0; s < 16; ++s) qf[s] = *(const bf16x8*)(Q + qoff + 8 * h2 + 16 * s);
    { float gk8[8];
#pragma unroll
      for (int e = 0; e < 8; ++e) gk8[e] = gkq[(tid & 31) * 8 + e];
#pragma unroll
      for (int i = 0; i < 16; ++i) { const int id = tid + 512 * i; float f[8]; unpack8(st[i], f);
          float sq = (f[0] * f[0] + f[1] * f[1]) + (f[2] * f[2] + f[3] * f[3]) + (f[4] * f[4] + f[5] * f[5]) + (f[6] * f[6] + f[7] * f[7]);
          sq += __shfl_xor(sq, 1); sq += __shfl_xor(sq, 2); sq += __shfl_xor(sq, 4); sq += __shfl_xor(sq, 8); sq += __shfl_xor(sq, 16);
          const float rk = 1.0f / sqrtf(sq * (1.0f / 256.0f) + EPS) * 0.0625f;
          v4u o; o.x = cvtpk(f[0] * rk * gk8[0], f[1] * rk * gk8[1]); o.y = cvtpk(f[2] * rk * gk8[2], f[3] * rk * gk8[3]); o.z = cvtpk(f[4] * rk * gk8[4], f[5] * rk * gk8[5]); o.w = cvtpk(f[6] * rk * gk8[6], f[7] * rk * gk8[7]);
          *(LAS v4u*)(lds + (id >> 5) * XA_STRIDE + (id & 31) * 16) = o; } }
    float ss = 0.f;
#pragma unroll
    for (int s = 0; s < 16; ++s)
#pragma unroll
        for (int j = 0; j < 8; ++j) { const float x = __uint_as_float((unsigned)(unsigned short)qf[s][j] << 16); ss += x * x; }
    ss += __shfl_xor(ss, 32);
    const float rsl = 1.0f / sqrtf(ss * (1.0f / 256.0f) + EPS) * 1.4426950408889634f;
    __syncthreads();
    bf16x8 pf[8][2]; float den = 0.f;
#pragma unroll
    for (int kb = 0; kb < 8; ++kb) {
        f32x16 acc;
#pragma unroll
        for (int i = 0; i < 16; ++i) acc[i] = 0.f;
        const LAS char* kp = lds + (32 * kb + r) * XA_STRIDE + h2 * 16;
#pragma unroll
        for (int s = 0; s < 16; ++s) { const bf16x8 a = *(const LAS bf16x8*)(kp + s * 32); acc = MFMA32(a, qf[s], acc); }
        float p[16];
#pragma unroll
        for (int i = 0; i < 16; ++i) { p[i] = __builtin_amdgcn_exp2f(acc[i] * rsl - 11.541560327111707f); den += p[i]; }
        pf[kb][0] = pack8(p[0], p[1], p[2], p[3], p[4], p[5], p[6], p[7]); pf[kb][1] = pack8(p[8], p[9], p[10], p[11], p[12], p[13], p[14], p[15]);
    }
    den += __shfl_xor(den, 32);
    const float inv = 1.0f / den;
    __syncthreads();
#pragma unroll
    for (int i = 0; i < 16; ++i) { const int id = tid + 512 * i; st[i] = *(const v4u*)(Vg + (size_t)(id >> 5) * 2048 + (id & 31) * 8); }
#pragma unroll
    for (int i = 0; i < 16; ++i) { const int id = tid + 512 * i; *(LAS v4u*)(lds + (id >> 5) * XA_STRIDE + (id & 31) * 16) = st[i]; }
    __syncthreads();
    const int lbase = tr_lane_base(lane, XA_STRIDE);
#pragma unroll
    for (int half = 0; half < 2; ++half) {
        f32x16 o[4];
#pragma unroll
        for (int vb = 0; vb < 4; ++vb)
#pragma unroll
            for (int i = 0; i < 16; ++i) o[vb][i] = 0.f;
#pragma unroll
        for (int kb = 0; kb < 8; ++kb)
#pragma unroll
            for (int s = 0; s < 2; ++s)
#pragma unroll
                for (int vb = 0; vb < 4; ++vb) { const bf16x8 a = tr_frag_perm(lds, XA_STRIDE, lbase, 32 * kb + 16 * s, 128 * half + 32 * vb); o[vb] = MFMA32(a, pf[kb][s], o[vb]); }
        bf16* orow = O + qoff + 128 * half + 4 * h2;
#pragma unroll
        for (int vb = 0; vb < 4; ++vb)
#pragma unroll
            for (int g4 = 0; g4 < 4; ++g4) { v2u wv; wv.x = cvtpk(o[vb][4 * g4] * inv, o[vb][4 * g4 + 1] * inv); wv.y = cvtpk(o[vb][4 * g4 + 2] * inv, o[vb][4 * g4 + 3] * inv);
                *(v2u*)(orow + 32 * vb + 8 * g4) = wv; }
    }
    __syncthreads();
}


constexpr int DA_STRIDE = 272, DA_LDS_BIAS = 384 * DA_STRIDE;
struct DaArgs { const bf16* QKV; const float* biasT; const float* gkq; bf16* N0; float* DEN0; const bf16* N1; const float* DEN1; const bf16* N2; const float* DEN2; bf16* O; int br0; int nbr; int mode; int pad; };
template <int MODE> __device__ __forceinline__ void dattn_unit(LAS char* lds, const DaArgs& a, int br, int bh, int x, int tid) {
    const int lane = tid & 63, w = __builtin_amdgcn_readfirstlane(tid >> 6), r = lane & 31, h2 = lane >> 5;
    const int b = bh >> 3, h = bh & 7, dil = 1 << (2 * br);
    const int cls = br == 0 ? 0 : (br == 1 ? (x & 3) : x), u = br == 0 ? x : (br == 1 ? (x >> 2) : 0), l0 = 256 * u;
    const bf16* base = a.QKV + (size_t)(b * SEQ) * OD_IN + h * 128;
    v4u st[6];
#pragma unroll
    for (int i = 0; i < 6; ++i) { const int id = tid + 512 * i, ki = id >> 4, lk = l0 - 128 + ki;
        st[i] = lk >= 0 ? *(const v4u*)(base + (size_t)(lk * dil + cls) * OD_IN + 1024 + (id & 15) * 8) : (v4u){0u, 0u, 0u, 0u}; }
    const size_t qrow = (size_t)(b * SEQ + (l0 + 32 * w + r) * dil + cls);
    bf16x8 qf[8];
#pragma unroll
    for (int s = 0; s < 8; ++s) qf[s] = *(const bf16x8*)(a.QKV + qrow * OD_IN + h * 128 + 8 * h2 + 16 * s);
    float gk8[8];
#pragma unroll
    for (int e = 0; e < 8; ++e) gk8[e] = a.gkq[(tid & 15) * 8 + e];
#define DA_NORM_STORE(ii, vv) do { const int id_ = tid + 512 * (ii); float f_[8]; unpack8((vv), f_); \
        float sq_ = (f_[0] * f_[0] + f_[1] * f_[1]) + (f_[2] * f_[2] + f_[3] * f_[3]) + (f_[4] * f_[4] + f_[5] * f_[5]) + (f_[6] * f_[6] + f_[7] * f_[7]); \
        sq_ += __shfl_xor(sq_, 1); sq_ += __shfl_xor(sq_, 2); sq_ += __shfl_xor(sq_, 4); sq_ += __shfl_xor(sq_, 8); \
        const float rk_ = 1.0f / sqrtf(sq_ * (1.0f / 128.0f) + EPS) * 0.08838834764831845f; \
        v4u o_; o_.x = cvtpk(f_[0] * rk_ * gk8[0], f_[1] * rk_ * gk8[1]); o_.y = cvtpk(f_[2] * rk_ * gk8[2], f_[3] * rk_ * gk8[3]); o_.z = cvtpk(f_[4] * rk_ * gk8[4], f_[5] * rk_ * gk8[5]); o_.w = cvtpk(f_[6] * rk_ * gk8[6], f_[7] * rk_ * gk8[7]); \
        *(LAS v4u*)(lds + (id_ >> 4) * DA_STRIDE + (id_ & 15) * 16) = o_; } while (0)
#pragma unroll
    for (int i = 0; i < 6; ++i) DA_NORM_STORE(i, st[i]);
    asm volatile("" ::: "memory");
#pragma unroll
    for (int i = 0; i < 6; ++i) { const int id = tid + 512 * (i + 6), ki = id >> 4, lk = l0 - 128 + ki;
        st[i] = lk >= 0 ? *(const v4u*)(base + (size_t)(lk * dil + cls) * OD_IN + 1024 + (id & 15) * 8) : (v4u){0u, 0u, 0u, 0u}; }
#pragma unroll
    for (int i = 0; i < 6; ++i) DA_NORM_STORE(i + 6, st[i]);
#undef DA_NORM_STORE
    LAS float* lbias = (LAS float*)(lds + DA_LDS_BIAS);
    if (tid < 132) lbias[tid] = a.biasT[(br * 8 + h) * 132 + tid];
    float ss = 0.f;
#pragma unroll
    for (int s = 0; s < 8; ++s)
#pragma unroll
        for (int j = 0; j < 8; ++j) { const float xq = __uint_as_float((unsigned)(unsigned short)qf[s][j] << 16); ss += xq * xq; }
    ss += __shfl_xor(ss, 32);
    const float rsl = 1.0f / sqrtf(ss * (1.0f / 128.0f) + EPS) * 1.4426950408889634f;
    __syncthreads();
    bf16x8 pf[5][2]; float den = 0.f;
#pragma unroll
    for (int kbi = 0; kbi < 5; ++kbi) {
        f32x16 acc;
#pragma unroll
        for (int i = 0; i < 16; ++i) acc[i] = 0.f;
        const LAS char* kp = lds + (32 * (w + kbi) + r) * DA_STRIDE + h2 * 16;
#pragma unroll
        for (int s = 0; s < 8; ++s) { const bf16x8 av = *(const LAS bf16x8*)(kp + s * 32); acc = MFMA32(av, qf[s], acc); }
        float p[16];
#pragma unroll
        for (int i = 0; i < 16; ++i) { const int c = (i & 3) + 8 * (i >> 2) + 4 * h2; const int delta = 128 - 32 * kbi + r - c; const int ki = 32 * (w + kbi) + c;
            const bool valid = (delta >= 0) && (delta <= 128) && (l0 - 128 + ki >= 0); const int dcl = delta < 0 ? 0 : (delta > 128 ? 128 : delta);
            const float e = __builtin_amdgcn_exp2f(acc[i] * rsl + lbias[dcl] * 1.4426950408889634f - 11.541560327111707f); p[i] = valid ? e : 0.f; den += p[i]; }
        pf[kbi][0] = pack8(p[0], p[1], p[2], p[3], p[4], p[5], p[6], p[7]); pf[kbi][1] = pack8(p[8], p[9], p[10], p[11], p[12], p[13], p[14], p[15]);
        asm volatile("" ::: "memory");
    }
    den += __shfl_xor(den, 32);
    __syncthreads();
#pragma unroll
    for (int bt = 0; bt < 2; ++bt) {
#pragma unroll
        for (int i = 0; i < 6; ++i) { const int id = tid + 512 * (i + 6 * bt), ki = id >> 4, lk = l0 - 128 + ki;
            st[i] = lk >= 0 ? *(const v4u*)(base + (size_t)(lk * dil + cls) * OD_IN + 2048 + (id & 15) * 8) : (v4u){0u, 0u, 0u, 0u}; }
#pragma unroll
        for (int i = 0; i < 6; ++i) { const int id = tid + 512 * (i + 6 * bt); *(LAS v4u*)(lds + (id >> 4) * DA_STRIDE + (id & 15) * 16) = st[i]; }
        asm volatile("" ::: "memory");
    }
    __syncthreads();
    const int lbase = tr_lane_base(lane, DA_STRIDE);
    const size_t ooff = qrow * D + h * 128 + 4 * h2;
    float inv = 1.0f;
    if (MODE == 0) { if (h2 == 0) ((float*)(br == 1 ? a.DEN1 : a.DEN2))[qrow * 8 + h] = den; }
    else { inv = 1.0f / (den + a.DEN1[qrow * 8 + h] + a.DEN2[qrow * 8 + h]); }
#pragma unroll
    for (int half = 0; half < 2; ++half) {
        f32x16 o[2];
#pragma unroll
        for (int vb = 0; vb < 2; ++vb)
#pragma unroll
            for (int i = 0; i < 16; ++i) o[vb][i] = 0.f;
#pragma unroll
        for (int kbi = 0; kbi < 5; ++kbi)
#pragma unroll
            for (int s = 0; s < 2; ++s)
#pragma unroll
                for (int vb = 0; vb < 2; ++vb) { const bf16x8 av = tr_frag_perm(lds, DA_STRIDE, lbase, 32 * (w + kbi) + 16 * s, 64 * half + 32 * vb); o[vb] = MFMA32(av, pf[kbi][s], o[vb]); }
        if (MODE == 0) {
            bf16* N = (bf16*)(br == 1 ? a.N1 : a.N2) + ooff + 64 * half;
#pragma unroll
            for (int vb = 0; vb < 2; ++vb)
#pragma unroll
                for (int g4 = 0; g4 < 4; ++g4) { v2u wv; wv.x = cvtpk(o[vb][4 * g4], o[vb][4 * g4 + 1]); wv.y = cvtpk(o[vb][4 * g4 + 2], o[vb][4 * g4 + 3]); *(v2u*)(N + 32 * vb + 8 * g4) = wv; }
        } else {
            const bf16* N1 = a.N1 + ooff + 64 * half; const bf16* N2 = a.N2 + ooff + 64 * half; bf16* Op = a.O + ooff + 64 * half;
#pragma unroll
            for (int vb = 0; vb < 2; ++vb)
#pragma unroll
                for (int g4 = 0; g4 < 4; ++g4) { const v2u n1 = *(const v2u*)(N1 + 32 * vb + 8 * g4), n2 = *(const v2u*)(N2 + 32 * vb + 8 * g4);
                    const float x0 = o[vb][4 * g4] + __uint_as_float(n1.x << 16) + __uint_as_float(n2.x << 16), x1 = o[vb][4 * g4 + 1] + __uint_as_float(n1.x & 0xffff0000u) + __uint_as_float(n2.x & 0xffff0000u);
                    const float x2 = o[vb][4 * g4 + 2] + __uint_as_float(n1.y << 16) + __uint_as_float(n2.y << 16), x3 = o[vb][4 * g4 + 3] + __uint_as_float(n1.y & 0xffff0000u) + __uint_as_float(n2.y & 0xffff0000u);
                    v2u wv; wv.x = cvtpk(x0 * inv, x1 * inv); wv.y = cvtpk(x2 * inv, x3 * inv); *(v2u*)(Op + 32 * vb + 8 * g4) = wv; }
        }
        asm volatile("" ::: "memory");
    }
    __syncthreads();
}


constexpr int MX_STRIDE = 272, MX_IMG = 128 * MX_STRIDE;
constexpr int MX_Q = 0, MX_K = MX_IMG, MX_V = 2 * MX_IMG, MX_SCR = 3 * MX_IMG;
struct MixArgs { bf16* Z; const float* lb; const float* ret_g; const float* hg_g; bf16* SBUF; float* DECA; float* DECB; };

__device__ __forceinline__ void st_chunk8(LAS char* img, int row, int c0, const float (&f)[8]) {
    v4u o; o.x = cvtpk(f[0], f[1]); o.y = cvtpk(f[2], f[3]); o.z = cvtpk(f[4], f[5]); o.w = cvtpk(f[6], f[7]); *(LAS v4u*)(img + row * MX_STRIDE + c0 * 2) = o; }

__device__ __forceinline__ void ret_prep_tile(LAS char* img, const bf16* zrow  , int j, int cg, const float (&sn)[16], const float (&cs)[16], float sc) {
#pragma unroll
    for (int hc = 0; hc < 2; ++hc) { float x1[8], x2[8], o1[8], o2[8];
        unpack8(*(const v4u*)(zrow + 16 * cg + 8 * hc), x1); unpack8(*(const v4u*)(zrow + 64 + 16 * cg + 8 * hc), x2);
#pragma unroll
        for (int e = 0; e < 8; ++e) { o1[e] = (x1[e] * cs[8 * hc + e] - x2[e] * sn[8 * hc + e]) * sc; o2[e] = (x1[e] * sn[8 * hc + e] + x2[e] * cs[8 * hc + e]) * sc; }
        st_chunk8(img, j, 16 * cg + 8 * hc, o1); st_chunk8(img, j, 64 + 16 * cg + 8 * hc, o2); }
}
__device__ __forceinline__ void copy_tile(LAS char* img, const bf16* src, int tid) {
#pragma unroll
    for (int i = 0; i < 4; ++i) { const int id = tid + 512 * i, row = id >> 4, ch = id & 15; *(LAS v4u*)(img + row * MX_STRIDE + ch * 16) = *(const v4u*)(src + (size_t)row * EV_IN + ch * 8); }
}
__device__ __forceinline__ void hg_gates(const bf16* zrow_f  , const float* lbh  , int tid, LAS float* scr, float (&cum)[32], float (&kk)[32]) {
    const int lane = tid & 63, hw = (tid >> 6) & 1, cg = tid >> 7;
#pragma unroll
    for (int q = 0; q < 4; ++q) { float fl[8]; unpack8(*(const v4u*)(zrow_f + 32 * cg + 8 * q), fl);
#pragma unroll
        for (int e = 0; e < 8; ++e) { const float l = lbh[32 * cg + 8 * q + e]; const float f = l + (1.0f - l) * (1.0f / (1.0f + __expf(-fl[e]))); kk[8 * q + e] = 1.0f - f; cum[8 * q + e] = __logf(fmaxf(f, 1e-6f)); } }
#pragma unroll
    for (int off = 1; off < 64; off <<= 1) {
#pragma unroll
        for (int c = 0; c < 32; ++c) { const float t = __shfl_up(cum[c], off); if (lane >= off) cum[c] += t; } }
    if (hw == 0 && lane == 63) {
#pragma unroll
        for (int c = 0; c < 32; ++c) scr[32 * cg + c] = cum[c]; }
    __syncthreads();
    if (hw == 1) {
#pragma unroll
        for (int c = 0; c < 32; ++c) cum[c] += scr[32 * cg + c]; }
    if (hw == 1 && lane == 63) {
#pragma unroll
        for (int c = 0; c < 32; ++c) scr[128 + 32 * cg + c] = cum[c]; }
    __syncthreads();
}

__device__ __forceinline__ void mixA_unit(LAS char* lds, const MixArgs& a, int u, int tid) {
    const int lane = tid & 63, w = __builtin_amdgcn_readfirstlane(tid >> 6), r = lane & 31, h2 = lane >> 5;
    const int g = u >> 5, n = u & 31, mixer = g >> 4, b = (g >> 2) & 3, h = g & 3;
    const int j = tid & 127, cg = tid >> 7;
    const bf16* zt = a.Z + (size_t)(b * SEQ + 128 * n) * EV_IN;
    LAS float* scr = (LAS float*)(lds + MX_SCR);
    if (mixer == 0) {
        const float gamma = 1.0f - exp2f(-5.0f - (float)h), lg2 = log2f(gamma);
        float sn[16], cs[16];
#pragma unroll
        for (int e = 0; e < 16; ++e) { const float inv = exp2f(-(float)(16 * cg + e) * (13.287712379549449f / 64.0f)); rope_sincos((float)(128 * n + j) * inv, sn[e], cs[e]); }
        ret_prep_tile(lds + MX_K, zt + (size_t)j * EV_IN + Z_RK + h * 128, j, cg, sn, cs, 0.08838834764831845f * exp2f((float)(127 - j) * lg2));
        copy_tile(lds + MX_V, zt + Z_RV + h * 128, tid);
        if (tid < 128) { a.DECA[(size_t)u * 128 + tid] = exp2f(128.0f * lg2); a.DECB[(size_t)u * 128 + tid] = gamma; }
    } else {
        float cum[32], kk[32];
        hg_gates(zt + (size_t)j * EV_IN + Z_GF + h * 128, a.lb + h * 128, tid, scr, cum, kk);
#pragma unroll
        for (int q = 0; q < 4; ++q) { float o[8];
#pragma unroll
            for (int e = 0; e < 8; ++e) o[e] = kk[8 * q + e] * __expf(scr[128 + 32 * cg + 8 * q + e] - cum[8 * q + e]);
            st_chunk8(lds + MX_K, j, 32 * cg + 8 * q, o); }
        copy_tile(lds + MX_V, zt + Z_GI + h * 128, tid);
        if (tid < 128) { a.DECA[(size_t)u * 128 + tid] = __expf(scr[128 + tid]); a.DECB[(size_t)u * 128 + tid] = __expf(scr[tid]); }
    }
    __syncthreads();
    const int lbn = tr_lane_base_nat(lane, MX_STRIDE); const int kbk = w >> 1, vb0 = 2 * (w & 1);
    f32x16 acc[2];
#pragma unroll
    for (int t = 0; t < 2; ++t)
#pragma unroll
        for (int i = 0; i < 16; ++i) acc[t][i] = 0.f;
#pragma unroll
    for (int s = 0; s < 8; ++s) { const bf16x8 av = tr_frag_nat(lds + MX_K, MX_STRIDE, lbn, 16 * s, 32 * kbk);
#pragma unroll
        for (int t = 0; t < 2; ++t) { const bf16x8 bv = tr_frag_nat(lds + MX_V, MX_STRIDE, lbn, 16 * s, 32 * (vb0 + t)); acc[t] = MFMA32(av, bv, acc[t]); } }
    bf16* sb = a.SBUF + (size_t)u * 16384;
#pragma unroll
    for (int t = 0; t < 2; ++t)
#pragma unroll
        for (int g4 = 0; g4 < 4; ++g4) { v2u wv; wv.x = cvtpk(acc[t][4 * g4], acc[t][4 * g4 + 1]); wv.y = cvtpk(acc[t][4 * g4 + 2], acc[t][4 * g4 + 3]);
            *(v2u*)(sb + (size_t)(32 * (vb0 + t) + r) * 128 + 32 * kbk + 8 * g4 + 4 * h2) = wv; }
    __syncthreads();
}

__device__ __forceinline__ void mix_scan(const MixArgs& a, int gtid, int nthreads) {
    for (int e = gtid; e < 32 * 4096; e += nthreads) { const int g = e >> 12, el = e & 4095, dk4 = el & 31;
        bf16* sp = a.SBUF + (size_t)(g * 32) * 16384 + (size_t)el * 4; const float* da = a.DECA + (size_t)(g * 32) * 128 + 4 * dk4; const float* db = a.DECB + (size_t)(g * 32) * 128 + 4 * dk4;
        f32x4 S = (f32x4){0.f, 0.f, 0.f, 0.f};
#pragma unroll 8
        for (int n = 0; n < 32; ++n) { const v2u kv = *(const v2u*)(sp + (size_t)n * 16384); const f32x4 A = *(const f32x4*)(da + n * 128), Bv = *(const f32x4*)(db + n * 128);
            const f32x4 so = S * Bv; v2u wv; wv.x = cvtpk(so[0], so[1]); wv.y = cvtpk(so[2], so[3]); *(v2u*)(sp + (size_t)n * 16384) = wv;
            S[0] = A[0] * S[0] + __uint_as_float(kv.x << 16); S[1] = A[1] * S[1] + __uint_as_float(kv.x & 0xffff0000u); S[2] = A[2] * S[2] + __uint_as_float(kv.y << 16); S[3] = A[3] * S[3] + __uint_as_float(kv.y & 0xffff0000u); }
    }
}

__device__ __forceinline__ void mixC_unit(LAS char* lds, const MixArgs& a, int u, int tid) {
    const int lane = tid & 63, w = __builtin_amdgcn_readfirstlane(tid >> 6), r = lane & 31, h2 = lane >> 5;
    const int g = u >> 5, n = u & 31, mixer = g >> 4, b = (g >> 2) & 3, h = g & 3;
    const int j = tid & 127, cg = tid >> 7;
    bf16* zt = a.Z + (size_t)(b * SEQ + 128 * n) * EV_IN;
    LAS float* scr = (LAS float*)(lds + MX_SCR);
    if (mixer == 0) {
        const float gamma = 1.0f - exp2f(-5.0f - (float)h), lg2 = log2f(gamma);
        float sn[16], cs[16];
#pragma unroll
        for (int e = 0; e < 16; ++e) { const float inv = exp2f(-(float)(16 * cg + e) * (13.287712379549449f / 64.0f)); rope_sincos((float)(128 * n + j) * inv, sn[e], cs[e]); }
        ret_prep_tile(lds + MX_Q, zt + (size_t)j * EV_IN + Z_RQ + h * 128, j, cg, sn, cs, exp2f((float)j * lg2));
        ret_prep_tile(lds + MX_K, zt + (size_t)j * EV_IN + Z_RK + h * 128, j, cg, sn, cs, 0.08838834764831845f * exp2f(-(float)j * lg2));
        copy_tile(lds + MX_V, zt + Z_RV + h * 128, tid);
    } else {
        float cum[32], kk[32];
        hg_gates(zt + (size_t)j * EV_IN + Z_GF + h * 128, a.lb + h * 128, tid, scr, cum, kk);
#pragma unroll
        for (int q = 0; q < 4; ++q) { float qv[8], oq[8], ok[8]; unpack8(*(const v4u*)(zt + (size_t)j * EV_IN + Z_GQ + h * 128 + 32 * cg + 8 * q), qv);
#pragma unroll
            for (int e = 0; e < 8; ++e) { const float d = cum[8 * q + e] - scr[32 * cg + 8 * q + e]; oq[e] = qv[e] * __expf(d); ok[e] = kk[8 * q + e] * __expf(-d); }
            st_chunk8(lds + MX_Q, j, 32 * cg + 8 * q, oq); st_chunk8(lds + MX_K, j, 32 * cg + 8 * q, ok); }
        copy_tile(lds + MX_V, zt + Z_GI + h * 128, tid);
    }
    __syncthreads();
    const int vb = w >> 1; const int lbp = tr_lane_base(lane, MX_STRIDE);
    const bf16* sb = a.SBUF + (size_t)u * 16384 + (size_t)(32 * vb + r) * 128 + 8 * h2;
    bf16x8 sf[8];
#pragma unroll
    for (int s = 0; s < 8; ++s) sf[s] = *(const bf16x8*)(sb + 16 * s);
    f32x16 o[2]; float s1[2], s2[2];
#pragma unroll
    for (int t = 0; t < 2; ++t) {
        const int ib = (w & 1) ? (1 + t) : (3 * t);
        bf16x8 qf[8];
#pragma unroll
        for (int s = 0; s < 8; ++s) qf[s] = *(const LAS bf16x8*)(lds + MX_Q + (32 * ib + r) * MX_STRIDE + h2 * 16 + s * 32);
#pragma unroll
        for (int i = 0; i < 16; ++i) o[t][i] = 0.f;
#pragma unroll
        for (int s = 0; s < 8; ++s) o[t] = MFMA32(sf[s], qf[s], o[t]);
        for (int jb = 0; jb <= ib; ++jb) {
            f32x16 acc;
#pragma unroll
            for (int i = 0; i < 16; ++i) acc[i] = 0.f;
            const LAS char* kp = lds + MX_K + (32 * jb + r) * MX_STRIDE + h2 * 16;
#pragma unroll
            for (int s = 0; s < 8; ++s) { const bf16x8 av = *(const LAS bf16x8*)(kp + s * 32); acc = MFMA32(av, qf[s], acc); }
            if (jb == ib) {
#pragma unroll
                for (int i = 0; i < 16; ++i) { const int c = (i & 3) + 8 * (i >> 2) + 4 * h2; if (c > r) acc[i] = 0.f; } }
            const bf16x8 p0 = pack8(acc[0], acc[1], acc[2], acc[3], acc[4], acc[5], acc[6], acc[7]), p1 = pack8(acc[8], acc[9], acc[10], acc[11], acc[12], acc[13], acc[14], acc[15]);
            const bf16x8 v0 = tr_frag_perm(lds + MX_V, MX_STRIDE, lbp, 32 * jb, 32 * vb), v1 = tr_frag_perm(lds + MX_V, MX_STRIDE, lbp, 32 * jb + 16, 32 * vb);
            o[t] = MFMA32(v0, p0, o[t]); o[t] = MFMA32(v1, p1, o[t]);
        }
        float a1 = 0.f, a2 = 0.f;
#pragma unroll
        for (int i = 0; i < 16; ++i) { a1 += o[t][i]; a2 += o[t][i] * o[t][i]; }
        a1 += __shfl_xor(a1, 32); a2 += __shfl_xor(a2, 32); s1[t] = a1; s2[t] = a2;
        if (h2 == 0) { scr[256 + (vb * 128 + 32 * ib + r) * 2] = a1; scr[256 + (vb * 128 + 32 * ib + r) * 2 + 1] = a2; }
    }
    __syncthreads();
    const float* gn = (mixer == 0 ? a.ret_g : a.hg_g) + h * 128 + 32 * vb + 4 * h2;
#pragma unroll
    for (int t = 0; t < 2; ++t) {
        const int ib = (w & 1) ? (1 + t) : (3 * t); const int tok = 32 * ib + r;
        float t1 = 0.f, t2 = 0.f;
#pragma unroll
        for (int v = 0; v < 4; ++v) { t1 += scr[256 + (v * 128 + tok) * 2]; t2 += scr[256 + (v * 128 + tok) * 2 + 1]; }
        float mu = 0.f, rstd;
        if (mixer == 0) { mu = t1 * (1.0f / 128.0f); rstd = 1.0f / sqrtf(fmaxf(t2 * (1.0f / 128.0f) - mu * mu, 0.f) + EPS); } else rstd = 1.0f / sqrtf(t2 * (1.0f / 128.0f) + EPS);
        bf16* zr = zt + (size_t)tok * EV_IN;
        const bf16* gp = zr + (mixer == 0 ? Z_RG : Z_GG) + h * 128 + 32 * vb + 4 * h2; bf16* yp = zr + (mixer == 0 ? Z_RQ : Z_GQ) + h * 128 + 32 * vb + 4 * h2;
#pragma unroll
        for (int g4 = 0; g4 < 4; ++g4) { const v2u gw = *(const v2u*)(gp + 8 * g4); const f32x4 gv = *(const f32x4*)(gn + 8 * g4);
            const float ga[4] = {__uint_as_float(gw.x << 16), __uint_as_float(gw.x & 0xffff0000u), __uint_as_float(gw.y << 16), __uint_as_float(gw.y & 0xffff0000u)}; float y[4];
#pragma unroll
            for (int e = 0; e < 4; ++e) { y[e] = (o[t][4 * g4 + e] - mu) * rstd * gv[e] * (ga[e] / (1.0f + __expf(-ga[e]))); }
            v2u wv; wv.x = cvtpk(y[0], y[1]); wv.y = cvtpk(y[2], y[3]); *(v2u*)(yp + 8 * g4) = wv; }
    }
    __syncthreads();
}


__device__ __forceinline__ float gelu_tanh(float x) { const float u = 0.7978845608028654f * (x + 0.044715f * x * x * x); const float t = 1.0f - 2.0f / (1.0f + __expf(2.0f * u)); return 0.5f * x * (1.0f + t); }
__device__ __forceinline__ void ffn_ew(const bf16* GU, const float* cw, const float* cb, bf16* H, int rows, int gtid, int nthreads) {
    for (int idx = gtid; idx < rows * (DFF / 8); idx += nthreads) {
        const int row = idx / (DFF / 8), c0 = (idx % (DFF / 8)) * 8, t = row % SEQ;
        float g0[8], g1[8], g2[8], u[8];
        unpack8(*(const v4u*)(GU + (size_t)row * (2 * DFF) + c0), g2); unpack8(*(const v4u*)(GU + (size_t)row * (2 * DFF) + DFF + c0), u);
        if (t >= 1) unpack8(*(const v4u*)(GU + (size_t)(row - 1) * (2 * DFF) + c0), g1); else { for (int i = 0; i < 8; ++i) g1[i] = 0.f; }
        if (t >= 2) unpack8(*(const v4u*)(GU + (size_t)(row - 2) * (2 * DFF) + c0), g0); else { for (int i = 0; i < 8; ++i) g0[i] = 0.f; }
        float r[8];
#pragma unroll
        for (int i = 0; i < 8; ++i) { const float y = cw[c0 + i] * g0[i] + cw[DFF + c0 + i] * g1[i] + cw[2 * DFF + c0 + i] * g2[i] + cb[c0 + i]; r[i] = gelu_tanh(y) * u[i]; }
        v4u o; o.x = cvtpk(r[0], r[1]); o.y = cvtpk(r[2], r[3]); o.z = cvtpk(r[4], r[5]); o.w = cvtpk(r[6], r[7]);
        *(v4u*)(H + (size_t)row * DFF + c0) = o;
    }
}

constexpr int LDS_BYTES = 147456;
constexpr int LDSCTL_OFF = LDS_BYTES - 512;
constexpr int CW_BAR = 4096;
constexpr size_t CTL_ZERO_BYTES = 1 * MiB;
#define XB_TMO      128
#define XB_XCNT(j)  (256  + 64 * (j))
#define XB_XSUB(j)  (1280 + 64 * (j))
#define XB_XGEN(j)  (2304 + 64 * (j))
#define XB_TOP      3328
#define XB_TOPGEN   3392
#define XCD_BAR_WORDS 3456
#define XB_SPIN_CAP (1u << 18)

__device__ __forceinline__ unsigned xb_ld(unsigned* p)              { return __hip_atomic_load(p, __ATOMIC_RELAXED, __HIP_MEMORY_SCOPE_AGENT); }
__device__ __forceinline__ unsigned xb_add(unsigned* p, unsigned v) { return __hip_atomic_fetch_add(p, v, __ATOMIC_RELAXED, __HIP_MEMORY_SCOPE_AGENT); }
__device__ __forceinline__ unsigned xb_xcc_id() { return (unsigned)__builtin_amdgcn_s_getreg((3 << 11) | 20) & 0xFu; }
#define XB_SPIN(cond, bar) do { unsigned _sp = 0; while (cond) { __builtin_amdgcn_s_sleep(1); \
    if ((++_sp & 255u) == 0u) { if (xb_ld(&(bar)[XB_TMO])) break; if (_sp > XB_SPIN_CAP) { atomicAdd(&(bar)[XB_TMO], 1u); break; } } } } while (0)

struct XcdBarrier {
    unsigned* bar; unsigned x;
    volatile LAS unsigned* st;
};

__device__ __forceinline__ XcdBarrier xcd_barrier_post(unsigned* bar, volatile LAS unsigned* st) {
    XcdBarrier b; b.bar = bar; b.x = xb_xcc_id(); b.st = st;
    if (threadIdx.x == 0) (void)xb_add(&bar[XB_XCNT(b.x)], 1u);
    return b;
}
__device__ __forceinline__ void xcd_barrier_complete(unsigned* bar, unsigned x, unsigned& nloc, unsigned& nx) {
    const unsigned G = gridDim.x * gridDim.y * gridDim.z;
    unsigned sum, cnt, mine, sp = 0u;
    for (;;) {
        sum = 0u; cnt = 0u; mine = 0u;
#pragma unroll
        for (unsigned j = 0; j < 16; ++j) { const unsigned c = xb_ld(&bar[XB_XCNT(j)]); sum += c; cnt += (c > 0u) ? 1u : 0u; mine = (j == x) ? c : mine; }
        if (sum == G) break;
        __builtin_amdgcn_s_sleep(1);
        if ((++sp & 255u) == 0u) { if (xb_ld(&bar[XB_TMO])) break; if (sp > XB_SPIN_CAP) { atomicAdd(&bar[XB_TMO], 1u); break; } }
    }
    nloc = mine > 0u ? mine : 1u; nx = cnt > 0u ? cnt : 1u;
}

__device__ __forceinline__ void xcd_barrier(const XcdBarrier& b) {
    asm volatile("s_waitcnt vmcnt(0)" ::: "memory");
    __syncthreads();
    if (threadIdx.x == 0) {
        unsigned* bar = b.bar;
        __builtin_amdgcn_s_waitcnt(0);
        unsigned nloc = b.st[0], nx = b.st[1];
        if (nloc == 0u) { xcd_barrier_complete(bar, b.x, nloc, nx); b.st[0] = nloc; b.st[1] = nx; }
        const unsigned old = xb_add(&bar[XB_XSUB(b.x)], 1u);
        const unsigned gen = old / nloc;
        if (old + 1u == (gen + 1u) * nloc) {
            __builtin_amdgcn_fence(__ATOMIC_RELEASE, "agent");
            asm volatile("s_waitcnt vmcnt(0)" ::: "memory");
            const unsigned og = xb_add(&bar[XB_TOP], 1u);
            const unsigned tg = og / nx;
            if (og + 1u == (tg + 1u) * nx) xb_add(&bar[XB_TOPGEN], 1u);
            else XB_SPIN(xb_ld(&bar[XB_TOPGEN]) == tg, bar);
            __builtin_amdgcn_fence(__ATOMIC_ACQUIRE, "agent");
            xb_add(&bar[XB_XGEN(b.x)], 1u);
            asm volatile("s_waitcnt vmcnt(0)" ::: "memory");
        } else {
            XB_SPIN(xb_ld(&bar[XB_XGEN(b.x)]) == gen, bar);
            __builtin_amdgcn_fence(__ATOMIC_ACQUIRE, "agent");
            asm volatile("s_waitcnt vmcnt(0)" ::: "memory");
        }
    }
    __syncthreads();
}


struct FwdArgs { const float* in[25]; float* out; unsigned char* ws; int ph_lo, ph_hi, li, pad; };
__global__ void __launch_bounds__(512, 2) fwd(FwdArgs a) {
    extern __shared__ __attribute__((aligned(16))) unsigned char lds_raw[];
    LAS unsigned char* lds = (LAS unsigned char*)lds_raw;
    const int tid = threadIdx.x, lane = tid & 63, wave = __builtin_amdgcn_readfirstlane(tid >> 6);
    const int G = gridDim.x, bx = blockIdx.x;
    volatile LAS unsigned* MISC = (volatile LAS unsigned*)(lds + LDSCTL_OFF);
    if (tid < 64) MISC[tid] = 0u;
    __syncthreads();
    unsigned char* ws = a.ws; float* out = a.out;
    XcdBarrier bar = xcd_barrier_post((unsigned*)(ws + WS_CTL) + CW_BAR + a.li * XCD_BAR_WORDS, MISC + 8);
    int ph = 0; const int lo = a.ph_lo, hi = a.ph_hi;
#define PH_ON (ph >= lo && ph < hi)
#define TID_L ({ int t_ = tid; asm volatile("" : "+v"(t_)); t_; })
#define PH_END do { if (ph >= lo && ph + 1 < hi) xcd_barrier(bar); ++ph; } while (0)
    bf16* XB = (bf16*)(ws + WS_XB); float* SSQP = (float*)(ws + WS_SSQP); bf16* ACT = (bf16*)(ws + WS_ACT);

    if (PH_ON) { ProArgs pa;
#pragma unroll
        for (int i = 0; i < 25; ++i) pa.in[i] = a.in[i];
        pa.ws = ws; pa.layer_mask = 3; pa.ffn_mode = 0;
        { const int t_ = TID_L; prologue_body(pa, bx * 8 + (t_ >> 6), G * 8, t_ & 63, (LAS float*)lds + (t_ >> 6) * 64 * 33); } }
    PH_END;

    for (int l = 0; l < 2; ++l) {
        if (PH_ON) {
            { pg8::Gemm g{XB, (const bf16*)(ws + (l ? WS_ODIN : WS_EVIN)), M, l ? OD_IN : EV_IN, D, D}; pg8::EpiBf16S E{ACT, SSQP, l ? OD_IN : EV_IN, M, EPS, 0};
              pg8::StaticOrder S; S.init(g.M, g.N, G, bx); pg8::gemm_phase<pg8::EpiBf16S, pg8::StaticOrder, true, true>(lds, g, S, E); }
            if (l == 0) {
                for (int lm = 0; lm < 2; ++lm) { __syncthreads();
                    pg8::Gemm g{(const bf16*)(ws + (lm ? WS_MEMH1 : WS_MEMH0)), (const bf16*)(ws + (lm ? WS_XKV1 : WS_XKV0)), MM, 2 * D, D, D}; pg8::EpiBf16S E{(bf16*)(ws + (lm ? WS_MKV1 : WS_MKV0)), nullptr, 2 * D, M, EPS, 0};
                    pg8::StaticOrder S; S.init(g.M, g.N, G, (bx + 128 + 64 * lm) % G); pg8::gemm_phase<pg8::EpiBf16S, pg8::StaticOrder, true, true>(lds, g, S, E); }
            }
        }
        PH_END;
        const bf16* mixo; int mixo_ld;
        if (l == 0) {
            MixArgs ma{ACT, (const float*)(ws + WS_LB), a.in[4], a.in[5], (bf16*)out, (float*)(ws + WS_DECA), (float*)(ws + WS_DECB)};
            if (PH_ON) { for (int u = bx; u < 1024; u += G) mixA_unit((LAS char*)lds, ma, u, TID_L); }
            PH_END;
            if (PH_ON) mix_scan(ma, bx * 512 + TID_L, G * 512);
            PH_END;
            if (PH_ON) { for (int u = bx; u < 1024; u += G) mixC_unit((LAS char*)lds, ma, u, TID_L); }
            PH_END;
            mixo = ACT; mixo_ld = EV_IN;
        } else {
            bf16* O = (bf16*)(ws + WS_ACT + 96 * MiB);
            DaArgs da; da.QKV = ACT; da.biasT = (const float*)(ws + WS_BIAST); da.gkq = (const float*)(ws + WS_GOD); da.N0 = (bf16*)(ws + WS_N2); da.DEN0 = (float*)(ws + WS_DEN23);
            da.N1 = (const bf16*)(ws + WS_N2); da.DEN1 = (const float*)(ws + WS_DEN23); da.N2 = (const bf16*)(ws + WS_N3); da.DEN2 = (const float*)(ws + WS_DEN23) + (size_t)M * 8; da.O = O; da.br0 = 1; da.nbr = 2; da.mode = 0; da.pad = 0;
            if (PH_ON) { for (int uu = bx; uu < 1024; uu += G) { const int br = 1 + (uu >> 9), rem = uu & 511; dattn_unit<0>((LAS char*)lds, da, br, rem >> 4, rem & 15, TID_L); } }
            PH_END;
            if (PH_ON) { for (int uu = bx; uu < 512; uu += G) dattn_unit<1>((LAS char*)lds, da, 0, uu >> 4, uu & 15, TID_L); }
            PH_END;
            mixo = O; mixo_ld = D;
        }
        if (PH_ON) { pg8::Gemm g{mixo, (const bf16*)(ws + (l ? WS_ODOUT : WS_EVOUT)), M, D, D, mixo_ld}; pg8::EpiResid E{l ? (const float*)out : a.in[0], out, XB, SSQP, D, M};
            pg8::StaticOrder S; S.init(g.M, g.N, G, bx); pg8::gemm_phase<pg8::EpiResid, pg8::StaticOrder, false, true>(lds, g, S, E); }
        PH_END;
        { bf16* Q = ACT; bf16* O = (bf16*)(ws + WS_ACT + 32 * MiB);
          if (PH_ON) { pg8::Gemm g{XB, (const bf16*)(ws + (l ? WS_XQ1 : WS_XQ0)), M, D, D, D}; pg8::EpiBf16S E{Q, SSQP, D, M, EPS, 0};
              pg8::StaticOrder S; S.init(g.M, g.N, G, bx); pg8::gemm_phase<pg8::EpiBf16S, pg8::StaticOrder, true, true>(lds, g, S, E); }
          PH_END;
          if (PH_ON) { for (int u = bx; u < (M / 256) * 4; u += G) xattn_unit((LAS char*)lds, Q, (const bf16*)(ws + (l ? WS_MKV1 : WS_MKV0)), (const float*)(ws + WS_GXA) + l * 256, O, u, TID_L); }
          PH_END;
          if (PH_ON) { pg8::Gemm g{O, (const bf16*)(ws + (l ? WS_XO1 : WS_XO0)), M, D, D, D}; pg8::EpiResid E{out, out, XB, SSQP, D, M};
              pg8::StaticOrder S; S.init(g.M, g.N, G, bx); pg8::gemm_phase<pg8::EpiResid, pg8::StaticOrder, false, true>(lds, g, S, E); }
          PH_END; }
        for (int hf = 0; hf < 2; ++hf) { const int r0 = hf * (M / 2), Mr = M / 2; bf16* GU = ACT; bf16* H = (bf16*)(ws + WS_ACT + 88 * MiB);
          if (PH_ON) { pg8::Gemm g{XB + (size_t)r0 * D, (const bf16*)(ws + (l ? WS_FIN1 : WS_FIN0)), Mr, 2 * DFF, D, D}; pg8::EpiBf16S E{GU, SSQP + r0, 2 * DFF, M, EPS, 0};
              pg8::StaticOrder S; S.init(g.M, g.N, G, bx); pg8::gemm_phase<pg8::EpiBf16S, pg8::StaticOrder, true, true>(lds, g, S, E); }
          PH_END;
          if (PH_ON) ffn_ew(GU, a.in[22] + (size_t)l * 3 * DFF, a.in[23] + (size_t)l * DFF, H, Mr, bx * 512 + TID_L, G * 512);
          PH_END;
          if (PH_ON) { pg8::Gemm g{H, (const bf16*)(ws + (l ? WS_FOUT1 : WS_FOUT0)), Mr, D, DFF, DFF}; pg8::EpiResid E{out + (size_t)r0 * D, out + (size_t)r0 * D, XB + (size_t)r0 * D, SSQP + r0, D, M};
              pg8::StaticOrder S; S.init(g.M, g.N, G, bx); pg8::gemm_phase<pg8::EpiResid, pg8::StaticOrder, false, true>(lds, g, S, E); }
          PH_END; }
    }
#undef PH_ON
#undef PH_END
#undef TID_L
}
constexpr int N_PHASES = 1 + 5 + 3 + 6 + 4 + 3 + 6;

#ifndef MK_PER_PHASE
#define MK_PER_PHASE 0
#endif
extern "C" void kernel_launch(void* const* d_in, const int* in_sizes, int n_in, void* d_out, int out_size, void* d_ws, size_t ws_size, hipStream_t stream) {
    static int inited = 0;
    if (!inited) {
        if (n_in != 25 || out_size != M * D || ws_size < WS_END) { fprintf(stderr, "kernel_launch: unexpected shapes (n_in %d, out %d, ws %zu)\n", n_in, out_size, ws_size); inited = -1; return; }
        if (hipFuncSetAttribute((const void*)fwd, hipFuncAttributeMaxDynamicSharedMemorySize, LDS_BYTES) != hipSuccess) { fprintf(stderr, "kernel_launch: hipFuncSetAttribute failed\n"); inited = -1; return; }
        inited = 1;
    }
    if (inited < 0) return;
    if (hipMemsetAsync((char*)d_ws + WS_CTL, 0, CTL_ZERO_BYTES, stream) != hipSuccess) return;
    FwdArgs fa{}; for (int i = 0; i < 25; ++i) fa.in[i] = (const float*)d_in[i]; fa.out = (float*)d_out; fa.ws = (unsigned char*)d_ws; fa.pad = 0;
#if MK_PER_PHASE
    for (int p = 0; p < N_PHASES; ++p) { fa.ph_lo = p; fa.ph_hi = p + 1; fa.li = 0; hipLaunchKernelGGL(fwd, dim3(256), dim3(512), LDS_BYTES, stream, fa); }
#else
    fa.ph_lo = 0; fa.ph_hi = N_PHASES; fa.li = 0; hipLaunchKernelGGL(fwd, dim3(256), dim3(512), LDS_BYTES, stream, fa);
#endif
}
```

```cpp
#include <hip/hip_runtime.h>
#include <cstdio>
#include <cstdint>
namespace pg8 {
#define PG8_LAS __attribute__((address_space(3)))
typedef unsigned short bf16_t;
typedef short bf16x8 __attribute__((ext_vector_type(8)));
typedef float f32x4 __attribute__((ext_vector_type(4)));
typedef unsigned u32x4 __attribute__((ext_vector_type(4)));
constexpr int BM = 256, BK = 64, HALF = 128, HTB = HALF * BK * 2  , STAGE_BYTES = 8 * HTB, NXCD = 8, WGM = 8;

__host__ __device__ __forceinline__ int lds_byte(int r, int c) { const int st = (r >> 4) * 2 + (c >> 5), rr = r & 15, cc = c & 31, ob = rr * 64 + cc * 2; return st * 1024 + (ob ^ (((ob >> 9) & 1) << 5)); }
__host__ __device__ __forceinline__ void stage_rc(int b, int& R, int& C) { const int st = b / 1024, sb = b % 1024, swz = sb ^ (((sb >> 9) & 1) << 5); R = (st >> 1) * 16 + swz / 64; C = (st & 1) * 32 + (swz % 64) / 2; }
__host__ __device__ __forceinline__ int perm32(int rho) { const int n = rho >> 4, i = rho & 15; return 8 * (i >> 2) + 4 * n + (i & 3); }

struct Unit { int pm, pn; };
struct Gemm { const bf16_t* A; const bf16_t* Bt; int M, N, K, lda; };

struct StaticOrder {
    int nM, nN, nwg, G, c;
    __host__ __device__ void init(int M, int N, int G_, int c_) { nM = M / BM; nN = N / BM; nwg = nM * nN; G = G_; c = c_; }
    __host__ __device__ bool next(int i, Unit& u) const {
        const long L = (long)i * G + c; if (L >= nwg) return false;
        int wgid = (int)L; { const int q = nwg / NXCD, r = nwg % NXCD, xcd = wgid % NXCD, off = wgid / NXCD; wgid = (xcd < r ? xcd * (q + 1) : r * (q + 1) + (xcd - r) * q) + off; }
        const int nig = WGM * nN, gid = wgid / nig, fm = gid * WGM, gsz = (nM - fm) < WGM ? (nM - fm) : WGM;
        u.pm = fm + ((wgid % nig) % gsz); u.pn = (wgid % nig) / gsz; return true;
    }
    __device__ __forceinline__ void a_ready(const Unit&) const {}
    __device__ __forceinline__ void done(const Unit&) const {}
    __device__ __forceinline__ int arow(const Unit& u) const { return u.pm * BM; }
};
struct FfnOrder : StaticOrder {
    __device__ __forceinline__ int arow(const Unit& u) const { return (u.pm / 17) * 4096 + 254 * (u.pm % 17) - 2; }
};

__device__ __forceinline__ unsigned cvt_pk_bf16(float lo, float hi) { unsigned r; asm volatile("v_cvt_pk_bf16_f32 %0, %1, %2" : "=v"(r) : "v"(lo), "v"(hi)); return r; }
typedef float f32x2 __attribute__((ext_vector_type(2)));
struct EpiBf16S {
    static constexpr bool PERM = true, AFTER_DRAIN = false;
    bf16_t* O; const float* ssqp; int ldc; int Mtot; float eps; int pad;
    __device__ __forceinline__ void operator()(f32x4 (&acc)[2][2][4][2], const Unit& u, int wr, int wc, int fr, int fq, PG8_LAS unsigned char*) const {
        const int row0 = u.pm * BM + wr * 64 + fr; const int col0 = u.pn * BM + wc * 32 + 8 * fq;
#pragma unroll
        for (int ai = 0; ai < 2; ++ai)
#pragma unroll
            for (int m = 0; m < 4; ++m) { const int row = row0 + ai * HALF + m * 16; float rs = 1.f;
                if (ssqp) { const float s = (ssqp[row] + ssqp[Mtot + row]) + (ssqp[2 * Mtot + row] + ssqp[3 * Mtot + row]); rs = 1.0f / sqrtf(s * (1.0f / 1024.0f) + eps); }
                bf16_t* rowp = O + (size_t)row * ldc + col0;
#pragma unroll
                for (int bj = 0; bj < 2; ++bj) { const f32x4 v0 = acc[ai][bj][m][0] * rs, v1 = acc[ai][bj][m][1] * rs;
                    u32x4 w; w.x = cvt_pk_bf16(v0[0], v0[1]); w.y = cvt_pk_bf16(v0[2], v0[3]); w.z = cvt_pk_bf16(v1[0], v1[1]); w.w = cvt_pk_bf16(v1[2], v1[3]);
                    *(u32x4*)(rowp + bj * HALF) = w; } }
    }
};

__device__ __forceinline__ float gelu_tanh_f(float x) { const float u = 0.7978845608028654f * (x + 0.044715f * x * x * x); const float t = 1.0f - 2.0f / (1.0f + __expf(2.0f * u)); return 0.5f * x * (1.0f + t); }
struct EpiFfn {
    static constexpr bool PERM = true, AFTER_DRAIN = false;
    bf16_t* H; const float* ssqp; const float* cw; const float* cb; int Mtot; float eps;
    __device__ __forceinline__ void operator()(f32x4 (&acc)[2][2][4][2], const Unit& u, int wr, int wc, int fr, int fq, PG8_LAS unsigned char* lds) const {
        constexpr int DFF_ = 2816;
        const int b = u.pm / 17, t = u.pm % 17, pos0 = 254 * t - 2, rowb = b * 4096 + pos0;
        const int colh = u.pn * 128 + wc * 32 + 8 * fq, lane = fq * 16 + fr;
        PG8_LAS float* halo = (PG8_LAS float*)(lds + STAGE_BYTES);
#pragma unroll
        for (int ai = 0; ai < 2; ++ai)
#pragma unroll
            for (int m = 0; m < 4; ++m) { const int rl = ai * HALF + wr * 64 + m * 16 + fr, row = rowb + rl; const int rc = row < 0 ? 0 : (row >= Mtot ? Mtot - 1 : row);
                const float sq = (ssqp[rc] + ssqp[Mtot + rc]) + (ssqp[2 * Mtot + rc] + ssqp[3 * Mtot + rc]); const float rs = 1.0f / sqrtf(sq * (1.0f / 1024.0f) + eps); const bool pad = (pos0 + rl) < 0;
#pragma unroll
                for (int n = 0; n < 2; ++n) {
#pragma unroll
                    for (int e = 0; e < 4; ++e) { acc[ai][0][m][n][e] = pad ? 0.f : acc[ai][0][m][n][e] * rs; acc[ai][1][m][n][e] *= rs; } } }
#pragma unroll
        for (int ai = 0; ai < 2; ++ai) if (fr >= 14) { PG8_LAS float* hp = halo + ((((2 * ai + wr) * 4 + wc) * 4 + fq) * 2 + (fr - 14)) * 8;
            *(PG8_LAS f32x4*)hp = acc[ai][0][3][0]; *(PG8_LAS f32x4*)(hp + 4) = acc[ai][0][3][1]; }
        asm volatile("s_waitcnt lgkmcnt(0)" ::: "memory"); __builtin_amdgcn_s_barrier(); asm volatile("" ::: "memory");
        const int src1 = (lane & 48) | ((fr + 15) & 15), src2 = (lane & 48) | ((fr + 14) & 15);
        typedef unsigned u32x2e __attribute__((ext_vector_type(2)));
#pragma unroll
        for (int n = 0; n < 2; ++n) {
            const f32x4 w0 = *(const f32x4*)(cw + colh + 4 * n), w1 = *(const f32x4*)(cw + DFF_ + colh + 4 * n), w2 = *(const f32x4*)(cw + 2 * DFF_ + colh + 4 * n), bb = *(const f32x4*)(cb + colh + 4 * n);
#pragma unroll
            for (int ai = 0; ai < 2; ++ai) {
                const int blk = 2 * ai + wr; f32x4 R1p = (f32x4){0.f, 0.f, 0.f, 0.f}, R2p = (f32x4){0.f, 0.f, 0.f, 0.f};
                if (blk >= 1) { const PG8_LAS float* hp = halo + ((((blk - 1) * 4 + wc) * 4 + fq) * 2) * 8 + 4 * n; const f32x4 h62 = *(const PG8_LAS f32x4*)hp, h63 = *(const PG8_LAS f32x4*)(hp + 8); R1p = h63; R2p = fr == 0 ? h62 : h63; }
#pragma unroll
                for (int m = 0; m < 4; ++m) { const int rl = ai * HALF + wr * 64 + m * 16 + fr; const bool ok = (rl >= 2) && (pos0 + rl < 4096);
                    float hv[4];
#pragma unroll
                    for (int e = 0; e < 4; ++e) { const float v = acc[ai][0][m][n][e]; const float r1 = __shfl(v, src1), r2 = __shfl(v, src2);
                        const float p1 = fr >= 1 ? r1 : R1p[e], p2 = fr >= 2 ? r2 : R2p[e]; R1p[e] = r1; R2p[e] = r2;
                        const float y = w0[e] * p2 + w1[e] * p1 + w2[e] * v + bb[e]; hv[e] = gelu_tanh_f(y) * acc[ai][1][m][n][e]; }
                    if (ok) { u32x2e w; w.x = cvt_pk_bf16(hv[0], hv[1]); w.y = cvt_pk_bf16(hv[2], hv[3]); *(u32x2e*)(H + (size_t)(rowb + rl) * DFF_ + colh + 4 * n) = w; } }
            }
        }
        asm volatile("s_waitcnt lgkmcnt(0)" ::: "memory"); __builtin_amdgcn_s_barrier(); asm volatile("" ::: "memory");
    }
};
struct EpiResid {
    static constexpr bool PERM = false, AFTER_DRAIN = true;
    const float* base; float* out; bf16_t* xb; float* ssqp; int ldc; int Mtot;
    __device__ __forceinline__ void fused(f32x4 (&acc)[2][2][4][2], const Unit& u, int wr, int wc, int fr, int fq, PG8_LAS unsigned char* lds, int wid, int lane) const {
        typedef unsigned u32x2v __attribute__((ext_vector_type(2)));
        PG8_LAS float* P = (PG8_LAS float*)lds;
        const int col0 = u.pn * BM + wc * 32 + 4 * fq;
#pragma unroll
        for (int ai = 0; ai < 2; ++ai)
#pragma unroll
            for (int m = 0; m < 4; ++m) { const int r = ai * HALF + wr * 64 + m * 16 + fr; const size_t off = (size_t)(u.pm * BM + r) * ldc + col0; float s = 0.f;
#pragma unroll
                for (int bj = 0; bj < 2; ++bj)
#pragma unroll
                    for (int n = 0; n < 2; ++n) { const f32x4 bs = *(const f32x4*)(base + off + bj * HALF + n * 16); const f32x4 o = bs + acc[ai][bj][m][n];
                        *(f32x4*)(out + off + bj * HALF + n * 16) = o; u32x2v w; w.x = cvt_pk_bf16(o[0], o[1]); w.y = cvt_pk_bf16(o[2], o[3]); *(u32x2v*)(xb + off + bj * HALF + n * 16) = w;
                        s += (o[0] * o[0] + o[1] * o[1]) + (o[2] * o[2] + o[3] * o[3]); }
                s += __shfl_xor(s, 16); s += __shfl_xor(s, 32);
                if (fq == 0) P[r * 4 + wc] = s;
                if (m & 1) asm volatile("" ::: "memory"); }
        asm volatile("s_waitcnt lgkmcnt(0)" ::: "memory"); __builtin_amdgcn_s_barrier(); asm volatile("" ::: "memory");
        if (lane < 32) { const int row = wid * 32 + lane; ssqp[(size_t)u.pn * Mtot + u.pm * BM + row] = (P[row * 4 + 0] + P[row * 4 + 1]) + (P[row * 4 + 2] + P[row * 4 + 3]); }
        asm volatile("s_waitcnt lgkmcnt(0)" ::: "memory"); __builtin_amdgcn_s_barrier(); asm volatile("" ::: "memory");
    }
};

template <class Epi, class Sched, bool ALIGN_EPI = false, bool SP2 = false>
__device__ __forceinline__ void gemm_phase(PG8_LAS unsigned char* lds, const Gemm g, const Sched& S, const Epi& E) {
    int tid_l = threadIdx.x; asm volatile("" : "+v"(tid_l));
    const int tid = tid_l, wid = __builtin_amdgcn_readfirstlane(tid >> 6), lane = tid & 63, wr = wid >> 2, wc = wid & 3, fr = lane & 15, fq = lane >> 4;
    const int K = g.K, nt = K / BK;
    unsigned voffA[2], voffB[2];
#pragma unroll
    for (int i = 0; i < 2; ++i) { int R, C; stage_rc(tid * 16 + i * 8192, R, C); const int Rb = Epi::PERM ? ((R & ~31) + perm32(R & 31)) : R;
        voffA[i] = (unsigned)(R * g.lda + C) * 2u; voffB[i] = (unsigned)(Rb * K + C) * 2u; }
    const size_t kstep = (size_t)(BK * 2);
    const size_t hstepA = (size_t)HALF * g.lda * 2, hstepB = (size_t)HALF * K * 2;
    const size_t tstepB = 2 * hstepB;
    const unsigned ldsw = (unsigned)wid * 1024u;
    const int aoff = lds_byte(wr * 64 + fr, fq * 8), boff = lds_byte(wc * 32 + fr, fq * 8);
#define PG8_SA(b, h) (((b) * 2 + (h)) * HTB)
#define PG8_SB(b, h) ((4 + (b) * 2 + (h)) * HTB)
#define PG8_STAGE(bufoff, gbase, voff) do { _Pragma("unroll") for (int _i = 0; _i < 2; ++_i) \
        __builtin_amdgcn_global_load_lds((const unsigned*)((const char*)(gbase) + (voff)[_i]), (PG8_LAS unsigned*)(lds + (bufoff) + ldsw + _i * 8192), 16, 0, 0); } while (0)
#define PG8_LDA(dst, b, h) do { _Pragma("unroll") for (int m = 0; m < 4; ++m) _Pragma("unroll") for (int k = 0; k < 2; ++k) dst[m][k] = *(const PG8_LAS bf16x8*)(lds + PG8_SA(b, h) + aoff + m * 2048 + k * 1024); } while (0)
#define PG8_LDB(dst, b, h) do { _Pragma("unroll") for (int n = 0; n < 2; ++n) _Pragma("unroll") for (int k = 0; k < 2; ++k) dst[n][k] = *(const PG8_LAS bf16x8*)(lds + PG8_SB(b, h) + boff + n * 2048 + k * 1024); } while (0)
#define PG8_MMA(ai, bj, At, Bt) do { __builtin_amdgcn_s_setprio(1); _Pragma("unroll") for (int m = 0; m < 4; ++m) _Pragma("unroll") for (int n = 0; n < 2; ++n) _Pragma("unroll") for (int k = 0; k < 2; ++k) \
        acc[ai][bj][m][n] = __builtin_amdgcn_mfma_f32_16x16x32_bf16(Bt[n][k], At[m][k], acc[ai][bj][m][n], 0, 0, 0); __builtin_amdgcn_s_setprio(0); } while (0)
#define PG8_WAIT_V(n) asm volatile("s_waitcnt vmcnt(" #n ")" ::: "memory")
#define PG8_WAIT_L(n) asm volatile("s_waitcnt lgkmcnt(" #n ")" ::: "memory")
#define PG8_BAR __builtin_amdgcn_s_barrier()
#define PG8_SCHED __builtin_amdgcn_sched_barrier(0)
    Unit cur, nxt; int ui = 0;
    if (!S.next(0, cur)) return;
    f32x4 acc[2][2][4][2];
#pragma unroll
    for (int a = 0; a < 2; ++a)
#pragma unroll
        for (int b = 0; b < 2; ++b)
#pragma unroll
            for (int m = 0; m < 4; ++m)
#pragma unroll
                for (int n = 0; n < 2; ++n) acc[a][b][m][n] = (f32x4){0.f, 0.f, 0.f, 0.f};
    bf16x8 At[4][2], B0[2][2], B1[2][2];
    const char* cA = (const char*)g.A + (ptrdiff_t)S.arow(cur) * (ptrdiff_t)(g.lda * 2); const char* cB = (const char*)g.Bt + (size_t)cur.pn * tstepB;
    S.a_ready(cur);
    if constexpr (SP2) {
        PG8_STAGE(PG8_SB(0, 0), cB, voffB); PG8_STAGE(PG8_SB(0, 1), cB + hstepB, voffB); PG8_STAGE(PG8_SA(0, 0), cA, voffA); PG8_STAGE(PG8_SA(0, 1), cA + hstepA, voffA);
        if (wr == 1) PG8_BAR;
        PG8_WAIT_V(2); PG8_BAR;
        PG8_STAGE(PG8_SB(1, 0), cB + kstep, voffB); PG8_STAGE(PG8_SA(1, 0), cA + kstep, voffA); PG8_STAGE(PG8_SB(1, 1), cB + hstepB + kstep, voffB);
        PG8_WAIT_V(6); PG8_BAR;
    } else {
        PG8_STAGE(PG8_SB(0, 0), cB, voffB); PG8_STAGE(PG8_SA(0, 0), cA, voffA); PG8_STAGE(PG8_SB(0, 1), cB + hstepB, voffB); PG8_STAGE(PG8_SA(0, 1), cA + hstepA, voffA);
        if (wr == 1) PG8_BAR;
        PG8_WAIT_V(4); PG8_BAR;
        PG8_STAGE(PG8_SB(1, 0), cB + kstep, voffB); PG8_STAGE(PG8_SA(1, 0), cA + kstep, voffA); PG8_STAGE(PG8_SB(1, 1), cB + hstepB + kstep, voffB);
        PG8_WAIT_V(6); PG8_BAR;
    }
    for (;;) {
        const bool has_next = S.next(ui + 1, nxt);
        const char* nA = has_next ? (const char*)g.A + (ptrdiff_t)S.arow(nxt) * (ptrdiff_t)(g.lda * 2) : cA; const char* nB = has_next ? (const char*)g.Bt + (size_t)nxt.pn * tstepB : cB;
        for (int t = 0; t < nt; t += 2) {
            const bool last = (t == nt - 2);
            const char* a1 = cA + (size_t)(t + 1) * kstep;
            const char* a2 = last ? nA : cA + (size_t)(t + 2) * kstep; const char* b2 = last ? nB : cB + (size_t)(t + 2) * kstep;
            const char* a3 = a2 + kstep; const char* b3 = b2 + kstep;
            if (last && has_next) S.a_ready(nxt);
            if constexpr (SP2) {
            PG8_LDB(B0, 0, 0); PG8_LDB(B1, 0, 1); PG8_SCHED; PG8_LDA(At, 0, 0); PG8_STAGE(PG8_SA(1, 1), a1 + hstepA, voffA);
            PG8_WAIT_V(8); PG8_WAIT_L(0); PG8_BAR; PG8_MMA(0, 0, At, B0); PG8_MMA(0, 1, At, B1); PG8_BAR; PG8_SCHED;
            PG8_LDA(At, 0, 1); PG8_STAGE(PG8_SB(0, 0), b2, voffB); PG8_STAGE(PG8_SB(0, 1), b2 + hstepB, voffB); PG8_STAGE(PG8_SA(0, 0), a2, voffA);
            PG8_WAIT_V(8); PG8_WAIT_L(0); PG8_BAR; PG8_MMA(1, 0, At, B0); PG8_MMA(1, 1, At, B1); PG8_BAR; PG8_SCHED;
            PG8_LDB(B0, 1, 0); PG8_LDB(B1, 1, 1); PG8_SCHED; PG8_LDA(At, 1, 0); PG8_STAGE(PG8_SA(0, 1), a2 + hstepA, voffA);
            PG8_WAIT_V(8); PG8_WAIT_L(0); PG8_BAR; PG8_MMA(0, 0, At, B0); PG8_MMA(0, 1, At, B1); PG8_BAR; PG8_SCHED;
            PG8_LDA(At, 1, 1); PG8_STAGE(PG8_SB(1, 0), b3, voffB); PG8_STAGE(PG8_SB(1, 1), b3 + hstepB, voffB); PG8_STAGE(PG8_SA(1, 0), a3, voffA);
            PG8_WAIT_V(8); PG8_WAIT_L(0); PG8_BAR; PG8_MMA(1, 0, At, B0); PG8_MMA(1, 1, At, B1); PG8_BAR; PG8_SCHED;
            } else {
            PG8_LDB(B0, 0, 0); PG8_SCHED; PG8_LDA(At, 0, 0); PG8_STAGE(PG8_SA(1, 1), a1 + hstepA, voffA);
            PG8_WAIT_L(8); PG8_BAR; PG8_WAIT_L(0); PG8_MMA(0, 0, At, B0); PG8_BAR; PG8_SCHED;
            PG8_LDB(B1, 0, 1); PG8_STAGE(PG8_SB(0, 0), b2, voffB);
            PG8_BAR; PG8_WAIT_L(0); PG8_MMA(0, 1, At, B1); PG8_BAR;
            PG8_LDA(At, 0, 1); PG8_STAGE(PG8_SA(0, 0), a2, voffA);
            PG8_BAR; PG8_WAIT_L(0); PG8_MMA(1, 0, At, B0); PG8_BAR; PG8_SCHED;
            PG8_STAGE(PG8_SB(0, 1), b2 + hstepB, voffB);
            PG8_WAIT_V(6); PG8_BAR; PG8_MMA(1, 1, At, B1); PG8_BAR;
            PG8_LDB(B0, 1, 0); PG8_SCHED; PG8_LDA(At, 1, 0); PG8_STAGE(PG8_SA(0, 1), a2 + hstepA, voffA);
            PG8_WAIT_L(8); PG8_BAR; PG8_WAIT_L(0); PG8_MMA(0, 0, At, B0); PG8_BAR; PG8_SCHED;
            PG8_LDB(B1, 1, 1); PG8_STAGE(PG8_SB(1, 0), b3, voffB);
            PG8_BAR; PG8_WAIT_L(0); PG8_MMA(0, 1, At, B1); PG8_BAR;
            PG8_LDA(At, 1, 1); PG8_STAGE(PG8_SA(1, 0), a3, voffA);
            PG8_BAR; PG8_WAIT_L(0); PG8_MMA(1, 0, At, B0); PG8_BAR; PG8_SCHED;
            PG8_STAGE(PG8_SB(1, 1), b3 + hstepB, voffB);
            PG8_WAIT_V(6); PG8_BAR; PG8_MMA(1, 1, At, B1); PG8_BAR;
            }
        }
        if constexpr (ALIGN_EPI) { if (wr == 0) PG8_BAR; }
        if constexpr (!Epi::AFTER_DRAIN) { E(acc, cur, wr, wc, fr, fq, lds); S.done(cur); }
        if (!has_next) break;
#pragma unroll
        for (int a = 0; a < 2; ++a)
#pragma unroll
            for (int b = 0; b < 2; ++b)
#pragma unroll
                for (int m = 0; m < 4; ++m)
#pragma unroll
                    for (int n = 0; n < 2; ++n) acc[a][b][m][n] = (f32x4){0.f, 0.f, 0.f, 0.f};
        cur = nxt; cA = nA; cB = nB; ++ui;
        if constexpr (ALIGN_EPI) { if (wr == 1) PG8_BAR; }
    }
    PG8_WAIT_V(0);
    if constexpr (!ALIGN_EPI) { if (wr == 0) PG8_BAR; }
    PG8_BAR;
    if constexpr (Epi::AFTER_DRAIN) { E.fused(acc, cur, wr, wc, fr, fq, lds, wid, lane); S.done(cur); }
#undef PG8_SA
#undef PG8_SB
#undef PG8_STAGE
#undef PG8_LDA
#undef PG8_LDB
#undef PG8_MMA
#undef PG8_WAIT_V
#undef PG8_WAIT_L
#undef PG8_BAR
#undef PG8_SCHED
}
}


#define GAS __attribute__((address_space(1)))
#define LAS __attribute__((address_space(3)))
typedef unsigned short bf16;
typedef unsigned v4u __attribute__((ext_vector_type(4)));
typedef unsigned v2u __attribute__((ext_vector_type(2)));
typedef float f32x4 __attribute__((ext_vector_type(4)));
constexpr int BATCH = 4, SEQ = 4096, D = 1024, M = BATCH * SEQ, NMEM = 256, MM = BATCH * NMEM, DFF = 2816;
constexpr int EV_IN = 4096, OD_IN = 3072;
constexpr float EPS = 1e-6f;
constexpr int Z_RQ = 0, Z_GQ = 512, Z_RK = 1024, Z_RV = 1536, Z_RG = 2048, Z_GF = 2560, Z_GI = 3072, Z_GG = 3584;

constexpr size_t MiB = 1u << 20;
constexpr size_t WS_CTL = 0;
constexpr size_t WS_EVIN = 1 * MiB, WS_EVOUT = 9 * MiB, WS_XQ0 = 11 * MiB, WS_XKV0 = 13 * MiB, WS_XO0 = 17 * MiB, WS_FIN0 = 19 * MiB, WS_FOUT0 = 30 * MiB;
constexpr size_t WS_ODIN = 36 * MiB, WS_ODOUT = 42 * MiB, WS_XQ1 = 44 * MiB, WS_XKV1 = 46 * MiB, WS_XO1 = 50 * MiB, WS_FIN1 = 52 * MiB, WS_FOUT1 = 63 * MiB;
constexpr size_t WS_XB = 69 * MiB;
constexpr size_t WS_MKV0 = 101 * MiB, WS_MKV1 = 105 * MiB;
constexpr size_t WS_MEMH0 = 109 * MiB, WS_MEMH1 = 111 * MiB;
constexpr size_t WS_SSQP = 113 * MiB;
constexpr size_t WS_LB = 113 * MiB + 512 * 1024;
constexpr size_t WS_BIAST = 113 * MiB + 516 * 1024;
constexpr size_t WS_GXA = 113 * MiB + 600 * 1024, WS_GOD = 113 * MiB + 604 * 1024;
constexpr size_t WS_DEN23 = 114 * MiB;
constexpr size_t WS_N2 = 1 * MiB;
constexpr size_t WS_N3 = 69 * MiB;
constexpr size_t WS_ACT = 115 * MiB;
constexpr size_t WS_DECA = 243 * MiB, WS_DECB = 243 * MiB + 512 * 1024;
constexpr size_t WS_END = 256 * MiB;

__device__ __forceinline__ float bf2f(bf16 u) { return __uint_as_float((unsigned)u << 16); }
__device__ __forceinline__ unsigned f2bf(float f) { unsigned u = __builtin_bit_cast(unsigned, f); return (u + 0x7fffu + ((u >> 16) & 1u)) >> 16; }
__device__ __forceinline__ unsigned pk2(float lo, float hi) { return f2bf(lo) | (f2bf(hi) << 16); }
__device__ __forceinline__ float wave_sum(float v) {
#pragma unroll
    for (int o = 1; o < 64; o <<= 1) v += __shfl_xor(v, o);
    return v;
}
__device__ __forceinline__ float wave_max(float v) {
#pragma unroll
    for (int o = 1; o < 64; o <<= 1) v = fmaxf(v, __shfl_xor(v, o));
    return v;
}
__device__ __forceinline__ void unpack8(const v4u w, float (&f)[8]) {
    f[0] = __uint_as_float(w.x << 16); f[1] = __uint_as_float(w.x & 0xffff0000u); f[2] = __uint_as_float(w.y << 16); f[3] = __uint_as_float(w.y & 0xffff0000u);
    f[4] = __uint_as_float(w.z << 16); f[5] = __uint_as_float(w.z & 0xffff0000u); f[6] = __uint_as_float(w.w << 16); f[7] = __uint_as_float(w.w & 0xffff0000u);
}
__device__ __forceinline__ void rope_sincos(float a, float& s, float& c) {
    const float n = rintf(a * 0.15915494309189535f);
    float r = fmaf(-n, 6.2831854820251465f, a); r = fmaf(-n, -1.7484555e-7f, r);
    const float rev = r * 0.15915494309189535f;
    s = __builtin_amdgcn_sinf(rev); c = __builtin_amdgcn_cosf(rev);
}

__device__ __forceinline__ int dst_row_map(int mode, int n0) {
    if (mode == 1) { const int seg = n0 >> 9, within = n0 & 511; const int dseg = (seg == 0) ? 0 : (seg == 4 ? 1 : (seg < 4 ? seg + 1 : seg)); return dseg * 512 + within; }
    if (mode == 2) { return n0 < DFF ? (n0 >> 7) * 256 + (n0 & 127) : ((n0 - DFF) >> 7) * 256 + 128 + ((n0 - DFF) & 127); }
    return n0;
}
__device__ __forceinline__ void transpose_item(const float* W, int K, int N, const float* g, bf16* WT, int mode, LAS float* scr, int item, int lane) {
    const int nblk = N / 32, kb = item / nblk, nb = item % nblk, k0 = 64 * kb, n0 = 32 * nb;
#pragma unroll 8
    for (int i = 0; i < 32; ++i) { const int kk = 2 * i + (lane >> 5); float w = W[(size_t)(k0 + kk) * N + n0 + (lane & 31)]; if (g) w *= g[k0 + kk]; scr[kk * 33 + (lane & 31)] = w; }
    asm volatile("s_waitcnt lgkmcnt(0)" ::: "memory");
    const int c = lane & 7; const int d0 = dst_row_map(mode, n0);
#pragma unroll
    for (int j = 0; j < 4; ++j) { const int n = (lane >> 3) + 8 * j; const LAS float* s = scr + (8 * c) * 33 + n;
        v4u o; o.x = pk2(s[0 * 33], s[1 * 33]); o.y = pk2(s[2 * 33], s[3 * 33]); o.z = pk2(s[4 * 33], s[5 * 33]); o.w = pk2(s[6 * 33], s[7 * 33]);
        *(v4u*)(WT + (size_t)(d0 + n) * K + k0 + 8 * c) = o; }
    asm volatile("s_waitcnt lgkmcnt(0)" ::: "memory");
}
struct ProArgs { const float* in[25]; unsigned char* ws; int layer_mask; int ffn_mode; };
#define CONVERT_JOB(Wp, K_, N_, gp, dst, mode) do { const int nitems = ((K_) / 64) * ((N_) / 32); for (int it = gw; it < nitems; it += NGW) transpose_item((Wp), (K_), (N_), (gp), (bf16*)(ws + (dst)), (mode), scr, it, lane); } while (0)
__device__ __forceinline__ void prologue_body(const ProArgs& a, int gw, int NGW, int lane, LAS float* scr) {
    unsigned char* ws = a.ws;
    const float* x = a.in[0]; const float* mem = a.in[1];
    if (a.layer_mask & 1) {
        CONVERT_JOB(a.in[3], D, EV_IN, a.in[2], WS_EVIN, 1);
        CONVERT_JOB(a.in[7], D, D, (const float*)nullptr, WS_EVOUT, 0);
        CONVERT_JOB(a.in[15], D, D, a.in[13], WS_XQ0, 0);
        CONVERT_JOB(a.in[16], D, 2 * D, (const float*)nullptr, WS_XKV0, 0);
        CONVERT_JOB(a.in[19], D, D, (const float*)nullptr, WS_XO0, 0);
        CONVERT_JOB(a.in[21], D, 2 * DFF, a.in[20], WS_FIN0, a.ffn_mode);
        CONVERT_JOB(a.in[24], DFF, D, (const float*)nullptr, WS_FOUT0, 0);
        for (int m = gw; m < M; m += NGW) {
            const f32x4* xr = (const f32x4*)(x + (size_t)m * D) + lane; v2u* o8 = (v2u*)((bf16*)(ws + WS_XB) + (size_t)m * D) + lane; float* sp = (float*)(ws + WS_SSQP);
#pragma unroll
            for (int j = 0; j < 4; ++j) { const f32x4 v = xr[64 * j]; v2u w; w.x = pk2(v[0], v[1]); w.y = pk2(v[2], v[3]); o8[64 * j] = w;
                const float s = wave_sum((v[0] * v[0] + v[1] * v[1]) + (v[2] * v[2] + v[3] * v[3])); if (lane == 0) sp[(size_t)j * M + m] = s; }
        }
        for (int r = gw; r < 2 * MM; r += NGW) { const int l = r / MM, m = r % MM;
            const f32x4* xr = (const f32x4*)(mem + (size_t)m * D) + lane; const f32x4* gr = (const f32x4*)(a.in[14] + (size_t)l * D) + lane;
            f32x4 v[4]; float s = 0.f;
#pragma unroll
            for (int j = 0; j < 4; ++j) { v[j] = xr[64 * j]; s += (v[j][0] * v[j][0] + v[j][1] * v[j][1]) + (v[j][2] * v[j][2] + v[j][3] * v[j][3]); }
            const float rs = 1.0f / sqrtf(wave_sum(s) * (1.0f / D) + EPS);
            v2u* o8 = (v2u*)((bf16*)(ws + (l ? WS_MEMH1 : WS_MEMH0)) + (size_t)m * D) + lane;
#pragma unroll
            for (int j = 0; j < 4; ++j) { const f32x4 g = gr[64 * j]; v2u w; w.x = pk2(v[j][0] * rs * g[0], v[j][1] * rs * g[1]); w.y = pk2(v[j][2] * rs * g[2], v[j][3] * rs * g[3]); o8[64 * j] = w; }
        }
        if (gw == 0) {
            const float* lg = a.in[6]; float* lb = (float*)(ws + WS_LB);
            for (int c = lane; c < 512; c += 64) { const float a0 = lg[c], a1 = lg[512 + c], a2 = lg[1024 + c]; const float mx = fmaxf(a0, fmaxf(a1, a2));
                const float e0 = expf(a0 - mx), e1 = expf(a1 - mx), e2 = expf(a2 - mx); lb[c] = e0 / (e0 + e1 + e2); }
        }
        if (gw == 2) {
            float* gx = (float*)(ws + WS_GXA); float* go = (float*)(ws + WS_GOD);
            for (int i = lane; i < 512; i += 64) gx[i] = a.in[18][i] * a.in[17][i];
            for (int i = lane; i < 128; i += 64) go[i] = a.in[10][i] * a.in[9][i];
        }
        if (gw == 1) {
            const float* rb = a.in[11]; float* bt = (float*)(ws + WS_BIAST);
            for (int i = lane; i < 3 * 8 * 132; i += 64) { const int br = i / (8 * 132), h = (i / 132) % 8, dl = i % 132; const int d = dl * (1 << (2 * br));
                int bucket; if (d < 16) bucket = d; else { const float lr = logf((float)d / 16.0f) / 4.852030263919617f; int lg2 = 16 + (int)(lr * 16.0f); bucket = lg2 < 31 ? lg2 : 31; }
                bt[i] = (dl <= 128) ? rb[bucket * 8 + h] : 0.f; }
        }
    }
    if (a.layer_mask & 2) {
        CONVERT_JOB(a.in[8], D, OD_IN, a.in[2] + D, WS_ODIN, 0);
        CONVERT_JOB(a.in[12], D, D, (const float*)nullptr, WS_ODOUT, 0);
        CONVERT_JOB(a.in[15] + (size_t)D * D, D, D, a.in[13] + D, WS_XQ1, 0);
        CONVERT_JOB(a.in[16] + (size_t)D * 2 * D, D, 2 * D, (const float*)nullptr, WS_XKV1, 0);
        CONVERT_JOB(a.in[19] + (size_t)D * D, D, D, (const float*)nullptr, WS_XO1, 0);
        CONVERT_JOB(a.in[21] + (size_t)D * 2 * DFF, D, 2 * DFF, a.in[20] + D, WS_FIN1, a.ffn_mode);
        CONVERT_JOB(a.in[24] + (size_t)DFF * D, DFF, D, (const float*)nullptr, WS_FOUT1, 0);
    }
}


typedef short bf16x8 __attribute__((ext_vector_type(8)));
typedef short s16x4 __attribute__((ext_vector_type(4)));
typedef float f32x16 __attribute__((ext_vector_type(16)));
typedef float f32x2_t __attribute__((ext_vector_type(2))); typedef __bf16 bf16x2_t __attribute__((ext_vector_type(2)));
typedef short v4i16_t __attribute__((ext_vector_type(4)));
#define MFMA32(a, b, c) __builtin_amdgcn_mfma_f32_32x32x16_bf16((a), (b), (c), 0, 0, 0)
__device__ __forceinline__ unsigned cvtpk(float lo, float hi) { f32x2_t v = {lo, hi}; bf16x2_t b = __builtin_convertvector(v, bf16x2_t); return __builtin_bit_cast(unsigned, b); }
__device__ __forceinline__ bf16x8 pack8(float a0, float a1, float a2, float a3, float a4, float a5, float a6, float a7) {
    v4u p; p.x = cvtpk(a0, a1); p.y = cvtpk(a2, a3); p.z = cvtpk(a4, a5); p.w = cvtpk(a6, a7); return __builtin_bit_cast(bf16x8, p); }
__device__ __forceinline__ s16x4 vtr(const LAS char* p) { return __builtin_bit_cast(s16x4, __builtin_amdgcn_ds_read_tr16_b64_v4i16((LAS v4i16_t*)p)); }
__device__ __forceinline__ int tr_lane_base(int lane, int stride) { const int g = lane >> 4, i = lane & 15, q = i >> 2, p = i & 3, h2 = g >> 1; return (4 * h2 + q) * stride + (16 * (g & 1) + 4 * p) * 2; }
__device__ __forceinline__ bf16x8 tr_frag_perm(const LAS char* img, int stride, int lbase, int k0, int n0) {
    const LAS char* p = img + lbase + k0 * stride + n0 * 2;
    const s16x4 lo = vtr(p), hi = vtr(p + 8 * stride);
    return (bf16x8){lo[0], lo[1], lo[2], lo[3], hi[0], hi[1], hi[2], hi[3]};
}
__device__ __forceinline__ int tr_lane_base_nat(int lane, int stride) { const int g = lane >> 4, i = lane & 15, q = i >> 2, p = i & 3, h2 = g >> 1; return (8 * h2 + q) * stride + (16 * (g & 1) + 4 * p) * 2; }
__device__ __forceinline__ bf16x8 tr_frag_nat(const LAS char* img, int stride, int lbase, int k0, int n0) {
    const LAS char* p = img + lbase + k0 * stride + n0 * 2;
    const s16x4 lo = vtr(p), hi = vtr(p + 4 * stride);
    return (bf16x8){lo[0], lo[1], lo[2], lo[3], hi[0], hi[1], hi[2], hi[3]};
}

constexpr int XA_STRIDE = 528;
constexpr int XA_LDS = 256 * XA_STRIDE;
__device__ __forceinline__ void xattn_unit(LAS char* lds, const bf16* __restrict__ Q, const bf16* __restrict__ MKV, const float* __restrict__ gkq, bf16* __restrict__ O, int unit, int tid) {
    const int lane = tid & 63, w = __builtin_amdgcn_readfirstlane(tid >> 6), r = lane & 31, h2 = lane >> 5;
    const int rb = unit >> 2, h = unit & 3, row0 = rb * 256, b = row0 / SEQ;
    const bf16* Kg = MKV + (size_t)(b * NMEM) * 2048 + h * 256; const bf16* Vg = Kg + 1024;
    v4u st[16];
#pragma unroll
    for (int i = 0; i < 16; ++i) { const int id = tid + 512 * i; st[i] = *(const v4u*)(Kg + (size_t)(id >> 5) * 2048 + (id & 31) * 8); }
    const size_t qoff = (size_t)(row0 + 32 * w + r) * D + h * 256;
    bf16x8 qf[16];
#pragma unroll
    for (int s = 0; s < 16; ++s) qf[s] = *(const bf16x8*)(Q + qoff + 8 * h2 + 16 * s);
    { float gk8[8];
#pragma unroll
      for (int e = 0; e < 8; ++e) gk8[e] = gkq[(tid & 31) * 8 + e];
#pragma unroll
      for (int i = 0; i < 16; ++i) { const int id = tid + 512 * i; float f[8]; unpack8(st[i], f);
          float sq = (f[0] * f[0] + f[1] * f[1]) + (f[2] * f[2] + f[3] * f[3]) + (f[4] * f[4] + f[5] * f[5]) + (f[6] * f[6] + f[7] * f[7]);
          sq += __shfl_xor(sq, 1); sq += __shfl_xor(sq, 2); sq += __shfl_xor(sq, 4); sq += __shfl_xor(sq, 8); sq += __shfl_xor(sq, 16);
          const float rk = 1.0f / sqrtf(sq * (1.0f / 256.0f) + EPS) * 0.0625f;
          v4u o; o.x = cvtpk(f[0] * rk * gk8[0], f[1] * rk * gk8[1]); o.y = cvtpk(f[2] * rk * gk8[2], f[3] * rk * gk8[3]); o.z = cvtpk(f[4] * rk * gk8[4], f[5] * rk * gk8[5]); o.w = cvtpk(f[6] * rk * gk8[6], f[7] * rk * gk8[7]);
          *(LAS v4u*)(lds + (id >> 5) * XA_STRIDE + (id & 31) * 16) = o; } }
    float ss = 0.f;
#pragma unroll
    for (int s = 0; s < 16; ++s)
#pragma unroll
        for (int j = 0; j < 8; ++j) { const float x = __uint_as_float((unsigned)(unsigned short)qf[s][j] << 16); ss += x * x; }
    ss += __shfl_xor(ss, 32);
    const float rsl = 1.0f / sqrtf(ss * (1.0f / 256.0f) + EPS) * 1.4426950408889634f;
    __syncthreads();
    bf16x8 pf[8][2]; float den = 0.f;
#pragma unroll
    for (int kb = 0; kb < 8; ++kb) {
        f32x16 acc;
#pragma unroll
        for (int i = 0; i < 16; ++i) acc[i] = 0.f;
        const LAS char* kp = lds + (32 * kb + r) * XA_STRIDE + h2 * 16;
#pragma unroll
        for (int s = 0; s < 16; ++s) { const bf16x8 a = *(const LAS bf16x8*)(kp + s * 32); acc = MFMA32(a, qf[s], acc); }
        float p[16];
#pragma unroll
        for (int i = 0; i < 16; ++i) { p[i] = __builtin_amdgcn_exp2f(acc[i] * rsl - 11.541560327111707f); den += p[i]; }
        pf[kb][0] = pack8(p[0], p[1], p[2], p[3], p[4], p[5], p[6], p[7]); pf[kb][1] = pack8(p[8], p[9], p[10], p[11], p[12], p[13], p[14], p[15]);
    }
    den += __shfl_xor(den, 32);
    const float inv = 1.0f / den;
    __syncthreads();
#pragma unroll
    for (int i = 0; i < 16; ++i) { const int id = tid + 512 * i; st[i] = *(const v4u*)(Vg + (size_t)(id >> 5) * 2048 + (id & 31) * 8); }
#pragma unroll
    for (int i = 0; i < 16; ++i) { const int id = tid + 512 * i; *(LAS v4u*)(lds + (id >> 5) * XA_STRIDE + (id & 31) * 16) = st[i]; }
    __syncthreads();
    const int lbase = tr_lane_base(lane, XA_STRIDE);
#pragma unroll
    for (int half = 0; half < 2; ++half) {
        f32x16 o[4];
#pragma unroll
        for (int vb = 0; vb < 4; ++vb)
#pragma unroll
            for (int i = 0; i < 16; ++i) o[vb][i] = 0.f;
#pragma unroll
        for (int kb = 0; kb < 8; ++kb)
#pragma unroll
            for (int s = 0; s < 2; ++s)
#pragma unroll
                for (int vb = 0; vb < 4; ++vb) { const bf16x8 a = tr_frag_perm(lds, XA_STRIDE, lbase, 32 * kb + 16 * s, 128 * half + 32 * vb); o[vb] = MFMA32(a, pf[kb][s], o[vb]); }
        bf16* orow = O + qoff + 128 * half + 4 * h2;
#pragma unroll
        for (int vb = 0; vb < 4; ++vb)
#pragma unroll
            for (int g4 = 0; g4 < 4; ++g4) { v2u wv; wv.x = cvtpk(o[vb][4 * g4] * inv, o[vb][4 * g4 + 1] * inv); wv.y = cvtpk(o[vb][4 * g4 + 2] * inv, o[vb][4 * g4 + 3] * inv);
                *(v2u*)(orow + 32 * vb + 8 * g4) = wv; }
    }
    __syncthreads();
}


constexpr int DA_STRIDE = 272, DA_LDS_BIAS = 384 * DA_STRIDE;
struct DaArgs { const bf16* QKV; const float* biasT; const float* gkq; bf16* N0; float* DEN0; const bf16* N1; const float* DEN1; const bf16* N2; const float* DEN2; bf16* O; int br0; int nbr; int mode; int pad; };
template <int MODE> __device__ __forceinline__ void dattn_unit(LAS char* lds, const DaArgs& a, int br, int bh, int x, int tid) {
    const int lane = tid & 63, w = __builtin_amdgcn_readfirstlane(tid >> 6), r = lane & 31, h2 = lane >> 5;
    const int b = bh >> 3, h = bh & 7, dil = 1 << (2 * br);
    const int cls = br == 0 ? 0 : (br == 1 ? (x & 3) : x), u = br == 0 ? x : (br == 1 ? (x >> 2) : 0), l0 = 256 * u;
    const bf16* base = a.QKV + (size_t)(b * SEQ) * OD_IN + h * 128;
    v4u st[6];
#pragma unroll
    for (int i = 0; i < 6; ++i) { const int id = tid + 512 * i, ki = id >> 4, lk = l0 - 128 + ki;
        st[i] = lk >= 0 ? *(const v4u*)(base + (size_t)(lk * dil + cls) * OD_IN + 1024 + (id & 15) * 8) : (v4u){0u, 0u, 0u, 0u}; }
    const size_t qrow = (size_t)(b * SEQ + (l0 + 32 * w + r) * dil + cls);
    bf16x8 qf[8];
#pragma unroll
    for (int s = 0; s < 8; ++s) qf[s] = *(const bf16x8*)(a.QKV + qrow * OD_IN + h * 128 + 8 * h2 + 16 * s);
    float gk8[8];
#pragma unroll
    for (int e = 0; e < 8; ++e) gk8[e] = a.gkq[(tid & 15) * 8 + e];
#define DA_NORM_STORE(ii, vv) do { const int id_ = tid + 512 * (ii); float f_[8]; unpack8((vv), f_); \
        float sq_ = (f_[0] * f_[0] + f_[1] * f_[1]) + (f_[2] * f_[2] + f_[3] * f_[3]) + (f_[4] * f_[4] + f_[5] * f_[5]) + (f_[6] * f_[6] + f_[7] * f_[7]); \
        sq_ += __shfl_xor(sq_, 1); sq_ += __shfl_xor(sq_, 2); sq_ += __shfl_xor(sq_, 4); sq_ += __shfl_xor(sq_, 8); \
        const float rk_ = 1.0f / sqrtf(sq_ * (1.0f / 128.0f) + EPS) * 0.08838834764831845f; \
        v4u o_; o_.x = cvtpk(f_[0] * rk_ * gk8[0], f_[1] * rk_ * gk8[1]); o_.y = cvtpk(f_[2] * rk_ * gk8[2], f_[3] * rk_ * gk8[3]); o_.z = cvtpk(f_[4] * rk_ * gk8[4], f_[5] * rk_ * gk8[5]); o_.w = cvtpk(f_[6] * rk_ * gk8[6], f_[7] * rk_ * gk8[7]); \
        *(LAS v4u*)(lds + (id_ >> 4) * DA_STRIDE + (id_ & 15) * 16) = o_; } while (0)
#pragma unroll
    for (int i = 0; i < 6; ++i) DA_NORM_STORE(i, st[i]);
    asm volatile("" ::: "memory");
#pragma unroll
    for (int i = 0; i < 6; ++i) { const int id = tid + 512 * (i + 6), ki = id >> 4, lk = l0 - 128 + ki;
        st[i] = lk >= 0 ? *(const v4u*)(base + (size_t)(lk * dil + cls) * OD_IN + 1024 + (id & 15) * 8) : (v4u){0u, 0u, 0u, 0u}; }
#pragma unroll
    for (int i = 0; i < 6; ++i) DA_NORM_STORE(i + 6, st[i]);
#undef DA_NORM_STORE
    LAS float* lbias = (LAS float*)(lds + DA_LDS_BIAS);
    if (tid < 132) lbias[tid] = a.biasT[(br * 8 + h) * 132 + tid];
    float ss = 0.f;
#pragma unroll
    for (int s = 0; s < 8; ++s)
#pragma unroll
        for (int j = 0; j < 8; ++j) { const float xq = __uint_as_float((unsigned)(unsigned short)qf[s][j] << 16); ss += xq * xq; }
    ss += __shfl_xor(ss, 32);
    const float rsl = 1.0f / sqrtf(ss * (1.0f / 128.0f) + EPS) * 1.4426950408889634f;
    __syncthreads();
    bf16x8 pf[5][2]; float den = 0.f;
#pragma unroll
    for (int kbi = 0; kbi < 5; ++kbi) {
        f32x16 acc;
#pragma unroll
        for (int i = 0; i < 16; ++i) acc[i] = 0.f;
        const LAS char* kp = lds + (32 * (w + kbi) + r) * DA_STRIDE + h2 * 16;
#pragma unroll
        for (int s = 0; s < 8; ++s) { const bf16x8 av = *(const LAS bf16x8*)(kp + s * 32); acc = MFMA32(av, qf[s], acc); }
        float p[16];
#pragma unroll
        for (int i = 0; i < 16; ++i) { const int c = (i & 3) + 8 * (i >> 2) + 4 * h2; const int delta = 128 - 32 * kbi + r - c; const int ki = 32 * (w + kbi) + c;
            const bool valid = (delta >= 0) && (delta <= 128) && (l0 - 128 + ki >= 0); const int dcl = delta < 0 ? 0 : (delta > 128 ? 128 : delta);
            const float e = __builtin_amdgcn_exp2f(acc[i] * rsl + lbias[dcl] * 1.4426950408889634f - 11.541560327111707f); p[i] = valid ? e : 0.f; den += p[i]; }
        pf[kbi][0] = pack8(p[0], p[1], p[2], p[3], p[4], p[5], p[6], p[7]); pf[kbi][1] = pack8(p[8], p[9], p[10], p[11], p[12], p[13], p[14], p[15]);
        asm volatile("" ::: "memory");
    }
    den += __shfl_xor(den, 32);
    __syncthreads();
#pragma unroll
    for (int bt = 0; bt < 2; ++bt) {
#pragma unroll
        for (int i = 0; i < 6; ++i) { const int id = tid + 512 * (i + 6 * bt), ki = id >> 4, lk = l0 - 128 + ki;
            st[i] = lk >= 0 ? *(const v4u*)(base + (size_t)(lk * dil + cls) * OD_IN + 2048 + (id & 15) * 8) : (v4u){0u, 0u, 0u, 0u}; }
#pragma unroll
        for (int i = 0; i < 6; ++i) { const int id = tid + 512 * (i + 6 * bt); *(LAS v4u*)(lds + (id >> 4) * DA_STRIDE + (id & 15) * 16) = st[i]; }
        asm volatile("" ::: "memory");
    }
    __syncthreads();
    const int lbase = tr_lane_base(lane, DA_STRIDE);
    const size_t ooff = qrow * D + h * 128 + 4 * h2;
    float inv = 1.0f;
    if (MODE == 0) { if (h2 == 0) ((float*)(br == 1 ? a.DEN1 : a.DEN2))[qrow * 8 + h] = den; }
    else { inv = 1.0f / (den + a.DEN1[qrow * 8 + h] + a.DEN2[qrow * 8 + h]); }
#pragma unroll
    for (int half = 0; half < 2; ++half) {
        f32x16 o[2];
#pragma unroll
        for (int vb = 0; vb < 2; ++vb)
#pragma unroll
            for (int i = 0; i < 16; ++i) o[vb][i] = 0.f;
#pragma unroll
        for (int kbi = 0; kbi < 5; ++kbi)
#pragma unroll
            for (int s = 0; s < 2; ++s)
#pragma unroll
                for (int vb = 0; vb < 2; ++vb) { const bf16x8 av = tr_frag_perm(lds, DA_STRIDE, lbase, 32 * (w + kbi) + 16 * s, 64 * half + 32 * vb); o[vb] = MFMA32(av, pf[kbi][s], o[vb]); }
        if (MODE == 0) {
            bf16* N = (bf16*)(br == 1 ? a.N1 : a.N2) + ooff + 64 * half;
#pragma unroll
            for (int vb = 0; vb < 2; ++vb)
#pragma unroll
                for (int g4 = 0; g4 < 4; ++g4) { v2u wv; wv.x = cvtpk(o[vb][4 * g4], o[vb][4 * g4 + 1]); wv.y = cvtpk(o[vb][4 * g4 + 2], o[vb][4 * g4 + 3]); *(v2u*)(N + 32 * vb + 8 * g4) = wv; }
        } else {
            const bf16* N1 = a.N1 + ooff + 64 * half; const bf16* N2 = a.N2 + ooff + 64 * half; bf16* Op = a.O + ooff + 64 * half;
#pragma unroll
            for (int vb = 0; vb < 2; ++vb)
#pragma unroll
                for (int g4 = 0; g4 < 4; ++g4) { const v2u n1 = *(const v2u*)(N1 + 32 * vb + 8 * g4), n2 = *(const v2u*)(N2 + 32 * vb + 8 * g4);
                    const float x0 = o[vb][4 * g4] + __uint_as_float(n1.x << 16) + __uint_as_float(n2.x << 16), x1 = o[vb][4 * g4 + 1] + __uint_as_float(n1.x & 0xffff0000u) + __uint_as_float(n2.x & 0xffff0000u);
                    const float x2 = o[vb][4 * g4 + 2] + __uint_as_float(n1.y << 16) + __uint_as_float(n2.y << 16), x3 = o[vb][4 * g4 + 3] + __uint_as_float(n1.y & 0xffff0000u) + __uint_as_float(n2.y & 0xffff0000u);
                    v2u wv; wv.x = cvtpk(x0 * inv, x1 * inv); wv.y = cvtpk(x2 * inv, x3 * inv); *(v2u*)(Op + 32 * vb + 8 * g4) = wv; }
        }
        asm volatile("" ::: "memory");
    }
    __syncthreads();
}


constexpr int MX_STRIDE = 272, MX_IMG = 128 * MX_STRIDE;
constexpr int MX_Q = 0, MX_K = MX_IMG, MX_V = 2 * MX_IMG, MX_SCR = 3 * MX_IMG;
struct MixArgs { bf16* Z; const float* lb; const float* ret_g; const float* hg_g; bf16* SBUF; float* DECA; float* DECB; };

__device__ __forceinline__ void st_chunk8(LAS char* img, int row, int c0, const float (&f)[8]) {
    v4u o; o.x = cvtpk(f[0], f[1]); o.y = cvtpk(f[2], f[3]); o.z = cvtpk(f[4], f[5]); o.w = cvtpk(f[6], f[7]); *(LAS v4u*)(img + row * MX_STRIDE + c0 * 2) = o; }

__device__ __forceinline__ void ret_prep_tile(LAS char* img, const bf16* zrow  , int j, int cg, const float (&sn)[16], const float (&cs)[16], float sc) {
#pragma unroll
    for (int hc = 0; hc < 2; ++hc) { float x1[8], x2[8], o1[8], o2[8];
        unpack8(*(const v4u*)(zrow + 16 * cg + 8 * hc), x1); unpack8(*(const v4u*)(zrow + 64 + 16 * cg + 8 * hc), x2);
#pragma unroll
        for (int e = 0; e < 8; ++e) { o1[e] = (x1[e] * cs[8 * hc + e] - x2[e] * sn[8 * hc + e]) * sc; o2[e] = (x1[e] * sn[8 * hc + e] + x2[e] * cs[8 * hc + e]) * sc; }
        st_chunk8(img, j, 16 * cg + 8 * hc, o1); st_chunk8(img, j, 64 + 16 * cg + 8 * hc, o2); }
}
__device__ __forceinline__ void copy_tile(LAS char* img, const bf16* src, int tid) {
#pragma unroll
    for (int i = 0; i < 4; ++i) { const int id = tid + 512 * i, row = id >> 4, ch = id & 15; *(LAS v4u*)(img + row * MX_STRIDE + ch * 16) = *(const v4u*)(src + (size_t)row * EV_IN + ch * 8); }
}
__device__ __forceinline__ void hg_gates(const bf16* zrow_f  , const float* lbh  , int tid, LAS float* scr, float (&cum)[32], float (&kk)[32]) {
    const int lane = tid & 63, hw = (tid >> 6) & 1, cg = tid >> 7;
#pragma unroll
    for (int q = 0; q < 4; ++q) { float fl[8]; unpack8(*(const v4u*)(zrow_f + 32 * cg + 8 * q), fl);
#pragma unroll
        for (int e = 0; e < 8; ++e) { const float l = lbh[32 * cg + 8 * q + e]; const float f = l + (1.0f - l) * (1.0f / (1.0f + __expf(-fl[e]))); kk[8 * q + e] = 1.0f - f; cum[8 * q + e] = __logf(fmaxf(f, 1e-6f)); } }
#pragma unroll
    for (int off = 1; off < 64; off <<= 1) {
#pragma unroll
        for (int c = 0; c < 32; ++c) { const float t = __shfl_up(cum[c], off); if (lane >= off) cum[c] += t; } }
    if (hw == 0 && lane == 63) {
#pragma unroll
        for (int c = 0; c < 32; ++c) scr[32 * cg + c] = cum[c]; }
    __syncthreads();
    if (hw == 1) {
#pragma unroll
        for (int c = 0; c < 32; ++c) cum[c] += scr[32 * cg + c]; }
    if (hw == 1 && lane == 63) {
#pragma unroll
        for (int c = 0; c < 32; ++c) scr[128 + 32 * cg + c] = cum[c]; }
    __syncthreads();
}

__device__ __forceinline__ void mixA_unit(LAS char* lds, const MixArgs& a, int u, int tid) {
    const int lane = tid & 63, w = __builtin_amdgcn_readfirstlane(tid >> 6), r = lane & 31, h2 = lane >> 5;
    const int g = u >> 5, n = u & 31, mixer = g >> 4, b = (g >> 2) & 3, h = g & 3;
    const int j = tid & 127, cg = tid >> 7;
    const bf16* zt = a.Z + (size_t)(b * SEQ + 128 * n) * EV_IN;
    LAS float* scr = (LAS float*)(lds + MX_SCR);
    if (mixer == 0) {
        const float gamma = 1.0f - exp2f(-5.0f - (float)h), lg2 = log2f(gamma);
        float sn[16], cs[16];
#pragma unroll
        for (int e = 0; e < 16; ++e) { const float inv = exp2f(-(float)(16 * cg + e) * (13.287712379549449f / 64.0f)); rope_sincos((float)(128 * n + j) * inv, sn[e], cs[e]); }
        ret_prep_tile(lds + MX_K, zt + (size_t)j * EV_IN + Z_RK + h * 128, j, cg, sn, cs, 0.08838834764831845f * exp2f((float)(127 - j) * lg2));
        copy_tile(lds + MX_V, zt + Z_RV + h * 128, tid);
        if (tid < 128) { a.DECA[(size_t)u * 128 + tid] = exp2f(128.0f * lg2); a.DECB[(size_t)u * 128 + tid] = gamma; }
    } else {
        float cum[32], kk[32];
        hg_gates(zt + (size_t)j * EV_IN + Z_GF + h * 128, a.lb + h * 128, tid, scr, cum, kk);
#pragma unroll
        for (int q = 0; q < 4; ++q) { float o[8];
#pragma unroll
            for (int e = 0; e < 8; ++e) o[e] = kk[8 * q + e] * __expf(scr[128 + 32 * cg + 8 * q + e] - cum[8 * q + e]);
            st_chunk8(lds + MX_K, j, 32 * cg + 8 * q, o); }
        copy_tile(lds + MX_V, zt + Z_GI + h * 128, tid);
        if (tid < 128) { a.DECA[(size_t)u * 128 + tid] = __expf(scr[128 + tid]); a.DECB[(size_t)u * 128 + tid] = __expf(scr[tid]); }
    }
    __syncthreads();
    const int lbn = tr_lane_base_nat(lane, MX_STRIDE); const int kbk = w >> 1, vb0 = 2 * (w & 1);
    f32x16 acc[2];
#pragma unroll
    for (int t = 0; t < 2; ++t)
#pragma unroll
        for (int i = 0; i < 16; ++i) acc[t][i] = 0.f;
#pragma unroll
    for (int s = 0; s < 8; ++s) { const bf16x8 av = tr_frag_nat(lds + MX_K, MX_STRIDE, lbn, 16 * s, 32 * kbk);
#pragma unroll
        for (int t = 0; t < 2; ++t) { const bf16x8 bv = tr_frag_nat(lds + MX_V, MX_STRIDE, lbn, 16 * s, 32 * (vb0 + t)); acc[t] = MFMA32(av, bv, acc[t]); } }
    bf16* sb = a.SBUF + (size_t)u * 16384;
#pragma unroll
    for (int t = 0; t < 2; ++t)
#pragma unroll
        for (int g4 = 0; g4 < 4; ++g4) { v2u wv; wv.x = cvtpk(acc[t][4 * g4], acc[t][4 * g4 + 1]); wv.y = cvtpk(acc[t][4 * g4 + 2], acc[t][4 * g4 + 3]);
            *(v2u*)(sb + (size_t)(32 * (vb0 + t) + r) * 128 + 32 * kbk + 8 * g4 + 4 * h2) = wv; }
    __syncthreads();
}

__device__ __forceinline__ void mix_scan(const MixArgs& a, int gtid, int nthreads) {
    for (int e = gtid; e < 32 * 4096; e += nthreads) { const int g = e >> 12, el = e & 4095, dk4 = el & 31;
        bf16* sp = a.SBUF + (size_t)(g * 32) * 16384 + (size_t)el * 4; const float* da = a.DECA + (size_t)(g * 32) * 128 + 4 * dk4; const float* db = a.DECB + (size_t)(g * 32) * 128 + 4 * dk4;
        f32x4 S = (f32x4){0.f, 0.f, 0.f, 0.f};
#pragma unroll 8
        for (int n = 0; n < 32; ++n) { const v2u kv = *(const v2u*)(sp + (size_t)n * 16384); const f32x4 A = *(const f32x4*)(da + n * 128), Bv = *(const f32x4*)(db + n * 128);
            const f32x4 so = S * Bv; v2u wv; wv.x = cvtpk(so[0], so[1]); wv.y = cvtpk(so[2], so[3]); *(v2u*)(sp + (size_t)n * 16384) = wv;
            S[0] = A[0] * S[0] + __uint_as_float(kv.x << 16); S[1] = A[1] * S[1] + __uint_as_float(kv.x & 0xffff0000u); S[2] = A[2] * S[2] + __uint_as_float(kv.y << 16); S[3] = A[3] * S[3] + __uint_as_float(kv.y & 0xffff0000u); }
    }
}

__device__ __forceinline__ void mixC_unit(LAS char* lds, const MixArgs& a, int u, int tid) {
    const int lane = tid & 63, w = __builtin_amdgcn_readfirstlane(tid >> 6), r = lane & 31, h2 = lane >> 5;
    const int g = u >> 5, n = u & 31, mixer = g >> 4, b = (g >> 2) & 3, h = g & 3;
    const int j = tid & 127, cg = tid >> 7;
    bf16* zt = a.Z + (size_t)(b * SEQ + 128 * n) * EV_IN;
    LAS float* scr = (LAS float*)(lds + MX_SCR);
    if (mixer == 0) {
        const float gamma = 1.0f - exp2f(-5.0f - (float)h), lg2 = log2f(gamma);
        float sn[16], cs[16];
#pragma unroll
        for (int e = 0; e < 16; ++e) { const float inv = exp2f(-(float)(16 * cg + e) * (13.287712379549449f / 64.0f)); rope_sincos((float)(128 * n + j) * inv, sn[e], cs[e]); }
        ret_prep_tile(lds + MX_Q, zt + (size_t)j * EV_IN + Z_RQ + h * 128, j, cg, sn, cs, exp2f((float)j * lg2));
        ret_prep_tile(lds + MX_K, zt + (size_t)j * EV_IN + Z_RK + h * 128, j, cg, sn, cs, 0.08838834764831845f * exp2f(-(float)j * lg2));
        copy_tile(lds + MX_V, zt + Z_RV + h * 128, tid);
    } else {
        float cum[32], kk[32];
        hg_gates(zt + (size_t)j * EV_IN + Z_GF + h * 128, a.lb + h * 128, tid, scr, cum, kk);
#pragma unroll
        for (int q = 0; q < 4; ++q) { float qv[8], oq[8], ok[8]; unpack8(*(const v4u*)(zt + (size_t)j * EV_IN + Z_GQ + h * 128 + 32 * cg + 8 * q), qv);
#pragma unroll
            for (int e = 0; e < 8; ++e) { const float d = cum[8 * q + e] - scr[32 * cg + 8 * q + e]; oq[e] = qv[e] * __expf(d); ok[e] = kk[8 * q + e] * __expf(-d); }
            st_chunk8(lds + MX_Q, j, 32 * cg + 8 * q, oq); st_chunk8(lds + MX_K, j, 32 * cg + 8 * q, ok); }
        copy_tile(lds + MX_V, zt + Z_GI + h * 128, tid);
    }
    __syncthreads();
    const int vb = w >> 1; const int lbp = tr_lane_base(lane, MX_STRIDE);
    const bf16* sb = a.SBUF + (size_t)u * 16384 + (size_t)(32 * vb + r) * 128 + 8 * h2;
    bf16x8 sf[8];
#pragma unroll
    for (int s = 0; s < 8; ++s) sf[s] = *(const bf16x8*)(sb + 16 * s);
    f32x16 o[2]; float s1[2], s2[2];
#pragma unroll
    for (int t = 0; t < 2; ++t) {
        const int ib = (w & 1) ? (1 + t) : (3 * t);
        bf16x8 qf[8];
#pragma unroll
        for (int s = 0; s < 8; ++s) qf[s] = *(const LAS bf16x8*)(lds + MX_Q + (32 * ib + r) * MX_STRIDE + h2 * 16 + s * 32);
#pragma unroll
        for (int i = 0; i < 16; ++i) o[t][i] = 0.f;
#pragma unroll
        for (int s = 0; s < 8; ++s) o[t] = MFMA32(sf[s], qf[s], o[t]);
        for (int jb = 0; jb <= ib; ++jb) {
            f32x16 acc;
#pragma unroll
            for (int i = 0; i < 16; ++i) acc[i] = 0.f;
            const LAS char* kp = lds + MX_K + (32 * jb + r) * MX_STRIDE + h2 * 16;
#pragma unroll
            for (int s = 0; s < 8; ++s) { const bf16x8 av = *(const LAS bf16x8*)(kp + s * 32); acc = MFMA32(av, qf[s], acc); }
            if (jb == ib) {
#pragma unroll
                for (int i = 0; i < 16; ++i) { const int c = (i & 3) + 8 * (i >> 2) + 4 * h2; if (c > r) acc[i] = 0.f; } }
            const bf16x8 p0 = pack8(acc[0], acc[1], acc[2], acc[3], acc[4], acc[5], acc[6], acc[7]), p1 = pack8(acc[8], acc[9], acc[10], acc[11], acc[12], acc[13], acc[14], acc[15]);
            const bf16x8 v0 = tr_frag_perm(lds + MX_V, MX_STRIDE, lbp, 32 * jb, 32 * vb), v1 = tr_frag_perm(lds + MX_V, MX_STRIDE, lbp, 32 * jb + 16, 32 * vb);
            o[t] = MFMA32(v0, p0, o[t]); o[t] = MFMA32(v1, p1, o[t]);
        }
        float a1 = 0.f, a2 = 0.f;
#pragma unroll
        for (int i = 0; i < 16; ++i) { a1 += o[t][i]; a2 += o[t][i] * o[t][i]; }
        a1 += __shfl_xor(a1, 32); a2 += __shfl_xor(a2, 32); s1[t] = a1; s2[t] = a2;
        if (h2 == 0) { scr[256 + (vb * 128 + 32 * ib + r) * 2] = a1; scr[256 + (vb * 128 + 32 * ib + r) * 2 + 1] = a2; }
    }
    __syncthreads();
    const float* gn = (mixer == 0 ? a.ret_g : a.hg_g) + h * 128 + 32 * vb + 4 * h2;
#pragma unroll
    for (int t = 0; t < 2; ++t) {
        const int ib = (w & 1) ? (1 + t) : (3 * t); const int tok = 32 * ib + r;
        float t1 = 0.f, t2 = 0.f;
#pragma unroll
        for (int v = 0; v < 4; ++v) { t1 += scr[256 + (v * 128 + tok) * 2]; t2 += scr[256 + (v * 128 + tok) * 2 + 1]; }
        float mu = 0.f, rstd;
        if (mixer == 0) { mu = t1 * (1.0f / 128.0f); rstd = 1.0f / sqrtf(fmaxf(t2 * (1.0f / 128.0f) - mu * mu, 0.f) + EPS); } else rstd = 1.0f / sqrtf(t2 * (1.0f / 128.0f) + EPS);
        bf16* zr = zt + (size_t)tok * EV_IN;
        const bf16* gp = zr + (mixer == 0 ? Z_RG : Z_GG) + h * 128 + 32 * vb + 4 * h2; bf16* yp = zr + (mixer == 0 ? Z_RQ : Z_GQ) + h * 128 + 32 * vb + 4 * h2;
#pragma unroll
        for (int g4 = 0; g4 < 4; ++g4) { const v2u gw = *(const v2u*)(gp + 8 * g4); const f32x4 gv = *(const f32x4*)(gn + 8 * g4);
            const float ga[4] = {__uint_as_float(gw.x << 16), __uint_as_float(gw.x & 0xffff0000u), __uint_as_float(gw.y << 16), __uint_as_float(gw.y & 0xffff0000u)}; float y[4];
#pragma unroll
            for (int e = 0; e < 4; ++e) { y[e] = (o[t][4 * g4 + e] - mu) * rstd * gv[e] * (ga[e] / (1.0f + __expf(-ga[e]))); }
            v2u wv; wv.x = cvtpk(y[0], y[1]); wv.y = cvtpk(y[2], y[3]); *(v2u*)(yp + 8 * g4) = wv; }
    }
    __syncthreads();
}


__device__ __forceinline__ float gelu_tanh(float x) { const float u = 0.7978845608028654f * (x + 0.044715f * x * x * x); const float t = 1.0f - 2.0f / (1.0f + __expf(2.0f * u)); return 0.5f * x * (1.0f + t); }
__device__ __forceinline__ void ffn_ew(const bf16* GU, const float* cw, const float* cb, bf16* H, int rows, int gtid, int nthreads) {
    for (int idx = gtid; idx < rows * (DFF / 8); idx += nthreads) {
        const int row = idx / (DFF / 8), c0 = (idx % (DFF / 8)) * 8, t = row % SEQ;
        float g0[8], g1[8], g2[8], u[8];
        unpack8(*(const v4u*)(GU + (size_t)row * (2 * DFF) + c0), g2); unpack8(*(const v4u*)(GU + (size_t)row * (2 * DFF) + DFF + c0), u);
        if (t >= 1) unpack8(*(const v4u*)(GU + (size_t)(row - 1) * (2 * DFF) + c0), g1); else { for (int i = 0; i < 8; ++i) g1[i] = 0.f; }
        if (t >= 2) unpack8(*(const v4u*)(GU + (size_t)(row - 2) * (2 * DFF) + c0), g0); else { for (int i = 0; i < 8; ++i) g0[i] = 0.f; }
        float r[8];
#pragma unroll
        for (int i = 0; i < 8; ++i) { const float y = cw[c0 + i] * g0[i] + cw[DFF + c0 + i] * g1[i] + cw[2 * DFF + c0 + i] * g2[i] + cb[c0 + i]; r[i] = gelu_tanh(y) * u[i]; }
        v4u o; o.x = cvtpk(r[0], r[1]); o.y = cvtpk(r[2], r[3]); o.z = cvtpk(r[4], r[5]); o.w = cvtpk(r[6], r[7]);
        *(v4u*)(H + (size_t)row * DFF + c0) = o;
    }
}

constexpr int LDS_BYTES = 147456;
constexpr int LDSCTL_OFF = LDS_BYTES - 512;
constexpr int CW_BAR = 4096;
constexpr size_t CTL_ZERO_BYTES = 1 * MiB;
#define XB_TMO      128
#define XB_XCNT(j)  (256  + 64 * (j))
#define XB_XSUB(j)  (1280 + 64 * (j))
#define XB_XGEN(j)  (2304 + 64 * (j))
#define XB_TOP      3328
#define XB_TOPGEN   3392
#define XCD_BAR_WORDS 3456
#define XB_SPIN_CAP (1u << 18)

__device__ __forceinline__ unsigned xb_ld(unsigned* p)              { return __hip_atomic_load(p, __ATOMIC_RELAXED, __HIP_MEMORY_SCOPE_AGENT); }
__device__ __forceinline__ unsigned xb_add(unsigned* p, unsigned v) { return __hip_atomic_fetch_add(p, v, __ATOMIC_RELAXED, __HIP_MEMORY_SCOPE_AGENT); }
__device__ __forceinline__ unsigned xb_xcc_id() { return (unsigned)__builtin_amdgcn_s_getreg((3 << 11) | 20) & 0xFu; }
#define XB_SPIN(cond, bar) do { unsigned _sp = 0; while (cond) { __builtin_amdgcn_s_sleep(1); \
    if ((++_sp & 255u) == 0u) { if (xb_ld(&(bar)[XB_TMO])) break; if (_sp > XB_SPIN_CAP) { atomicAdd(&(bar)[XB_TMO], 1u); break; } } } } while (0)

struct XcdBarrier {
    unsigned* bar; unsigned x;
    volatile LAS unsigned* st;
};

__device__ __forceinline__ XcdBarrier xcd_barrier_post(unsigned* bar, volatile LAS unsigned* st) {
    XcdBarrier b; b.bar = bar; b.x = xb_xcc_id(); b.st = st;
    if (threadIdx.x == 0) (void)xb_add(&bar[XB_XCNT(b.x)], 1u);
    return b;
}
__device__ __forceinline__ void xcd_barrier_complete(unsigned* bar, unsigned x, unsigned& nloc, unsigned& nx) {
    const unsigned G = gridDim.x * gridDim.y * gridDim.z;
    unsigned sum, cnt, mine, sp = 0u;
    for (;;) {
        sum = 0u; cnt = 0u; mine = 0u;
#pragma unroll
        for (unsigned j = 0; j < 16; ++j) { const unsigned c = xb_ld(&bar[XB_XCNT(j)]); sum += c; cnt += (c > 0u) ? 1u : 0u; mine = (j == x) ? c : mine; }
        if (sum == G) break;
        __builtin_amdgcn_s_sleep(1);
        if ((++sp & 255u) == 0u) { if (xb_ld(&bar[XB_TMO])) break; if (sp > XB_SPIN_CAP) { atomicAdd(&bar[XB_TMO], 1u); break; } }
    }
    nloc = mine > 0u ? mine : 1u; nx = cnt > 0u ? cnt : 1u;
}

__device__ __forceinline__ void xcd_barrier(const XcdBarrier& b) {
    asm volatile("s_waitcnt vmcnt(0)" ::: "memory");
    __syncthreads();
    if (threadIdx.x == 0) {
        unsigned* bar = b.bar;
        __builtin_amdgcn_s_waitcnt(0);
        unsigned nloc = b.st[0], nx = b.st[1];
        if (nloc == 0u) { xcd_barrier_complete(bar, b.x, nloc, nx); b.st[0] = nloc; b.st[1] = nx; }
        const unsigned old = xb_add(&bar[XB_XSUB(b.x)], 1u);
        const unsigned gen = old / nloc;
        if (old + 1u == (gen + 1u) * nloc) {
            __builtin_amdgcn_fence(__ATOMIC_RELEASE, "agent");
            asm volatile("s_waitcnt vmcnt(0)" ::: "memory");
            const unsigned og = xb_add(&bar[XB_TOP], 1u);
            const unsigned tg = og / nx;
            if (og + 1u == (tg + 1u) * nx) xb_add(&bar[XB_TOPGEN], 1u);
            else XB_SPIN(xb_ld(&bar[XB_TOPGEN]) == tg, bar);
            __builtin_amdgcn_fence(__ATOMIC_ACQUIRE, "agent");
            xb_add(&bar[XB_XGEN(b.x)], 1u);
            asm volatile("s_waitcnt vmcnt(0)" ::: "memory");
        } else {
            XB_SPIN(xb_ld(&bar[XB_XGEN(b.x)]) == gen, bar);
            __builtin_amdgcn_fence(__ATOMIC_ACQUIRE, "agent");
            asm volatile("s_waitcnt vmcnt(0)" ::: "memory");
        }
    }
    __syncthreads();
}


struct FwdArgs { const float* in[25]; float* out; unsigned char* ws; int ph_lo, ph_hi, li, pad; };
__global__ void __launch_bounds__(512, 2) fwd(FwdArgs a) {
    extern __shared__ __attribute__((aligned(16))) unsigned char lds_raw[];
    LAS unsigned char* lds = (LAS unsigned char*)lds_raw;
    const int tid = threadIdx.x, lane = tid & 63, wave = __builtin_amdgcn_readfirstlane(tid >> 6);
    const int G = gridDim.x, bx = blockIdx.x;
    volatile LAS unsigned* MISC = (volatile LAS unsigned*)(lds + LDSCTL_OFF);
    if (tid < 64) MISC[tid] = 0u;
    __syncthreads();
    unsigned char* ws = a.ws; float* out = a.out;
    XcdBarrier bar = xcd_barrier_post((unsigned*)(ws + WS_CTL) + CW_BAR + a.li * XCD_BAR_WORDS, MISC + 8);
    int ph = 0; const int lo = a.ph_lo, hi = a.ph_hi;
#define PH_ON (ph >= lo && ph < hi)
#define TID_L ({ int t_ = tid; asm volatile("" : "+v"(t_)); t_; })
#define PH_END do { if (ph >= lo && ph + 1 < hi) xcd_barrier(bar); ++ph; } while (0)
    bf16* XB = (bf16*)(ws + WS_XB); float* SSQP = (float*)(ws + WS_SSQP); bf16* ACT = (bf16*)(ws + WS_ACT);

    if (PH_ON) { ProArgs pa;
#pragma unroll
        for (int i = 0; i < 25; ++i) pa.in[i] = a.in[i];
        pa.ws = ws; pa.layer_mask = 3; pa.ffn_mode = 2;
        { const int t_ = TID_L; prologue_body(pa, bx * 8 + (t_ >> 6), G * 8, t_ & 63, (LAS float*)lds + (t_ >> 6) * 64 * 33); } }
    PH_END;

    for (int l = 0; l < 2; ++l) {
        if (PH_ON) {
            { pg8::Gemm g{XB, (const bf16*)(ws + (l ? WS_ODIN : WS_EVIN)), M, l ? OD_IN : EV_IN, D, D}; pg8::EpiBf16S E{ACT, SSQP, l ? OD_IN : EV_IN, M, EPS, 0};
              pg8::StaticOrder S; S.init(g.M, g.N, G, bx); pg8::gemm_phase<pg8::EpiBf16S, pg8::StaticOrder, true, true>(lds, g, S, E); }
            if (l == 0) {
                for (int lm = 0; lm < 2; ++lm) { __syncthreads();
                    pg8::Gemm g{(const bf16*)(ws + (lm ? WS_MEMH1 : WS_MEMH0)), (const bf16*)(ws + (lm ? WS_XKV1 : WS_XKV0)), MM, 2 * D, D, D}; pg8::EpiBf16S E{(bf16*)(ws + (lm ? WS_MKV1 : WS_MKV0)), nullptr, 2 * D, M, EPS, 0};
                    pg8::StaticOrder S; S.init(g.M, g.N, G, (bx + 128 + 64 * lm) % G); pg8::gemm_phase<pg8::EpiBf16S, pg8::StaticOrder, true, true>(lds, g, S, E); }
            }
        }
        PH_END;
        const bf16* mixo; int mixo_ld;
        if (l == 0) {
            MixArgs ma{ACT, (const float*)(ws + WS_LB), a.in[4], a.in[5], (bf16*)out, (float*)(ws + WS_DECA), (float*)(ws + WS_DECB)};
            if (PH_ON) { for (int u = bx; u < 1024; u += G) mixA_unit((LAS char*)lds, ma, u, TID_L); }
            PH_END;
            if (PH_ON) mix_scan(ma, bx * 512 + TID_L, G * 512);
            PH_END;
            if (PH_ON) { for (int u = bx; u < 1024; u += G) mixC_unit((LAS char*)lds, ma, u, TID_L); }
            PH_END;
            mixo = ACT; mixo_ld = EV_IN;
        } else {
            bf16* O = (bf16*)(ws + WS_ACT + 96 * MiB);
            DaArgs da; da.QKV = ACT; da.biasT = (const float*)(ws + WS_BIAST); da.gkq = (const float*)(ws + WS_GOD); da.N0 = (bf16*)(ws + WS_N2); da.DEN0 = (float*)(ws + WS_DEN23);
            da.N1 = (const bf16*)(ws + WS_N2); da.DEN1 = (const float*)(ws + WS_DEN23); da.N2 = (const bf16*)(ws + WS_N3); da.DEN2 = (const float*)(ws + WS_DEN23) + (size_t)M * 8; da.O = O; da.br0 = 1; da.nbr = 2; da.mode = 0; da.pad = 0;
            if (PH_ON) { for (int uu = bx; uu < 1024; uu += G) { const int br = 1 + (uu >> 9), rem = uu & 511; dattn_unit<0>((LAS char*)lds, da, br, rem >> 4, rem & 15, TID_L); } }
            PH_END;
            if (PH_ON) { for (int uu = bx; uu < 512; uu += G) dattn_unit<1>((LAS char*)lds, da, 0, uu >> 4, uu & 15, TID_L); }
            PH_END;
            mixo = O; mixo_ld = D;
        }
        if (PH_ON) { pg8::Gemm g{mixo, (const bf16*)(ws + (l ? WS_ODOUT : WS_EVOUT)), M, D, D, mixo_ld}; pg8::EpiResid E{l ? (const float*)out : a.in[0], out, XB, SSQP, D, M};
            pg8::StaticOrder S; S.init(g.M, g.N, G, bx); pg8::gemm_phase<pg8::EpiResid, pg8::StaticOrder, false, true>(lds, g, S, E); }
        PH_END;
        { bf16* Q = ACT; bf16* O = (bf16*)(ws + WS_ACT + 32 * MiB);
          if (PH_ON) { pg8::Gemm g{XB, (const bf16*)(ws + (l ? WS_XQ1 : WS_XQ0)), M, D, D, D}; pg8::EpiBf16S E{Q, SSQP, D, M, EPS, 0};
              pg8::StaticOrder S; S.init(g.M, g.N, G, bx); pg8::gemm_phase<pg8::EpiBf16S, pg8::StaticOrder, true, true>(lds, g, S, E); }
          PH_END;
          if (PH_ON) { for (int u = bx; u < (M / 256) * 4; u += G) xattn_unit((LAS char*)lds, Q, (const bf16*)(ws + (l ? WS_MKV1 : WS_MKV0)), (const float*)(ws + WS_GXA) + l * 256, O, u, TID_L); }
          PH_END;
          if (PH_ON) { pg8::Gemm g{O, (const bf16*)(ws + (l ? WS_XO1 : WS_XO0)), M, D, D, D}; pg8::EpiResid E{out, out, XB, SSQP, D, M};
              pg8::StaticOrder S; S.init(g.M, g.N, G, bx); pg8::gemm_phase<pg8::EpiResid, pg8::StaticOrder, false, true>(lds, g, S, E); }
          PH_END; }
        { bf16* H = ACT;
          if (PH_ON) { pg8::Gemm g{XB, (const bf16*)(ws + (l ? WS_FIN1 : WS_FIN0)), 68 * 256, 2 * DFF, D, D}; pg8::EpiFfn E{H, SSQP, a.in[22] + (size_t)l * 3 * DFF, a.in[23] + (size_t)l * DFF, M, EPS};
              pg8::FfnOrder S; S.init(g.M, g.N, G, bx); pg8::gemm_phase<pg8::EpiFfn, pg8::FfnOrder, true, true>(lds, g, S, E); }
          PH_END;
          if (PH_ON) { pg8::Gemm g{H, (const bf16*)(ws + (l ? WS_FOUT1 : WS_FOUT0)), M, D, DFF, DFF}; pg8::EpiResid E{out, out, XB, SSQP, D, M};
              pg8::StaticOrder S; S.init(g.M, g.N, G, bx); pg8::gemm_phase<pg8::EpiResid, pg8::StaticOrder, false, true>(lds, g, S, E); }
          PH_END; }
    }
#undef PH_ON
#undef PH_END
#undef TID_L
}
constexpr int N_PHASES = 1 + 10 + 9;

#ifndef MK_PER_PHASE
#define MK_PER_PHASE 0
#endif
extern "C" void kernel_launch(void* const* d_in, const int* in_sizes, int n_in, void* d_out, int out_size, void* d_ws, size_t ws_size, hipStream_t stream) {
    static int inited = 0;
    if (!inited) {
        if (n_in != 25 || out_size != M * D || ws_size < WS_END) { fprintf(stderr, "kernel_launch: unexpected shapes (n_in %d, out %d, ws %zu)\n", n_in, out_size, ws_size); inited = -1; return; }
        if (hipFuncSetAttribute((const void*)fwd, hipFuncAttributeMaxDynamicSharedMemorySize, LDS_BYTES) != hipSuccess) { fprintf(stderr, "kernel_launch: hipFuncSetAttribute failed\n"); inited = -1; return; }
        inited = 1;
    }
    if (inited < 0) return;
    if (hipMemsetAsync((char*)d_ws + WS_CTL, 0, CTL_ZERO_BYTES, stream) != hipSuccess) return;
    FwdArgs fa{}; for (int i = 0; i < 25; ++i) fa.in[i] = (const float*)d_in[i]; fa.out = (float*)d_out; fa.ws = (unsigned char*)d_ws; fa.pad = 0;
#if MK_PER_PHASE
    for (int p = 0; p < N_PHASES; ++p) { fa.ph_lo = p; fa.ph_hi = p + 1; fa.li = 0; hipLaunchKernelGGL(fwd, dim3(256), dim3(512), LDS_BYTES, stream, fa); }
#else
    fa.ph_lo = 0; fa.ph_hi = N_PHASES; fa.li = 0; hipLaunchKernelGGL(fwd, dim3(256), dim3(512), LDS_BYTES, stream, fa);
#endif
}
```

```cpp
#include <hip/hip_runtime.h>
#include <cstdio>
#include <cstdint>
namespace pg8 {
#define PG8_LAS __attribute__((address_space(3)))
typedef unsigned short bf16_t;
typedef short bf16x8 __attribute__((ext_vector_type(8)));
typedef float f32x4 __attribute__((ext_vector_type(4)));
typedef unsigned u32x4 __attribute__((ext_vector_type(4)));
constexpr int BM = 256, BK = 64, HALF = 128, HTB = HALF * BK * 2  , STAGE_BYTES = 8 * HTB, NXCD = 8, WGM = 8;

__host__ __device__ __forceinline__ int lds_byte(int r, int c) { const int st = (r >> 4) * 2 + (c >> 5), rr = r & 15, cc = c & 31, ob = rr * 64 + cc * 2; return st * 1024 + (ob ^ (((ob >> 9) & 1) << 5)); }
__host__ __device__ __forceinline__ void stage_rc(int b, int& R, int& C) { const int st = b / 1024, sb = b % 1024, swz = sb ^ (((sb >> 9) & 1) << 5); R = (st >> 1) * 16 + swz / 64; C = (st & 1) * 32 + (swz % 64) / 2; }
__host__ __device__ __forceinline__ int perm32(int rho) { const int n = rho >> 4, i = rho & 15; return 8 * (i >> 2) + 4 * n + (i & 3); }

struct Unit { int pm, pn; };
struct Gemm { const bf16_t* A; const bf16_t* Bt; int M, N, K, lda; };

struct StaticOrder {
    int nM, nN, nwg, G, c;
    __host__ __device__ void init(int M, int N, int G_, int c_) { nM = M / BM; nN = N / BM; nwg = nM * nN; G = G_; c = c_; }
    __host__ __device__ bool next(int i, Unit& u) const {
        const long L = (long)i * G + c; if (L >= nwg) return false;
        int wgid = (int)L; { const int q = nwg / NXCD, r = nwg % NXCD, xcd = wgid % NXCD, off = wgid / NXCD; wgid = (xcd < r ? xcd * (q + 1) : r * (q + 1) + (xcd - r) * q) + off; }
        const int nig = WGM * nN, gid = wgid / nig, fm = gid * WGM, gsz = (nM - fm) < WGM ? (nM - fm) : WGM;
        u.pm = fm + ((wgid % nig) % gsz); u.pn = (wgid % nig) / gsz; return true;
    }
    __device__ __forceinline__ void a_ready(const Unit&) const {}
    __device__ __forceinline__ void done(const Unit&) const {}
    __device__ __forceinline__ int arow(const Unit& u) const { return u.pm * BM; }
};
struct FfnOrder : StaticOrder {
    __device__ __forceinline__ int arow(const Unit& u) const { return (u.pm / 17) * 4096 + 254 * (u.pm % 17) - 2; }
};

__device__ __forceinline__ unsigned cvt_pk_bf16(float lo, float hi) { unsigned r; asm volatile("v_cvt_pk_bf16_f32 %0, %1, %2" : "=v"(r) : "v"(lo), "v"(hi)); return r; }
typedef float f32x2 __attribute__((ext_vector_type(2)));
struct EpiBf16S {
    static constexpr bool PERM = true, AFTER_DRAIN = false;
    bf16_t* O; const float* ssqp; int ldc; int Mtot; float eps; int pad;
    __device__ __forceinline__ void operator()(f32x4 (&acc)[2][2][4][2], const Unit& u, int wr, int wc, int fr, int fq, PG8_LAS unsigned char*) const {
        const int row0 = u.pm * BM + wr * 64 + fr; const int col0 = u.pn * BM + wc * 32 + 8 * fq;
#pragma unroll
        for (int ai = 0; ai < 2; ++ai)
#pragma unroll
            for (int m = 0; m < 4; ++m) { const int row = row0 + ai * HALF + m * 16; float rs = 1.f;
                if (ssqp) { const float s = (ssqp[row] + ssqp[Mtot + row]) + (ssqp[2 * Mtot + row] + ssqp[3 * Mtot + row]); rs = 1.0f / sqrtf(s * (1.0f / 1024.0f) + eps); }
                bf16_t* rowp = O + (size_t)row * ldc + col0;
#pragma unroll
                for (int bj = 0; bj < 2; ++bj) { const f32x4 v0 = acc[ai][bj][m][0] * rs, v1 = acc[ai][bj][m][1] * rs;
                    u32x4 w; w.x = cvt_pk_bf16(v0[0], v0[1]); w.y = cvt_pk_bf16(v0[2], v0[3]); w.z = cvt_pk_bf16(v1[0], v1[1]); w.w = cvt_pk_bf16(v1[2], v1[3]);
                    *(u32x4*)(rowp + bj * HALF) = w; } }
    }
};

__device__ __forceinline__ float gelu_tanh_f(float x) { const float u = 0.7978845608028654f * (x + 0.044715f * x * x * x); const float t = 1.0f - 2.0f / (1.0f + __expf(2.0f * u)); return 0.5f * x * (1.0f + t); }
struct EpiFfn {
    static constexpr bool PERM = true, AFTER_DRAIN = false;
    bf16_t* H; const float* ssqp; const float* cw; const float* cb; int Mtot; float eps;
    __device__ __forceinline__ void operator()(f32x4 (&acc)[2][2][4][2], const Unit& u, int wr, int wc, int fr, int fq, PG8_LAS unsigned char* lds) const {
        constexpr int DFF_ = 2816;
        const int b = u.pm / 17, t = u.pm % 17, pos0 = 254 * t - 2, rowb = b * 4096 + pos0;
        const int colh = u.pn * 128 + wc * 32 + 8 * fq, lane = fq * 16 + fr;
        PG8_LAS float* halo = (PG8_LAS float*)(lds + STAGE_BYTES);
#pragma unroll
        for (int ai = 0; ai < 2; ++ai)
#pragma unroll
            for (int m = 0; m < 4; ++m) { const int rl = ai * HALF + wr * 64 + m * 16 + fr, row = rowb + rl; const int rc = row < 0 ? 0 : (row >= Mtot ? Mtot - 1 : row);
                const float sq = (ssqp[rc] + ssqp[Mtot + rc]) + (ssqp[2 * Mtot + rc] + ssqp[3 * Mtot + rc]); const float rs = 1.0f / sqrtf(sq * (1.0f / 1024.0f) + eps); const bool pad = (pos0 + rl) < 0;
#pragma unroll
                for (int n = 0; n < 2; ++n) {
#pragma unroll
                    for (int e = 0; e < 4; ++e) { acc[ai][0][m][n][e] = pad ? 0.f : acc[ai][0][m][n][e] * rs; acc[ai][1][m][n][e] *= rs; } } }
#pragma unroll
        for (int ai = 0; ai < 2; ++ai) if (fr >= 14) { PG8_LAS float* hp = halo + ((((2 * ai + wr) * 4 + wc) * 4 + fq) * 2 + (fr - 14)) * 8;
            *(PG8_LAS f32x4*)hp = acc[ai][0][3][0]; *(PG8_LAS f32x4*)(hp + 4) = acc[ai][0][3][1]; }
        asm volatile("s_waitcnt lgkmcnt(0)" ::: "memory"); __builtin_amdgcn_s_barrier(); asm volatile("" ::: "memory");
        typedef unsigned u32x2e __attribute__((ext_vector_type(2)));
#define DPPF(x, ctrl) __builtin_bit_cast(float, __builtin_amdgcn_update_dpp(0, __builtin_bit_cast(int, (x)), (ctrl), 0xf, 0xf, true))
#pragma unroll
        for (int n = 0; n < 2; ++n) {
            const f32x4 w0 = *(const f32x4*)(cw + colh + 4 * n), w1 = *(const f32x4*)(cw + DFF_ + colh + 4 * n), w2 = *(const f32x4*)(cw + 2 * DFF_ + colh + 4 * n), bb = *(const f32x4*)(cb + colh + 4 * n);
#pragma unroll
            for (int ai = 0; ai < 2; ++ai) {
                const int blk = 2 * ai + wr; f32x4 R1p = (f32x4){0.f, 0.f, 0.f, 0.f}, R2p = (f32x4){0.f, 0.f, 0.f, 0.f};
                if (blk >= 1) { const PG8_LAS float* hp = halo + ((((blk - 1) * 4 + wc) * 4 + fq) * 2) * 8 + 4 * n; const f32x4 h62 = *(const PG8_LAS f32x4*)hp, h63 = *(const PG8_LAS f32x4*)(hp + 8);
                    const f32x4 z4 = (f32x4){0.f, 0.f, 0.f, 0.f}; R1p = fr == 0 ? h63 : z4; R2p = fr == 0 ? h62 : (fr == 1 ? h63 : z4); }
#pragma unroll
                for (int m = 0; m < 4; ++m) { const int rl = ai * HALF + wr * 64 + m * 16 + fr; const bool ok = (rl >= 2) && (pos0 + rl < 4096);
                    float hv[4];
#pragma unroll
                    for (int e = 0; e < 4; ++e) { const float v = acc[ai][0][m][n][e];
                        const float p1 = DPPF(v, 0x111) + R1p[e], p2 = DPPF(v, 0x112) + R2p[e]; R1p[e] = DPPF(v, 0x10F); R2p[e] = DPPF(v, 0x10E);
                        const float y = w0[e] * p2 + (w1[e] * p1 + (w2[e] * v + bb[e]));
                        const float tq = y * (-2.302208198f + -0.10294324f * (y * y));
                        const float sg = __builtin_amdgcn_rcpf(1.0f + __builtin_amdgcn_exp2f(tq));
                        hv[e] = (y * acc[ai][1][m][n][e]) * sg; }
                    if (ok) { u32x2e w; w.x = cvt_pk_bf16(hv[0], hv[1]); w.y = cvt_pk_bf16(hv[2], hv[3]); *(u32x2e*)(H + (size_t)(rowb + rl) * DFF_ + colh + 4 * n) = w; } }
            }
        }
#undef DPPF
        asm volatile("s_waitcnt lgkmcnt(0)" ::: "memory"); __builtin_amdgcn_s_barrier(); asm volatile("" ::: "memory");
    }
};
struct EpiResid {
    static constexpr bool PERM = false, AFTER_DRAIN = true;
    const float* base; float* out; bf16_t* xb; float* ssqp; int ldc; int Mtot;
    __device__ __forceinline__ void init(f32x4 (&acc)[2][2][4][2], const Unit& u, int wr, int wc, int fr, int fq) const {
        const int col0 = u.pn * BM + wc * 32 + 4 * fq;
#pragma unroll
        for (int ai = 0; ai < 2; ++ai)
#pragma unroll
            for (int m = 0; m < 4; ++m) { const size_t off = (size_t)(u.pm * BM + ai * HALF + wr * 64 + m * 16 + fr) * ldc + col0;
#pragma unroll
                for (int bj = 0; bj < 2; ++bj)
#pragma unroll
                    for (int n = 0; n < 2; ++n) acc[ai][bj][m][n] = *(const f32x4*)(base + off + bj * HALF + n * 16); }
    }
    __device__ __forceinline__ void fused(f32x4 (&acc)[2][2][4][2], const Unit& u, int wr, int wc, int fr, int fq, PG8_LAS unsigned char* lds, int wid, int lane) const {
        typedef unsigned u32x2v __attribute__((ext_vector_type(2)));
        PG8_LAS float* P = (PG8_LAS float*)lds;
        const int col0 = u.pn * BM + wc * 32 + 4 * fq;
#pragma unroll
        for (int ai = 0; ai < 2; ++ai)
#pragma unroll
            for (int m = 0; m < 4; ++m) { const int r = ai * HALF + wr * 64 + m * 16 + fr; const size_t off = (size_t)(u.pm * BM + r) * ldc + col0; float s = 0.f;
#pragma unroll
                for (int bj = 0; bj < 2; ++bj)
#pragma unroll
                    for (int n = 0; n < 2; ++n) { const f32x4 o = acc[ai][bj][m][n];
                        *(f32x4*)(out + off + bj * HALF + n * 16) = o; u32x2v w; w.x = cvt_pk_bf16(o[0], o[1]); w.y = cvt_pk_bf16(o[2], o[3]); *(u32x2v*)(xb + off + bj * HALF + n * 16) = w;
                        s += (o[0] * o[0] + o[1] * o[1]) + (o[2] * o[2] + o[3] * o[3]); }
                s += __shfl_xor(s, 16); s += __shfl_xor(s, 32);
                if (fq == 0) P[r * 4 + wc] = s;
                if (m & 1) asm volatile("" ::: "memory"); }
        asm volatile("s_waitcnt lgkmcnt(0)" ::: "memory"); __builtin_amdgcn_s_barrier(); asm volatile("" ::: "memory");
        if (lane < 32) { const int row = wid * 32 + lane; ssqp[(size_t)u.pn * Mtot + u.pm * BM + row] = (P[row * 4 + 0] + P[row * 4 + 1]) + (P[row * 4 + 2] + P[row * 4 + 3]); }
        asm volatile("s_waitcnt lgkmcnt(0)" ::: "memory"); __builtin_amdgcn_s_barrier(); asm volatile("" ::: "memory");
    }
};

template <class Epi, class Sched, bool ALIGN_EPI = false, bool SP2 = false>
__device__ __forceinline__ void gemm_phase(PG8_LAS unsigned char* lds, const Gemm g, const Sched& S, const Epi& E) {
    int tid_l = threadIdx.x; asm volatile("" : "+v"(tid_l));
    const int tid = tid_l, wid = __builtin_amdgcn_readfirstlane(tid >> 6), lane = tid & 63, wr = wid >> 2, wc = wid & 3, fr = lane & 15, fq = lane >> 4;
    const int K = g.K, nt = K / BK;
    unsigned voffA[2], voffB[2];
#pragma unroll
    for (int i = 0; i < 2; ++i) { int R, C; stage_rc(tid * 16 + i * 8192, R, C); const int Rb = Epi::PERM ? ((R & ~31) + perm32(R & 31)) : R;
        voffA[i] = (unsigned)(R * g.lda + C) * 2u; voffB[i] = (unsigned)(Rb * K + C) * 2u; }
    const size_t kstep = (size_t)(BK * 2);
    const size_t hstepA = (size_t)HALF * g.lda * 2, hstepB = (size_t)HALF * K * 2;
    const size_t tstepB = 2 * hstepB;
    const unsigned ldsw = (unsigned)wid * 1024u;
    const int aoff = lds_byte(wr * 64 + fr, fq * 8), boff = lds_byte(wc * 32 + fr, fq * 8);
#define PG8_SA(b, h) (((b) * 2 + (h)) * HTB)
#define PG8_SB(b, h) ((4 + (b) * 2 + (h)) * HTB)
#define PG8_STAGE(bufoff, gbase, voff) do { _Pragma("unroll") for (int _i = 0; _i < 2; ++_i) \
        __builtin_amdgcn_global_load_lds((const unsigned*)((const char*)(gbase) + (voff)[_i]), (PG8_LAS unsigned*)(lds + (bufoff) + ldsw + _i * 8192), 16, 0, 0); } while (0)
#define PG8_LDA(dst, b, h) do { _Pragma("unroll") for (int m = 0; m < 4; ++m) _Pragma("unroll") for (int k = 0; k < 2; ++k) dst[m][k] = *(const PG8_LAS bf16x8*)(lds + PG8_SA(b, h) + aoff + m * 2048 + k * 1024); } while (0)
#define PG8_LDB(dst, b, h) do { _Pragma("unroll") for (int n = 0; n < 2; ++n) _Pragma("unroll") for (int k = 0; k < 2; ++k) dst[n][k] = *(const PG8_LAS bf16x8*)(lds + PG8_SB(b, h) + boff + n * 2048 + k * 1024); } while (0)
#define PG8_MMA(ai, bj, At, Bt) do { __builtin_amdgcn_s_setprio(1); _Pragma("unroll") for (int m = 0; m < 4; ++m) _Pragma("unroll") for (int n = 0; n < 2; ++n) _Pragma("unroll") for (int k = 0; k < 2; ++k) \
        acc[ai][bj][m][n] = __builtin_amdgcn_mfma_f32_16x16x32_bf16(Bt[n][k], At[m][k], acc[ai][bj][m][n], 0, 0, 0); __builtin_amdgcn_s_setprio(0); } while (0)
#define PG8_WAIT_V(n) asm volatile("s_waitcnt vmcnt(" #n ")" ::: "memory")
#define PG8_WAIT_L(n) asm volatile("s_waitcnt lgkmcnt(" #n ")" ::: "memory")
#define PG8_BAR __builtin_amdgcn_s_barrier()
#define PG8_SCHED __builtin_amdgcn_sched_barrier(0)
    Unit cur, nxt; int ui = 0;
    if (!S.next(0, cur)) return;
    f32x4 acc[2][2][4][2];
#pragma unroll
    for (int a = 0; a < 2; ++a)
#pragma unroll
        for (int b = 0; b < 2; ++b)
#pragma unroll
            for (int m = 0; m < 4; ++m)
#pragma unroll
                for (int n = 0; n < 2; ++n) acc[a][b][m][n] = (f32x4){0.f, 0.f, 0.f, 0.f};
    if constexpr (Epi::AFTER_DRAIN) E.init(acc, cur, wr, wc, fr, fq);
    bf16x8 At[4][2], B0[2][2], B1[2][2];
    const char* cA = (const char*)g.A + (ptrdiff_t)S.arow(cur) * (ptrdiff_t)(g.lda * 2); const char* cB = (const char*)g.Bt + (size_t)cur.pn * tstepB;
    S.a_ready(cur);
    if constexpr (SP2) {
        PG8_STAGE(PG8_SB(0, 0), cB, voffB); PG8_STAGE(PG8_SB(0, 1), cB + hstepB, voffB); PG8_STAGE(PG8_SA(0, 0), cA, voffA); PG8_STAGE(PG8_SA(0, 1), cA + hstepA, voffA);
        if (wr == 1) PG8_BAR;
        PG8_WAIT_V(2); PG8_BAR;
        PG8_STAGE(PG8_SB(1, 0), cB + kstep, voffB); PG8_STAGE(PG8_SA(1, 0), cA + kstep, voffA); PG8_STAGE(PG8_SB(1, 1), cB + hstepB + kstep, voffB);
        PG8_WAIT_V(6); PG8_BAR;
        if constexpr (Epi::AFTER_DRAIN) {
#pragma unroll
            for (int a_ = 0; a_ < 2; ++a_)
#pragma unroll
                for (int b_ = 0; b_ < 2; ++b_) asm volatile("" : "+v"(acc[a_][b_][0][0]), "+v"(acc[a_][b_][0][1]), "+v"(acc[a_][b_][1][0]), "+v"(acc[a_][b_][1][1]), "+v"(acc[a_][b_][2][0]), "+v"(acc[a_][b_][2][1]), "+v"(acc[a_][b_][3][0]), "+v"(acc[a_][b_][3][1]));
        }
    } else {
        PG8_STAGE(PG8_SB(0, 0), cB, voffB); PG8_STAGE(PG8_SA(0, 0), cA, voffA); PG8_STAGE(PG8_SB(0, 1), cB + hstepB, voffB); PG8_STAGE(PG8_SA(0, 1), cA + hstepA, voffA);
        if (wr == 1) PG8_BAR;
        PG8_WAIT_V(4); PG8_BAR;
        PG8_STAGE(PG8_SB(1, 0), cB + kstep, voffB); PG8_STAGE(PG8_SA(1, 0), cA + kstep, voffA); PG8_STAGE(PG8_SB(1, 1), cB + hstepB + kstep, voffB);
        PG8_WAIT_V(6); PG8_BAR;
    }
    for (;;) {
        const bool has_next = S.next(ui + 1, nxt);
        const char* nA = has_next ? (const char*)g.A + (ptrdiff_t)S.arow(nxt) * (ptrdiff_t)(g.lda * 2) : cA; const char* nB = has_next ? (const char*)g.Bt + (size_t)nxt.pn * tstepB : cB;
        for (int t = 0; t < nt; t += 2) {
            const bool last = (t == nt - 2);
            const char* a1 = cA + (size_t)(t + 1) * kstep;
            const char* a2 = last ? nA : cA + (size_t)(t + 2) * kstep; const char* b2 = last ? nB : cB + (size_t)(t + 2) * kstep;
            const char* a3 = a2 + kstep; const char* b3 = b2 + kstep;
            if (last && has_next) S.a_ready(nxt);
            if constexpr (SP2) {
            PG8_LDB(B0, 0, 0); PG8_LDB(B1, 0, 1); PG8_SCHED; PG8_LDA(At, 0, 0); PG8_STAGE(PG8_SA(1, 1), a1 + hstepA, voffA);
            PG8_WAIT_V(8); PG8_WAIT_L(0); PG8_BAR; PG8_MMA(0, 0, At, B0); PG8_MMA(0, 1, At, B1); PG8_BAR; PG8_SCHED;
            PG8_LDA(At, 0, 1); PG8_STAGE(PG8_SB(0, 0), b2, voffB); PG8_STAGE(PG8_SB(0, 1), b2 + hstepB, voffB); PG8_STAGE(PG8_SA(0, 0), a2, voffA);
            PG8_WAIT_V(8); PG8_WAIT_L(0); PG8_BAR; PG8_MMA(1, 0, At, B0); PG8_MMA(1, 1, At, B1); PG8_BAR; PG8_SCHED;
            PG8_LDB(B0, 1, 0); PG8_LDB(B1, 1, 1); PG8_SCHED; PG8_LDA(At, 1, 0); PG8_STAGE(PG8_SA(0, 1), a2 + hstepA, voffA);
            PG8_WAIT_V(8); PG8_WAIT_L(0); PG8_BAR; PG8_MMA(0, 0, At, B0); PG8_MMA(0, 1, At, B1); PG8_BAR; PG8_SCHED;
            PG8_LDA(At, 1, 1); PG8_STAGE(PG8_SB(1, 0), b3, voffB); PG8_STAGE(PG8_SB(1, 1), b3 + hstepB, voffB); PG8_STAGE(PG8_SA(1, 0), a3, voffA);
            PG8_WAIT_V(8); PG8_WAIT_L(0); PG8_BAR; PG8_MMA(1, 0, At, B0); PG8_MMA(1, 1, At, B1); PG8_BAR; PG8_SCHED;
            } else {
            PG8_LDB(B0, 0, 0); PG8_SCHED; PG8_LDA(At, 0, 0); PG8_STAGE(PG8_SA(1, 1), a1 + hstepA, voffA);
            PG8_WAIT_L(8); PG8_BAR; PG8_WAIT_L(0); PG8_MMA(0, 0, At, B0); PG8_BAR; PG8_SCHED;
            PG8_LDB(B1, 0, 1); PG8_STAGE(PG8_SB(0, 0), b2, voffB);
            PG8_BAR; PG8_WAIT_L(0); PG8_MMA(0, 1, At, B1); PG8_BAR;
            PG8_LDA(At, 0, 1); PG8_STAGE(PG8_SA(0, 0), a2, voffA);
            PG8_BAR; PG8_WAIT_L(0); PG8_MMA(1, 0, At, B0); PG8_BAR; PG8_SCHED;
            PG8_STAGE(PG8_SB(0, 1), b2 + hstepB, voffB);
            PG8_WAIT_V(6); PG8_BAR; PG8_MMA(1, 1, At, B1); PG8_BAR;
            PG8_LDB(B0, 1, 0); PG8_SCHED; PG8_LDA(At, 1, 0); PG8_STAGE(PG8_SA(0, 1), a2 + hstepA, voffA);
            PG8_WAIT_L(8); PG8_BAR; PG8_WAIT_L(0); PG8_MMA(0, 0, At, B0); PG8_BAR; PG8_SCHED;
            PG8_LDB(B1, 1, 1); PG8_STAGE(PG8_SB(1, 0), b3, voffB);
            PG8_BAR; PG8_WAIT_L(0); PG8_MMA(0, 1, At, B1); PG8_BAR;
            PG8_LDA(At, 1, 1); PG8_STAGE(PG8_SA(1, 0), a3, voffA);
            PG8_BAR; PG8_WAIT_L(0); PG8_MMA(1, 0, At, B0); PG8_BAR; PG8_SCHED;
            PG8_STAGE(PG8_SB(1, 1), b3 + hstepB, voffB);
            PG8_WAIT_V(6); PG8_BAR; PG8_MMA(1, 1, At, B1); PG8_BAR;
            }
        }
        if constexpr (ALIGN_EPI) { if (wr == 0) PG8_BAR; }
        if constexpr (!Epi::AFTER_DRAIN) { E(acc, cur, wr, wc, fr, fq, lds); S.done(cur); }
        if (!has_next) break;
#pragma unroll
        for (int a = 0; a < 2; ++a)
#pragma unroll
            for (int b = 0; b < 2; ++b)
#pragma unroll
                for (int m = 0; m < 4; ++m)
#pragma unroll
                    for (int n = 0; n < 2; ++n) acc[a][b][m][n] = (f32x4){0.f, 0.f, 0.f, 0.f};
        cur = nxt; cA = nA; cB = nB; ++ui;
        if constexpr (ALIGN_EPI) { if (wr == 1) PG8_BAR; }
    }
    PG8_WAIT_V(0);
    if constexpr (!ALIGN_EPI) { if (wr == 0) PG8_BAR; }
    PG8_BAR;
    if constexpr (Epi::AFTER_DRAIN) { E.fused(acc, cur, wr, wc, fr, fq, lds, wid, lane); S.done(cur); }
#undef PG8_SA
#undef PG8_SB
#undef PG8_STAGE
#undef PG8_LDA
#undef PG8_LDB
#undef PG8_MMA
#undef PG8_WAIT_V
#undef PG8_WAIT_L
#undef PG8_BAR
#undef PG8_SCHED
}
}


#define GAS __attribute__((address_space(1)))
#define LAS __attribute__((address_space(3)))
typedef unsigned short bf16;
typedef unsigned v4u __attribute__((ext_vector_type(4)));
typedef unsigned v2u __attribute__((ext_vector_type(2)));
typedef float f32x4 __attribute__((ext_vector_type(4)));
constexpr int BATCH = 4, SEQ = 4096, D = 1024, M = BATCH * SEQ, NMEM = 256, MM = BATCH * NMEM, DFF = 2816;
constexpr int EV_IN = 4096, OD_IN = 3072;
constexpr float EPS = 1e-6f;
constexpr int Z_RQ = 0, Z_GQ = 512, Z_RK = 1024, Z_RV = 1536, Z_RG = 2048, Z_GF = 2560, Z_GI = 3072, Z_GG = 3584;

constexpr size_t MiB = 1u << 20;
constexpr size_t WS_CTL = 0;
constexpr size_t WS_EVIN = 1 * MiB, WS_EVOUT = 9 * MiB, WS_XQ0 = 11 * MiB, WS_XKV0 = 13 * MiB, WS_XO0 = 17 * MiB, WS_FIN0 = 19 * MiB, WS_FOUT0 = 30 * MiB;
constexpr size_t WS_ODIN = 36 * MiB, WS_ODOUT = 42 * MiB, WS_XQ1 = 44 * MiB, WS_XKV1 = 46 * MiB, WS_XO1 = 50 * MiB, WS_FIN1 = 52 * MiB, WS_FOUT1 = 63 * MiB;
constexpr size_t WS_XB = 69 * MiB;
constexpr size_t WS_MKV0 = 101 * MiB, WS_MKV1 = 105 * MiB;
constexpr size_t WS_MEMH0 = 109 * MiB, WS_MEMH1 = 111 * MiB;
constexpr size_t WS_SSQP = 113 * MiB;
constexpr size_t WS_LB = 113 * MiB + 512 * 1024;
constexpr size_t WS_BIAST = 113 * MiB + 516 * 1024;
constexpr size_t WS_GXA = 113 * MiB + 600 * 1024, WS_GOD = 113 * MiB + 604 * 1024;
constexpr size_t WS_DEN23 = 114 * MiB;
constexpr size_t WS_N2 = 1 * MiB;
constexpr size_t WS_N3 = 69 * MiB;
constexpr size_t WS_ACT = 115 * MiB;
constexpr size_t WS_DECA = 243 * MiB, WS_DECB = 243 * MiB + 512 * 1024;
constexpr size_t WS_END = 256 * MiB;

__device__ __forceinline__ float bf2f(bf16 u) { return __uint_as_float((unsigned)u << 16); }
__device__ __forceinline__ unsigned f2bf(float f) { unsigned u = __builtin_bit_cast(unsigned, f); return (u + 0x7fffu + ((u >> 16) & 1u)) >> 16; }
__device__ __forceinline__ unsigned pk2(float lo, float hi) { return f2bf(lo) | (f2bf(hi) << 16); }
__device__ __forceinline__ float wave_sum(float v) {
#pragma unroll
    for (int o = 1; o < 64; o <<= 1) v += __shfl_xor(v, o);
    return v;
}
__device__ __forceinline__ float wave_max(float v) {
#pragma unroll
    for (int o = 1; o < 64; o <<= 1) v = fmaxf(v, __shfl_xor(v, o));
    return v;
}
__device__ __forceinline__ void unpack8(const v4u w, float (&f)[8]) {
    f[0] = __uint_as_float(w.x << 16); f[1] = __uint_as_float(w.x & 0xffff0000u); f[2] = __uint_as_float(w.y << 16); f[3] = __uint_as_float(w.y & 0xffff0000u);
    f[4] = __uint_as_float(w.z << 16); f[5] = __uint_as_float(w.z & 0xffff0000u); f[6] = __uint_as_float(w.w << 16); f[7] = __uint_as_float(w.w & 0xffff0000u);
}
__device__ __forceinline__ void rope_sincos(float a, float& s, float& c) {
    const float n = rintf(a * 0.15915494309189535f);
    float r = fmaf(-n, 6.2831854820251465f, a); r = fmaf(-n, -1.7484555e-7f, r);
    const float rev = r * 0.15915494309189535f;
    s = __builtin_amdgcn_sinf(rev); c = __builtin_amdgcn_cosf(rev);
}

__device__ __forceinline__ int dst_row_map(int mode, int n0) {
    if (mode == 1) { const int seg = n0 >> 9, within = n0 & 511; const int dseg = (seg == 0) ? 0 : (seg == 4 ? 1 : (seg < 4 ? seg + 1 : seg)); return dseg * 512 + within; }
    if (mode == 2) { return n0 < DFF ? (n0 >> 7) * 256 + (n0 & 127) : ((n0 - DFF) >> 7) * 256 + 128 + ((n0 - DFF) & 127); }
    return n0;
}
__device__ __forceinline__ void transpose_item(const float* W, int K, int N, const float* g, bf16* WT, int mode, LAS float* scr, int item, int lane) {
    const int nblk = N / 64, kb = item / nblk, nb = item % nblk, k0 = 64 * kb, n0 = 64 * nb, lr = lane >> 4, lc = lane & 15;
    f32x4 v[16];
#pragma unroll
    for (int i = 0; i < 16; ++i) v[i] = *(const f32x4*)(W + (size_t)(k0 + 4 * i + lr) * N + n0 + 4 * lc);
#pragma unroll
    for (int i = 0; i < 16; ++i) { const int kk = 4 * i + lr; const float gg = g ? g[k0 + kk] : 1.0f; LAS float* p = scr + kk * 65 + 4 * lc; p[0] = v[i][0] * gg; p[1] = v[i][1] * gg; p[2] = v[i][2] * gg; p[3] = v[i][3] * gg; }
    asm volatile("s_waitcnt lgkmcnt(0)" ::: "memory");
    const int c = lane & 7; const int d0 = dst_row_map(mode, n0);
#pragma unroll
    for (int j = 0; j < 8; ++j) { const int n = (lane >> 3) + 8 * j; const LAS float* sp = scr + (8 * c) * 65 + n;
        v4u o; o.x = pk2(sp[0 * 65], sp[1 * 65]); o.y = pk2(sp[2 * 65], sp[3 * 65]); o.z = pk2(sp[4 * 65], sp[5 * 65]); o.w = pk2(sp[6 * 65], sp[7 * 65]);
        *(v4u*)(WT + (size_t)(d0 + n) * K + k0 + 8 * c) = o; }
    asm volatile("s_waitcnt lgkmcnt(0)" ::: "memory");
}
struct ProArgs { const float* in[25]; unsigned char* ws; int layer_mask; int ffn_mode; };
#define CONVERT_JOB(Wp, K_, N_, gp, dst, mode) do { const int nitems = ((K_) / 64) * ((N_) / 64); for (int it = gw; it < nitems; it += NGW) transpose_item((Wp), (K_), (N_), (gp), (bf16*)(ws + (dst)), (mode), scr, it, lane); } while (0)
__device__ __forceinline__ void prologue_body(const ProArgs& a, int gw, int NGW, int lane, LAS float* scr) {
    unsigned char* ws = a.ws;
    const float* x = a.in[0]; const float* mem = a.in[1];
    if (a.layer_mask & 1) {
        CONVERT_JOB(a.in[3], D, EV_IN, a.in[2], WS_EVIN, 1);
        CONVERT_JOB(a.in[7], D, D, (const float*)nullptr, WS_EVOUT, 0);
        CONVERT_JOB(a.in[15], D, D, a.in[13], WS_XQ0, 0);
        CONVERT_JOB(a.in[16], D, 2 * D, (const float*)nullptr, WS_XKV0, 0);
        CONVERT_JOB(a.in[19], D, D, (const float*)nullptr, WS_XO0, 0);
        CONVERT_JOB(a.in[21], D, 2 * DFF, a.in[20], WS_FIN0, a.ffn_mode);
        CONVERT_JOB(a.in[24], DFF, D, (const float*)nullptr, WS_FOUT0, 0);
        for (int m = 2 * gw; m < M; m += 2 * NGW) {
            const f32x4* xr = (const f32x4*)(x + (size_t)m * D) + lane; v2u* o8 = (v2u*)((bf16*)(ws + WS_XB) + (size_t)m * D) + lane; float* sp = (float*)(ws + WS_SSQP);
            f32x4 v[8];
#pragma unroll
            for (int j = 0; j < 8; ++j) v[j] = xr[64 * j];
#pragma unroll
            for (int j = 0; j < 8; ++j) { v2u w; w.x = pk2(v[j][0], v[j][1]); w.y = pk2(v[j][2], v[j][3]); o8[64 * j] = w;
                const float s2 = wave_sum((v[j][0] * v[j][0] + v[j][1] * v[j][1]) + (v[j][2] * v[j][2] + v[j][3] * v[j][3])); if (lane == 0) sp[(size_t)(j & 3) * M + m + (j >> 2)] = s2; }
        }
        for (int r = gw; r < 2 * MM; r += NGW) { const int l = r / MM, m = r % MM;
            const f32x4* xr = (const f32x4*)(mem + (size_t)m * D) + lane; const f32x4* gr = (const f32x4*)(a.in[14] + (size_t)l * D) + lane;
            f32x4 v[4]; float s = 0.f;
#pragma unroll
            for (int j = 0; j < 4; ++j) { v[j] = xr[64 * j]; s += (v[j][0] * v[j][0] + v[j][1] * v[j][1]) + (v[j][2] * v[j][2] + v[j][3] * v[j][3]); }
            const float rs = 1.0f / sqrtf(wave_sum(s) * (1.0f / D) + EPS);
            v2u* o8 = (v2u*)((bf16*)(ws + (l ? WS_MEMH1 : WS_MEMH0)) + (size_t)m * D) + lane;
#pragma unroll
            for (int j = 0; j < 4; ++j) { const f32x4 g = gr[64 * j]; v2u w; w.x = pk2(v[j][0] * rs * g[0], v[j][1] * rs * g[1]); w.y = pk2(v[j][2] * rs * g[2], v[j][3] * rs * g[3]); o8[64 * j] = w; }
        }
        if (gw == 0) {
            const float* lg = a.in[6]; float* lb = (float*)(ws + WS_LB);
            for (int c = lane; c < 512; c += 64) { const float a0 = lg[c], a1 = lg[512 + c], a2 = lg[1024 + c]; const float mx = fmaxf(a0, fmaxf(a1, a2));
                const float e0 = expf(a0 - mx), e1 = expf(a1 - mx), e2 = expf(a2 - mx); lb[c] = e0 / (e0 + e1 + e2); }
        }
        if (gw == 2) {
            float* gx = (float*)(ws + WS_GXA); float* go = (float*)(ws + WS_GOD);
            for (int i = lane; i < 512; i += 64) gx[i] = a.in[18][i] * a.in[17][i];
            for (int i = lane; i < 128; i += 64) go[i] = a.in[10][i] * a.in[9][i];
        }
        if (gw == 1) {
            const float* rb = a.in[11]; float* bt = (float*)(ws + WS_BIAST);
            for (int i = lane; i < 3 * 8 * 132; i += 64) { const int br = i / (8 * 132), h = (i / 132) % 8, dl = i % 132; const int d = dl * (1 << (2 * br));
                int bucket; if (d < 16) bucket = d; else { const float lr = logf((float)d / 16.0f) / 4.852030263919617f; int lg2 = 16 + (int)(lr * 16.0f); bucket = lg2 < 31 ? lg2 : 31; }
                bt[i] = (dl <= 128) ? rb[bucket * 8 + h] : 0.f; }
        }
    }
    if (a.layer_mask & 2) {
        CONVERT_JOB(a.in[8], D, OD_IN, a.in[2] + D, WS_ODIN, 0);
        CONVERT_JOB(a.in[12], D, D, (const float*)nullptr, WS_ODOUT, 0);
        CONVERT_JOB(a.in[15] + (size_t)D * D, D, D, a.in[13] + D, WS_XQ1, 0);
        CONVERT_JOB(a.in[16] + (size_t)D * 2 * D, D, 2 * D, (const float*)nullptr, WS_XKV1, 0);
        CONVERT_JOB(a.in[19] + (size_t)D * D, D, D, (const float*)nullptr, WS_XO1, 0);
        CONVERT_JOB(a.in[21] + (size_t)D * 2 * DFF, D, 2 * DFF, a.in[20] + D, WS_FIN1, a.ffn_mode);
        CONVERT_JOB(a.in[24] + (size_t)DFF * D, DFF, D, (const float*)nullptr, WS_FOUT1, 0);
    }
}


typedef short bf16x8 __attribute__((ext_vector_type(8)));
typedef short s16x4 __attribute__((ext_vector_type(4)));
typedef float f32x16 __attribute__((ext_vector_type(16)));
typedef float f32x2_t __attribute__((ext_vector_type(2))); typedef __bf16 bf16x2_t __attribute__((ext_vector_type(2)));
typedef short v4i16_t __attribute__((ext_vector_type(4)));
#define MFMA32(a, b, c) __builtin_amdgcn_mfma_f32_32x32x16_bf16((a), (b), (c), 0, 0, 0)
__device__ __forceinline__ unsigned cvtpk(float lo, float hi) { f32x2_t v = {lo, hi}; bf16x2_t b = __builtin_convertvector(v, bf16x2_t); return __builtin_bit_cast(unsigned, b); }
__device__ __forceinline__ bf16x8 pack8(float a0, float a1, float a2, float a3, float a4, float a5, float a6, float a7) {
    v4u p; p.x = cvtpk(a0, a1); p.y = cvtpk(a2, a3); p.z = cvtpk(a4, a5); p.w = cvtpk(a6, a7); return __builtin_bit_cast(bf16x8, p); }
__device__ __forceinline__ s16x4 vtr(const LAS char* p) { return __builtin_bit_cast(s16x4, __builtin_amdgcn_ds_read_tr16_b64_v4i16((LAS v4i16_t*)p)); }
__device__ __forceinline__ int tr_lane_base(int lane, int stride) { const int g = lane >> 4, i = lane & 15, q = i >> 2, p = i & 3, h2 = g >> 1; return (4 * h2 + q) * stride + (16 * (g & 1) + 4 * p) * 2; }
__device__ __forceinline__ bf16x8 tr_frag_perm(const LAS char* img, int stride, int lbase, int k0, int n0) {
    const LAS char* p = img + lbase + k0 * stride + n0 * 2;
    const s16x4 lo = vtr(p), hi = vtr(p + 8 * stride);
    return (bf16x8){lo[0], lo[1], lo[2], lo[3], hi[0], hi[1], hi[2], hi[3]};
}
__device__ __forceinline__ int tr_lane_base_nat(int lane, int stride) { const int g = lane >> 4, i = lane & 15, q = i >> 2, p = i & 3, h2 = g >> 1; return (8 * h2 + q) * stride + (16 * (g & 1) + 4 * p) * 2; }
__device__ __forceinline__ bf16x8 tr_frag_nat(const LAS char* img, int stride, int lbase, int k0, int n0) {
    const LAS char* p = img + lbase + k0 * stride + n0 * 2;
    const s16x4 lo = vtr(p), hi = vtr(p + 4 * stride);
    return (bf16x8){lo[0], lo[1], lo[2], lo[3], hi[0], hi[1], hi[2], hi[3]};
}

constexpr int XA_STRIDE = 528;
constexpr int XA_LDS = 256 * XA_STRIDE;
__device__ __forceinline__ void xattn_unit(LAS char* lds, const bf16* __restrict__ Q, const bf16* __restrict__ MKV, const float* __restrict__ gkq, bf16* __restrict__ O, int unit, int tid) {
    const int lane = tid & 63, w = __builtin_amdgcn_readfirstlane(tid >> 6), r = lane & 31, h2 = lane >> 5;
    const int rb = unit >> 2, h = unit & 3, row0 = rb * 256, b = row0 / SEQ;
    const bf16* Kg = MKV + (size_t)(b * NMEM) * 2048 + h * 256; const bf16* Vg = Kg + 1024;
    v4u st[16];
#pragma unroll
    for (int i = 0; i < 16; ++i) { const int id = tid + 512 * i; st[i] = *(const v4u*)(Kg + (size_t)(id >> 5) * 2048 + (id & 31) * 8); }
    const size_t qoff = (size_t)(row0 + 32 * w + r) * D + h * 256;
    bf16x8 qf[16];
#pragma unroll
    for (int s = 0; s < 16; ++s) qf[s] = *(const bf16x8*)(Q + qoff + 8 * h2 + 16 * s);
    { float gk8[8];
#pragma unroll
      for (int e = 0; e < 8; ++e) gk8[e] = gkq[(tid & 31) * 8 + e];
#pragma unroll
      for (int i = 0; i < 16; ++i) { const int id = tid + 512 * i; float f[8]; unpack8(st[i], f);
          float sq = (f[0] * f[0] + f[1] * f[1]) + (f[2] * f[2] + f[3] * f[3]) + (f[4] * f[4] + f[5] * f[5]) + (f[6] * f[6] + f[7] * f[7]);
          sq += __shfl_xor(sq, 1); sq += __shfl_xor(sq, 2); sq += __shfl_xor(sq, 4); sq += __shfl_xor(sq, 8); sq += __shfl_xor(sq, 16);
          const float rk = 1.0f / sqrtf(sq * (1.0f / 256.0f) + EPS) * 0.0625f;
          v4u o; o.x = cvtpk(f[0] * rk * gk8[0], f[1] * rk * gk8[1]); o.y = cvtpk(f[2] * rk * gk8[2], f[3] * rk * gk8[3]); o.z = cvtpk(f[4] * rk * gk8[4], f[5] * rk * gk8[5]); o.w = cvtpk(f[6] * rk * gk8[6], f[7] * rk * gk8[7]);
          *(LAS v4u*)(lds + (id >> 5) * XA_STRIDE + (id & 31) * 16) = o; } }
    float ss = 0.f;
#pragma unroll
    for (int s = 0; s < 16; ++s)
#pragma unroll
        for (int j = 0; j < 8; ++j) { const float x = __uint_as_float((unsigned)(unsigned short)qf[s][j] << 16); ss += x * x; }
    ss += __shfl_xor(ss, 32);
    const float rsl = 1.0f / sqrtf(ss * (1.0f / 256.0f) + EPS) * 1.4426950408889634f;
    __syncthreads();
    bf16x8 pf[8][2]; float den = 0.f;
#pragma unroll
    for (int kb = 0; kb < 8; ++kb) {
        f32x16 acc;
#pragma unroll
        for (int i = 0; i < 16; ++i) acc[i] = 0.f;
        const LAS char* kp = lds + (32 * kb + r) * XA_STRIDE + h2 * 16;
#pragma unroll
        for (int s = 0; s < 16; ++s) { const bf16x8 a = *(const LAS bf16x8*)(kp + s * 32); acc = MFMA32(a, qf[s], acc); }
        float p[16];
#pragma unroll
        for (int i = 0; i < 16; ++i) { p[i] = __builtin_amdgcn_exp2f(acc[i] * rsl - 11.541560327111707f); den += p[i]; }
        pf[kb][0] = pack8(p[0], p[1], p[2], p[3], p[4], p[5], p[6], p[7]); pf[kb][1] = pack8(p[8], p[9], p[10], p[11], p[12], p[13], p[14], p[15]);
    }
    den += __shfl_xor(den, 32);
    const float inv = 1.0f / den;
    __syncthreads();
#pragma unroll
    for (int i = 0; i < 16; ++i) { const int id = tid + 512 * i; st[i] = *(const v4u*)(Vg + (size_t)(id >> 5) * 2048 + (id & 31) * 8); }
#pragma unroll
    for (int i = 0; i < 16; ++i) { const int id = tid + 512 * i; *(LAS v4u*)(lds + (id >> 5) * XA_STRIDE + (id & 31) * 16) = st[i]; }
    __syncthreads();
    const int lbase = tr_lane_base(lane, XA_STRIDE);
#pragma unroll
    for (int half = 0; half < 2; ++half) {
        f32x16 o[4];
#pragma unroll
        for (int vb = 0; vb < 4; ++vb)
#pragma unroll
            for (int i = 0; i < 16; ++i) o[vb][i] = 0.f;
#pragma unroll
        for (int kb = 0; kb < 8; ++kb)
#pragma unroll
            for (int s = 0; s < 2; ++s)
#pragma unroll
                for (int vb = 0; vb < 4; ++vb) { const bf16x8 a = tr_frag_perm(lds, XA_STRIDE, lbase, 32 * kb + 16 * s, 128 * half + 32 * vb); o[vb] = MFMA32(a, pf[kb][s], o[vb]); }
        bf16* orow = O + qoff + 128 * half + 4 * h2;
#pragma unroll
        for (int vb = 0; vb < 4; ++vb)
#pragma unroll
            for (int g4 = 0; g4 < 4; ++g4) { v2u wv; wv.x = cvtpk(o[vb][4 * g4] * inv, o[vb][4 * g4 + 1] * inv); wv.y = cvtpk(o[vb][4 * g4 + 2] * inv, o[vb][4 * g4 + 3] * inv);
                *(v2u*)(orow + 32 * vb + 8 * g4) = wv; }
    }
    __syncthreads();
}


constexpr int DA_STRIDE = 272, DA_LDS_BIAS = 384 * DA_STRIDE;
struct DaArgs { const bf16* QKV; const float* biasT; const float* gkq; bf16* N0; float* DEN0; const bf16* N1; const float* DEN1; const bf16* N2; const float* DEN2; bf16* O; int br0; int nbr; int mode; int pad; };
#define LDS_BARRIER() do { asm volatile("s_waitcnt lgkmcnt(0)" ::: "memory"); __builtin_amdgcn_s_barrier(); asm volatile("" ::: "memory"); } while (0)
struct DaUnit { int br, b, h, dil, cls, l0; };
template <int MODE> __device__ __forceinline__ DaUnit da_decode(int uu) {
    DaUnit U; U.br = MODE == 0 ? __builtin_amdgcn_readfirstlane(1 + (uu >> 9)) : 0; const int rem = __builtin_amdgcn_readfirstlane(uu & 511), x = rem & 15; U.b = rem >> 7; U.h = (rem >> 4) & 7; U.dil = 1 << (2 * U.br);
    U.cls = U.br == 0 ? 0 : (U.br == 1 ? (x & 3) : x); U.l0 = 256 * (U.br == 0 ? x : (U.br == 1 ? (x >> 2) : 0)); return U; }
__device__ __forceinline__ void da_load_rows(v4u (&st)[12], const bf16* QKV, const DaUnit& U, int col, int tid) {
    const bf16* base = QKV + (size_t)(U.b * SEQ) * OD_IN + U.h * 128 + col + (tid & 15) * 8;
#pragma unroll
    for (int i = 0; i < 12; ++i) { const int ki = (tid >> 4) + 32 * i, lk = U.l0 - 128 + ki, lkc = lk < 0 ? 0 : lk; st[i] = *(const v4u*)(base + (size_t)(lkc * U.dil + U.cls) * OD_IN); }
}
template <int MODE> __device__ __forceinline__ void dattn_phase(LAS char* lds, const DaArgs& a, int bx, int G, int tid) {
    constexpr int NUNITS = MODE == 0 ? 1024 : 512;
    const int lane = tid & 63, w = __builtin_amdgcn_readfirstlane(tid >> 6), r = lane & 31, h2 = lane >> 5;
    int uu = bx; if (uu >= NUNITS) return;
    v4u st[12];
    { const DaUnit U0 = da_decode<MODE>(uu); da_load_rows(st, a.QKV, U0, 1024, tid); }
    LAS float* lbias = (LAS float*)(lds + DA_LDS_BIAS);
    const int lbase = tr_lane_base(lane, DA_STRIDE);
    for (;;) {
        const DaUnit U = da_decode<MODE>(uu);
        const int l0 = U.l0, h = U.h; const bool zfirst = (l0 == 0);
        int r_l = r; asm volatile("" : "+v"(r_l));
        float gk8[8];
#pragma unroll
        for (int e = 0; e < 8; ++e) gk8[e] = a.gkq[(tid & 15) * 8 + e];
        const size_t qrow = (size_t)(U.b * SEQ + (l0 + 32 * w + r) * U.dil + U.cls);
#pragma unroll
        for (int i = 0; i < 12; ++i) { float f_[8]; unpack8((i < 4 && zfirst) ? (v4u){0u, 0u, 0u, 0u} : st[i], f_);
            float sq_ = (f_[0] * f_[0] + f_[1] * f_[1]) + (f_[2] * f_[2] + f_[3] * f_[3]) + (f_[4] * f_[4] + f_[5] * f_[5]) + (f_[6] * f_[6] + f_[7] * f_[7]);
            sq_ += __shfl_xor(sq_, 1); sq_ += __shfl_xor(sq_, 2); sq_ += __shfl_xor(sq_, 4); sq_ += __shfl_xor(sq_, 8);
            const float rk_ = 1.0f / sqrtf(sq_ * (1.0f / 128.0f) + EPS) * 0.08838834764831845f;
            v4u o_; o_.x = cvtpk(f_[0] * rk_ * gk8[0], f_[1] * rk_ * gk8[1]); o_.y = cvtpk(f_[2] * rk_ * gk8[2], f_[3] * rk_ * gk8[3]); o_.z = cvtpk(f_[4] * rk_ * gk8[4], f_[5] * rk_ * gk8[5]); o_.w = cvtpk(f_[6] * rk_ * gk8[6], f_[7] * rk_ * gk8[7]);
            *(LAS v4u*)(lds + ((tid >> 4) + 32 * i) * DA_STRIDE + (tid & 15) * 16) = o_; }
        if (tid < 132) lbias[tid] = a.biasT[(U.br * 8 + h) * 132 + tid];
        asm volatile("" ::: "memory");
        bf16x8 qf[8];
#pragma unroll
        for (int s = 0; s < 8; ++s) qf[s] = *(const bf16x8*)(a.QKV + qrow * OD_IN + h * 128 + 8 * h2 + 16 * s);
        da_load_rows(st, a.QKV, U, 2048, tid);
        float ss = 0.f;
#pragma unroll
        for (int s = 0; s < 8; ++s)
#pragma unroll
            for (int j = 0; j < 8; ++j) { const float xq = __uint_as_float((unsigned)(unsigned short)qf[s][j] << 16); ss += xq * xq; }
        ss += __shfl_xor(ss, 32);
        const float rsl = 1.0f / sqrtf(ss * (1.0f / 128.0f) + EPS) * 1.4426950408889634f;
        LDS_BARRIER();
        bf16x8 pf[5][2]; float den = 0.f;
#pragma unroll
        for (int kbi = 0; kbi < 5; ++kbi) {
            f32x16 acc;
#pragma unroll
            for (int i = 0; i < 16; ++i) acc[i] = 0.f;
            const LAS char* kp = lds + (32 * (w + kbi) + r) * DA_STRIDE + h2 * 16;
#pragma unroll
            for (int s = 0; s < 8; ++s) { const bf16x8 av = *(const LAS bf16x8*)(kp + s * 32); acc = MFMA32(av, qf[s], acc); }
            __builtin_amdgcn_sched_barrier(0);
#pragma unroll
            for (int hh = 0; hh < 2; ++hh) { float p[8];
#pragma unroll
                for (int i8 = 0; i8 < 8; ++i8) { const int i = 8 * hh + i8; const int c = (i & 3) + 8 * (i >> 2) + 4 * h2; const int delta = 128 - 32 * kbi + r_l - c; const int ki = 32 * (w + kbi) + c;
                    const bool valid = (delta >= 0) && (delta <= 128) && (l0 - 128 + ki >= 0); const int dcl = delta < 0 ? 0 : (delta > 128 ? 128 : delta);
                    const float e = __builtin_amdgcn_exp2f(acc[i] * rsl + lbias[dcl] * 1.4426950408889634f - 11.541560327111707f); p[i8] = valid ? e : 0.f; den += p[i8]; }
                pf[kbi][hh] = pack8(p[0], p[1], p[2], p[3], p[4], p[5], p[6], p[7]);
                __builtin_amdgcn_sched_barrier(0); }
            asm volatile("" ::: "memory");
        }
        den += __shfl_xor(den, 32);
        LDS_BARRIER();
#pragma unroll
        for (int i = 0; i < 12; ++i) *(LAS v4u*)(lds + ((tid >> 4) + 32 * i) * DA_STRIDE + (tid & 15) * 16) = (i < 4 && zfirst) ? (v4u){0u, 0u, 0u, 0u} : st[i];
        LDS_BARRIER();
        const int un = uu + G; const bool more = un < NUNITS; const DaUnit Un = da_decode<MODE>(more ? un : uu);
        if (more) da_load_rows(st, a.QKV, Un, 1024, tid);
        const size_t ooff = qrow * D + h * 128 + 4 * h2;
        float inv = 1.0f;
        if (MODE == 0) { if (h2 == 0) ((float*)(U.br == 1 ? a.DEN1 : a.DEN2))[qrow * 8 + h] = den; }
        else { inv = 1.0f / (den + a.DEN1[qrow * 8 + h] + a.DEN2[qrow * 8 + h]); }
#pragma unroll
        for (int half = 0; half < 2; ++half) {
            f32x16 o[2];
#pragma unroll
            for (int vb = 0; vb < 2; ++vb)
#pragma unroll
                for (int i = 0; i < 16; ++i) o[vb][i] = 0.f;
#pragma unroll
            for (int kbi = 0; kbi < 5; ++kbi)
#pragma unroll
                for (int s = 0; s < 2; ++s)
#pragma unroll
                    for (int vb = 0; vb < 2; ++vb) { const bf16x8 av = tr_frag_perm(lds, DA_STRIDE, lbase, 32 * (w + kbi) + 16 * s, 64 * half + 32 * vb); o[vb] = MFMA32(av, pf[kbi][s], o[vb]); }
            if (MODE == 0) {
                bf16* N = (bf16*)(U.br == 1 ? a.N1 : a.N2) + ooff + 64 * half;
#pragma unroll
                for (int vb = 0; vb < 2; ++vb)
#pragma unroll
                    for (int g4 = 0; g4 < 4; ++g4) { v2u wv; wv.x = cvtpk(o[vb][4 * g4], o[vb][4 * g4 + 1]); wv.y = cvtpk(o[vb][4 * g4 + 2], o[vb][4 * g4 + 3]); *(v2u*)(N + 32 * vb + 8 * g4) = wv; }
            } else {
                const bf16* N1 = a.N1 + ooff + 64 * half; const bf16* N2 = a.N2 + ooff + 64 * half; bf16* Op = a.O + ooff + 64 * half;
#pragma unroll
                for (int vb = 0; vb < 2; ++vb)
#pragma unroll
                    for (int g4 = 0; g4 < 4; ++g4) { const v2u n1 = *(const v2u*)(N1 + 32 * vb + 8 * g4), n2 = *(const v2u*)(N2 + 32 * vb + 8 * g4);
                        const float x0 = o[vb][4 * g4] + __uint_as_float(n1.x << 16) + __uint_as_float(n2.x << 16), x1 = o[vb][4 * g4 + 1] + __uint_as_float(n1.x & 0xffff0000u) + __uint_as_float(n2.x & 0xffff0000u);
                        const float x2 = o[vb][4 * g4 + 2] + __uint_as_float(n1.y << 16) + __uint_as_float(n2.y << 16), x3 = o[vb][4 * g4 + 3] + __uint_as_float(n1.y & 0xffff0000u) + __uint_as_float(n2.y & 0xffff0000u);
                        v2u wv; wv.x = cvtpk(x0 * inv, x1 * inv); wv.y = cvtpk(x2 * inv, x3 * inv); *(v2u*)(Op + 32 * vb + 8 * g4) = wv; }
            }
            asm volatile("" ::: "memory");
        }
        LDS_BARRIER();
        if (!more) break;
        uu = un;
    }
}

constexpr int MX_STRIDE = 272, MX_IMG = 128 * MX_STRIDE;
constexpr int MX_Q = 0, MX_K = MX_IMG, MX_V = 2 * MX_IMG, MX_SCR = 3 * MX_IMG;
struct MixArgs { bf16* Z; const float* lb; const float* ret_g; const float* hg_g; bf16* SBUF; float* DECA; float* DECB; };

__device__ __forceinline__ void st_chunk8(LAS char* img, int row, int c0, const float (&f)[8]) {
    v4u o; o.x = cvtpk(f[0], f[1]); o.y = cvtpk(f[2], f[3]); o.z = cvtpk(f[4], f[5]); o.w = cvtpk(f[6], f[7]); *(LAS v4u*)(img + row * MX_STRIDE + c0 * 2) = o; }

__device__ __forceinline__ void ret_prep_tile(LAS char* img, const bf16* zrow  , int j, int cg, const float (&sn)[16], const float (&cs)[16], float sc) {
#pragma unroll
    for (int hc = 0; hc < 2; ++hc) { float x1[8], x2[8], o1[8], o2[8];
        unpack8(*(const v4u*)(zrow + 16 * cg + 8 * hc), x1); unpack8(*(const v4u*)(zrow + 64 + 16 * cg + 8 * hc), x2);
#pragma unroll
        for (int e = 0; e < 8; ++e) { o1[e] = (x1[e] * cs[8 * hc + e] - x2[e] * sn[8 * hc + e]) * sc; o2[e] = (x1[e] * sn[8 * hc + e] + x2[e] * cs[8 * hc + e]) * sc; }
        st_chunk8(img, j, 16 * cg + 8 * hc, o1); st_chunk8(img, j, 64 + 16 * cg + 8 * hc, o2); }
}
__device__ __forceinline__ void copy_tile(LAS char* img, const bf16* src, int tid) {
#pragma unroll
    for (int i = 0; i < 4; ++i) { const int id = tid + 512 * i, row = id >> 4, ch = id & 15; *(LAS v4u*)(img + row * MX_STRIDE + ch * 16) = *(const v4u*)(src + (size_t)row * EV_IN + ch * 8); }
}
__device__ __forceinline__ void hg_gates(const bf16* zrow_f  , const float* lbh  , int tid, LAS float* scr, float (&cum)[32], float (&kk)[32]) {
    const int lane = tid & 63, hw = (tid >> 6) & 1, cg = tid >> 7;
#pragma unroll
    for (int q = 0; q < 4; ++q) { float fl[8]; unpack8(*(const v4u*)(zrow_f + 32 * cg + 8 * q), fl);
#pragma unroll
        for (int e = 0; e < 8; ++e) { const float l = lbh[32 * cg + 8 * q + e]; const float f = l + (1.0f - l) * (1.0f / (1.0f + __expf(-fl[e]))); kk[8 * q + e] = 1.0f - f; cum[8 * q + e] = __logf(fmaxf(f, 1e-6f)); } }
#pragma unroll
    for (int off = 1; off < 64; off <<= 1) {
#pragma unroll
        for (int c = 0; c < 32; ++c) { const float t = __shfl_up(cum[c], off); if (lane >= off) cum[c] += t; } }
    if (hw == 0 && lane == 63) {
#pragma unroll
        for (int c = 0; c < 32; ++c) scr[32 * cg + c] = cum[c]; }
    __syncthreads();
    if (hw == 1) {
#pragma unroll
        for (int c = 0; c < 32; ++c) cum[c] += scr[32 * cg + c]; }
    if (hw == 1 && lane == 63) {
#pragma unroll
        for (int c = 0; c < 32; ++c) scr[128 + 32 * cg + c] = cum[c]; }
    __syncthreads();
}

__device__ __forceinline__ void mixA_unit(LAS char* lds, const MixArgs& a, int u, int tid) {
    const int lane = tid & 63, w = __builtin_amdgcn_readfirstlane(tid >> 6), r = lane & 31, h2 = lane >> 5;
    const int g = u >> 5, n = u & 31, mixer = g >> 4, b = (g >> 2) & 3, h = g & 3;
    const int j = tid & 127, cg = tid >> 7;
    const bf16* zt = a.Z + (size_t)(b * SEQ + 128 * n) * EV_IN;
    LAS float* scr = (LAS float*)(lds + MX_SCR);
    if (mixer == 0) {
        const float gamma = 1.0f - exp2f(-5.0f - (float)h), lg2 = log2f(gamma);
        float sn[16], cs[16];
#pragma unroll
        for (int e = 0; e < 16; ++e) { const float inv = exp2f(-(float)(16 * cg + e) * (13.287712379549449f / 64.0f)); rope_sincos((float)(128 * n + j) * inv, sn[e], cs[e]); }
        ret_prep_tile(lds + MX_K, zt + (size_t)j * EV_IN + Z_RK + h * 128, j, cg, sn, cs, 0.08838834764831845f * exp2f((float)(127 - j) * lg2));
        copy_tile(lds + MX_V, zt + Z_RV + h * 128, tid);
        if (tid < 128) { a.DECA[(size_t)u * 128 + tid] = exp2f(128.0f * lg2); a.DECB[(size_t)u * 128 + tid] = gamma; }
    } else {
        float cum[32], kk[32];
        hg_gates(zt + (size_t)j * EV_IN + Z_GF + h * 128, a.lb + h * 128, tid, scr, cum, kk);
#pragma unroll
        for (int q = 0; q < 4; ++q) { float o[8];
#pragma unroll
            for (int e = 0; e < 8; ++e) o[e] = kk[8 * q + e] * __expf(scr[128 + 32 * cg + 8 * q + e] - cum[8 * q + e]);
            st_chunk8(lds + MX_K, j, 32 * cg + 8 * q, o); }
        copy_tile(lds + MX_V, zt + Z_GI + h * 128, tid);
        if (tid < 128) { a.DECA[(size_t)u * 128 + tid] = __expf(scr[128 + tid]); a.DECB[(size_t)u * 128 + tid] = __expf(scr[tid]); }
    }
    __syncthreads();
    const int lbn = tr_lane_base_nat(lane, MX_STRIDE); const int kbk = w >> 1, vb0 = 2 * (w & 1);
    f32x16 acc[2];
#pragma unroll
    for (int t = 0; t < 2; ++t)
#pragma unroll
        for (int i = 0; i < 16; ++i) acc[t][i] = 0.f;
#pragma unroll
    for (int s = 0; s < 8; ++s) { const bf16x8 av = tr_frag_nat(lds + MX_K, MX_STRIDE, lbn, 16 * s, 32 * kbk);
#pragma unroll
        for (int t = 0; t < 2; ++t) { const bf16x8 bv = tr_frag_nat(lds + MX_V, MX_STRIDE, lbn, 16 * s, 32 * (vb0 + t)); acc[t] = MFMA32(av, bv, acc[t]); } }
    bf16* sb = a.SBUF + (size_t)u * 16384;
#pragma unroll
    for (int t = 0; t < 2; ++t)
#pragma unroll
        for (int g4 = 0; g4 < 4; ++g4) { v2u wv; wv.x = cvtpk(acc[t][4 * g4], acc[t][4 * g4 + 1]); wv.y = cvtpk(acc[t][4 * g4 + 2], acc[t][4 * g4 + 3]);
            *(v2u*)(sb + (size_t)(32 * (vb0 + t) + r) * 128 + 32 * kbk + 8 * g4 + 4 * h2) = wv; }
    __syncthreads();
}

__device__ __forceinline__ void mix_scan(const MixArgs& a, int gtid, int nthreads, bool dry = false) {
    for (int e = gtid; e < 32 * 4096; e += nthreads) { const int g = e >> 12, el = e & 4095, dk4 = el & 31;
        bf16* sp = a.SBUF + (size_t)(g * 32) * 16384 + (size_t)el * 4; const float* da = a.DECA + (size_t)(g * 32) * 128 + 4 * dk4; const float* db = a.DECB + (size_t)(g * 32) * 128 + 4 * dk4;
        f32x4 S = (f32x4){0.f, 0.f, 0.f, 0.f};
#pragma unroll 8
        for (int n = 0; n < 32; ++n) { const v2u kv = *(const v2u*)(sp + (size_t)n * 16384); const f32x4 A = *(const f32x4*)(da + n * 128), Bv = *(const f32x4*)(db + n * 128);
            const f32x4 so = S * Bv; v2u wv; wv.x = cvtpk(so[0], so[1]); wv.y = cvtpk(so[2], so[3]); if (!dry) *(v2u*)(sp + (size_t)n * 16384) = wv;
            S[0] = A[0] * S[0] + __uint_as_float(kv.x << 16); S[1] = A[1] * S[1] + __uint_as_float(kv.x & 0xffff0000u); S[2] = A[2] * S[2] + __uint_as_float(kv.y << 16); S[3] = A[3] * S[3] + __uint_as_float(kv.y & 0xffff0000u); }
    }
}

__device__ __forceinline__ void mixC_unit(LAS char* lds, const MixArgs& a, int u, int tid, bool dry = false) {
    const int lane = tid & 63, w = __builtin_amdgcn_readfirstlane(tid >> 6), r = lane & 31, h2 = lane >> 5;
    const int g = u >> 5, n = u & 31, mixer = g >> 4, b = (g >> 2) & 3, h = g & 3;
    const int j = tid & 127, cg = tid >> 7;
    bf16* zt = a.Z + (size_t)(b * SEQ + 128 * n) * EV_IN;
    LAS float* scr = (LAS float*)(lds + MX_SCR);
    if (mixer == 0) {
        const float gamma = 1.0f - exp2f(-5.0f - (float)h), lg2 = log2f(gamma);
        float sn[16], cs[16];
#pragma unroll
        for (int e = 0; e < 16; ++e) { const float inv = exp2f(-(float)(16 * cg + e) * (13.287712379549449f / 64.0f)); rope_sincos((float)(128 * n + j) * inv, sn[e], cs[e]); }
        ret_prep_tile(lds + MX_Q, zt + (size_t)j * EV_IN + Z_RQ + h * 128, j, cg, sn, cs, exp2f((float)j * lg2));
        ret_prep_tile(lds + MX_K, zt + (size_t)j * EV_IN + Z_RK + h * 128, j, cg, sn, cs, 0.08838834764831845f * exp2f(-(float)j * lg2));
        copy_tile(lds + MX_V, zt + Z_RV + h * 128, tid);
    } else {
        float cum[32], kk[32];
        hg_gates(zt + (size_t)j * EV_IN + Z_GF + h * 128, a.lb + h * 128, tid, scr, cum, kk);
#pragma unroll
        for (int q = 0; q < 4; ++q) { float qv[8], oq[8], ok[8]; unpack8(*(const v4u*)(zt + (size_t)j * EV_IN + Z_GQ + h * 128 + 32 * cg + 8 * q), qv);
#pragma unroll
            for (int e = 0; e < 8; ++e) { const float d = cum[8 * q + e] - scr[32 * cg + 8 * q + e]; oq[e] = qv[e] * __expf(d); ok[e] = kk[8 * q + e] * __expf(-d); }
            st_chunk8(lds + MX_Q, j, 32 * cg + 8 * q, oq); st_chunk8(lds + MX_K, j, 32 * cg + 8 * q, ok); }
        copy_tile(lds + MX_V, zt + Z_GI + h * 128, tid);
    }
    __syncthreads();
    const int vb = w >> 1; const int lbp = tr_lane_base(lane, MX_STRIDE);
    const bf16* sb = a.SBUF + (size_t)u * 16384 + (size_t)(32 * vb + r) * 128 + 8 * h2;
    bf16x8 sf[8];
#pragma unroll
    for (int s = 0; s < 8; ++s) sf[s] = *(const bf16x8*)(sb + 16 * s);
    f32x16 o[2]; float s1[2], s2[2];
#pragma unroll
    for (int t = 0; t < 2; ++t) {
        const int ib = (w & 1) ? (1 + t) : (3 * t);
        bf16x8 qf[8];
#pragma unroll
        for (int s = 0; s < 8; ++s) qf[s] = *(const LAS bf16x8*)(lds + MX_Q + (32 * ib + r) * MX_STRIDE + h2 * 16 + s * 32);
#pragma unroll
        for (int i = 0; i < 16; ++i) o[t][i] = 0.f;
#pragma unroll
        for (int s = 0; s < 8; ++s) o[t] = MFMA32(sf[s], qf[s], o[t]);
        for (int jb = 0; jb <= ib; ++jb) {
            f32x16 acc;
#pragma unroll
            for (int i = 0; i < 16; ++i) acc[i] = 0.f;
            const LAS char* kp = lds + MX_K + (32 * jb + r) * MX_STRIDE + h2 * 16;
#pragma unroll
            for (int s = 0; s < 8; ++s) { const bf16x8 av = *(const LAS bf16x8*)(kp + s * 32); acc = MFMA32(av, qf[s], acc); }
            if (jb == ib) {
#pragma unroll
                for (int i = 0; i < 16; ++i) { const int c = (i & 3) + 8 * (i >> 2) + 4 * h2; if (c > r) acc[i] = 0.f; } }
            const bf16x8 p0 = pack8(acc[0], acc[1], acc[2], acc[3], acc[4], acc[5], acc[6], acc[7]), p1 = pack8(acc[8], acc[9], acc[10], acc[11], acc[12], acc[13], acc[14], acc[15]);
            const bf16x8 v0 = tr_frag_perm(lds + MX_V, MX_STRIDE, lbp, 32 * jb, 32 * vb), v1 = tr_frag_perm(lds + MX_V, MX_STRIDE, lbp, 32 * jb + 16, 32 * vb);
            o[t] = MFMA32(v0, p0, o[t]); o[t] = MFMA32(v1, p1, o[t]);
        }
        float a1 = 0.f, a2 = 0.f;
#pragma unroll
        for (int i = 0; i < 16; ++i) { a1 += o[t][i]; a2 += o[t][i] * o[t][i]; }
        a1 += __shfl_xor(a1, 32); a2 += __shfl_xor(a2, 32); s1[t] = a1; s2[t] = a2;
        if (h2 == 0) { scr[256 + (vb * 128 + 32 * ib + r) * 2] = a1; scr[256 + (vb * 128 + 32 * ib + r) * 2 + 1] = a2; }
    }
    __syncthreads();
    const float* gn = (mixer == 0 ? a.ret_g : a.hg_g) + h * 128 + 32 * vb + 4 * h2;
#pragma unroll
    for (int t = 0; t < 2; ++t) {
        const int ib = (w & 1) ? (1 + t) : (3 * t); const int tok = 32 * ib + r;
        float t1 = 0.f, t2 = 0.f;
#pragma unroll
        for (int v = 0; v < 4; ++v) { t1 += scr[256 + (v * 128 + tok) * 2]; t2 += scr[256 + (v * 128 + tok) * 2 + 1]; }
        float mu = 0.f, rstd;
        if (mixer == 0) { mu = t1 * (1.0f / 128.0f); rstd = 1.0f / sqrtf(fmaxf(t2 * (1.0f / 128.0f) - mu * mu, 0.f) + EPS); } else rstd = 1.0f / sqrtf(t2 * (1.0f / 128.0f) + EPS);
        bf16* zr = zt + (size_t)tok * EV_IN;
        const bf16* gp = zr + (mixer == 0 ? Z_RG : Z_GG) + h * 128 + 32 * vb + 4 * h2; bf16* yp = zr + (mixer == 0 ? Z_RQ : Z_GQ) + h * 128 + 32 * vb + 4 * h2;
#pragma unroll
        for (int g4 = 0; g4 < 4; ++g4) { const v2u gw = *(const v2u*)(gp + 8 * g4); const f32x4 gv = *(const f32x4*)(gn + 8 * g4);
            const float ga[4] = {__uint_as_float(gw.x << 16), __uint_as_float(gw.x & 0xffff0000u), __uint_as_float(gw.y << 16), __uint_as_float(gw.y & 0xffff0000u)}; float y[4];
#pragma unroll
            for (int e = 0; e < 4; ++e) { y[e] = (o[t][4 * g4 + e] - mu) * rstd * gv[e] * (ga[e] / (1.0f + __expf(-ga[e]))); }
            v2u wv; wv.x = cvtpk(y[0], y[1]); wv.y = cvtpk(y[2], y[3]); if (!dry) *(v2u*)(yp + 8 * g4) = wv; }
    }
    __syncthreads();
}


__device__ __forceinline__ float gelu_tanh(float x) { const float u = 0.7978845608028654f * (x + 0.044715f * x * x * x); const float t = 1.0f - 2.0f / (1.0f + __expf(2.0f * u)); return 0.5f * x * (1.0f + t); }
__device__ __forceinline__ void ffn_ew(const bf16* GU, const float* cw, const float* cb, bf16* H, int rows, int gtid, int nthreads) {
    for (int idx = gtid; idx < rows * (DFF / 8); idx += nthreads) {
        const int row = idx / (DFF / 8), c0 = (idx % (DFF / 8)) * 8, t = row % SEQ;
        float g0[8], g1[8], g2[8], u[8];
        unpack8(*(const v4u*)(GU + (size_t)row * (2 * DFF) + c0), g2); unpack8(*(const v4u*)(GU + (size_t)row * (2 * DFF) + DFF + c0), u);
        if (t >= 1) unpack8(*(const v4u*)(GU + (size_t)(row - 1) * (2 * DFF) + c0), g1); else { for (int i = 0; i < 8; ++i) g1[i] = 0.f; }
        if (t >= 2) unpack8(*(const v4u*)(GU + (size_t)(row - 2) * (2 * DFF) + c0), g0); else { for (int i = 0; i < 8; ++i) g0[i] = 0.f; }
        float r[8];
#pragma unroll
        for (int i = 0; i < 8; ++i) { const float y = cw[c0 + i] * g0[i] + cw[DFF + c0 + i] * g1[i] + cw[2 * DFF + c0 + i] * g2[i] + cb[c0 + i]; r[i] = gelu_tanh(y) * u[i]; }
        v4u o; o.x = cvtpk(r[0], r[1]); o.y = cvtpk(r[2], r[3]); o.z = cvtpk(r[4], r[5]); o.w = cvtpk(r[6], r[7]);
        *(v4u*)(H + (size_t)row * DFF + c0) = o;
    }
}

constexpr int LDS_BYTES = 147456;
constexpr int LDSCTL_OFF = LDS_BYTES - 512;
constexpr int CW_BAR = 4096;
constexpr size_t CTL_ZERO_BYTES = 1 * MiB;
#define XB_TMO      128
#define XB_XCNT(j)  (256  + 64 * (j))
#define XB_XSUB(j)  (1280 + 64 * (j))
#define XB_XGEN(j)  (2304 + 64 * (j))
#define XB_TOP      3328
#define XB_TOPGEN   3392
#define XCD_BAR_WORDS 3456
#define XB_SPIN_CAP (1u << 18)

__device__ __forceinline__ unsigned xb_ld(unsigned* p)              { return __hip_atomic_load(p, __ATOMIC_RELAXED, __HIP_MEMORY_SCOPE_AGENT); }
__device__ __forceinline__ unsigned xb_add(unsigned* p, unsigned v) { return __hip_atomic_fetch_add(p, v, __ATOMIC_RELAXED, __HIP_MEMORY_SCOPE_AGENT); }
__device__ __forceinline__ unsigned xb_xcc_id() { return (unsigned)__builtin_amdgcn_s_getreg((3 << 11) | 20) & 0xFu; }
#define XB_SPIN(cond, bar) do { unsigned _sp = 0; while (cond) { __builtin_amdgcn_s_sleep(1); \
    if ((++_sp & 255u) == 0u) { if (xb_ld(&(bar)[XB_TMO])) break; if (_sp > XB_SPIN_CAP) { atomicAdd(&(bar)[XB_TMO], 1u); break; } } } } while (0)

struct XcdBarrier {
    unsigned* bar; unsigned x;
    volatile LAS unsigned* st;
};

__device__ __forceinline__ XcdBarrier xcd_barrier_post(unsigned* bar, volatile LAS unsigned* st) {
    XcdBarrier b; b.bar = bar; b.x = xb_xcc_id(); b.st = st;
    if (threadIdx.x == 0) (void)xb_add(&bar[XB_XCNT(b.x)], 1u);
    return b;
}
__device__ __forceinline__ void xcd_barrier_complete(unsigned* bar, unsigned x, unsigned& nloc, unsigned& nx) {
    const unsigned G = gridDim.x * gridDim.y * gridDim.z;
    unsigned sum, cnt, mine, sp = 0u;
    for (;;) {
        sum = 0u; cnt = 0u; mine = 0u;
#pragma unroll
        for (unsigned j = 0; j < 16; ++j) { const unsigned c = xb_ld(&bar[XB_XCNT(j)]); sum += c; cnt += (c > 0u) ? 1u : 0u; mine = (j == x) ? c : mine; }
        if (sum == G) break;
        __builtin_amdgcn_s_sleep(1);
        if ((++sp & 255u) == 0u) { if (xb_ld(&bar[XB_TMO])) break; if (sp > XB_SPIN_CAP) { atomicAdd(&bar[XB_TMO], 1u); break; } }
    }
    nloc = mine > 0u ? mine : 1u; nx = cnt > 0u ? cnt : 1u;
}

__device__ __forceinline__ void xcd_barrier(const XcdBarrier& b) {
    asm volatile("s_waitcnt vmcnt(0)" ::: "memory");
    __syncthreads();
    if (threadIdx.x == 0) {
        unsigned* bar = b.bar;
        __builtin_amdgcn_s_waitcnt(0);
        unsigned nloc = b.st[0], nx = b.st[1];
        if (nloc == 0u) { xcd_barrier_complete(bar, b.x, nloc, nx); b.st[0] = nloc; b.st[1] = nx; }
        const unsigned old = xb_add(&bar[XB_XSUB(b.x)], 1u);
        const unsigned gen = old / nloc;
        if (old + 1u == (gen + 1u) * nloc) {
            __builtin_amdgcn_fence(__ATOMIC_RELEASE, "agent");
            asm volatile("s_waitcnt vmcnt(0)" ::: "memory");
            const unsigned og = xb_add(&bar[XB_TOP], 1u);
            const unsigned tg = og / nx;
            if (og + 1u == (tg + 1u) * nx) xb_add(&bar[XB_TOPGEN], 1u);
            else XB_SPIN(xb_ld(&bar[XB_TOPGEN]) == tg, bar);
            __builtin_amdgcn_fence(__ATOMIC_ACQUIRE, "agent");
            xb_add(&bar[XB_XGEN(b.x)], 1u);
            asm volatile("s_waitcnt vmcnt(0)" ::: "memory");
        } else {
            XB_SPIN(xb_ld(&bar[XB_XGEN(b.x)]) == gen, bar);
            __builtin_amdgcn_fence(__ATOMIC_ACQUIRE, "agent");
            asm volatile("s_waitcnt vmcnt(0)" ::: "memory");
        }
    }
    __syncthreads();
}


struct FwdArgs { const float* in[25]; float* out; unsigned char* ws; int ph_lo, ph_hi, li, pad; };
__global__ void __launch_bounds__(512, 2) fwd(FwdArgs a) {
    extern __shared__ __attribute__((aligned(16))) unsigned char lds_raw[];
    LAS unsigned char* lds = (LAS unsigned char*)lds_raw;
    const int tid = threadIdx.x, lane = tid & 63, wave = __builtin_amdgcn_readfirstlane(tid >> 6);
    const int G = gridDim.x, bx = blockIdx.x;
    volatile LAS unsigned* MISC = (volatile LAS unsigned*)(lds + LDSCTL_OFF);
    if (tid < 64) MISC[tid] = 0u;
    __syncthreads();
    unsigned char* ws = a.ws; float* out = a.out;
    XcdBarrier bar = xcd_barrier_post((unsigned*)(ws + WS_CTL) + CW_BAR + a.li * XCD_BAR_WORDS, MISC + 8);
    int ph = 0; const int lo = a.ph_lo, hi = a.ph_hi;
#define PH_ON true) for (int rp_ = 0, nr_ = (ph >= lo && ph < hi) ? 1 + ((a.pad >> ph) & 1) : 0; rp_ < nr_; ++rp_, __syncthreads()
#define TID_L ({ int t_ = tid; asm volatile("" : "+v"(t_)); t_; })
#define PH_END do { if (ph >= lo && ph + 1 < hi) xcd_barrier(bar); ++ph; } while (0)
    bf16* XB = (bf16*)(ws + WS_XB); float* SSQP = (float*)(ws + WS_SSQP); bf16* ACT = (bf16*)(ws + WS_ACT);

    if (PH_ON) { ProArgs pa;
#pragma unroll
        for (int i = 0; i < 25; ++i) pa.in[i] = a.in[i];
        pa.ws = ws; pa.layer_mask = 3; pa.ffn_mode = 2;
        { const int t_ = TID_L; prologue_body(pa, bx * 8 + (t_ >> 6), G * 8, t_ & 63, (LAS float*)lds + (t_ >> 6) * 64 * 65); } }
    PH_END;

    for (int l = 0; l < 2; ++l) {
        if (PH_ON) {
            { pg8::Gemm g{XB, (const bf16*)(ws + (l ? WS_ODIN : WS_EVIN)), M, l ? OD_IN : EV_IN, D, D}; pg8::EpiBf16S E{ACT, SSQP, l ? OD_IN : EV_IN, M, EPS, 0};
              pg8::StaticOrder S; S.init(g.M, g.N, G, bx); pg8::gemm_phase<pg8::EpiBf16S, pg8::StaticOrder, true, true>(lds, g, S, E); }
        }
        PH_END;
        const bf16* mixo; int mixo_ld;
        if (l == 0) {
            MixArgs ma{ACT, (const float*)(ws + WS_LB), a.in[4], a.in[5], (bf16*)out, (float*)(ws + WS_DECA), (float*)(ws + WS_DECB)};
            if (PH_ON) { for (int u = bx; u < 1024; u += G) mixA_unit((LAS char*)lds, ma, u, TID_L); }
            PH_END;
            if (PH_ON) {
                if (bx < 64 && G > 64) { const int lm = bx >> 5;
                    pg8::Gemm g{(const bf16*)(ws + (lm ? WS_MEMH1 : WS_MEMH0)), (const bf16*)(ws + (lm ? WS_XKV1 : WS_XKV0)), MM, 2 * D, D, D}; pg8::EpiBf16S E{(bf16*)(ws + (lm ? WS_MKV1 : WS_MKV0)), nullptr, 2 * D, M, EPS, 0};
                    pg8::StaticOrder S; S.init(g.M, g.N, G, bx & 31); pg8::gemm_phase<pg8::EpiBf16S, pg8::StaticOrder, true, true>(lds, g, S, E); }
                else mix_scan(ma, (bx - 64) * 512 + TID_L, (G - 64) * 512, rp_ + 1 < nr_);
            }
            PH_END;
            if (PH_ON) { for (int u = bx; u < 1024; u += G) mixC_unit((LAS char*)lds, ma, u, TID_L, rp_ + 1 < nr_); }
            PH_END;
            mixo = ACT; mixo_ld = EV_IN;
        } else {
            bf16* O = (bf16*)(ws + WS_ACT + 96 * MiB);
            DaArgs da; da.QKV = ACT; da.biasT = (const float*)(ws + WS_BIAST); da.gkq = (const float*)(ws + WS_GOD); da.N0 = (bf16*)(ws + WS_N2); da.DEN0 = (float*)(ws + WS_DEN23);
            da.N1 = (const bf16*)(ws + WS_N2); da.DEN1 = (const float*)(ws + WS_DEN23); da.N2 = (const bf16*)(ws + WS_N3); da.DEN2 = (const float*)(ws + WS_DEN23) + (size_t)M * 8; da.O = O; da.br0 = 1; da.nbr = 2; da.mode = 0; da.pad = 0;
            if (PH_ON) dattn_phase<0>((LAS char*)lds, da, bx, G, TID_L);
            PH_END;
            if (PH_ON) dattn_phase<1>((LAS char*)lds, da, bx, G, TID_L);
            PH_END;
            mixo = O; mixo_ld = D;
        }
        if (PH_ON) { pg8::Gemm g{mixo, (const bf16*)(ws + (l ? WS_ODOUT : WS_EVOUT)), M, D, D, mixo_ld}; pg8::EpiResid E{l ? (const float*)out : a.in[0], out, XB, SSQP, D, M};
            pg8::StaticOrder S; S.init(g.M, g.N, G, bx); pg8::gemm_phase<pg8::EpiResid, pg8::StaticOrder, false, true>(lds, g, S, E); }
        PH_END;
        { bf16* Q = ACT; bf16* O = (bf16*)(ws + WS_ACT + 32 * MiB);
          if (PH_ON) { pg8::Gemm g{XB, (const bf16*)(ws + (l ? WS_XQ1 : WS_XQ0)), M, D, D, D}; pg8::EpiBf16S E{Q, SSQP, D, M, EPS, 0};
              pg8::StaticOrder S; S.init(g.M, g.N, G, bx); pg8::gemm_phase<pg8::EpiBf16S, pg8::StaticOrder, true, true>(lds, g, S, E); }
          PH_END;
          if (PH_ON) { for (int u = bx; u < (M / 256) * 4; u += G) xattn_unit((LAS char*)lds, Q, (const bf16*)(ws + (l ? WS_MKV1 : WS_MKV0)), (const float*)(ws + WS_GXA) + l * 256, O, u, TID_L); }
          PH_END;
          if (PH_ON) { pg8::Gemm g{O, (const bf16*)(ws + (l ? WS_XO1 : WS_XO0)), M, D, D, D}; pg8::EpiResid E{out, out, XB, SSQP, D, M};
              pg8::StaticOrder S; S.init(g.M, g.N, G, bx); pg8::gemm_phase<pg8::EpiResid, pg8::StaticOrder, false, true>(lds, g, S, E); }
          PH_END; }
        { bf16* H = ACT;
          if (PH_ON) { pg8::Gemm g{XB, (const bf16*)(ws + (l ? WS_FIN1 : WS_FIN0)), 68 * 256, 2 * DFF, D, D}; pg8::EpiFfn E{H, SSQP, a.in[22] + (size_t)l * 3 * DFF, a.in[23] + (size_t)l * DFF, M, EPS};
              pg8::FfnOrder S; S.init(g.M, g.N, G, bx); pg8::gemm_phase<pg8::EpiFfn, pg8::FfnOrder, true, true>(lds, g, S, E); }
          PH_END;
          if (PH_ON) { pg8::Gemm g{H, (const bf16*)(ws + (l ? WS_FOUT1 : WS_FOUT0)), M, D, DFF, DFF}; pg8::EpiResid E{out, out, XB, SSQP, D, M};
              pg8::StaticOrder S; S.init(g.M, g.N, G, bx); pg8::gemm_phase<pg8::EpiResid, pg8::StaticOrder, false, true>(lds, g, S, E); }
          PH_END; }
    }
#undef PH_ON
#undef PH_END
#undef TID_L
}
constexpr int N_PHASES = 1 + 10 + 9;

#ifndef PROBE_MASK
#define PROBE_MASK 0
#endif
#ifndef MK_PER_PHASE
#define MK_PER_PHASE 0
#endif
extern "C" void kernel_launch(void* const* d_in, const int* in_sizes, int n_in, void* d_out, int out_size, void* d_ws, size_t ws_size, hipStream_t stream) {
    static int inited = 0;
    if (!inited) {
        if (n_in != 25 || out_size != M * D || ws_size < WS_END) { fprintf(stderr, "kernel_launch: unexpected shapes (n_in %d, out %d, ws %zu)\n", n_in, out_size, ws_size); inited = -1; return; }
        if (hipFuncSetAttribute((const void*)fwd, hipFuncAttributeMaxDynamicSharedMemorySize, LDS_BYTES) != hipSuccess) { fprintf(stderr, "kernel_launch: hipFuncSetAttribute failed\n"); inited = -1; return; }
        inited = 1;
    }
    if (inited < 0) return;
    if (hipMemsetAsync((char*)d_ws + WS_CTL, 0, CTL_ZERO_BYTES, stream) != hipSuccess) return;
    FwdArgs fa{}; for (int i = 0; i < 25; ++i) fa.in[i] = (const float*)d_in[i]; fa.out = (float*)d_out; fa.ws = (unsigned char*)d_ws; fa.pad = PROBE_MASK;
#if MK_PER_PHASE
    for (int p = 0; p < N_PHASES; ++p) { fa.ph_lo = p; fa.ph_hi = p + 1; fa.li = 0; hipLaunchKernelGGL(fwd, dim3(256), dim3(512), LDS_BYTES, stream, fa); }
#else
    fa.ph_lo = 0; fa.ph_hi = N_PHASES; fa.li = 0; hipLaunchKernelGGL(fwd, dim3(256), dim3(512), LDS_BYTES, stream, fa);
#endif
}
```

```cpp
#include <hip/hip_runtime.h>
#include <cstdio>
#include <cstdint>
namespace pg8 {
#define PG8_LAS __attribute__((address_space(3)))
typedef unsigned short bf16_t;
typedef short bf16x8 __attribute__((ext_vector_type(8)));
typedef float f32x4 __attribute__((ext_vector_type(4)));
typedef unsigned u32x4 __attribute__((ext_vector_type(4)));
constexpr int BM = 256, BK = 64, HALF = 128, HTB = HALF * BK * 2  , STAGE_BYTES = 8 * HTB, NXCD = 8, WGM = 8;
constexpr int SSQ_LDS = STAGE_BYTES + 4096, CW_LDS = STAGE_BYTES + 8192;

__host__ __device__ __forceinline__ int lds_byte(int r, int c) { const int st = (r >> 4) * 2 + (c >> 5), rr = r & 15, cc = c & 31, ob = rr * 64 + cc * 2; return st * 1024 + (ob ^ (((ob >> 9) & 1) << 5)); }
__host__ __device__ __forceinline__ void stage_rc(int b, int& R, int& C) { const int st = b / 1024, sb = b % 1024, swz = sb ^ (((sb >> 9) & 1) << 5); R = (st >> 1) * 16 + swz / 64; C = (st & 1) * 32 + (swz % 64) / 2; }
__host__ __device__ __forceinline__ int perm32(int rho) { const int n = rho >> 4, i = rho & 15; return 8 * (i >> 2) + 4 * n + (i & 3); }

struct Unit { int pm, pn; };
struct Gemm { const bf16_t* A; const bf16_t* Bt; int M, N, K, lda; };

struct StaticOrder {
    int nM, nN, nwg, G, c;
    __host__ __device__ void init(int M, int N, int G_, int c_) { nM = M / BM; nN = N / BM; nwg = nM * nN; G = G_; c = c_; }
    __host__ __device__ bool next(int i, Unit& u) const {
        const long L = (long)i * G + c; if (L >= nwg) return false;
        int wgid = (int)L; { const int q = nwg / NXCD, r = nwg % NXCD, xcd = wgid % NXCD, off = wgid / NXCD; wgid = (xcd < r ? xcd * (q + 1) : r * (q + 1) + (xcd - r) * q) + off; }
        const int nig = WGM * nN, gid = wgid / nig, fm = gid * WGM, gsz = (nM - fm) < WGM ? (nM - fm) : WGM;
        u.pm = fm + ((wgid % nig) % gsz); u.pn = (wgid % nig) / gsz; return true;
    }
    __device__ __forceinline__ void a_ready(const Unit&) const {}
    __device__ __forceinline__ void done(const Unit&) const {}
    __device__ __forceinline__ int arow(const Unit& u) const { return u.pm * BM; }
};
struct FfnOrder : StaticOrder {
    __device__ __forceinline__ int arow(const Unit& u) const { return (u.pm / 17) * 4096 + 254 * (u.pm % 17) - 2; }
};

__device__ __forceinline__ unsigned cvt_pk_bf16(float lo, float hi) { unsigned r; asm volatile("v_cvt_pk_bf16_f32 %0, %1, %2" : "=v"(r) : "v"(lo), "v"(hi)); return r; }
typedef float f32x2 __attribute__((ext_vector_type(2)));
struct EpiBf16S {
    static constexpr bool PERM = true, AFTER_DRAIN = false;
    bf16_t* O; const float* ssqp; int ldc; int Mtot; float eps; int pad;
    __device__ __forceinline__ void preload(PG8_LAS unsigned char* lds, const Unit& u, int wr, int wc, int lane) const {
        if (!ssqp) return;
#pragma unroll
        for (int ai = 0; ai < 2; ++ai) __builtin_amdgcn_global_load_lds((const unsigned*)(ssqp + (size_t)wc * Mtot + u.pm * BM + ai * HALF + wr * 64 + lane), (PG8_LAS unsigned*)(lds + SSQ_LDS + (((wr * 2 + ai) * 4 + wc) * 64) * 4), 4, 0, 0);
    }
    __device__ __forceinline__ void preload_unit(PG8_LAS unsigned char*, const Unit&, int, int, int) const {}
    __device__ __forceinline__ void operator()(f32x4 (&acc)[2][2][4][2], const Unit& u, int wr, int wc, int fr, int fq, PG8_LAS unsigned char* lds) const {
        const int row0 = u.pm * BM + wr * 64 + fr; const int col0 = u.pn * BM + wc * 32 + 8 * fq;
        const PG8_LAS float* sl = (const PG8_LAS float*)(lds + SSQ_LDS);
#pragma unroll
        for (int ai = 0; ai < 2; ++ai)
#pragma unroll
            for (int m = 0; m < 4; ++m) { const int row = row0 + ai * HALF + m * 16; float rs = 1.f;
                if (ssqp) { const PG8_LAS float* sp = sl + ((wr * 2 + ai) * 4) * 64 + m * 16 + fr; const float s = (sp[0] + sp[64]) + (sp[128] + sp[192]); rs = 1.0f / sqrtf(s * (1.0f / 1024.0f) + eps); }
                bf16_t* rowp = O + (size_t)row * ldc + col0;
#pragma unroll
                for (int bj = 0; bj < 2; ++bj) { const f32x4 v0 = acc[ai][bj][m][0] * rs, v1 = acc[ai][bj][m][1] * rs;
                    u32x4 w; w.x = cvt_pk_bf16(v0[0], v0[1]); w.y = cvt_pk_bf16(v0[2], v0[3]); w.z = cvt_pk_bf16(v1[0], v1[1]); w.w = cvt_pk_bf16(v1[2], v1[3]);
                    *(u32x4*)(rowp + bj * HALF) = w; } }
    }
};

__device__ __forceinline__ float gelu_tanh_f(float x) { const float u = 0.7978845608028654f * (x + 0.044715f * x * x * x); const float t = 1.0f - 2.0f / (1.0f + __expf(2.0f * u)); return 0.5f * x * (1.0f + t); }
struct EpiFfn {
    static constexpr bool PERM = true, AFTER_DRAIN = false;
    bf16_t* H; const float* ssqp; const float* cw; const float* cb; int Mtot; float eps;
    __device__ __forceinline__ void preload(PG8_LAS unsigned char* lds, const Unit& u, int wr, int wc, int lane) const {
        const int rowb = (u.pm / 17) * 4096 + 254 * (u.pm % 17) - 2;
#pragma unroll
        for (int ai = 0; ai < 2; ++ai) { const int row = rowb + ai * HALF + wr * 64 + lane; const int rc = row < 0 ? 0 : (row >= Mtot ? Mtot - 1 : row);
            __builtin_amdgcn_global_load_lds((const unsigned*)(ssqp + (size_t)wc * Mtot + rc), (PG8_LAS unsigned*)(lds + SSQ_LDS + (((wr * 2 + ai) * 4 + wc) * 64) * 4), 4, 0, 0); }
    }
    __device__ __forceinline__ void preload_unit(PG8_LAS unsigned char* lds, const Unit& u, int wr, int wc, int lane) const {
        const float* src = (wc < 3 ? cw + (size_t)wc * 2816 : cb) + u.pn * 128 + 64 * wr + lane;
        __builtin_amdgcn_global_load_lds((const unsigned*)src, (PG8_LAS unsigned*)(lds + CW_LDS + (wc * 128 + 64 * wr) * 4), 4, 0, 0);
    }
    __device__ __forceinline__ void operator()(f32x4 (&acc)[2][2][4][2], const Unit& u, int wr, int wc, int fr, int fq, PG8_LAS unsigned char* lds) const {
        constexpr int DFF_ = 2816;
        const int b = u.pm / 17, t = u.pm % 17, pos0 = 254 * t - 2, rowb = b * 4096 + pos0;
        const int colh = u.pn * 128 + wc * 32 + 8 * fq, lane = fq * 16 + fr;
        PG8_LAS float* halo = (PG8_LAS float*)(lds + STAGE_BYTES);
#pragma unroll
        for (int ai = 0; ai < 2; ++ai)
#pragma unroll
            for (int m = 0; m < 4; ++m) { const int rl = ai * HALF + wr * 64 + m * 16 + fr; const PG8_LAS float* sp = (const PG8_LAS float*)(lds + SSQ_LDS) + ((wr * 2 + ai) * 4) * 64 + m * 16 + fr;
                const float sq = (sp[0] + sp[64]) + (sp[128] + sp[192]); const float rs = 1.0f / sqrtf(sq * (1.0f / 1024.0f) + eps); const bool pad = (pos0 + rl) < 0;
#pragma unroll
                for (int n = 0; n < 2; ++n) {
#pragma unroll
                    for (int e = 0; e < 4; ++e) { acc[ai][0][m][n][e] = pad ? 0.f : acc[ai][0][m][n][e] * rs; acc[ai][1][m][n][e] *= rs; } } }
#pragma unroll
        for (int ai = 0; ai < 2; ++ai) if (fr >= 14) { PG8_LAS float* hp = halo + ((((2 * ai + wr) * 4 + wc) * 4 + fq) * 2 + (fr - 14)) * 8;
            *(PG8_LAS f32x4*)hp = acc[ai][0][3][0]; *(PG8_LAS f32x4*)(hp + 4) = acc[ai][0][3][1]; }
        asm volatile("s_waitcnt lgkmcnt(0)" ::: "memory"); __builtin_amdgcn_s_barrier(); asm volatile("" ::: "memory");
        typedef unsigned u32x2e __attribute__((ext_vector_type(2)));
#define DPPF(x, ctrl) __builtin_bit_cast(float, __builtin_amdgcn_update_dpp(0, __builtin_bit_cast(int, (x)), (ctrl), 0xf, 0xf, true))
#pragma unroll
        for (int n = 0; n < 2; ++n) {
            const PG8_LAS float* cwl = (const PG8_LAS float*)(lds + CW_LDS) + wc * 32 + 8 * fq + 4 * n;
            const f32x4 w0 = *(const PG8_LAS f32x4*)cwl, w1 = *(const PG8_LAS f32x4*)(cwl + 128), w2 = *(const PG8_LAS f32x4*)(cwl + 256), bb = *(const PG8_LAS f32x4*)(cwl + 384);
#pragma unroll
            for (int ai = 0; ai < 2; ++ai) {
                const int blk = 2 * ai + wr; f32x4 R1p = (f32x4){0.f, 0.f, 0.f, 0.f}, R2p = (f32x4){0.f, 0.f, 0.f, 0.f};
                if (blk >= 1) { const PG8_LAS float* hp = halo + ((((blk - 1) * 4 + wc) * 4 + fq) * 2) * 8 + 4 * n; const f32x4 h62 = *(const PG8_LAS f32x4*)hp, h63 = *(const PG8_LAS f32x4*)(hp + 8);
                    const f32x4 z4 = (f32x4){0.f, 0.f, 0.f, 0.f}; R1p = fr == 0 ? h63 : z4; R2p = fr == 0 ? h62 : (fr == 1 ? h63 : z4); }
#pragma unroll
                for (int m = 0; m < 4; ++m) { const int rl = ai * HALF + wr * 64 + m * 16 + fr; const bool ok = (rl >= 2) && (pos0 + rl < 4096);
                    float hv[4];
#pragma unroll
                    for (int e = 0; e < 4; ++e) { const float v = acc[ai][0][m][n][e];
                        const float p1 = DPPF(v, 0x111) + R1p[e], p2 = DPPF(v, 0x112) + R2p[e]; R1p[e] = DPPF(v, 0x10F); R2p[e] = DPPF(v, 0x10E);
                        const float y = w0[e] * p2 + (w1[e] * p1 + (w2[e] * v + bb[e]));
                        const float tq = y * (-2.302208198f + -0.10294324f * (y * y));
                        const float sg = __builtin_amdgcn_rcpf(1.0f + __builtin_amdgcn_exp2f(tq));
                        hv[e] = (y * acc[ai][1][m][n][e]) * sg; }
                    if (ok) { u32x2e w; w.x = cvt_pk_bf16(hv[0], hv[1]); w.y = cvt_pk_bf16(hv[2], hv[3]); *(u32x2e*)(H + (size_t)(rowb + rl) * DFF_ + colh + 4 * n) = w; } }
            }
        }
#undef DPPF
        asm volatile("s_waitcnt lgkmcnt(0)" ::: "memory"); __builtin_amdgcn_s_barrier(); asm volatile("" ::: "memory");
    }
};
struct EpiResid {
    static constexpr bool PERM = false, AFTER_DRAIN = true;
    const float* base; float* out; bf16_t* xb; float* ssqp; int ldc; int Mtot;
    __device__ __forceinline__ void init(f32x4 (&acc)[2][2][4][2], const Unit& u, int wr, int wc, int fr, int fq) const {
        const int col0 = u.pn * BM + wc * 32 + 4 * fq;
#pragma unroll
        for (int ai = 0; ai < 2; ++ai)
#pragma unroll
            for (int m = 0; m < 4; ++m) { const size_t off = (size_t)(u.pm * BM + ai * HALF + wr * 64 + m * 16 + fr) * ldc + col0;
#pragma unroll
                for (int bj = 0; bj < 2; ++bj)
#pragma unroll
                    for (int n = 0; n < 2; ++n) {
                        if (base) acc[ai][bj][m][n] = *(const f32x4*)(base + off + bj * HALF + n * 16);
                        else { typedef unsigned u32x2i __attribute__((ext_vector_type(2))); const u32x2i w = *(const u32x2i*)(xb + off + bj * HALF + n * 16);
                            acc[ai][bj][m][n] = (f32x4){__uint_as_float(w.x << 16), __uint_as_float(w.x & 0xffff0000u), __uint_as_float(w.y << 16), __uint_as_float(w.y & 0xffff0000u)}; } } }
    }
    __device__ __forceinline__ void fused(f32x4 (&acc)[2][2][4][2], const Unit& u, int wr, int wc, int fr, int fq, PG8_LAS unsigned char* lds, int wid, int lane) const {
        typedef unsigned u32x2v __attribute__((ext_vector_type(2)));
        PG8_LAS float* P = (PG8_LAS float*)lds;
        const int col0 = u.pn * BM + wc * 32 + 4 * fq;
#pragma unroll
        for (int ai = 0; ai < 2; ++ai)
#pragma unroll
            for (int m = 0; m < 4; ++m) { const int r = ai * HALF + wr * 64 + m * 16 + fr; const size_t off = (size_t)(u.pm * BM + r) * ldc + col0; float s = 0.f;
#pragma unroll
                for (int bj = 0; bj < 2; ++bj)
#pragma unroll
                    for (int n = 0; n < 2; ++n) { const f32x4 o = acc[ai][bj][m][n];
                        if (out) *(f32x4*)(out + off + bj * HALF + n * 16) = o; u32x2v w; w.x = cvt_pk_bf16(o[0], o[1]); w.y = cvt_pk_bf16(o[2], o[3]); *(u32x2v*)(xb + off + bj * HALF + n * 16) = w;
                        s += (o[0] * o[0] + o[1] * o[1]) + (o[2] * o[2] + o[3] * o[3]); }
                s += __shfl_xor(s, 16); s += __shfl_xor(s, 32);
                if (fq == 0) P[r * 4 + wc] = s;
                if (m & 1) asm volatile("" ::: "memory"); }
        asm volatile("s_waitcnt lgkmcnt(0)" ::: "memory"); __builtin_amdgcn_s_barrier(); asm volatile("" ::: "memory");
        if (lane < 32) { const int row = wid * 32 + lane; ssqp[(size_t)u.pn * Mtot + u.pm * BM + row] = (P[row * 4 + 0] + P[row * 4 + 1]) + (P[row * 4 + 2] + P[row * 4 + 3]); }
        asm volatile("s_waitcnt lgkmcnt(0)" ::: "memory"); __builtin_amdgcn_s_barrier(); asm volatile("" ::: "memory");
    }
};

template <class Epi, class Sched, bool ALIGN_EPI = false, bool SP2 = false>
__device__ __forceinline__ void gemm_phase(PG8_LAS unsigned char* lds, const Gemm g, const Sched& S, const Epi& E, int tid_in) {
    int tid_l = tid_in; asm volatile("" : "+v"(tid_l));
    const int tid = tid_l, wid = __builtin_amdgcn_readfirstlane(tid >> 6), lane = tid & 63, wr = wid >> 2, wc = wid & 3, fr = lane & 15, fq = lane >> 4;
    const int K = g.K, nt = K / BK;
    unsigned voffA[2], voffB[2];
#pragma unroll
    for (int i = 0; i < 2; ++i) { int R, C; stage_rc(tid * 16 + i * 8192, R, C); const int Rb = Epi::PERM ? ((R & ~31) + perm32(R & 31)) : R;
        voffA[i] = (unsigned)(R * g.lda + C) * 2u; voffB[i] = (unsigned)(Rb * K + C) * 2u; }
    const size_t kstep = (size_t)(BK * 2);
    const size_t hstepA = (size_t)HALF * g.lda * 2, hstepB = (size_t)HALF * K * 2;
    const size_t tstepB = 2 * hstepB;
    const unsigned ldsw = (unsigned)wid * 1024u;
    const int aoff = lds_byte(wr * 64 + fr, fq * 8), boff = lds_byte(wc * 32 + fr, fq * 8);
#define PG8_SA(b, h) (((b) * 2 + (h)) * HTB)
#define PG8_SB(b, h) ((4 + (b) * 2 + (h)) * HTB)
#define PG8_STAGE(bufoff, gbase, voff) do { _Pragma("unroll") for (int _i = 0; _i < 2; ++_i) \
        __builtin_amdgcn_global_load_lds((const unsigned*)((const char*)(gbase) + (voff)[_i]), (PG8_LAS unsigned*)(lds + (bufoff) + ldsw + _i * 8192), 16, 0, 0); } while (0)
#define PG8_LDA(dst, b, h) do { _Pragma("unroll") for (int m = 0; m < 4; ++m) _Pragma("unroll") for (int k = 0; k < 2; ++k) dst[m][k] = *(const PG8_LAS bf16x8*)(lds + PG8_SA(b, h) + aoff + m * 2048 + k * 1024); } while (0)
#define PG8_LDB(dst, b, h) do { _Pragma("unroll") for (int n = 0; n < 2; ++n) _Pragma("unroll") for (int k = 0; k < 2; ++k) dst[n][k] = *(const PG8_LAS bf16x8*)(lds + PG8_SB(b, h) + boff + n * 2048 + k * 1024); } while (0)
#define PG8_MMA(ai, bj, At, Bt) do { __builtin_amdgcn_s_setprio(1); _Pragma("unroll") for (int m = 0; m < 4; ++m) _Pragma("unroll") for (int n = 0; n < 2; ++n) _Pragma("unroll") for (int k = 0; k < 2; ++k) \
        acc[ai][bj][m][n] = __builtin_amdgcn_mfma_f32_16x16x32_bf16(Bt[n][k], At[m][k], acc[ai][bj][m][n], 0, 0, 0); __builtin_amdgcn_s_setprio(0); } while (0)
#define PG8_WAIT_V(n) asm volatile("s_waitcnt vmcnt(" #n ")" ::: "memory")
#define PG8_WAIT_L(n) asm volatile("s_waitcnt lgkmcnt(" #n ")" ::: "memory")
#define PG8_BAR __builtin_amdgcn_s_barrier()
#define PG8_SCHED __builtin_amdgcn_sched_barrier(0)
    Unit cur, nxt; int ui = 0;
    if (!S.next(0, cur)) return;
    f32x4 acc[2][2][4][2];
#pragma unroll
    for (int a = 0; a < 2; ++a)
#pragma unroll
        for (int b = 0; b < 2; ++b)
#pragma unroll
            for (int m = 0; m < 4; ++m)
#pragma unroll
                for (int n = 0; n < 2; ++n) acc[a][b][m][n] = (f32x4){0.f, 0.f, 0.f, 0.f};
    if constexpr (Epi::AFTER_DRAIN) E.init(acc, cur, wr, wc, fr, fq);
    bf16x8 At[4][2], B0[2][2], B1[2][2];
    const char* cA = (const char*)g.A + (ptrdiff_t)S.arow(cur) * (ptrdiff_t)(g.lda * 2); const char* cB = (const char*)g.Bt + (size_t)cur.pn * tstepB;
    S.a_ready(cur);
    if constexpr (!Epi::AFTER_DRAIN) E.preload_unit(lds, cur, wr, wc, lane);
    if constexpr (SP2) {
        PG8_STAGE(PG8_SB(0, 0), cB, voffB); PG8_STAGE(PG8_SB(0, 1), cB + hstepB, voffB); PG8_STAGE(PG8_SA(0, 0), cA, voffA); PG8_STAGE(PG8_SA(0, 1), cA + hstepA, voffA);
        if (wr == 1) PG8_BAR;
        PG8_WAIT_V(2); PG8_BAR;
        PG8_STAGE(PG8_SB(1, 0), cB + kstep, voffB); PG8_STAGE(PG8_SA(1, 0), cA + kstep, voffA); PG8_STAGE(PG8_SB(1, 1), cB + hstepB + kstep, voffB);
        PG8_WAIT_V(6); PG8_BAR;
        if constexpr (Epi::AFTER_DRAIN) {
#pragma unroll
            for (int a_ = 0; a_ < 2; ++a_)
#pragma unroll
                for (int b_ = 0; b_ < 2; ++b_) asm volatile("" : "+v"(acc[a_][b_][0][0]), "+v"(acc[a_][b_][0][1]), "+v"(acc[a_][b_][1][0]), "+v"(acc[a_][b_][1][1]), "+v"(acc[a_][b_][2][0]), "+v"(acc[a_][b_][2][1]), "+v"(acc[a_][b_][3][0]), "+v"(acc[a_][b_][3][1]));
        }
    } else {
        PG8_STAGE(PG8_SB(0, 0), cB, voffB); PG8_STAGE(PG8_SA(0, 0), cA, voffA); PG8_STAGE(PG8_SB(0, 1), cB + hstepB, voffB); PG8_STAGE(PG8_SA(0, 1), cA + hstepA, voffA);
        if (wr == 1) PG8_BAR;
        PG8_WAIT_V(4); PG8_BAR;
        PG8_STAGE(PG8_SB(1, 0), cB + kstep, voffB); PG8_STAGE(PG8_SA(1, 0), cA + kstep, voffA); PG8_STAGE(PG8_SB(1, 1), cB + hstepB + kstep, voffB);
        PG8_WAIT_V(6); PG8_BAR;
    }
    for (;;) {
        const bool has_next = S.next(ui + 1, nxt);
        const char* nA = has_next ? (const char*)g.A + (ptrdiff_t)S.arow(nxt) * (ptrdiff_t)(g.lda * 2) : cA; const char* nB = has_next ? (const char*)g.Bt + (size_t)nxt.pn * tstepB : cB;
        for (int t = 0; t < nt; t += 2) {
            const bool last = (t == nt - 2);
            const char* a1 = cA + (size_t)(t + 1) * kstep;
            const char* a2 = last ? nA : cA + (size_t)(t + 2) * kstep; const char* b2 = last ? nB : cB + (size_t)(t + 2) * kstep;
            const char* a3 = a2 + kstep; const char* b3 = b2 + kstep;
            if (last && has_next) S.a_ready(nxt);
            if constexpr (!Epi::AFTER_DRAIN) { if (last) E.preload(lds, cur, wr, wc, lane); }
            if constexpr (SP2) {
            PG8_LDB(B0, 0, 0); PG8_LDB(B1, 0, 1); PG8_SCHED; PG8_LDA(At, 0, 0); PG8_STAGE(PG8_SA(1, 1), a1 + hstepA, voffA);
            PG8_WAIT_V(8); PG8_WAIT_L(0); PG8_BAR; PG8_MMA(0, 0, At, B0); PG8_MMA(0, 1, At, B1); PG8_BAR; PG8_SCHED;
            PG8_LDA(At, 0, 1); PG8_STAGE(PG8_SB(0, 0), b2, voffB); PG8_STAGE(PG8_SB(0, 1), b2 + hstepB, voffB); PG8_STAGE(PG8_SA(0, 0), a2, voffA);
            PG8_WAIT_V(8); PG8_WAIT_L(0); PG8_BAR; PG8_MMA(1, 0, At, B0); PG8_MMA(1, 1, At, B1); PG8_BAR; PG8_SCHED;
            PG8_LDB(B0, 1, 0); PG8_LDB(B1, 1, 1); PG8_SCHED; PG8_LDA(At, 1, 0); PG8_STAGE(PG8_SA(0, 1), a2 + hstepA, voffA);
            PG8_WAIT_V(8); PG8_WAIT_L(0); PG8_BAR; PG8_MMA(0, 0, At, B0); PG8_MMA(0, 1, At, B1); PG8_BAR; PG8_SCHED;
            PG8_LDA(At, 1, 1); PG8_STAGE(PG8_SB(1, 0), b3, voffB); PG8_STAGE(PG8_SB(1, 1), b3 + hstepB, voffB); PG8_STAGE(PG8_SA(1, 0), a3, voffA);
            PG8_WAIT_V(8); PG8_WAIT_L(0); PG8_BAR; PG8_MMA(1, 0, At, B0); PG8_MMA(1, 1, At, B1); PG8_BAR; PG8_SCHED;
            } else {
            PG8_LDB(B0, 0, 0); PG8_SCHED; PG8_LDA(At, 0, 0); PG8_STAGE(PG8_SA(1, 1), a1 + hstepA, voffA);
            PG8_WAIT_L(8); PG8_BAR; PG8_WAIT_L(0); PG8_MMA(0, 0, At, B0); PG8_BAR; PG8_SCHED;
            PG8_LDB(B1, 0, 1); PG8_STAGE(PG8_SB(0, 0), b2, voffB);
            PG8_BAR; PG8_WAIT_L(0); PG8_MMA(0, 1, At, B1); PG8_BAR;
            PG8_LDA(At, 0, 1); PG8_STAGE(PG8_SA(0, 0), a2, voffA);
            PG8_BAR; PG8_WAIT_L(0); PG8_MMA(1, 0, At, B0); PG8_BAR; PG8_SCHED;
            PG8_STAGE(PG8_SB(0, 1), b2 + hstepB, voffB);
            PG8_WAIT_V(6); PG8_BAR; PG8_MMA(1, 1, At, B1); PG8_BAR;
            PG8_LDB(B0, 1, 0); PG8_SCHED; PG8_LDA(At, 1, 0); PG8_STAGE(PG8_SA(0, 1), a2 + hstepA, voffA);
            PG8_WAIT_L(8); PG8_BAR; PG8_WAIT_L(0); PG8_MMA(0, 0, At, B0); PG8_BAR; PG8_SCHED;
            PG8_LDB(B1, 1, 1); PG8_STAGE(PG8_SB(1, 0), b3, voffB);
            PG8_BAR; PG8_WAIT_L(0); PG8_MMA(0, 1, At, B1); PG8_BAR;
            PG8_LDA(At, 1, 1); PG8_STAGE(PG8_SA(1, 0), a3, voffA);
            PG8_BAR; PG8_WAIT_L(0); PG8_MMA(1, 0, At, B0); PG8_BAR; PG8_SCHED;
            PG8_STAGE(PG8_SB(1, 1), b3 + hstepB, voffB);
            PG8_WAIT_V(6); PG8_BAR; PG8_MMA(1, 1, At, B1); PG8_BAR;
            }
        }
        if constexpr (ALIGN_EPI) { if (wr == 0) PG8_BAR; }
        if constexpr (!Epi::AFTER_DRAIN) { E(acc, cur, wr, wc, fr, fq, lds); S.done(cur); if (has_next) E.preload_unit(lds, nxt, wr, wc, lane); }
        if (!has_next) break;
#pragma unroll
        for (int a = 0; a < 2; ++a)
#pragma unroll
            for (int b = 0; b < 2; ++b)
#pragma unroll
                for (int m = 0; m < 4; ++m)
#pragma unroll
                    for (int n = 0; n < 2; ++n) acc[a][b][m][n] = (f32x4){0.f, 0.f, 0.f, 0.f};
        cur = nxt; cA = nA; cB = nB; ++ui;
        if constexpr (ALIGN_EPI) { if (wr == 1) PG8_BAR; }
    }
    PG8_WAIT_V(0);
    if constexpr (!ALIGN_EPI) { if (wr == 0) PG8_BAR; }
    PG8_BAR;
    if constexpr (Epi::AFTER_DRAIN) { E.fused(acc, cur, wr, wc, fr, fq, lds, wid, lane); S.done(cur); }
#undef PG8_SA
#undef PG8_SB
#undef PG8_STAGE
#undef PG8_LDA
#undef PG8_LDB
#undef PG8_MMA
#undef PG8_WAIT_V
#undef PG8_WAIT_L
#undef PG8_BAR
#undef PG8_SCHED
}
}


#define GAS __attribute__((address_space(1)))
#define LAS __attribute__((address_space(3)))
typedef unsigned short bf16;
typedef unsigned v4u __attribute__((ext_vector_type(4)));
typedef unsigned v2u __attribute__((ext_vector_type(2)));
typedef float f32x4 __attribute__((ext_vector_type(4)));
constexpr int BATCH = 4, SEQ = 4096, D = 1024, M = BATCH * SEQ, NMEM = 256, MM = BATCH * NMEM, DFF = 2816;
constexpr int EV_IN = 4096, OD_IN = 3072;
constexpr float EPS = 1e-6f;
constexpr int Z_RQ = 0, Z_GQ = 512, Z_RK = 1024, Z_RV = 1536, Z_RG = 2048, Z_GF = 2560, Z_GI = 3072, Z_GG = 3584;

constexpr size_t MiB = 1u << 20;
constexpr size_t WS_CTL = 0;
constexpr size_t WS_EVIN = 1 * MiB, WS_EVOUT = 9 * MiB, WS_XQ0 = 11 * MiB, WS_XKV0 = 13 * MiB, WS_XO0 = 17 * MiB, WS_FIN0 = 19 * MiB, WS_FOUT0 = 30 * MiB;
constexpr size_t WS_ODIN = 36 * MiB, WS_ODOUT = 42 * MiB, WS_XQ1 = 44 * MiB, WS_XKV1 = 46 * MiB, WS_XO1 = 50 * MiB, WS_FIN1 = 52 * MiB, WS_FOUT1 = 63 * MiB;
constexpr size_t WS_XB = 69 * MiB;
constexpr size_t WS_MKV0 = 101 * MiB, WS_MKV1 = 105 * MiB;
constexpr size_t WS_MEMH0 = 109 * MiB, WS_MEMH1 = 111 * MiB;
constexpr size_t WS_SSQP = 113 * MiB;
constexpr size_t WS_LB = 113 * MiB + 512 * 1024;
constexpr size_t WS_BIAST = 113 * MiB + 516 * 1024;
constexpr size_t WS_GXA = 113 * MiB + 600 * 1024, WS_GOD = 113 * MiB + 604 * 1024;
constexpr size_t WS_DEN23 = 114 * MiB;
constexpr size_t WS_N2 = 1 * MiB;
constexpr size_t WS_ACT = 115 * MiB;
constexpr size_t WS_DECA = 243 * MiB, WS_DECB = 243 * MiB + 512 * 1024;
constexpr size_t WS_END = 256 * MiB;

__device__ __forceinline__ float bf2f(bf16 u) { return __uint_as_float((unsigned)u << 16); }
__device__ __forceinline__ unsigned f2bf(float f) { unsigned u = __builtin_bit_cast(unsigned, f); return (u + 0x7fffu + ((u >> 16) & 1u)) >> 16; }
__device__ __forceinline__ unsigned pk2(float lo, float hi) { return f2bf(lo) | (f2bf(hi) << 16); }
__device__ __forceinline__ float wave_sum(float v) {
#pragma unroll
    for (int o = 1; o < 64; o <<= 1) v += __shfl_xor(v, o);
    return v;
}
__device__ __forceinline__ float wave_max(float v) {
#pragma unroll
    for (int o = 1; o < 64; o <<= 1) v = fmaxf(v, __shfl_xor(v, o));
    return v;
}
__device__ __forceinline__ void unpack8(const v4u w, float (&f)[8]) {
    f[0] = __uint_as_float(w.x << 16); f[1] = __uint_as_float(w.x & 0xffff0000u); f[2] = __uint_as_float(w.y << 16); f[3] = __uint_as_float(w.y & 0xffff0000u);
    f[4] = __uint_as_float(w.z << 16); f[5] = __uint_as_float(w.z & 0xffff0000u); f[6] = __uint_as_float(w.w << 16); f[7] = __uint_as_float(w.w & 0xffff0000u);
}
__device__ __forceinline__ void rope_sincos(float a, float& s, float& c) {
    const float n = rintf(a * 0.15915494309189535f);
    float r = fmaf(-n, 6.2831854820251465f, a); r = fmaf(-n, -1.7484555e-7f, r);
    const float rev = r * 0.15915494309189535f;
    s = __builtin_amdgcn_sinf(rev); c = __builtin_amdgcn_cosf(rev);
}

__device__ __forceinline__ int dst_row_map(int mode, int n0) {
    if (mode == 1) { const int seg = n0 >> 9, within = n0 & 511; const int dseg = (seg == 0) ? 0 : (seg == 4 ? 1 : (seg < 4 ? seg + 1 : seg)); return dseg * 512 + within; }
    if (mode == 2) { return n0 < DFF ? (n0 >> 7) * 256 + (n0 & 127) : ((n0 - DFF) >> 7) * 256 + 128 + ((n0 - DFF) & 127); }
    return n0;
}
__device__ __forceinline__ void transpose_item(const float* W, int K, int N, const float* g, bf16* WT, int mode, LAS float* scr, int item, int lane) {
    const int nblk = N / 64, kb = item / nblk, nb = item % nblk, k0 = 64 * kb, n0 = 64 * nb, lr = lane >> 4, lc = lane & 15;
    f32x4 v[16];
#pragma unroll
    for (int i = 0; i < 16; ++i) v[i] = *(const f32x4*)(W + (size_t)(k0 + 4 * i + lr) * N + n0 + 4 * lc);
#pragma unroll
    for (int i = 0; i < 16; ++i) { const int kk = 4 * i + lr; const float gg = g ? g[k0 + kk] : 1.0f; LAS float* p = scr + kk * 65 + 4 * lc; p[0] = v[i][0] * gg; p[1] = v[i][1] * gg; p[2] = v[i][2] * gg; p[3] = v[i][3] * gg; }
    asm volatile("s_waitcnt lgkmcnt(0)" ::: "memory");
    const int c = lane & 7; const int d0 = dst_row_map(mode, n0);
#pragma unroll
    for (int j = 0; j < 8; ++j) { const int n = (lane >> 3) + 8 * j; const LAS float* sp = scr + (8 * c) * 65 + n;
        v4u o; o.x = pk2(sp[0 * 65], sp[1 * 65]); o.y = pk2(sp[2 * 65], sp[3 * 65]); o.z = pk2(sp[4 * 65], sp[5 * 65]); o.w = pk2(sp[6 * 65], sp[7 * 65]);
        *(v4u*)(WT + (size_t)(d0 + n) * K + k0 + 8 * c) = o; }
    asm volatile("s_waitcnt lgkmcnt(0)" ::: "memory");
}
struct ProArgs { const float* in[25]; unsigned char* ws; int layer_mask; int ffn_mode; };
#define CONVERT_JOB(Wp, K_, N_, gp, dst, mode) do { const int nitems = ((K_) / 64) * ((N_) / 64); for (int it = gw; it < nitems; it += NGW) transpose_item((Wp), (K_), (N_), (gp), (bf16*)(ws + (dst)), (mode), scr, it, lane); } while (0)
__device__ __forceinline__ void prologue_body(const ProArgs& a, int gw, int NGW, int lane, LAS float* scr) {
    unsigned char* ws = a.ws;
    const float* x = a.in[0]; const float* mem = a.in[1];
    if (a.layer_mask & 1) {
        CONVERT_JOB(a.in[3], D, EV_IN, a.in[2], WS_EVIN, 1);
        CONVERT_JOB(a.in[7], D, D, (const float*)nullptr, WS_EVOUT, 0);
        CONVERT_JOB(a.in[15], D, D, a.in[13], WS_XQ0, 0);
        CONVERT_JOB(a.in[16], D, 2 * D, (const float*)nullptr, WS_XKV0, 0);
        CONVERT_JOB(a.in[19], D, D, (const float*)nullptr, WS_XO0, 0);
        CONVERT_JOB(a.in[21], D, 2 * DFF, a.in[20], WS_FIN0, a.ffn_mode);
        CONVERT_JOB(a.in[24], DFF, D, (const float*)nullptr, WS_FOUT0, 0);
        for (int m = 2 * gw; m < M; m += 2 * NGW) {
            const f32x4* xr = (const f32x4*)(x + (size_t)m * D) + lane; v2u* o8 = (v2u*)((bf16*)(ws + WS_XB) + (size_t)m * D) + lane; float* sp = (float*)(ws + WS_SSQP);
            f32x4 v[8];
#pragma unroll
            for (int j = 0; j < 8; ++j) v[j] = xr[64 * j];
#pragma unroll
            for (int j = 0; j < 8; ++j) { v2u w; w.x = pk2(v[j][0], v[j][1]); w.y = pk2(v[j][2], v[j][3]); o8[64 * j] = w;
                const float s2 = wave_sum((v[j][0] * v[j][0] + v[j][1] * v[j][1]) + (v[j][2] * v[j][2] + v[j][3] * v[j][3])); if (lane == 0) sp[(size_t)(j & 3) * M + m + (j >> 2)] = s2; }
        }
        for (int r = gw; r < 2 * MM; r += NGW) { const int l = r / MM, m = r % MM;
            const f32x4* xr = (const f32x4*)(mem + (size_t)m * D) + lane; const f32x4* gr = (const f32x4*)(a.in[14] + (size_t)l * D) + lane;
            f32x4 v[4]; float s = 0.f;
#pragma unroll
            for (int j = 0; j < 4; ++j) { v[j] = xr[64 * j]; s += (v[j][0] * v[j][0] + v[j][1] * v[j][1]) + (v[j][2] * v[j][2] + v[j][3] * v[j][3]); }
            const float rs = 1.0f / sqrtf(wave_sum(s) * (1.0f / D) + EPS);
            v2u* o8 = (v2u*)((bf16*)(ws + (l ? WS_MEMH1 : WS_MEMH0)) + (size_t)m * D) + lane;
#pragma unroll
            for (int j = 0; j < 4; ++j) { const f32x4 g = gr[64 * j]; v2u w; w.x = pk2(v[j][0] * rs * g[0], v[j][1] * rs * g[1]); w.y = pk2(v[j][2] * rs * g[2], v[j][3] * rs * g[3]); o8[64 * j] = w; }
        }
        if (gw == 0) {
            const float* lg = a.in[6]; float* lb = (float*)(ws + WS_LB);
            for (int c = lane; c < 512; c += 64) { const float a0 = lg[c], a1 = lg[512 + c], a2 = lg[1024 + c]; const float mx = fmaxf(a0, fmaxf(a1, a2));
                const float e0 = expf(a0 - mx), e1 = expf(a1 - mx), e2 = expf(a2 - mx); lb[c] = e0 / (e0 + e1 + e2); }
        }
        if (gw == 2) {
            float* gx = (float*)(ws + WS_GXA); float* go = (float*)(ws + WS_GOD);
            for (int i = lane; i < 512; i += 64) gx[i] = a.in[18][i] * a.in[17][i];
            for (int i = lane; i < 128; i += 64) go[i] = a.in[10][i] * a.in[9][i];
        }
        if (gw == 1) {
            const float* rb = a.in[11]; float* bt = (float*)(ws + WS_BIAST);
            for (int i = lane; i < 3 * 8 * 132; i += 64) { const int br = i / (8 * 132), h = (i / 132) % 8, dl = i % 132; const int d = dl * (1 << (2 * br));
                int bucket; if (d < 16) bucket = d; else { const float lr = logf((float)d / 16.0f) / 4.852030263919617f; int lg2 = 16 + (int)(lr * 16.0f); bucket = lg2 < 31 ? lg2 : 31; }
                bt[i] = (dl <= 128) ? rb[bucket * 8 + h] : 0.f; }
        }
    }
    if (a.layer_mask & 2) {
        CONVERT_JOB(a.in[8], D, OD_IN, a.in[2] + D, WS_ODIN, 0);
        CONVERT_JOB(a.in[12], D, D, (const float*)nullptr, WS_ODOUT, 0);
        CONVERT_JOB(a.in[15] + (size_t)D * D, D, D, a.in[13] + D, WS_XQ1, 0);
        CONVERT_JOB(a.in[16] + (size_t)D * 2 * D, D, 2 * D, (const float*)nullptr, WS_XKV1, 0);
        CONVERT_JOB(a.in[19] + (size_t)D * D, D, D, (const float*)nullptr, WS_XO1, 0);
        CONVERT_JOB(a.in[21] + (size_t)D * 2 * DFF, D, 2 * DFF, a.in[20] + D, WS_FIN1, a.ffn_mode);
        CONVERT_JOB(a.in[24] + (size_t)DFF * D, DFF, D, (const float*)nullptr, WS_FOUT1, 0);
    }
}


typedef short bf16x8 __attribute__((ext_vector_type(8)));
typedef short s16x4 __attribute__((ext_vector_type(4)));
typedef float f32x16 __attribute__((ext_vector_type(16)));
typedef float f32x2_t __attribute__((ext_vector_type(2))); typedef __bf16 bf16x2_t __attribute__((ext_vector_type(2)));
typedef short v4i16_t __attribute__((ext_vector_type(4)));
#define MFMA32(a, b, c) __builtin_amdgcn_mfma_f32_32x32x16_bf16((a), (b), (c), 0, 0, 0)
__device__ __forceinline__ unsigned cvtpk(float lo, float hi) { f32x2_t v = {lo, hi}; bf16x2_t b = __builtin_convertvector(v, bf16x2_t); return __builtin_bit_cast(unsigned, b); }
__device__ __forceinline__ bf16x8 pack8(float a0, float a1, float a2, float a3, float a4, float a5, float a6, float a7) {
    v4u p; p.x = cvtpk(a0, a1); p.y = cvtpk(a2, a3); p.z = cvtpk(a4, a5); p.w = cvtpk(a6, a7); return __builtin_bit_cast(bf16x8, p); }
__device__ __forceinline__ s16x4 vtr(const LAS char* p) { return __builtin_bit_cast(s16x4, __builtin_amdgcn_ds_read_tr16_b64_v4i16((LAS v4i16_t*)p)); }
__device__ __forceinline__ int tr_lane_base(int lane, int stride) { const int g = lane >> 4, i = lane & 15, q = i >> 2, p = i & 3, h2 = g >> 1; return (4 * h2 + q) * stride + (16 * (g & 1) + 4 * p) * 2; }
__device__ __forceinline__ bf16x8 tr_frag_perm(const LAS char* img, int stride, int lbase, int k0, int n0) {
    const LAS char* p = img + lbase + k0 * stride + n0 * 2;
    const s16x4 lo = vtr(p), hi = vtr(p + 8 * stride);
    return (bf16x8){lo[0], lo[1], lo[2], lo[3], hi[0], hi[1], hi[2], hi[3]};
}
__device__ __forceinline__ int tr_lane_base_nat(int lane, int stride) { const int g = lane >> 4, i = lane & 15, q = i >> 2, p = i & 3, h2 = g >> 1; return (8 * h2 + q) * stride + (16 * (g & 1) + 4 * p) * 2; }
__device__ __forceinline__ bf16x8 tr_frag_nat(const LAS char* img, int stride, int lbase, int k0, int n0) {
    const LAS char* p = img + lbase + k0 * stride + n0 * 2;
    const s16x4 lo = vtr(p), hi = vtr(p + 4 * stride);
    return (bf16x8){lo[0], lo[1], lo[2], lo[3], hi[0], hi[1], hi[2], hi[3]};
}

constexpr int XA_STRIDE = 528;
constexpr int XA_LDS = 256 * XA_STRIDE;
__device__ __forceinline__ void xattn_unit(LAS char* lds, const bf16* __restrict__ Q, const bf16* __restrict__ MKV, const float* __restrict__ gkq, bf16* __restrict__ O, int unit, int tid) {
    const int lane = tid & 63, w = __builtin_amdgcn_readfirstlane(tid >> 6), r = lane & 31, h2 = lane >> 5;
    const int rb = unit >> 2, h = unit & 3, row0 = rb * 256, b = row0 / SEQ;
    const bf16* Kg = MKV + (size_t)(b * NMEM) * 2048 + h * 256; const bf16* Vg = Kg + 1024;
    v4u st[16];
#pragma unroll
    for (int i = 0; i < 16; ++i) { const int id = tid + 512 * i; st[i] = *(const v4u*)(Kg + (size_t)(id >> 5) * 2048 + (id & 31) * 8); }
    const size_t qoff = (size_t)(row0 + 32 * w + r) * D + h * 256;
    bf16x8 qf[16];
#pragma unroll
    for (int s = 0; s < 16; ++s) qf[s] = *(const bf16x8*)(Q + qoff + 8 * h2 + 16 * s);
    { float gk8[8];
#pragma unroll
      for (int e = 0; e < 8; ++e) gk8[e] = gkq[(tid & 31) * 8 + e];
#pragma unroll
      for (int i = 0; i < 16; ++i) { const int id = tid + 512 * i; float f[8]; unpack8(st[i], f);
          float sq = (f[0] * f[0] + f[1] * f[1]) + (f[2] * f[2] + f[3] * f[3]) + (f[4] * f[4] + f[5] * f[5]) + (f[6] * f[6] + f[7] * f[7]);
          sq += __shfl_xor(sq, 1); sq += __shfl_xor(sq, 2); sq += __shfl_xor(sq, 4); sq += __shfl_xor(sq, 8); sq += __shfl_xor(sq, 16);
          const float rk = 1.0f / sqrtf(sq * (1.0f / 256.0f) + EPS) * 0.0625f;
          v4u o; o.x = cvtpk(f[0] * rk * gk8[0], f[1] * rk * gk8[1]); o.y = cvtpk(f[2] * rk * gk8[2], f[3] * rk * gk8[3]); o.z = cvtpk(f[4] * rk * gk8[4], f[5] * rk * gk8[5]); o.w = cvtpk(f[6] * rk * gk8[6], f[7] * rk * gk8[7]);
          *(LAS v4u*)(lds + (id >> 5) * XA_STRIDE + (id & 31) * 16) = o; } }
    float ss = 0.f;
#pragma unroll
    for (int s = 0; s < 16; ++s)
#pragma unroll
        for (int j = 0; j < 8; ++j) { const float x = __uint_as_float((unsigned)(unsigned short)qf[s][j] << 16); ss += x * x; }
    ss += __shfl_xor(ss, 32);
    const float rsl = 1.0f / sqrtf(ss * (1.0f / 256.0f) + EPS) * 1.4426950408889634f;
    __syncthreads();
    bf16x8 pf[8][2]; float den = 0.f;
#pragma unroll
    for (int kb = 0; kb < 8; ++kb) {
        f32x16 acc;
#pragma unroll
        for (int i = 0; i < 16; ++i) acc[i] = 0.f;
        const LAS char* kp = lds + (32 * kb + r) * XA_STRIDE + h2 * 16;
#pragma unroll
        for (int s = 0; s < 16; ++s) { const bf16x8 a = *(const LAS bf16x8*)(kp + s * 32); acc = MFMA32(a, qf[s], acc); }
        float p[16];
#pragma unroll
        for (int i = 0; i < 16; ++i) { p[i] = __builtin_amdgcn_exp2f(acc[i] * rsl - 11.541560327111707f); den += p[i]; }
        pf[kb][0] = pack8(p[0], p[1], p[2], p[3], p[4], p[5], p[6], p[7]); pf[kb][1] = pack8(p[8], p[9], p[10], p[11], p[12], p[13], p[14], p[15]);
    }
    den += __shfl_xor(den, 32);
    const float inv = 1.0f / den;
    __syncthreads();
#pragma unroll
    for (int i = 0; i < 16; ++i) { const int id = tid + 512 * i; st[i] = *(const v4u*)(Vg + (size_t)(id >> 5) * 2048 + (id & 31) * 8); }
#pragma unroll
    for (int i = 0; i < 16; ++i) { const int id = tid + 512 * i; *(LAS v4u*)(lds + (id >> 5) * XA_STRIDE + (id & 31) * 16) = st[i]; }
    __syncthreads();
    const int lbase = tr_lane_base(lane, XA_STRIDE);
#pragma unroll
    for (int half = 0; half < 2; ++half) {
        f32x16 o[4];
#pragma unroll
        for (int vb = 0; vb < 4; ++vb)
#pragma unroll
            for (int i = 0; i < 16; ++i) o[vb][i] = 0.f;
#pragma unroll
        for (int kb = 0; kb < 8; ++kb)
#pragma unroll
            for (int s = 0; s < 2; ++s)
#pragma unroll
                for (int vb = 0; vb < 4; ++vb) { const bf16x8 a = tr_frag_perm(lds, XA_STRIDE, lbase, 32 * kb + 16 * s, 128 * half + 32 * vb); o[vb] = MFMA32(a, pf[kb][s], o[vb]); }
        bf16* orow = O + qoff + 128 * half + 4 * h2;
#pragma unroll
        for (int vb = 0; vb < 4; ++vb)
#pragma unroll
            for (int g4 = 0; g4 < 4; ++g4) { v2u wv; wv.x = cvtpk(o[vb][4 * g4] * inv, o[vb][4 * g4 + 1] * inv); wv.y = cvtpk(o[vb][4 * g4 + 2] * inv, o[vb][4 * g4 + 3] * inv);
                *(v2u*)(orow + 32 * vb + 8 * g4) = wv; }
    }
    __syncthreads();
}


constexpr int DA_STRIDE = 272, DA_LDS_BIAS = 384 * DA_STRIDE;
struct DaArgs { const bf16* QKV; const float* biasT; const float* gkq; bf16* N0; float* DEN0; const bf16* N1; const float* DEN1; const bf16* N2; const float* DEN2; bf16* O; int br0; int nbr; int mode; int pad; };
#define LDS_BARRIER() do { asm volatile("s_waitcnt lgkmcnt(0)" ::: "memory"); __builtin_amdgcn_s_barrier(); asm volatile("" ::: "memory"); } while (0)
struct DaUnit { int br, b, h, dil, cls, l0; };
template <int MODE> __device__ __forceinline__ DaUnit da_decode(int uu) {
    DaUnit U; U.br = MODE == 0 ? __builtin_amdgcn_readfirstlane(1 + (uu >> 9)) : 0; const int rem = __builtin_amdgcn_readfirstlane(uu & 511), x = rem & 15; U.b = rem >> 7; U.h = (rem >> 4) & 7; U.dil = 1 << (2 * U.br);
    U.cls = U.br == 0 ? 0 : (U.br == 1 ? (x & 3) : x); U.l0 = 256 * (U.br == 0 ? x : (U.br == 1 ? (x >> 2) : 0)); return U; }
__device__ __forceinline__ void da_load_rows(v4u (&st)[12], const bf16* QKV, const DaUnit& U, int col, int tid) {
    const bf16* base = QKV + (size_t)(U.b * SEQ) * OD_IN + U.h * 128 + col + (tid & 15) * 8;
#pragma unroll
    for (int i = 0; i < 12; ++i) { const int ki = (tid >> 4) + 32 * i, lk = U.l0 - 128 + ki, lkc = lk < 0 ? 0 : lk; st[i] = *(const v4u*)(base + (size_t)(lkc * U.dil + U.cls) * OD_IN); }
}
template <int MODE> __device__ __forceinline__ void dattn_phase(LAS char* lds, const DaArgs& a, int bx, int G, int tid) {
    constexpr int NUNITS = MODE == 0 ? 1024 : 512;
    const int lane = tid & 63, w = __builtin_amdgcn_readfirstlane(tid >> 6), r = lane & 31, h2 = lane >> 5;
    int uu = bx; if (uu >= NUNITS) return;
    v4u st[12];
    { const DaUnit U0 = da_decode<MODE>(uu); da_load_rows(st, a.QKV, U0, 1024, tid); }
    LAS float* lbias = (LAS float*)(lds + DA_LDS_BIAS);
    const int lbase = tr_lane_base(lane, DA_STRIDE);
    for (;;) {
        const DaUnit U = da_decode<MODE>(uu);
        const int l0 = U.l0, h = U.h; const bool zfirst = (l0 == 0);
        int r_l = r; asm volatile("" : "+v"(r_l));
        float gk8[8];
#pragma unroll
        for (int e = 0; e < 8; ++e) gk8[e] = a.gkq[(tid & 15) * 8 + e];
        const size_t qrow = (size_t)(U.b * SEQ + (l0 + 32 * w + r) * U.dil + U.cls);
#pragma unroll
        for (int i = 0; i < 12; ++i) { float f_[8]; unpack8((i < 4 && zfirst) ? (v4u){0u, 0u, 0u, 0u} : st[i], f_);
            float sq_ = (f_[0] * f_[0] + f_[1] * f_[1]) + (f_[2] * f_[2] + f_[3] * f_[3]) + (f_[4] * f_[4] + f_[5] * f_[5]) + (f_[6] * f_[6] + f_[7] * f_[7]);
            sq_ += __shfl_xor(sq_, 1); sq_ += __shfl_xor(sq_, 2); sq_ += __shfl_xor(sq_, 4); sq_ += __shfl_xor(sq_, 8);
            const float rk_ = 1.0f / sqrtf(sq_ * (1.0f / 128.0f) + EPS) * 0.08838834764831845f;
            v4u o_; o_.x = cvtpk(f_[0] * rk_ * gk8[0], f_[1] * rk_ * gk8[1]); o_.y = cvtpk(f_[2] * rk_ * gk8[2], f_[3] * rk_ * gk8[3]); o_.z = cvtpk(f_[4] * rk_ * gk8[4], f_[5] * rk_ * gk8[5]); o_.w = cvtpk(f_[6] * rk_ * gk8[6], f_[7] * rk_ * gk8[7]);
            *(LAS v4u*)(lds + ((tid >> 4) + 32 * i) * DA_STRIDE + (tid & 15) * 16) = o_; }
        if (tid < 132) lbias[tid] = a.biasT[(U.br * 8 + h) * 132 + tid];
        asm volatile("" ::: "memory");
        bf16x8 qf[8];
#pragma unroll
        for (int s = 0; s < 8; ++s) qf[s] = *(const bf16x8*)(a.QKV + qrow * OD_IN + h * 128 + 8 * h2 + 16 * s);
        da_load_rows(st, a.QKV, U, 2048, tid);
        float ss = 0.f;
#pragma unroll
        for (int s = 0; s < 8; ++s)
#pragma unroll
            for (int j = 0; j < 8; ++j) { const float xq = __uint_as_float((unsigned)(unsigned short)qf[s][j] << 16); ss += xq * xq; }
        ss += __shfl_xor(ss, 32);
        const float rsl = 1.0f / sqrtf(ss * (1.0f / 128.0f) + EPS) * 1.4426950408889634f;
        LDS_BARRIER();
        bf16x8 pf[5][2]; float den = 0.f;
#pragma unroll
        for (int kbi = 0; kbi < 5; ++kbi) {
            f32x16 acc;
#pragma unroll
            for (int i = 0; i < 16; ++i) acc[i] = 0.f;
            const LAS char* kp = lds + (32 * (w + kbi) + r) * DA_STRIDE + h2 * 16;
#pragma unroll
            for (int s = 0; s < 8; ++s) { const bf16x8 av = *(const LAS bf16x8*)(kp + s * 32); acc = MFMA32(av, qf[s], acc); }
            __builtin_amdgcn_sched_barrier(0);
#pragma unroll
            for (int hh = 0; hh < 2; ++hh) { float p[8];
#pragma unroll
                for (int i8 = 0; i8 < 8; ++i8) { const int i = 8 * hh + i8; const int c = (i & 3) + 8 * (i >> 2) + 4 * h2; const int delta = 128 - 32 * kbi + r_l - c; const int ki = 32 * (w + kbi) + c;
                    const bool valid = (delta >= 0) && (delta <= 128) && (l0 - 128 + ki >= 0); const int dcl = delta < 0 ? 0 : (delta > 128 ? 128 : delta);
                    const float e = __builtin_amdgcn_exp2f(acc[i] * rsl + lbias[dcl] * 1.4426950408889634f - 11.541560327111707f); p[i8] = valid ? e : 0.f; den += p[i8]; }
                pf[kbi][hh] = pack8(p[0], p[1], p[2], p[3], p[4], p[5], p[6], p[7]);
                __builtin_amdgcn_sched_barrier(0); }
            asm volatile("" ::: "memory");
        }
        den += __shfl_xor(den, 32);
        LDS_BARRIER();
#pragma unroll
        for (int i = 0; i < 12; ++i) *(LAS v4u*)(lds + ((tid >> 4) + 32 * i) * DA_STRIDE + (tid & 15) * 16) = (i < 4 && zfirst) ? (v4u){0u, 0u, 0u, 0u} : st[i];
        LDS_BARRIER();
        const int un = uu + G; const bool more = un < NUNITS; const DaUnit Un = da_decode<MODE>(more ? un : uu);
        if (more) da_load_rows(st, a.QKV, Un, 1024, tid);
        const size_t ooff = qrow * D + h * 128 + 4 * h2;
        float inv = 1.0f;
        if (MODE == 0) { if (h2 == 0) ((float*)(U.br == 1 ? a.DEN1 : a.DEN2))[qrow * 8 + h] = den; }
        else { inv = 1.0f / (den + a.DEN1[qrow * 8 + h] + a.DEN2[qrow * 8 + h]); }
#pragma unroll
        for (int half = 0; half < 2; ++half) {
            f32x16 o[2];
#pragma unroll
            for (int vb = 0; vb < 2; ++vb)
#pragma unroll
                for (int i = 0; i < 16; ++i) o[vb][i] = 0.f;
#pragma unroll
            for (int kbi = 0; kbi < 5; ++kbi)
#pragma unroll
                for (int s = 0; s < 2; ++s)
#pragma unroll
                    for (int vb = 0; vb < 2; ++vb) { const bf16x8 av = tr_frag_perm(lds, DA_STRIDE, lbase, 32 * (w + kbi) + 16 * s, 64 * half + 32 * vb); o[vb] = MFMA32(av, pf[kbi][s], o[vb]); }
            if (MODE == 0) {
                bf16* N = (bf16*)(U.br == 1 ? a.N1 : a.N2) + ooff + 64 * half;
#pragma unroll
                for (int vb = 0; vb < 2; ++vb)
#pragma unroll
                    for (int g4 = 0; g4 < 4; ++g4) { v2u wv; wv.x = cvtpk(o[vb][4 * g4], o[vb][4 * g4 + 1]); wv.y = cvtpk(o[vb][4 * g4 + 2], o[vb][4 * g4 + 3]); *(v2u*)(N + 32 * vb + 8 * g4) = wv; }
            } else {
                const bf16* N1 = a.N1 + ooff + 64 * half; const bf16* N2 = a.N2 + ooff + 64 * half; bf16* Op = a.O + ooff + 64 * half;
#pragma unroll
                for (int vb = 0; vb < 2; ++vb)
#pragma unroll
                    for (int g4 = 0; g4 < 4; ++g4) { const v2u n1 = *(const v2u*)(N1 + 32 * vb + 8 * g4), n2 = *(const v2u*)(N2 + 32 * vb + 8 * g4);
                        const float x0 = o[vb][4 * g4] + __uint_as_float(n1.x << 16) + __uint_as_float(n2.x << 16), x1 = o[vb][4 * g4 + 1] + __uint_as_float(n1.x & 0xffff0000u) + __uint_as_float(n2.x & 0xffff0000u);
                        const float x2 = o[vb][4 * g4 + 2] + __uint_as_float(n1.y << 16) + __uint_as_float(n2.y << 16), x3 = o[vb][4 * g4 + 3] + __uint_as_float(n1.y & 0xffff0000u) + __uint_as_float(n2.y & 0xffff0000u);
                        v2u wv; wv.x = cvtpk(x0 * inv, x1 * inv); wv.y = cvtpk(x2 * inv, x3 * inv); *(v2u*)(Op + 32 * vb + 8 * g4) = wv; }
            }
            asm volatile("" ::: "memory");
        }
        LDS_BARRIER();
        if (!more) break;
        uu = un;
    }
}

constexpr int MX_STRIDE = 272, MX_IMG = 128 * MX_STRIDE;
constexpr int MX_Q = 0, MX_K = MX_IMG, MX_V = 2 * MX_IMG, MX_SCR = 3 * MX_IMG;
struct MixArgs { bf16* Z; const float* lb; const float* ret_g; const float* hg_g; bf16* SBUF; float* DECA; float* DECB; };

__device__ __forceinline__ void st_chunk8(LAS char* img, int row, int c0, const float (&f)[8]) {
    v4u o; o.x = cvtpk(f[0], f[1]); o.y = cvtpk(f[2], f[3]); o.z = cvtpk(f[4], f[5]); o.w = cvtpk(f[6], f[7]); *(LAS v4u*)(img + row * MX_STRIDE + c0 * 2) = o; }

__device__ __forceinline__ void ret_prep_tile(LAS char* img, const bf16* zrow  , int j, int cg, const float (&sn)[16], const float (&cs)[16], float sc) {
#pragma unroll
    for (int hc = 0; hc < 2; ++hc) { float x1[8], x2[8], o1[8], o2[8];
        unpack8(*(const v4u*)(zrow + 16 * cg + 8 * hc), x1); unpack8(*(const v4u*)(zrow + 64 + 16 * cg + 8 * hc), x2);
#pragma unroll
        for (int e = 0; e < 8; ++e) { o1[e] = (x1[e] * cs[8 * hc + e] - x2[e] * sn[8 * hc + e]) * sc; o2[e] = (x1[e] * sn[8 * hc + e] + x2[e] * cs[8 * hc + e]) * sc; }
        st_chunk8(img, j, 16 * cg + 8 * hc, o1); st_chunk8(img, j, 64 + 16 * cg + 8 * hc, o2); }
}
__device__ __forceinline__ void copy_tile(LAS char* img, const bf16* src, int tid) {
#pragma unroll
    for (int i = 0; i < 4; ++i) { const int id = tid + 512 * i, row = id >> 4, ch = id & 15; *(LAS v4u*)(img + row * MX_STRIDE + ch * 16) = *(const v4u*)(src + (size_t)row * EV_IN + ch * 8); }
}
__device__ __forceinline__ void hg_gates(const bf16* zrow_f  , const float* lbh  , int tid, LAS float* scr, float (&cum)[32], float (&kk)[32]) {
    const int lane = tid & 63, hw = (tid >> 6) & 1, cg = tid >> 7;
#pragma unroll
    for (int q = 0; q < 4; ++q) { float fl[8]; unpack8(*(const v4u*)(zrow_f + 32 * cg + 8 * q), fl);
#pragma unroll
        for (int e = 0; e < 8; ++e) { const float l = lbh[32 * cg + 8 * q + e]; const float f = l + (1.0f - l) * (1.0f / (1.0f + __expf(-fl[e]))); kk[8 * q + e] = 1.0f - f; cum[8 * q + e] = __logf(fmaxf(f, 1e-6f)); } }
#pragma unroll
    for (int off = 1; off < 64; off <<= 1) {
#pragma unroll
        for (int c = 0; c < 32; ++c) { const float t = __shfl_up(cum[c], off); if (lane >= off) cum[c] += t; } }
    if (hw == 0 && lane == 63) {
#pragma unroll
        for (int c = 0; c < 32; ++c) scr[32 * cg + c] = cum[c]; }
    __syncthreads();
    if (hw == 1) {
#pragma unroll
        for (int c = 0; c < 32; ++c) cum[c] += scr[32 * cg + c]; }
    if (hw == 1 && lane == 63) {
#pragma unroll
        for (int c = 0; c < 32; ++c) scr[128 + 32 * cg + c] = cum[c]; }
    __syncthreads();
}

__device__ __forceinline__ void mixA_unit(LAS char* lds, const MixArgs& a, int u, int tid) {
    const int lane = tid & 63, w = __builtin_amdgcn_readfirstlane(tid >> 6), r = lane & 31, h2 = lane >> 5;
    const int g = u >> 5, n = u & 31, mixer = g >> 4, b = (g >> 2) & 3, h = g & 3;
    const int j = tid & 127, cg = tid >> 7;
    const bf16* zt = a.Z + (size_t)(b * SEQ + 128 * n) * EV_IN;
    LAS float* scr = (LAS float*)(lds + MX_SCR);
    if (mixer == 0) {
        const float gamma = 1.0f - exp2f(-5.0f - (float)h), lg2 = log2f(gamma);
        float sn[16], cs[16];
#pragma unroll
        for (int e = 0; e < 16; ++e) { const float inv = exp2f(-(float)(16 * cg + e) * (13.287712379549449f / 64.0f)); rope_sincos((float)(128 * n + j) * inv, sn[e], cs[e]); }
        ret_prep_tile(lds + MX_K, zt + (size_t)j * EV_IN + Z_RK + h * 128, j, cg, sn, cs, 0.08838834764831845f * exp2f((float)(127 - j) * lg2));
        copy_tile(lds + MX_V, zt + Z_RV + h * 128, tid);
        if (tid < 128) { a.DECA[(size_t)u * 128 + tid] = exp2f(128.0f * lg2); a.DECB[(size_t)u * 128 + tid] = gamma; }
    } else {
        float cum[32], kk[32];
        hg_gates(zt + (size_t)j * EV_IN + Z_GF + h * 128, a.lb + h * 128, tid, scr, cum, kk);
#pragma unroll
        for (int q = 0; q < 4; ++q) { float o[8];
#pragma unroll
            for (int e = 0; e < 8; ++e) o[e] = kk[8 * q + e] * __expf(scr[128 + 32 * cg + 8 * q + e] - cum[8 * q + e]);
            st_chunk8(lds + MX_K, j, 32 * cg + 8 * q, o); }
        copy_tile(lds + MX_V, zt + Z_GI + h * 128, tid);
        if (tid < 128) { a.DECA[(size_t)u * 128 + tid] = __expf(scr[128 + tid]); a.DECB[(size_t)u * 128 + tid] = __expf(scr[tid]); }
    }
    __syncthreads();
    const int lbn = tr_lane_base_nat(lane, MX_STRIDE); const int kbk = w >> 1, vb0 = 2 * (w & 1);
    f32x16 acc[2];
#pragma unroll
    for (int t = 0; t < 2; ++t)
#pragma unroll
        for (int i = 0; i < 16; ++i) acc[t][i] = 0.f;
#pragma unroll
    for (int s = 0; s < 8; ++s) { const bf16x8 av = tr_frag_nat(lds + MX_K, MX_STRIDE, lbn, 16 * s, 32 * kbk);
#pragma unroll
        for (int t = 0; t < 2; ++t) { const bf16x8 bv = tr_frag_nat(lds + MX_V, MX_STRIDE, lbn, 16 * s, 32 * (vb0 + t)); acc[t] = MFMA32(av, bv, acc[t]); } }
    bf16* sb = a.SBUF + (size_t)u * 16384;
#pragma unroll
    for (int t = 0; t < 2; ++t)
#pragma unroll
        for (int g4 = 0; g4 < 4; ++g4) { v2u wv; wv.x = cvtpk(acc[t][4 * g4], acc[t][4 * g4 + 1]); wv.y = cvtpk(acc[t][4 * g4 + 2], acc[t][4 * g4 + 3]);
            *(v2u*)(sb + (size_t)(32 * (vb0 + t) + r) * 128 + 32 * kbk + 8 * g4 + 4 * h2) = wv; }
    __syncthreads();
}

__device__ __forceinline__ void mix_scan(const MixArgs& a, int gtid, int nthreads, bool dry = false) {
    for (int e = gtid; e < 32 * 4096; e += nthreads) { const int g = e >> 12, el = e & 4095, dk4 = el & 31;
        bf16* sp = a.SBUF + (size_t)(g * 32) * 16384 + (size_t)el * 4; const float* da = a.DECA + (size_t)(g * 32) * 128 + 4 * dk4; const float* db = a.DECB + (size_t)(g * 32) * 128 + 4 * dk4;
        f32x4 S = (f32x4){0.f, 0.f, 0.f, 0.f};
#pragma unroll 8
        for (int n = 0; n < 32; ++n) { const v2u kv = *(const v2u*)(sp + (size_t)n * 16384); const f32x4 A = *(const f32x4*)(da + n * 128), Bv = *(const f32x4*)(db + n * 128);
            const f32x4 so = S * Bv; v2u wv; wv.x = cvtpk(so[0], so[1]); wv.y = cvtpk(so[2], so[3]); if (!dry) *(v2u*)(sp + (size_t)n * 16384) = wv;
            S[0] = A[0] * S[0] + __uint_as_float(kv.x << 16); S[1] = A[1] * S[1] + __uint_as_float(kv.x & 0xffff0000u); S[2] = A[2] * S[2] + __uint_as_float(kv.y << 16); S[3] = A[3] * S[3] + __uint_as_float(kv.y & 0xffff0000u); }
    }
}

__device__ __forceinline__ void mixC_unit(LAS char* lds, const MixArgs& a, int u, int tid, bool dry = false) {
    const int lane = tid & 63, w = __builtin_amdgcn_readfirstlane(tid >> 6), r = lane & 31, h2 = lane >> 5;
    const int g = u >> 5, n = u & 31, mixer = g >> 4, b = (g >> 2) & 3, h = g & 3;
    const int j = tid & 127, cg = tid >> 7;
    bf16* zt = a.Z + (size_t)(b * SEQ + 128 * n) * EV_IN;
    LAS float* scr = (LAS float*)(lds + MX_SCR);
    if (mixer == 0) {
        const float gamma = 1.0f - exp2f(-5.0f - (float)h), lg2 = log2f(gamma);
        float sn[16], cs[16];
#pragma unroll
        for (int e = 0; e < 16; ++e) { const float inv = exp2f(-(float)(16 * cg + e) * (13.287712379549449f / 64.0f)); rope_sincos((float)(128 * n + j) * inv, sn[e], cs[e]); }
        ret_prep_tile(lds + MX_Q, zt + (size_t)j * EV_IN + Z_RQ + h * 128, j, cg, sn, cs, exp2f((float)j * lg2));
        ret_prep_tile(lds + MX_K, zt + (size_t)j * EV_IN + Z_RK + h * 128, j, cg, sn, cs, 0.08838834764831845f * exp2f(-(float)j * lg2));
        copy_tile(lds + MX_V, zt + Z_RV + h * 128, tid);
    } else {
        float cum[32], kk[32];
        hg_gates(zt + (size_t)j * EV_IN + Z_GF + h * 128, a.lb + h * 128, tid, scr, cum, kk);
#pragma unroll
        for (int q = 0; q < 4; ++q) { float qv[8], oq[8], ok[8]; unpack8(*(const v4u*)(zt + (size_t)j * EV_IN + Z_GQ + h * 128 + 32 * cg + 8 * q), qv);
#pragma unroll
            for (int e = 0; e < 8; ++e) { const float d = cum[8 * q + e] - scr[32 * cg + 8 * q + e]; oq[e] = qv[e] * __expf(d); ok[e] = kk[8 * q + e] * __expf(-d); }
            st_chunk8(lds + MX_Q, j, 32 * cg + 8 * q, oq); st_chunk8(lds + MX_K, j, 32 * cg + 8 * q, ok); }
        copy_tile(lds + MX_V, zt + Z_GI + h * 128, tid);
    }
    __syncthreads();
    const int vb = w >> 1; const int lbp = tr_lane_base(lane, MX_STRIDE);
    const bf16* sb = a.SBUF + (size_t)u * 16384 + (size_t)(32 * vb + r) * 128 + 8 * h2;
    bf16x8 sf[8];
#pragma unroll
    for (int s = 0; s < 8; ++s) sf[s] = *(const bf16x8*)(sb + 16 * s);
    f32x16 o[2]; float s1[2], s2[2];
#pragma unroll
    for (int t = 0; t < 2; ++t) {
        const int ib = (w & 1) ? (1 + t) : (3 * t);
        bf16x8 qf[8];
#pragma unroll
        for (int s = 0; s < 8; ++s) qf[s] = *(const LAS bf16x8*)(lds + MX_Q + (32 * ib + r) * MX_STRIDE + h2 * 16 + s * 32);
#pragma unroll
        for (int i = 0; i < 16; ++i) o[t][i] = 0.f;
#pragma unroll
        for (int s = 0; s < 8; ++s) o[t] = MFMA32(sf[s], qf[s], o[t]);
        for (int jb = 0; jb <= ib; ++jb) {
            f32x16 acc;
#pragma unroll
            for (int i = 0; i < 16; ++i) acc[i] = 0.f;
            const LAS char* kp = lds + MX_K + (32 * jb + r) * MX_STRIDE + h2 * 16;
#pragma unroll
            for (int s = 0; s < 8; ++s) { const bf16x8 av = *(const LAS bf16x8*)(kp + s * 32); acc = MFMA32(av, qf[s], acc); }
            if (jb == ib) {
#pragma unroll
                for (int i = 0; i < 16; ++i) { const int c = (i & 3) + 8 * (i >> 2) + 4 * h2; if (c > r) acc[i] = 0.f; } }
            const bf16x8 p0 = pack8(acc[0], acc[1], acc[2], acc[3], acc[4], acc[5], acc[6], acc[7]), p1 = pack8(acc[8], acc[9], acc[10], acc[11], acc[12], acc[13], acc[14], acc[15]);
            const bf16x8 v0 = tr_frag_perm(lds + MX_V, MX_STRIDE, lbp, 32 * jb, 32 * vb), v1 = tr_frag_perm(lds + MX_V, MX_STRIDE, lbp, 32 * jb + 16, 32 * vb);
            o[t] = MFMA32(v0, p0, o[t]); o[t] = MFMA32(v1, p1, o[t]);
        }
        float a1 = 0.f, a2 = 0.f;
#pragma unroll
        for (int i = 0; i < 16; ++i) { a1 += o[t][i]; a2 += o[t][i] * o[t][i]; }
        a1 += __shfl_xor(a1, 32); a2 += __shfl_xor(a2, 32); s1[t] = a1; s2[t] = a2;
        if (h2 == 0) { scr[256 + (vb * 128 + 32 * ib + r) * 2] = a1; scr[256 + (vb * 128 + 32 * ib + r) * 2 + 1] = a2; }
    }
    __syncthreads();
    const float* gn = (mixer == 0 ? a.ret_g : a.hg_g) + h * 128 + 32 * vb + 4 * h2;
#pragma unroll
    for (int t = 0; t < 2; ++t) {
        const int ib = (w & 1) ? (1 + t) : (3 * t); const int tok = 32 * ib + r;
        float t1 = 0.f, t2 = 0.f;
#pragma unroll
        for (int v = 0; v < 4; ++v) { t1 += scr[256 + (v * 128 + tok) * 2]; t2 += scr[256 + (v * 128 + tok) * 2 + 1]; }
        float mu = 0.f, rstd;
        if (mixer == 0) { mu = t1 * (1.0f / 128.0f); rstd = 1.0f / sqrtf(fmaxf(t2 * (1.0f / 128.0f) - mu * mu, 0.f) + EPS); } else rstd = 1.0f / sqrtf(t2 * (1.0f / 128.0f) + EPS);
        bf16* zr = zt + (size_t)tok * EV_IN;
        const bf16* gp = zr + (mixer == 0 ? Z_RG : Z_GG) + h * 128 + 32 * vb + 4 * h2; bf16* yp = zr + (mixer == 0 ? Z_RQ : Z_GQ) + h * 128 + 32 * vb + 4 * h2;
#pragma unroll
        for (int g4 = 0; g4 < 4; ++g4) { const v2u gw = *(const v2u*)(gp + 8 * g4); const f32x4 gv = *(const f32x4*)(gn + 8 * g4);
            const float ga[4] = {__uint_as_float(gw.x << 16), __uint_as_float(gw.x & 0xffff0000u), __uint_as_float(gw.y << 16), __uint_as_float(gw.y & 0xffff0000u)}; float y[4];
#pragma unroll
            for (int e = 0; e < 4; ++e) { y[e] = (o[t][4 * g4 + e] - mu) * rstd * gv[e] * (ga[e] / (1.0f + __expf(-ga[e]))); }
            v2u wv; wv.x = cvtpk(y[0], y[1]); wv.y = cvtpk(y[2], y[3]); if (!dry) *(v2u*)(yp + 8 * g4) = wv; }
    }
    __syncthreads();
}


__device__ __forceinline__ float gelu_tanh(float x) { const float u = 0.7978845608028654f * (x + 0.044715f * x * x * x); const float t = 1.0f - 2.0f / (1.0f + __expf(2.0f * u)); return 0.5f * x * (1.0f + t); }
__device__ __forceinline__ void ffn_ew(const bf16* GU, const float* cw, const float* cb, bf16* H, int rows, int gtid, int nthreads) {
    for (int idx = gtid; idx < rows * (DFF / 8); idx += nthreads) {
        const int row = idx / (DFF / 8), c0 = (idx % (DFF / 8)) * 8, t = row % SEQ;
        float g0[8], g1[8], g2[8], u[8];
        unpack8(*(const v4u*)(GU + (size_t)row * (2 * DFF) + c0), g2); unpack8(*(const v4u*)(GU + (size_t)row * (2 * DFF) + DFF + c0), u);
        if (t >= 1) unpack8(*(const v4u*)(GU + (size_t)(row - 1) * (2 * DFF) + c0), g1); else { for (int i = 0; i < 8; ++i) g1[i] = 0.f; }
        if (t >= 2) unpack8(*(const v4u*)(GU + (size_t)(row - 2) * (2 * DFF) + c0), g0); else { for (int i = 0; i < 8; ++i) g0[i] = 0.f; }
        float r[8];
#pragma unroll
        for (int i = 0; i < 8; ++i) { const float y = cw[c0 + i] * g0[i] + cw[DFF + c0 + i] * g1[i] + cw[2 * DFF + c0 + i] * g2[i] + cb[c0 + i]; r[i] = gelu_tanh(y) * u[i]; }
        v4u o; o.x = cvtpk(r[0], r[1]); o.y = cvtpk(r[2], r[3]); o.z = cvtpk(r[4], r[5]); o.w = cvtpk(r[6], r[7]);
        *(v4u*)(H + (size_t)row * DFF + c0) = o;
    }
}

constexpr int LDS_BYTES = 147456;
constexpr int LDSCTL_OFF = LDS_BYTES - 512;
constexpr int CW_BAR = 4096;
constexpr size_t CTL_ZERO_BYTES = 1 * MiB;
#define XB_TMO      128
#define XB_XCNT(j)  (256  + 64 * (j))
#define XB_XSUB(j)  (1280 + 64 * (j))
#define XB_XGEN(j)  (2304 + 64 * (j))
#define XB_TOP      3328
#define XB_TOPGEN   3392
#define XCD_BAR_WORDS 3456
#define XB_SPIN_CAP (1u << 18)

__device__ __forceinline__ unsigned xb_ld(unsigned* p)              { return __hip_atomic_load(p, __ATOMIC_RELAXED, __HIP_MEMORY_SCOPE_AGENT); }
__device__ __forceinline__ unsigned xb_add(unsigned* p, unsigned v) { return __hip_atomic_fetch_add(p, v, __ATOMIC_RELAXED, __HIP_MEMORY_SCOPE_AGENT); }
__device__ __forceinline__ unsigned xb_xcc_id() { return (unsigned)__builtin_amdgcn_s_getreg((3 << 11) | 20) & 0xFu; }
#define XB_SPIN(cond, bar) do { unsigned _sp = 0; while (cond) { __builtin_amdgcn_s_sleep(1); \
    if ((++_sp & 255u) == 0u) { if (xb_ld(&(bar)[XB_TMO])) break; if (_sp > XB_SPIN_CAP) { atomicAdd(&(bar)[XB_TMO], 1u); break; } } } } while (0)

struct XcdBarrier {
    unsigned* bar; unsigned x;
    volatile LAS unsigned* st;
};

__device__ __forceinline__ XcdBarrier xcd_barrier_post(unsigned* bar, volatile LAS unsigned* st) {
    XcdBarrier b; b.bar = bar; b.x = xb_xcc_id(); b.st = st;
    if (threadIdx.x == 0) (void)xb_add(&bar[XB_XCNT(b.x)], 1u);
    return b;
}
__device__ __forceinline__ void xcd_barrier_complete(unsigned* bar, unsigned x, unsigned& nloc, unsigned& nx) {
    const unsigned G = gridDim.x * gridDim.y * gridDim.z;
    unsigned sum, cnt, mine, sp = 0u;
    for (;;) {
        sum = 0u; cnt = 0u; mine = 0u;
#pragma unroll
        for (unsigned j = 0; j < 16; ++j) { const unsigned c = xb_ld(&bar[XB_XCNT(j)]); sum += c; cnt += (c > 0u) ? 1u : 0u; mine = (j == x) ? c : mine; }
        if (sum == G) break;
        __builtin_amdgcn_s_sleep(1);
        if ((++sp & 255u) == 0u) { if (xb_ld(&bar[XB_TMO])) break; if (sp > XB_SPIN_CAP) { atomicAdd(&bar[XB_TMO], 1u); break; } }
    }
    nloc = mine > 0u ? mine : 1u; nx = cnt > 0u ? cnt : 1u;
}

__device__ __forceinline__ void xcd_barrier(const XcdBarrier& b) {
    asm volatile("s_waitcnt vmcnt(0)" ::: "memory");
    __syncthreads();
    if (threadIdx.x == 0) {
        unsigned* bar = b.bar;
        __builtin_amdgcn_s_waitcnt(0);
        unsigned nloc = b.st[0], nx = b.st[1];
        if (nloc == 0u) { xcd_barrier_complete(bar, b.x, nloc, nx); b.st[0] = nloc; b.st[1] = nx; }
        const unsigned old = xb_add(&bar[XB_XSUB(b.x)], 1u);
        const unsigned gen = old / nloc;
        if (old + 1u == (gen + 1u) * nloc) {
            __builtin_amdgcn_fence(__ATOMIC_RELEASE, "agent");
            asm volatile("s_waitcnt vmcnt(0)" ::: "memory");
            const unsigned og = xb_add(&bar[XB_TOP], 1u);
            const unsigned tg = og / nx;
            if (og + 1u == (tg + 1u) * nx) xb_add(&bar[XB_TOPGEN], 1u);
            else XB_SPIN(xb_ld(&bar[XB_TOPGEN]) == tg, bar);
            __builtin_amdgcn_fence(__ATOMIC_ACQUIRE, "agent");
            xb_add(&bar[XB_XGEN(b.x)], 1u);
            asm volatile("s_waitcnt vmcnt(0)" ::: "memory");
        } else {
            XB_SPIN(xb_ld(&bar[XB_XGEN(b.x)]) == gen, bar);
            __builtin_amdgcn_fence(__ATOMIC_ACQUIRE, "agent");
            asm volatile("s_waitcnt vmcnt(0)" ::: "memory");
        }
    }
    __syncthreads();
}


struct FwdArgs { const float* in[25]; float* out; unsigned char* ws; int ph_lo, ph_hi, li, pad; };
__global__ void __launch_bounds__(512, 2) fwd(FwdArgs a) {
    extern __shared__ __attribute__((aligned(16))) unsigned char lds_raw[];
    LAS unsigned char* lds = (LAS unsigned char*)lds_raw;
    const int tid = threadIdx.x, lane = tid & 63, wave = __builtin_amdgcn_readfirstlane(tid >> 6);
    const int G = gridDim.x, bx = blockIdx.x;
    volatile LAS unsigned* MISC = (volatile LAS unsigned*)(lds + LDSCTL_OFF);
    if (tid < 64) MISC[tid] = 0u;
    __syncthreads();
    unsigned char* ws = a.ws; float* out = a.out;
    XcdBarrier bar = xcd_barrier_post((unsigned*)(ws + WS_CTL) + CW_BAR + a.li * XCD_BAR_WORDS, MISC + 8);
    int ph = 0; const int lo = a.ph_lo, hi = a.ph_hi;
#define PH_ON true) for (int rp_ = 0, nr_ = (ph >= lo && ph < hi) ? 1 + ((a.pad >> ph) & 1) : 0; rp_ < nr_; ++rp_, __syncthreads()
#define TID_L ({ int l_; asm volatile("v_mbcnt_lo_u32_b32 %0, -1, 0\n\tv_mbcnt_hi_u32_b32 %0, -1, %0" : "=v"(l_)); wave * 64 + l_; })
#define PH_END do { if (ph >= lo && ph + 1 < hi) xcd_barrier(bar); ++ph; } while (0)
    bf16* XB = (bf16*)(ws + WS_XB); float* SSQP = (float*)(ws + WS_SSQP); bf16* ACT = (bf16*)(ws + WS_ACT);

    if (PH_ON) { ProArgs pa;
#pragma unroll
        for (int i = 0; i < 25; ++i) pa.in[i] = a.in[i];
        pa.ws = ws; pa.layer_mask = 3; pa.ffn_mode = 2;
        { const int t_ = TID_L; prologue_body(pa, bx * 8 + (t_ >> 6), G * 8, t_ & 63, (LAS float*)lds + (t_ >> 6) * 64 * 65); } }
    PH_END;

    for (int l = 0; l < 2; ++l) {
        if (PH_ON) {
            { pg8::Gemm g{XB, (const bf16*)(ws + (l ? WS_ODIN : WS_EVIN)), M, l ? OD_IN : EV_IN, D, D}; pg8::EpiBf16S E{ACT, SSQP, l ? OD_IN : EV_IN, M, EPS, 0};
              pg8::StaticOrder S; S.init(g.M, g.N, G, bx); pg8::gemm_phase<pg8::EpiBf16S, pg8::StaticOrder, true, true>(lds, g, S, E, TID_L); }
        }
        PH_END;
        const bf16* mixo; int mixo_ld;
        if (l == 0) {
            MixArgs ma{ACT, (const float*)(ws + WS_LB), a.in[4], a.in[5], (bf16*)out, (float*)(ws + WS_DECA), (float*)(ws + WS_DECB)};
            if (PH_ON) { for (int u = bx; u < 1024; u += G) mixA_unit((LAS char*)lds, ma, u, TID_L); }
            PH_END;
            if (PH_ON) {
                if (bx < 64 && G > 64) { const int lm = bx >> 5;
                    pg8::Gemm g{(const bf16*)(ws + (lm ? WS_MEMH1 : WS_MEMH0)), (const bf16*)(ws + (lm ? WS_XKV1 : WS_XKV0)), MM, 2 * D, D, D}; pg8::EpiBf16S E{(bf16*)(ws + (lm ? WS_MKV1 : WS_MKV0)), nullptr, 2 * D, M, EPS, 0};
                    pg8::StaticOrder S; S.init(g.M, g.N, G, bx & 31); pg8::gemm_phase<pg8::EpiBf16S, pg8::StaticOrder, true, true>(lds, g, S, E, TID_L); }
                else mix_scan(ma, (bx - 64) * 512 + TID_L, (G - 64) * 512, rp_ + 1 < nr_);
            }
            PH_END;
            if (PH_ON) { for (int u = bx; u < 1024; u += G) mixC_unit((LAS char*)lds, ma, u, TID_L, rp_ + 1 < nr_); }
            PH_END;
            mixo = ACT; mixo_ld = EV_IN;
        } else {
            bf16* O = (bf16*)(ws + WS_ACT + 96 * MiB);
            DaArgs da; da.QKV = ACT; da.biasT = (const float*)(ws + WS_BIAST); da.gkq = (const float*)(ws + WS_GOD); da.N0 = (bf16*)(ws + WS_N2); da.DEN0 = (float*)(ws + WS_DEN23);
            da.N1 = (const bf16*)(ws + WS_N2); da.DEN1 = (const float*)(ws + WS_DEN23); da.N2 = (const bf16*)out; da.DEN2 = (const float*)(ws + WS_DEN23) + (size_t)M * 8; da.O = O; da.br0 = 1; da.nbr = 2; da.mode = 0; da.pad = 0;
            if (PH_ON) dattn_phase<0>((LAS char*)lds, da, bx, G, TID_L);
            PH_END;
            if (PH_ON) dattn_phase<1>((LAS char*)lds, da, bx, G, TID_L);
            PH_END;
            mixo = O; mixo_ld = D;
        }
        if (PH_ON) { pg8::Gemm g{mixo, (const bf16*)(ws + (l ? WS_ODOUT : WS_EVOUT)), M, D, D, mixo_ld}; pg8::EpiResid E{l ? (const float*)nullptr : a.in[0], nullptr, XB, SSQP, D, M};
            pg8::StaticOrder S; S.init(g.M, g.N, G, bx); pg8::gemm_phase<pg8::EpiResid, pg8::StaticOrder, false, true>(lds, g, S, E, TID_L); }
        PH_END;
        { bf16* Q = ACT; bf16* O = (bf16*)(ws + WS_ACT + 32 * MiB);
          if (PH_ON) { pg8::Gemm g{XB, (const bf16*)(ws + (l ? WS_XQ1 : WS_XQ0)), M, D, D, D}; pg8::EpiBf16S E{Q, SSQP, D, M, EPS, 0};
              pg8::StaticOrder S; S.init(g.M, g.N, G, bx); pg8::gemm_phase<pg8::EpiBf16S, pg8::StaticOrder, true, true>(lds, g, S, E, TID_L); }
          PH_END;
          if (PH_ON) { for (int u = bx; u < (M / 256) * 4; u += G) xattn_unit((LAS char*)lds, Q, (const bf16*)(ws + (l ? WS_MKV1 : WS_MKV0)), (const float*)(ws + WS_GXA) + l * 256, O, u, TID_L); }
          PH_END;
          if (PH_ON) { pg8::Gemm g{O, (const bf16*)(ws + (l ? WS_XO1 : WS_XO0)), M, D, D, D}; pg8::EpiResid E{nullptr, nullptr, XB, SSQP, D, M};
              pg8::StaticOrder S; S.init(g.M, g.N, G, bx); pg8::gemm_phase<pg8::EpiResid, pg8::StaticOrder, false, true>(lds, g, S, E, TID_L); }
          PH_END; }
        { bf16* H = ACT;
          if (PH_ON) { pg8::Gemm g{XB, (const bf16*)(ws + (l ? WS_FIN1 : WS_FIN0)), 68 * 256, 2 * DFF, D, D}; pg8::EpiFfn E{H, SSQP, a.in[22] + (size_t)l * 3 * DFF, a.in[23] + (size_t)l * DFF, M, EPS};
              pg8::FfnOrder S; S.init(g.M, g.N, G, bx); pg8::gemm_phase<pg8::EpiFfn, pg8::FfnOrder, true, true>(lds, g, S, E, TID_L); }
          PH_END;
          if (PH_ON) { pg8::Gemm g{H, (const bf16*)(ws + (l ? WS_FOUT1 : WS_FOUT0)), M, D, DFF, DFF}; pg8::EpiResid E{nullptr, l ? out : (float*)nullptr, XB, SSQP, D, M};
              pg8::StaticOrder S; S.init(g.M, g.N, G, bx); pg8::gemm_phase<pg8::EpiResid, pg8::StaticOrder, false, true>(lds, g, S, E, TID_L); }
          PH_END; }
    }
#undef PH_ON
#undef PH_END
#undef TID_L
}
constexpr int N_PHASES = 1 + 10 + 9;

#ifndef PROBE_MASK
#define PROBE_MASK 0
#endif
#ifndef MK_PER_PHASE
#define MK_PER_PHASE 0
#endif
extern "C" void kernel_launch(void* const* d_in, const int* in_sizes, int n_in, void* d_out, int out_size, void* d_ws, size_t ws_size, hipStream_t stream) {
    static int inited = 0;
    if (!inited) {
        if (n_in != 25 || out_size != M * D || ws_size < WS_END) { fprintf(stderr, "kernel_launch: unexpected shapes (n_in %d, out %d, ws %zu)\n", n_in, out_size, ws_size); inited = -1; return; }
        if (hipFuncSetAttribute((const void*)fwd, hipFuncAttributeMaxDynamicSharedMemorySize, LDS_BYTES) != hipSuccess) { fprintf(stderr, "kernel_launch: hipFuncSetAttribute failed\n"); inited = -1; return; }
        inited = 1;
    }
    if (inited < 0) return;
    if (hipMemsetAsync((char*)d_ws + WS_CTL, 0, CTL_ZERO_BYTES, stream) != hipSuccess) return;
    FwdArgs fa{}; for (int i = 0; i < 25; ++i) fa.in[i] = (const float*)d_in[i]; fa.out = (float*)d_out; fa.ws = (unsigned char*)d_ws; fa.pad = PROBE_MASK;
#if MK_PER_PHASE
    for (int p = 0; p < N_PHASES; ++p) { fa.ph_lo = p; fa.ph_hi = p + 1; fa.li = 0; hipLaunchKernelGGL(fwd, dim3(256), dim3(512), LDS_BYTES, stream, fa); }
#else
    fa.ph_lo = 0; fa.ph_hi = N_PHASES; fa.li = 0; hipLaunchKernelGGL(fwd, dim3(256), dim3(512), LDS_BYTES, stream, fa);
#endif
}
```

```cpp
#include <hip/hip_runtime.h>
#include <cstdio>
#include <cstdint>
namespace pg8 {
#define PG8_LAS __attribute__((address_space(3)))
typedef unsigned short bf16_t;
typedef short bf16x8 __attribute__((ext_vector_type(8)));
typedef float f32x4 __attribute__((ext_vector_type(4)));
typedef unsigned u32x4 __attribute__((ext_vector_type(4)));
constexpr int BM = 256, BK = 64, HALF = 128, HTB = HALF * BK * 2  , STAGE_BYTES = 8 * HTB, NXCD = 8, WGM = 8;
constexpr int SSQ_LDS = STAGE_BYTES + 4096, CW_LDS = STAGE_BYTES + 8192;

__host__ __device__ __forceinline__ int lds_byte(int r, int c) { const int st = (r >> 4) * 2 + (c >> 5), rr = r & 15, cc = c & 31, ob = rr * 64 + cc * 2; return st * 1024 + (ob ^ (((ob >> 9) & 1) << 5)); }
__host__ __device__ __forceinline__ void stage_rc(int b, int& R, int& C) { const int st = b / 1024, sb = b % 1024, swz = sb ^ (((sb >> 9) & 1) << 5); R = (st >> 1) * 16 + swz / 64; C = (st & 1) * 32 + (swz % 64) / 2; }
__host__ __device__ __forceinline__ int perm32(int rho) { const int n = rho >> 4, i = rho & 15; return 8 * (i >> 2) + 4 * n + (i & 3); }

struct Unit { int pm, pn; };
struct Gemm { const bf16_t* A; const bf16_t* Bt; int M, N, K, lda; };

struct StaticOrder {
    int nM, nN, nwg, G, c;
    __host__ __device__ __forceinline__ void init(int M, int N, int G_, int c_) { nM = M / BM; nN = N / BM; nwg = nM * nN; G = G_; c = c_; }
    __host__ __device__ __forceinline__ bool next(int i, Unit& u) const {
        const long L = (long)i * G + c; if (L >= nwg) return false;
        int wgid = (int)L; { const int q = nwg / NXCD, r = nwg % NXCD, xcd = wgid % NXCD, off = wgid / NXCD; wgid = (xcd < r ? xcd * (q + 1) : r * (q + 1) + (xcd - r) * q) + off; }
        const int nig = WGM * nN, gid = wgid / nig, fm = gid * WGM, gsz = (nM - fm) < WGM ? (nM - fm) : WGM;
        u.pm = fm + ((wgid % nig) % gsz); u.pn = (wgid % nig) / gsz; return true;
    }
    __device__ __forceinline__ void a_ready(const Unit&) const {}
    __device__ __forceinline__ void done(const Unit&) const {}
    __device__ __forceinline__ int arow(const Unit& u) const { return u.pm * BM; }
};
struct FfnOrder : StaticOrder {
    __device__ __forceinline__ int arow(const Unit& u) const { return (u.pm / 17) * 4096 + 254 * (u.pm % 17) - 2; }
};

__device__ __forceinline__ unsigned cvt_pk_bf16(float lo, float hi) { unsigned r; asm volatile("v_cvt_pk_bf16_f32 %0, %1, %2" : "=v"(r) : "v"(lo), "v"(hi)); return r; }
typedef float f32x2 __attribute__((ext_vector_type(2)));
struct EpiBf16S {
    static constexpr bool PERM = true, AFTER_DRAIN = false;
    bf16_t* O; const float* ssqp; int ldc; int Mtot; float eps; int pad;
    __device__ __forceinline__ void preload(PG8_LAS unsigned char* lds, const Unit& u, int wr, int wc, int lane) const {
        if (!ssqp) return;
#pragma unroll
        for (int ai = 0; ai < 2; ++ai) __builtin_amdgcn_global_load_lds((const unsigned*)(ssqp + (size_t)wc * Mtot + u.pm * BM + ai * HALF + wr * 64 + lane), (PG8_LAS unsigned*)(lds + SSQ_LDS + (((wr * 2 + ai) * 4 + wc) * 64) * 4), 4, 0, 0);
    }
    __device__ __forceinline__ void preload_unit(PG8_LAS unsigned char*, const Unit&, int, int, int) const {}
    __device__ __forceinline__ void operator()(f32x4 (&acc)[2][2][4][2], const Unit& u, int wr, int wc, int fr, int fq, PG8_LAS unsigned char* lds) const {
        const int row0 = u.pm * BM + wr * 64 + fr; const int col0 = u.pn * BM + wc * 32 + 8 * fq;
        const PG8_LAS float* sl = (const PG8_LAS float*)(lds + SSQ_LDS);
#pragma unroll
        for (int ai = 0; ai < 2; ++ai)
#pragma unroll
            for (int m = 0; m < 4; ++m) { const int row = row0 + ai * HALF + m * 16; float rs = 1.f;
                if (ssqp) { const PG8_LAS float* sp = sl + ((wr * 2 + ai) * 4) * 64 + m * 16 + fr; const float s = (sp[0] + sp[64]) + (sp[128] + sp[192]); rs = 1.0f / sqrtf(s * (1.0f / 1024.0f) + eps); }
                bf16_t* rowp = O + (size_t)row * ldc + col0;
#pragma unroll
                for (int bj = 0; bj < 2; ++bj) { const f32x4 v0 = acc[ai][bj][m][0] * rs, v1 = acc[ai][bj][m][1] * rs;
                    u32x4 w; w.x = cvt_pk_bf16(v0[0], v0[1]); w.y = cvt_pk_bf16(v0[2], v0[3]); w.z = cvt_pk_bf16(v1[0], v1[1]); w.w = cvt_pk_bf16(v1[2], v1[3]);
                    *(u32x4*)(rowp + bj * HALF) = w; } }
    }
};

__device__ __forceinline__ float gelu_tanh_f(float x) { const float u = 0.7978845608028654f * (x + 0.044715f * x * x * x); const float t = 1.0f - 2.0f / (1.0f + __expf(2.0f * u)); return 0.5f * x * (1.0f + t); }
struct EpiFfn {
    static constexpr bool PERM = true, AFTER_DRAIN = false;
    bf16_t* H; const float* ssqp; const float* cw; const float* cb; int Mtot; float eps;
    __device__ __forceinline__ void preload(PG8_LAS unsigned char* lds, const Unit& u, int wr, int wc, int lane) const {
        const int rowb = (u.pm / 17) * 4096 + 254 * (u.pm % 17) - 2;
#pragma unroll
        for (int ai = 0; ai < 2; ++ai) { const int row = rowb + ai * HALF + wr * 64 + lane; const int rc = row < 0 ? 0 : (row >= Mtot ? Mtot - 1 : row);
            __builtin_amdgcn_global_load_lds((const unsigned*)(ssqp + (size_t)wc * Mtot + rc), (PG8_LAS unsigned*)(lds + SSQ_LDS + (((wr * 2 + ai) * 4 + wc) * 64) * 4), 4, 0, 0); }
    }
    __device__ __forceinline__ void preload_unit(PG8_LAS unsigned char* lds, const Unit& u, int wr, int wc, int lane) const {
        const float* src = (wc < 3 ? cw + (size_t)wc * 2816 : cb) + u.pn * 128 + 64 * wr + lane;
        __builtin_amdgcn_global_load_lds((const unsigned*)src, (PG8_LAS unsigned*)(lds + CW_LDS + (wc * 128 + 64 * wr) * 4), 4, 0, 0);
    }
    __device__ __forceinline__ void operator()(f32x4 (&acc)[2][2][4][2], const Unit& u, int wr, int wc, int fr, int fq, PG8_LAS unsigned char* lds) const {
        constexpr int DFF_ = 2816;
        const int b = u.pm / 17, t = u.pm % 17, pos0 = 254 * t - 2, rowb = b * 4096 + pos0;
        const int colh = u.pn * 128 + wc * 32 + 8 * fq, lane = fq * 16 + fr;
        PG8_LAS float* halo = (PG8_LAS float*)(lds + STAGE_BYTES);
#pragma unroll
        for (int ai = 0; ai < 2; ++ai)
#pragma unroll
            for (int m = 0; m < 4; ++m) { const int rl = ai * HALF + wr * 64 + m * 16 + fr; const PG8_LAS float* sp = (const PG8_LAS float*)(lds + SSQ_LDS) + ((wr * 2 + ai) * 4) * 64 + m * 16 + fr;
                const float sq = (sp[0] + sp[64]) + (sp[128] + sp[192]); const float rs = 1.0f / sqrtf(sq * (1.0f / 1024.0f) + eps); const bool pad = (pos0 + rl) < 0;
#pragma unroll
                for (int n = 0; n < 2; ++n) {
#pragma unroll
                    for (int e = 0; e < 4; ++e) { acc[ai][0][m][n][e] = pad ? 0.f : acc[ai][0][m][n][e] * rs; acc[ai][1][m][n][e] *= rs; } } }
#pragma unroll
        for (int ai = 0; ai < 2; ++ai) if (fr >= 14) { PG8_LAS float* hp = halo + ((((2 * ai + wr) * 4 + wc) * 4 + fq) * 2 + (fr - 14)) * 8;
            *(PG8_LAS f32x4*)hp = acc[ai][0][3][0]; *(PG8_LAS f32x4*)(hp + 4) = acc[ai][0][3][1]; }
        asm volatile("s_waitcnt lgkmcnt(0)" ::: "memory"); __builtin_amdgcn_s_barrier(); asm volatile("" ::: "memory");
        typedef unsigned u32x2e __attribute__((ext_vector_type(2)));
#define DPPF(x, ctrl) __builtin_bit_cast(float, __builtin_amdgcn_update_dpp(0, __builtin_bit_cast(int, (x)), (ctrl), 0xf, 0xf, true))
#pragma unroll
        for (int n = 0; n < 2; ++n) {
            const PG8_LAS float* cwl = (const PG8_LAS float*)(lds + CW_LDS) + wc * 32 + 8 * fq + 4 * n;
            const f32x4 w0 = *(const PG8_LAS f32x4*)cwl, w1 = *(const PG8_LAS f32x4*)(cwl + 128), w2 = *(const PG8_LAS f32x4*)(cwl + 256), bb = *(const PG8_LAS f32x4*)(cwl + 384);
#pragma unroll
            for (int ai = 0; ai < 2; ++ai) {
                const int blk = 2 * ai + wr; f32x4 R1p = (f32x4){0.f, 0.f, 0.f, 0.f}, R2p = (f32x4){0.f, 0.f, 0.f, 0.f};
                if (blk >= 1) { const PG8_LAS float* hp = halo + ((((blk - 1) * 4 + wc) * 4 + fq) * 2) * 8 + 4 * n; const f32x4 h62 = *(const PG8_LAS f32x4*)hp, h63 = *(const PG8_LAS f32x4*)(hp + 8);
                    const f32x4 z4 = (f32x4){0.f, 0.f, 0.f, 0.f}; R1p = fr == 0 ? h63 : z4; R2p = fr == 0 ? h62 : (fr == 1 ? h63 : z4); }
#pragma unroll
                for (int m = 0; m < 4; ++m) { const int rl = ai * HALF + wr * 64 + m * 16 + fr; const bool ok = (rl >= 2) && (pos0 + rl < 4096);
                    float hv[4];
#pragma unroll
                    for (int e = 0; e < 4; ++e) { const float v = acc[ai][0][m][n][e];
                        const float p1 = DPPF(v, 0x111) + R1p[e], p2 = DPPF(v, 0x112) + R2p[e]; R1p[e] = DPPF(v, 0x10F); R2p[e] = DPPF(v, 0x10E);
                        const float y = w0[e] * p2 + (w1[e] * p1 + (w2[e] * v + bb[e]));
                        const float tq = y * (-2.302208198f + -0.10294324f * (y * y));
                        const float sg = __builtin_amdgcn_rcpf(1.0f + __builtin_amdgcn_exp2f(tq));
                        hv[e] = (y * acc[ai][1][m][n][e]) * sg; }
                    if (ok) { u32x2e w; w.x = cvt_pk_bf16(hv[0], hv[1]); w.y = cvt_pk_bf16(hv[2], hv[3]); *(u32x2e*)(H + (size_t)(rowb + rl) * DFF_ + colh + 4 * n) = w; } }
            }
        }
#undef DPPF
        asm volatile("s_waitcnt lgkmcnt(0)" ::: "memory"); __builtin_amdgcn_s_barrier(); asm volatile("" ::: "memory");
    }
};
struct EpiResid {
    static constexpr bool PERM = false, AFTER_DRAIN = true;
    const float* base; float* out; bf16_t* xb; float* ssqp; int ldc; int Mtot;
    __device__ __forceinline__ void init(f32x4 (&acc)[2][2][4][2], const Unit& u, int wr, int wc, int fr, int fq) const {
        const int col0 = u.pn * BM + wc * 32 + 4 * fq;
#pragma unroll
        for (int ai = 0; ai < 2; ++ai)
#pragma unroll
            for (int m = 0; m < 4; ++m) { const size_t off = (size_t)(u.pm * BM + ai * HALF + wr * 64 + m * 16 + fr) * ldc + col0;
#pragma unroll
                for (int bj = 0; bj < 2; ++bj)
#pragma unroll
                    for (int n = 0; n < 2; ++n) {
                        if (base) acc[ai][bj][m][n] = *(const f32x4*)(base + off + bj * HALF + n * 16);
                        else { typedef unsigned u32x2i __attribute__((ext_vector_type(2))); const u32x2i w = *(const u32x2i*)(xb + off + bj * HALF + n * 16);
                            acc[ai][bj][m][n] = (f32x4){__uint_as_float(w.x << 16), __uint_as_float(w.x & 0xffff0000u), __uint_as_float(w.y << 16), __uint_as_float(w.y & 0xffff0000u)}; } } }
    }
    __device__ __forceinline__ void fused(f32x4 (&acc)[2][2][4][2], const Unit& u, int wr, int wc, int fr, int fq, PG8_LAS unsigned char* lds, int wid, int lane) const {
        typedef unsigned u32x2v __attribute__((ext_vector_type(2)));
        PG8_LAS float* P = (PG8_LAS float*)lds;
        const int col0 = u.pn * BM + wc * 32 + 4 * fq;
#pragma unroll
        for (int ai = 0; ai < 2; ++ai)
#pragma unroll
            for (int m = 0; m < 4; ++m) { const int r = ai * HALF + wr * 64 + m * 16 + fr; const size_t off = (size_t)(u.pm * BM + r) * ldc + col0; float s = 0.f;
#pragma unroll
                for (int bj = 0; bj < 2; ++bj)
#pragma unroll
                    for (int n = 0; n < 2; ++n) { const f32x4 o = acc[ai][bj][m][n];
                        if (out) *(f32x4*)(out + off + bj * HALF + n * 16) = o; u32x2v w; w.x = cvt_pk_bf16(o[0], o[1]); w.y = cvt_pk_bf16(o[2], o[3]); *(u32x2v*)(xb + off + bj * HALF + n * 16) = w;
                        s += (o[0] * o[0] + o[1] * o[1]) + (o[2] * o[2] + o[3] * o[3]); }
                s += __shfl_xor(s, 16); s += __shfl_xor(s, 32);
                if (fq == 0) P[r * 4 + wc] = s;
                if (m & 1) asm volatile("" ::: "memory"); }
        asm volatile("s_waitcnt lgkmcnt(0)" ::: "memory"); __builtin_amdgcn_s_barrier(); asm volatile("" ::: "memory");
        if (lane < 32) { const int row = wid * 32 + lane; ssqp[(size_t)u.pn * Mtot + u.pm * BM + row] = (P[row * 4 + 0] + P[row * 4 + 1]) + (P[row * 4 + 2] + P[row * 4 + 3]); }
        asm volatile("s_waitcnt lgkmcnt(0)" ::: "memory"); __builtin_amdgcn_s_barrier(); asm volatile("" ::: "memory");
    }
};

template <class Epi, class Sched, bool ALIGN_EPI = false, bool SP2 = false>
__device__ __forceinline__ void gemm_phase(PG8_LAS unsigned char* lds, const Gemm g, const Sched& S, const Epi& E, int tid_in) {
    int tid_l = tid_in; asm volatile("" : "+v"(tid_l));
    const int tid = tid_l, wid = __builtin_amdgcn_readfirstlane(tid >> 6), lane = tid & 63, wr = wid >> 2, wc = wid & 3, fr = lane & 15, fq = lane >> 4;
    const int K = g.K, nt = K / BK;
    unsigned voffA[2], voffB[2];
#pragma unroll
    for (int i = 0; i < 2; ++i) { int R, C; stage_rc(tid * 16 + i * 8192, R, C); const int Rb = Epi::PERM ? ((R & ~31) + perm32(R & 31)) : R;
        voffA[i] = (unsigned)(R * g.lda + C) * 2u; voffB[i] = (unsigned)(Rb * K + C) * 2u; }
    const size_t kstep = (size_t)(BK * 2);
    const size_t hstepA = (size_t)HALF * g.lda * 2, hstepB = (size_t)HALF * K * 2;
    const size_t tstepB = 2 * hstepB;
    const unsigned ldsw = (unsigned)wid * 1024u;
    const int aoff = lds_byte(wr * 64 + fr, fq * 8), boff = lds_byte(wc * 32 + fr, fq * 8);
#define PG8_SA(b, h) (((b) * 2 + (h)) * HTB)
#define PG8_SB(b, h) ((4 + (b) * 2 + (h)) * HTB)
#define PG8_STAGE(bufoff, gbase, voff) do { _Pragma("unroll") for (int _i = 0; _i < 2; ++_i) \
        __builtin_amdgcn_global_load_lds((const unsigned*)((const char*)(gbase) + (voff)[_i]), (PG8_LAS unsigned*)(lds + (bufoff) + ldsw + _i * 8192), 16, 0, 0); } while (0)
#define PG8_LDA(dst, b, h) do { _Pragma("unroll") for (int m = 0; m < 4; ++m) _Pragma("unroll") for (int k = 0; k < 2; ++k) dst[m][k] = *(const PG8_LAS bf16x8*)(lds + PG8_SA(b, h) + aoff + m * 2048 + k * 1024); } while (0)
#define PG8_LDB(dst, b, h) do { _Pragma("unroll") for (int n = 0; n < 2; ++n) _Pragma("unroll") for (int k = 0; k < 2; ++k) dst[n][k] = *(const PG8_LAS bf16x8*)(lds + PG8_SB(b, h) + boff + n * 2048 + k * 1024); } while (0)
#define PG8_MMA(ai, bj, At, Bt) do { __builtin_amdgcn_s_setprio(1); _Pragma("unroll") for (int m = 0; m < 4; ++m) _Pragma("unroll") for (int n = 0; n < 2; ++n) _Pragma("unroll") for (int k = 0; k < 2; ++k) \
        acc[ai][bj][m][n] = __builtin_amdgcn_mfma_f32_16x16x32_bf16(Bt[n][k], At[m][k], acc[ai][bj][m][n], 0, 0, 0); __builtin_amdgcn_s_setprio(0); } while (0)
#define PG8_WAIT_V(n) asm volatile("s_waitcnt vmcnt(" #n ")" ::: "memory")
#define PG8_WAIT_L(n) asm volatile("s_waitcnt lgkmcnt(" #n ")" ::: "memory")
#define PG8_BAR __builtin_amdgcn_s_barrier()
#define PG8_SCHED __builtin_amdgcn_sched_barrier(0)
    Unit cur, nxt; int ui = 0;
    if (!S.next(0, cur)) return;
    f32x4 acc[2][2][4][2];
#pragma unroll
    for (int a = 0; a < 2; ++a)
#pragma unroll
        for (int b = 0; b < 2; ++b)
#pragma unroll
            for (int m = 0; m < 4; ++m)
#pragma unroll
                for (int n = 0; n < 2; ++n) acc[a][b][m][n] = (f32x4){0.f, 0.f, 0.f, 0.f};
    if constexpr (Epi::AFTER_DRAIN) E.init(acc, cur, wr, wc, fr, fq);
    bf16x8 At[4][2], B0[2][2], B1[2][2];
    const char* cA = (const char*)g.A + (ptrdiff_t)S.arow(cur) * (ptrdiff_t)(g.lda * 2); const char* cB = (const char*)g.Bt + (size_t)cur.pn * tstepB;
    S.a_ready(cur);
    if constexpr (!Epi::AFTER_DRAIN) E.preload_unit(lds, cur, wr, wc, lane);
    if constexpr (SP2) {
        PG8_STAGE(PG8_SB(0, 0), cB, voffB); PG8_STAGE(PG8_SB(0, 1), cB + hstepB, voffB); PG8_STAGE(PG8_SA(0, 0), cA, voffA); PG8_STAGE(PG8_SA(0, 1), cA + hstepA, voffA);
        if (wr == 1) PG8_BAR;
        PG8_WAIT_V(2); PG8_BAR;
        PG8_STAGE(PG8_SB(1, 0), cB + kstep, voffB); PG8_STAGE(PG8_SA(1, 0), cA + kstep, voffA); PG8_STAGE(PG8_SB(1, 1), cB + hstepB + kstep, voffB);
        PG8_WAIT_V(6); PG8_BAR;
        if constexpr (Epi::AFTER_DRAIN) {
#pragma unroll
            for (int a_ = 0; a_ < 2; ++a_)
#pragma unroll
                for (int b_ = 0; b_ < 2; ++b_) asm volatile("" : "+v"(acc[a_][b_][0][0]), "+v"(acc[a_][b_][0][1]), "+v"(acc[a_][b_][1][0]), "+v"(acc[a_][b_][1][1]), "+v"(acc[a_][b_][2][0]), "+v"(acc[a_][b_][2][1]), "+v"(acc[a_][b_][3][0]), "+v"(acc[a_][b_][3][1]));
        }
    } else {
        PG8_STAGE(PG8_SB(0, 0), cB, voffB); PG8_STAGE(PG8_SA(0, 0), cA, voffA); PG8_STAGE(PG8_SB(0, 1), cB + hstepB, voffB); PG8_STAGE(PG8_SA(0, 1), cA + hstepA, voffA);
        if (wr == 1) PG8_BAR;
        PG8_WAIT_V(4); PG8_BAR;
        PG8_STAGE(PG8_SB(1, 0), cB + kstep, voffB); PG8_STAGE(PG8_SA(1, 0), cA + kstep, voffA); PG8_STAGE(PG8_SB(1, 1), cB + hstepB + kstep, voffB);
        PG8_WAIT_V(6); PG8_BAR;
    }
    for (;;) {
        const bool has_next = S.next(ui + 1, nxt);
        const char* nA = has_next ? (const char*)g.A + (ptrdiff_t)S.arow(nxt) * (ptrdiff_t)(g.lda * 2) : cA; const char* nB = has_next ? (const char*)g.Bt + (size_t)nxt.pn * tstepB : cB;
        for (int t = 0; t < nt; t += 2) {
            const bool last = (t == nt - 2);
            const char* a1 = cA + (size_t)(t + 1) * kstep;
            const char* a2 = last ? nA : cA + (size_t)(t + 2) * kstep; const char* b2 = last ? nB : cB + (size_t)(t + 2) * kstep;
            const char* a3 = a2 + kstep; const char* b3 = b2 + kstep;
            if (last && has_next) S.a_ready(nxt);
            if constexpr (!Epi::AFTER_DRAIN) { if (last) E.preload(lds, cur, wr, wc, lane); }
            if constexpr (SP2) {
            PG8_LDB(B0, 0, 0); PG8_LDB(B1, 0, 1); PG8_SCHED; PG8_LDA(At, 0, 0); PG8_STAGE(PG8_SA(1, 1), a1 + hstepA, voffA);
            PG8_WAIT_V(8); PG8_WAIT_L(0); PG8_BAR; PG8_MMA(0, 0, At, B0); PG8_MMA(0, 1, At, B1); PG8_BAR; PG8_SCHED;
            PG8_LDA(At, 0, 1); PG8_STAGE(PG8_SB(0, 0), b2, voffB); PG8_STAGE(PG8_SB(0, 1), b2 + hstepB, voffB); PG8_STAGE(PG8_SA(0, 0), a2, voffA);
            PG8_WAIT_V(8); PG8_WAIT_L(0); PG8_BAR; PG8_MMA(1, 0, At, B0); PG8_MMA(1, 1, At, B1); PG8_BAR; PG8_SCHED;
            PG8_LDB(B0, 1, 0); PG8_LDB(B1, 1, 1); PG8_SCHED; PG8_LDA(At, 1, 0); PG8_STAGE(PG8_SA(0, 1), a2 + hstepA, voffA);
            PG8_WAIT_V(8); PG8_WAIT_L(0); PG8_BAR; PG8_MMA(0, 0, At, B0); PG8_MMA(0, 1, At, B1); PG8_BAR; PG8_SCHED;
            PG8_LDA(At, 1, 1); PG8_STAGE(PG8_SB(1, 0), b3, voffB); PG8_STAGE(PG8_SB(1, 1), b3 + hstepB, voffB); PG8_STAGE(PG8_SA(1, 0), a3, voffA);
            PG8_WAIT_V(8); PG8_WAIT_L(0); PG8_BAR; PG8_MMA(1, 0, At, B0); PG8_MMA(1, 1, At, B1); PG8_BAR; PG8_SCHED;
            } else {
            PG8_LDB(B0, 0, 0); PG8_SCHED; PG8_LDA(At, 0, 0); PG8_STAGE(PG8_SA(1, 1), a1 + hstepA, voffA);
            PG8_WAIT_L(8); PG8_BAR; PG8_WAIT_L(0); PG8_MMA(0, 0, At, B0); PG8_BAR; PG8_SCHED;
            PG8_LDB(B1, 0, 1); PG8_STAGE(PG8_SB(0, 0), b2, voffB);
            PG8_BAR; PG8_WAIT_L(0); PG8_MMA(0, 1, At, B1); PG8_BAR;
            PG8_LDA(At, 0, 1); PG8_STAGE(PG8_SA(0, 0), a2, voffA);
            PG8_BAR; PG8_WAIT_L(0); PG8_MMA(1, 0, At, B0); PG8_BAR; PG8_SCHED;
            PG8_STAGE(PG8_SB(0, 1), b2 + hstepB, voffB);
            PG8_WAIT_V(6); PG8_BAR; PG8_MMA(1, 1, At, B1); PG8_BAR;
            PG8_LDB(B0, 1, 0); PG8_SCHED; PG8_LDA(At, 1, 0); PG8_STAGE(PG8_SA(0, 1), a2 + hstepA, voffA);
            PG8_WAIT_L(8); PG8_BAR; PG8_WAIT_L(0); PG8_MMA(0, 0, At, B0); PG8_BAR; PG8_SCHED;
            PG8_LDB(B1, 1, 1); PG8_STAGE(PG8_SB(1, 0), b3, voffB);
            PG8_BAR; PG8_WAIT_L(0); PG8_MMA(0, 1, At, B1); PG8_BAR;
            PG8_LDA(At, 1, 1); PG8_STAGE(PG8_SA(1, 0), a3, voffA);
            PG8_BAR; PG8_WAIT_L(0); PG8_MMA(1, 0, At, B0); PG8_BAR; PG8_SCHED;
            PG8_STAGE(PG8_SB(1, 1), b3 + hstepB, voffB);
            PG8_WAIT_V(6); PG8_BAR; PG8_MMA(1, 1, At, B1); PG8_BAR;
            }
        }
        if constexpr (ALIGN_EPI) { if (wr == 0) PG8_BAR; }
        if constexpr (!Epi::AFTER_DRAIN) { E(acc, cur, wr, wc, fr, fq, lds); S.done(cur); if (has_next) E.preload_unit(lds, nxt, wr, wc, lane); }
        if (!has_next) break;
#pragma unroll
        for (int a = 0; a < 2; ++a)
#pragma unroll
            for (int b = 0; b < 2; ++b)
#pragma unroll
                for (int m = 0; m < 4; ++m)
#pragma unroll
                    for (int n = 0; n < 2; ++n) acc[a][b][m][n] = (f32x4){0.f, 0.f, 0.f, 0.f};
        cur = nxt; cA = nA; cB = nB; ++ui;
        if constexpr (ALIGN_EPI) { if (wr == 1) PG8_BAR; }
    }
    PG8_WAIT_V(0);
    if constexpr (!ALIGN_EPI) { if (wr == 0) PG8_BAR; }
    PG8_BAR;
    if constexpr (Epi::AFTER_DRAIN) { E.fused(acc, cur, wr, wc, fr, fq, lds, wid, lane); S.done(cur); }
#undef PG8_SA
#undef PG8_SB
#undef PG8_STAGE
#undef PG8_LDA
#undef PG8_LDB
#undef PG8_MMA
#undef PG8_WAIT_V
#undef PG8_WAIT_L
#undef PG8_BAR
#undef PG8_SCHED
}
}


#define GAS __attribute__((address_space(1)))
#define LAS __attribute__((address_space(3)))
typedef unsigned short bf16;
typedef unsigned v4u __attribute__((ext_vector_type(4)));
typedef unsigned v2u __attribute__((ext_vector_type(2)));
typedef float f32x4 __attribute__((ext_vector_type(4)));
constexpr int BATCH = 4, SEQ = 4096, D = 1024, M = BATCH * SEQ, NMEM = 256, MM = BATCH * NMEM, DFF = 2816;
constexpr int EV_IN = 4096, OD_IN = 3072;
constexpr float EPS = 1e-6f;
constexpr int Z_RQ = 0, Z_GQ = 512, Z_RK = 1024, Z_RV = 1536, Z_RG = 2048, Z_GF = 2560, Z_GI = 3072, Z_GG = 3584;

constexpr size_t MiB = 1u << 20;
constexpr size_t WS_CTL = 0;
constexpr size_t WS_EVIN = 1 * MiB, WS_EVOUT = 9 * MiB, WS_XQ0 = 11 * MiB, WS_XKV0 = 13 * MiB, WS_XO0 = 17 * MiB, WS_FIN0 = 19 * MiB, WS_FOUT0 = 30 * MiB;
constexpr size_t WS_ODIN = 36 * MiB, WS_ODOUT = 42 * MiB, WS_XQ1 = 44 * MiB, WS_XKV1 = 46 * MiB, WS_XO1 = 50 * MiB, WS_FIN1 = 52 * MiB, WS_FOUT1 = 63 * MiB;
constexpr size_t WS_XB = 69 * MiB;
constexpr size_t WS_MKV0 = 101 * MiB, WS_MKV1 = 105 * MiB;
constexpr size_t WS_MEMH0 = 109 * MiB, WS_MEMH1 = 111 * MiB;
constexpr size_t WS_SSQP = 113 * MiB;
constexpr size_t WS_LB = 113 * MiB + 512 * 1024;
constexpr size_t WS_BIAST = 113 * MiB + 516 * 1024;
constexpr size_t WS_GXA = 113 * MiB + 600 * 1024, WS_GOD = 113 * MiB + 604 * 1024;
constexpr size_t WS_DEN23 = 114 * MiB;
constexpr size_t WS_N2 = 1 * MiB;
constexpr size_t WS_ACT = 115 * MiB;
constexpr size_t WS_DECA = 243 * MiB, WS_DECB = 243 * MiB + 512 * 1024;
constexpr size_t WS_END = 256 * MiB;

__device__ __forceinline__ float bf2f(bf16 u) { return __uint_as_float((unsigned)u << 16); }
__device__ __forceinline__ unsigned f2bf(float f) { unsigned u = __builtin_bit_cast(unsigned, f); return (u + 0x7fffu + ((u >> 16) & 1u)) >> 16; }
__device__ __forceinline__ unsigned pk2(float lo, float hi) { return f2bf(lo) | (f2bf(hi) << 16); }
__device__ __forceinline__ float wave_sum(float v) {
#pragma unroll
    for (int o = 1; o < 64; o <<= 1) v += __shfl_xor(v, o);
    return v;
}
__device__ __forceinline__ float wave_max(float v) {
#pragma unroll
    for (int o = 1; o < 64; o <<= 1) v = fmaxf(v, __shfl_xor(v, o));
    return v;
}
__device__ __forceinline__ void unpack8(const v4u w, float (&f)[8]) {
    f[0] = __uint_as_float(w.x << 16); f[1] = __uint_as_float(w.x & 0xffff0000u); f[2] = __uint_as_float(w.y << 16); f[3] = __uint_as_float(w.y & 0xffff0000u);
    f[4] = __uint_as_float(w.z << 16); f[5] = __uint_as_float(w.z & 0xffff0000u); f[6] = __uint_as_float(w.w << 16); f[7] = __uint_as_float(w.w & 0xffff0000u);
}
__device__ __forceinline__ void rope_sincos(float a, float& s, float& c) {
    const float n = rintf(a * 0.15915494309189535f);
    float r = fmaf(-n, 6.2831854820251465f, a); r = fmaf(-n, -1.7484555e-7f, r);
    const float rev = r * 0.15915494309189535f;
    s = __builtin_amdgcn_sinf(rev); c = __builtin_amdgcn_cosf(rev);
}

__device__ __forceinline__ int dst_row_map(int mode, int n0) {
    if (mode == 1) { const int seg = n0 >> 9, within = n0 & 511; const int dseg = (seg == 0) ? 0 : (seg == 4 ? 1 : (seg < 4 ? seg + 1 : seg)); return dseg * 512 + within; }
    if (mode == 2) { return n0 < DFF ? (n0 >> 7) * 256 + (n0 & 127) : ((n0 - DFF) >> 7) * 256 + 128 + ((n0 - DFF) & 127); }
    return n0;
}
__device__ __forceinline__ void transpose_item(const float* W, int K, int N, const float* g, bf16* WT, int mode, LAS float* scr, int item, int lane) {
    const int nblk = N / 64, kb = item / nblk, nb = item % nblk, k0 = 64 * kb, n0 = 64 * nb, lr = lane >> 4, lc = lane & 15;
    f32x4 v[16];
#pragma unroll
    for (int i = 0; i < 16; ++i) v[i] = *(const f32x4*)(W + (size_t)(k0 + 4 * i + lr) * N + n0 + 4 * lc);
#pragma unroll
    for (int i = 0; i < 16; ++i) { const int kk = 4 * i + lr; const float gg = g ? g[k0 + kk] : 1.0f; LAS float* p = scr + kk * 65 + 4 * lc; p[0] = v[i][0] * gg; p[1] = v[i][1] * gg; p[2] = v[i][2] * gg; p[3] = v[i][3] * gg; }
    asm volatile("s_waitcnt lgkmcnt(0)" ::: "memory");
    const int c = lane & 7; const int d0 = dst_row_map(mode, n0);
#pragma unroll
    for (int j = 0; j < 8; ++j) { const int n = (lane >> 3) + 8 * j; const LAS float* sp = scr + (8 * c) * 65 + n;
        v4u o; o.x = pk2(sp[0 * 65], sp[1 * 65]); o.y = pk2(sp[2 * 65], sp[3 * 65]); o.z = pk2(sp[4 * 65], sp[5 * 65]); o.w = pk2(sp[6 * 65], sp[7 * 65]);
        *(v4u*)(WT + (size_t)(d0 + n) * K + k0 + 8 * c) = o; }
    asm volatile("s_waitcnt lgkmcnt(0)" ::: "memory");
}
struct ProArgs { const float* in[25]; unsigned char* ws; int layer_mask; int ffn_mode; };
#define CONVERT_JOB(Wp, K_, N_, gp, dst, mode) do { const int nitems = ((K_) / 64) * ((N_) / 64); for (int it = gw; it < nitems; it += NGW) transpose_item((Wp), (K_), (N_), (gp), (bf16*)(ws + (dst)), (mode), scr, it, lane); } while (0)
__device__ __forceinline__ void prologue_body(const ProArgs& a, int gw, int NGW, int lane, LAS float* scr) {
    unsigned char* ws = a.ws;
    const float* x = a.in[0]; const float* mem = a.in[1];
    if (a.layer_mask & 1) {
        CONVERT_JOB(a.in[3], D, EV_IN, a.in[2], WS_EVIN, 1);
        CONVERT_JOB(a.in[7], D, D, (const float*)nullptr, WS_EVOUT, 0);
        CONVERT_JOB(a.in[15], D, D, a.in[13], WS_XQ0, 0);
        CONVERT_JOB(a.in[16], D, 2 * D, (const float*)nullptr, WS_XKV0, 0);
        CONVERT_JOB(a.in[19], D, D, (const float*)nullptr, WS_XO0, 0);
        CONVERT_JOB(a.in[21], D, 2 * DFF, a.in[20], WS_FIN0, a.ffn_mode);
        CONVERT_JOB(a.in[24], DFF, D, (const float*)nullptr, WS_FOUT0, 0);
        for (int m = 2 * gw; m < M; m += 2 * NGW) {
            const f32x4* xr = (const f32x4*)(x + (size_t)m * D) + lane; v2u* o8 = (v2u*)((bf16*)(ws + WS_XB) + (size_t)m * D) + lane; float* sp = (float*)(ws + WS_SSQP);
            f32x4 v[8];
#pragma unroll
            for (int j = 0; j < 8; ++j) v[j] = xr[64 * j];
#pragma unroll
            for (int j = 0; j < 8; ++j) { v2u w; w.x = pk2(v[j][0], v[j][1]); w.y = pk2(v[j][2], v[j][3]); o8[64 * j] = w;
                const float s2 = wave_sum((v[j][0] * v[j][0] + v[j][1] * v[j][1]) + (v[j][2] * v[j][2] + v[j][3] * v[j][3])); if (lane == 0) sp[(size_t)(j & 3) * M + m + (j >> 2)] = s2; }
        }
        for (int r = gw; r < 2 * MM; r += NGW) { const int l = r / MM, m = r % MM;
            const f32x4* xr = (const f32x4*)(mem + (size_t)m * D) + lane; const f32x4* gr = (const f32x4*)(a.in[14] + (size_t)l * D) + lane;
            f32x4 v[4]; float s = 0.f;
#pragma unroll
            for (int j = 0; j < 4; ++j) { v[j] = xr[64 * j]; s += (v[j][0] * v[j][0] + v[j][1] * v[j][1]) + (v[j][2] * v[j][2] + v[j][3] * v[j][3]); }
            const float rs = 1.0f / sqrtf(wave_sum(s) * (1.0f / D) + EPS);
            v2u* o8 = (v2u*)((bf16*)(ws + (l ? WS_MEMH1 : WS_MEMH0)) + (size_t)m * D) + lane;
#pragma unroll
            for (int j = 0; j < 4; ++j) { const f32x4 g = gr[64 * j]; v2u w; w.x = pk2(v[j][0] * rs * g[0], v[j][1] * rs * g[1]); w.y = pk2(v[j][2] * rs * g[2], v[j][3] * rs * g[3]); o8[64 * j] = w; }
        }
        if (gw == 0) {
            const float* lg = a.in[6]; float* lb = (float*)(ws + WS_LB);
            for (int c = lane; c < 512; c += 64) { const float a0 = lg[c], a1 = lg[512 + c], a2 = lg[1024 + c]; const float mx = fmaxf(a0, fmaxf(a1, a2));
                const float e0 = expf(a0 - mx), e1 = expf(a1 - mx), e2 = expf(a2 - mx); lb[c] = e0 / (e0 + e1 + e2); }
        }
        if (gw == 2) {
            float* gx = (float*)(ws + WS_GXA); float* go = (float*)(ws + WS_GOD);
            for (int i = lane; i < 512; i += 64) gx[i] = a.in[18][i] * a.in[17][i];
            for (int i = lane; i < 128; i += 64) go[i] = a.in[10][i] * a.in[9][i];
        }
        if (gw == 1) {
            const float* rb = a.in[11]; float* bt = (float*)(ws + WS_BIAST);
            for (int i = lane; i < 3 * 8 * 132; i += 64) { const int br = i / (8 * 132), h = (i / 132) % 8, dl = i % 132; const int d = dl * (1 << (2 * br));
                int bucket; if (d < 16) bucket = d; else { const float lr = logf((float)d / 16.0f) / 4.852030263919617f; int lg2 = 16 + (int)(lr * 16.0f); bucket = lg2 < 31 ? lg2 : 31; }
                bt[i] = (dl <= 128) ? rb[bucket * 8 + h] : 0.f; }
        }
    }
    if (a.layer_mask & 2) {
        CONVERT_JOB(a.in[8], D, OD_IN, a.in[2] + D, WS_ODIN, 0);
        CONVERT_JOB(a.in[12], D, D, (const float*)nullptr, WS_ODOUT, 0);
        CONVERT_JOB(a.in[15] + (size_t)D * D, D, D, a.in[13] + D, WS_XQ1, 0);
        CONVERT_JOB(a.in[16] + (size_t)D * 2 * D, D, 2 * D, (const float*)nullptr, WS_XKV1, 0);
        CONVERT_JOB(a.in[19] + (size_t)D * D, D, D, (const float*)nullptr, WS_XO1, 0);
        CONVERT_JOB(a.in[21] + (size_t)D * 2 * DFF, D, 2 * DFF, a.in[20] + D, WS_FIN1, a.ffn_mode);
        CONVERT_JOB(a.in[24] + (size_t)DFF * D, DFF, D, (const float*)nullptr, WS_FOUT1, 0);
    }
}


typedef short bf16x8 __attribute__((ext_vector_type(8)));
typedef short s16x4 __attribute__((ext_vector_type(4)));
typedef float f32x16 __attribute__((ext_vector_type(16)));
typedef float f32x2_t __attribute__((ext_vector_type(2))); typedef __bf16 bf16x2_t __attribute__((ext_vector_type(2)));
typedef short v4i16_t __attribute__((ext_vector_type(4)));
#define MFMA32(a, b, c) __builtin_amdgcn_mfma_f32_32x32x16_bf16((a), (b), (c), 0, 0, 0)
__device__ __forceinline__ unsigned cvtpk(float lo, float hi) { f32x2_t v = {lo, hi}; bf16x2_t b = __builtin_convertvector(v, bf16x2_t); return __builtin_bit_cast(unsigned, b); }
__device__ __forceinline__ bf16x8 pack8(float a0, float a1, float a2, float a3, float a4, float a5, float a6, float a7) {
    v4u p; p.x = cvtpk(a0, a1); p.y = cvtpk(a2, a3); p.z = cvtpk(a4, a5); p.w = cvtpk(a6, a7); return __builtin_bit_cast(bf16x8, p); }
__device__ __forceinline__ s16x4 vtr(const LAS char* p) { return __builtin_bit_cast(s16x4, __builtin_amdgcn_ds_read_tr16_b64_v4i16((LAS v4i16_t*)p)); }
__device__ __forceinline__ int tr_lane_base(int lane, int stride) { const int g = lane >> 4, i = lane & 15, q = i >> 2, p = i & 3, h2 = g >> 1; return (4 * h2 + q) * stride + (16 * (g & 1) + 4 * p) * 2; }
__device__ __forceinline__ bf16x8 tr_frag_perm(const LAS char* img, int stride, int lbase, int k0, int n0) {
    const LAS char* p = img + lbase + k0 * stride + n0 * 2;
    const s16x4 lo = vtr(p), hi = vtr(p + 8 * stride);
    return (bf16x8){lo[0], lo[1], lo[2], lo[3], hi[0], hi[1], hi[2], hi[3]};
}
__device__ __forceinline__ int tr_lane_base_nat(int lane, int stride) { const int g = lane >> 4, i = lane & 15, q = i >> 2, p = i & 3, h2 = g >> 1; return (8 * h2 + q) * stride + (16 * (g & 1) + 4 * p) * 2; }
__device__ __forceinline__ bf16x8 tr_frag_nat(const LAS char* img, int stride, int lbase, int k0, int n0) {
    const LAS char* p = img + lbase + k0 * stride + n0 * 2;
    const s16x4 lo = vtr(p), hi = vtr(p + 4 * stride);
    return (bf16x8){lo[0], lo[1], lo[2], lo[3], hi[0], hi[1], hi[2], hi[3]};
}

constexpr int XA_STRIDE = 528, XA_VSTRIDE = 576;
constexpr int XA_LDS = 256 * XA_STRIDE;
template <bool Q_IN_LDS> __device__ __forceinline__ void xattn_unit(LAS char* lds, const bf16* __restrict__ Q, const bf16* __restrict__ MKV, const float* __restrict__ gkq, bf16* __restrict__ O, int unit, int tid) {
    const int lane = tid & 63, w = __builtin_amdgcn_readfirstlane(tid >> 6), r = lane & 31, h2 = lane >> 5;
    const int rb = unit >> 2, h = unit & 3, row0 = rb * 256, b = row0 / SEQ;
    const bf16* Kg = MKV + (size_t)(b * NMEM) * 2048 + h * 256; const bf16* Vg = Kg + 1024;
    v4u st[16];
#pragma unroll
    for (int i = 0; i < 16; ++i) { const int id = tid + 512 * i; st[i] = *(const v4u*)(Kg + (size_t)(id >> 5) * 2048 + (id & 31) * 8); }
    const size_t qoff = (size_t)(row0 + 32 * w + r) * D + h * 256;
    bf16x8 qf[16];
    if (Q_IN_LDS) {
#pragma unroll
        for (int s = 0; s < 16; ++s) qf[s] = *(const LAS bf16x8*)(lds + (32 * w + r) * XA_STRIDE + h2 * 16 + s * 32);
        asm volatile("s_waitcnt lgkmcnt(0)" ::: "memory"); __builtin_amdgcn_s_barrier(); asm volatile("" ::: "memory");
    } else {
#pragma unroll
        for (int s = 0; s < 16; ++s) qf[s] = *(const bf16x8*)(Q + qoff + 8 * h2 + 16 * s);
    }
    { float gk8[8];
#pragma unroll
      for (int e = 0; e < 8; ++e) gk8[e] = gkq[(tid & 31) * 8 + e];
#pragma unroll
      for (int i = 0; i < 16; ++i) { const int id = tid + 512 * i; float f[8]; unpack8(st[i], f);
          float sq = (f[0] * f[0] + f[1] * f[1]) + (f[2] * f[2] + f[3] * f[3]) + (f[4] * f[4] + f[5] * f[5]) + (f[6] * f[6] + f[7] * f[7]);
          sq += __shfl_xor(sq, 1); sq += __shfl_xor(sq, 2); sq += __shfl_xor(sq, 4); sq += __shfl_xor(sq, 8); sq += __shfl_xor(sq, 16);
          const float rk = 1.0f / sqrtf(sq * (1.0f / 256.0f) + EPS) * 0.0625f;
          v4u o; o.x = cvtpk(f[0] * rk * gk8[0], f[1] * rk * gk8[1]); o.y = cvtpk(f[2] * rk * gk8[2], f[3] * rk * gk8[3]); o.z = cvtpk(f[4] * rk * gk8[4], f[5] * rk * gk8[5]); o.w = cvtpk(f[6] * rk * gk8[6], f[7] * rk * gk8[7]);
          *(LAS v4u*)(lds + (id >> 5) * XA_STRIDE + (id & 31) * 16) = o; } }
    float ss = 0.f;
#pragma unroll
    for (int s = 0; s < 16; ++s)
#pragma unroll
        for (int j = 0; j < 8; ++j) { const float x = __uint_as_float((unsigned)(unsigned short)qf[s][j] << 16); ss += x * x; }
    ss += __shfl_xor(ss, 32);
    const float rsl = 1.0f / sqrtf(ss * (1.0f / 256.0f) + EPS) * 1.4426950408889634f;
    __syncthreads();
    bf16x8 pf[8][2]; float den = 0.f;
#pragma unroll
    for (int kb = 0; kb < 8; ++kb) {
        f32x16 acc;
#pragma unroll
        for (int i = 0; i < 16; ++i) acc[i] = 0.f;
        const LAS char* kp = lds + (32 * kb + r) * XA_STRIDE + h2 * 16;
#pragma unroll
        for (int s = 0; s < 16; ++s) { const bf16x8 a = *(const LAS bf16x8*)(kp + s * 32); acc = MFMA32(a, qf[s], acc); }
        float p[16];
#pragma unroll
        for (int i = 0; i < 16; ++i) { p[i] = __builtin_amdgcn_exp2f(acc[i] * rsl - 11.541560327111707f); den += p[i]; }
        pf[kb][0] = pack8(p[0], p[1], p[2], p[3], p[4], p[5], p[6], p[7]); pf[kb][1] = pack8(p[8], p[9], p[10], p[11], p[12], p[13], p[14], p[15]);
    }
    den += __shfl_xor(den, 32);
    const float inv = 1.0f / den;
    __syncthreads();
#pragma unroll
    for (int i = 0; i < 16; ++i) { const int id = tid + 512 * i; st[i] = *(const v4u*)(Vg + (size_t)(id >> 5) * 2048 + (id & 31) * 8); }
#pragma unroll
    for (int i = 0; i < 16; ++i) { const int id = tid + 512 * i; *(LAS v4u*)(lds + (id >> 5) * XA_VSTRIDE + (id & 31) * 16) = st[i]; }
    __syncthreads();
    const int lbase = tr_lane_base(lane, XA_VSTRIDE);
#pragma unroll
    for (int half = 0; half < 2; ++half) {
        f32x16 o[4];
#pragma unroll
        for (int vb = 0; vb < 4; ++vb)
#pragma unroll
            for (int i = 0; i < 16; ++i) o[vb][i] = 0.f;
#pragma unroll
        for (int kb = 0; kb < 8; ++kb)
#pragma unroll
            for (int s = 0; s < 2; ++s)
#pragma unroll
                for (int vb = 0; vb < 4; ++vb) { const bf16x8 a = tr_frag_perm(lds, XA_VSTRIDE, lbase, 32 * kb + 16 * s, 128 * half + 32 * vb); o[vb] = MFMA32(a, pf[kb][s], o[vb]); }
        bf16* orow = O + qoff + 128 * half + 4 * h2;
#pragma unroll
        for (int vb = 0; vb < 4; ++vb)
#pragma unroll
            for (int g4 = 0; g4 < 4; ++g4) { v2u wv; wv.x = cvtpk(o[vb][4 * g4] * inv, o[vb][4 * g4 + 1] * inv); wv.y = cvtpk(o[vb][4 * g4 + 2] * inv, o[vb][4 * g4 + 3] * inv);
                *(v2u*)(orow + 32 * vb + 8 * g4) = wv; }
    }
    __syncthreads();
}


struct EpiXattn {
    static constexpr bool PERM = true, AFTER_DRAIN = true;
    struct Pre { int unused; };
    const bf16* MKV; const float* gkq; bf16* O;
    __device__ __forceinline__ void init(f32x4 (&)[2][2][4][2], const pg8::Unit&, int, int, int, int) const {}
    __device__ __forceinline__ void fused(f32x4 (&acc)[2][2][4][2], const pg8::Unit& u, int wr, int wc, int fr, int fq, LAS unsigned char* lds, int wid, int lane) const {
#pragma unroll
        for (int ai = 0; ai < 2; ++ai)
#pragma unroll
            for (int m = 0; m < 4; ++m) { const int row = ai * 128 + wr * 64 + m * 16 + fr;
#pragma unroll
                for (int bj = 0; bj < 2; ++bj) { const f32x4 v0 = acc[ai][bj][m][0], v1 = acc[ai][bj][m][1];
                    v4u o; o.x = cvtpk(v0[0], v0[1]); o.y = cvtpk(v0[2], v0[3]); o.z = cvtpk(v1[0], v1[1]); o.w = cvtpk(v1[2], v1[3]);
                    *(LAS v4u*)(lds + row * XA_STRIDE + (bj * 128 + wc * 32 + 8 * fq) * 2) = o; } }
        asm volatile("s_waitcnt lgkmcnt(0)" ::: "memory"); __builtin_amdgcn_s_barrier(); asm volatile("" ::: "memory");
    }
};

constexpr int DA_STRIDE = 272, DA_VSTRIDE = 320, DA_LDS_BIAS = 384 * DA_VSTRIDE;
struct DaArgs { const bf16* QKV; const float* biasT; const float* gkq; bf16* N0; float* DEN0; const bf16* N1; const float* DEN1; const bf16* N2; const float* DEN2; bf16* O; int br0; int nbr; int mode; int pad; };
#define LDS_BARRIER() do { asm volatile("s_waitcnt lgkmcnt(0)" ::: "memory"); __builtin_amdgcn_s_barrier(); asm volatile("" ::: "memory"); } while (0)
struct DaUnit { int br, b, h, dil, cls, l0; };
template <int MODE> __device__ __forceinline__ DaUnit da_decode(int uu) {
    DaUnit U; U.br = MODE == 0 ? __builtin_amdgcn_readfirstlane(1 + (uu >> 9)) : 0; const int rem = __builtin_amdgcn_readfirstlane(uu & 511), x = rem & 15; U.b = rem >> 7; U.h = (rem >> 4) & 7; U.dil = 1 << (2 * U.br);
    U.cls = U.br == 0 ? 0 : (U.br == 1 ? (x & 3) : x); U.l0 = 256 * (U.br == 0 ? x : (U.br == 1 ? (x >> 2) : 0)); return U; }
__device__ __forceinline__ void da_load_rows(v4u (&st)[12], const bf16* QKV, const DaUnit& U, int col, int tid) {
    const bf16* base = QKV + (size_t)(U.b * SEQ) * OD_IN + U.h * 128 + col + (tid & 15) * 8;
#pragma unroll
    for (int i = 0; i < 12; ++i) { const int ki = (tid >> 4) + 32 * i, lk = U.l0 - 128 + ki, lkc = lk < 0 ? 0 : lk; st[i] = *(const v4u*)(base + (size_t)(lkc * U.dil + U.cls) * OD_IN); }
}
template <int MODE> __device__ __forceinline__ void dattn_phase(LAS char* lds, const DaArgs& a, int bx, int G, int tid) {
    constexpr int NUNITS = MODE == 0 ? 1024 : 512;
    const int lane = tid & 63, w = __builtin_amdgcn_readfirstlane(tid >> 6), r = lane & 31, h2 = lane >> 5;
    int uu = bx; if (uu >= NUNITS) return;
    v4u st[12];
    { const DaUnit U0 = da_decode<MODE>(uu); da_load_rows(st, a.QKV, U0, 1024, tid); }
    LAS float* lbias = (LAS float*)(lds + DA_LDS_BIAS);
    const int lbase = tr_lane_base(lane, DA_VSTRIDE);
    for (;;) {
        const DaUnit U = da_decode<MODE>(uu);
        const int l0 = U.l0, h = U.h; const bool zfirst = (l0 == 0);
        int r_l = r; asm volatile("" : "+v"(r_l));
        float gk8[8];
#pragma unroll
        for (int e = 0; e < 8; ++e) gk8[e] = a.gkq[(tid & 15) * 8 + e];
        const size_t qrow = (size_t)(U.b * SEQ + (l0 + 32 * w + r) * U.dil + U.cls);
#pragma unroll
        for (int i = 0; i < 12; ++i) { float f_[8]; unpack8((i < 4 && zfirst) ? (v4u){0u, 0u, 0u, 0u} : st[i], f_);
            float sq_ = (f_[0] * f_[0] + f_[1] * f_[1]) + (f_[2] * f_[2] + f_[3] * f_[3]) + (f_[4] * f_[4] + f_[5] * f_[5]) + (f_[6] * f_[6] + f_[7] * f_[7]);
            sq_ += __shfl_xor(sq_, 1); sq_ += __shfl_xor(sq_, 2); sq_ += __shfl_xor(sq_, 4); sq_ += __shfl_xor(sq_, 8);
            const float rk_ = 1.0f / sqrtf(sq_ * (1.0f / 128.0f) + EPS) * 0.08838834764831845f;
            v4u o_; o_.x = cvtpk(f_[0] * rk_ * gk8[0], f_[1] * rk_ * gk8[1]); o_.y = cvtpk(f_[2] * rk_ * gk8[2], f_[3] * rk_ * gk8[3]); o_.z = cvtpk(f_[4] * rk_ * gk8[4], f_[5] * rk_ * gk8[5]); o_.w = cvtpk(f_[6] * rk_ * gk8[6], f_[7] * rk_ * gk8[7]);
            *(LAS v4u*)(lds + ((tid >> 4) + 32 * i) * DA_STRIDE + (tid & 15) * 16) = o_; }
        if (tid < 192) { const int dl = tid - 32; lbias[tid] = (dl >= 0 && dl <= 128) ? a.biasT[(U.br * 8 + h) * 132 + dl] * 1.4426950408889634f - 11.541560327111707f : -__builtin_inff(); }
        asm volatile("" ::: "memory");
        bf16x8 qf[8];
#pragma unroll
        for (int s = 0; s < 8; ++s) qf[s] = *(const bf16x8*)(a.QKV + qrow * OD_IN + h * 128 + 8 * h2 + 16 * s);
        da_load_rows(st, a.QKV, U, 2048, tid);
        float ss = 0.f;
#pragma unroll
        for (int s = 0; s < 8; ++s)
#pragma unroll
            for (int j = 0; j < 8; ++j) { const float xq = __uint_as_float((unsigned)(unsigned short)qf[s][j] << 16); ss += xq * xq; }
        ss += __shfl_xor(ss, 32);
        const float rsl = 1.0f / sqrtf(ss * (1.0f / 128.0f) + EPS) * 1.4426950408889634f;
        LDS_BARRIER();
        bf16x8 pf[5][2]; float den = 0.f;
#pragma unroll
        for (int kbi = 0; kbi < 5; ++kbi) {
            if (zfirst && w + kbi < 4) { pf[kbi][0] = (bf16x8){0, 0, 0, 0, 0, 0, 0, 0}; pf[kbi][1] = pf[kbi][0]; continue; }
            f32x16 acc;
#pragma unroll
            for (int i = 0; i < 16; ++i) acc[i] = 0.f;
            const LAS char* kp = lds + (32 * (w + kbi) + r) * DA_STRIDE + h2 * 16;
#pragma unroll
            for (int s = 0; s < 8; ++s) { const bf16x8 av = *(const LAS bf16x8*)(kp + s * 32); acc = MFMA32(av, qf[s], acc); }
            __builtin_amdgcn_sched_barrier(0);
            const LAS float* tb = lbias + (r_l - 4 * h2);
#pragma unroll
            for (int hh = 0; hh < 2; ++hh) { float p[8];
#pragma unroll
                for (int i8 = 0; i8 < 8; ++i8) { const int i = 8 * hh + i8;
                    p[i8] = __builtin_amdgcn_exp2f(acc[i] * rsl + tb[160 - 32 * kbi - ((i & 3) + 8 * (i >> 2))]); den += p[i8]; }
                pf[kbi][hh] = pack8(p[0], p[1], p[2], p[3], p[4], p[5], p[6], p[7]);
                __builtin_amdgcn_sched_barrier(0); }
            asm volatile("" ::: "memory");
        }
        den += __shfl_xor(den, 32);
        LDS_BARRIER();
#pragma unroll
        for (int i = 0; i < 12; ++i) *(LAS v4u*)(lds + ((tid >> 4) + 32 * i) * DA_VSTRIDE + (tid & 15) * 16) = (i < 4 && zfirst) ? (v4u){0u, 0u, 0u, 0u} : st[i];
        LDS_BARRIER();
        const int un = uu + G; const bool more = un < NUNITS; const DaUnit Un = da_decode<MODE>(more ? un : uu);
        if (more) da_load_rows(st, a.QKV, Un, 1024, tid);
        const size_t ooff = qrow * D + h * 128 + 4 * h2;
        float inv = 1.0f;
        if (MODE == 0) { if (h2 == 0) ((float*)(U.br == 1 ? a.DEN1 : a.DEN2))[qrow * 8 + h] = den; }
        else { inv = 1.0f / (den + a.DEN1[qrow * 8 + h] + a.DEN2[qrow * 8 + h]); }
#pragma unroll
        for (int half = 0; half < 2; ++half) {
            f32x16 o[2];
#pragma unroll
            for (int vb = 0; vb < 2; ++vb)
#pragma unroll
                for (int i = 0; i < 16; ++i) o[vb][i] = 0.f;
#pragma unroll
            for (int kbi = 0; kbi < 5; ++kbi)
#pragma unroll
                for (int s = 0; s < 2; ++s)
#pragma unroll
                    for (int vb = 0; vb < 2; ++vb) { const bf16x8 av = tr_frag_perm(lds, DA_VSTRIDE, lbase, 32 * (w + kbi) + 16 * s, 64 * half + 32 * vb); o[vb] = MFMA32(av, pf[kbi][s], o[vb]); }
            if (MODE == 0) {
                bf16* N = (bf16*)(U.br == 1 ? a.N1 : a.N2) + ooff + 64 * half;
#pragma unroll
                for (int vb = 0; vb < 2; ++vb)
#pragma unroll
                    for (int g4 = 0; g4 < 4; ++g4) { v2u wv; wv.x = cvtpk(o[vb][4 * g4], o[vb][4 * g4 + 1]); wv.y = cvtpk(o[vb][4 * g4 + 2], o[vb][4 * g4 + 3]); *(v2u*)(N + 32 * vb + 8 * g4) = wv; }
            } else {
                const bf16* N1 = a.N1 + ooff + 64 * half; const bf16* N2 = a.N2 + ooff + 64 * half; bf16* Op = a.O + ooff + 64 * half;
#pragma unroll
                for (int vb = 0; vb < 2; ++vb)
#pragma unroll
                    for (int g4 = 0; g4 < 4; ++g4) { const v2u n1 = *(const v2u*)(N1 + 32 * vb + 8 * g4), n2 = *(const v2u*)(N2 + 32 * vb + 8 * g4);
                        const float x0 = o[vb][4 * g4] + __uint_as_float(n1.x << 16) + __uint_as_float(n2.x << 16), x1 = o[vb][4 * g4 + 1] + __uint_as_float(n1.x & 0xffff0000u) + __uint_as_float(n2.x & 0xffff0000u);
                        const float x2 = o[vb][4 * g4 + 2] + __uint_as_float(n1.y << 16) + __uint_as_float(n2.y << 16), x3 = o[vb][4 * g4 + 3] + __uint_as_float(n1.y & 0xffff0000u) + __uint_as_float(n2.y & 0xffff0000u);
                        v2u wv; wv.x = cvtpk(x0 * inv, x1 * inv); wv.y = cvtpk(x2 * inv, x3 * inv); *(v2u*)(Op + 32 * vb + 8 * g4) = wv; }
            }
            asm volatile("" ::: "memory");
        }
        LDS_BARRIER();
        if (!more) break;
        uu = un;
    }
}

constexpr int MX_STRIDE = 272, MX_TSTRIDE = 320, MX_IMG = 128 * MX_TSTRIDE;
constexpr int MX_Q = 0, MX_K = MX_IMG, MX_V = 2 * MX_IMG, MX_SCR = 3 * MX_IMG;
struct MixArgs { bf16* Z; const float* lb; const float* ret_g; const float* hg_g; bf16* SBUF; float* DECA; float* DECB; };

__device__ __forceinline__ void st_chunk8(LAS char* img, int stride, int row, int c0, const float (&f)[8]) {
    v4u o; o.x = cvtpk(f[0], f[1]); o.y = cvtpk(f[2], f[3]); o.z = cvtpk(f[4], f[5]); o.w = cvtpk(f[6], f[7]); *(LAS v4u*)(img + row * stride + c0 * 2) = o; }

__device__ __forceinline__ void ret_prep_tile(LAS char* img, int stride, const bf16* zrow  , int j, int cg, const float (&sn)[16], const float (&cs)[16], float sc) {
#pragma unroll
    for (int hc = 0; hc < 2; ++hc) { float x1[8], x2[8], o1[8], o2[8];
        unpack8(*(const v4u*)(zrow + 16 * cg + 8 * hc), x1); unpack8(*(const v4u*)(zrow + 64 + 16 * cg + 8 * hc), x2);
#pragma unroll
        for (int e = 0; e < 8; ++e) { o1[e] = (x1[e] * cs[8 * hc + e] - x2[e] * sn[8 * hc + e]) * sc; o2[e] = (x1[e] * sn[8 * hc + e] + x2[e] * cs[8 * hc + e]) * sc; }
        st_chunk8(img, stride, j, 16 * cg + 8 * hc, o1); st_chunk8(img, stride, j, 64 + 16 * cg + 8 * hc, o2); }
}
__device__ __forceinline__ void copy_tile(LAS char* img, int stride, const bf16* src, int tid) {
#pragma unroll
    for (int i = 0; i < 4; ++i) { const int id = tid + 512 * i, row = id >> 4, ch = id & 15; *(LAS v4u*)(img + row * stride + ch * 16) = *(const v4u*)(src + (size_t)row * EV_IN + ch * 8); }
}
__device__ __forceinline__ void hg_gates(const bf16* zrow_f  , const float* lbh  , int tid, LAS float* scr, float (&cum)[32], float (&kk)[32]) {
    const int lane = tid & 63, hw = (tid >> 6) & 1, cg = tid >> 7;
#pragma unroll
    for (int q = 0; q < 4; ++q) { float fl[8]; unpack8(*(const v4u*)(zrow_f + 32 * cg + 8 * q), fl);
#pragma unroll
        for (int e = 0; e < 8; ++e) { const float l = lbh[32 * cg + 8 * q + e]; const float f = l + (1.0f - l) * (1.0f / (1.0f + __expf(-fl[e]))); kk[8 * q + e] = 1.0f - f; cum[8 * q + e] = __logf(fmaxf(f, 1e-6f)); } }
#pragma unroll
    for (int off = 1; off < 64; off <<= 1) {
#pragma unroll
        for (int c = 0; c < 32; ++c) { const float t = __shfl_up(cum[c], off); if (lane >= off) cum[c] += t; } }
    if (hw == 0 && lane == 63) {
#pragma unroll
        for (int c = 0; c < 32; ++c) scr[32 * cg + c] = cum[c]; }
    __syncthreads();
    if (hw == 1) {
#pragma unroll
        for (int c = 0; c < 32; ++c) cum[c] += scr[32 * cg + c]; }
    if (hw == 1 && lane == 63) {
#pragma unroll
        for (int c = 0; c < 32; ++c) scr[128 + 32 * cg + c] = cum[c]; }
    __syncthreads();
}

__device__ __forceinline__ void load_prep4(v4u (&rw)[4], const bf16* zrow_seg, int mixer, int cg) {
#pragma unroll
    for (int q = 0; q < 4; ++q) { const int col = mixer == 0 ? ((q >> 1) * 64 + 16 * cg + 8 * (q & 1)) : (32 * cg + 8 * q); rw[q] = *(const v4u*)(zrow_seg + col); }
}
__device__ __forceinline__ void load_copy4(v4u (&rw)[4], const bf16* tile, int tid) {
#pragma unroll
    for (int i = 0; i < 4; ++i) { const int id = tid + 512 * i; rw[i] = *(const v4u*)(tile + (size_t)(id >> 4) * EV_IN + (id & 15) * 8); }
}
__device__ __forceinline__ void store_copy4(LAS char* img, int stride, const v4u (&rw)[4], int tid) {
#pragma unroll
    for (int i = 0; i < 4; ++i) { const int id = tid + 512 * i; *(LAS v4u*)(img + (id >> 4) * stride + (id & 15) * 16) = rw[i]; }
}
__device__ __forceinline__ void ret_prep_raw(LAS char* img, int stride, const v4u (&rw)[4], int j, int cg, const float (&sn)[16], const float (&cs)[16], float sc) {
#pragma unroll
    for (int hc = 0; hc < 2; ++hc) { float x1[8], x2[8], o1[8], o2[8]; unpack8(rw[hc], x1); unpack8(rw[2 + hc], x2);
#pragma unroll
        for (int e = 0; e < 8; ++e) { o1[e] = (x1[e] * cs[8 * hc + e] - x2[e] * sn[8 * hc + e]) * sc; o2[e] = (x1[e] * sn[8 * hc + e] + x2[e] * cs[8 * hc + e]) * sc; }
        st_chunk8(img, stride, j, 16 * cg + 8 * hc, o1); st_chunk8(img, stride, j, 64 + 16 * cg + 8 * hc, o2); }
}
__device__ __forceinline__ void hg_gates_raw(const v4u (&rw)[4], const float* lbh, int tid, LAS float* scr, float (&cum)[32], float (&kk)[32]) {
    const int lane = tid & 63, hw = (tid >> 6) & 1, cg = tid >> 7;
#pragma unroll
    for (int q = 0; q < 4; ++q) { float fl[8]; unpack8(rw[q], fl);
#pragma unroll
        for (int e = 0; e < 8; ++e) { const float l = lbh[32 * cg + 8 * q + e]; const float f = l + (1.0f - l) * (1.0f / (1.0f + __expf(-fl[e]))); kk[8 * q + e] = 1.0f - f; cum[8 * q + e] = __logf(fmaxf(f, 1e-6f)); } }
#pragma unroll
    for (int off = 1; off < 64; off <<= 1) {
#pragma unroll
        for (int c = 0; c < 32; ++c) { const float t = __shfl_up(cum[c], off); if (lane >= off) cum[c] += t; } }
    if (hw == 0 && lane == 63) {
#pragma unroll
        for (int c = 0; c < 32; ++c) scr[32 * cg + c] = cum[c]; }
    LDS_BARRIER();
    if (hw == 1) {
#pragma unroll
        for (int c = 0; c < 32; ++c) cum[c] += scr[32 * cg + c]; }
    if (hw == 1 && lane == 63) {
#pragma unroll
        for (int c = 0; c < 32; ++c) scr[128 + 32 * cg + c] = cum[c]; }
    LDS_BARRIER();
}
struct MixU { int mixer, b, h, n; };
__device__ __forceinline__ MixU mix_decode(int u) { MixU U; const int g = __builtin_amdgcn_readfirstlane(u >> 5); U.n = __builtin_amdgcn_readfirstlane(u & 31); U.mixer = g >> 4; U.b = (g >> 2) & 3; U.h = g & 3; return U; }

__device__ __forceinline__ void mixA_phase(LAS char* lds, const MixArgs& a, int bx, int G, int tid) {
    const int lane = tid & 63, w = __builtin_amdgcn_readfirstlane(tid >> 6), r = lane & 31, h2 = lane >> 5;
    const int j = tid & 127, cg = tid >> 7;
    LAS float* scr = (LAS float*)(lds + MX_SCR);
    int u = bx; if (u >= 1024) return;
    v4u rk[4], rv[4];
    { const MixU U = mix_decode(u); const bf16* zt = a.Z + (size_t)(U.b * SEQ + 128 * U.n) * EV_IN;
      load_prep4(rk, zt + (size_t)j * EV_IN + (U.mixer == 0 ? Z_RK : Z_GF) + U.h * 128, U.mixer, cg); load_copy4(rv, zt + (U.mixer == 0 ? Z_RV : Z_GI) + U.h * 128, tid); }
    for (;;) {
        const MixU U = mix_decode(u); const int h = U.h, n = U.n;
        if (U.mixer == 0) {
            const float gamma = 1.0f - exp2f(-5.0f - (float)h), lg2 = log2f(gamma);
            float sn[16], cs[16];
#pragma unroll
            for (int e = 0; e < 16; ++e) { const float inv = exp2f(-(float)(16 * cg + e) * (13.287712379549449f / 64.0f)); rope_sincos((float)(128 * n + j) * inv, sn[e], cs[e]); }
            ret_prep_raw(lds + MX_K, MX_TSTRIDE, rk, j, cg, sn, cs, 0.08838834764831845f * exp2f((float)(127 - j) * lg2));
            if (tid < 128) { a.DECA[(size_t)u * 128 + tid] = exp2f(128.0f * lg2); a.DECB[(size_t)u * 128 + tid] = gamma; }
        } else {
            float cum[32], kk[32];
            hg_gates_raw(rk, a.lb + h * 128, tid, scr, cum, kk);
#pragma unroll
            for (int q = 0; q < 4; ++q) { float o[8];
#pragma unroll
                for (int e = 0; e < 8; ++e) o[e] = kk[8 * q + e] * __expf(scr[128 + 32 * cg + 8 * q + e] - cum[8 * q + e]);
                st_chunk8(lds + MX_K, MX_TSTRIDE, j, 32 * cg + 8 * q, o); }
            if (tid < 128) { a.DECA[(size_t)u * 128 + tid] = __expf(scr[128 + tid]); a.DECB[(size_t)u * 128 + tid] = __expf(scr[tid]); }
        }
        store_copy4(lds + MX_V, MX_TSTRIDE, rv, tid);
        LDS_BARRIER();
        const int un = u + G; const bool more = un < 1024;
        if (more) { const MixU Un = mix_decode(un); const bf16* zt = a.Z + (size_t)(Un.b * SEQ + 128 * Un.n) * EV_IN;
            load_prep4(rk, zt + (size_t)j * EV_IN + (Un.mixer == 0 ? Z_RK : Z_GF) + Un.h * 128, Un.mixer, cg); load_copy4(rv, zt + (Un.mixer == 0 ? Z_RV : Z_GI) + Un.h * 128, tid); }
        const int lbn = tr_lane_base_nat(lane, MX_TSTRIDE); const int kbk = w >> 1, vb0 = 2 * (w & 1);
        f32x16 acc[2];
#pragma unroll
        for (int t = 0; t < 2; ++t)
#pragma unroll
            for (int i = 0; i < 16; ++i) acc[t][i] = 0.f;
#pragma unroll
        for (int s_ = 0; s_ < 8; ++s_) { const bf16x8 av = tr_frag_nat(lds + MX_K, MX_TSTRIDE, lbn, 16 * s_, 32 * kbk);
#pragma unroll
            for (int t = 0; t < 2; ++t) { const bf16x8 bv = tr_frag_nat(lds + MX_V, MX_TSTRIDE, lbn, 16 * s_, 32 * (vb0 + t)); acc[t] = MFMA32(av, bv, acc[t]); } }
        bf16* sb = a.SBUF + (size_t)u * 16384;
#pragma unroll
        for (int t = 0; t < 2; ++t)
#pragma unroll
            for (int g4 = 0; g4 < 4; ++g4) { v2u wv; wv.x = cvtpk(acc[t][4 * g4], acc[t][4 * g4 + 1]); wv.y = cvtpk(acc[t][4 * g4 + 2], acc[t][4 * g4 + 3]);
                *(v2u*)(sb + (size_t)(32 * (vb0 + t) + r) * 128 + 32 * kbk + 8 * g4 + 4 * h2) = wv; }
        LDS_BARRIER();
        if (!more) break;
        u = un;
    }
}

__device__ __forceinline__ void mixA_unit(LAS char* lds, const MixArgs& a, int u, int tid) {
    const int lane = tid & 63, w = __builtin_amdgcn_readfirstlane(tid >> 6), r = lane & 31, h2 = lane >> 5;
    const int g = u >> 5, n = u & 31, mixer = g >> 4, b = (g >> 2) & 3, h = g & 3;
    const int j = tid & 127, cg = tid >> 7;
    const bf16* zt = a.Z + (size_t)(b * SEQ + 128 * n) * EV_IN;
    LAS float* scr = (LAS float*)(lds + MX_SCR);
    if (mixer == 0) {
        const float gamma = 1.0f - exp2f(-5.0f - (float)h), lg2 = log2f(gamma);
        float sn[16], cs[16];
#pragma unroll
        for (int e = 0; e < 16; ++e) { const float inv = exp2f(-(float)(16 * cg + e) * (13.287712379549449f / 64.0f)); rope_sincos((float)(128 * n + j) * inv, sn[e], cs[e]); }
        ret_prep_tile(lds + MX_K, MX_TSTRIDE, zt + (size_t)j * EV_IN + Z_RK + h * 128, j, cg, sn, cs, 0.08838834764831845f * exp2f((float)(127 - j) * lg2));
        copy_tile(lds + MX_V, MX_TSTRIDE, zt + Z_RV + h * 128, tid);
        if (tid < 128) { a.DECA[(size_t)u * 128 + tid] = exp2f(128.0f * lg2); a.DECB[(size_t)u * 128 + tid] = gamma; }
    } else {
        float cum[32], kk[32];
        hg_gates(zt + (size_t)j * EV_IN + Z_GF + h * 128, a.lb + h * 128, tid, scr, cum, kk);
#pragma unroll
        for (int q = 0; q < 4; ++q) { float o[8];
#pragma unroll
            for (int e = 0; e < 8; ++e) o[e] = kk[8 * q + e] * __expf(scr[128 + 32 * cg + 8 * q + e] - cum[8 * q + e]);
            st_chunk8(lds + MX_K, MX_TSTRIDE, j, 32 * cg + 8 * q, o); }
        copy_tile(lds + MX_V, MX_TSTRIDE, zt + Z_GI + h * 128, tid);
        if (tid < 128) { a.DECA[(size_t)u * 128 + tid] = __expf(scr[128 + tid]); a.DECB[(size_t)u * 128 + tid] = __expf(scr[tid]); }
    }
    __syncthreads();
    const int lbn = tr_lane_base_nat(lane, MX_TSTRIDE); const int kbk = w >> 1, vb0 = 2 * (w & 1);
    f32x16 acc[2];
#pragma unroll
    for (int t = 0; t < 2; ++t)
#pragma unroll
        for (int i = 0; i < 16; ++i) acc[t][i] = 0.f;
#pragma unroll
    for (int s = 0; s < 8; ++s) { const bf16x8 av = tr_frag_nat(lds + MX_K, MX_TSTRIDE, lbn, 16 * s, 32 * kbk);
#pragma unroll
        for (int t = 0; t < 2; ++t) { const bf16x8 bv = tr_frag_nat(lds + MX_V, MX_TSTRIDE, lbn, 16 * s, 32 * (vb0 + t)); acc[t] = MFMA32(av, bv, acc[t]); } }
    bf16* sb = a.SBUF + (size_t)u * 16384;
#pragma unroll
    for (int t = 0; t < 2; ++t)
#pragma unroll
        for (int g4 = 0; g4 < 4; ++g4) { v2u wv; wv.x = cvtpk(acc[t][4 * g4], acc[t][4 * g4 + 1]); wv.y = cvtpk(acc[t][4 * g4 + 2], acc[t][4 * g4 + 3]);
            *(v2u*)(sb + (size_t)(32 * (vb0 + t) + r) * 128 + 32 * kbk + 8 * g4 + 4 * h2) = wv; }
    __syncthreads();
}

__device__ __forceinline__ void mix_scan(const MixArgs& a, int gtid, int nthreads, bool dry = false) {
    for (int e = gtid; e < 32 * 4096; e += nthreads) { const int g = e >> 12, el = e & 4095, dk4 = el & 31;
        bf16* sp = a.SBUF + (size_t)(g * 32) * 16384 + (size_t)el * 4; const float* da = a.DECA + (size_t)(g * 32) * 128 + 4 * dk4; const float* db = a.DECB + (size_t)(g * 32) * 128 + 4 * dk4;
        f32x4 S = (f32x4){0.f, 0.f, 0.f, 0.f};
#pragma unroll 8
        for (int n = 0; n < 32; ++n) { const v2u kv = *(const v2u*)(sp + (size_t)n * 16384); const f32x4 A = *(const f32x4*)(da + n * 128), Bv = *(const f32x4*)(db + n * 128);
            const f32x4 so = S * Bv; v2u wv; wv.x = cvtpk(so[0], so[1]); wv.y = cvtpk(so[2], so[3]); if (!dry) *(v2u*)(sp + (size_t)n * 16384) = wv;
            S[0] = A[0] * S[0] + __uint_as_float(kv.x << 16); S[1] = A[1] * S[1] + __uint_as_float(kv.x & 0xffff0000u); S[2] = A[2] * S[2] + __uint_as_float(kv.y << 16); S[3] = A[3] * S[3] + __uint_as_float(kv.y & 0xffff0000u); }
    }
}

__device__ __forceinline__ void mixC_unit(LAS char* lds, const MixArgs& a, int u, int tid, bool dry = false) {
    const int lane = tid & 63, w = __builtin_amdgcn_readfirstlane(tid >> 6), r = lane & 31, h2 = lane >> 5;
    const int g = u >> 5, n = u & 31, mixer = g >> 4, b = (g >> 2) & 3, h = g & 3;
    const int j = tid & 127, cg = tid >> 7;
    bf16* zt = a.Z + (size_t)(b * SEQ + 128 * n) * EV_IN;
    LAS float* scr = (LAS float*)(lds + MX_SCR);
    if (mixer == 0) {
        const float gamma = 1.0f - exp2f(-5.0f - (float)h), lg2 = log2f(gamma);
        float sn[16], cs[16];
#pragma unroll
        for (int e = 0; e < 16; ++e) { const float inv = exp2f(-(float)(16 * cg + e) * (13.287712379549449f / 64.0f)); rope_sincos((float)(128 * n + j) * inv, sn[e], cs[e]); }
        ret_prep_tile(lds + MX_Q, MX_STRIDE, zt + (size_t)j * EV_IN + Z_RQ + h * 128, j, cg, sn, cs, exp2f((float)j * lg2));
        ret_prep_tile(lds + MX_K, MX_STRIDE, zt + (size_t)j * EV_IN + Z_RK + h * 128, j, cg, sn, cs, 0.08838834764831845f * exp2f(-(float)j * lg2));
        copy_tile(lds + MX_V, MX_TSTRIDE, zt + Z_RV + h * 128, tid);
    } else {
        float cum[32], kk[32];
        hg_gates(zt + (size_t)j * EV_IN + Z_GF + h * 128, a.lb + h * 128, tid, scr, cum, kk);
#pragma unroll
        for (int q = 0; q < 4; ++q) { float qv[8], oq[8], ok[8]; unpack8(*(const v4u*)(zt + (size_t)j * EV_IN + Z_GQ + h * 128 + 32 * cg + 8 * q), qv);
#pragma unroll
            for (int e = 0; e < 8; ++e) { const float d = cum[8 * q + e] - scr[32 * cg + 8 * q + e]; oq[e] = qv[e] * __expf(d); ok[e] = kk[8 * q + e] * __expf(-d); }
            st_chunk8(lds + MX_Q, MX_STRIDE, j, 32 * cg + 8 * q, oq); st_chunk8(lds + MX_K, MX_STRIDE, j, 32 * cg + 8 * q, ok); }
        copy_tile(lds + MX_V, MX_TSTRIDE, zt + Z_GI + h * 128, tid);
    }
    __syncthreads();
    const int vb = w >> 1; const int lbp = tr_lane_base(lane, MX_TSTRIDE);
    const bf16* sb = a.SBUF + (size_t)u * 16384 + (size_t)(32 * vb + r) * 128 + 8 * h2;
    bf16x8 sf[8];
#pragma unroll
    for (int s = 0; s < 8; ++s) sf[s] = *(const bf16x8*)(sb + 16 * s);
    f32x16 o[2]; float s1[2], s2[2];
#pragma unroll
    for (int t = 0; t < 2; ++t) {
        const int ib = (w & 1) ? (1 + t) : (3 * t);
        bf16x8 qf[8];
#pragma unroll
        for (int s = 0; s < 8; ++s) qf[s] = *(const LAS bf16x8*)(lds + MX_Q + (32 * ib + r) * MX_STRIDE + h2 * 16 + s * 32);
#pragma unroll
        for (int i = 0; i < 16; ++i) o[t][i] = 0.f;
#pragma unroll
        for (int s = 0; s < 8; ++s) o[t] = MFMA32(sf[s], qf[s], o[t]);
        for (int jb = 0; jb <= ib; ++jb) {
            f32x16 acc;
#pragma unroll
            for (int i = 0; i < 16; ++i) acc[i] = 0.f;
            const LAS char* kp = lds + MX_K + (32 * jb + r) * MX_STRIDE + h2 * 16;
#pragma unroll
            for (int s = 0; s < 8; ++s) { const bf16x8 av = *(const LAS bf16x8*)(kp + s * 32); acc = MFMA32(av, qf[s], acc); }
            if (jb == ib) {
#pragma unroll
                for (int i = 0; i < 16; ++i) { const int c = (i & 3) + 8 * (i >> 2) + 4 * h2; if (c > r) acc[i] = 0.f; } }
            const bf16x8 p0 = pack8(acc[0], acc[1], acc[2], acc[3], acc[4], acc[5], acc[6], acc[7]), p1 = pack8(acc[8], acc[9], acc[10], acc[11], acc[12], acc[13], acc[14], acc[15]);
            const bf16x8 v0 = tr_frag_perm(lds + MX_V, MX_TSTRIDE, lbp, 32 * jb, 32 * vb), v1 = tr_frag_perm(lds + MX_V, MX_TSTRIDE, lbp, 32 * jb + 16, 32 * vb);
            o[t] = MFMA32(v0, p0, o[t]); o[t] = MFMA32(v1, p1, o[t]);
        }
        float a1 = 0.f, a2 = 0.f;
#pragma unroll
        for (int i = 0; i < 16; ++i) { a1 += o[t][i]; a2 += o[t][i] * o[t][i]; }
        a1 += __shfl_xor(a1, 32); a2 += __shfl_xor(a2, 32); s1[t] = a1; s2[t] = a2;
        if (h2 == 0) { scr[256 + (vb * 128 + 32 * ib + r) * 2] = a1; scr[256 + (vb * 128 + 32 * ib + r) * 2 + 1] = a2; }
    }
    __syncthreads();
    const float* gn = (mixer == 0 ? a.ret_g : a.hg_g) + h * 128 + 32 * vb + 4 * h2;
#pragma unroll
    for (int t = 0; t < 2; ++t) {
        const int ib = (w & 1) ? (1 + t) : (3 * t); const int tok = 32 * ib + r;
        float t1 = 0.f, t2 = 0.f;
#pragma unroll
        for (int v = 0; v < 4; ++v) { t1 += scr[256 + (v * 128 + tok) * 2]; t2 += scr[256 + (v * 128 + tok) * 2 + 1]; }
        float mu = 0.f, rstd;
        if (mixer == 0) { mu = t1 * (1.0f / 128.0f); rstd = 1.0f / sqrtf(fmaxf(t2 * (1.0f / 128.0f) - mu * mu, 0.f) + EPS); } else rstd = 1.0f / sqrtf(t2 * (1.0f / 128.0f) + EPS);
        bf16* zr = zt + (size_t)tok * EV_IN;
        const bf16* gp = zr + (mixer == 0 ? Z_RG : Z_GG) + h * 128 + 32 * vb + 4 * h2; bf16* yp = zr + (mixer == 0 ? Z_RQ : Z_GQ) + h * 128 + 32 * vb + 4 * h2;
#pragma unroll
        for (int g4 = 0; g4 < 4; ++g4) { const v2u gw = *(const v2u*)(gp + 8 * g4); const f32x4 gv = *(const f32x4*)(gn + 8 * g4);
            const float ga[4] = {__uint_as_float(gw.x << 16), __uint_as_float(gw.x & 0xffff0000u), __uint_as_float(gw.y << 16), __uint_as_float(gw.y & 0xffff0000u)}; float y[4];
#pragma unroll
            for (int e = 0; e < 4; ++e) { y[e] = (o[t][4 * g4 + e] - mu) * rstd * gv[e] * (ga[e] / (1.0f + __expf(-ga[e]))); }
            v2u wv; wv.x = cvtpk(y[0], y[1]); wv.y = cvtpk(y[2], y[3]); if (!dry) *(v2u*)(yp + 8 * g4) = wv; }
    }
    __syncthreads();
}


__device__ __forceinline__ float gelu_tanh(float x) { const float u = 0.7978845608028654f * (x + 0.044715f * x * x * x); const float t = 1.0f - 2.0f / (1.0f + __expf(2.0f * u)); return 0.5f * x * (1.0f + t); }
__device__ __forceinline__ void ffn_ew(const bf16* GU, const float* cw, const float* cb, bf16* H, int rows, int gtid, int nthreads) {
    for (int idx = gtid; idx < rows * (DFF / 8); idx += nthreads) {
        const int row = idx / (DFF / 8), c0 = (idx % (DFF / 8)) * 8, t = row % SEQ;
        float g0[8], g1[8], g2[8], u[8];
        unpack8(*(const v4u*)(GU + (size_t)row * (2 * DFF) + c0), g2); unpack8(*(const v4u*)(GU + (size_t)row * (2 * DFF) + DFF + c0), u);
        if (t >= 1) unpack8(*(const v4u*)(GU + (size_t)(row - 1) * (2 * DFF) + c0), g1); else { for (int i = 0; i < 8; ++i) g1[i] = 0.f; }
        if (t >= 2) unpack8(*(const v4u*)(GU + (size_t)(row - 2) * (2 * DFF) + c0), g0); else { for (int i = 0; i < 8; ++i) g0[i] = 0.f; }
        float r[8];
#pragma unroll
        for (int i = 0; i < 8; ++i) { const float y = cw[c0 + i] * g0[i] + cw[DFF + c0 + i] * g1[i] + cw[2 * DFF + c0 + i] * g2[i] + cb[c0 + i]; r[i] = gelu_tanh(y) * u[i]; }
        v4u o; o.x = cvtpk(r[0], r[1]); o.y = cvtpk(r[2], r[3]); o.z = cvtpk(r[4], r[5]); o.w = cvtpk(r[6], r[7]);
        *(v4u*)(H + (size_t)row * DFF + c0) = o;
    }
}

constexpr int LDS_BYTES = 163840;
constexpr int LDSCTL_OFF = LDS_BYTES - 512;
constexpr int CW_BAR = 4096;
constexpr size_t CTL_ZERO_BYTES = 1 * MiB;
#define XB_TMO      128
#define XB_XCNT(j)  (256  + 64 * (j))
#define XB_XSUB(j)  (1280 + 64 * (j))
#define XB_XGEN(j)  (2304 + 64 * (j))
#define XB_TOP      3328
#define XB_TOPGEN   3392
#define XCD_BAR_WORDS 3456
#define XB_SPIN_CAP (1u << 18)

__device__ __forceinline__ unsigned xb_ld(unsigned* p)              { return __hip_atomic_load(p, __ATOMIC_RELAXED, __HIP_MEMORY_SCOPE_AGENT); }
__device__ __forceinline__ unsigned xb_add(unsigned* p, unsigned v) { return __hip_atomic_fetch_add(p, v, __ATOMIC_RELAXED, __HIP_MEMORY_SCOPE_AGENT); }
__device__ __forceinline__ unsigned xb_xcc_id() { return (unsigned)__builtin_amdgcn_s_getreg((3 << 11) | 20) & 0xFu; }
#define XB_SPIN(cond, bar) do { unsigned _sp = 0; while (cond) { __builtin_amdgcn_s_sleep(1); \
    if ((++_sp & 255u) == 0u) { if (xb_ld(&(bar)[XB_TMO])) break; if (_sp > XB_SPIN_CAP) { atomicAdd(&(bar)[XB_TMO], 1u); break; } } } } while (0)

struct XcdBarrier {
    unsigned* bar; unsigned x;
    volatile LAS unsigned* st;
};

__device__ __forceinline__ XcdBarrier xcd_barrier_post(unsigned* bar, volatile LAS unsigned* st) {
    XcdBarrier b; b.bar = bar; b.x = xb_xcc_id(); b.st = st;
    if (threadIdx.x == 0) (void)xb_add(&bar[XB_XCNT(b.x)], 1u);
    return b;
}
__device__ __forceinline__ void xcd_barrier_complete(unsigned* bar, unsigned x, unsigned& nloc, unsigned& nx) {
    const unsigned G = gridDim.x * gridDim.y * gridDim.z;
    unsigned sum, cnt, mine, sp = 0u;
    for (;;) {
        sum = 0u; cnt = 0u; mine = 0u;
#pragma unroll
        for (unsigned j = 0; j < 16; ++j) { const unsigned c = xb_ld(&bar[XB_XCNT(j)]); sum += c; cnt += (c > 0u) ? 1u : 0u; mine = (j == x) ? c : mine; }
        if (sum == G) break;
        __builtin_amdgcn_s_sleep(1);
        if ((++sp & 255u) == 0u) { if (xb_ld(&bar[XB_TMO])) break; if (sp > XB_SPIN_CAP) { atomicAdd(&bar[XB_TMO], 1u); break; } }
    }
    nloc = mine > 0u ? mine : 1u; nx = cnt > 0u ? cnt : 1u;
}

__device__ __forceinline__ void xcd_barrier(const XcdBarrier& b) {
    asm volatile("s_waitcnt vmcnt(0)" ::: "memory");
    __syncthreads();
    if (threadIdx.x == 0) {
        unsigned* bar = b.bar;
        __builtin_amdgcn_s_waitcnt(0);
        unsigned nloc = b.st[0], nx = b.st[1];
        if (nloc == 0u) { xcd_barrier_complete(bar, b.x, nloc, nx); b.st[0] = nloc; b.st[1] = nx; }
        const unsigned old = xb_add(&bar[XB_XSUB(b.x)], 1u);
        const unsigned gen = old / nloc;
        if (old + 1u == (gen + 1u) * nloc) {
            __builtin_amdgcn_fence(__ATOMIC_RELEASE, "agent");
            asm volatile("s_waitcnt vmcnt(0)" ::: "memory");
            const unsigned og = xb_add(&bar[XB_TOP], 1u);
            const unsigned tg = og / nx;
            if (og + 1u == (tg + 1u) * nx) xb_add(&bar[XB_TOPGEN], 1u);
            else XB_SPIN(xb_ld(&bar[XB_TOPGEN]) == tg, bar);
            __builtin_amdgcn_fence(__ATOMIC_ACQUIRE, "agent");
            xb_add(&bar[XB_XGEN(b.x)], 1u);
            asm volatile("s_waitcnt vmcnt(0)" ::: "memory");
        } else {
            XB_SPIN(xb_ld(&bar[XB_XGEN(b.x)]) == gen, bar);
            __builtin_amdgcn_fence(__ATOMIC_ACQUIRE, "agent");
            asm volatile("s_waitcnt vmcnt(0)" ::: "memory");
        }
    }
    __syncthreads();
}


__device__ __forceinline__ unsigned char* launder_s(unsigned char* p) { asm volatile("" : "+s"(p)); return p; }
__device__ __forceinline__ float* launder_sf(float* p) { asm volatile("" : "+s"(p)); return p; }
struct FwdArgs { const float* in[25]; float* out; unsigned char* ws; int ph_lo, ph_hi, li, pad; };
__global__ void __launch_bounds__(512, 2) fwd(FwdArgs a) {
    extern __shared__ __attribute__((aligned(16))) unsigned char lds_raw[];
    LAS unsigned char* lds = (LAS unsigned char*)lds_raw;
    const int tid = threadIdx.x, lane = tid & 63, wave = __builtin_amdgcn_readfirstlane(tid >> 6);
    const int G = gridDim.x, bx = blockIdx.x;
    volatile LAS unsigned* MISC = (volatile LAS unsigned*)(lds + LDSCTL_OFF);
    if (tid < 64) MISC[tid] = 0u;
    __syncthreads();
#define WSP (launder_s(a.ws))
#define OUTP (launder_sf(a.out))
    XcdBarrier bar = xcd_barrier_post((unsigned*)(WSP + WS_CTL) + CW_BAR + a.li * XCD_BAR_WORDS, MISC + 8);
    int ph = 0; const int lo = a.ph_lo, hi = a.ph_hi;
#define PH_ON true) for (int rp_ = 0, nr_ = (ph >= lo && ph < hi) ? 1 + ((a.pad >> ph) & 1) : 0; rp_ < nr_; ++rp_, __syncthreads()
#define TID_L ({ int l_; asm volatile("v_mbcnt_lo_u32_b32 %0, -1, 0\n\tv_mbcnt_hi_u32_b32 %0, -1, %0" : "=v"(l_)); wave * 64 + l_; })
#define PH_END do { if (ph >= lo && ph + 1 < hi) xcd_barrier(bar); ++ph; } while (0)
#define XB ((bf16*)(WSP + WS_XB))
#define SSQP ((float*)(WSP + WS_SSQP))
#define ACT ((bf16*)(WSP + WS_ACT))

    if (PH_ON) { ProArgs pa;
#pragma unroll
        for (int i = 0; i < 25; ++i) pa.in[i] = a.in[i];
        pa.ws = WSP; pa.layer_mask = 3; pa.ffn_mode = 2;
        { const int t_ = TID_L; prologue_body(pa, bx * 8 + (t_ >> 6), G * 8, t_ & 63, (LAS float*)lds + (t_ >> 6) * 64 * 65); } }
    PH_END;

    for (int l = 0; l < 2; ++l) {
        if (PH_ON) {
            { pg8::Gemm g{XB, (const bf16*)(WSP + (l ? WS_ODIN : WS_EVIN)), M, l ? OD_IN : EV_IN, D, D}; pg8::EpiBf16S E{ACT, SSQP, l ? OD_IN : EV_IN, M, EPS, 0};
              pg8::StaticOrder S; S.init(g.M, g.N, G, bx); pg8::gemm_phase<pg8::EpiBf16S, pg8::StaticOrder, true, true>(lds, g, S, E, TID_L); }
        }
        PH_END;
        const bf16* mixo; int mixo_ld;
        if (l == 0) {
            MixArgs ma{ACT, (const float*)(WSP + WS_LB), a.in[4], a.in[5], (bf16*)OUTP, (float*)(WSP + WS_DECA), (float*)(WSP + WS_DECB)};
            if (PH_ON) mixA_phase((LAS char*)lds, ma, bx, G, TID_L);
            PH_END;
            if (PH_ON) {
                if (bx < 64 && G > 64) { const int lm = bx >> 5;
                    pg8::Gemm g{(const bf16*)(WSP + (lm ? WS_MEMH1 : WS_MEMH0)), (const bf16*)(WSP + (lm ? WS_XKV1 : WS_XKV0)), MM, 2 * D, D, D}; pg8::EpiBf16S E{(bf16*)(WSP + (lm ? WS_MKV1 : WS_MKV0)), nullptr, 2 * D, M, EPS, 0};
                    pg8::StaticOrder S; S.init(g.M, g.N, G, bx & 31); pg8::gemm_phase<pg8::EpiBf16S, pg8::StaticOrder, true, true>(lds, g, S, E, TID_L); }
                else mix_scan(ma, (bx - 64) * 512 + TID_L, (G - 64) * 512, rp_ + 1 < nr_);
            }
            PH_END;
            if (PH_ON) { for (int u = bx; u < 1024; u += G) mixC_unit((LAS char*)lds, ma, u, TID_L, rp_ + 1 < nr_); }
            PH_END;
            mixo = ACT; mixo_ld = EV_IN;
        } else {
            bf16* O = (bf16*)(WSP + WS_ACT + 96 * MiB);
            DaArgs da; da.QKV = ACT; da.biasT = (const float*)(WSP + WS_BIAST); da.gkq = (const float*)(WSP + WS_GOD); da.N0 = (bf16*)(WSP + WS_N2); da.DEN0 = (float*)(WSP + WS_DEN23);
            da.N1 = (const bf16*)(WSP + WS_N2); da.DEN1 = (const float*)(WSP + WS_DEN23); da.N2 = (const bf16*)OUTP; da.DEN2 = (const float*)(WSP + WS_DEN23) + (size_t)M * 8; da.O = O; da.br0 = 1; da.nbr = 2; da.mode = 0; da.pad = 0;
            if (PH_ON) dattn_phase<0>((LAS char*)lds, da, bx, G, TID_L);
            PH_END;
            if (PH_ON) dattn_phase<1>((LAS char*)lds, da, bx, G, TID_L);
            PH_END;
            mixo = O; mixo_ld = D;
        }
        if (PH_ON) { pg8::Gemm g{mixo, (const bf16*)(WSP + (l ? WS_ODOUT : WS_EVOUT)), M, D, D, mixo_ld}; pg8::EpiResid E{l ? (const float*)nullptr : a.in[0], nullptr, XB, SSQP, D, M};
            pg8::StaticOrder S; S.init(g.M, g.N, G, bx); pg8::gemm_phase<pg8::EpiResid, pg8::StaticOrder, false, true>(lds, g, S, E, TID_L); }
        PH_END;
        { bf16* O = (bf16*)(WSP + WS_ACT + 32 * MiB);
          if (PH_ON) { pg8::Gemm g{XB, (const bf16*)(WSP + (l ? WS_XQ1 : WS_XQ0)), M, D, D, D}; EpiXattn E{(const bf16*)(WSP + (l ? WS_MKV1 : WS_MKV0)), (const float*)(WSP + WS_GXA) + l * 256, O};
              pg8::StaticOrder S; S.init(g.M, g.N, G, bx); pg8::gemm_phase<EpiXattn, pg8::StaticOrder, false, true>(lds, g, S, E, TID_L);
              pg8::StaticOrder S2; S2.init(M, D, G, bx); pg8::Unit uq; if (S2.next(0, uq)) xattn_unit<true>((LAS char*)lds, nullptr, (const bf16*)(WSP + (l ? WS_MKV1 : WS_MKV0)), (const float*)(WSP + WS_GXA) + l * 256, O, uq.pm * 4 + uq.pn, TID_L); }
          PH_END;
          if (PH_ON) { pg8::Gemm g{O, (const bf16*)(WSP + (l ? WS_XO1 : WS_XO0)), M, D, D, D}; pg8::EpiResid E{nullptr, nullptr, XB, SSQP, D, M};
              pg8::StaticOrder S; S.init(g.M, g.N, G, bx); pg8::gemm_phase<pg8::EpiResid, pg8::StaticOrder, false, true>(lds, g, S, E, TID_L); }
          PH_END; }
        { bf16* H = ACT;
          if (PH_ON) { pg8::Gemm g{XB, (const bf16*)(WSP + (l ? WS_FIN1 : WS_FIN0)), 68 * 256, 2 * DFF, D, D}; pg8::EpiFfn E{H, SSQP, a.in[22] + (size_t)l * 3 * DFF, a.in[23] + (size_t)l * DFF, M, EPS};
              pg8::FfnOrder S; S.init(g.M, g.N, G, bx); pg8::gemm_phase<pg8::EpiFfn, pg8::FfnOrder, true, true>(lds, g, S, E, TID_L); }
          PH_END;
          if (PH_ON) { pg8::Gemm g{H, (const bf16*)(WSP + (l ? WS_FOUT1 : WS_FOUT0)), M, D, DFF, DFF}; pg8::EpiResid E{nullptr, l ? OUTP : (float*)nullptr, XB, SSQP, D, M};
              pg8::StaticOrder S; S.init(g.M, g.N, G, bx); pg8::gemm_phase<pg8::EpiResid, pg8::StaticOrder, false, true>(lds, g, S, E, TID_L); }
          PH_END; }
    }
#undef PH_ON
#undef PH_END
#undef TID_L
#undef WSP
#undef OUTP
#undef XB
#undef SSQP
#undef ACT
}
constexpr int N_PHASES = 1 + 9 + 8;

#ifndef PROBE_MASK
#define PROBE_MASK 0
#endif
#ifndef MK_PER_PHASE
#define MK_PER_PHASE 0
#endif
extern "C" void kernel_launch(void* const* d_in, const int* in_sizes, int n_in, void* d_out, int out_size, void* d_ws, size_t ws_size, hipStream_t stream) {
    static int inited = 0;
    if (!inited) {
        if (n_in != 25 || out_size != M * D || ws_size < WS_END) { fprintf(stderr, "kernel_launch: unexpected shapes (n_in %d, out %d, ws %zu)\n", n_in, out_size, ws_size); inited = -1; return; }
        if (hipFuncSetAttribute((const void*)fwd, hipFuncAttributeMaxDynamicSharedMemorySize, LDS_BYTES) != hipSuccess) { fprintf(stderr, "kernel_launch: hipFuncSetAttribute failed\n"); inited = -1; return; }
        inited = 1;
    }
    if (inited < 0) return;
    if (hipMemsetAsync((char*)d_ws + WS_CTL, 0, CTL_ZERO_BYTES, stream) != hipSuccess) return;
    FwdArgs fa{}; for (int i = 0; i < 25; ++i) fa.in[i] = (const float*)d_in[i]; fa.out = (float*)d_out; fa.ws = (unsigned char*)d_ws; fa.pad = PROBE_MASK;
#if MK_PER_PHASE
    for (int p = 0; p < N_PHASES; ++p) { fa.ph_lo = p; fa.ph_hi = p + 1; fa.li = 0; hipLaunchKernelGGL(fwd, dim3(256), dim3(512), LDS_BYTES, stream, fa); }
#else
    fa.ph_lo = 0; fa.ph_hi = N_PHASES; fa.li = 0; hipLaunchKernelGGL(fwd, dim3(256), dim3(512), LDS_BYTES, stream, fa);
#endif
}
```

```cpp
#include <hip/hip_runtime.h>
#include <cstdio>
#include <cstdint>
namespace pg8 {
#define PG8_LAS __attribute__((address_space(3)))
typedef unsigned short bf16_t;
typedef short bf16x8 __attribute__((ext_vector_type(8)));
typedef float f32x4 __attribute__((ext_vector_type(4)));
typedef unsigned u32x4 __attribute__((ext_vector_type(4)));
constexpr int BM = 256, BK = 64, HALF = 128, HTB = HALF * BK * 2  , STAGE_BYTES = 8 * HTB, NXCD = 8, WGM = 8;
constexpr int SSQ_LDS = STAGE_BYTES + 4096, CW_LDS = STAGE_BYTES + 8192;

__host__ __device__ __forceinline__ int lds_byte(int r, int c) { const int st = (r >> 4) * 2 + (c >> 5), rr = r & 15, cc = c & 31, ob = rr * 64 + cc * 2; return st * 1024 + (ob ^ (((ob >> 9) & 1) << 5)); }
__host__ __device__ __forceinline__ void stage_rc(int b, int& R, int& C) { const int st = b / 1024, sb = b % 1024, swz = sb ^ (((sb >> 9) & 1) << 5); R = (st >> 1) * 16 + swz / 64; C = (st & 1) * 32 + (swz % 64) / 2; }
__host__ __device__ __forceinline__ int perm32(int rho) { const int n = rho >> 4, i = rho & 15; return 8 * (i >> 2) + 4 * n + (i & 3); }

struct Unit { int pm, pn; };
struct Gemm { const bf16_t* A; const bf16_t* Bt; int M, N, K, lda; };

struct StaticOrder {
    int nM, nN, nwg, G, c;
    __host__ __device__ __forceinline__ void init(int M, int N, int G_, int c_) { nM = M / BM; nN = N / BM; nwg = nM * nN; G = G_; c = c_; }
    __host__ __device__ __forceinline__ bool next(int i, Unit& u) const {
        const long L = (long)i * G + c; if (L >= nwg) return false;
        int wgid = (int)L; { const int q = nwg / NXCD, r = nwg % NXCD, xcd = wgid % NXCD, off = wgid / NXCD; wgid = (xcd < r ? xcd * (q + 1) : r * (q + 1) + (xcd - r) * q) + off; }
        const int nig = WGM * nN, gid = wgid / nig, fm = gid * WGM, gsz = (nM - fm) < WGM ? (nM - fm) : WGM;
        u.pm = fm + ((wgid % nig) % gsz); u.pn = (wgid % nig) / gsz; return true;
    }
    __device__ __forceinline__ void a_ready(const Unit&) const {}
    __device__ __forceinline__ void done(const Unit&) const {}
    __device__ __forceinline__ int arow(const Unit& u) const { return u.pm * BM; }
};
struct FfnOrder : StaticOrder {
    __device__ __forceinline__ int arow(const Unit& u) const { return (u.pm / 17) * 4096 + 254 * (u.pm % 17) - 2; }
};

__device__ __forceinline__ unsigned cvt_pk_bf16(float lo, float hi) { unsigned r; asm volatile("v_cvt_pk_bf16_f32 %0, %1, %2" : "=v"(r) : "v"(lo), "v"(hi)); return r; }
typedef float f32x2 __attribute__((ext_vector_type(2)));
struct EpiBf16S {
    static constexpr bool PERM = true, AFTER_DRAIN = false;
    bf16_t* O; const float* ssqp; int ldc; int Mtot; float eps; int pad;
    __device__ __forceinline__ void preload(PG8_LAS unsigned char* lds, const Unit& u, int wr, int wc, int lane) const {
        if (!ssqp) return;
#pragma unroll
        for (int ai = 0; ai < 2; ++ai) __builtin_amdgcn_global_load_lds((const unsigned*)(ssqp + (size_t)wc * Mtot + u.pm * BM + ai * HALF + wr * 64 + lane), (PG8_LAS unsigned*)(lds + SSQ_LDS + (((wr * 2 + ai) * 4 + wc) * 64) * 4), 4, 0, 0);
    }
    __device__ __forceinline__ void preload_unit(PG8_LAS unsigned char*, const Unit&, int, int, int) const {}
    __device__ __forceinline__ void operator()(f32x4 (&acc)[2][2][4][2], const Unit& u, int wr, int wc, int fr, int fq, PG8_LAS unsigned char* lds) const {
        const int row0 = u.pm * BM + wr * 64 + fr; const int col0 = u.pn * BM + wc * 32 + 8 * fq;
        const PG8_LAS float* sl = (const PG8_LAS float*)(lds + SSQ_LDS);
#pragma unroll
        for (int ai = 0; ai < 2; ++ai)
#pragma unroll
            for (int m = 0; m < 4; ++m) { const int row = row0 + ai * HALF + m * 16; float rs = 1.f;
                if (ssqp) { const PG8_LAS float* sp = sl + ((wr * 2 + ai) * 4) * 64 + m * 16 + fr; const float s = (sp[0] + sp[64]) + (sp[128] + sp[192]); rs = 1.0f / sqrtf(s * (1.0f / 1024.0f) + eps); }
                bf16_t* rowp = O + (size_t)row * ldc + col0;
#pragma unroll
                for (int bj = 0; bj < 2; ++bj) { const f32x4 v0 = acc[ai][bj][m][0] * rs, v1 = acc[ai][bj][m][1] * rs;
                    u32x4 w; w.x = cvt_pk_bf16(v0[0], v0[1]); w.y = cvt_pk_bf16(v0[2], v0[3]); w.z = cvt_pk_bf16(v1[0], v1[1]); w.w = cvt_pk_bf16(v1[2], v1[3]);
                    *(u32x4*)(rowp + bj * HALF) = w; } }
    }
};

__device__ __forceinline__ float gelu_tanh_f(float x) { const float u = 0.7978845608028654f * (x + 0.044715f * x * x * x); const float t = 1.0f - 2.0f / (1.0f + __expf(2.0f * u)); return 0.5f * x * (1.0f + t); }
struct EpiFfn {
    static constexpr bool PERM = true, AFTER_DRAIN = false;
    bf16_t* H; const float* ssqp; const float* cw; const float* cb; int Mtot; float eps;
    __device__ __forceinline__ void preload(PG8_LAS unsigned char* lds, const Unit& u, int wr, int wc, int lane) const {
        const int rowb = (u.pm / 17) * 4096 + 254 * (u.pm % 17) - 2;
#pragma unroll
        for (int ai = 0; ai < 2; ++ai) { const int row = rowb + ai * HALF + wr * 64 + lane; const int rc = row < 0 ? 0 : (row >= Mtot ? Mtot - 1 : row);
            __builtin_amdgcn_global_load_lds((const unsigned*)(ssqp + (size_t)wc * Mtot + rc), (PG8_LAS unsigned*)(lds + SSQ_LDS + (((wr * 2 + ai) * 4 + wc) * 64) * 4), 4, 0, 0); }
    }
    __device__ __forceinline__ void preload_unit(PG8_LAS unsigned char* lds, const Unit& u, int wr, int wc, int lane) const {
        const float* src = (wc < 3 ? cw + (size_t)wc * 2816 : cb) + u.pn * 128 + 64 * wr + lane;
        __builtin_amdgcn_global_load_lds((const unsigned*)src, (PG8_LAS unsigned*)(lds + CW_LDS + (wc * 128 + 64 * wr) * 4), 4, 0, 0);
    }
    __device__ __forceinline__ void operator()(f32x4 (&acc)[2][2][4][2], const Unit& u, int wr, int wc, int fr, int fq, PG8_LAS unsigned char* lds) const {
        constexpr int DFF_ = 2816;
        const int b = u.pm / 17, t = u.pm % 17, pos0 = 254 * t - 2, rowb = b * 4096 + pos0;
        const int colh = u.pn * 128 + wc * 32 + 8 * fq, lane = fq * 16 + fr;
        PG8_LAS float* halo = (PG8_LAS float*)(lds + STAGE_BYTES);
#pragma unroll
        for (int ai = 0; ai < 2; ++ai)
#pragma unroll
            for (int m = 0; m < 4; ++m) { const int rl = ai * HALF + wr * 64 + m * 16 + fr; const PG8_LAS float* sp = (const PG8_LAS float*)(lds + SSQ_LDS) + ((wr * 2 + ai) * 4) * 64 + m * 16 + fr;
                const float sq = (sp[0] + sp[64]) + (sp[128] + sp[192]); const float rs = 1.0f / sqrtf(sq * (1.0f / 1024.0f) + eps); const bool pad = (pos0 + rl) < 0;
#pragma unroll
                for (int n = 0; n < 2; ++n) {
#pragma unroll
                    for (int e = 0; e < 4; ++e) { acc[ai][0][m][n][e] = pad ? 0.f : acc[ai][0][m][n][e] * rs; acc[ai][1][m][n][e] *= rs; } } }
#pragma unroll
        for (int ai = 0; ai < 2; ++ai) if (fr >= 14) { PG8_LAS float* hp = halo + ((((2 * ai + wr) * 4 + wc) * 4 + fq) * 2 + (fr - 14)) * 8;
            *(PG8_LAS f32x4*)hp = acc[ai][0][3][0]; *(PG8_LAS f32x4*)(hp + 4) = acc[ai][0][3][1]; }
        asm volatile("s_waitcnt lgkmcnt(0)" ::: "memory"); __builtin_amdgcn_s_barrier(); asm volatile("" ::: "memory");
        typedef unsigned u32x2e __attribute__((ext_vector_type(2)));
#define DPPF(x, ctrl) __builtin_bit_cast(float, __builtin_amdgcn_update_dpp(0, __builtin_bit_cast(int, (x)), (ctrl), 0xf, 0xf, true))
#pragma unroll
        for (int n = 0; n < 2; ++n) {
            const PG8_LAS float* cwl = (const PG8_LAS float*)(lds + CW_LDS) + wc * 32 + 8 * fq + 4 * n;
            const f32x4 w0 = *(const PG8_LAS f32x4*)cwl, w1 = *(const PG8_LAS f32x4*)(cwl + 128), w2 = *(const PG8_LAS f32x4*)(cwl + 256), bb = *(const PG8_LAS f32x4*)(cwl + 384);
#pragma unroll
            for (int ai = 0; ai < 2; ++ai) {
                const int blk = 2 * ai + wr; f32x4 R1p = (f32x4){0.f, 0.f, 0.f, 0.f}, R2p = (f32x4){0.f, 0.f, 0.f, 0.f};
                if (blk >= 1) { const PG8_LAS float* hp = halo + ((((blk - 1) * 4 + wc) * 4 + fq) * 2) * 8 + 4 * n; const f32x4 h62 = *(const PG8_LAS f32x4*)hp, h63 = *(const PG8_LAS f32x4*)(hp + 8);
                    const f32x4 z4 = (f32x4){0.f, 0.f, 0.f, 0.f}; R1p = fr == 0 ? h63 : z4; R2p = fr == 0 ? h62 : (fr == 1 ? h63 : z4); }
#pragma unroll
                for (int m = 0; m < 4; ++m) { const int rl = ai * HALF + wr * 64 + m * 16 + fr; const bool ok = (rl >= 2) && (pos0 + rl < 4096);
                    float hv[4];
#pragma unroll
                    for (int e = 0; e < 4; ++e) { const float v = acc[ai][0][m][n][e];
                        const float p1 = DPPF(v, 0x111) + R1p[e], p2 = DPPF(v, 0x112) + R2p[e]; R1p[e] = DPPF(v, 0x10F); R2p[e] = DPPF(v, 0x10E);
                        const float y = w0[e] * p2 + (w1[e] * p1 + (w2[e] * v + bb[e]));
                        const float tq = y * (-2.302208198f + -0.10294324f * (y * y));
                        const float sg = __builtin_amdgcn_rcpf(1.0f + __builtin_amdgcn_exp2f(tq));
                        hv[e] = (y * acc[ai][1][m][n][e]) * sg; }
                    if (ok) { u32x2e w; w.x = cvt_pk_bf16(hv[0], hv[1]); w.y = cvt_pk_bf16(hv[2], hv[3]); *(u32x2e*)(H + (size_t)(rowb + rl) * DFF_ + colh + 4 * n) = w; } }
            }
        }
#undef DPPF
        asm volatile("s_waitcnt lgkmcnt(0)" ::: "memory"); __builtin_amdgcn_s_barrier(); asm volatile("" ::: "memory");
    }
};
struct EpiResid {
    static constexpr bool PERM = false, AFTER_DRAIN = true;
    const float* base; float* out; bf16_t* xb; float* ssqp; int ldc; int Mtot;
    __device__ __forceinline__ void init(f32x4 (&acc)[2][2][4][2], const Unit& u, int wr, int wc, int fr, int fq) const {
        const int col0 = u.pn * BM + wc * 32 + 4 * fq;
#pragma unroll
        for (int ai = 0; ai < 2; ++ai)
#pragma unroll
            for (int m = 0; m < 4; ++m) { const size_t off = (size_t)(u.pm * BM + ai * HALF + wr * 64 + m * 16 + fr) * ldc + col0;
#pragma unroll
                for (int bj = 0; bj < 2; ++bj)
#pragma unroll
                    for (int n = 0; n < 2; ++n) {
                        if (base) acc[ai][bj][m][n] = *(const f32x4*)(base + off + bj * HALF + n * 16);
                        else { typedef unsigned u32x2i __attribute__((ext_vector_type(2))); const u32x2i w = *(const u32x2i*)(xb + off + bj * HALF + n * 16);
                            acc[ai][bj][m][n] = (f32x4){__uint_as_float(w.x << 16), __uint_as_float(w.x & 0xffff0000u), __uint_as_float(w.y << 16), __uint_as_float(w.y & 0xffff0000u)}; } } }
    }
    __device__ __forceinline__ void fused(f32x4 (&acc)[2][2][4][2], const Unit& u, int wr, int wc, int fr, int fq, PG8_LAS unsigned char* lds, int wid, int lane) const {
        typedef unsigned u32x2v __attribute__((ext_vector_type(2)));
        PG8_LAS float* P = (PG8_LAS float*)lds;
        const int col0 = u.pn * BM + wc * 32 + 4 * fq;
#pragma unroll
        for (int ai = 0; ai < 2; ++ai)
#pragma unroll
            for (int m = 0; m < 4; ++m) { const int r = ai * HALF + wr * 64 + m * 16 + fr; const size_t off = (size_t)(u.pm * BM + r) * ldc + col0; float s = 0.f;
#pragma unroll
                for (int bj = 0; bj < 2; ++bj)
#pragma unroll
                    for (int n = 0; n < 2; ++n) { const f32x4 o = acc[ai][bj][m][n];
                        if (out) *(f32x4*)(out + off + bj * HALF + n * 16) = o; u32x2v w; w.x = cvt_pk_bf16(o[0], o[1]); w.y = cvt_pk_bf16(o[2], o[3]); *(u32x2v*)(xb + off + bj * HALF + n * 16) = w;
                        s += (o[0] * o[0] + o[1] * o[1]) + (o[2] * o[2] + o[3] * o[3]); }
                s += __shfl_xor(s, 16); s += __shfl_xor(s, 32);
                if (fq == 0) P[r * 4 + wc] = s;
                if (m & 1) asm volatile("" ::: "memory"); }
        asm volatile("s_waitcnt lgkmcnt(0)" ::: "memory"); __builtin_amdgcn_s_barrier(); asm volatile("" ::: "memory");
        if (lane < 32) { const int row = wid * 32 + lane; ssqp[(size_t)u.pn * Mtot + u.pm * BM + row] = (P[row * 4 + 0] + P[row * 4 + 1]) + (P[row * 4 + 2] + P[row * 4 + 3]); }
        asm volatile("s_waitcnt lgkmcnt(0)" ::: "memory"); __builtin_amdgcn_s_barrier(); asm volatile("" ::: "memory");
    }
};

template <class Epi, class Sched, bool ALIGN_EPI = false, bool SP2 = false>
__device__ __forceinline__ void gemm_phase(PG8_LAS unsigned char* lds, const Gemm g, const Sched& S, const Epi& E, int tid_in) {
    int tid_l = tid_in; asm volatile("" : "+v"(tid_l));
    const int tid = tid_l, wid = __builtin_amdgcn_readfirstlane(tid >> 6), lane = tid & 63, wr = wid >> 2, wc = wid & 3, fr = lane & 15, fq = lane >> 4;
    const int K = g.K, nt = K / BK;
    unsigned voffA[2], voffB[2];
#pragma unroll
    for (int i = 0; i < 2; ++i) { int R, C; stage_rc(tid * 16 + i * 8192, R, C); const int Rb = Epi::PERM ? ((R & ~31) + perm32(R & 31)) : R;
        voffA[i] = (unsigned)(R * g.lda + C) * 2u; voffB[i] = (unsigned)(Rb * K + C) * 2u; }
    const size_t kstep = (size_t)(BK * 2);
    const size_t hstepA = (size_t)HALF * g.lda * 2, hstepB = (size_t)HALF * K * 2;
    const size_t tstepB = 2 * hstepB;
    const unsigned ldsw = (unsigned)wid * 1024u;
    const int aoff = lds_byte(wr * 64 + fr, fq * 8), boff = lds_byte(wc * 32 + fr, fq * 8);
#define PG8_SA(b, h) (((b) * 2 + (h)) * HTB)
#define PG8_SB(b, h) ((4 + (b) * 2 + (h)) * HTB)
#define PG8_STAGE(bufoff, gbase, voff) do { _Pragma("unroll") for (int _i = 0; _i < 2; ++_i) \
        __builtin_amdgcn_global_load_lds((const unsigned*)((const char*)(gbase) + (voff)[_i]), (PG8_LAS unsigned*)(lds + (bufoff) + ldsw + _i * 8192), 16, 0, 0); } while (0)
#define PG8_LDA(dst, b, h) do { _Pragma("unroll") for (int m = 0; m < 4; ++m) _Pragma("unroll") for (int k = 0; k < 2; ++k) dst[m][k] = *(const PG8_LAS bf16x8*)(lds + PG8_SA(b, h) + aoff + m * 2048 + k * 1024); } while (0)
#define PG8_LDB(dst, b, h) do { _Pragma("unroll") for (int n = 0; n < 2; ++n) _Pragma("unroll") for (int k = 0; k < 2; ++k) dst[n][k] = *(const PG8_LAS bf16x8*)(lds + PG8_SB(b, h) + boff + n * 2048 + k * 1024); } while (0)
#define PG8_MMA(ai, bj, At, Bt) do { __builtin_amdgcn_s_setprio(1); _Pragma("unroll") for (int m = 0; m < 4; ++m) _Pragma("unroll") for (int n = 0; n < 2; ++n) _Pragma("unroll") for (int k = 0; k < 2; ++k) \
        acc[ai][bj][m][n] = __builtin_amdgcn_mfma_f32_16x16x32_bf16(Bt[n][k], At[m][k], acc[ai][bj][m][n], 0, 0, 0); __builtin_amdgcn_s_setprio(0); } while (0)
#define PG8_WAIT_V(n) asm volatile("s_waitcnt vmcnt(" #n ")" ::: "memory")
#define PG8_WAIT_L(n) asm volatile("s_waitcnt lgkmcnt(" #n ")" ::: "memory")
#define PG8_BAR __builtin_amdgcn_s_barrier()
#define PG8_SCHED __builtin_amdgcn_sched_barrier(0)
    Unit cur, nxt; int ui = 0;
    if (!S.next(0, cur)) return;
    f32x4 acc[2][2][4][2];
#pragma unroll
    for (int a = 0; a < 2; ++a)
#pragma unroll
        for (int b = 0; b < 2; ++b)
#pragma unroll
            for (int m = 0; m < 4; ++m)
#pragma unroll
                for (int n = 0; n < 2; ++n) acc[a][b][m][n] = (f32x4){0.f, 0.f, 0.f, 0.f};
    if constexpr (Epi::AFTER_DRAIN) E.init(acc, cur, wr, wc, fr, fq);
    bf16x8 At[4][2], B0[2][2], B1[2][2];
    const char* cA = (const char*)g.A + (ptrdiff_t)S.arow(cur) * (ptrdiff_t)(g.lda * 2); const char* cB = (const char*)g.Bt + (size_t)cur.pn * tstepB;
    S.a_ready(cur);
    if constexpr (!Epi::AFTER_DRAIN) E.preload_unit(lds, cur, wr, wc, lane);
    if constexpr (SP2) {
        PG8_STAGE(PG8_SB(0, 0), cB, voffB); PG8_STAGE(PG8_SB(0, 1), cB + hstepB, voffB); PG8_STAGE(PG8_SA(0, 0), cA, voffA); PG8_STAGE(PG8_SA(0, 1), cA + hstepA, voffA);
        if (wr == 1) PG8_BAR;
        PG8_WAIT_V(2); PG8_BAR;
        PG8_STAGE(PG8_SB(1, 0), cB + kstep, voffB); PG8_STAGE(PG8_SA(1, 0), cA + kstep, voffA); PG8_STAGE(PG8_SB(1, 1), cB + hstepB + kstep, voffB);
        PG8_WAIT_V(6); PG8_BAR;
        if constexpr (Epi::AFTER_DRAIN) {
#pragma unroll
            for (int a_ = 0; a_ < 2; ++a_)
#pragma unroll
                for (int b_ = 0; b_ < 2; ++b_) asm volatile("" : "+v"(acc[a_][b_][0][0]), "+v"(acc[a_][b_][0][1]), "+v"(acc[a_][b_][1][0]), "+v"(acc[a_][b_][1][1]), "+v"(acc[a_][b_][2][0]), "+v"(acc[a_][b_][2][1]), "+v"(acc[a_][b_][3][0]), "+v"(acc[a_][b_][3][1]));
        }
    } else {
        PG8_STAGE(PG8_SB(0, 0), cB, voffB); PG8_STAGE(PG8_SA(0, 0), cA, voffA); PG8_STAGE(PG8_SB(0, 1), cB + hstepB, voffB); PG8_STAGE(PG8_SA(0, 1), cA + hstepA, voffA);
        if (wr == 1) PG8_BAR;
        PG8_WAIT_V(4); PG8_BAR;
        PG8_STAGE(PG8_SB(1, 0), cB + kstep, voffB); PG8_STAGE(PG8_SA(1, 0), cA + kstep, voffA); PG8_STAGE(PG8_SB(1, 1), cB + hstepB + kstep, voffB);
        PG8_WAIT_V(6); PG8_BAR;
    }
    for (;;) {
        const bool has_next = S.next(ui + 1, nxt);
        const char* nA = has_next ? (const char*)g.A + (ptrdiff_t)S.arow(nxt) * (ptrdiff_t)(g.lda * 2) : cA; const char* nB = has_next ? (const char*)g.Bt + (size_t)nxt.pn * tstepB : cB;
        for (int t = 0; t < nt; t += 2) {
            const bool last = (t == nt - 2);
            const char* a1 = cA + (size_t)(t + 1) * kstep;
            const char* a2 = last ? nA : cA + (size_t)(t + 2) * kstep; const char* b2 = last ? nB : cB + (size_t)(t + 2) * kstep;
            const char* a3 = a2 + kstep; const char* b3 = b2 + kstep;
            if (last && has_next) S.a_ready(nxt);
            if constexpr (!Epi::AFTER_DRAIN) { if (last) E.preload(lds, cur, wr, wc, lane); }
            if constexpr (SP2) {
            PG8_LDB(B0, 0, 0); PG8_LDB(B1, 0, 1); PG8_SCHED; PG8_LDA(At, 0, 0); PG8_STAGE(PG8_SA(1, 1), a1 + hstepA, voffA);
            PG8_WAIT_V(8); PG8_WAIT_L(0); PG8_BAR; PG8_MMA(0, 0, At, B0); PG8_MMA(0, 1, At, B1); PG8_BAR; PG8_SCHED;
            PG8_LDA(At, 0, 1); PG8_STAGE(PG8_SB(0, 0), b2, voffB); PG8_STAGE(PG8_SB(0, 1), b2 + hstepB, voffB); PG8_STAGE(PG8_SA(0, 0), a2, voffA);
            PG8_WAIT_V(8); PG8_WAIT_L(0); PG8_BAR; PG8_MMA(1, 0, At, B0); PG8_MMA(1, 1, At, B1); PG8_BAR; PG8_SCHED;
            PG8_LDB(B0, 1, 0); PG8_LDB(B1, 1, 1); PG8_SCHED; PG8_LDA(At, 1, 0); PG8_STAGE(PG8_SA(0, 1), a2 + hstepA, voffA);
            PG8_WAIT_V(8); PG8_WAIT_L(0); PG8_BAR; PG8_MMA(0, 0, At, B0); PG8_MMA(0, 1, At, B1); PG8_BAR; PG8_SCHED;
            PG8_LDA(At, 1, 1); PG8_STAGE(PG8_SB(1, 0), b3, voffB); PG8_STAGE(PG8_SB(1, 1), b3 + hstepB, voffB); PG8_STAGE(PG8_SA(1, 0), a3, voffA);
            PG8_WAIT_V(8); PG8_WAIT_L(0); PG8_BAR; PG8_MMA(1, 0, At, B0); PG8_MMA(1, 1, At, B1); PG8_BAR; PG8_SCHED;
            } else {
            PG8_LDB(B0, 0, 0); PG8_SCHED; PG8_LDA(At, 0, 0); PG8_STAGE(PG8_SA(1, 1), a1 + hstepA, voffA);
            PG8_WAIT_L(8); PG8_BAR; PG8_WAIT_L(0); PG8_MMA(0, 0, At, B0); PG8_BAR; PG8_SCHED;
            PG8_LDB(B1, 0, 1); PG8_STAGE(PG8_SB(0, 0), b2, voffB);
            PG8_BAR; PG8_WAIT_L(0); PG8_MMA(0, 1, At, B1); PG8_BAR;
            PG8_LDA(At, 0, 1); PG8_STAGE(PG8_SA(0, 0), a2, voffA);
            PG8_BAR; PG8_WAIT_L(0); PG8_MMA(1, 0, At, B0); PG8_BAR; PG8_SCHED;
            PG8_STAGE(PG8_SB(0, 1), b2 + hstepB, voffB);
            PG8_WAIT_V(6); PG8_BAR; PG8_MMA(1, 1, At, B1); PG8_BAR;
            PG8_LDB(B0, 1, 0); PG8_SCHED; PG8_LDA(At, 1, 0); PG8_STAGE(PG8_SA(0, 1), a2 + hstepA, voffA);
            PG8_WAIT_L(8); PG8_BAR; PG8_WAIT_L(0); PG8_MMA(0, 0, At, B0); PG8_BAR; PG8_SCHED;
            PG8_LDB(B1, 1, 1); PG8_STAGE(PG8_SB(1, 0), b3, voffB);
            PG8_BAR; PG8_WAIT_L(0); PG8_MMA(0, 1, At, B1); PG8_BAR;
            PG8_LDA(At, 1, 1); PG8_STAGE(PG8_SA(1, 0), a3, voffA);
            PG8_BAR; PG8_WAIT_L(0); PG8_MMA(1, 0, At, B0); PG8_BAR; PG8_SCHED;
            PG8_STAGE(PG8_SB(1, 1), b3 + hstepB, voffB);
            PG8_WAIT_V(6); PG8_BAR; PG8_MMA(1, 1, At, B1); PG8_BAR;
            }
        }
        if constexpr (ALIGN_EPI) { if (wr == 0) PG8_BAR; }
        if constexpr (!Epi::AFTER_DRAIN) { E(acc, cur, wr, wc, fr, fq, lds); S.done(cur); if (has_next) E.preload_unit(lds, nxt, wr, wc, lane); }
        if (!has_next) break;
#pragma unroll
        for (int a = 0; a < 2; ++a)
#pragma unroll
            for (int b = 0; b < 2; ++b)
#pragma unroll
                for (int m = 0; m < 4; ++m)
#pragma unroll
                    for (int n = 0; n < 2; ++n) acc[a][b][m][n] = (f32x4){0.f, 0.f, 0.f, 0.f};
        cur = nxt; cA = nA; cB = nB; ++ui;
        if constexpr (ALIGN_EPI) { if (wr == 1) PG8_BAR; }
    }
    PG8_WAIT_V(0);
    if constexpr (!ALIGN_EPI) { if (wr == 0) PG8_BAR; }
    PG8_BAR;
    if constexpr (Epi::AFTER_DRAIN) { E.fused(acc, cur, wr, wc, fr, fq, lds, wid, lane); S.done(cur); }
#undef PG8_SA
#undef PG8_SB
#undef PG8_STAGE
#undef PG8_LDA
#undef PG8_LDB
#undef PG8_MMA
#undef PG8_WAIT_V
#undef PG8_WAIT_L
#undef PG8_BAR
#undef PG8_SCHED
}
}


#define GAS __attribute__((address_space(1)))
#define LAS __attribute__((address_space(3)))
typedef unsigned short bf16;
typedef unsigned v4u __attribute__((ext_vector_type(4)));
typedef unsigned v2u __attribute__((ext_vector_type(2)));
typedef float f32x4 __attribute__((ext_vector_type(4)));
constexpr int BATCH = 4, SEQ = 4096, D = 1024, M = BATCH * SEQ, NMEM = 256, MM = BATCH * NMEM, DFF = 2816;
constexpr int EV_IN = 4096, OD_IN = 3072;
constexpr float EPS = 1e-6f;
constexpr int Z_RQ = 0, Z_GQ = 512, Z_RK = 1024, Z_RV = 1536, Z_RG = 2048, Z_GF = 2560, Z_GI = 3072, Z_GG = 3584;

constexpr size_t MiB = 1u << 20;
constexpr size_t WS_CTL = 0;
constexpr size_t WS_EVIN = 1 * MiB, WS_EVOUT = 9 * MiB, WS_XQ0 = 11 * MiB, WS_XKV0 = 13 * MiB, WS_XO0 = 17 * MiB, WS_FIN0 = 19 * MiB, WS_FOUT0 = 30 * MiB;
constexpr size_t WS_ODIN = 36 * MiB, WS_ODOUT = 42 * MiB, WS_XQ1 = 44 * MiB, WS_XKV1 = 46 * MiB, WS_XO1 = 50 * MiB, WS_FIN1 = 52 * MiB, WS_FOUT1 = 63 * MiB;
constexpr size_t WS_XB = 69 * MiB;
constexpr size_t WS_MKV0 = 101 * MiB, WS_MKV1 = 105 * MiB;
constexpr size_t WS_MEMH0 = 109 * MiB, WS_MEMH1 = 111 * MiB;
constexpr size_t WS_SSQP = 113 * MiB;
constexpr size_t WS_LB = 113 * MiB + 512 * 1024;
constexpr size_t WS_BIAST = 113 * MiB + 516 * 1024;
constexpr size_t WS_GXA = 113 * MiB + 600 * 1024, WS_GOD = 113 * MiB + 604 * 1024;
constexpr size_t WS_DEN23 = 114 * MiB;
constexpr size_t WS_N2 = 1 * MiB;
constexpr size_t WS_ACT = 115 * MiB;
constexpr size_t WS_DECA = 243 * MiB, WS_DECB = 243 * MiB + 512 * 1024;
constexpr size_t WS_END = 256 * MiB;

__device__ __forceinline__ float bf2f(bf16 u) { return __uint_as_float((unsigned)u << 16); }
__device__ __forceinline__ unsigned f2bf(float f) { unsigned u = __builtin_bit_cast(unsigned, f); return (u + 0x7fffu + ((u >> 16) & 1u)) >> 16; }
__device__ __forceinline__ unsigned pk2(float lo, float hi) { return f2bf(lo) | (f2bf(hi) << 16); }
__device__ __forceinline__ float wave_sum(float v) {
#pragma unroll
    for (int o = 1; o < 64; o <<= 1) v += __shfl_xor(v, o);
    return v;
}
__device__ __forceinline__ float wave_max(float v) {
#pragma unroll
    for (int o = 1; o < 64; o <<= 1) v = fmaxf(v, __shfl_xor(v, o));
    return v;
}
__device__ __forceinline__ void unpack8(const v4u w, float (&f)[8]) {
    f[0] = __uint_as_float(w.x << 16); f[1] = __uint_as_float(w.x & 0xffff0000u); f[2] = __uint_as_float(w.y << 16); f[3] = __uint_as_float(w.y & 0xffff0000u);
    f[4] = __uint_as_float(w.z << 16); f[5] = __uint_as_float(w.z & 0xffff0000u); f[6] = __uint_as_float(w.w << 16); f[7] = __uint_as_float(w.w & 0xffff0000u);
}
__device__ __forceinline__ void rope_sincos(float a, float& s, float& c) {
    const float n = rintf(a * 0.15915494309189535f);
    float r = fmaf(-n, 6.2831854820251465f, a); r = fmaf(-n, -1.7484555e-7f, r);
    const float rev = r * 0.15915494309189535f;
    s = __builtin_amdgcn_sinf(rev); c = __builtin_amdgcn_cosf(rev);
}

__device__ __forceinline__ int dst_row_map(int mode, int n0) {
    if (mode == 1) { const int seg = n0 >> 9, within = n0 & 511; const int dseg = (seg == 0) ? 0 : (seg == 4 ? 1 : (seg < 4 ? seg + 1 : seg)); return dseg * 512 + within; }
    if (mode == 2) { return n0 < DFF ? (n0 >> 7) * 256 + (n0 & 127) : ((n0 - DFF) >> 7) * 256 + 128 + ((n0 - DFF) & 127); }
    return n0;
}
__device__ __forceinline__ void transpose_item(const float* W, int K, int N, const float* g, bf16* WT, int mode, LAS float* scr, int item, int lane) {
    const int nblk = N / 64, kb = item / nblk, nb = item % nblk, k0 = 64 * kb, n0 = 64 * nb, lr = lane >> 4, lc = lane & 15;
    f32x4 v[16];
#pragma unroll
    for (int i = 0; i < 16; ++i) v[i] = *(const f32x4*)(W + (size_t)(k0 + 4 * i + lr) * N + n0 + 4 * lc);
#pragma unroll
    for (int i = 0; i < 16; ++i) { const int kk = 4 * i + lr; const float gg = g ? g[k0 + kk] : 1.0f; LAS float* p = scr + kk * 65 + 4 * lc; p[0] = v[i][0] * gg; p[1] = v[i][1] * gg; p[2] = v[i][2] * gg; p[3] = v[i][3] * gg; }
    asm volatile("s_waitcnt lgkmcnt(0)" ::: "memory");
    const int c = lane & 7; const int d0 = dst_row_map(mode, n0);
#pragma unroll
    for (int j = 0; j < 8; ++j) { const int n = (lane >> 3) + 8 * j; const LAS float* sp = scr + (8 * c) * 65 + n;
        v4u o; o.x = pk2(sp[0 * 65], sp[1 * 65]); o.y = pk2(sp[2 * 65], sp[3 * 65]); o.z = pk2(sp[4 * 65], sp[5 * 65]); o.w = pk2(sp[6 * 65], sp[7 * 65]);
        *(v4u*)(WT + (size_t)(d0 + n) * K + k0 + 8 * c) = o; }
    asm volatile("s_waitcnt lgkmcnt(0)" ::: "memory");
}
struct ProArgs { const float* in[25]; unsigned char* ws; int layer_mask; int ffn_mode; };
#define CONVERT_JOB(Wp, K_, N_, gp, dst, mode) do { const int nitems = ((K_) / 64) * ((N_) / 64); for (int it = gw; it < nitems; it += NGW) transpose_item((Wp), (K_), (N_), (gp), (bf16*)(ws + (dst)), (mode), scr, it, lane); } while (0)
__device__ __forceinline__ void prologue_body(const ProArgs& a, int gw, int NGW, int lane, LAS float* scr) {
    unsigned char* ws = a.ws;
    const float* x = a.in[0]; const float* mem = a.in[1];
    if (a.layer_mask & 1) {
        CONVERT_JOB(a.in[3], D, EV_IN, a.in[2], WS_EVIN, 1);
        CONVERT_JOB(a.in[7], D, D, (const float*)nullptr, WS_EVOUT, 0);
        CONVERT_JOB(a.in[15], D, D, a.in[13], WS_XQ0, 0);
        CONVERT_JOB(a.in[16], D, 2 * D, (const float*)nullptr, WS_XKV0, 0);
        CONVERT_JOB(a.in[19], D, D, (const float*)nullptr, WS_XO0, 0);
        CONVERT_JOB(a.in[21], D, 2 * DFF, a.in[20], WS_FIN0, a.ffn_mode);
        CONVERT_JOB(a.in[24], DFF, D, (const float*)nullptr, WS_FOUT0, 0);
        for (int m = 2 * gw; m < M; m += 2 * NGW) {
            const f32x4* xr = (const f32x4*)(x + (size_t)m * D) + lane; v2u* o8 = (v2u*)((bf16*)(ws + WS_XB) + (size_t)m * D) + lane; float* sp = (float*)(ws + WS_SSQP);
            f32x4 v[8];
#pragma unroll
            for (int j = 0; j < 8; ++j) v[j] = xr[64 * j];
#pragma unroll
            for (int j = 0; j < 8; ++j) { v2u w; w.x = pk2(v[j][0], v[j][1]); w.y = pk2(v[j][2], v[j][3]); o8[64 * j] = w;
                const float s2 = wave_sum((v[j][0] * v[j][0] + v[j][1] * v[j][1]) + (v[j][2] * v[j][2] + v[j][3] * v[j][3])); if (lane == 0) sp[(size_t)(j & 3) * M + m + (j >> 2)] = s2; }
        }
        for (int r = gw; r < 2 * MM; r += NGW) { const int l = r / MM, m = r % MM;
            const f32x4* xr = (const f32x4*)(mem + (size_t)m * D) + lane; const f32x4* gr = (const f32x4*)(a.in[14] + (size_t)l * D) + lane;
            f32x4 v[4]; float s = 0.f;
#pragma unroll
            for (int j = 0; j < 4; ++j) { v[j] = xr[64 * j]; s += (v[j][0] * v[j][0] + v[j][1] * v[j][1]) + (v[j][2] * v[j][2] + v[j][3] * v[j][3]); }
            const float rs = 1.0f / sqrtf(wave_sum(s) * (1.0f / D) + EPS);
            v2u* o8 = (v2u*)((bf16*)(ws + (l ? WS_MEMH1 : WS_MEMH0)) + (size_t)m * D) + lane;
#pragma unroll
            for (int j = 0; j < 4; ++j) { const f32x4 g = gr[64 * j]; v2u w; w.x = pk2(v[j][0] * rs * g[0], v[j][1] * rs * g[1]); w.y = pk2(v[j][2] * rs * g[2], v[j][3] * rs * g[3]); o8[64 * j] = w; }
        }
        if (gw == 0) {
            const float* lg = a.in[6]; float* lb = (float*)(ws + WS_LB);
            for (int c = lane; c < 512; c += 64) { const float a0 = lg[c], a1 = lg[512 + c], a2 = lg[1024 + c]; const float mx = fmaxf(a0, fmaxf(a1, a2));
                const float e0 = expf(a0 - mx), e1 = expf(a1 - mx), e2 = expf(a2 - mx); lb[c] = e0 / (e0 + e1 + e2); }
        }
        if (gw == 2) {
            float* gx = (float*)(ws + WS_GXA); float* go = (float*)(ws + WS_GOD);
            for (int i = lane; i < 512; i += 64) gx[i] = a.in[18][i] * a.in[17][i];
            for (int i = lane; i < 128; i += 64) go[i] = a.in[10][i] * a.in[9][i];
        }
        if (gw == 1) {
            const float* rb = a.in[11]; float* bt = (float*)(ws + WS_BIAST);
            for (int i = lane; i < 3 * 8 * 132; i += 64) { const int br = i / (8 * 132), h = (i / 132) % 8, dl = i % 132; const int d = dl * (1 << (2 * br));
                int bucket; if (d < 16) bucket = d; else { const float lr = logf((float)d / 16.0f) / 4.852030263919617f; int lg2 = 16 + (int)(lr * 16.0f); bucket = lg2 < 31 ? lg2 : 31; }
                bt[i] = (dl <= 128) ? rb[bucket * 8 + h] : 0.f; }
        }
    }
    if (a.layer_mask & 2) {
        CONVERT_JOB(a.in[8], D, OD_IN, a.in[2] + D, WS_ODIN, 0);
        CONVERT_JOB(a.in[12], D, D, (const float*)nullptr, WS_ODOUT, 0);
        CONVERT_JOB(a.in[15] + (size_t)D * D, D, D, a.in[13] + D, WS_XQ1, 0);
        CONVERT_JOB(a.in[16] + (size_t)D * 2 * D, D, 2 * D, (const float*)nullptr, WS_XKV1, 0);
        CONVERT_JOB(a.in[19] + (size_t)D * D, D, D, (const float*)nullptr, WS_XO1, 0);
        CONVERT_JOB(a.in[21] + (size_t)D * 2 * DFF, D, 2 * DFF, a.in[20] + D, WS_FIN1, a.ffn_mode);
        CONVERT_JOB(a.in[24] + (size_t)DFF * D, DFF, D, (const float*)nullptr, WS_FOUT1, 0);
    }
}


typedef short bf16x8 __attribute__((ext_vector_type(8)));
typedef short s16x4 __attribute__((ext_vector_type(4)));
typedef float f32x16 __attribute__((ext_vector_type(16)));
typedef float f32x2_t __attribute__((ext_vector_type(2))); typedef __bf16 bf16x2_t __attribute__((ext_vector_type(2)));
typedef short v4i16_t __attribute__((ext_vector_type(4)));
#define MFMA32(a, b, c) __builtin_amdgcn_mfma_f32_32x32x16_bf16((a), (b), (c), 0, 0, 0)
__device__ __forceinline__ unsigned cvtpk(float lo, float hi) { f32x2_t v = {lo, hi}; bf16x2_t b = __builtin_convertvector(v, bf16x2_t); return __builtin_bit_cast(unsigned, b); }
__device__ __forceinline__ bf16x8 pack8(float a0, float a1, float a2, float a3, float a4, float a5, float a6, float a7) {
    v4u p; p.x = cvtpk(a0, a1); p.y = cvtpk(a2, a3); p.z = cvtpk(a4, a5); p.w = cvtpk(a6, a7); return __builtin_bit_cast(bf16x8, p); }
__device__ __forceinline__ s16x4 vtr(const LAS char* p) { return __builtin_bit_cast(s16x4, __builtin_amdgcn_ds_read_tr16_b64_v4i16((LAS v4i16_t*)p)); }
__device__ __forceinline__ int tr_lane_base(int lane, int stride) { const int g = lane >> 4, i = lane & 15, q = i >> 2, p = i & 3, h2 = g >> 1; return (4 * h2 + q) * stride + (16 * (g & 1) + 4 * p) * 2; }
__device__ __forceinline__ bf16x8 tr_frag_perm(const LAS char* img, int stride, int lbase, int k0, int n0) {
    const LAS char* p = img + lbase + k0 * stride + n0 * 2;
    const s16x4 lo = vtr(p), hi = vtr(p + 8 * stride);
    return (bf16x8){lo[0], lo[1], lo[2], lo[3], hi[0], hi[1], hi[2], hi[3]};
}
__device__ __forceinline__ int tr_lane_base_nat(int lane, int stride) { const int g = lane >> 4, i = lane & 15, q = i >> 2, p = i & 3, h2 = g >> 1; return (8 * h2 + q) * stride + (16 * (g & 1) + 4 * p) * 2; }
__device__ __forceinline__ bf16x8 tr_frag_nat(const LAS char* img, int stride, int lbase, int k0, int n0) {
    const LAS char* p = img + lbase + k0 * stride + n0 * 2;
    const s16x4 lo = vtr(p), hi = vtr(p + 4 * stride);
    return (bf16x8){lo[0], lo[1], lo[2], lo[3], hi[0], hi[1], hi[2], hi[3]};
}

#define LDS_BARRIER() do { asm volatile("s_waitcnt lgkmcnt(0)" ::: "memory"); __builtin_amdgcn_s_barrier(); asm volatile("" ::: "memory"); } while (0)
constexpr int XA_STRIDE = 528, XA_VSTRIDE = 576;
constexpr int XA_LDS = 256 * XA_STRIDE;
template <bool Q_IN_LDS> __device__ __forceinline__ void xattn_unit(LAS char* lds, const bf16* __restrict__ Q, const bf16* __restrict__ MKV, const float* __restrict__ gkq, bf16* __restrict__ O, int unit, int tid) {
    const int lane = tid & 63, w = __builtin_amdgcn_readfirstlane(tid >> 6), r = lane & 31, h2 = lane >> 5;
    const int rb = unit >> 2, h = unit & 3, row0 = rb * 256, b = row0 / SEQ;
    const bf16* Kg = MKV + (size_t)(b * NMEM) * 2048 + h * 256; const bf16* Vg = Kg + 1024;
    v4u st[16];
#pragma unroll
    for (int i = 0; i < 16; ++i) { const int id = tid + 512 * i; st[i] = *(const v4u*)(Kg + (size_t)(id >> 5) * 2048 + (id & 31) * 8); }
    const size_t qoff = (size_t)(row0 + 32 * w + r) * D + h * 256;
    bf16x8 qf[16];
    if (Q_IN_LDS) {
#pragma unroll
        for (int s = 0; s < 16; ++s) qf[s] = *(const LAS bf16x8*)(lds + (32 * w + r) * XA_STRIDE + h2 * 16 + s * 32);
        asm volatile("s_waitcnt lgkmcnt(0)" ::: "memory"); __builtin_amdgcn_s_barrier(); asm volatile("" ::: "memory");
    } else {
#pragma unroll
        for (int s = 0; s < 16; ++s) qf[s] = *(const bf16x8*)(Q + qoff + 8 * h2 + 16 * s);
    }
    { float gk8[8];
#pragma unroll
      for (int e = 0; e < 8; ++e) gk8[e] = gkq[(tid & 31) * 8 + e];
#pragma unroll
      for (int i = 0; i < 16; ++i) { const int id = tid + 512 * i; float f[8]; unpack8(st[i], f);
          float sq = (f[0] * f[0] + f[1] * f[1]) + (f[2] * f[2] + f[3] * f[3]) + (f[4] * f[4] + f[5] * f[5]) + (f[6] * f[6] + f[7] * f[7]);
          sq += __shfl_xor(sq, 1); sq += __shfl_xor(sq, 2); sq += __shfl_xor(sq, 4); sq += __shfl_xor(sq, 8); sq += __shfl_xor(sq, 16);
          const float rk = 1.0f / sqrtf(sq * (1.0f / 256.0f) + EPS) * 0.0625f;
          v4u o; o.x = cvtpk(f[0] * rk * gk8[0], f[1] * rk * gk8[1]); o.y = cvtpk(f[2] * rk * gk8[2], f[3] * rk * gk8[3]); o.z = cvtpk(f[4] * rk * gk8[4], f[5] * rk * gk8[5]); o.w = cvtpk(f[6] * rk * gk8[6], f[7] * rk * gk8[7]);
          *(LAS v4u*)(lds + (id >> 5) * XA_STRIDE + (id & 31) * 16) = o; } }
    float ss = 0.f;
#pragma unroll
    for (int s = 0; s < 16; ++s)
#pragma unroll
        for (int j = 0; j < 8; ++j) { const float x = __uint_as_float((unsigned)(unsigned short)qf[s][j] << 16); ss += x * x; }
    ss += __shfl_xor(ss, 32);
    const float rsl = 1.0f / sqrtf(ss * (1.0f / 256.0f) + EPS) * 1.4426950408889634f;
    asm volatile("" ::: "memory");
#pragma unroll
    for (int i = 0; i < 8; ++i) { const int id = tid + 512 * i; st[i] = *(const v4u*)(Vg + (size_t)(id >> 5) * 2048 + (id & 31) * 8); }
    LDS_BARRIER();
    bf16x8 pf[8][2]; float den = 0.f;
#pragma unroll
    for (int kb = 0; kb < 8; ++kb) {
        f32x16 acc;
#pragma unroll
        for (int i = 0; i < 16; ++i) acc[i] = 0.f;
        const LAS char* kp = lds + (32 * kb + r) * XA_STRIDE + h2 * 16;
#pragma unroll
        for (int s = 0; s < 16; ++s) { const bf16x8 a = *(const LAS bf16x8*)(kp + s * 32); acc = MFMA32(a, qf[s], acc); }
        float p[16];
#pragma unroll
        for (int i = 0; i < 16; ++i) { p[i] = __builtin_amdgcn_exp2f(acc[i] * rsl - 11.541560327111707f); den += p[i]; }
        pf[kb][0] = pack8(p[0], p[1], p[2], p[3], p[4], p[5], p[6], p[7]); pf[kb][1] = pack8(p[8], p[9], p[10], p[11], p[12], p[13], p[14], p[15]);
    }
    den += __shfl_xor(den, 32);
    const float inv = 1.0f / den;
    LDS_BARRIER();
#pragma unroll
    for (int i = 8; i < 16; ++i) { const int id = tid + 512 * i; st[i] = *(const v4u*)(Vg + (size_t)(id >> 5) * 2048 + (id & 31) * 8); }
#pragma unroll
    for (int i = 0; i < 16; ++i) { const int id = tid + 512 * i; *(LAS v4u*)(lds + (id >> 5) * XA_VSTRIDE + (id & 31) * 16) = st[i]; }
    LDS_BARRIER();
    const int lbase = tr_lane_base(lane, XA_VSTRIDE);
#pragma unroll
    for (int half = 0; half < 2; ++half) {
        f32x16 o[4];
#pragma unroll
        for (int vb = 0; vb < 4; ++vb)
#pragma unroll
            for (int i = 0; i < 16; ++i) o[vb][i] = 0.f;
#pragma unroll
        for (int kb = 0; kb < 8; ++kb)
#pragma unroll
            for (int s = 0; s < 2; ++s)
#pragma unroll
                for (int vb = 0; vb < 4; ++vb) { const bf16x8 a = tr_frag_perm(lds, XA_VSTRIDE, lbase, 32 * kb + 16 * s, 128 * half + 32 * vb); o[vb] = MFMA32(a, pf[kb][s], o[vb]); }
        bf16* orow = O + qoff + 128 * half + 4 * h2;
#pragma unroll
        for (int vb = 0; vb < 4; ++vb)
#pragma unroll
            for (int g4 = 0; g4 < 4; ++g4) { v2u wv; wv.x = cvtpk(o[vb][4 * g4] * inv, o[vb][4 * g4 + 1] * inv); wv.y = cvtpk(o[vb][4 * g4 + 2] * inv, o[vb][4 * g4 + 3] * inv);
                *(v2u*)(orow + 32 * vb + 8 * g4) = wv; }
    }
    __syncthreads();
}


struct EpiXattn {
    static constexpr bool PERM = true, AFTER_DRAIN = true;
    struct Pre { int unused; };
    const bf16* MKV; const float* gkq; bf16* O;
    __device__ __forceinline__ void init(f32x4 (&)[2][2][4][2], const pg8::Unit&, int, int, int, int) const {}
    __device__ __forceinline__ void fused(f32x4 (&acc)[2][2][4][2], const pg8::Unit& u, int wr, int wc, int fr, int fq, LAS unsigned char* lds, int wid, int lane) const {
#pragma unroll
        for (int ai = 0; ai < 2; ++ai)
#pragma unroll
            for (int m = 0; m < 4; ++m) { const int row = ai * 128 + wr * 64 + m * 16 + fr;
#pragma unroll
                for (int bj = 0; bj < 2; ++bj) { const f32x4 v0 = acc[ai][bj][m][0], v1 = acc[ai][bj][m][1];
                    v4u o; o.x = cvtpk(v0[0], v0[1]); o.y = cvtpk(v0[2], v0[3]); o.z = cvtpk(v1[0], v1[1]); o.w = cvtpk(v1[2], v1[3]);
                    *(LAS v4u*)(lds + row * XA_STRIDE + (bj * 128 + wc * 32 + 8 * fq) * 2) = o; } }
        asm volatile("s_waitcnt lgkmcnt(0)" ::: "memory"); __builtin_amdgcn_s_barrier(); asm volatile("" ::: "memory");
    }
};

constexpr int DA_STRIDE = 272, DA_VSTRIDE = 320, DA_LDS_BIAS = 384 * DA_VSTRIDE;
struct DaArgs { const bf16* QKV; const float* biasT; const float* gkq; bf16* N0; float* DEN0; const bf16* N1; const float* DEN1; const bf16* N2; const float* DEN2; bf16* O; int br0; int nbr; int mode; int pad; };
struct DaUnit { int br, b, h, dil, cls, l0; };
template <int MODE> __device__ __forceinline__ DaUnit da_decode(int uu) {
    DaUnit U; U.br = MODE == 0 ? __builtin_amdgcn_readfirstlane(1 + (uu >> 9)) : 0; const int rem = __builtin_amdgcn_readfirstlane(uu & 511), x = rem & 15; U.b = rem >> 7; U.h = (rem >> 4) & 7; U.dil = 1 << (2 * U.br);
    U.cls = U.br == 0 ? 0 : (U.br == 1 ? (x & 3) : x); U.l0 = 256 * (U.br == 0 ? x : (U.br == 1 ? (x >> 2) : 0)); return U; }
__device__ __forceinline__ void da_load_rows(v4u (&st)[12], const bf16* QKV, const DaUnit& U, int col, int tid) {
    const bf16* base = QKV + (size_t)(U.b * SEQ) * OD_IN + U.h * 128 + col + (tid & 15) * 8;
#pragma unroll
    for (int i = 0; i < 12; ++i) { const int ki = (tid >> 4) + 32 * i, lk = U.l0 - 128 + ki, lkc = lk < 0 ? 0 : lk; st[i] = *(const v4u*)(base + (size_t)(lkc * U.dil + U.cls) * OD_IN); }
}
template <int MODE> __device__ __forceinline__ void dattn_phase(LAS char* lds, const DaArgs& a, int bx, int G, int tid) {
    constexpr int NUNITS = MODE == 0 ? 1024 : 512;
    const int lane = tid & 63, w = __builtin_amdgcn_readfirstlane(tid >> 6), r = lane & 31, h2 = lane >> 5;
    int uu = bx; if (uu >= NUNITS) return;
    v4u st[12];
    { const DaUnit U0 = da_decode<MODE>(uu); da_load_rows(st, a.QKV, U0, 1024, tid); }
    LAS float* lbias = (LAS float*)(lds + DA_LDS_BIAS);
    const int lbase = tr_lane_base(lane, DA_VSTRIDE);
    for (;;) {
        const DaUnit U = da_decode<MODE>(uu);
        const int l0 = U.l0, h = U.h; const bool zfirst = (l0 == 0);
        int r_l = r; asm volatile("" : "+v"(r_l));
        float gk8[8];
#pragma unroll
        for (int e = 0; e < 8; ++e) gk8[e] = a.gkq[(tid & 15) * 8 + e];
        const size_t qrow = (size_t)(U.b * SEQ + (l0 + 32 * w + r) * U.dil + U.cls);
#pragma unroll
        for (int i = 0; i < 12; ++i) { float f_[8]; unpack8((i < 4 && zfirst) ? (v4u){0u, 0u, 0u, 0u} : st[i], f_);
            float sq_ = (f_[0] * f_[0] + f_[1] * f_[1]) + (f_[2] * f_[2] + f_[3] * f_[3]) + (f_[4] * f_[4] + f_[5] * f_[5]) + (f_[6] * f_[6] + f_[7] * f_[7]);
            sq_ += __shfl_xor(sq_, 1); sq_ += __shfl_xor(sq_, 2); sq_ += __shfl_xor(sq_, 4); sq_ += __shfl_xor(sq_, 8);
            const float rk_ = 1.0f / sqrtf(sq_ * (1.0f / 128.0f) + EPS) * 0.08838834764831845f;
            v4u o_; o_.x = cvtpk(f_[0] * rk_ * gk8[0], f_[1] * rk_ * gk8[1]); o_.y = cvtpk(f_[2] * rk_ * gk8[2], f_[3] * rk_ * gk8[3]); o_.z = cvtpk(f_[4] * rk_ * gk8[4], f_[5] * rk_ * gk8[5]); o_.w = cvtpk(f_[6] * rk_ * gk8[6], f_[7] * rk_ * gk8[7]);
            *(LAS v4u*)(lds + ((tid >> 4) + 32 * i) * DA_STRIDE + (tid & 15) * 16) = o_; }
        if (tid < 192) { const int dl = tid - 32; lbias[tid] = (dl >= 0 && dl <= 128) ? a.biasT[(U.br * 8 + h) * 132 + dl] * 1.4426950408889634f - 11.541560327111707f : -__builtin_inff(); }
        asm volatile("" ::: "memory");
        bf16x8 qf[8];
#pragma unroll
        for (int s = 0; s < 8; ++s) qf[s] = *(const bf16x8*)(a.QKV + qrow * OD_IN + h * 128 + 8 * h2 + 16 * s);
        da_load_rows(st, a.QKV, U, 2048, tid);
        float ss = 0.f;
#pragma unroll
        for (int s = 0; s < 8; ++s)
#pragma unroll
            for (int j = 0; j < 8; ++j) { const float xq = __uint_as_float((unsigned)(unsigned short)qf[s][j] << 16); ss += xq * xq; }
        ss += __shfl_xor(ss, 32);
        const float rsl = 1.0f / sqrtf(ss * (1.0f / 128.0f) + EPS) * 1.4426950408889634f;
        LDS_BARRIER();
        bf16x8 pf[5][2]; float den = 0.f;
#pragma unroll
        for (int kbi = 0; kbi < 5; ++kbi) {
            if (zfirst && w + kbi < 4) { pf[kbi][0] = (bf16x8){0, 0, 0, 0, 0, 0, 0, 0}; pf[kbi][1] = pf[kbi][0]; continue; }
            f32x16 acc;
#pragma unroll
            for (int i = 0; i < 16; ++i) acc[i] = 0.f;
            const LAS char* kp = lds + (32 * (w + kbi) + r) * DA_STRIDE + h2 * 16;
#pragma unroll
            for (int s = 0; s < 8; ++s) { const bf16x8 av = *(const LAS bf16x8*)(kp + s * 32); acc = MFMA32(av, qf[s], acc); }
            __builtin_amdgcn_sched_barrier(0);
            const LAS float* tb = lbias + (r_l - 4 * h2);
#pragma unroll
            for (int hh = 0; hh < 2; ++hh) { float p[8];
#pragma unroll
                for (int i8 = 0; i8 < 8; ++i8) { const int i = 8 * hh + i8;
                    p[i8] = __builtin_amdgcn_exp2f(acc[i] * rsl + tb[160 - 32 * kbi - ((i & 3) + 8 * (i >> 2))]); den += p[i8]; }
                pf[kbi][hh] = pack8(p[0], p[1], p[2], p[3], p[4], p[5], p[6], p[7]);
                __builtin_amdgcn_sched_barrier(0); }
            asm volatile("" ::: "memory");
        }
        den += __shfl_xor(den, 32);
        LDS_BARRIER();
#pragma unroll
        for (int i = 0; i < 12; ++i) *(LAS v4u*)(lds + ((tid >> 4) + 32 * i) * DA_VSTRIDE + (tid & 15) * 16) = (i < 4 && zfirst) ? (v4u){0u, 0u, 0u, 0u} : st[i];
        LDS_BARRIER();
        const int un = uu + G; const bool more = un < NUNITS; const DaUnit Un = da_decode<MODE>(more ? un : uu);
        if (more) da_load_rows(st, a.QKV, Un, 1024, tid);
        const size_t ooff = qrow * D + h * 128 + 4 * h2;
        float inv = 1.0f;
        if (MODE == 0) { if (h2 == 0) ((float*)(U.br == 1 ? a.DEN1 : a.DEN2))[qrow * 8 + h] = den; }
        else { inv = 1.0f / (den + a.DEN1[qrow * 8 + h] + a.DEN2[qrow * 8 + h]); }
#pragma unroll
        for (int half = 0; half < 2; ++half) {
            f32x16 o[2];
            v2u n1v[2][4], n2v[2][4];
            if (MODE == 1) { const bf16* N1 = a.N1 + ooff + 64 * half; const bf16* N2 = a.N2 + ooff + 64 * half;
#pragma unroll
                for (int vb = 0; vb < 2; ++vb)
#pragma unroll
                    for (int g4 = 0; g4 < 4; ++g4) { n1v[vb][g4] = *(const v2u*)(N1 + 32 * vb + 8 * g4); n2v[vb][g4] = *(const v2u*)(N2 + 32 * vb + 8 * g4); } }
#pragma unroll
            for (int vb = 0; vb < 2; ++vb)
#pragma unroll
                for (int i = 0; i < 16; ++i) o[vb][i] = 0.f;
#pragma unroll
            for (int kbi = 0; kbi < 5; ++kbi)
#pragma unroll
                for (int s = 0; s < 2; ++s)
#pragma unroll
                    for (int vb = 0; vb < 2; ++vb) { const bf16x8 av = tr_frag_perm(lds, DA_VSTRIDE, lbase, 32 * (w + kbi) + 16 * s, 64 * half + 32 * vb); o[vb] = MFMA32(av, pf[kbi][s], o[vb]); }
            if (MODE == 0) {
                bf16* N = (bf16*)(U.br == 1 ? a.N1 : a.N2) + ooff + 64 * half;
#pragma unroll
                for (int vb = 0; vb < 2; ++vb)
#pragma unroll
                    for (int g4 = 0; g4 < 4; ++g4) { v2u wv; wv.x = cvtpk(o[vb][4 * g4], o[vb][4 * g4 + 1]); wv.y = cvtpk(o[vb][4 * g4 + 2], o[vb][4 * g4 + 3]); *(v2u*)(N + 32 * vb + 8 * g4) = wv; }
            } else {
                bf16* Op = a.O + ooff + 64 * half;
#pragma unroll
                for (int vb = 0; vb < 2; ++vb)
#pragma unroll
                    for (int g4 = 0; g4 < 4; ++g4) { const v2u n1 = n1v[vb][g4], n2 = n2v[vb][g4];
                        const float x0 = o[vb][4 * g4] + __uint_as_float(n1.x << 16) + __uint_as_float(n2.x << 16), x1 = o[vb][4 * g4 + 1] + __uint_as_float(n1.x & 0xffff0000u) + __uint_as_float(n2.x & 0xffff0000u);
                        const float x2 = o[vb][4 * g4 + 2] + __uint_as_float(n1.y << 16) + __uint_as_float(n2.y << 16), x3 = o[vb][4 * g4 + 3] + __uint_as_float(n1.y & 0xffff0000u) + __uint_as_float(n2.y & 0xffff0000u);
                        v2u wv; wv.x = cvtpk(x0 * inv, x1 * inv); wv.y = cvtpk(x2 * inv, x3 * inv); *(v2u*)(Op + 32 * vb + 8 * g4) = wv; }
            }
            asm volatile("" ::: "memory");
        }
        LDS_BARRIER();
        if (!more) break;
        uu = un;
    }
}

constexpr int MX_STRIDE = 272, MX_TSTRIDE = 320, MX_IMG = 128 * MX_TSTRIDE;
constexpr int MX_Q = 0, MX_K = MX_IMG, MX_V = 2 * MX_IMG, MX_SCR = 3 * MX_IMG;
struct MixArgs { bf16* Z; const float* lb; const float* ret_g; const float* hg_g; bf16* SBUF; float* DECA; float* DECB; };

__device__ __forceinline__ void st_chunk8(LAS char* img, int stride, int row, int c0, const float (&f)[8]) {
    v4u o; o.x = cvtpk(f[0], f[1]); o.y = cvtpk(f[2], f[3]); o.z = cvtpk(f[4], f[5]); o.w = cvtpk(f[6], f[7]); *(LAS v4u*)(img + row * stride + c0 * 2) = o; }

__device__ __forceinline__ void ret_prep_tile(LAS char* img, int stride, const bf16* zrow  , int j, int cg, const float (&sn)[16], const float (&cs)[16], float sc) {
#pragma unroll
    for (int hc = 0; hc < 2; ++hc) { float x1[8], x2[8], o1[8], o2[8];
        unpack8(*(const v4u*)(zrow + 16 * cg + 8 * hc), x1); unpack8(*(const v4u*)(zrow + 64 + 16 * cg + 8 * hc), x2);
#pragma unroll
        for (int e = 0; e < 8; ++e) { o1[e] = (x1[e] * cs[8 * hc + e] - x2[e] * sn[8 * hc + e]) * sc; o2[e] = (x1[e] * sn[8 * hc + e] + x2[e] * cs[8 * hc + e]) * sc; }
        st_chunk8(img, stride, j, 16 * cg + 8 * hc, o1); st_chunk8(img, stride, j, 64 + 16 * cg + 8 * hc, o2); }
}
__device__ __forceinline__ void copy_tile(LAS char* img, int stride, const bf16* src, int tid) {
#pragma unroll
    for (int i = 0; i < 4; ++i) { const int id = tid + 512 * i, row = id >> 4, ch = id & 15; *(LAS v4u*)(img + row * stride + ch * 16) = *(const v4u*)(src + (size_t)row * EV_IN + ch * 8); }
}
__device__ __forceinline__ void hg_gates(const bf16* zrow_f  , const float* lbh  , int tid, LAS float* scr, float (&cum)[32], float (&kk)[32]) {
    const int lane = tid & 63, hw = (tid >> 6) & 1, cg = tid >> 7;
#pragma unroll
    for (int q = 0; q < 4; ++q) { float fl[8]; unpack8(*(const v4u*)(zrow_f + 32 * cg + 8 * q), fl);
#pragma unroll
        for (int e = 0; e < 8; ++e) { const float l = lbh[32 * cg + 8 * q + e]; const float f = l + (1.0f - l) * (1.0f / (1.0f + __expf(-fl[e]))); kk[8 * q + e] = 1.0f - f; cum[8 * q + e] = __logf(fmaxf(f, 1e-6f)); } }
#pragma unroll
    for (int off = 1; off < 64; off <<= 1) {
#pragma unroll
        for (int c = 0; c < 32; ++c) { const float t = __shfl_up(cum[c], off); if (lane >= off) cum[c] += t; } }
    if (hw == 0 && lane == 63) {
#pragma unroll
        for (int c = 0; c < 32; ++c) scr[32 * cg + c] = cum[c]; }
    __syncthreads();
    if (hw == 1) {
#pragma unroll
        for (int c = 0; c < 32; ++c) cum[c] += scr[32 * cg + c]; }
    if (hw == 1 && lane == 63) {
#pragma unroll
        for (int c = 0; c < 32; ++c) scr[128 + 32 * cg + c] = cum[c]; }
    __syncthreads();
}

__device__ __forceinline__ void load_prep4(v4u (&rw)[4], const bf16* zrow_seg, int mixer, int cg) {
#pragma unroll
    for (int q = 0; q < 4; ++q) { const int col = mixer == 0 ? ((q >> 1) * 64 + 16 * cg + 8 * (q & 1)) : (32 * cg + 8 * q); rw[q] = *(const v4u*)(zrow_seg + col); }
}
__device__ __forceinline__ void load_copy4(v4u (&rw)[4], const bf16* tile, int tid) {
#pragma unroll
    for (int i = 0; i < 4; ++i) { const int id = tid + 512 * i; rw[i] = *(const v4u*)(tile + (size_t)(id >> 4) * EV_IN + (id & 15) * 8); }
}
__device__ __forceinline__ void store_copy4(LAS char* img, int stride, const v4u (&rw)[4], int tid) {
#pragma unroll
    for (int i = 0; i < 4; ++i) { const int id = tid + 512 * i; *(LAS v4u*)(img + (id >> 4) * stride + (id & 15) * 16) = rw[i]; }
}
__device__ __forceinline__ void ret_prep_raw(LAS char* img, int stride, const v4u (&rw)[4], int j, int cg, const float (&sn)[16], const float (&cs)[16], float sc) {
#pragma unroll
    for (int hc = 0; hc < 2; ++hc) { float x1[8], x2[8], o1[8], o2[8]; unpack8(rw[hc], x1); unpack8(rw[2 + hc], x2);
#pragma unroll
        for (int e = 0; e < 8; ++e) { o1[e] = (x1[e] * cs[8 * hc + e] - x2[e] * sn[8 * hc + e]) * sc; o2[e] = (x1[e] * sn[8 * hc + e] + x2[e] * cs[8 * hc + e]) * sc; }
        st_chunk8(img, stride, j, 16 * cg + 8 * hc, o1); st_chunk8(img, stride, j, 64 + 16 * cg + 8 * hc, o2); }
}
__device__ __forceinline__ void hg_gates_raw(const v4u (&rw)[4], const float* lbh, int tid, LAS float* scr, float (&cum)[32], float (&kk)[32]) {
    const int lane = tid & 63, hw = (tid >> 6) & 1, cg = tid >> 7;
#pragma unroll
    for (int q = 0; q < 4; ++q) { float fl[8]; unpack8(rw[q], fl);
#pragma unroll
        for (int e = 0; e < 8; ++e) { const float l = lbh[32 * cg + 8 * q + e]; const float f = l + (1.0f - l) * (1.0f / (1.0f + __expf(-fl[e]))); kk[8 * q + e] = 1.0f - f; cum[8 * q + e] = __logf(fmaxf(f, 1e-6f)); } }
#pragma unroll
    for (int off = 1; off < 64; off <<= 1) {
#pragma unroll
        for (int c = 0; c < 32; ++c) { const float t = __shfl_up(cum[c], off); if (lane >= off) cum[c] += t; } }
    if (hw == 0 && lane == 63) {
#pragma unroll
        for (int c = 0; c < 32; ++c) scr[32 * cg + c] = cum[c]; }
    LDS_BARRIER();
    if (hw == 1) {
#pragma unroll
        for (int c = 0; c < 32; ++c) cum[c] += scr[32 * cg + c]; }
    if (hw == 1 && lane == 63) {
#pragma unroll
        for (int c = 0; c < 32; ++c) scr[128 + 32 * cg + c] = cum[c]; }
    LDS_BARRIER();
}
struct MixU { int mixer, b, h, n; };
__device__ __forceinline__ MixU mix_decode(int u) { MixU U; const int g = __builtin_amdgcn_readfirstlane(u >> 5); U.n = __builtin_amdgcn_readfirstlane(u & 31); U.mixer = g >> 4; U.b = (g >> 2) & 3; U.h = g & 3; return U; }

__device__ __forceinline__ void mixA_phase(LAS char* lds, const MixArgs& a, int bx, int G, int tid) {
    const int lane = tid & 63, w = __builtin_amdgcn_readfirstlane(tid >> 6), r = lane & 31, h2 = lane >> 5;
    const int j = tid & 127, cg = tid >> 7;
    LAS float* scr = (LAS float*)(lds + MX_SCR);
    int u = bx; if (u >= 1024) return;
    v4u rk[4], rv[4];
    { const MixU U = mix_decode(u); const bf16* zt = a.Z + (size_t)(U.b * SEQ + 128 * U.n) * EV_IN;
      load_prep4(rk, zt + (size_t)j * EV_IN + (U.mixer == 0 ? Z_RK : Z_GF) + U.h * 128, U.mixer, cg); load_copy4(rv, zt + (U.mixer == 0 ? Z_RV : Z_GI) + U.h * 128, tid); }
    for (;;) {
        const MixU U = mix_decode(u); const int h = U.h, n = U.n;
        if (U.mixer == 0) {
            const float gamma = 1.0f - exp2f(-5.0f - (float)h), lg2 = log2f(gamma);
            float sn[16], cs[16];
#pragma unroll
            for (int e = 0; e < 16; ++e) { const float inv = exp2f(-(float)(16 * cg + e) * (13.287712379549449f / 64.0f)); rope_sincos((float)(128 * n + j) * inv, sn[e], cs[e]); }
            ret_prep_raw(lds + MX_K, MX_TSTRIDE, rk, j, cg, sn, cs, 0.08838834764831845f * exp2f((float)(127 - j) * lg2));
            if (tid < 128) { a.DECA[(size_t)u * 128 + tid] = exp2f(128.0f * lg2); a.DECB[(size_t)u * 128 + tid] = gamma; }
        } else {
            float cum[32], kk[32];
            hg_gates_raw(rk, a.lb + h * 128, tid, scr, cum, kk);
#pragma unroll
            for (int q = 0; q < 4; ++q) { float o[8];
#pragma unroll
                for (int e = 0; e < 8; ++e) o[e] = kk[8 * q + e] * __expf(scr[128 + 32 * cg + 8 * q + e] - cum[8 * q + e]);
                st_chunk8(lds + MX_K, MX_TSTRIDE, j, 32 * cg + 8 * q, o); }
            if (tid < 128) { a.DECA[(size_t)u * 128 + tid] = __expf(scr[128 + tid]); a.DECB[(size_t)u * 128 + tid] = __expf(scr[tid]); }
        }
        store_copy4(lds + MX_V, MX_TSTRIDE, rv, tid);
        LDS_BARRIER();
        const int un = u + G; const bool more = un < 1024;
        if (more) { const MixU Un = mix_decode(un); const bf16* zt = a.Z + (size_t)(Un.b * SEQ + 128 * Un.n) * EV_IN;
            load_prep4(rk, zt + (size_t)j * EV_IN + (Un.mixer == 0 ? Z_RK : Z_GF) + Un.h * 128, Un.mixer, cg); load_copy4(rv, zt + (Un.mixer == 0 ? Z_RV : Z_GI) + Un.h * 128, tid); }
        const int lbn = tr_lane_base_nat(lane, MX_TSTRIDE); const int kbk = w >> 1, vb0 = 2 * (w & 1);
        f32x16 acc[2];
#pragma unroll
        for (int t = 0; t < 2; ++t)
#pragma unroll
            for (int i = 0; i < 16; ++i) acc[t][i] = 0.f;
#pragma unroll
        for (int s_ = 0; s_ < 8; ++s_) { const bf16x8 av = tr_frag_nat(lds + MX_K, MX_TSTRIDE, lbn, 16 * s_, 32 * kbk);
#pragma unroll
            for (int t = 0; t < 2; ++t) { const bf16x8 bv = tr_frag_nat(lds + MX_V, MX_TSTRIDE, lbn, 16 * s_, 32 * (vb0 + t)); acc[t] = MFMA32(av, bv, acc[t]); } }
        bf16* sb = a.SBUF + (size_t)u * 16384;
#pragma unroll
        for (int t = 0; t < 2; ++t)
#pragma unroll
            for (int g4 = 0; g4 < 4; ++g4) { v2u wv; wv.x = cvtpk(acc[t][4 * g4], acc[t][4 * g4 + 1]); wv.y = cvtpk(acc[t][4 * g4 + 2], acc[t][4 * g4 + 3]);
                *(v2u*)(sb + (size_t)(32 * (vb0 + t) + r) * 128 + 32 * kbk + 8 * g4 + 4 * h2) = wv; }
        LDS_BARRIER();
        if (!more) break;
        u = un;
    }
}

__device__ __forceinline__ void mixA_unit(LAS char* lds, const MixArgs& a, int u, int tid) {
    const int lane = tid & 63, w = __builtin_amdgcn_readfirstlane(tid >> 6), r = lane & 31, h2 = lane >> 5;
    const int g = u >> 5, n = u & 31, mixer = g >> 4, b = (g >> 2) & 3, h = g & 3;
    const int j = tid & 127, cg = tid >> 7;
    const bf16* zt = a.Z + (size_t)(b * SEQ + 128 * n) * EV_IN;
    LAS float* scr = (LAS float*)(lds + MX_SCR);
    if (mixer == 0) {
        const float gamma = 1.0f - exp2f(-5.0f - (float)h), lg2 = log2f(gamma);
        float sn[16], cs[16];
#pragma unroll
        for (int e = 0; e < 16; ++e) { const float inv = exp2f(-(float)(16 * cg + e) * (13.287712379549449f / 64.0f)); rope_sincos((float)(128 * n + j) * inv, sn[e], cs[e]); }
        ret_prep_tile(lds + MX_K, MX_TSTRIDE, zt + (size_t)j * EV_IN + Z_RK + h * 128, j, cg, sn, cs, 0.08838834764831845f * exp2f((float)(127 - j) * lg2));
        copy_tile(lds + MX_V, MX_TSTRIDE, zt + Z_RV + h * 128, tid);
        if (tid < 128) { a.DECA[(size_t)u * 128 + tid] = exp2f(128.0f * lg2); a.DECB[(size_t)u * 128 + tid] = gamma; }
    } else {
        float cum[32], kk[32];
        hg_gates(zt + (size_t)j * EV_IN + Z_GF + h * 128, a.lb + h * 128, tid, scr, cum, kk);
#pragma unroll
        for (int q = 0; q < 4; ++q) { float o[8];
#pragma unroll
            for (int e = 0; e < 8; ++e) o[e] = kk[8 * q + e] * __expf(scr[128 + 32 * cg + 8 * q + e] - cum[8 * q + e]);
            st_chunk8(lds + MX_K, MX_TSTRIDE, j, 32 * cg + 8 * q, o); }
        copy_tile(lds + MX_V, MX_TSTRIDE, zt + Z_GI + h * 128, tid);
        if (tid < 128) { a.DECA[(size_t)u * 128 + tid] = __expf(scr[128 + tid]); a.DECB[(size_t)u * 128 + tid] = __expf(scr[tid]); }
    }
    __syncthreads();
    const int lbn = tr_lane_base_nat(lane, MX_TSTRIDE); const int kbk = w >> 1, vb0 = 2 * (w & 1);
    f32x16 acc[2];
#pragma unroll
    for (int t = 0; t < 2; ++t)
#pragma unroll
        for (int i = 0; i < 16; ++i) acc[t][i] = 0.f;
#pragma unroll
    for (int s = 0; s < 8; ++s) { const bf16x8 av = tr_frag_nat(lds + MX_K, MX_TSTRIDE, lbn, 16 * s, 32 * kbk);
#pragma unroll
        for (int t = 0; t < 2; ++t) { const bf16x8 bv = tr_frag_nat(lds + MX_V, MX_TSTRIDE, lbn, 16 * s, 32 * (vb0 + t)); acc[t] = MFMA32(av, bv, acc[t]); } }
    bf16* sb = a.SBUF + (size_t)u * 16384;
#pragma unroll
    for (int t = 0; t < 2; ++t)
#pragma unroll
        for (int g4 = 0; g4 < 4; ++g4) { v2u wv; wv.x = cvtpk(acc[t][4 * g4], acc[t][4 * g4 + 1]); wv.y = cvtpk(acc[t][4 * g4 + 2], acc[t][4 * g4 + 3]);
            *(v2u*)(sb + (size_t)(32 * (vb0 + t) + r) * 128 + 32 * kbk + 8 * g4 + 4 * h2) = wv; }
    __syncthreads();
}

__device__ __forceinline__ void mix_scan(const MixArgs& a, int gtid, int nthreads, bool dry = false) {
    for (int e = gtid; e < 32 * 4096; e += nthreads) { const int g = e >> 12, el = e & 4095, dk4 = el & 31;
        bf16* sp = a.SBUF + (size_t)(g * 32) * 16384 + (size_t)el * 4; const float* da = a.DECA + (size_t)(g * 32) * 128 + 4 * dk4; const float* db = a.DECB + (size_t)(g * 32) * 128 + 4 * dk4;
        f32x4 S = (f32x4){0.f, 0.f, 0.f, 0.f};
#pragma unroll 8
        for (int n = 0; n < 32; ++n) { const v2u kv = *(const v2u*)(sp + (size_t)n * 16384); const f32x4 A = *(const f32x4*)(da + n * 128), Bv = *(const f32x4*)(db + n * 128);
            const f32x4 so = S * Bv; v2u wv; wv.x = cvtpk(so[0], so[1]); wv.y = cvtpk(so[2], so[3]); if (!dry) *(v2u*)(sp + (size_t)n * 16384) = wv;
            S[0] = A[0] * S[0] + __uint_as_float(kv.x << 16); S[1] = A[1] * S[1] + __uint_as_float(kv.x & 0xffff0000u); S[2] = A[2] * S[2] + __uint_as_float(kv.y << 16); S[3] = A[3] * S[3] + __uint_as_float(kv.y & 0xffff0000u); }
    }
}

__device__ __forceinline__ void mixC_unit(LAS char* lds, const MixArgs& a, int u, int tid, bool dry = false) {
    const int lane = tid & 63, w = __builtin_amdgcn_readfirstlane(tid >> 6), r = lane & 31, h2 = lane >> 5;
    const int g = u >> 5, n = u & 31, mixer = g >> 4, b = (g >> 2) & 3, h = g & 3;
    const int j = tid & 127, cg = tid >> 7;
    bf16* zt = a.Z + (size_t)(b * SEQ + 128 * n) * EV_IN;
    LAS float* scr = (LAS float*)(lds + MX_SCR);
    if (mixer == 0) {
        const float gamma = 1.0f - exp2f(-5.0f - (float)h), lg2 = log2f(gamma);
        float sn[16], cs[16];
#pragma unroll
        for (int e = 0; e < 16; ++e) { const float inv = exp2f(-(float)(16 * cg + e) * (13.287712379549449f / 64.0f)); rope_sincos((float)(128 * n + j) * inv, sn[e], cs[e]); }
        ret_prep_tile(lds + MX_Q, MX_STRIDE, zt + (size_t)j * EV_IN + Z_RQ + h * 128, j, cg, sn, cs, exp2f((float)j * lg2));
        ret_prep_tile(lds + MX_K, MX_STRIDE, zt + (size_t)j * EV_IN + Z_RK + h * 128, j, cg, sn, cs, 0.08838834764831845f * exp2f(-(float)j * lg2));
        copy_tile(lds + MX_V, MX_TSTRIDE, zt + Z_RV + h * 128, tid);
    } else {
        float cum[32], kk[32];
        hg_gates(zt + (size_t)j * EV_IN + Z_GF + h * 128, a.lb + h * 128, tid, scr, cum, kk);
#pragma unroll
        for (int q = 0; q < 4; ++q) { float qv[8], oq[8], ok[8]; unpack8(*(const v4u*)(zt + (size_t)j * EV_IN + Z_GQ + h * 128 + 32 * cg + 8 * q), qv);
#pragma unroll
            for (int e = 0; e < 8; ++e) { const float d = cum[8 * q + e] - scr[32 * cg + 8 * q + e]; oq[e] = qv[e] * __expf(d); ok[e] = kk[8 * q + e] * __expf(-d); }
            st_chunk8(lds + MX_Q, MX_STRIDE, j, 32 * cg + 8 * q, oq); st_chunk8(lds + MX_K, MX_STRIDE, j, 32 * cg + 8 * q, ok); }
        copy_tile(lds + MX_V, MX_TSTRIDE, zt + Z_GI + h * 128, tid);
    }
    __syncthreads();
    const int vb = w >> 1; const int lbp = tr_lane_base(lane, MX_TSTRIDE);
    const bf16* sb = a.SBUF + (size_t)u * 16384 + (size_t)(32 * vb + r) * 128 + 8 * h2;
    bf16x8 sf[8];
#pragma unroll
    for (int s = 0; s < 8; ++s) sf[s] = *(const bf16x8*)(sb + 16 * s);
    f32x16 o[2]; float s1[2], s2[2];
    const float* rg_ = a.ret_g; const float* hg_ = a.hg_g; const float* gn = (mixer == 0 ? rg_ : hg_) + h * 128 + 32 * vb + 4 * h2;
    unsigned long long gwv[8];
#pragma unroll
    for (int t = 0; t < 2; ++t) { const int ib = (w & 1) ? (1 + t) : (3 * t); const bf16* gp = zt + (size_t)(32 * ib + r) * EV_IN + (mixer == 0 ? Z_RG : Z_GG) + h * 128 + 32 * vb + 4 * h2;
#pragma unroll
        for (int g4 = 0; g4 < 4; ++g4) gwv[t * 4 + g4] = *(const unsigned long long*)(gp + 8 * g4); }
#pragma unroll
    for (int t = 0; t < 2; ++t) {
        const int ib = (w & 1) ? (1 + t) : (3 * t);
        bf16x8 qf[8];
#pragma unroll
        for (int s = 0; s < 8; ++s) qf[s] = *(const LAS bf16x8*)(lds + MX_Q + (32 * ib + r) * MX_STRIDE + h2 * 16 + s * 32);
#pragma unroll
        for (int i = 0; i < 16; ++i) o[t][i] = 0.f;
#pragma unroll
        for (int s = 0; s < 8; ++s) o[t] = MFMA32(sf[s], qf[s], o[t]);
        for (int jb = 0; jb <= ib; ++jb) {
            f32x16 acc;
#pragma unroll
            for (int i = 0; i < 16; ++i) acc[i] = 0.f;
            const LAS char* kp = lds + MX_K + (32 * jb + r) * MX_STRIDE + h2 * 16;
#pragma unroll
            for (int s = 0; s < 8; ++s) { const bf16x8 av = *(const LAS bf16x8*)(kp + s * 32); acc = MFMA32(av, qf[s], acc); }
            if (jb == ib) {
#pragma unroll
                for (int i = 0; i < 16; ++i) { const int c = (i & 3) + 8 * (i >> 2) + 4 * h2; if (c > r) acc[i] = 0.f; } }
            const bf16x8 p0 = pack8(acc[0], acc[1], acc[2], acc[3], acc[4], acc[5], acc[6], acc[7]), p1 = pack8(acc[8], acc[9], acc[10], acc[11], acc[12], acc[13], acc[14], acc[15]);
            const bf16x8 v0 = tr_frag_perm(lds + MX_V, MX_TSTRIDE, lbp, 32 * jb, 32 * vb), v1 = tr_frag_perm(lds + MX_V, MX_TSTRIDE, lbp, 32 * jb + 16, 32 * vb);
            o[t] = MFMA32(v0, p0, o[t]); o[t] = MFMA32(v1, p1, o[t]);
        }
        float a1 = 0.f, a2 = 0.f;
#pragma unroll
        for (int i = 0; i < 16; ++i) { a1 += o[t][i]; a2 += o[t][i] * o[t][i]; }
        a1 += __shfl_xor(a1, 32); a2 += __shfl_xor(a2, 32); s1[t] = a1; s2[t] = a2;
        if (h2 == 0) { scr[256 + (vb * 128 + 32 * ib + r) * 2] = a1; scr[256 + (vb * 128 + 32 * ib + r) * 2 + 1] = a2; }
    }
    LDS_BARRIER();
#pragma unroll
    for (int t = 0; t < 2; ++t) {
        const int ib = (w & 1) ? (1 + t) : (3 * t); const int tok = 32 * ib + r;
        float t1 = 0.f, t2 = 0.f;
#pragma unroll
        for (int v = 0; v < 4; ++v) { t1 += scr[256 + (v * 128 + tok) * 2]; t2 += scr[256 + (v * 128 + tok) * 2 + 1]; }
        float mu = 0.f, rstd;
        if (mixer == 0) { mu = t1 * (1.0f / 128.0f); rstd = 1.0f / sqrtf(fmaxf(t2 * (1.0f / 128.0f) - mu * mu, 0.f) + EPS); } else rstd = 1.0f / sqrtf(t2 * (1.0f / 128.0f) + EPS);
        bf16* zr = zt + (size_t)tok * EV_IN;
        bf16* yp = zr + (mixer == 0 ? Z_RQ : Z_GQ) + h * 128 + 32 * vb + 4 * h2;
#pragma unroll
        for (int g4 = 0; g4 < 4; ++g4) { v2u gw; gw.x = (unsigned)gwv[t * 4 + g4]; gw.y = (unsigned)(gwv[t * 4 + g4] >> 32); const f32x4 gv = *(const f32x4*)(gn + 8 * g4);
            const float ga[4] = {__uint_as_float(gw.x << 16), __uint_as_float(gw.x & 0xffff0000u), __uint_as_float(gw.y << 16), __uint_as_float(gw.y & 0xffff0000u)}; float y[4];
#pragma unroll
            for (int e = 0; e < 4; ++e) { y[e] = (o[t][4 * g4 + e] - mu) * rstd * gv[e] * (ga[e] / (1.0f + __expf(-ga[e]))); }
            v2u wv; wv.x = cvtpk(y[0], y[1]); wv.y = cvtpk(y[2], y[3]); if (!dry) *(v2u*)(yp + 8 * g4) = wv; }
    }
    __syncthreads();
}


__device__ __forceinline__ float gelu_tanh(float x) { const float u = 0.7978845608028654f * (x + 0.044715f * x * x * x); const float t = 1.0f - 2.0f / (1.0f + __expf(2.0f * u)); return 0.5f * x * (1.0f + t); }
__device__ __forceinline__ void ffn_ew(const bf16* GU, const float* cw, const float* cb, bf16* H, int rows, int gtid, int nthreads) {
    for (int idx = gtid; idx < rows * (DFF / 8); idx += nthreads) {
        const int row = idx / (DFF / 8), c0 = (idx % (DFF / 8)) * 8, t = row % SEQ;
        float g0[8], g1[8], g2[8], u[8];
        unpack8(*(const v4u*)(GU + (size_t)row * (2 * DFF) + c0), g2); unpack8(*(const v4u*)(GU + (size_t)row * (2 * DFF) + DFF + c0), u);
        if (t >= 1) unpack8(*(const v4u*)(GU + (size_t)(row - 1) * (2 * DFF) + c0), g1); else { for (int i = 0; i < 8; ++i) g1[i] = 0.f; }
        if (t >= 2) unpack8(*(const v4u*)(GU + (size_t)(row - 2) * (2 * DFF) + c0), g0); else { for (int i = 0; i < 8; ++i) g0[i] = 0.f; }
        float r[8];
#pragma unroll
        for (int i = 0; i < 8; ++i) { const float y = cw[c0 + i] * g0[i] + cw[DFF + c0 + i] * g1[i] + cw[2 * DFF + c0 + i] * g2[i] + cb[c0 + i]; r[i] = gelu_tanh(y) * u[i]; }
        v4u o; o.x = cvtpk(r[0], r[1]); o.y = cvtpk(r[2], r[3]); o.z = cvtpk(r[4], r[5]); o.w = cvtpk(r[6], r[7]);
        *(v4u*)(H + (size_t)row * DFF + c0) = o;
    }
}

constexpr int LDS_BYTES = 163840;
constexpr int LDSCTL_OFF = LDS_BYTES - 512;
constexpr int CW_BAR = 4096;
constexpr size_t CTL_ZERO_BYTES = 1 * MiB;
#define XB_TMO      128
#define XB_XCNT(j)  (256  + 64 * (j))
#define XB_XSUB(j)  (1280 + 64 * (j))
#define XB_XGEN(j)  (2304 + 64 * (j))
#define XB_TOP      3328
#define XB_TOPGEN   3392
#define XCD_BAR_WORDS 3456
#define XB_SPIN_CAP (1u << 18)

__device__ __forceinline__ unsigned xb_ld(unsigned* p)              { return __hip_atomic_load(p, __ATOMIC_RELAXED, __HIP_MEMORY_SCOPE_AGENT); }
__device__ __forceinline__ unsigned xb_add(unsigned* p, unsigned v) { return __hip_atomic_fetch_add(p, v, __ATOMIC_RELAXED, __HIP_MEMORY_SCOPE_AGENT); }
__device__ __forceinline__ unsigned xb_xcc_id() { return (unsigned)__builtin_amdgcn_s_getreg((3 << 11) | 20) & 0xFu; }
#define XB_SPIN(cond, bar) do { unsigned _sp = 0; while (cond) { __builtin_amdgcn_s_sleep(1); \
    if ((++_sp & 255u) == 0u) { if (xb_ld(&(bar)[XB_TMO])) break; if (_sp > XB_SPIN_CAP) { atomicAdd(&(bar)[XB_TMO], 1u); break; } } } } while (0)

struct XcdBarrier {
    unsigned* bar; unsigned x;
    volatile LAS unsigned* st;
};

__device__ __forceinline__ XcdBarrier xcd_barrier_post(unsigned* bar, volatile LAS unsigned* st) {
    XcdBarrier b; b.bar = bar; b.x = xb_xcc_id(); b.st = st;
    if (threadIdx.x == 0) (void)xb_add(&bar[XB_XCNT(b.x)], 1u);
    return b;
}
__device__ __forceinline__ void xcd_barrier_complete(unsigned* bar, unsigned x, unsigned& nloc, unsigned& nx) {
    const unsigned G = gridDim.x * gridDim.y * gridDim.z;
    unsigned sum, cnt, mine, sp = 0u;
    for (;;) {
        sum = 0u; cnt = 0u; mine = 0u;
#pragma unroll
        for (unsigned j = 0; j < 16; ++j) { const unsigned c = xb_ld(&bar[XB_XCNT(j)]); sum += c; cnt += (c > 0u) ? 1u : 0u; mine = (j == x) ? c : mine; }
        if (sum == G) break;
        __builtin_amdgcn_s_sleep(1);
        if ((++sp & 255u) == 0u) { if (xb_ld(&bar[XB_TMO])) break; if (sp > XB_SPIN_CAP) { atomicAdd(&bar[XB_TMO], 1u); break; } }
    }
    nloc = mine > 0u ? mine : 1u; nx = cnt > 0u ? cnt : 1u;
}

__device__ __forceinline__ void xcd_barrier(const XcdBarrier& b) {
    asm volatile("s_waitcnt vmcnt(0)" ::: "memory");
    __syncthreads();
    if (threadIdx.x == 0) {
        unsigned* bar = b.bar;
        __builtin_amdgcn_s_waitcnt(0);
        unsigned nloc = b.st[0], nx = b.st[1];
        if (nloc == 0u) { xcd_barrier_complete(bar, b.x, nloc, nx); b.st[0] = nloc; b.st[1] = nx; }
        const unsigned old = xb_add(&bar[XB_XSUB(b.x)], 1u);
        const unsigned gen = old / nloc;
        if (old + 1u == (gen + 1u) * nloc) {
            __builtin_amdgcn_fence(__ATOMIC_RELEASE, "agent");
            asm volatile("s_waitcnt vmcnt(0)" ::: "memory");
            const unsigned og = xb_add(&bar[XB_TOP], 1u);
            const unsigned tg = og / nx;
            if (og + 1u == (tg + 1u) * nx) xb_add(&bar[XB_TOPGEN], 1u);
            else XB_SPIN(xb_ld(&bar[XB_TOPGEN]) == tg, bar);
            __builtin_amdgcn_fence(__ATOMIC_ACQUIRE, "agent");
            xb_add(&bar[XB_XGEN(b.x)], 1u);
            asm volatile("s_waitcnt vmcnt(0)" ::: "memory");
        } else {
            XB_SPIN(xb_ld(&bar[XB_XGEN(b.x)]) == gen, bar);
            __builtin_amdgcn_fence(__ATOMIC_ACQUIRE, "agent");
            asm volatile("s_waitcnt vmcnt(0)" ::: "memory");
        }
    }
    __syncthreads();
}


__device__ __forceinline__ GAS unsigned char* launder_s(unsigned char* p) { unsigned long long v = (unsigned long long)p; asm volatile("" : "+s"(v)); return (GAS unsigned char*)v; }
__device__ __forceinline__ GAS float* launder_sf(float* p) { unsigned long long v = (unsigned long long)p; asm volatile("" : "+s"(v)); return (GAS float*)v; }
struct FwdArgs { const float* in[25]; float* out; unsigned char* ws; int ph_lo, ph_hi, li, pad; };
__global__ void __launch_bounds__(512, 2) fwd(FwdArgs a) {
    extern __shared__ __attribute__((aligned(16))) unsigned char lds_raw[];
    LAS unsigned char* lds = (LAS unsigned char*)lds_raw;
    const int tid = threadIdx.x, lane = tid & 63, wave = __builtin_amdgcn_readfirstlane(tid >> 6);
    const int G = gridDim.x, bx = blockIdx.x;
    volatile LAS unsigned* MISC = (volatile LAS unsigned*)(lds + LDSCTL_OFF);
    if (tid < 64) MISC[tid] = 0u;
    __syncthreads();
#define WSP (launder_s(a.ws))
#define OUTP (launder_sf(a.out))
    XcdBarrier bar = xcd_barrier_post((unsigned*)(WSP + WS_CTL) + CW_BAR + a.li * XCD_BAR_WORDS, MISC + 8);
    int ph = 0; const int lo = a.ph_lo, hi = a.ph_hi;
#define PH_ON true) for (int rp_ = 0, nr_ = (ph >= lo && ph < hi) ? 1 + ((a.pad >> ph) & 1) : 0; rp_ < nr_; ++rp_, __syncthreads()
#define TID_L ({ int l_; asm volatile("v_mbcnt_lo_u32_b32 %0, -1, 0\n\tv_mbcnt_hi_u32_b32 %0, -1, %0" : "=v"(l_)); wave * 64 + l_; })
#define PH_END do { if (ph >= lo && ph + 1 < hi) xcd_barrier(bar); ++ph; } while (0)
#define XB ((bf16*)(WSP + WS_XB))
#define SSQP ((float*)(WSP + WS_SSQP))
#define ACT ((bf16*)(WSP + WS_ACT))

    if (PH_ON) { ProArgs pa;
#pragma unroll
        for (int i = 0; i < 25; ++i) pa.in[i] = a.in[i];
        pa.ws = (unsigned char*)WSP; pa.layer_mask = 3; pa.ffn_mode = 2;
        { const int t_ = TID_L; prologue_body(pa, bx * 8 + (t_ >> 6), G * 8, t_ & 63, (LAS float*)lds + (t_ >> 6) * 64 * 65); } }
    PH_END;

    for (int l = 0; l < 2; ++l) {
        if (PH_ON) {
            { pg8::Gemm g{XB, (const bf16*)(WSP + (l ? WS_ODIN : WS_EVIN)), M, l ? OD_IN : EV_IN, D, D}; pg8::EpiBf16S E{ACT, SSQP, l ? OD_IN : EV_IN, M, EPS, 0};
              pg8::StaticOrder S; S.init(g.M, g.N, G, bx); pg8::gemm_phase<pg8::EpiBf16S, pg8::StaticOrder, true, true>(lds, g, S, E, TID_L); }
        }
        PH_END;
        const bf16* mixo; int mixo_ld;
        if (l == 0) {
            MixArgs ma{ACT, (const float*)(WSP + WS_LB), a.in[4], a.in[5], (bf16*)OUTP, (float*)(WSP + WS_DECA), (float*)(WSP + WS_DECB)};
            if (PH_ON) mixA_phase((LAS char*)lds, ma, bx, G, TID_L);
            PH_END;
            if (PH_ON) {
                if (bx < 64 && G > 64) { const int lm = bx >> 5;
                    pg8::Gemm g{(const bf16*)(WSP + (lm ? WS_MEMH1 : WS_MEMH0)), (const bf16*)(WSP + (lm ? WS_XKV1 : WS_XKV0)), MM, 2 * D, D, D}; pg8::EpiBf16S E{(bf16*)(WSP + (lm ? WS_MKV1 : WS_MKV0)), nullptr, 2 * D, M, EPS, 0};
                    pg8::StaticOrder S; S.init(g.M, g.N, G, bx & 31); pg8::gemm_phase<pg8::EpiBf16S, pg8::StaticOrder, true, true>(lds, g, S, E, TID_L); }
                else mix_scan(ma, (bx - 64) * 512 + TID_L, (G - 64) * 512, rp_ + 1 < nr_);
            }
            PH_END;
            if (PH_ON) { for (int u = bx; u < 1024; u += G) mixC_unit((LAS char*)lds, ma, u, TID_L, rp_ + 1 < nr_); }
            PH_END;
            mixo = ACT; mixo_ld = EV_IN;
        } else {
            bf16* O = (bf16*)(WSP + WS_ACT + 96 * MiB);
            DaArgs da; da.QKV = ACT; da.biasT = (const float*)(WSP + WS_BIAST); da.gkq = (const float*)(WSP + WS_GOD); da.N0 = (bf16*)(WSP + WS_N2); da.DEN0 = (float*)(WSP + WS_DEN23);
            da.N1 = (const bf16*)(WSP + WS_N2); da.DEN1 = (const float*)(WSP + WS_DEN23); da.N2 = (const bf16*)OUTP; da.DEN2 = (const float*)(WSP + WS_DEN23) + (size_t)M * 8; da.O = O; da.br0 = 1; da.nbr = 2; da.mode = 0; da.pad = 0;
            if (PH_ON) dattn_phase<0>((LAS char*)lds, da, bx, G, TID_L);
            PH_END;
            if (PH_ON) dattn_phase<1>((LAS char*)lds, da, bx, G, TID_L);
            PH_END;
            mixo = O; mixo_ld = D;
        }
        if (PH_ON) { pg8::Gemm g{mixo, (const bf16*)(WSP + (l ? WS_ODOUT : WS_EVOUT)), M, D, D, mixo_ld}; pg8::EpiResid E{l ? (const float*)nullptr : a.in[0], nullptr, XB, SSQP, D, M};
            pg8::StaticOrder S; S.init(g.M, g.N, G, bx); pg8::gemm_phase<pg8::EpiResid, pg8::StaticOrder, false, true>(lds, g, S, E, TID_L); }
        PH_END;
        { bf16* O = (bf16*)(WSP + WS_ACT + 32 * MiB);
          if (PH_ON) { pg8::Gemm g{XB, (const bf16*)(WSP + (l ? WS_XQ1 : WS_XQ0)), M, D, D, D}; EpiXattn E{(const bf16*)(WSP + (l ? WS_MKV1 : WS_MKV0)), (const float*)(WSP + WS_GXA) + l * 256, O};
              pg8::StaticOrder S; S.init(g.M, g.N, G, bx); pg8::gemm_phase<EpiXattn, pg8::StaticOrder, false, true>(lds, g, S, E, TID_L);
              pg8::StaticOrder S2; S2.init(M, D, G, bx); pg8::Unit uq; if (S2.next(0, uq)) xattn_unit<true>((LAS char*)lds, nullptr, (const bf16*)(WSP + (l ? WS_MKV1 : WS_MKV0)), (const float*)(WSP + WS_GXA) + l * 256, O, uq.pm * 4 + uq.pn, TID_L); }
          PH_END;
          if (PH_ON) { pg8::Gemm g{O, (const bf16*)(WSP + (l ? WS_XO1 : WS_XO0)), M, D, D, D}; pg8::EpiResid E{nullptr, nullptr, XB, SSQP, D, M};
              pg8::StaticOrder S; S.init(g.M, g.N, G, bx); pg8::gemm_phase<pg8::EpiResid, pg8::StaticOrder, false, true>(lds, g, S, E, TID_L); }
          PH_END; }
        { bf16* H = ACT;
          if (PH_ON) { pg8::Gemm g{XB, (const bf16*)(WSP + (l ? WS_FIN1 : WS_FIN0)), 68 * 256, 2 * DFF, D, D}; pg8::EpiFfn E{H, SSQP, a.in[22] + (size_t)l * 3 * DFF, a.in[23] + (size_t)l * DFF, M, EPS};
              pg8::FfnOrder S; S.init(g.M, g.N, G, bx); pg8::gemm_phase<pg8::EpiFfn, pg8::FfnOrder, true, true>(lds, g, S, E, TID_L); }
          PH_END;
          if (PH_ON) { pg8::Gemm g{H, (const bf16*)(WSP + (l ? WS_FOUT1 : WS_FOUT0)), M, D, DFF, DFF}; pg8::EpiResid E{nullptr, l ? (float*)OUTP : (float*)nullptr, XB, SSQP, D, M};
              pg8::StaticOrder S; S.init(g.M, g.N, G, bx); pg8::gemm_phase<pg8::EpiResid, pg8::StaticOrder, false, true>(lds, g, S, E, TID_L); }
          PH_END; }
    }
#undef PH_ON
#undef PH_END
#undef TID_L
#undef WSP
#undef OUTP
#undef XB
#undef SSQP
#undef ACT
}
constexpr int N_PHASES = 1 + 9 + 8;

#ifndef PROBE_MASK
#define PROBE_MASK 0
#endif
#ifndef MK_PER_PHASE
#define MK_PER_PHASE 0
#endif
extern "C" void kernel_launch(void* const* d_in, const int* in_sizes, int n_in, void* d_out, int out_size, void* d_ws, size_t ws_size, hipStream_t stream) {
    static int inited = 0;
    if (!inited) {
        if (n_in != 25 || out_size != M * D || ws_size < WS_END) { fprintf(stderr, "kernel_launch: unexpected shapes (n_in %d, out %d, ws %zu)\n", n_in, out_size, ws_size); inited = -1; return; }
        if (hipFuncSetAttribute((const void*)fwd, hipFuncAttributeMaxDynamicSharedMemorySize, LDS_BYTES) != hipSuccess) { fprintf(stderr, "kernel_launch: hipFuncSetAttribute failed\n"); inited = -1; return; }
        inited = 1;
    }
    if (inited < 0) return;
    if (hipMemsetAsync((char*)d_ws + WS_CTL, 0, CTL_ZERO_BYTES, stream) != hipSuccess) return;
    FwdArgs fa{}; for (int i = 0; i < 25; ++i) fa.in[i] = (const float*)d_in[i]; fa.out = (float*)d_out; fa.ws = (unsigned char*)d_ws; fa.pad = PROBE_MASK;
#if MK_PER_PHASE
    for (int p = 0; p < N_PHASES; ++p) { fa.ph_lo = p; fa.ph_hi = p + 1; fa.li = 0; hipLaunchKernelGGL(fwd, dim3(256), dim3(512), LDS_BYTES, stream, fa); }
#else
    fa.ph_lo = 0; fa.ph_hi = N_PHASES; fa.li = 0; hipLaunchKernelGGL(fwd, dim3(256), dim3(512), LDS_BYTES, stream, fa);
#endif
}
```

```cpp
#include <hip/hip_runtime.h>
#include <cstdio>
#include <cstdint>
namespace pg8 {
#define PG8_LAS __attribute__((address_space(3)))
typedef unsigned short bf16_t;
typedef short bf16x8 __attribute__((ext_vector_type(8)));
typedef float f32x4 __attribute__((ext_vector_type(4)));
typedef unsigned u32x4 __attribute__((ext_vector_type(4)));
constexpr int BM = 256, BK = 64, HALF = 128, HTB = HALF * BK * 2  , STAGE_BYTES = 8 * HTB, NXCD = 8, WGM = 8;
constexpr int SSQ_LDS = STAGE_BYTES + 4096, CW_LDS = STAGE_BYTES + 8192;

__host__ __device__ __forceinline__ int lds_byte(int r, int c) { const int st = (r >> 4) * 2 + (c >> 5), rr = r & 15, cc = c & 31, ob = rr * 64 + cc * 2; return st * 1024 + (ob ^ (((ob >> 9) & 1) << 5)); }
__host__ __device__ __forceinline__ void stage_rc(int b, int& R, int& C) { const int st = b / 1024, sb = b % 1024, swz = sb ^ (((sb >> 9) & 1) << 5); R = (st >> 1) * 16 + swz / 64; C = (st & 1) * 32 + (swz % 64) / 2; }
__host__ __device__ __forceinline__ int perm32(int rho) { const int n = rho >> 4, i = rho & 15; return 8 * (i >> 2) + 4 * n + (i & 3); }

struct Unit { int pm, pn; };
struct Gemm { const bf16_t* A; const bf16_t* Bt; int M, N, K, lda; };

struct StaticOrder {
    int nM, nN, nwg, G, c;
    __host__ __device__ __forceinline__ void init(int M, int N, int G_, int c_) { nM = M / BM; nN = N / BM; nwg = nM * nN; G = G_; c = c_; }
    __host__ __device__ __forceinline__ bool next(int i, Unit& u) const {
        const long L = (long)i * G + c; if (L >= nwg) return false;
        int wgid = (int)L; { const int q = nwg / NXCD, r = nwg % NXCD, xcd = wgid % NXCD, off = wgid / NXCD; wgid = (xcd < r ? xcd * (q + 1) : r * (q + 1) + (xcd - r) * q) + off; }
        const int nig = WGM * nN, gid = wgid / nig, fm = gid * WGM, gsz = (nM - fm) < WGM ? (nM - fm) : WGM;
        u.pm = fm + ((wgid % nig) % gsz); u.pn = (wgid % nig) / gsz; return true;
    }
    __device__ __forceinline__ void a_ready(const Unit&) const {}
    __device__ __forceinline__ void done(const Unit&) const {}
    __device__ __forceinline__ int arow(const Unit& u) const { return u.pm * BM; }
};
struct FfnOrder : StaticOrder {
    __device__ __forceinline__ int arow(const Unit& u) const { return (u.pm / 17) * 4096 + 254 * (u.pm % 17) - 2; }
};

__device__ __forceinline__ unsigned cvt_pk_bf16(float lo, float hi) { unsigned r; asm volatile("v_cvt_pk_bf16_f32 %0, %1, %2" : "=v"(r) : "v"(lo), "v"(hi)); return r; }
typedef float f32x2 __attribute__((ext_vector_type(2)));
struct EpiBf16S {
    static constexpr bool PERM = true, AFTER_DRAIN = false;
    bf16_t* O; const float* ssqp; int ldc; int Mtot; float eps; int pad;
    __device__ __forceinline__ void preload(PG8_LAS unsigned char* lds, const Unit& u, int wr, int wc, int lane) const {
        if (!ssqp) return;
#pragma unroll
        for (int ai = 0; ai < 2; ++ai) __builtin_amdgcn_global_load_lds((const unsigned*)(ssqp + (size_t)wc * Mtot + u.pm * BM + ai * HALF + wr * 64 + lane), (PG8_LAS unsigned*)(lds + SSQ_LDS + (((wr * 2 + ai) * 4 + wc) * 64) * 4), 4, 0, 0);
    }
    __device__ __forceinline__ void preload_unit(PG8_LAS unsigned char*, const Unit&, int, int, int) const {}
    __device__ __forceinline__ void operator()(f32x4 (&acc)[2][2][4][2], const Unit& u, int wr, int wc, int fr, int fq, PG8_LAS unsigned char* lds) const {
        const int row0 = u.pm * BM + wr * 64 + fr; const int col0 = u.pn * BM + wc * 32 + 8 * fq;
        const PG8_LAS float* sl = (const PG8_LAS float*)(lds + SSQ_LDS);
#pragma unroll
        for (int ai = 0; ai < 2; ++ai)
#pragma unroll
            for (int m = 0; m < 4; ++m) { const int row = row0 + ai * HALF + m * 16; float rs = 1.f;
                if (ssqp) { const PG8_LAS float* sp = sl + ((wr * 2 + ai) * 4) * 64 + m * 16 + fr; const float s = (sp[0] + sp[64]) + (sp[128] + sp[192]); rs = 1.0f / sqrtf(s * (1.0f / 1024.0f) + eps); }
                bf16_t* rowp = O + (size_t)row * ldc + col0;
#pragma unroll
                for (int bj = 0; bj < 2; ++bj) { const f32x4 v0 = acc[ai][bj][m][0] * rs, v1 = acc[ai][bj][m][1] * rs;
                    u32x4 w; w.x = cvt_pk_bf16(v0[0], v0[1]); w.y = cvt_pk_bf16(v0[2], v0[3]); w.z = cvt_pk_bf16(v1[0], v1[1]); w.w = cvt_pk_bf16(v1[2], v1[3]);
                    *(u32x4*)(rowp + bj * HALF) = w; } }
    }
};

__device__ __forceinline__ float gelu_tanh_f(float x) { const float u = 0.7978845608028654f * (x + 0.044715f * x * x * x); const float t = 1.0f - 2.0f / (1.0f + __expf(2.0f * u)); return 0.5f * x * (1.0f + t); }
struct EpiFfn {
    static constexpr bool PERM = true, AFTER_DRAIN = false;
    bf16_t* H; const float* ssqp; const float* cw; const float* cb; int Mtot; float eps;
    __device__ __forceinline__ void preload(PG8_LAS unsigned char* lds, const Unit& u, int wr, int wc, int lane) const {
        const int rowb = (u.pm / 17) * 4096 + 254 * (u.pm % 17) - 2;
#pragma unroll
        for (int ai = 0; ai < 2; ++ai) { const int row = rowb + ai * HALF + wr * 64 + lane; const int rc = row < 0 ? 0 : (row >= Mtot ? Mtot - 1 : row);
            __builtin_amdgcn_global_load_lds((const unsigned*)(ssqp + (size_t)wc * Mtot + rc), (PG8_LAS unsigned*)(lds + SSQ_LDS + (((wr * 2 + ai) * 4 + wc) * 64) * 4), 4, 0, 0); }
    }
    __device__ __forceinline__ void preload_unit(PG8_LAS unsigned char* lds, const Unit& u, int wr, int wc, int lane) const {
        const float* src = (wc < 3 ? cw + (size_t)wc * 2816 : cb) + u.pn * 128 + 64 * wr + lane;
        __builtin_amdgcn_global_load_lds((const unsigned*)src, (PG8_LAS unsigned*)(lds + CW_LDS + (wc * 128 + 64 * wr) * 4), 4, 0, 0);
    }
    __device__ __forceinline__ void operator()(f32x4 (&acc)[2][2][4][2], const Unit& u, int wr, int wc, int fr, int fq, PG8_LAS unsigned char* lds) const {
        constexpr int DFF_ = 2816;
        const int b = u.pm / 17, t = u.pm % 17, pos0 = 254 * t - 2, rowb = b * 4096 + pos0;
        const int colh = u.pn * 128 + wc * 32 + 8 * fq, lane = fq * 16 + fr;
        PG8_LAS float* halo = (PG8_LAS float*)(lds + STAGE_BYTES);
#pragma unroll
        for (int ai = 0; ai < 2; ++ai)
#pragma unroll
            for (int m = 0; m < 4; ++m) { const int rl = ai * HALF + wr * 64 + m * 16 + fr; const PG8_LAS float* sp = (const PG8_LAS float*)(lds + SSQ_LDS) + ((wr * 2 + ai) * 4) * 64 + m * 16 + fr;
                const float sq = (sp[0] + sp[64]) + (sp[128] + sp[192]); const float rs = 1.0f / sqrtf(sq * (1.0f / 1024.0f) + eps); const bool pad = (pos0 + rl) < 0;
#pragma unroll
                for (int n = 0; n < 2; ++n) {
#pragma unroll
                    for (int e = 0; e < 4; ++e) { acc[ai][0][m][n][e] = pad ? 0.f : acc[ai][0][m][n][e] * rs; acc[ai][1][m][n][e] *= rs; } } }
#pragma unroll
        for (int ai = 0; ai < 2; ++ai) if (fr >= 14) { PG8_LAS float* hp = halo + ((((2 * ai + wr) * 4 + wc) * 4 + fq) * 2 + (fr - 14)) * 8;
            *(PG8_LAS f32x4*)hp = acc[ai][0][3][0]; *(PG8_LAS f32x4*)(hp + 4) = acc[ai][0][3][1]; }
        asm volatile("s_waitcnt lgkmcnt(0)" ::: "memory"); __builtin_amdgcn_s_barrier(); asm volatile("" ::: "memory");
        typedef unsigned u32x2e __attribute__((ext_vector_type(2)));
#define DPPF(x, ctrl) __builtin_bit_cast(float, __builtin_amdgcn_update_dpp(0, __builtin_bit_cast(int, (x)), (ctrl), 0xf, 0xf, true))
        u32x2e hold[2][4];
#pragma unroll
        for (int n = 0; n < 2; ++n) {
            const PG8_LAS float* cwl = (const PG8_LAS float*)(lds + CW_LDS) + wc * 32 + 8 * fq + 4 * n;
            const f32x4 w0 = *(const PG8_LAS f32x4*)cwl, w1 = *(const PG8_LAS f32x4*)(cwl + 128), w2 = *(const PG8_LAS f32x4*)(cwl + 256), bb = *(const PG8_LAS f32x4*)(cwl + 384);
#pragma unroll
            for (int ai = 0; ai < 2; ++ai) {
                const int blk = 2 * ai + wr; f32x4 R1p = (f32x4){0.f, 0.f, 0.f, 0.f}, R2p = (f32x4){0.f, 0.f, 0.f, 0.f};
                if (blk >= 1) { const PG8_LAS float* hp = halo + ((((blk - 1) * 4 + wc) * 4 + fq) * 2) * 8 + 4 * n; const f32x4 h62 = *(const PG8_LAS f32x4*)hp, h63 = *(const PG8_LAS f32x4*)(hp + 8);
                    const f32x4 z4 = (f32x4){0.f, 0.f, 0.f, 0.f}; R1p = fr == 0 ? h63 : z4; R2p = fr == 0 ? h62 : (fr == 1 ? h63 : z4); }
#pragma unroll
                for (int m = 0; m < 4; ++m) { const int rl = ai * HALF + wr * 64 + m * 16 + fr; const bool ok = (rl >= 2) && (pos0 + rl < 4096);
                    float hv[4];
#pragma unroll
                    for (int e = 0; e < 4; ++e) { const float v = acc[ai][0][m][n][e];
                        const float p1 = DPPF(v, 0x111) + R1p[e], p2 = DPPF(v, 0x112) + R2p[e]; R1p[e] = DPPF(v, 0x10F); R2p[e] = DPPF(v, 0x10E);
                        const float y = w0[e] * p2 + (w1[e] * p1 + (w2[e] * v + bb[e]));
                        const float tq = y * (-2.302208198f + -0.10294324f * (y * y));
                        const float sg = __builtin_amdgcn_rcpf(1.0f + __builtin_amdgcn_exp2f(tq));
                        hv[e] = (y * acc[ai][1][m][n][e]) * sg; }
                    u32x2e w; w.x = cvt_pk_bf16(hv[0], hv[1]); w.y = cvt_pk_bf16(hv[2], hv[3]);
                    if (n == 0) hold[ai][m] = w;
                    else if (ok) { u32x4 w4; w4.x = hold[ai][m].x; w4.y = hold[ai][m].y; w4.z = w.x; w4.w = w.y; *(u32x4*)(H + (size_t)(rowb + rl) * DFF_ + colh) = w4; } }
            }
        }
#undef DPPF
        asm volatile("s_waitcnt lgkmcnt(0)" ::: "memory"); __builtin_amdgcn_s_barrier(); asm volatile("" ::: "memory");
    }
};
struct EpiResid {
    static constexpr bool PERM = true, AFTER_DRAIN = true;
    struct Pre { int unused; };
    const float* base; float* out; bf16_t* xb; float* ssqp; int ldc; int Mtot;
    __device__ __forceinline__ void init(f32x4 (&acc)[2][2][4][2], const Unit& u, int wr, int wc, int fr, int fq) const {
        const int col0 = u.pn * BM + wc * 32 + 8 * fq;
#pragma unroll
        for (int ai = 0; ai < 2; ++ai)
#pragma unroll
            for (int m = 0; m < 4; ++m) { const size_t off = (size_t)(u.pm * BM + ai * HALF + wr * 64 + m * 16 + fr) * ldc + col0;
#pragma unroll
                for (int bj = 0; bj < 2; ++bj) {
                    if (base) { acc[ai][bj][m][0] = *(const f32x4*)(base + off + bj * HALF); acc[ai][bj][m][1] = *(const f32x4*)(base + off + bj * HALF + 4); }
                    else { const u32x4 w = *(const u32x4*)(xb + off + bj * HALF);
                        acc[ai][bj][m][0] = (f32x4){__uint_as_float(w.x << 16), __uint_as_float(w.x & 0xffff0000u), __uint_as_float(w.y << 16), __uint_as_float(w.y & 0xffff0000u)};
                        acc[ai][bj][m][1] = (f32x4){__uint_as_float(w.z << 16), __uint_as_float(w.z & 0xffff0000u), __uint_as_float(w.w << 16), __uint_as_float(w.w & 0xffff0000u)}; } } }
    }
    __device__ __forceinline__ void fused(f32x4 (&acc)[2][2][4][2], const Unit& u, int wr, int wc, int fr, int fq, PG8_LAS unsigned char* lds, int wid, int lane) const {
        PG8_LAS float* P = (PG8_LAS float*)lds;
        const int col0 = u.pn * BM + wc * 32 + 8 * fq;
#pragma unroll
        for (int ai = 0; ai < 2; ++ai)
#pragma unroll
            for (int m = 0; m < 4; ++m) { const int r = ai * HALF + wr * 64 + m * 16 + fr; const size_t off = (size_t)(u.pm * BM + r) * ldc + col0; float s = 0.f;
#pragma unroll
                for (int bj = 0; bj < 2; ++bj) { const f32x4 o0 = acc[ai][bj][m][0], o1 = acc[ai][bj][m][1];
                    if (out) { *(f32x4*)(out + off + bj * HALF) = o0; *(f32x4*)(out + off + bj * HALF + 4) = o1; }
                    u32x4 w; w.x = cvt_pk_bf16(o0[0], o0[1]); w.y = cvt_pk_bf16(o0[2], o0[3]); w.z = cvt_pk_bf16(o1[0], o1[1]); w.w = cvt_pk_bf16(o1[2], o1[3]); *(u32x4*)(xb + off + bj * HALF) = w;
                    s += ((o0[0] * o0[0] + o0[1] * o0[1]) + (o0[2] * o0[2] + o0[3] * o0[3])) + ((o1[0] * o1[0] + o1[1] * o1[1]) + (o1[2] * o1[2] + o1[3] * o1[3])); }
                s += __shfl_xor(s, 16); s += __shfl_xor(s, 32);
                if (fq == 0) P[r * 4 + wc] = s;
                if (m & 1) asm volatile("" ::: "memory"); }
        asm volatile("s_waitcnt lgkmcnt(0)" ::: "memory"); __builtin_amdgcn_s_barrier(); asm volatile("" ::: "memory");
        if (lane < 32) { const int row = wid * 32 + lane; ssqp[(size_t)u.pn * Mtot + u.pm * BM + row] = (P[row * 4 + 0] + P[row * 4 + 1]) + (P[row * 4 + 2] + P[row * 4 + 3]); }
        asm volatile("s_waitcnt lgkmcnt(0)" ::: "memory"); __builtin_amdgcn_s_barrier(); asm volatile("" ::: "memory");
    }
};

template <class Epi, class Sched, bool ALIGN_EPI = false, bool SP2 = false>
__device__ __forceinline__ void gemm_phase(PG8_LAS unsigned char* lds, const Gemm g, const Sched& S, const Epi& E, int tid_in) {
    int tid_l = tid_in; asm volatile("" : "+v"(tid_l));
    const int tid = tid_l, wid = __builtin_amdgcn_readfirstlane(tid >> 6), lane = tid & 63, wr = wid >> 2, wc = wid & 3, fr = lane & 15, fq = lane >> 4;
    const int K = g.K, nt = K / BK;
    unsigned voffA[2], voffB[2];
#pragma unroll
    for (int i = 0; i < 2; ++i) { int R, C; stage_rc(tid * 16 + i * 8192, R, C); const int Rb = Epi::PERM ? ((R & ~31) + perm32(R & 31)) : R;
        voffA[i] = (unsigned)(R * g.lda + C) * 2u; voffB[i] = (unsigned)(Rb * K + C) * 2u; }
    const size_t kstep = (size_t)(BK * 2);
    const size_t hstepA = (size_t)HALF * g.lda * 2, hstepB = (size_t)HALF * K * 2;
    const size_t tstepB = 2 * hstepB;
    const unsigned ldsw = (unsigned)wid * 1024u;
    const int aoff = lds_byte(wr * 64 + fr, fq * 8), boff = lds_byte(wc * 32 + fr, fq * 8);
#define PG8_SA(b, h) (((b) * 2 + (h)) * HTB)
#define PG8_SB(b, h) ((4 + (b) * 2 + (h)) * HTB)
#define PG8_STAGE(bufoff, gbase, voff) do { _Pragma("unroll") for (int _i = 0; _i < 2; ++_i) \
        __builtin_amdgcn_global_load_lds((const unsigned*)((const char*)(gbase) + (voff)[_i]), (PG8_LAS unsigned*)(lds + (bufoff) + ldsw + _i * 8192), 16, 0, 0); } while (0)
#define PG8_LDA(dst, b, h) do { _Pragma("unroll") for (int m = 0; m < 4; ++m) _Pragma("unroll") for (int k = 0; k < 2; ++k) dst[m][k] = *(const PG8_LAS bf16x8*)(lds + PG8_SA(b, h) + aoff + m * 2048 + k * 1024); } while (0)
#define PG8_LDB(dst, b, h) do { _Pragma("unroll") for (int n = 0; n < 2; ++n) _Pragma("unroll") for (int k = 0; k < 2; ++k) dst[n][k] = *(const PG8_LAS bf16x8*)(lds + PG8_SB(b, h) + boff + n * 2048 + k * 1024); } while (0)
#define PG8_MMA(ai, bj, At, Bt) do { __builtin_amdgcn_s_setprio(1); _Pragma("unroll") for (int m = 0; m < 4; ++m) _Pragma("unroll") for (int n = 0; n < 2; ++n) _Pragma("unroll") for (int k = 0; k < 2; ++k) \
        acc[ai][bj][m][n] = __builtin_amdgcn_mfma_f32_16x16x32_bf16(Bt[n][k], At[m][k], acc[ai][bj][m][n], 0, 0, 0); __builtin_amdgcn_s_setprio(0); } while (0)
#define PG8_WAIT_V(n) asm volatile("s_waitcnt vmcnt(" #n ")" ::: "memory")
#define PG8_WAIT_L(n) asm volatile("s_waitcnt lgkmcnt(" #n ")" ::: "memory")
#define PG8_BAR __builtin_amdgcn_s_barrier()
#define PG8_SCHED __builtin_amdgcn_sched_barrier(0)
    Unit cur, nxt; int ui = 0;
    if (!S.next(0, cur)) return;
    f32x4 acc[2][2][4][2];
#pragma unroll
    for (int a = 0; a < 2; ++a)
#pragma unroll
        for (int b = 0; b < 2; ++b)
#pragma unroll
            for (int m = 0; m < 4; ++m)
#pragma unroll
                for (int n = 0; n < 2; ++n) acc[a][b][m][n] = (f32x4){0.f, 0.f, 0.f, 0.f};
    if constexpr (Epi::AFTER_DRAIN) E.init(acc, cur, wr, wc, fr, fq);
    bf16x8 At[4][2], B0[2][2], B1[2][2];
    const char* cA = (const char*)g.A + (ptrdiff_t)S.arow(cur) * (ptrdiff_t)(g.lda * 2); const char* cB = (const char*)g.Bt + (size_t)cur.pn * tstepB;
    S.a_ready(cur);
    if constexpr (!Epi::AFTER_DRAIN) E.preload_unit(lds, cur, wr, wc, lane);
    if constexpr (SP2) {
        PG8_STAGE(PG8_SB(0, 0), cB, voffB); PG8_STAGE(PG8_SB(0, 1), cB + hstepB, voffB); PG8_STAGE(PG8_SA(0, 0), cA, voffA); PG8_STAGE(PG8_SA(0, 1), cA + hstepA, voffA);
        if (wr == 1) PG8_BAR;
        PG8_WAIT_V(2); PG8_BAR;
        PG8_STAGE(PG8_SB(1, 0), cB + kstep, voffB); PG8_STAGE(PG8_SA(1, 0), cA + kstep, voffA); PG8_STAGE(PG8_SB(1, 1), cB + hstepB + kstep, voffB);
        PG8_WAIT_V(6); PG8_BAR;
        if constexpr (Epi::AFTER_DRAIN) {
#pragma unroll
            for (int a_ = 0; a_ < 2; ++a_)
#pragma unroll
                for (int b_ = 0; b_ < 2; ++b_) asm volatile("" : "+v"(acc[a_][b_][0][0]), "+v"(acc[a_][b_][0][1]), "+v"(acc[a_][b_][1][0]), "+v"(acc[a_][b_][1][1]), "+v"(acc[a_][b_][2][0]), "+v"(acc[a_][b_][2][1]), "+v"(acc[a_][b_][3][0]), "+v"(acc[a_][b_][3][1]));
        }
    } else {
        PG8_STAGE(PG8_SB(0, 0), cB, voffB); PG8_STAGE(PG8_SA(0, 0), cA, voffA); PG8_STAGE(PG8_SB(0, 1), cB + hstepB, voffB); PG8_STAGE(PG8_SA(0, 1), cA + hstepA, voffA);
        if (wr == 1) PG8_BAR;
        PG8_WAIT_V(4); PG8_BAR;
        PG8_STAGE(PG8_SB(1, 0), cB + kstep, voffB); PG8_STAGE(PG8_SA(1, 0), cA + kstep, voffA); PG8_STAGE(PG8_SB(1, 1), cB + hstepB + kstep, voffB);
        PG8_WAIT_V(6); PG8_BAR;
    }
    for (;;) {
        const bool has_next = S.next(ui + 1, nxt);
        const char* nA = has_next ? (const char*)g.A + (ptrdiff_t)S.arow(nxt) * (ptrdiff_t)(g.lda * 2) : cA; const char* nB = has_next ? (const char*)g.Bt + (size_t)nxt.pn * tstepB : cB;
        for (int t = 0; t < nt; t += 2) {
            const bool last = (t == nt - 2);
            const char* a1 = cA + (size_t)(t + 1) * kstep;
            const char* a2 = last ? nA : cA + (size_t)(t + 2) * kstep; const char* b2 = last ? nB : cB + (size_t)(t + 2) * kstep;
            const char* a3 = a2 + kstep; const char* b3 = b2 + kstep;
            if (last && has_next) S.a_ready(nxt);
            if constexpr (!Epi::AFTER_DRAIN) { if (last) E.preload(lds, cur, wr, wc, lane); }
            if constexpr (SP2) {
            PG8_LDB(B0, 0, 0); PG8_LDB(B1, 0, 1); PG8_SCHED; PG8_LDA(At, 0, 0); PG8_STAGE(PG8_SA(1, 1), a1 + hstepA, voffA);
            PG8_WAIT_V(8); PG8_WAIT_L(0); PG8_BAR; PG8_MMA(0, 0, At, B0); PG8_MMA(0, 1, At, B1); PG8_BAR; PG8_SCHED;
            PG8_LDA(At, 0, 1); PG8_STAGE(PG8_SB(0, 0), b2, voffB); PG8_STAGE(PG8_SB(0, 1), b2 + hstepB, voffB); PG8_STAGE(PG8_SA(0, 0), a2, voffA);
            PG8_WAIT_V(8); PG8_WAIT_L(0); PG8_BAR; PG8_MMA(1, 0, At, B0); PG8_MMA(1, 1, At, B1); PG8_BAR; PG8_SCHED;
            PG8_LDB(B0, 1, 0); PG8_LDB(B1, 1, 1); PG8_SCHED; PG8_LDA(At, 1, 0); PG8_STAGE(PG8_SA(0, 1), a2 + hstepA, voffA);
            PG8_WAIT_V(8); PG8_WAIT_L(0); PG8_BAR; PG8_MMA(0, 0, At, B0); PG8_MMA(0, 1, At, B1); PG8_BAR; PG8_SCHED;
            PG8_LDA(At, 1, 1); PG8_STAGE(PG8_SB(1, 0), b3, voffB); PG8_STAGE(PG8_SB(1, 1), b3 + hstepB, voffB); PG8_STAGE(PG8_SA(1, 0), a3, voffA);
            PG8_WAIT_V(8); PG8_WAIT_L(0); PG8_BAR; PG8_MMA(1, 0, At, B0); PG8_MMA(1, 1, At, B1); PG8_BAR; PG8_SCHED;
            } else {
            PG8_LDB(B0, 0, 0); PG8_SCHED; PG8_LDA(At, 0, 0); PG8_STAGE(PG8_SA(1, 1), a1 + hstepA, voffA);
            PG8_WAIT_L(8); PG8_BAR; PG8_WAIT_L(0); PG8_MMA(0, 0, At, B0); PG8_BAR; PG8_SCHED;
            PG8_LDB(B1, 0, 1); PG8_STAGE(PG8_SB(0, 0), b2, voffB);
            PG8_BAR; PG8_WAIT_L(0); PG8_MMA(0, 1, At, B1); PG8_BAR;
            PG8_LDA(At, 0, 1); PG8_STAGE(PG8_SA(0, 0), a2, voffA);
            PG8_BAR; PG8_WAIT_L(0); PG8_MMA(1, 0, At, B0); PG8_BAR; PG8_SCHED;
            PG8_STAGE(PG8_SB(0, 1), b2 + hstepB, voffB);
            PG8_WAIT_V(6); PG8_BAR; PG8_MMA(1, 1, At, B1); PG8_BAR;
            PG8_LDB(B0, 1, 0); PG8_SCHED; PG8_LDA(At, 1, 0); PG8_STAGE(PG8_SA(0, 1), a2 + hstepA, voffA);
            PG8_WAIT_L(8); PG8_BAR; PG8_WAIT_L(0); PG8_MMA(0, 0, At, B0); PG8_BAR; PG8_SCHED;
            PG8_LDB(B1, 1, 1); PG8_STAGE(PG8_SB(1, 0), b3, voffB);
            PG8_BAR; PG8_WAIT_L(0); PG8_MMA(0, 1, At, B1); PG8_BAR;
            PG8_LDA(At, 1, 1); PG8_STAGE(PG8_SA(1, 0), a3, voffA);
            PG8_BAR; PG8_WAIT_L(0); PG8_MMA(1, 0, At, B0); PG8_BAR; PG8_SCHED;
            PG8_STAGE(PG8_SB(1, 1), b3 + hstepB, voffB);
            PG8_WAIT_V(6); PG8_BAR; PG8_MMA(1, 1, At, B1); PG8_BAR;
            }
        }
        if constexpr (ALIGN_EPI) { if (wr == 0) PG8_BAR; }
        if constexpr (!Epi::AFTER_DRAIN) { E(acc, cur, wr, wc, fr, fq, lds); S.done(cur); if (has_next) E.preload_unit(lds, nxt, wr, wc, lane); }
        if (!has_next) break;
#pragma unroll
        for (int a = 0; a < 2; ++a)
#pragma unroll
            for (int b = 0; b < 2; ++b)
#pragma unroll
                for (int m = 0; m < 4; ++m)
#pragma unroll
                    for (int n = 0; n < 2; ++n) acc[a][b][m][n] = (f32x4){0.f, 0.f, 0.f, 0.f};
        cur = nxt; cA = nA; cB = nB; ++ui;
        if constexpr (ALIGN_EPI) { if (wr == 1) PG8_BAR; }
    }
    PG8_WAIT_V(0);
    if constexpr (!ALIGN_EPI) { if (wr == 0) PG8_BAR; }
    PG8_BAR;
    if constexpr (Epi::AFTER_DRAIN) { E.fused(acc, cur, wr, wc, fr, fq, lds, wid, lane); S.done(cur); }
#undef PG8_SA
#undef PG8_SB
#undef PG8_STAGE
#undef PG8_LDA
#undef PG8_LDB
#undef PG8_MMA
#undef PG8_WAIT_V
#undef PG8_WAIT_L
#undef PG8_BAR
#undef PG8_SCHED
}
}


#define GAS __attribute__((address_space(1)))
#define LAS __attribute__((address_space(3)))
typedef unsigned short bf16;
typedef unsigned v4u __attribute__((ext_vector_type(4)));
typedef unsigned v2u __attribute__((ext_vector_type(2)));
typedef float f32x4 __attribute__((ext_vector_type(4)));
constexpr int BATCH = 4, SEQ = 4096, D = 1024, M = BATCH * SEQ, NMEM = 256, MM = BATCH * NMEM, DFF = 2816;
constexpr int EV_IN = 4096, OD_IN = 3072;
constexpr float EPS = 1e-6f;
constexpr int Z_RQ = 0, Z_GQ = 512, Z_RK = 1024, Z_RV = 1536, Z_RG = 2048, Z_GF = 2560, Z_GI = 3072, Z_GG = 3584;

constexpr size_t MiB = 1u << 20;
constexpr size_t WS_CTL = 0;
constexpr size_t WS_EVIN = 1 * MiB, WS_EVOUT = 9 * MiB, WS_XQ0 = 11 * MiB, WS_XKV0 = 13 * MiB, WS_XO0 = 17 * MiB, WS_FIN0 = 19 * MiB, WS_FOUT0 = 30 * MiB;
constexpr size_t WS_ODIN = 36 * MiB, WS_ODOUT = 42 * MiB, WS_XQ1 = 44 * MiB, WS_XKV1 = 46 * MiB, WS_XO1 = 50 * MiB, WS_FIN1 = 52 * MiB, WS_FOUT1 = 63 * MiB;
constexpr size_t WS_XB = 69 * MiB;
constexpr size_t WS_MKV0 = 101 * MiB, WS_MKV1 = 105 * MiB;
constexpr size_t WS_MEMH0 = 109 * MiB, WS_MEMH1 = 111 * MiB;
constexpr size_t WS_SSQP = 113 * MiB;
constexpr size_t WS_LB = 113 * MiB + 512 * 1024;
constexpr size_t WS_BIAST = 113 * MiB + 516 * 1024;
constexpr size_t WS_GXA = 113 * MiB + 600 * 1024, WS_GOD = 113 * MiB + 604 * 1024;
constexpr size_t WS_DEN23 = 114 * MiB;
constexpr size_t WS_N2 = 1 * MiB;
constexpr size_t WS_ACT = 115 * MiB;
constexpr size_t WS_DECA = 243 * MiB, WS_DECB = 243 * MiB + 512 * 1024;
constexpr size_t WS_END = 256 * MiB;

__device__ __forceinline__ float bf2f(bf16 u) { return __uint_as_float((unsigned)u << 16); }
__device__ __forceinline__ unsigned f2bf(float f) { unsigned u = __builtin_bit_cast(unsigned, f); return (u + 0x7fffu + ((u >> 16) & 1u)) >> 16; }
__device__ __forceinline__ unsigned pk2(float lo, float hi) { return f2bf(lo) | (f2bf(hi) << 16); }
__device__ __forceinline__ float wave_sum(float v) {
#pragma unroll
    for (int o = 1; o < 64; o <<= 1) v += __shfl_xor(v, o);
    return v;
}
__device__ __forceinline__ float wave_max(float v) {
#pragma unroll
    for (int o = 1; o < 64; o <<= 1) v = fmaxf(v, __shfl_xor(v, o));
    return v;
}
__device__ __forceinline__ void unpack8(const v4u w, float (&f)[8]) {
    f[0] = __uint_as_float(w.x << 16); f[1] = __uint_as_float(w.x & 0xffff0000u); f[2] = __uint_as_float(w.y << 16); f[3] = __uint_as_float(w.y & 0xffff0000u);
    f[4] = __uint_as_float(w.z << 16); f[5] = __uint_as_float(w.z & 0xffff0000u); f[6] = __uint_as_float(w.w << 16); f[7] = __uint_as_float(w.w & 0xffff0000u);
}
__device__ __forceinline__ void rope_sincos(float a, float& s, float& c) {
    const float n = rintf(a * 0.15915494309189535f);
    float r = fmaf(-n, 6.2831854820251465f, a); r = fmaf(-n, -1.7484555e-7f, r);
    const float rev = r * 0.15915494309189535f;
    s = __builtin_amdgcn_sinf(rev); c = __builtin_amdgcn_cosf(rev);
}

__device__ __forceinline__ int dst_row_map(int mode, int n0) {
    if (mode == 1) { const int seg = n0 >> 9, within = n0 & 511; const int dseg = (seg == 0) ? 0 : (seg == 4 ? 1 : (seg < 4 ? seg + 1 : seg)); return dseg * 512 + within; }
    if (mode == 2) { return n0 < DFF ? (n0 >> 7) * 256 + (n0 & 127) : ((n0 - DFF) >> 7) * 256 + 128 + ((n0 - DFF) & 127); }
    return n0;
}
__device__ __forceinline__ void transpose_item(const float* W, int K, int N, const float* g, bf16* WT, int mode, LAS float* scr, int item, int lane) {
    const int nblk = N / 64, kb = item / nblk, nb = item % nblk, k0 = 64 * kb, n0 = 64 * nb, lr = lane >> 4, lc = lane & 15;
    f32x4 v[16];
#pragma unroll
    for (int i = 0; i < 16; ++i) v[i] = *(const f32x4*)(W + (size_t)(k0 + 4 * i + lr) * N + n0 + 4 * lc);
#pragma unroll
    for (int i = 0; i < 16; ++i) { const int kk = 4 * i + lr; const float gg = g ? g[k0 + kk] : 1.0f; LAS float* p = scr + kk * 65 + 4 * lc; p[0] = v[i][0] * gg; p[1] = v[i][1] * gg; p[2] = v[i][2] * gg; p[3] = v[i][3] * gg; }
    asm volatile("s_waitcnt lgkmcnt(0)" ::: "memory");
    const int c = lane & 7; const int d0 = dst_row_map(mode, n0);
#pragma unroll
    for (int j = 0; j < 8; ++j) { const int n = (lane >> 3) + 8 * j; const LAS float* sp = scr + (8 * c) * 65 + n;
        v4u o; o.x = pk2(sp[0 * 65], sp[1 * 65]); o.y = pk2(sp[2 * 65], sp[3 * 65]); o.z = pk2(sp[4 * 65], sp[5 * 65]); o.w = pk2(sp[6 * 65], sp[7 * 65]);
        *(v4u*)(WT + (size_t)(d0 + n) * K + k0 + 8 * c) = o; }
    asm volatile("s_waitcnt lgkmcnt(0)" ::: "memory");
}
struct ProArgs { const float* in[25]; unsigned char* ws; int layer_mask; int ffn_mode; };
#define CONVERT_JOB(Wp, K_, N_, gp, dst, mode) do { const int nitems = ((K_) / 64) * ((N_) / 64); for (int it = gw; it < nitems; it += NGW) transpose_item((Wp), (K_), (N_), (gp), (bf16*)(ws + (dst)), (mode), scr, it, lane); } while (0)
__device__ __forceinline__ void prologue_body(const ProArgs& a, int gw, int NGW, int lane, LAS float* scr) {
    unsigned char* ws = a.ws;
    const float* x = a.in[0]; const float* mem = a.in[1];
    if (a.layer_mask & 1) {
        CONVERT_JOB(a.in[3], D, EV_IN, a.in[2], WS_EVIN, 1);
        CONVERT_JOB(a.in[7], D, D, (const float*)nullptr, WS_EVOUT, 0);
        CONVERT_JOB(a.in[15], D, D, a.in[13], WS_XQ0, 0);
        CONVERT_JOB(a.in[16], D, 2 * D, (const float*)nullptr, WS_XKV0, 0);
        CONVERT_JOB(a.in[19], D, D, (const float*)nullptr, WS_XO0, 0);
        CONVERT_JOB(a.in[21], D, 2 * DFF, a.in[20], WS_FIN0, a.ffn_mode);
        CONVERT_JOB(a.in[24], DFF, D, (const float*)nullptr, WS_FOUT0, 0);
        for (int m = 2 * gw; m < M; m += 2 * NGW) {
            const f32x4* xr = (const f32x4*)(x + (size_t)m * D) + lane; v2u* o8 = (v2u*)((bf16*)(ws + WS_XB) + (size_t)m * D) + lane; float* sp = (float*)(ws + WS_SSQP);
            f32x4 v[8];
#pragma unroll
            for (int j = 0; j < 8; ++j) v[j] = xr[64 * j];
#pragma unroll
            for (int j = 0; j < 8; ++j) { v2u w; w.x = pk2(v[j][0], v[j][1]); w.y = pk2(v[j][2], v[j][3]); o8[64 * j] = w;
                const float s2 = wave_sum((v[j][0] * v[j][0] + v[j][1] * v[j][1]) + (v[j][2] * v[j][2] + v[j][3] * v[j][3])); if (lane == 0) sp[(size_t)(j & 3) * M + m + (j >> 2)] = s2; }
        }
        for (int r = gw; r < 2 * MM; r += NGW) { const int l = r / MM, m = r % MM;
            const f32x4* xr = (const f32x4*)(mem + (size_t)m * D) + lane; const f32x4* gr = (const f32x4*)(a.in[14] + (size_t)l * D) + lane;
            f32x4 v[4]; float s = 0.f;
#pragma unroll
            for (int j = 0; j < 4; ++j) { v[j] = xr[64 * j]; s += (v[j][0] * v[j][0] + v[j][1] * v[j][1]) + (v[j][2] * v[j][2] + v[j][3] * v[j][3]); }
            const float rs = 1.0f / sqrtf(wave_sum(s) * (1.0f / D) + EPS);
            v2u* o8 = (v2u*)((bf16*)(ws + (l ? WS_MEMH1 : WS_MEMH0)) + (size_t)m * D) + lane;
#pragma unroll
            for (int j = 0; j < 4; ++j) { const f32x4 g = gr[64 * j]; v2u w; w.x = pk2(v[j][0] * rs * g[0], v[j][1] * rs * g[1]); w.y = pk2(v[j][2] * rs * g[2], v[j][3] * rs * g[3]); o8[64 * j] = w; }
        }
        if (gw == 0) {
            const float* lg = a.in[6]; float* lb = (float*)(ws + WS_LB);
            for (int c = lane; c < 512; c += 64) { const float a0 = lg[c], a1 = lg[512 + c], a2 = lg[1024 + c]; const float mx = fmaxf(a0, fmaxf(a1, a2));
                const float e0 = expf(a0 - mx), e1 = expf(a1 - mx), e2 = expf(a2 - mx); lb[c] = e0 / (e0 + e1 + e2); }
        }
        if (gw == 2) {
            float* gx = (float*)(ws + WS_GXA); float* go = (float*)(ws + WS_GOD);
            for (int i = lane; i < 512; i += 64) gx[i] = a.in[18][i] * a.in[17][i];
            for (int i = lane; i < 128; i += 64) go[i] = a.in[10][i] * a.in[9][i];
        }
        if (gw == 1) {
            const float* rb = a.in[11]; float* bt = (float*)(ws + WS_BIAST);
            for (int i = lane; i < 3 * 8 * 132; i += 64) { const int br = i / (8 * 132), h = (i / 132) % 8, dl = i % 132; const int d = dl * (1 << (2 * br));
                int bucket; if (d < 16) bucket = d; else { const float lr = logf((float)d / 16.0f) / 4.852030263919617f; int lg2 = 16 + (int)(lr * 16.0f); bucket = lg2 < 31 ? lg2 : 31; }
                bt[i] = (dl <= 128) ? rb[bucket * 8 + h] : 0.f; }
        }
    }
    if (a.layer_mask & 2) {
        CONVERT_JOB(a.in[8], D, OD_IN, a.in[2] + D, WS_ODIN, 0);
        CONVERT_JOB(a.in[12], D, D, (const float*)nullptr, WS_ODOUT, 0);
        CONVERT_JOB(a.in[15] + (size_t)D * D, D, D, a.in[13] + D, WS_XQ1, 0);
        CONVERT_JOB(a.in[16] + (size_t)D * 2 * D, D, 2 * D, (const float*)nullptr, WS_XKV1, 0);
        CONVERT_JOB(a.in[19] + (size_t)D * D, D, D, (const float*)nullptr, WS_XO1, 0);
        CONVERT_JOB(a.in[21] + (size_t)D * 2 * DFF, D, 2 * DFF, a.in[20] + D, WS_FIN1, a.ffn_mode);
        CONVERT_JOB(a.in[24] + (size_t)DFF * D, DFF, D, (const float*)nullptr, WS_FOUT1, 0);
    }
}


typedef short bf16x8 __attribute__((ext_vector_type(8)));
typedef short s16x4 __attribute__((ext_vector_type(4)));
typedef float f32x16 __attribute__((ext_vector_type(16)));
typedef float f32x2_t __attribute__((ext_vector_type(2))); typedef __bf16 bf16x2_t __attribute__((ext_vector_type(2)));
typedef short v4i16_t __attribute__((ext_vector_type(4)));
#define MFMA32(a, b, c) __builtin_amdgcn_mfma_f32_32x32x16_bf16((a), (b), (c), 0, 0, 0)
__device__ __forceinline__ unsigned cvtpk(float lo, float hi) { f32x2_t v = {lo, hi}; bf16x2_t b = __builtin_convertvector(v, bf16x2_t); return __builtin_bit_cast(unsigned, b); }
__device__ __forceinline__ bf16x8 pack8(float a0, float a1, float a2, float a3, float a4, float a5, float a6, float a7) {
    v4u p; p.x = cvtpk(a0, a1); p.y = cvtpk(a2, a3); p.z = cvtpk(a4, a5); p.w = cvtpk(a6, a7); return __builtin_bit_cast(bf16x8, p); }
__device__ __forceinline__ s16x4 vtr(const LAS char* p) { return __builtin_bit_cast(s16x4, __builtin_amdgcn_ds_read_tr16_b64_v4i16((LAS v4i16_t*)p)); }
__device__ __forceinline__ int tr_lane_base(int lane, int stride) { const int g = lane >> 4, i = lane & 15, q = i >> 2, p = i & 3, h2 = g >> 1; return (4 * h2 + q) * stride + (16 * (g & 1) + 4 * p) * 2; }
__device__ __forceinline__ bf16x8 tr_frag_perm(const LAS char* img, int stride, int lbase, int k0, int n0) {
    const LAS char* p = img + lbase + k0 * stride + n0 * 2;
    const s16x4 lo = vtr(p), hi = vtr(p + 8 * stride);
    return (bf16x8){lo[0], lo[1], lo[2], lo[3], hi[0], hi[1], hi[2], hi[3]};
}
__device__ __forceinline__ int tr_lane_base_nat(int lane, int stride) { const int g = lane >> 4, i = lane & 15, q = i >> 2, p = i & 3, h2 = g >> 1; return (8 * h2 + q) * stride + (16 * (g & 1) + 4 * p) * 2; }
__device__ __forceinline__ bf16x8 tr_frag_nat(const LAS char* img, int stride, int lbase, int k0, int n0) {
    const LAS char* p = img + lbase + k0 * stride + n0 * 2;
    const s16x4 lo = vtr(p), hi = vtr(p + 4 * stride);
    return (bf16x8){lo[0], lo[1], lo[2], lo[3], hi[0], hi[1], hi[2], hi[3]};
}

#define LDS_BARRIER() do { asm volatile("s_waitcnt lgkmcnt(0)" ::: "memory"); __builtin_amdgcn_s_barrier(); asm volatile("" ::: "memory"); } while (0)
constexpr int XA_STRIDE = 528, XA_VSTRIDE = 528;
constexpr int XA_LDS = 256 * XA_STRIDE;
template <bool Q_IN_LDS> __device__ __forceinline__ void xattn_unit(LAS char* lds, const bf16* __restrict__ Q, const bf16* __restrict__ MKV, const float* __restrict__ gkq, bf16* __restrict__ O, int unit, int tid) {
    const int lane = tid & 63, w = __builtin_amdgcn_readfirstlane(tid >> 6), r = lane & 31, h2 = lane >> 5;
    const int rb = unit >> 2, h = unit & 3, row0 = rb * 256, b = row0 / SEQ;
    const bf16* Kg = MKV + (size_t)(b * NMEM) * 2048 + h * 256; const bf16* Vg = Kg + 1024;
    v4u st[16];
#pragma unroll
    for (int i = 0; i < 16; ++i) { const int id = tid + 512 * i; st[i] = *(const v4u*)(Kg + (size_t)(id >> 5) * 2048 + (id & 31) * 8); }
    const size_t qoff = (size_t)(row0 + 32 * w + r) * D + h * 256;
    bf16x8 qf[16];
    if (Q_IN_LDS) {
#pragma unroll
        for (int s = 0; s < 16; ++s) qf[s] = *(const LAS bf16x8*)(lds + (32 * w + r) * XA_STRIDE + h2 * 16 + s * 32);
        asm volatile("s_waitcnt lgkmcnt(0)" ::: "memory"); __builtin_amdgcn_s_barrier(); asm volatile("" ::: "memory");
    } else {
#pragma unroll
        for (int s = 0; s < 16; ++s) qf[s] = *(const bf16x8*)(Q + qoff + 8 * h2 + 16 * s);
    }
    { float gk8[8];
#pragma unroll
      for (int e = 0; e < 8; ++e) gk8[e] = gkq[(tid & 31) * 8 + e];
#pragma unroll
      for (int i = 0; i < 16; ++i) { const int id = tid + 512 * i; float f[8]; unpack8(st[i], f);
          float sq = (f[0] * f[0] + f[1] * f[1]) + (f[2] * f[2] + f[3] * f[3]) + (f[4] * f[4] + f[5] * f[5]) + (f[6] * f[6] + f[7] * f[7]);
          sq += __shfl_xor(sq, 1); sq += __shfl_xor(sq, 2); sq += __shfl_xor(sq, 4); sq += __shfl_xor(sq, 8); sq += __shfl_xor(sq, 16);
          const float rk = 1.0f / sqrtf(sq * (1.0f / 256.0f) + EPS) * 0.0625f;
          v4u o; o.x = cvtpk(f[0] * rk * gk8[0], f[1] * rk * gk8[1]); o.y = cvtpk(f[2] * rk * gk8[2], f[3] * rk * gk8[3]); o.z = cvtpk(f[4] * rk * gk8[4], f[5] * rk * gk8[5]); o.w = cvtpk(f[6] * rk * gk8[6], f[7] * rk * gk8[7]);
          *(LAS v4u*)(lds + (id >> 5) * XA_STRIDE + (id & 31) * 16) = o; } }
    float ss = 0.f;
#pragma unroll
    for (int s = 0; s < 16; ++s)
#pragma unroll
        for (int j = 0; j < 8; ++j) { const float x = __uint_as_float((unsigned)(unsigned short)qf[s][j] << 16); ss += x * x; }
    ss += __shfl_xor(ss, 32);
    const float rsl = 1.0f / sqrtf(ss * (1.0f / 256.0f) + EPS) * 1.4426950408889634f;
    asm volatile("" ::: "memory");
#pragma unroll
    for (int i = 0; i < 8; ++i) { const int id = tid + 512 * i; st[i] = *(const v4u*)(Vg + (size_t)(id >> 5) * 2048 + (id & 31) * 8); }
    LDS_BARRIER();
    bf16x8 pf[8][2]; float den = 0.f;
#pragma unroll
    for (int kb = 0; kb < 8; ++kb) {
        f32x16 acc;
#pragma unroll
        for (int i = 0; i < 16; ++i) acc[i] = 0.f;
        const LAS char* kp = lds + (32 * kb + r) * XA_STRIDE + h2 * 16;
#pragma unroll
        for (int s = 0; s < 16; ++s) { const bf16x8 a = *(const LAS bf16x8*)(kp + s * 32); acc = MFMA32(a, qf[s], acc); }
        float p[16];
#pragma unroll
        for (int i = 0; i < 16; ++i) { p[i] = __builtin_amdgcn_exp2f(acc[i] * rsl - 11.541560327111707f); den += p[i]; }
        pf[kb][0] = pack8(p[0], p[1], p[2], p[3], p[4], p[5], p[6], p[7]); pf[kb][1] = pack8(p[8], p[9], p[10], p[11], p[12], p[13], p[14], p[15]);
    }
    den += __shfl_xor(den, 32);
    const float inv = 1.0f / den;
    LDS_BARRIER();
#pragma unroll
    for (int i = 8; i < 16; ++i) { const int id = tid + 512 * i; st[i] = *(const v4u*)(Vg + (size_t)(id >> 5) * 2048 + (id & 31) * 8); }
#pragma unroll
    for (int i = 0; i < 16; ++i) { const int id = tid + 512 * i; *(LAS v4u*)(lds + (id >> 5) * XA_VSTRIDE + (id & 31) * 16) = st[i]; }
    LDS_BARRIER();
    const int lbase = tr_lane_base(lane, XA_VSTRIDE);
#pragma unroll
    for (int half = 0; half < 2; ++half) {
        f32x16 o[4];
#pragma unroll
        for (int vb = 0; vb < 4; ++vb)
#pragma unroll
            for (int i = 0; i < 16; ++i) o[vb][i] = 0.f;
#pragma unroll
        for (int kb = 0; kb < 8; ++kb)
#pragma unroll
            for (int s = 0; s < 2; ++s)
#pragma unroll
                for (int vb = 0; vb < 4; ++vb) { const bf16x8 a = tr_frag_perm(lds, XA_VSTRIDE, lbase, 32 * kb + 16 * s, 128 * half + 32 * vb); o[vb] = MFMA32(a, pf[kb][s], o[vb]); }
        LAS char* tile = lds + 256 * XA_VSTRIDE + w * 2560;
#pragma unroll
        for (int vb = 0; vb < 4; ++vb) {
#pragma unroll
            for (int g4 = 0; g4 < 4; ++g4) { v2u wv; wv.x = cvtpk(o[vb][4 * g4] * inv, o[vb][4 * g4 + 1] * inv); wv.y = cvtpk(o[vb][4 * g4 + 2] * inv, o[vb][4 * g4 + 3] * inv);
                *(LAS v2u*)(tile + r * 80 + (8 * g4 + 4 * h2) * 2) = wv; }
            asm volatile("s_waitcnt lgkmcnt(0)" ::: "memory");
#pragma unroll
            for (int i = 0; i < 2; ++i) { const int id = lane + 64 * i; *(v4u*)(O + (size_t)(row0 + 32 * w + (id >> 2)) * D + h * 256 + 128 * half + 32 * vb + 8 * (id & 3)) = *(const LAS v4u*)(tile + (id >> 2) * 80 + (id & 3) * 16); }
            asm volatile("s_waitcnt lgkmcnt(0)" ::: "memory");
        }
    }
    __syncthreads();
}


struct EpiXattn {
    static constexpr bool PERM = true, AFTER_DRAIN = true;
    struct Pre { int unused; };
    const bf16* MKV; const float* gkq; bf16* O;
    __device__ __forceinline__ void init(f32x4 (&)[2][2][4][2], const pg8::Unit&, int, int, int, int) const {}
    __device__ __forceinline__ void fused(f32x4 (&acc)[2][2][4][2], const pg8::Unit& u, int wr, int wc, int fr, int fq, LAS unsigned char* lds, int wid, int lane) const {
#pragma unroll
        for (int ai = 0; ai < 2; ++ai)
#pragma unroll
            for (int m = 0; m < 4; ++m) { const int row = ai * 128 + wr * 64 + m * 16 + fr;
#pragma unroll
                for (int bj = 0; bj < 2; ++bj) { const f32x4 v0 = acc[ai][bj][m][0], v1 = acc[ai][bj][m][1];
                    v4u o; o.x = cvtpk(v0[0], v0[1]); o.y = cvtpk(v0[2], v0[3]); o.z = cvtpk(v1[0], v1[1]); o.w = cvtpk(v1[2], v1[3]);
                    *(LAS v4u*)(lds + row * XA_STRIDE + (bj * 128 + wc * 32 + 8 * fq) * 2) = o; } }
        asm volatile("s_waitcnt lgkmcnt(0)" ::: "memory"); __builtin_amdgcn_s_barrier(); asm volatile("" ::: "memory");
    }
};

constexpr int DA_STRIDE = 272, DA_VSTRIDE = 320, DA_LDS_BIAS = 384 * DA_VSTRIDE, DA_LDS_OSTG = DA_LDS_BIAS + 768, DA_OSTG_WAVE = 32 * 144 + 128;
static_assert(DA_LDS_OSTG + 8 * DA_OSTG_WAVE <= 163840 - 512, "dilated attention LDS map");
constexpr int DA_UNUSED0 = 0;
struct DaArgs { const bf16* QKV; const float* biasT; const float* gkq; bf16* N0; float* DEN0; const bf16* N1; const float* DEN1; const bf16* N2; const float* DEN2; bf16* O; int br0; int nbr; int mode; int pad; };
struct DaUnit { int br, b, h, dil, cls, l0; };
template <int MODE> __device__ __forceinline__ DaUnit da_decode(int uu) {
    DaUnit U; U.br = MODE == 0 ? __builtin_amdgcn_readfirstlane(1 + (uu >> 9)) : 0; const int rem = __builtin_amdgcn_readfirstlane(uu & 511), x = rem & 15; U.b = rem >> 7; U.h = (rem >> 4) & 7; U.dil = 1 << (2 * U.br);
    U.cls = U.br == 0 ? 0 : (U.br == 1 ? (x & 3) : x); U.l0 = 256 * (U.br == 0 ? x : (U.br == 1 ? (x >> 2) : 0)); return U; }
__device__ __forceinline__ void da_load_rows(v4u (&st)[12], const bf16* QKV, const DaUnit& U, int col, int tid) {
    const bf16* base = QKV + (size_t)(U.b * SEQ) * OD_IN + U.h * 128 + col + (tid & 15) * 8;
#pragma unroll
    for (int i = 0; i < 12; ++i) { const int ki = (tid >> 4) + 32 * i, lk = U.l0 - 128 + ki, lkc = lk < 0 ? 0 : lk; st[i] = *(const v4u*)(base + (size_t)(lkc * U.dil + U.cls) * OD_IN); }
}
template <int MODE> __device__ __forceinline__ void dattn_phase(LAS char* lds, const DaArgs& a, int bx, int G, int tid) {
    constexpr int NUNITS = MODE == 0 ? 1024 : 512;
    const int lane = tid & 63, w = __builtin_amdgcn_readfirstlane(tid >> 6), r = lane & 31, h2 = lane >> 5;
    int uu = (G == 256) ? (((bx & 7) << 5) | (bx >> 3)) : bx; if (uu >= NUNITS) return;
    v4u st[12];
    { const DaUnit U0 = da_decode<MODE>(uu); da_load_rows(st, a.QKV, U0, 1024, tid); }
    LAS float* lbias = (LAS float*)(lds + DA_LDS_BIAS);
    const int lbase = tr_lane_base(lane, DA_VSTRIDE);
    for (;;) {
        const DaUnit U = da_decode<MODE>(uu);
        const int l0 = U.l0, h = U.h; const bool zfirst = (l0 == 0);
        int r_l = r; asm volatile("" : "+v"(r_l));
        float gk8[8];
#pragma unroll
        for (int e = 0; e < 8; ++e) gk8[e] = a.gkq[(tid & 15) * 8 + e];
        const size_t qrow = (size_t)(U.b * SEQ + (l0 + 32 * w + r) * U.dil + U.cls);
#pragma unroll
        for (int i = 0; i < 12; ++i) { float f_[8]; unpack8((i < 4 && zfirst) ? (v4u){0u, 0u, 0u, 0u} : st[i], f_);
            float sq_ = (f_[0] * f_[0] + f_[1] * f_[1]) + (f_[2] * f_[2] + f_[3] * f_[3]) + (f_[4] * f_[4] + f_[5] * f_[5]) + (f_[6] * f_[6] + f_[7] * f_[7]);
            sq_ += __shfl_xor(sq_, 1); sq_ += __shfl_xor(sq_, 2); sq_ += __shfl_xor(sq_, 4); sq_ += __shfl_xor(sq_, 8);
            const float rk_ = 1.0f / sqrtf(sq_ * (1.0f / 128.0f) + EPS) * 0.08838834764831845f;
            v4u o_; o_.x = cvtpk(f_[0] * rk_ * gk8[0], f_[1] * rk_ * gk8[1]); o_.y = cvtpk(f_[2] * rk_ * gk8[2], f_[3] * rk_ * gk8[3]); o_.z = cvtpk(f_[4] * rk_ * gk8[4], f_[5] * rk_ * gk8[5]); o_.w = cvtpk(f_[6] * rk_ * gk8[6], f_[7] * rk_ * gk8[7]);
            *(LAS v4u*)(lds + ((tid >> 4) + 32 * i) * DA_STRIDE + (tid & 15) * 16) = o_; }
        if (tid < 192) { const int dl = tid - 32; lbias[tid] = (dl >= 0 && dl <= 128) ? a.biasT[(U.br * 8 + h) * 132 + dl] * 1.4426950408889634f - 11.541560327111707f : -__builtin_inff(); }
        asm volatile("" ::: "memory");
        bf16x8 qf[8];
#pragma unroll
        for (int s = 0; s < 8; ++s) qf[s] = *(const bf16x8*)(a.QKV + qrow * OD_IN + h * 128 + 8 * h2 + 16 * s);
        da_load_rows(st, a.QKV, U, 2048, tid);
        float ss = 0.f;
#pragma unroll
        for (int s = 0; s < 8; ++s)
#pragma unroll
            for (int j = 0; j < 8; ++j) { const float xq = __uint_as_float((unsigned)(unsigned short)qf[s][j] << 16); ss += xq * xq; }
        ss += __shfl_xor(ss, 32);
        const float rsl = 1.0f / sqrtf(ss * (1.0f / 128.0f) + EPS) * 1.4426950408889634f;
        LDS_BARRIER();
        bf16x8 pf[5][2]; float den = 0.f;
#pragma unroll
        for (int kbi = 0; kbi < 5; ++kbi) {
            if (zfirst && w + kbi < 4) { pf[kbi][0] = (bf16x8){0, 0, 0, 0, 0, 0, 0, 0}; pf[kbi][1] = pf[kbi][0]; continue; }
            f32x16 acc;
#pragma unroll
            for (int i = 0; i < 16; ++i) acc[i] = 0.f;
            const LAS char* kp = lds + (32 * (w + kbi) + r) * DA_STRIDE + h2 * 16;
#pragma unroll
            for (int s = 0; s < 8; ++s) { const bf16x8 av = *(const LAS bf16x8*)(kp + s * 32); acc = MFMA32(av, qf[s], acc); }
            __builtin_amdgcn_sched_barrier(0);
            const LAS float* tb = lbias + (r_l - 4 * h2);
#pragma unroll
            for (int hh = 0; hh < 2; ++hh) { float p[8];
#pragma unroll
                for (int i8 = 0; i8 < 8; ++i8) { const int i = 8 * hh + i8;
                    p[i8] = __builtin_amdgcn_exp2f(acc[i] * rsl + tb[160 - 32 * kbi - ((i & 3) + 8 * (i >> 2))]); den += p[i8]; }
                pf[kbi][hh] = pack8(p[0], p[1], p[2], p[3], p[4], p[5], p[6], p[7]);
                __builtin_amdgcn_sched_barrier(0); }
            asm volatile("" ::: "memory");
        }
        den += __shfl_xor(den, 32);
        LDS_BARRIER();
#pragma unroll
        for (int i = 0; i < 12; ++i) *(LAS v4u*)(lds + ((tid >> 4) + 32 * i) * DA_VSTRIDE + (tid & 15) * 16) = (i < 4 && zfirst) ? (v4u){0u, 0u, 0u, 0u} : st[i];
        LDS_BARRIER();
        const int un = uu + G; const bool more = un < NUNITS; const DaUnit Un = da_decode<MODE>(more ? un : uu);
        if (more) da_load_rows(st, a.QKV, Un, 1024, tid);
        LAS char* stg = lds + DA_LDS_OSTG + w * DA_OSTG_WAVE;
        float inv = 1.0f;
        if (MODE == 0) { if (h2 == 0) ((float*)(U.br == 1 ? a.DEN1 : a.DEN2))[qrow * 8 + h] = den; }
        else { inv = 1.0f / (den + a.DEN1[qrow * 8 + h] + a.DEN2[qrow * 8 + h]); if (h2 == 0) ((LAS float*)(stg + 32 * 144))[r] = inv; }
        size_t goff[4];
#pragma unroll
        for (int i = 0; i < 4; ++i) { const int id = lane + 64 * i, row = id >> 3, ch = id & 7; goff[i] = (size_t)(U.b * SEQ + (l0 + 32 * w + row) * U.dil + U.cls) * D + h * 128 + ch * 8; }
#pragma unroll
        for (int half = 0; half < 2; ++half) {
            f32x16 o[2];
            v4u n1v[4], n2v[4];
            if (MODE == 1) {
#pragma unroll
                for (int i = 0; i < 4; ++i) { n1v[i] = *(const v4u*)(a.N1 + goff[i] + 64 * half); n2v[i] = *(const v4u*)(a.N2 + goff[i] + 64 * half); } }
#pragma unroll
            for (int vb = 0; vb < 2; ++vb)
#pragma unroll
                for (int i = 0; i < 16; ++i) o[vb][i] = 0.f;
#pragma unroll
            for (int kbi = 0; kbi < 5; ++kbi)
#pragma unroll
                for (int s = 0; s < 2; ++s)
#pragma unroll
                    for (int vb = 0; vb < 2; ++vb) { const bf16x8 av = tr_frag_perm(lds, DA_VSTRIDE, lbase, 32 * (w + kbi) + 16 * s, 64 * half + 32 * vb); o[vb] = MFMA32(av, pf[kbi][s], o[vb]); }
#pragma unroll
            for (int vb = 0; vb < 2; ++vb)
#pragma unroll
                for (int g4 = 0; g4 < 4; ++g4) { v2u wv; wv.x = cvtpk(o[vb][4 * g4], o[vb][4 * g4 + 1]); wv.y = cvtpk(o[vb][4 * g4 + 2], o[vb][4 * g4 + 3]); *(LAS v2u*)(stg + r * 144 + (32 * vb + 8 * g4 + 4 * h2) * 2) = wv; }
            asm volatile("s_waitcnt lgkmcnt(0)" ::: "memory");
            if (MODE == 0) {
                bf16* N = (bf16*)(U.br == 1 ? a.N1 : a.N2) + 64 * half;
#pragma unroll
                for (int i = 0; i < 4; ++i) { const int id = lane + 64 * i; *(v4u*)(N + goff[i]) = *(const LAS v4u*)(stg + (id >> 3) * 144 + (id & 7) * 16); }
            } else {
#pragma unroll
                for (int i = 0; i < 4; ++i) { const int id = lane + 64 * i; float fo[8], f1[8], f2[8]; unpack8(*(const LAS v4u*)(stg + (id >> 3) * 144 + (id & 7) * 16), fo); unpack8(n1v[i], f1); unpack8(n2v[i], f2);
                    const float iv = ((const LAS float*)(stg + 32 * 144))[id >> 3];
                    v4u ov; ov.x = cvtpk((fo[0] + f1[0] + f2[0]) * iv, (fo[1] + f1[1] + f2[1]) * iv); ov.y = cvtpk((fo[2] + f1[2] + f2[2]) * iv, (fo[3] + f1[3] + f2[3]) * iv);
                    ov.z = cvtpk((fo[4] + f1[4] + f2[4]) * iv, (fo[5] + f1[5] + f2[5]) * iv); ov.w = cvtpk((fo[6] + f1[6] + f2[6]) * iv, (fo[7] + f1[7] + f2[7]) * iv);
                    *(v4u*)(a.O + goff[i] + 64 * half) = ov; }
            }
            asm volatile("s_waitcnt lgkmcnt(0)" ::: "memory");
        }
        LDS_BARRIER();
        if (!more) break;
        uu = un;
    }
}

constexpr int MX_STRIDE = 272, MX_TSTRIDE = 320, MX_IMG = 128 * MX_TSTRIDE;
constexpr int MX_Q = 0, MX_K = MX_IMG, MX_V = 2 * MX_IMG, MX_SCR = 3 * MX_IMG, MX_OSTG = MX_SCR + 5120;
constexpr int MX_UNUSED0 = 0;
struct MixArgs { bf16* Z; const float* lb; const float* ret_g; const float* hg_g; bf16* SBUF; float* DECA; float* DECB; };

__device__ __forceinline__ void st_chunk8(LAS char* img, int stride, int row, int c0, const float (&f)[8]) {
    v4u o; o.x = cvtpk(f[0], f[1]); o.y = cvtpk(f[2], f[3]); o.z = cvtpk(f[4], f[5]); o.w = cvtpk(f[6], f[7]); *(LAS v4u*)(img + row * stride + c0 * 2) = o; }

__device__ __forceinline__ void ret_prep_tile(LAS char* img, int stride, const bf16* zrow  , int j, int cg, const float (&sn)[16], const float (&cs)[16], float sc) {
#pragma unroll
    for (int hc = 0; hc < 2; ++hc) { float x1[8], x2[8], o1[8], o2[8];
        unpack8(*(const v4u*)(zrow + 16 * cg + 8 * hc), x1); unpack8(*(const v4u*)(zrow + 64 + 16 * cg + 8 * hc), x2);
#pragma unroll
        for (int e = 0; e < 8; ++e) { o1[e] = (x1[e] * cs[8 * hc + e] - x2[e] * sn[8 * hc + e]) * sc; o2[e] = (x1[e] * sn[8 * hc + e] + x2[e] * cs[8 * hc + e]) * sc; }
        st_chunk8(img, stride, j, 16 * cg + 8 * hc, o1); st_chunk8(img, stride, j, 64 + 16 * cg + 8 * hc, o2); }
}
__device__ __forceinline__ void copy_tile(LAS char* img, int stride, const bf16* src, int tid) {
#pragma unroll
    for (int i = 0; i < 4; ++i) { const int id = tid + 512 * i, row = id >> 4, ch = id & 15; *(LAS v4u*)(img + row * stride + ch * 16) = *(const v4u*)(src + (size_t)row * EV_IN + ch * 8); }
}
__device__ __forceinline__ void hg_gates(const bf16* zrow_f  , const float* lbh  , int tid, LAS float* scr, float (&cum)[32], float (&kk)[32]) {
    const int lane = tid & 63, hw = (tid >> 6) & 1, cg = tid >> 7;
#pragma unroll
    for (int q = 0; q < 4; ++q) { float fl[8]; unpack8(*(const v4u*)(zrow_f + 32 * cg + 8 * q), fl);
#pragma unroll
        for (int e = 0; e < 8; ++e) { const float l = lbh[32 * cg + 8 * q + e]; const float f = l + (1.0f - l) * (1.0f / (1.0f + __expf(-fl[e]))); kk[8 * q + e] = 1.0f - f; cum[8 * q + e] = __logf(fmaxf(f, 1e-6f)); } }
#pragma unroll
    for (int off = 1; off < 64; off <<= 1) {
#pragma unroll
        for (int c = 0; c < 32; ++c) { const float t = __shfl_up(cum[c], off); if (lane >= off) cum[c] += t; } }
    if (hw == 0 && lane == 63) {
#pragma unroll
        for (int c = 0; c < 32; ++c) scr[32 * cg + c] = cum[c]; }
    __syncthreads();
    if (hw == 1) {
#pragma unroll
        for (int c = 0; c < 32; ++c) cum[c] += scr[32 * cg + c]; }
    if (hw == 1 && lane == 63) {
#pragma unroll
        for (int c = 0; c < 32; ++c) scr[128 + 32 * cg + c] = cum[c]; }
    __syncthreads();
}

__device__ __forceinline__ void load_prep4(v4u (&rw)[4], const bf16* zrow_seg, int mixer, int cg) {
#pragma unroll
    for (int q = 0; q < 4; ++q) { const int col = mixer == 0 ? ((q >> 1) * 64 + 16 * cg + 8 * (q & 1)) : (32 * cg + 8 * q); rw[q] = *(const v4u*)(zrow_seg + col); }
}
__device__ __forceinline__ void load_copy4(v4u (&rw)[4], const bf16* tile, int tid) {
#pragma unroll
    for (int i = 0; i < 4; ++i) { const int id = tid + 512 * i; rw[i] = *(const v4u*)(tile + (size_t)(id >> 4) * EV_IN + (id & 15) * 8); }
}
__device__ __forceinline__ void store_copy4(LAS char* img, int stride, const v4u (&rw)[4], int tid) {
#pragma unroll
    for (int i = 0; i < 4; ++i) { const int id = tid + 512 * i; *(LAS v4u*)(img + (id >> 4) * stride + (id & 15) * 16) = rw[i]; }
}
__device__ __forceinline__ void ret_prep_raw(LAS char* img, int stride, const v4u (&rw)[4], int j, int cg, const float (&sn)[16], const float (&cs)[16], float sc) {
#pragma unroll
    for (int hc = 0; hc < 2; ++hc) { float x1[8], x2[8], o1[8], o2[8]; unpack8(rw[hc], x1); unpack8(rw[2 + hc], x2);
#pragma unroll
        for (int e = 0; e < 8; ++e) { o1[e] = (x1[e] * cs[8 * hc + e] - x2[e] * sn[8 * hc + e]) * sc; o2[e] = (x1[e] * sn[8 * hc + e] + x2[e] * cs[8 * hc + e]) * sc; }
        st_chunk8(img, stride, j, 16 * cg + 8 * hc, o1); st_chunk8(img, stride, j, 64 + 16 * cg + 8 * hc, o2); }
}
__device__ __forceinline__ void hg_gates_raw(const v4u (&rw)[4], const float* lbh, int tid, LAS float* scr, float (&cum)[32], float (&kk)[32]) {
    const int lane = tid & 63, hw = (tid >> 6) & 1, cg = tid >> 7;
#pragma unroll
    for (int q = 0; q < 4; ++q) { float fl[8]; unpack8(rw[q], fl);
#pragma unroll
        for (int e = 0; e < 8; ++e) { const float l = lbh[32 * cg + 8 * q + e]; const float f = l + (1.0f - l) * (1.0f / (1.0f + __expf(-fl[e]))); kk[8 * q + e] = 1.0f - f; cum[8 * q + e] = __logf(fmaxf(f, 1e-6f)); } }
#pragma unroll
    for (int off = 1; off < 64; off <<= 1) {
#pragma unroll
        for (int c = 0; c < 32; ++c) { const float t = __shfl_up(cum[c], off); if (lane >= off) cum[c] += t; } }
    if (hw == 0 && lane == 63) {
#pragma unroll
        for (int c = 0; c < 32; ++c) scr[32 * cg + c] = cum[c]; }
    LDS_BARRIER();
    if (hw == 1) {
#pragma unroll
        for (int c = 0; c < 32; ++c) cum[c] += scr[32 * cg + c]; }
    if (hw == 1 && lane == 63) {
#pragma unroll
        for (int c = 0; c < 32; ++c) scr[128 + 32 * cg + c] = cum[c]; }
    LDS_BARRIER();
}
struct MixU { int mixer, b, h, n; };
__device__ __forceinline__ MixU mix_decode(int u) { MixU U; const int g = __builtin_amdgcn_readfirstlane(u >> 5); U.n = __builtin_amdgcn_readfirstlane(u & 31); U.mixer = g >> 4; U.b = (g >> 2) & 3; U.h = g & 3; return U; }

__device__ __forceinline__ void mixA_phase(LAS char* lds, const MixArgs& a, int bx, int G, int tid) {
    const int lane = tid & 63, w = __builtin_amdgcn_readfirstlane(tid >> 6), r = lane & 31, h2 = lane >> 5;
    const int j = tid & 127, cg = tid >> 7;
    LAS float* scr = (LAS float*)(lds + MX_SCR);
    int u = bx; if (u >= 1024) return;
    v4u rk[4], rv[4];
    { const MixU U = mix_decode(u); const bf16* zt = a.Z + (size_t)(U.b * SEQ + 128 * U.n) * EV_IN;
      load_prep4(rk, zt + (size_t)j * EV_IN + (U.mixer == 0 ? Z_RK : Z_GF) + U.h * 128, U.mixer, cg); load_copy4(rv, zt + (U.mixer == 0 ? Z_RV : Z_GI) + U.h * 128, tid); }
    for (;;) {
        const MixU U = mix_decode(u); const int h = U.h, n = U.n;
        if (U.mixer == 0) {
            const float gamma = 1.0f - exp2f(-5.0f - (float)h), lg2 = log2f(gamma);
            float sn[16], cs[16];
#pragma unroll
            for (int e = 0; e < 16; ++e) { const float inv = exp2f(-(float)(16 * cg + e) * (13.287712379549449f / 64.0f)); rope_sincos((float)(128 * n + j) * inv, sn[e], cs[e]); }
            ret_prep_raw(lds + MX_K, MX_TSTRIDE, rk, j, cg, sn, cs, 0.08838834764831845f * exp2f((float)(127 - j) * lg2));
            if (tid < 128) { a.DECA[(size_t)u * 128 + tid] = exp2f(128.0f * lg2); a.DECB[(size_t)u * 128 + tid] = gamma; }
        } else {
            float cum[32], kk[32];
            hg_gates_raw(rk, a.lb + h * 128, tid, scr, cum, kk);
#pragma unroll
            for (int q = 0; q < 4; ++q) { float o[8];
#pragma unroll
                for (int e = 0; e < 8; ++e) o[e] = kk[8 * q + e] * __expf(scr[128 + 32 * cg + 8 * q + e] - cum[8 * q + e]);
                st_chunk8(lds + MX_K, MX_TSTRIDE, j, 32 * cg + 8 * q, o); }
            if (tid < 128) { a.DECA[(size_t)u * 128 + tid] = __expf(scr[128 + tid]); a.DECB[(size_t)u * 128 + tid] = __expf(scr[tid]); }
        }
        store_copy4(lds + MX_V, MX_TSTRIDE, rv, tid);
        LDS_BARRIER();
        const int un = u + G; const bool more = un < 1024;
        if (more) { const MixU Un = mix_decode(un); const bf16* zt = a.Z + (size_t)(Un.b * SEQ + 128 * Un.n) * EV_IN;
            load_prep4(rk, zt + (size_t)j * EV_IN + (Un.mixer == 0 ? Z_RK : Z_GF) + Un.h * 128, Un.mixer, cg); load_copy4(rv, zt + (Un.mixer == 0 ? Z_RV : Z_GI) + Un.h * 128, tid); }
        const int lbn = tr_lane_base_nat(lane, MX_TSTRIDE); const int kbk = w >> 1, vb0 = 2 * (w & 1);
        f32x16 acc[2];
#pragma unroll
        for (int t = 0; t < 2; ++t)
#pragma unroll
            for (int i = 0; i < 16; ++i) acc[t][i] = 0.f;
#pragma unroll
        for (int s_ = 0; s_ < 8; ++s_) { const bf16x8 av = tr_frag_nat(lds + MX_K, MX_TSTRIDE, lbn, 16 * s_, 32 * kbk);
#pragma unroll
            for (int t = 0; t < 2; ++t) { const bf16x8 bv = tr_frag_nat(lds + MX_V, MX_TSTRIDE, lbn, 16 * s_, 32 * (vb0 + t)); acc[t] = MFMA32(av, bv, acc[t]); } }
        bf16* sb = a.SBUF + (size_t)u * 16384;
#pragma unroll
        for (int t = 0; t < 2; ++t)
#pragma unroll
            for (int g4 = 0; g4 < 4; ++g4) { v2u wv; wv.x = cvtpk(acc[t][4 * g4], acc[t][4 * g4 + 1]); wv.y = cvtpk(acc[t][4 * g4 + 2], acc[t][4 * g4 + 3]);
                *(v2u*)(sb + ((((((vb0 + t) * 8 + 2 * kbk + (g4 >> 1)) * 2 + (g4 & 1)) * 32 + r) * 8) + 4 * h2)) = wv; }
        LDS_BARRIER();
        if (!more) break;
        u = un;
    }
}

__device__ __forceinline__ void mixA_unit(LAS char* lds, const MixArgs& a, int u, int tid) {
    const int lane = tid & 63, w = __builtin_amdgcn_readfirstlane(tid >> 6), r = lane & 31, h2 = lane >> 5;
    const int g = u >> 5, n = u & 31, mixer = g >> 4, b = (g >> 2) & 3, h = g & 3;
    const int j = tid & 127, cg = tid >> 7;
    const bf16* zt = a.Z + (size_t)(b * SEQ + 128 * n) * EV_IN;
    LAS float* scr = (LAS float*)(lds + MX_SCR);
    if (mixer == 0) {
        const float gamma = 1.0f - exp2f(-5.0f - (float)h), lg2 = log2f(gamma);
        float sn[16], cs[16];
#pragma unroll
        for (int e = 0; e < 16; ++e) { const float inv = exp2f(-(float)(16 * cg + e) * (13.287712379549449f / 64.0f)); rope_sincos((float)(128 * n + j) * inv, sn[e], cs[e]); }
        ret_prep_tile(lds + MX_K, MX_TSTRIDE, zt + (size_t)j * EV_IN + Z_RK + h * 128, j, cg, sn, cs, 0.08838834764831845f * exp2f((float)(127 - j) * lg2));
        copy_tile(lds + MX_V, MX_TSTRIDE, zt + Z_RV + h * 128, tid);
        if (tid < 128) { a.DECA[(size_t)u * 128 + tid] = exp2f(128.0f * lg2); a.DECB[(size_t)u * 128 + tid] = gamma; }
    } else {
        float cum[32], kk[32];
        hg_gates(zt + (size_t)j * EV_IN + Z_GF + h * 128, a.lb + h * 128, tid, scr, cum, kk);
#pragma unroll
        for (int q = 0; q < 4; ++q) { float o[8];
#pragma unroll
            for (int e = 0; e < 8; ++e) o[e] = kk[8 * q + e] * __expf(scr[128 + 32 * cg + 8 * q + e] - cum[8 * q + e]);
            st_chunk8(lds + MX_K, MX_TSTRIDE, j, 32 * cg + 8 * q, o); }
        copy_tile(lds + MX_V, MX_TSTRIDE, zt + Z_GI + h * 128, tid);
        if (tid < 128) { a.DECA[(size_t)u * 128 + tid] = __expf(scr[128 + tid]); a.DECB[(size_t)u * 128 + tid] = __expf(scr[tid]); }
    }
    __syncthreads();
    const int lbn = tr_lane_base_nat(lane, MX_TSTRIDE); const int kbk = w >> 1, vb0 = 2 * (w & 1);
    f32x16 acc[2];
#pragma unroll
    for (int t = 0; t < 2; ++t)
#pragma unroll
        for (int i = 0; i < 16; ++i) acc[t][i] = 0.f;
#pragma unroll
    for (int s = 0; s < 8; ++s) { const bf16x8 av = tr_frag_nat(lds + MX_K, MX_TSTRIDE, lbn, 16 * s, 32 * kbk);
#pragma unroll
        for (int t = 0; t < 2; ++t) { const bf16x8 bv = tr_frag_nat(lds + MX_V, MX_TSTRIDE, lbn, 16 * s, 32 * (vb0 + t)); acc[t] = MFMA32(av, bv, acc[t]); } }
    bf16* sb = a.SBUF + (size_t)u * 16384;
#pragma unroll
    for (int t = 0; t < 2; ++t)
#pragma unroll
        for (int g4 = 0; g4 < 4; ++g4) { v2u wv; wv.x = cvtpk(acc[t][4 * g4], acc[t][4 * g4 + 1]); wv.y = cvtpk(acc[t][4 * g4 + 2], acc[t][4 * g4 + 3]);
            *(v2u*)(sb + ((((((vb0 + t) * 8 + 2 * kbk + (g4 >> 1)) * 2 + (g4 & 1)) * 32 + r) * 8) + 4 * h2)) = wv; }
    __syncthreads();
}

__device__ __forceinline__ void mix_scan(const MixArgs& a, int gtid, int nthreads, bool dry = false) {
    for (int e = gtid; e < 32 * 4096; e += nthreads) { const int g = e >> 12, el = e & 4095, dk4 = 4 * ((el >> 7) & 7) + 2 * ((el >> 6) & 1) + (el & 1);
        bf16* sp = a.SBUF + (size_t)(g * 32) * 16384 + (size_t)el * 4; const float* da = a.DECA + (size_t)(g * 32) * 128 + 4 * dk4; const float* db = a.DECB + (size_t)(g * 32) * 128 + 4 * dk4;
        f32x4 S = (f32x4){0.f, 0.f, 0.f, 0.f};
#pragma unroll 8
        for (int n = 0; n < 32; ++n) { const v2u kv = *(const v2u*)(sp + (size_t)n * 16384); const f32x4 A = *(const f32x4*)(da + n * 128), Bv = *(const f32x4*)(db + n * 128);
            const f32x4 so = S * Bv; v2u wv; wv.x = cvtpk(so[0], so[1]); wv.y = cvtpk(so[2], so[3]); if (!dry) *(v2u*)(sp + (size_t)n * 16384) = wv;
            S[0] = A[0] * S[0] + __uint_as_float(kv.x << 16); S[1] = A[1] * S[1] + __uint_as_float(kv.x & 0xffff0000u); S[2] = A[2] * S[2] + __uint_as_float(kv.y << 16); S[3] = A[3] * S[3] + __uint_as_float(kv.y & 0xffff0000u); }
    }
}

__device__ __forceinline__ void mixC_unit(LAS char* lds, const MixArgs& a, int u, int tid, bool dry = false) {
    const int lane = tid & 63, w = __builtin_amdgcn_readfirstlane(tid >> 6), r = lane & 31, h2 = lane >> 5;
    const int g = u >> 5, n = u & 31, mixer = g >> 4, b = (g >> 2) & 3, h = g & 3;
    const int j = tid & 127, cg = tid >> 7;
    bf16* zt = a.Z + (size_t)(b * SEQ + 128 * n) * EV_IN;
    LAS float* scr = (LAS float*)(lds + MX_SCR);
    if (mixer == 0) {
        const float gamma = 1.0f - exp2f(-5.0f - (float)h), lg2 = log2f(gamma);
        float sn[16], cs[16];
#pragma unroll
        for (int e = 0; e < 16; ++e) { const float inv = exp2f(-(float)(16 * cg + e) * (13.287712379549449f / 64.0f)); rope_sincos((float)(128 * n + j) * inv, sn[e], cs[e]); }
        ret_prep_tile(lds + MX_Q, MX_STRIDE, zt + (size_t)j * EV_IN + Z_RQ + h * 128, j, cg, sn, cs, exp2f((float)j * lg2));
        ret_prep_tile(lds + MX_K, MX_STRIDE, zt + (size_t)j * EV_IN + Z_RK + h * 128, j, cg, sn, cs, 0.08838834764831845f * exp2f(-(float)j * lg2));
        copy_tile(lds + MX_V, MX_TSTRIDE, zt + Z_RV + h * 128, tid);
    } else {
        float cum[32], kk[32];
        hg_gates(zt + (size_t)j * EV_IN + Z_GF + h * 128, a.lb + h * 128, tid, scr, cum, kk);
#pragma unroll
        for (int q = 0; q < 4; ++q) { float qv[8], oq[8], ok[8]; unpack8(*(const v4u*)(zt + (size_t)j * EV_IN + Z_GQ + h * 128 + 32 * cg + 8 * q), qv);
#pragma unroll
            for (int e = 0; e < 8; ++e) { const float d = cum[8 * q + e] - scr[32 * cg + 8 * q + e]; oq[e] = qv[e] * __expf(d); ok[e] = kk[8 * q + e] * __expf(-d); }
            st_chunk8(lds + MX_Q, MX_STRIDE, j, 32 * cg + 8 * q, oq); st_chunk8(lds + MX_K, MX_STRIDE, j, 32 * cg + 8 * q, ok); }
        copy_tile(lds + MX_V, MX_TSTRIDE, zt + Z_GI + h * 128, tid);
    }
    __syncthreads();
    const int vb = w >> 1; const int lbp = tr_lane_base(lane, MX_TSTRIDE);
    const bf16* sb = a.SBUF + (size_t)u * 16384 + (size_t)((vb * 16 + h2) * 32 + r) * 8;
    bf16x8 sf[8];
#pragma unroll
    for (int s = 0; s < 8; ++s) sf[s] = *(const bf16x8*)(sb + s * 512);
    f32x16 o[2]; float s1[2], s2[2];
    const float* rg_ = a.ret_g; const float* hg_ = a.hg_g; const float* gn = (mixer == 0 ? rg_ : hg_) + h * 128 + 32 * vb + 4 * h2;
    v4u gwv[4];
#pragma unroll
    for (int t = 0; t < 2; ++t) { const int ib = (w & 1) ? (1 + t) : (3 * t);
#pragma unroll
        for (int i = 0; i < 2; ++i) { const int id = lane + 64 * i; gwv[2 * t + i] = *(const v4u*)(zt + (size_t)(32 * ib + (id >> 2)) * EV_IN + (mixer == 0 ? Z_RG : Z_GG) + h * 128 + 32 * vb + 8 * (id & 3)); } }
#pragma unroll
    for (int t = 0; t < 2; ++t) {
        const int ib = (w & 1) ? (1 + t) : (3 * t);
        bf16x8 qf[8];
#pragma unroll
        for (int s = 0; s < 8; ++s) qf[s] = *(const LAS bf16x8*)(lds + MX_Q + (32 * ib + r) * MX_STRIDE + h2 * 16 + s * 32);
#pragma unroll
        for (int i = 0; i < 16; ++i) o[t][i] = 0.f;
#pragma unroll
        for (int s = 0; s < 8; ++s) o[t] = MFMA32(sf[s], qf[s], o[t]);
        for (int jb = 0; jb <= ib; ++jb) {
            f32x16 acc;
#pragma unroll
            for (int i = 0; i < 16; ++i) acc[i] = 0.f;
            const LAS char* kp = lds + MX_K + (32 * jb + r) * MX_STRIDE + h2 * 16;
#pragma unroll
            for (int s = 0; s < 8; ++s) { const bf16x8 av = *(const LAS bf16x8*)(kp + s * 32); acc = MFMA32(av, qf[s], acc); }
            if (jb == ib) {
#pragma unroll
                for (int i = 0; i < 16; ++i) { const int c = (i & 3) + 8 * (i >> 2) + 4 * h2; if (c > r) acc[i] = 0.f; } }
            const bf16x8 p0 = pack8(acc[0], acc[1], acc[2], acc[3], acc[4], acc[5], acc[6], acc[7]), p1 = pack8(acc[8], acc[9], acc[10], acc[11], acc[12], acc[13], acc[14], acc[15]);
            const bf16x8 v0 = tr_frag_perm(lds + MX_V, MX_TSTRIDE, lbp, 32 * jb, 32 * vb), v1 = tr_frag_perm(lds + MX_V, MX_TSTRIDE, lbp, 32 * jb + 16, 32 * vb);
            o[t] = MFMA32(v0, p0, o[t]); o[t] = MFMA32(v1, p1, o[t]);
        }
        float a1 = 0.f, a2 = 0.f;
#pragma unroll
        for (int i = 0; i < 16; ++i) { a1 += o[t][i]; a2 += o[t][i] * o[t][i]; }
        a1 += __shfl_xor(a1, 32); a2 += __shfl_xor(a2, 32); s1[t] = a1; s2[t] = a2;
        if (h2 == 0) { scr[256 + (vb * 128 + 32 * ib + r) * 2] = a1; scr[256 + (vb * 128 + 32 * ib + r) * 2 + 1] = a2; }
    }
    LDS_BARRIER();
#pragma unroll
    for (int t = 0; t < 2; ++t) {
        const int ib = (w & 1) ? (1 + t) : (3 * t); const int tok = 32 * ib + r;
        float t1 = 0.f, t2 = 0.f;
#pragma unroll
        for (int v = 0; v < 4; ++v) { t1 += scr[256 + (v * 128 + tok) * 2]; t2 += scr[256 + (v * 128 + tok) * 2 + 1]; }
        float mu = 0.f, rstd;
        if (mixer == 0) { mu = t1 * (1.0f / 128.0f); rstd = 1.0f / sqrtf(fmaxf(t2 * (1.0f / 128.0f) - mu * mu, 0.f) + EPS); } else rstd = 1.0f / sqrtf(t2 * (1.0f / 128.0f) + EPS);
        bf16* zr = zt + (size_t)tok * EV_IN;
        (void)zr;
        LAS char* tile = lds + MX_OSTG + w * 2560;
#pragma unroll
        for (int i = 0; i < 2; ++i) { const int id = lane + 64 * i; *(LAS v4u*)(tile + (id >> 2) * 80 + (id & 3) * 16) = gwv[2 * t + i]; }
        asm volatile("s_waitcnt lgkmcnt(0)" ::: "memory");
#pragma unroll
        for (int g4 = 0; g4 < 4; ++g4) { const v2u gw = *(const LAS v2u*)(tile + r * 80 + (8 * g4 + 4 * h2) * 2); const f32x4 gv = *(const f32x4*)(gn + 8 * g4);
            const float ga[4] = {__uint_as_float(gw.x << 16), __uint_as_float(gw.x & 0xffff0000u), __uint_as_float(gw.y << 16), __uint_as_float(gw.y & 0xffff0000u)}; float y[4];
#pragma unroll
            for (int e = 0; e < 4; ++e) { y[e] = (o[t][4 * g4 + e] - mu) * rstd * gv[e] * (ga[e] / (1.0f + __expf(-ga[e]))); }
            v2u wv; wv.x = cvtpk(y[0], y[1]); wv.y = cvtpk(y[2], y[3]); *(LAS v2u*)(tile + r * 80 + (8 * g4 + 4 * h2) * 2) = wv; }
        asm volatile("s_waitcnt lgkmcnt(0)" ::: "memory");
#pragma unroll
        for (int i = 0; i < 2; ++i) { const int id = lane + 64 * i; const v4u yv = *(const LAS v4u*)(tile + (id >> 2) * 80 + (id & 3) * 16);
            if (!dry) *(v4u*)(zt + (size_t)(32 * ib + (id >> 2)) * EV_IN + (mixer == 0 ? Z_RQ : Z_GQ) + h * 128 + 32 * vb + 8 * (id & 3)) = yv; }
        asm volatile("s_waitcnt lgkmcnt(0)" ::: "memory");
    }
    __syncthreads();
}


__device__ __forceinline__ float gelu_tanh(float x) { const float u = 0.7978845608028654f * (x + 0.044715f * x * x * x); const float t = 1.0f - 2.0f / (1.0f + __expf(2.0f * u)); return 0.5f * x * (1.0f + t); }
__device__ __forceinline__ void ffn_ew(const bf16* GU, const float* cw, const float* cb, bf16* H, int rows, int gtid, int nthreads) {
    for (int idx = gtid; idx < rows * (DFF / 8); idx += nthreads) {
        const int row = idx / (DFF / 8), c0 = (idx % (DFF / 8)) * 8, t = row % SEQ;
        float g0[8], g1[8], g2[8], u[8];
        unpack8(*(const v4u*)(GU + (size_t)row * (2 * DFF) + c0), g2); unpack8(*(const v4u*)(GU + (size_t)row * (2 * DFF) + DFF + c0), u);
        if (t >= 1) unpack8(*(const v4u*)(GU + (size_t)(row - 1) * (2 * DFF) + c0), g1); else { for (int i = 0; i < 8; ++i) g1[i] = 0.f; }
        if (t >= 2) unpack8(*(const v4u*)(GU + (size_t)(row - 2) * (2 * DFF) + c0), g0); else { for (int i = 0; i < 8; ++i) g0[i] = 0.f; }
        float r[8];
#pragma unroll
        for (int i = 0; i < 8; ++i) { const float y = cw[c0 + i] * g0[i] + cw[DFF + c0 + i] * g1[i] + cw[2 * DFF + c0 + i] * g2[i] + cb[c0 + i]; r[i] = gelu_tanh(y) * u[i]; }
        v4u o; o.x = cvtpk(r[0], r[1]); o.y = cvtpk(r[2], r[3]); o.z = cvtpk(r[4], r[5]); o.w = cvtpk(r[6], r[7]);
        *(v4u*)(H + (size_t)row * DFF + c0) = o;
    }
}

constexpr int LDS_BYTES = 163840;
constexpr int LDSCTL_OFF = LDS_BYTES - 512;
constexpr int CW_BAR = 4096;
constexpr size_t CTL_ZERO_BYTES = 1 * MiB;
#define XB_TMO      128
#define XB_XCNT(j)  (256  + 64 * (j))
#define XB_XSUB(j)  (1280 + 64 * (j))
#define XB_XGEN(j)  (2304 + 64 * (j))
#define XB_TOP      3328
#define XB_TOPGEN   3392
#define XCD_BAR_WORDS 3456
#define XB_SPIN_CAP (1u << 18)

__device__ __forceinline__ unsigned xb_ld(unsigned* p)              { return __hip_atomic_load(p, __ATOMIC_RELAXED, __HIP_MEMORY_SCOPE_AGENT); }
__device__ __forceinline__ unsigned xb_add(unsigned* p, unsigned v) { return __hip_atomic_fetch_add(p, v, __ATOMIC_RELAXED, __HIP_MEMORY_SCOPE_AGENT); }
__device__ __forceinline__ unsigned xb_xcc_id() { return (unsigned)__builtin_amdgcn_s_getreg((3 << 11) | 20) & 0xFu; }
#define XB_SPIN(cond, bar) do { unsigned _sp = 0; while (cond) { __builtin_amdgcn_s_sleep(1); \
    if ((++_sp & 255u) == 0u) { if (xb_ld(&(bar)[XB_TMO])) break; if (_sp > XB_SPIN_CAP) { atomicAdd(&(bar)[XB_TMO], 1u); break; } } } } while (0)

struct XcdBarrier {
    unsigned* bar; unsigned x;
    volatile LAS unsigned* st;
};

__device__ __forceinline__ XcdBarrier xcd_barrier_post(unsigned* bar, volatile LAS unsigned* st) {
    XcdBarrier b; b.bar = bar; b.x = xb_xcc_id(); b.st = st;
    if (threadIdx.x == 0) (void)xb_add(&bar[XB_XCNT(b.x)], 1u);
    return b;
}
__device__ __forceinline__ void xcd_barrier_complete(unsigned* bar, unsigned x, unsigned& nloc, unsigned& nx) {
    const unsigned G = gridDim.x * gridDim.y * gridDim.z;
    unsigned sum, cnt, mine, sp = 0u;
    for (;;) {
        sum = 0u; cnt = 0u; mine = 0u;
#pragma unroll
        for (unsigned j = 0; j < 16; ++j) { const unsigned c = xb_ld(&bar[XB_XCNT(j)]); sum += c; cnt += (c > 0u) ? 1u : 0u; mine = (j == x) ? c : mine; }
        if (sum == G) break;
        __builtin_amdgcn_s_sleep(1);
        if ((++sp & 255u) == 0u) { if (xb_ld(&bar[XB_TMO])) break; if (sp > XB_SPIN_CAP) { atomicAdd(&bar[XB_TMO], 1u); break; } }
    }
    nloc = mine > 0u ? mine : 1u; nx = cnt > 0u ? cnt : 1u;
}

__device__ __forceinline__ void xcd_barrier(const XcdBarrier& b) {
    asm volatile("s_waitcnt vmcnt(0)" ::: "memory");
    __syncthreads();
    if (threadIdx.x == 0) {
        unsigned* bar = b.bar;
        __builtin_amdgcn_s_waitcnt(0);
        unsigned nloc = b.st[0], nx = b.st[1];
        if (nloc == 0u) { xcd_barrier_complete(bar, b.x, nloc, nx); b.st[0] = nloc; b.st[1] = nx; }
        const unsigned old = xb_add(&bar[XB_XSUB(b.x)], 1u);
        const unsigned gen = old / nloc;
        if (old + 1u == (gen + 1u) * nloc) {
            __builtin_amdgcn_fence(__ATOMIC_RELEASE, "agent");
            asm volatile("s_waitcnt vmcnt(0)" ::: "memory");
            const unsigned og = xb_add(&bar[XB_TOP], 1u);
            const unsigned tg = og / nx;
            if (og + 1u == (tg + 1u) * nx) xb_add(&bar[XB_TOPGEN], 1u);
            else XB_SPIN(xb_ld(&bar[XB_TOPGEN]) == tg, bar);
            __builtin_amdgcn_fence(__ATOMIC_ACQUIRE, "agent");
            xb_add(&bar[XB_XGEN(b.x)], 1u);
            asm volatile("s_waitcnt vmcnt(0)" ::: "memory");
        } else {
            XB_SPIN(xb_ld(&bar[XB_XGEN(b.x)]) == gen, bar);
            __builtin_amdgcn_fence(__ATOMIC_ACQUIRE, "agent");
            asm volatile("s_waitcnt vmcnt(0)" ::: "memory");
        }
    }
    __syncthreads();
}


__device__ __forceinline__ GAS unsigned char* launder_s(unsigned char* p) { unsigned long long v = (unsigned long long)p; asm volatile("" : "+s"(v)); return (GAS unsigned char*)v; }
__device__ __forceinline__ GAS float* launder_sf(float* p) { unsigned long long v = (unsigned long long)p; asm volatile("" : "+s"(v)); return (GAS float*)v; }
struct FwdArgs { const float* in[25]; float* out; unsigned char* ws; int ph_lo, ph_hi, li, pad; };
__global__ void __launch_bounds__(512, 2) fwd(FwdArgs a) {
    extern __shared__ __attribute__((aligned(16))) unsigned char lds_raw[];
    LAS unsigned char* lds = (LAS unsigned char*)lds_raw;
    const int tid = threadIdx.x, lane = tid & 63, wave = __builtin_amdgcn_readfirstlane(tid >> 6);
    const int G = gridDim.x, bx = blockIdx.x;
    volatile LAS unsigned* MISC = (volatile LAS unsigned*)(lds + LDSCTL_OFF);
    if (tid < 64) MISC[tid] = 0u;
    __syncthreads();
#define WSP (launder_s(a.ws))
#define OUTP (launder_sf(a.out))
    XcdBarrier bar = xcd_barrier_post((unsigned*)(WSP + WS_CTL) + CW_BAR + a.li * XCD_BAR_WORDS, MISC + 8);
    int ph = 0; const int lo = a.ph_lo, hi = a.ph_hi;
#define PH_ON true) for (int rp_ = 0, nr_ = (ph >= lo && ph < hi) ? 1 + ((a.pad >> ph) & 1) : 0; rp_ < nr_; ++rp_, __syncthreads()
#define TID_L ({ int l_; asm volatile("v_mbcnt_lo_u32_b32 %0, -1, 0\n\tv_mbcnt_hi_u32_b32 %0, -1, %0" : "=v"(l_)); wave * 64 + l_; })
#define PH_END do { if (ph >= lo && ph + 1 < hi) xcd_barrier(bar); ++ph; } while (0)
#define XB ((bf16*)(WSP + WS_XB))
#define SSQP ((float*)(WSP + WS_SSQP))
#define ACT ((bf16*)(WSP + WS_ACT))

    if (PH_ON) { ProArgs pa;
#pragma unroll
        for (int i = 0; i < 25; ++i) pa.in[i] = a.in[i];
        pa.ws = (unsigned char*)WSP; pa.layer_mask = 3; pa.ffn_mode = 2;
        { const int t_ = TID_L; prologue_body(pa, bx * 8 + (t_ >> 6), G * 8, t_ & 63, (LAS float*)lds + (t_ >> 6) * 64 * 65); } }
    PH_END;

    for (int l = 0; l < 2; ++l) {
        if (PH_ON) {
            { pg8::Gemm g{XB, (const bf16*)(WSP + (l ? WS_ODIN : WS_EVIN)), M, l ? OD_IN : EV_IN, D, D}; pg8::EpiBf16S E{ACT, SSQP, l ? OD_IN : EV_IN, M, EPS, 0};
              pg8::StaticOrder S; S.init(g.M, g.N, G, bx); pg8::gemm_phase<pg8::EpiBf16S, pg8::StaticOrder, true, true>(lds, g, S, E, TID_L); }
        }
        PH_END;
        const bf16* mixo; int mixo_ld;
        if (l == 0) {
            MixArgs ma{ACT, (const float*)(WSP + WS_LB), a.in[4], a.in[5], (bf16*)OUTP, (float*)(WSP + WS_DECA), (float*)(WSP + WS_DECB)};
            if (PH_ON) mixA_phase((LAS char*)lds, ma, bx, G, TID_L);
            PH_END;
            if (PH_ON) {
                if (bx < 64 && G > 64) { const int lm = bx >> 5;
                    pg8::Gemm g{(const bf16*)(WSP + (lm ? WS_MEMH1 : WS_MEMH0)), (const bf16*)(WSP + (lm ? WS_XKV1 : WS_XKV0)), MM, 2 * D, D, D}; pg8::EpiBf16S E{(bf16*)(WSP + (lm ? WS_MKV1 : WS_MKV0)), nullptr, 2 * D, M, EPS, 0};
                    pg8::StaticOrder S; S.init(g.M, g.N, G, bx & 31); pg8::gemm_phase<pg8::EpiBf16S, pg8::StaticOrder, true, true>(lds, g, S, E, TID_L); }
                else mix_scan(ma, (bx - 64) * 512 + TID_L, (G - 64) * 512, rp_ + 1 < nr_);
            }
            PH_END;
            if (PH_ON) { for (int u = bx; u < 1024; u += G) mixC_unit((LAS char*)lds, ma, u, TID_L, rp_ + 1 < nr_); }
            PH_END;
            mixo = ACT; mixo_ld = EV_IN;
        } else {
            bf16* O = (bf16*)(WSP + WS_ACT + 96 * MiB);
            DaArgs da; da.QKV = ACT; da.biasT = (const float*)(WSP + WS_BIAST); da.gkq = (const float*)(WSP + WS_GOD); da.N0 = (bf16*)(WSP + WS_N2); da.DEN0 = (float*)(WSP + WS_DEN23);
            da.N1 = (const bf16*)(WSP + WS_N2); da.DEN1 = (const float*)(WSP + WS_DEN23); da.N2 = (const bf16*)OUTP; da.DEN2 = (const float*)(WSP + WS_DEN23) + (size_t)M * 8; da.O = O; da.br0 = 1; da.nbr = 2; da.mode = 0; da.pad = 0;
            if (PH_ON) dattn_phase<0>((LAS char*)lds, da, bx, G, TID_L);
            PH_END;
            if (PH_ON) dattn_phase<1>((LAS char*)lds, da, bx, G, TID_L);
            PH_END;
            mixo = O; mixo_ld = D;
        }
        if (PH_ON) { pg8::Gemm g{mixo, (const bf16*)(WSP + (l ? WS_ODOUT : WS_EVOUT)), M, D, D, mixo_ld}; pg8::EpiResid E{l ? (const float*)nullptr : a.in[0], nullptr, XB, SSQP, D, M};
            pg8::StaticOrder S; S.init(g.M, g.N, G, bx); pg8::gemm_phase<pg8::EpiResid, pg8::StaticOrder, false, true>(lds, g, S, E, TID_L); }
        PH_END;
        { bf16* O = (bf16*)(WSP + WS_ACT + 32 * MiB);
          if (PH_ON) { pg8::Gemm g{XB, (const bf16*)(WSP + (l ? WS_XQ1 : WS_XQ0)), M, D, D, D}; EpiXattn E{(const bf16*)(WSP + (l ? WS_MKV1 : WS_MKV0)), (const float*)(WSP + WS_GXA) + l * 256, O};
              pg8::StaticOrder S; S.init(g.M, g.N, G, bx); pg8::gemm_phase<EpiXattn, pg8::StaticOrder, false, true>(lds, g, S, E, TID_L);
              pg8::StaticOrder S2; S2.init(M, D, G, bx); pg8::Unit uq; if (S2.next(0, uq)) xattn_unit<true>((LAS char*)lds, nullptr, (const bf16*)(WSP + (l ? WS_MKV1 : WS_MKV0)), (const float*)(WSP + WS_GXA) + l * 256, O, uq.pm * 4 + uq.pn, TID_L); }
          PH_END;
          if (PH_ON) { pg8::Gemm g{O, (const bf16*)(WSP + (l ? WS_XO1 : WS_XO0)), M, D, D, D}; pg8::EpiResid E{nullptr, nullptr, XB, SSQP, D, M};
              pg8::StaticOrder S; S.init(g.M, g.N, G, bx); pg8::gemm_phase<pg8::EpiResid, pg8::StaticOrder, false, true>(lds, g, S, E, TID_L); }
          PH_END; }
        { bf16* H = ACT;
          if (PH_ON) { pg8::Gemm g{XB, (const bf16*)(WSP + (l ? WS_FIN1 : WS_FIN0)), 68 * 256, 2 * DFF, D, D}; pg8::EpiFfn E{H, SSQP, a.in[22] + (size_t)l * 3 * DFF, a.in[23] + (size_t)l * DFF, M, EPS};
              pg8::FfnOrder S; S.init(g.M, g.N, G, bx); pg8::gemm_phase<pg8::EpiFfn, pg8::FfnOrder, true, true>(lds, g, S, E, TID_L); }
          PH_END;
          if (PH_ON) { pg8::Gemm g{H, (const bf16*)(WSP + (l ? WS_FOUT1 : WS_FOUT0)), M, D, DFF, DFF}; pg8::EpiResid E{nullptr, l ? (float*)OUTP : (float*)nullptr, XB, SSQP, D, M};
              pg8::StaticOrder S; S.init(g.M, g.N, G, bx); pg8::gemm_phase<pg8::EpiResid, pg8::StaticOrder, false, true>(lds, g, S, E, TID_L); }
          PH_END; }
    }
#undef PH_ON
#undef PH_END
#undef TID_L
#undef WSP
#undef OUTP
#undef XB
#undef SSQP
#undef ACT
}
constexpr int N_PHASES = 1 + 9 + 8;

#ifndef PROBE_MASK
#define PROBE_MASK 0
#endif
#ifndef MK_PER_PHASE
#define MK_PER_PHASE 0
#endif
extern "C" void kernel_launch(void* const* d_in, const int* in_sizes, int n_in, void* d_out, int out_size, void* d_ws, size_t ws_size, hipStream_t stream) {
    static int inited = 0;
    if (!inited) {
        if (n_in != 25 || out_size != M * D || ws_size < WS_END) { fprintf(stderr, "kernel_launch: unexpected shapes (n_in %d, out %d, ws %zu)\n", n_in, out_size, ws_size); inited = -1; return; }
        if (hipFuncSetAttribute((const void*)fwd, hipFuncAttributeMaxDynamicSharedMemorySize, LDS_BYTES) != hipSuccess) { fprintf(stderr, "kernel_launch: hipFuncSetAttribute failed\n"); inited = -1; return; }
        inited = 1;
    }
    if (inited < 0) return;
    if (hipMemsetAsync((char*)d_ws + WS_CTL, 0, CTL_ZERO_BYTES, stream) != hipSuccess) return;
    FwdArgs fa{}; for (int i = 0; i < 25; ++i) fa.in[i] = (const float*)d_in[i]; fa.out = (float*)d_out; fa.ws = (unsigned char*)d_ws; fa.pad = PROBE_MASK;
#if MK_PER_PHASE
    for (int p = 0; p < N_PHASES; ++p) { fa.ph_lo = p; fa.ph_hi = p + 1; fa.li = 0; hipLaunchKernelGGL(fwd, dim3(256), dim3(512), LDS_BYTES, stream, fa); }
#else
    fa.ph_lo = 0; fa.ph_hi = N_PHASES; fa.li = 0; hipLaunchKernelGGL(fwd, dim3(256), dim3(512), LDS_BYTES, stream, fa);
#endif
}
```

```cpp
#include <hip/hip_runtime.h>
#include <cstdio>
#include <cstdint>
namespace pg8 {
#define PG8_LAS __attribute__((address_space(3)))
typedef unsigned short bf16_t;
typedef short bf16x8 __attribute__((ext_vector_type(8)));
typedef float f32x4 __attribute__((ext_vector_type(4)));
typedef unsigned u32x4 __attribute__((ext_vector_type(4)));
constexpr int BM = 256, BK = 64, HALF = 128, HTB = HALF * BK * 2  , STAGE_BYTES = 8 * HTB, NXCD = 8, WGM = 8;
constexpr int SSQ_LDS = STAGE_BYTES + 4096, CW_LDS = STAGE_BYTES + 8192;

__host__ __device__ __forceinline__ int lds_byte(int r, int c) { const int st = (r >> 4) * 2 + (c >> 5), rr = r & 15, cc = c & 31, ob = rr * 64 + cc * 2; return st * 1024 + (ob ^ (((ob >> 9) & 1) << 5)); }
__host__ __device__ __forceinline__ void stage_rc(int b, int& R, int& C) { const int st = b / 1024, sb = b % 1024, swz = sb ^ (((sb >> 9) & 1) << 5); R = (st >> 1) * 16 + swz / 64; C = (st & 1) * 32 + (swz % 64) / 2; }
__host__ __device__ __forceinline__ int perm32(int rho) { const int n = rho >> 4, i = rho & 15; return 8 * (i >> 2) + 4 * n + (i & 3); }

struct Unit { int pm, pn; };
struct Gemm { const bf16_t* A; const bf16_t* Bt; int M, N, K, lda; };

struct StaticOrder {
    int nM, nN, nwg, G, c;
    __host__ __device__ __forceinline__ void init(int M, int N, int G_, int c_) { nM = M / BM; nN = N / BM; nwg = nM * nN; G = G_; c = c_; }
    __host__ __device__ __forceinline__ bool next(int i, Unit& u) const {
        const long L = (long)i * G + c; if (L >= nwg) return false;
        int wgid = (int)L; { const int q = nwg / NXCD, r = nwg % NXCD, xcd = wgid % NXCD, off = wgid / NXCD; wgid = (xcd < r ? xcd * (q + 1) : r * (q + 1) + (xcd - r) * q) + off; }
        const int nig = WGM * nN, gid = wgid / nig, fm = gid * WGM, gsz = (nM - fm) < WGM ? (nM - fm) : WGM;
        u.pm = fm + ((wgid % nig) % gsz); u.pn = (wgid % nig) / gsz; return true;
    }
    __device__ __forceinline__ void a_ready(const Unit&) const {}
    __device__ __forceinline__ void done(const Unit&) const {}
    __device__ __forceinline__ int arow(const Unit& u) const { return u.pm * BM; }
};
struct FfnOrder : StaticOrder {
    __device__ __forceinline__ int arow(const Unit& u) const { return (u.pm / 17) * 4096 + 254 * (u.pm % 17) - 2; }
};

__device__ __forceinline__ unsigned cvt_pk_bf16(float lo, float hi) { unsigned r; asm volatile("v_cvt_pk_bf16_f32 %0, %1, %2" : "=v"(r) : "v"(lo), "v"(hi)); return r; }
typedef float f32x2 __attribute__((ext_vector_type(2)));
struct EpiBf16S {
    static constexpr int PERM = 3; static constexpr bool AFTER_DRAIN = false;
    bf16_t* O; const float* ssqp; int ldc; int Mtot; float eps; int pad;
    __device__ __forceinline__ void preload(PG8_LAS unsigned char* lds, const Unit& u, int wr, int wc, int lane) const {
        if (!ssqp) return;
#pragma unroll
        for (int ai = 0; ai < 2; ++ai) __builtin_amdgcn_global_load_lds((const unsigned*)(ssqp + (size_t)wc * Mtot + u.pm * BM + ai * HALF + wr * 64 + lane), (PG8_LAS unsigned*)(lds + SSQ_LDS + (((wr * 2 + ai) * 4 + wc) * 64) * 4), 4, 0, 0);
    }
    __device__ __forceinline__ void preload_unit(PG8_LAS unsigned char*, const Unit&, int, int, int) const {}
    __device__ __forceinline__ void operator()(f32x4 (&acc)[2][2][4][2], const Unit& u, int wr, int wc, int fr, int fq, PG8_LAS unsigned char* lds) const {
        const int row0 = u.pm * BM + wr * 64 + fr; const int col0 = u.pn * BM + wc * 64 + 8 * fq;
        const PG8_LAS float* sl = (const PG8_LAS float*)(lds + SSQ_LDS);
#pragma unroll
        for (int ai = 0; ai < 2; ++ai)
#pragma unroll
            for (int m = 0; m < 4; ++m) { const int row = row0 + ai * HALF + m * 16; float rs = 1.f;
                if (ssqp) { const PG8_LAS float* sp = sl + ((wr * 2 + ai) * 4) * 64 + m * 16 + fr; const float s = (sp[0] + sp[64]) + (sp[128] + sp[192]); rs = 1.0f / sqrtf(s * (1.0f / 1024.0f) + eps); }
                bf16_t* rowp = O + (size_t)row * ldc + col0;
#pragma unroll
                for (int bj = 0; bj < 2; ++bj) { const f32x4 v0 = acc[ai][bj][m][0] * rs, v1 = acc[ai][bj][m][1] * rs;
                    u32x4 w; w.x = cvt_pk_bf16(v0[0], v0[1]); w.y = cvt_pk_bf16(v0[2], v0[3]); w.z = cvt_pk_bf16(v1[0], v1[1]); w.w = cvt_pk_bf16(v1[2], v1[3]);
                    *(u32x4*)(rowp + bj * 32) = w; } }
    }
};

__device__ __forceinline__ float gelu_tanh_f(float x) { const float u = 0.7978845608028654f * (x + 0.044715f * x * x * x); const float t = 1.0f - 2.0f / (1.0f + __expf(2.0f * u)); return 0.5f * x * (1.0f + t); }
struct EpiFfn {
    static constexpr int PERM = 1; static constexpr bool AFTER_DRAIN = false;
    bf16_t* H; const float* ssqp; const float* cw; const float* cb; int Mtot; float eps;
    __device__ __forceinline__ void preload(PG8_LAS unsigned char* lds, const Unit& u, int wr, int wc, int lane) const {
        const int rowb = (u.pm / 17) * 4096 + 254 * (u.pm % 17) - 2;
#pragma unroll
        for (int ai = 0; ai < 2; ++ai) { const int row = rowb + ai * HALF + wr * 64 + lane; const int rc = row < 0 ? 0 : (row >= Mtot ? Mtot - 1 : row);
            __builtin_amdgcn_global_load_lds((const unsigned*)(ssqp + (size_t)wc * Mtot + rc), (PG8_LAS unsigned*)(lds + SSQ_LDS + (((wr * 2 + ai) * 4 + wc) * 64) * 4), 4, 0, 0); }
    }
    __device__ __forceinline__ void preload_unit(PG8_LAS unsigned char* lds, const Unit& u, int wr, int wc, int lane) const {
        const float* src = (wc < 3 ? cw + (size_t)wc * 2816 : cb) + u.pn * 128 + 64 * wr + lane;
        __builtin_amdgcn_global_load_lds((const unsigned*)src, (PG8_LAS unsigned*)(lds + CW_LDS + (wc * 128 + 64 * wr) * 4), 4, 0, 0);
    }
    __device__ __forceinline__ void operator()(f32x4 (&acc)[2][2][4][2], const Unit& u, int wr, int wc, int fr, int fq, PG8_LAS unsigned char* lds) const {
        constexpr int DFF_ = 2816;
        const int b = u.pm / 17, t = u.pm % 17, pos0 = 254 * t - 2, rowb = b * 4096 + pos0;
        const int colh = u.pn * 128 + wc * 32 + 8 * fq, lane = fq * 16 + fr;
        PG8_LAS float* halo = (PG8_LAS float*)(lds + STAGE_BYTES);
#pragma unroll
        for (int ai = 0; ai < 2; ++ai)
#pragma unroll
            for (int m = 0; m < 4; ++m) { const int rl = ai * HALF + wr * 64 + m * 16 + fr; const PG8_LAS float* sp = (const PG8_LAS float*)(lds + SSQ_LDS) + ((wr * 2 + ai) * 4) * 64 + m * 16 + fr;
                const float sq = (sp[0] + sp[64]) + (sp[128] + sp[192]); const float rs = 1.0f / sqrtf(sq * (1.0f / 1024.0f) + eps); const bool pad = (pos0 + rl) < 0;
#pragma unroll
                for (int n = 0; n < 2; ++n) {
#pragma unroll
                    for (int e = 0; e < 4; ++e) { acc[ai][0][m][n][e] = pad ? 0.f : acc[ai][0][m][n][e] * rs; acc[ai][1][m][n][e] *= rs; } } }
#pragma unroll
        for (int ai = 0; ai < 2; ++ai) if (fr >= 14) { PG8_LAS float* hp = halo + ((((2 * ai + wr) * 4 + wc) * 4 + fq) * 2 + (fr - 14)) * 8;
            *(PG8_LAS f32x4*)hp = acc[ai][0][3][0]; *(PG8_LAS f32x4*)(hp + 4) = acc[ai][0][3][1]; }
        asm volatile("s_waitcnt lgkmcnt(0)" ::: "memory"); __builtin_amdgcn_s_barrier(); asm volatile("" ::: "memory");
        typedef unsigned u32x2e __attribute__((ext_vector_type(2)));
#define DPPF(x, ctrl) __builtin_bit_cast(float, __builtin_amdgcn_update_dpp(0, __builtin_bit_cast(int, (x)), (ctrl), 0xf, 0xf, true))
        u32x2e hold[2][4];
#pragma unroll
        for (int n = 0; n < 2; ++n) {
            const PG8_LAS float* cwl = (const PG8_LAS float*)(lds + CW_LDS) + wc * 32 + 8 * fq + 4 * n;
            const f32x4 w0 = *(const PG8_LAS f32x4*)cwl, w1 = *(const PG8_LAS f32x4*)(cwl + 128), w2 = *(const PG8_LAS f32x4*)(cwl + 256), bb = *(const PG8_LAS f32x4*)(cwl + 384);
#pragma unroll
            for (int ai = 0; ai < 2; ++ai) {
                const int blk = 2 * ai + wr; f32x4 R1p = (f32x4){0.f, 0.f, 0.f, 0.f}, R2p = (f32x4){0.f, 0.f, 0.f, 0.f};
                if (blk >= 1) { const PG8_LAS float* hp = halo + ((((blk - 1) * 4 + wc) * 4 + fq) * 2) * 8 + 4 * n; const f32x4 h62 = *(const PG8_LAS f32x4*)hp, h63 = *(const PG8_LAS f32x4*)(hp + 8);
                    const f32x4 z4 = (f32x4){0.f, 0.f, 0.f, 0.f}; R1p = fr == 0 ? h63 : z4; R2p = fr == 0 ? h62 : (fr == 1 ? h63 : z4); }
#pragma unroll
                for (int m = 0; m < 4; ++m) { const int rl = ai * HALF + wr * 64 + m * 16 + fr; const bool ok = (rl >= 2) && (pos0 + rl < 4096);
                    float hv[4];
#pragma unroll
                    for (int e = 0; e < 4; ++e) { const float v = acc[ai][0][m][n][e];
                        const float p1 = DPPF(v, 0x111) + R1p[e], p2 = DPPF(v, 0x112) + R2p[e]; R1p[e] = DPPF(v, 0x10F); R2p[e] = DPPF(v, 0x10E);
                        const float y = w0[e] * p2 + (w1[e] * p1 + (w2[e] * v + bb[e]));
                        const float tq = y * (-2.302208198f + -0.10294324f * (y * y));
                        const float sg = __builtin_amdgcn_rcpf(1.0f + __builtin_amdgcn_exp2f(tq));
                        hv[e] = (y * acc[ai][1][m][n][e]) * sg; }
                    u32x2e w; w.x = cvt_pk_bf16(hv[0], hv[1]); w.y = cvt_pk_bf16(hv[2], hv[3]);
                    if (n == 0) hold[ai][m] = w;
                    else if (ok) { u32x4 w4; w4.x = hold[ai][m].x; w4.y = hold[ai][m].y; w4.z = w.x; w4.w = w.y; *(u32x4*)(H + (size_t)(rowb + rl) * DFF_ + colh) = w4; } }
            }
        }
#undef DPPF
        asm volatile("s_waitcnt lgkmcnt(0)" ::: "memory"); __builtin_amdgcn_s_barrier(); asm volatile("" ::: "memory");
    }
};
struct EpiResid {
    static constexpr int PERM = 1; static constexpr bool AFTER_DRAIN = true;
    struct Pre { int unused; };
    const float* base; float* out; bf16_t* xb; float* ssqp; int ldc; int Mtot;
    __device__ __forceinline__ void init(f32x4 (&acc)[2][2][4][2], const Unit& u, int wr, int wc, int fr, int fq) const {
        const int col0 = u.pn * BM + wc * 32 + 8 * fq;
#pragma unroll
        for (int ai = 0; ai < 2; ++ai)
#pragma unroll
            for (int m = 0; m < 4; ++m) { const size_t off = (size_t)(u.pm * BM + ai * HALF + wr * 64 + m * 16 + fr) * ldc + col0;
#pragma unroll
                for (int bj = 0; bj < 2; ++bj) {
                    if (base) { acc[ai][bj][m][0] = *(const f32x4*)(base + off + bj * HALF); acc[ai][bj][m][1] = *(const f32x4*)(base + off + bj * HALF + 4); }
                    else { const u32x4 w = *(const u32x4*)(xb + off + bj * HALF);
                        acc[ai][bj][m][0] = (f32x4){__uint_as_float(w.x << 16), __uint_as_float(w.x & 0xffff0000u), __uint_as_float(w.y << 16), __uint_as_float(w.y & 0xffff0000u)};
                        acc[ai][bj][m][1] = (f32x4){__uint_as_float(w.z << 16), __uint_as_float(w.z & 0xffff0000u), __uint_as_float(w.w << 16), __uint_as_float(w.w & 0xffff0000u)}; } } }
    }
    __device__ __forceinline__ void fused(f32x4 (&acc)[2][2][4][2], const Unit& u, int wr, int wc, int fr, int fq, PG8_LAS unsigned char* lds, int wid, int lane) const {
        PG8_LAS float* P = (PG8_LAS float*)lds;
        const int col0 = u.pn * BM + wc * 32 + 8 * fq;
#pragma unroll
        for (int ai = 0; ai < 2; ++ai)
#pragma unroll
            for (int m = 0; m < 4; ++m) { const int r = ai * HALF + wr * 64 + m * 16 + fr; const size_t off = (size_t)(u.pm * BM + r) * ldc + col0; float s = 0.f;
#pragma unroll
                for (int bj = 0; bj < 2; ++bj) { const f32x4 o0 = acc[ai][bj][m][0], o1 = acc[ai][bj][m][1];
                    if (out) { *(f32x4*)(out + off + bj * HALF) = o0; *(f32x4*)(out + off + bj * HALF + 4) = o1; }
                    u32x4 w; w.x = cvt_pk_bf16(o0[0], o0[1]); w.y = cvt_pk_bf16(o0[2], o0[3]); w.z = cvt_pk_bf16(o1[0], o1[1]); w.w = cvt_pk_bf16(o1[2], o1[3]); *(u32x4*)(xb + off + bj * HALF) = w;
                    s += ((o0[0] * o0[0] + o0[1] * o0[1]) + (o0[2] * o0[2] + o0[3] * o0[3])) + ((o1[0] * o1[0] + o1[1] * o1[1]) + (o1[2] * o1[2] + o1[3] * o1[3])); }
                s += __shfl_xor(s, 16); s += __shfl_xor(s, 32);
                if (fq == 0) P[r * 4 + wc] = s;
                if (m & 1) asm volatile("" ::: "memory"); }
        asm volatile("s_waitcnt lgkmcnt(0)" ::: "memory"); __builtin_amdgcn_s_barrier(); asm volatile("" ::: "memory");
        if (lane < 32) { const int row = wid * 32 + lane; ssqp[(size_t)u.pn * Mtot + u.pm * BM + row] = (P[row * 4 + 0] + P[row * 4 + 1]) + (P[row * 4 + 2] + P[row * 4 + 3]); }
        asm volatile("s_waitcnt lgkmcnt(0)" ::: "memory"); __builtin_amdgcn_s_barrier(); asm volatile("" ::: "memory");
    }
};

template <class Epi, class Sched, bool ALIGN_EPI = false, bool SP2 = false>
__device__ __forceinline__ void gemm_phase(PG8_LAS unsigned char* lds, const Gemm g, const Sched& S, const Epi& E, int tid_in) {
    int tid_l = tid_in; asm volatile("" : "+v"(tid_l));
    const int tid = tid_l, wid = __builtin_amdgcn_readfirstlane(tid >> 6), lane = tid & 63, wr = wid >> 2, wc = wid & 3, fr = lane & 15, fq = lane >> 4;
    const int K = g.K, nt = K / BK;
    unsigned voffA[2], voffB[2];
#pragma unroll
    for (int i = 0; i < 2; ++i) { int R, C; stage_rc(tid * 16 + i * 8192, R, C); const int Rb = (int)Epi::PERM == 3 ? (64 * (R >> 5) + perm32(R & 31)) : ((int)Epi::PERM == 1 ? ((R & ~31) + perm32(R & 31)) : R);
        voffA[i] = (unsigned)(R * g.lda + C) * 2u; voffB[i] = (unsigned)(Rb * K + C) * 2u; }
    const size_t kstep = (size_t)(BK * 2);
    const size_t hstepA = (size_t)HALF * g.lda * 2, hstepB = (size_t)((int)Epi::PERM == 3 ? 32 : HALF) * K * 2;
    const size_t tstepB = (size_t)BM * K * 2;
    const unsigned ldsw = (unsigned)wid * 1024u;
    const int aoff = lds_byte(wr * 64 + fr, fq * 8), boff = lds_byte(wc * 32 + fr, fq * 8);
#define PG8_SA(b, h) (((b) * 2 + (h)) * HTB)
#define PG8_SB(b, h) ((4 + (b) * 2 + (h)) * HTB)
#define PG8_STAGE(bufoff, gbase, voff) do { _Pragma("unroll") for (int _i = 0; _i < 2; ++_i) \
        __builtin_amdgcn_global_load_lds((const unsigned*)((const char*)(gbase) + (voff)[_i]), (PG8_LAS unsigned*)(lds + (bufoff) + ldsw + _i * 8192), 16, 0, 0); } while (0)
#define PG8_LDA(dst, b, h) do { _Pragma("unroll") for (int m = 0; m < 4; ++m) _Pragma("unroll") for (int k = 0; k < 2; ++k) dst[m][k] = *(const PG8_LAS bf16x8*)(lds + PG8_SA(b, h) + aoff + m * 2048 + k * 1024); } while (0)
#define PG8_LDB(dst, b, h) do { _Pragma("unroll") for (int n = 0; n < 2; ++n) _Pragma("unroll") for (int k = 0; k < 2; ++k) dst[n][k] = *(const PG8_LAS bf16x8*)(lds + PG8_SB(b, h) + boff + n * 2048 + k * 1024); } while (0)
#define PG8_MMA(ai, bj, At, Bt) do { __builtin_amdgcn_s_setprio(1); _Pragma("unroll") for (int m = 0; m < 4; ++m) _Pragma("unroll") for (int n = 0; n < 2; ++n) _Pragma("unroll") for (int k = 0; k < 2; ++k) \
        acc[ai][bj][m][n] = __builtin_amdgcn_mfma_f32_16x16x32_bf16(Bt[n][k], At[m][k], acc[ai][bj][m][n], 0, 0, 0); __builtin_amdgcn_s_setprio(0); } while (0)
#define PG8_WAIT_V(n) asm volatile("s_waitcnt vmcnt(" #n ")" ::: "memory")
#define PG8_WAIT_L(n) asm volatile("s_waitcnt lgkmcnt(" #n ")" ::: "memory")
#define PG8_BAR __builtin_amdgcn_s_barrier()
#define PG8_SCHED __builtin_amdgcn_sched_barrier(0)
    Unit cur, nxt; int ui = 0;
    if (!S.next(0, cur)) return;
    f32x4 acc[2][2][4][2];
#pragma unroll
    for (int a = 0; a < 2; ++a)
#pragma unroll
        for (int b = 0; b < 2; ++b)
#pragma unroll
            for (int m = 0; m < 4; ++m)
#pragma unroll
                for (int n = 0; n < 2; ++n) acc[a][b][m][n] = (f32x4){0.f, 0.f, 0.f, 0.f};
    if constexpr (Epi::AFTER_DRAIN) E.init(acc, cur, wr, wc, fr, fq);
    bf16x8 At[4][2], B0[2][2], B1[2][2];
    const char* cA = (const char*)g.A + (ptrdiff_t)S.arow(cur) * (ptrdiff_t)(g.lda * 2); const char* cB = (const char*)g.Bt + (size_t)cur.pn * tstepB;
    S.a_ready(cur);
    if constexpr (!Epi::AFTER_DRAIN) E.preload_unit(lds, cur, wr, wc, lane);
    if constexpr (SP2) {
        PG8_STAGE(PG8_SB(0, 0), cB, voffB); PG8_STAGE(PG8_SB(0, 1), cB + hstepB, voffB); PG8_STAGE(PG8_SA(0, 0), cA, voffA); PG8_STAGE(PG8_SA(0, 1), cA + hstepA, voffA);
        if (wr == 1) PG8_BAR;
        PG8_WAIT_V(2); PG8_BAR;
        PG8_STAGE(PG8_SB(1, 0), cB + kstep, voffB); PG8_STAGE(PG8_SA(1, 0), cA + kstep, voffA); PG8_STAGE(PG8_SB(1, 1), cB + hstepB + kstep, voffB);
        PG8_WAIT_V(6); PG8_BAR;
        if constexpr (Epi::AFTER_DRAIN) {
#pragma unroll
            for (int a_ = 0; a_ < 2; ++a_)
#pragma unroll
                for (int b_ = 0; b_ < 2; ++b_) asm volatile("" : "+v"(acc[a_][b_][0][0]), "+v"(acc[a_][b_][0][1]), "+v"(acc[a_][b_][1][0]), "+v"(acc[a_][b_][1][1]), "+v"(acc[a_][b_][2][0]), "+v"(acc[a_][b_][2][1]), "+v"(acc[a_][b_][3][0]), "+v"(acc[a_][b_][3][1]));
        }
    } else {
        PG8_STAGE(PG8_SB(0, 0), cB, voffB); PG8_STAGE(PG8_SA(0, 0), cA, voffA); PG8_STAGE(PG8_SB(0, 1), cB + hstepB, voffB); PG8_STAGE(PG8_SA(0, 1), cA + hstepA, voffA);
        if (wr == 1) PG8_BAR;
        PG8_WAIT_V(4); PG8_BAR;
        PG8_STAGE(PG8_SB(1, 0), cB + kstep, voffB); PG8_STAGE(PG8_SA(1, 0), cA + kstep, voffA); PG8_STAGE(PG8_SB(1, 1), cB + hstepB + kstep, voffB);
        PG8_WAIT_V(6); PG8_BAR;
    }
    for (;;) {
        const bool has_next = S.next(ui + 1, nxt);
        const char* nA = has_next ? (const char*)g.A + (ptrdiff_t)S.arow(nxt) * (ptrdiff_t)(g.lda * 2) : cA; const char* nB = has_next ? (const char*)g.Bt + (size_t)nxt.pn * tstepB : cB;
        for (int t = 0; t < nt; t += 2) {
            const bool last = (t == nt - 2);
            const char* a1 = cA + (size_t)(t + 1) * kstep;
            const char* a2 = last ? nA : cA + (size_t)(t + 2) * kstep; const char* b2 = last ? nB : cB + (size_t)(t + 2) * kstep;
            const char* a3 = a2 + kstep; const char* b3 = b2 + kstep;
            if (last && has_next) S.a_ready(nxt);
            if constexpr (!Epi::AFTER_DRAIN) { if (last) E.preload(lds, cur, wr, wc, lane); }
            if constexpr (SP2) {
            PG8_LDB(B0, 0, 0); PG8_LDB(B1, 0, 1); PG8_SCHED; PG8_LDA(At, 0, 0); PG8_STAGE(PG8_SA(1, 1), a1 + hstepA, voffA);
            PG8_WAIT_V(8); PG8_WAIT_L(0); PG8_BAR; PG8_MMA(0, 0, At, B0); PG8_MMA(0, 1, At, B1); PG8_BAR; PG8_SCHED;
            PG8_LDA(At, 0, 1); PG8_STAGE(PG8_SB(0, 0), b2, voffB); PG8_STAGE(PG8_SB(0, 1), b2 + hstepB, voffB); PG8_STAGE(PG8_SA(0, 0), a2, voffA);
            PG8_WAIT_V(8); PG8_WAIT_L(0); PG8_BAR; PG8_MMA(1, 0, At, B0); PG8_MMA(1, 1, At, B1); PG8_BAR; PG8_SCHED;
            PG8_LDB(B0, 1, 0); PG8_LDB(B1, 1, 1); PG8_SCHED; PG8_LDA(At, 1, 0); PG8_STAGE(PG8_SA(0, 1), a2 + hstepA, voffA);
            PG8_WAIT_V(8); PG8_WAIT_L(0); PG8_BAR; PG8_MMA(0, 0, At, B0); PG8_MMA(0, 1, At, B1); PG8_BAR; PG8_SCHED;
            PG8_LDA(At, 1, 1); PG8_STAGE(PG8_SB(1, 0), b3, voffB); PG8_STAGE(PG8_SB(1, 1), b3 + hstepB, voffB); PG8_STAGE(PG8_SA(1, 0), a3, voffA);
            PG8_WAIT_V(8); PG8_WAIT_L(0); PG8_BAR; PG8_MMA(1, 0, At, B0); PG8_MMA(1, 1, At, B1); PG8_BAR; PG8_SCHED;
            } else {
            PG8_LDB(B0, 0, 0); PG8_SCHED; PG8_LDA(At, 0, 0); PG8_STAGE(PG8_SA(1, 1), a1 + hstepA, voffA);
            PG8_WAIT_L(8); PG8_BAR; PG8_WAIT_L(0); PG8_MMA(0, 0, At, B0); PG8_BAR; PG8_SCHED;
            PG8_LDB(B1, 0, 1); PG8_STAGE(PG8_SB(0, 0), b2, voffB);
            PG8_BAR; PG8_WAIT_L(0); PG8_MMA(0, 1, At, B1); PG8_BAR;
            PG8_LDA(At, 0, 1); PG8_STAGE(PG8_SA(0, 0), a2, voffA);
            PG8_BAR; PG8_WAIT_L(0); PG8_MMA(1, 0, At, B0); PG8_BAR; PG8_SCHED;
            PG8_STAGE(PG8_SB(0, 1), b2 + hstepB, voffB);
            PG8_WAIT_V(6); PG8_BAR; PG8_MMA(1, 1, At, B1); PG8_BAR;
            PG8_LDB(B0, 1, 0); PG8_SCHED; PG8_LDA(At, 1, 0); PG8_STAGE(PG8_SA(0, 1), a2 + hstepA, voffA);
            PG8_WAIT_L(8); PG8_BAR; PG8_WAIT_L(0); PG8_MMA(0, 0, At, B0); PG8_BAR; PG8_SCHED;
            PG8_LDB(B1, 1, 1); PG8_STAGE(PG8_SB(1, 0), b3, voffB);
            PG8_BAR; PG8_WAIT_L(0); PG8_MMA(0, 1, At, B1); PG8_BAR;
            PG8_LDA(At, 1, 1); PG8_STAGE(PG8_SA(1, 0), a3, voffA);
            PG8_BAR; PG8_WAIT_L(0); PG8_MMA(1, 0, At, B0); PG8_BAR; PG8_SCHED;
            PG8_STAGE(PG8_SB(1, 1), b3 + hstepB, voffB);
            PG8_WAIT_V(6); PG8_BAR; PG8_MMA(1, 1, At, B1); PG8_BAR;
            }
        }
        if constexpr (ALIGN_EPI) { if (wr == 0) PG8_BAR; }
        if constexpr (!Epi::AFTER_DRAIN) { E(acc, cur, wr, wc, fr, fq, lds); S.done(cur); if (has_next) E.preload_unit(lds, nxt, wr, wc, lane); }
        if (!has_next) break;
#pragma unroll
        for (int a = 0; a < 2; ++a)
#pragma unroll
            for (int b = 0; b < 2; ++b)
#pragma unroll
                for (int m = 0; m < 4; ++m)
#pragma unroll
                    for (int n = 0; n < 2; ++n) acc[a][b][m][n] = (f32x4){0.f, 0.f, 0.f, 0.f};
        cur = nxt; cA = nA; cB = nB; ++ui;
        if constexpr (ALIGN_EPI) { if (wr == 1) PG8_BAR; }
    }
    PG8_WAIT_V(0);
    if constexpr (!ALIGN_EPI) { if (wr == 0) PG8_BAR; }
    PG8_BAR;
    if constexpr (Epi::AFTER_DRAIN) { E.fused(acc, cur, wr, wc, fr, fq, lds, wid, lane); S.done(cur); }
#undef PG8_SA
#undef PG8_SB
#undef PG8_STAGE
#undef PG8_LDA
#undef PG8_LDB
#undef PG8_MMA
#undef PG8_WAIT_V
#undef PG8_WAIT_L
#undef PG8_BAR
#undef PG8_SCHED
}
}


#define GAS __attribute__((address_space(1)))
#define LAS __attribute__((address_space(3)))
typedef unsigned short bf16;
typedef unsigned v4u __attribute__((ext_vector_type(4)));
typedef unsigned v2u __attribute__((ext_vector_type(2)));
typedef float f32x4 __attribute__((ext_vector_type(4)));
constexpr int BATCH = 4, SEQ = 4096, D = 1024, M = BATCH * SEQ, NMEM = 256, MM = BATCH * NMEM, DFF = 2816;
constexpr int EV_IN = 4096, OD_IN = 3072;
constexpr float EPS = 1e-6f;
constexpr int Z_RQ = 0, Z_GQ = 512, Z_RK = 1024, Z_RV = 1536, Z_RG = 2048, Z_GF = 2560, Z_GI = 3072, Z_GG = 3584;

constexpr size_t MiB = 1u << 20;
constexpr size_t WS_CTL = 0;
constexpr size_t WS_EVIN = 1 * MiB, WS_EVOUT = 9 * MiB, WS_XQ0 = 11 * MiB, WS_XKV0 = 13 * MiB, WS_XO0 = 17 * MiB, WS_FIN0 = 19 * MiB, WS_FOUT0 = 30 * MiB;
constexpr size_t WS_ODIN = 36 * MiB, WS_ODOUT = 42 * MiB, WS_XQ1 = 44 * MiB, WS_XKV1 = 46 * MiB, WS_XO1 = 50 * MiB, WS_FIN1 = 52 * MiB, WS_FOUT1 = 63 * MiB;
constexpr size_t WS_XB = 69 * MiB;
constexpr size_t WS_MKV0 = 101 * MiB, WS_MKV1 = 105 * MiB;
constexpr size_t WS_MEMH0 = 109 * MiB, WS_MEMH1 = 111 * MiB;
constexpr size_t WS_SSQP = 113 * MiB;
constexpr size_t WS_LB = 113 * MiB + 512 * 1024;
constexpr size_t WS_BIAST = 113 * MiB + 516 * 1024;
constexpr size_t WS_GXA = 113 * MiB + 600 * 1024, WS_GOD = 113 * MiB + 604 * 1024;
constexpr size_t WS_DEN23 = 114 * MiB;
constexpr size_t WS_N2 = 1 * MiB;
constexpr size_t WS_ACT = 115 * MiB;
constexpr size_t WS_DECA = 243 * MiB, WS_DECB = 243 * MiB + 512 * 1024;
constexpr size_t WS_END = 256 * MiB;

__device__ __forceinline__ float bf2f(bf16 u) { return __uint_as_float((unsigned)u << 16); }
__device__ __forceinline__ unsigned f2bf(float f) { unsigned u = __builtin_bit_cast(unsigned, f); return (u + 0x7fffu + ((u >> 16) & 1u)) >> 16; }
__device__ __forceinline__ unsigned pk2(float lo, float hi) { return f2bf(lo) | (f2bf(hi) << 16); }
__device__ __forceinline__ float wave_sum(float v) {
#pragma unroll
    for (int o = 1; o < 64; o <<= 1) v += __shfl_xor(v, o);
    return v;
}
__device__ __forceinline__ float wave_max(float v) {
#pragma unroll
    for (int o = 1; o < 64; o <<= 1) v = fmaxf(v, __shfl_xor(v, o));
    return v;
}
__device__ __forceinline__ void unpack8(const v4u w, float (&f)[8]) {
    f[0] = __uint_as_float(w.x << 16); f[1] = __uint_as_float(w.x & 0xffff0000u); f[2] = __uint_as_float(w.y << 16); f[3] = __uint_as_float(w.y & 0xffff0000u);
    f[4] = __uint_as_float(w.z << 16); f[5] = __uint_as_float(w.z & 0xffff0000u); f[6] = __uint_as_float(w.w << 16); f[7] = __uint_as_float(w.w & 0xffff0000u);
}
__device__ __forceinline__ void rope_sincos(float a, float& s, float& c) {
    const float n = rintf(a * 0.15915494309189535f);
    float r = fmaf(-n, 6.2831854820251465f, a); r = fmaf(-n, -1.7484555e-7f, r);
    const float rev = r * 0.15915494309189535f;
    s = __builtin_amdgcn_sinf(rev); c = __builtin_amdgcn_cosf(rev);
}

__device__ __forceinline__ int dst_row_map(int mode, int n0) {
    if (mode == 1) { const int seg = n0 >> 9, within = n0 & 511; const int dseg = (seg == 0) ? 0 : (seg == 4 ? 1 : (seg < 4 ? seg + 1 : seg)); return dseg * 512 + within; }
    if (mode == 2) { return n0 < DFF ? (n0 >> 7) * 256 + (n0 & 127) : ((n0 - DFF) >> 7) * 256 + 128 + ((n0 - DFF) & 127); }
    return n0;
}
__device__ __forceinline__ void transpose_item(const float* W, int K, int N, const float* g, bf16* WT, int mode, LAS float* scr, int item, int lane) {
    const int nblk = N / 64, kb = item / nblk, nb = item % nblk, k0 = 64 * kb, n0 = 64 * nb, lr = lane >> 4, lc = lane & 15;
    f32x4 v[16];
#pragma unroll
    for (int i = 0; i < 16; ++i) v[i] = *(const f32x4*)(W + (size_t)(k0 + 4 * i + lr) * N + n0 + 4 * lc);
#pragma unroll
    for (int i = 0; i < 16; ++i) { const int kk = 4 * i + lr; const float gg = g ? g[k0 + kk] : 1.0f; LAS float* p = scr + kk * 65 + 4 * lc; p[0] = v[i][0] * gg; p[1] = v[i][1] * gg; p[2] = v[i][2] * gg; p[3] = v[i][3] * gg; }
    asm volatile("s_waitcnt lgkmcnt(0)" ::: "memory");
    const int c = lane & 7; const int d0 = dst_row_map(mode, n0);
#pragma unroll
    for (int j = 0; j < 8; ++j) { const int n = (lane >> 3) + 8 * j; const LAS float* sp = scr + (8 * c) * 65 + n;
        v4u o; o.x = pk2(sp[0 * 65], sp[1 * 65]); o.y = pk2(sp[2 * 65], sp[3 * 65]); o.z = pk2(sp[4 * 65], sp[5 * 65]); o.w = pk2(sp[6 * 65], sp[7 * 65]);
        *(v4u*)(WT + (size_t)(d0 + n) * K + k0 + 8 * c) = o; }
    asm volatile("s_waitcnt lgkmcnt(0)" ::: "memory");
}
struct ProArgs { const float* in[25]; unsigned char* ws; int layer_mask; int ffn_mode; };
#define PICK_JOB(Wp_, K__, N__, gp_, dst_, mode_) if (!found) { const int ni_ = ((K__) / 64) * ((N__) / 64); if (r < ni_) { W_ = (Wp_); K_ = (K__); N_ = (N__); g_ = (gp_); d_ = (dst_); m_ = (mode_); found = true; } else r -= ni_; }
__device__ __forceinline__ void prologue_body(const ProArgs& a, int gw, int NGW, int lane, LAS float* scr) {
    unsigned char* ws = a.ws;
    const float* x = a.in[0]; const float* mem = a.in[1];
    if (a.layer_mask & 1) {
        constexpr int NITEMS_ALL = 2 * ((D / 64) * (D / 64) * 3 + (D / 64) * (2 * D / 64) + (D / 64) * (2 * DFF / 64) + (DFF / 64) * (D / 64)) + (D / 64) * (EV_IN / 64) + (D / 64) * (OD_IN / 64) + (D / 64) * (D / 64) * 0;
        for (int it = gw; it < NITEMS_ALL; it += NGW) {
            int r = it; bool found = false; const float* W_ = nullptr; const float* g_ = nullptr; int K_ = 0, N_ = 0, m_ = 0; size_t d_ = 0;
            PICK_JOB(a.in[3], D, EV_IN, a.in[2], WS_EVIN, 1)
            PICK_JOB(a.in[21], D, 2 * DFF, a.in[20], WS_FIN0, a.ffn_mode)
            PICK_JOB(a.in[21] + (size_t)D * 2 * DFF, D, 2 * DFF, a.in[20] + D, WS_FIN1, a.ffn_mode)
            PICK_JOB(a.in[8], D, OD_IN, a.in[2] + D, WS_ODIN, 0)
            PICK_JOB(a.in[24], DFF, D, (const float*)nullptr, WS_FOUT0, 0)
            PICK_JOB(a.in[24] + (size_t)DFF * D, DFF, D, (const float*)nullptr, WS_FOUT1, 0)
            PICK_JOB(a.in[16], D, 2 * D, (const float*)nullptr, WS_XKV0, 0)
            PICK_JOB(a.in[16] + (size_t)D * 2 * D, D, 2 * D, (const float*)nullptr, WS_XKV1, 0)
            PICK_JOB(a.in[7], D, D, (const float*)nullptr, WS_EVOUT, 0)
            PICK_JOB(a.in[12], D, D, (const float*)nullptr, WS_ODOUT, 0)
            PICK_JOB(a.in[15], D, D, a.in[13], WS_XQ0, 0)
            PICK_JOB(a.in[15] + (size_t)D * D, D, D, a.in[13] + D, WS_XQ1, 0)
            PICK_JOB(a.in[19], D, D, (const float*)nullptr, WS_XO0, 0)
            PICK_JOB(a.in[19] + (size_t)D * D, D, D, (const float*)nullptr, WS_XO1, 0)
            if (found) transpose_item(W_, K_, N_, g_, (bf16*)(ws + d_), m_, scr, r, lane);
        }
        for (int m = 2 * gw; m < M; m += 2 * NGW) {
            const f32x4* xr = (const f32x4*)(x + (size_t)m * D) + lane; v2u* o8 = (v2u*)((bf16*)(ws + WS_XB) + (size_t)m * D) + lane; float* sp = (float*)(ws + WS_SSQP);
            f32x4 v[8];
#pragma unroll
            for (int j = 0; j < 8; ++j) v[j] = xr[64 * j];
#pragma unroll
            for (int j = 0; j < 8; ++j) { v2u w; w.x = pk2(v[j][0], v[j][1]); w.y = pk2(v[j][2], v[j][3]); o8[64 * j] = w;
                const float s2 = wave_sum((v[j][0] * v[j][0] + v[j][1] * v[j][1]) + (v[j][2] * v[j][2] + v[j][3] * v[j][3])); if (lane == 0) sp[(size_t)(j & 3) * M + m + (j >> 2)] = s2; }
        }
        for (int r = gw; r < 2 * MM; r += NGW) { const int l = r / MM, m = r % MM;
            const f32x4* xr = (const f32x4*)(mem + (size_t)m * D) + lane; const f32x4* gr = (const f32x4*)(a.in[14] + (size_t)l * D) + lane;
            f32x4 v[4]; float s = 0.f;
#pragma unroll
            for (int j = 0; j < 4; ++j) { v[j] = xr[64 * j]; s += (v[j][0] * v[j][0] + v[j][1] * v[j][1]) + (v[j][2] * v[j][2] + v[j][3] * v[j][3]); }
            const float rs = 1.0f / sqrtf(wave_sum(s) * (1.0f / D) + EPS);
            v2u* o8 = (v2u*)((bf16*)(ws + (l ? WS_MEMH1 : WS_MEMH0)) + (size_t)m * D) + lane;
#pragma unroll
            for (int j = 0; j < 4; ++j) { const f32x4 g = gr[64 * j]; v2u w; w.x = pk2(v[j][0] * rs * g[0], v[j][1] * rs * g[1]); w.y = pk2(v[j][2] * rs * g[2], v[j][3] * rs * g[3]); o8[64 * j] = w; }
        }
        if (gw == 0) {
            const float* lg = a.in[6]; float* lb = (float*)(ws + WS_LB);
            for (int c = lane; c < 512; c += 64) { const float a0 = lg[c], a1 = lg[512 + c], a2 = lg[1024 + c]; const float mx = fmaxf(a0, fmaxf(a1, a2));
                const float e0 = expf(a0 - mx), e1 = expf(a1 - mx), e2 = expf(a2 - mx); lb[c] = e0 / (e0 + e1 + e2); }
        }
        if (gw == 2) {
            float* gx = (float*)(ws + WS_GXA); float* go = (float*)(ws + WS_GOD);
            for (int i = lane; i < 512; i += 64) gx[i] = a.in[18][i] * a.in[17][i];
            for (int i = lane; i < 128; i += 64) go[i] = a.in[10][i] * a.in[9][i];
        }
        if (gw == 1) {
            const float* rb = a.in[11]; float* bt = (float*)(ws + WS_BIAST);
            for (int i = lane; i < 3 * 8 * 132; i += 64) { const int br = i / (8 * 132), h = (i / 132) % 8, dl = i % 132; const int d = dl * (1 << (2 * br));
                int bucket; if (d < 16) bucket = d; else { const float lr = logf((float)d / 16.0f) / 4.852030263919617f; int lg2 = 16 + (int)(lr * 16.0f); bucket = lg2 < 31 ? lg2 : 31; }
                bt[i] = (dl <= 128) ? rb[bucket * 8 + h] : 0.f; }
        }
    }
}


typedef short bf16x8 __attribute__((ext_vector_type(8)));
typedef short s16x4 __attribute__((ext_vector_type(4)));
typedef float f32x16 __attribute__((ext_vector_type(16)));
typedef float f32x2_t __attribute__((ext_vector_type(2))); typedef __bf16 bf16x2_t __attribute__((ext_vector_type(2)));
typedef short v4i16_t __attribute__((ext_vector_type(4)));
#define MFMA32(a, b, c) __builtin_amdgcn_mfma_f32_32x32x16_bf16((a), (b), (c), 0, 0, 0)
__device__ __forceinline__ unsigned cvtpk(float lo, float hi) { f32x2_t v = {lo, hi}; bf16x2_t b = __builtin_convertvector(v, bf16x2_t); return __builtin_bit_cast(unsigned, b); }
__device__ __forceinline__ bf16x8 pack8(float a0, float a1, float a2, float a3, float a4, float a5, float a6, float a7) {
    v4u p; p.x = cvtpk(a0, a1); p.y = cvtpk(a2, a3); p.z = cvtpk(a4, a5); p.w = cvtpk(a6, a7); return __builtin_bit_cast(bf16x8, p); }
__device__ __forceinline__ s16x4 vtr(const LAS char* p) { return __builtin_bit_cast(s16x4, __builtin_amdgcn_ds_read_tr16_b64_v4i16((LAS v4i16_t*)p)); }
__device__ __forceinline__ int tr_lane_base(int lane, int stride) { const int g = lane >> 4, i = lane & 15, q = i >> 2, p = i & 3, h2 = g >> 1; return (4 * h2 + q) * stride + (16 * (g & 1) + 4 * p) * 2; }
__device__ __forceinline__ bf16x8 tr_frag_perm(const LAS char* img, int stride, int lbase, int k0, int n0) {
    const LAS char* p = img + lbase + k0 * stride + n0 * 2;
    const s16x4 lo = vtr(p), hi = vtr(p + 8 * stride);
    return (bf16x8){lo[0], lo[1], lo[2], lo[3], hi[0], hi[1], hi[2], hi[3]};
}
__device__ __forceinline__ int tr_lane_base_nat(int lane, int stride) { const int g = lane >> 4, i = lane & 15, q = i >> 2, p = i & 3, h2 = g >> 1; return (8 * h2 + q) * stride + (16 * (g & 1) + 4 * p) * 2; }
__device__ __forceinline__ bf16x8 tr_frag_nat(const LAS char* img, int stride, int lbase, int k0, int n0) {
    const LAS char* p = img + lbase + k0 * stride + n0 * 2;
    const s16x4 lo = vtr(p), hi = vtr(p + 4 * stride);
    return (bf16x8){lo[0], lo[1], lo[2], lo[3], hi[0], hi[1], hi[2], hi[3]};
}

#define LDS_BARRIER() do { asm volatile("s_waitcnt lgkmcnt(0)" ::: "memory"); __builtin_amdgcn_s_barrier(); asm volatile("" ::: "memory"); } while (0)
constexpr int XA_STRIDE = 528, XA_VSTRIDE = 528;
constexpr int XA_LDS = 256 * XA_STRIDE;
template <bool Q_IN_LDS> __device__ __forceinline__ void xattn_unit(LAS char* lds, const bf16* __restrict__ Q, const bf16* __restrict__ MKV, const float* __restrict__ gkq, bf16* __restrict__ O, int unit, int tid) {
    const int lane = tid & 63, w = __builtin_amdgcn_readfirstlane(tid >> 6), r = lane & 31, h2 = lane >> 5;
    const int rb = unit >> 2, h = unit & 3, row0 = rb * 256, b = row0 / SEQ;
    const bf16* Kg = MKV + (size_t)(b * NMEM) * 2048 + h * 256; const bf16* Vg = Kg + 1024;
    v4u st[16];
#pragma unroll
    for (int i = 0; i < 16; ++i) { const int id = tid + 512 * i; st[i] = *(const v4u*)(Kg + (size_t)(id >> 5) * 2048 + (id & 31) * 8); }
    const size_t qoff = (size_t)(row0 + 32 * w + r) * D + h * 256;
    bf16x8 qf[16];
    if (Q_IN_LDS) {
#pragma unroll
        for (int s = 0; s < 16; ++s) qf[s] = *(const LAS bf16x8*)(lds + (32 * w + r) * XA_STRIDE + h2 * 16 + s * 32);
        asm volatile("s_waitcnt lgkmcnt(0)" ::: "memory"); __builtin_amdgcn_s_barrier(); asm volatile("" ::: "memory");
    } else {
#pragma unroll
        for (int s = 0; s < 16; ++s) qf[s] = *(const bf16x8*)(Q + qoff + 8 * h2 + 16 * s);
    }
    { float gk8[8];
#pragma unroll
      for (int e = 0; e < 8; ++e) gk8[e] = gkq[(tid & 31) * 8 + e];
#pragma unroll
      for (int i = 0; i < 16; ++i) { const int id = tid + 512 * i; float f[8]; unpack8(st[i], f);
          float sq = (f[0] * f[0] + f[1] * f[1]) + (f[2] * f[2] + f[3] * f[3]) + (f[4] * f[4] + f[5] * f[5]) + (f[6] * f[6] + f[7] * f[7]);
          sq += __shfl_xor(sq, 1); sq += __shfl_xor(sq, 2); sq += __shfl_xor(sq, 4); sq += __shfl_xor(sq, 8); sq += __shfl_xor(sq, 16);
          const float rk = 1.0f / sqrtf(sq * (1.0f / 256.0f) + EPS) * 0.0625f;
          v4u o; o.x = cvtpk(f[0] * rk * gk8[0], f[1] * rk * gk8[1]); o.y = cvtpk(f[2] * rk * gk8[2], f[3] * rk * gk8[3]); o.z = cvtpk(f[4] * rk * gk8[4], f[5] * rk * gk8[5]); o.w = cvtpk(f[6] * rk * gk8[6], f[7] * rk * gk8[7]);
          *(LAS v4u*)(lds + (id >> 5) * XA_STRIDE + (id & 31) * 16) = o; } }
    float ss = 0.f;
#pragma unroll
    for (int s = 0; s < 16; ++s)
#pragma unroll
        for (int j = 0; j < 8; ++j) { const float x = __uint_as_float((unsigned)(unsigned short)qf[s][j] << 16); ss += x * x; }
    ss += __shfl_xor(ss, 32);
    const float rsl = 1.0f / sqrtf(ss * (1.0f / 256.0f) + EPS) * 1.4426950408889634f;
    asm volatile("" ::: "memory");
#pragma unroll
    for (int i = 0; i < 8; ++i) { const int id = tid + 512 * i; st[i] = *(const v4u*)(Vg + (size_t)(id >> 5) * 2048 + (id & 31) * 8); }
    LDS_BARRIER();
    bf16x8 pf[8][2]; float den = 0.f;
#pragma unroll
    for (int kb = 0; kb < 8; ++kb) {
        f32x16 acc;
#pragma unroll
        for (int i = 0; i < 16; ++i) acc[i] = 0.f;
        const LAS char* kp = lds + (32 * kb + r) * XA_STRIDE + h2 * 16;
#pragma unroll
        for (int s = 0; s < 16; ++s) { const bf16x8 a = *(const LAS bf16x8*)(kp + s * 32); acc = MFMA32(a, qf[s], acc); }
        float p[16];
#pragma unroll
        for (int i = 0; i < 16; ++i) { p[i] = __builtin_amdgcn_exp2f(acc[i] * rsl - 11.541560327111707f); den += p[i]; }
        pf[kb][0] = pack8(p[0], p[1], p[2], p[3], p[4], p[5], p[6], p[7]); pf[kb][1] = pack8(p[8], p[9], p[10], p[11], p[12], p[13], p[14], p[15]);
    }
    den += __shfl_xor(den, 32);
    const float inv = 1.0f / den;
    LDS_BARRIER();
#pragma unroll
    for (int i = 8; i < 16; ++i) { const int id = tid + 512 * i; st[i] = *(const v4u*)(Vg + (size_t)(id >> 5) * 2048 + (id & 31) * 8); }
#pragma unroll
    for (int i = 0; i < 16; ++i) { const int id = tid + 512 * i; *(LAS v4u*)(lds + (id >> 5) * XA_VSTRIDE + (id & 31) * 16) = st[i]; }
    LDS_BARRIER();
    const int lbase = tr_lane_base(lane, XA_VSTRIDE);
#pragma unroll
    for (int half = 0; half < 2; ++half) {
        f32x16 o[4];
#pragma unroll
        for (int vb = 0; vb < 4; ++vb)
#pragma unroll
            for (int i = 0; i < 16; ++i) o[vb][i] = 0.f;
#pragma unroll
        for (int kb = 0; kb < 8; ++kb)
#pragma unroll
            for (int s = 0; s < 2; ++s)
#pragma unroll
                for (int vb = 0; vb < 4; ++vb) { const bf16x8 a = tr_frag_perm(lds, XA_VSTRIDE, lbase, 32 * kb + 16 * s, 128 * half + 32 * vb); o[vb] = MFMA32(a, pf[kb][s], o[vb]); }
        LAS char* tile = lds + 256 * XA_VSTRIDE + w * 2560;
#pragma unroll
        for (int vb = 0; vb < 4; ++vb) {
#pragma unroll
            for (int g4 = 0; g4 < 4; ++g4) { v2u wv; wv.x = cvtpk(o[vb][4 * g4] * inv, o[vb][4 * g4 + 1] * inv); wv.y = cvtpk(o[vb][4 * g4 + 2] * inv, o[vb][4 * g4 + 3] * inv);
                *(LAS v2u*)(tile + r * 80 + (8 * g4 + 4 * h2) * 2) = wv; }
            asm volatile("s_waitcnt lgkmcnt(0)" ::: "memory");
#pragma unroll
            for (int i = 0; i < 2; ++i) { const int id = lane + 64 * i; *(v4u*)(O + (size_t)(row0 + 32 * w + (id >> 2)) * D + h * 256 + 128 * half + 32 * vb + 8 * (id & 3)) = *(const LAS v4u*)(tile + (id >> 2) * 80 + (id & 3) * 16); }
            asm volatile("s_waitcnt lgkmcnt(0)" ::: "memory");
        }
    }
    __syncthreads();
}


struct EpiXattn {
    static constexpr int PERM = 1; static constexpr bool AFTER_DRAIN = true;
    struct Pre { int unused; };
    const bf16* MKV; const float* gkq; bf16* O;
    __device__ __forceinline__ void init(f32x4 (&)[2][2][4][2], const pg8::Unit&, int, int, int, int) const {}
    __device__ __forceinline__ void fused(f32x4 (&acc)[2][2][4][2], const pg8::Unit& u, int wr, int wc, int fr, int fq, LAS unsigned char* lds, int wid, int lane) const {
#pragma unroll
        for (int ai = 0; ai < 2; ++ai)
#pragma unroll
            for (int m = 0; m < 4; ++m) { const int row = ai * 128 + wr * 64 + m * 16 + fr;
#pragma unroll
                for (int bj = 0; bj < 2; ++bj) { const f32x4 v0 = acc[ai][bj][m][0], v1 = acc[ai][bj][m][1];
                    v4u o; o.x = cvtpk(v0[0], v0[1]); o.y = cvtpk(v0[2], v0[3]); o.z = cvtpk(v1[0], v1[1]); o.w = cvtpk(v1[2], v1[3]);
                    *(LAS v4u*)(lds + row * XA_STRIDE + (bj * 128 + wc * 32 + 8 * fq) * 2) = o; } }
        asm volatile("s_waitcnt lgkmcnt(0)" ::: "memory"); __builtin_amdgcn_s_barrier(); asm volatile("" ::: "memory");
    }
};

constexpr int DA_STRIDE = 272, DA_VSTRIDE = 320, DA_LDS_BIAS = 384 * DA_VSTRIDE, DA_LDS_OSTG = DA_LDS_BIAS + 768, DA_OSTG_WAVE = 32 * 144 + 128;
static_assert(DA_LDS_OSTG + 8 * DA_OSTG_WAVE <= 163840 - 512, "dilated attention LDS map");
constexpr int DA_UNUSED0 = 0;
struct DaArgs { const bf16* QKV; const float* biasT; const float* gkq; bf16* N0; float* DEN0; const bf16* N1; const float* DEN1; const bf16* N2; const float* DEN2; bf16* O; int br0; int nbr; int mode; int pad; };
struct DaUnit { int br, b, h, dil, cls, l0; };
template <int MODE> __device__ __forceinline__ DaUnit da_decode(int uu) {
    DaUnit U; U.br = MODE == 0 ? __builtin_amdgcn_readfirstlane(1 + (uu >> 9)) : 0; const int rem = __builtin_amdgcn_readfirstlane(uu & 511), x = rem & 15; U.b = rem >> 7; U.h = (rem >> 4) & 7; U.dil = 1 << (2 * U.br);
    U.cls = U.br == 0 ? 0 : (U.br == 1 ? (x & 3) : x); U.l0 = 256 * (U.br == 0 ? x : (U.br == 1 ? (x >> 2) : 0)); return U; }
__device__ __forceinline__ void da_load_rows(v4u (&st)[12], const bf16* QKV, const DaUnit& U, int col, int tid) {
    const bf16* base = QKV + (size_t)(U.b * SEQ) * OD_IN + U.h * 128 + col + (tid & 15) * 8;
#pragma unroll
    for (int i = 0; i < 12; ++i) { const int ki = (tid >> 4) + 32 * i, lk = U.l0 - 128 + ki, lkc = lk < 0 ? 0 : lk; st[i] = *(const v4u*)(base + (size_t)(lkc * U.dil + U.cls) * OD_IN); }
}
template <int MODE> __device__ __forceinline__ void dattn_phase(LAS char* lds, const DaArgs& a, int bx, int G, int tid) {
    constexpr int NUNITS = MODE == 0 ? 1024 : 512;
    const int lane = tid & 63, w = __builtin_amdgcn_readfirstlane(tid >> 6), r = lane & 31, h2 = lane >> 5;
    int uu = (G == 256) ? (((bx & 7) << 5) | (bx >> 3)) : bx; if (uu >= NUNITS) return;
    v4u st[12];
    { const DaUnit U0 = da_decode<MODE>(uu); da_load_rows(st, a.QKV, U0, 1024, tid); }
    LAS float* lbias = (LAS float*)(lds + DA_LDS_BIAS);
    const int lbase = tr_lane_base(lane, DA_VSTRIDE);
    for (;;) {
        const DaUnit U = da_decode<MODE>(uu);
        const int l0 = U.l0, h = U.h; const bool zfirst = (l0 == 0);
        int r_l = r; asm volatile("" : "+v"(r_l));
        float gk8[8];
#pragma unroll
        for (int e = 0; e < 8; ++e) gk8[e] = a.gkq[(tid & 15) * 8 + e];
        const size_t qrow = (size_t)(U.b * SEQ + (l0 + 32 * w + r) * U.dil + U.cls);
#pragma unroll
        for (int i = 0; i < 12; ++i) { float f_[8]; unpack8((i < 4 && zfirst) ? (v4u){0u, 0u, 0u, 0u} : st[i], f_);
            float sq_ = (f_[0] * f_[0] + f_[1] * f_[1]) + (f_[2] * f_[2] + f_[3] * f_[3]) + (f_[4] * f_[4] + f_[5] * f_[5]) + (f_[6] * f_[6] + f_[7] * f_[7]);
            sq_ += __shfl_xor(sq_, 1); sq_ += __shfl_xor(sq_, 2); sq_ += __shfl_xor(sq_, 4); sq_ += __shfl_xor(sq_, 8);
            const float rk_ = 1.0f / sqrtf(sq_ * (1.0f / 128.0f) + EPS) * 0.08838834764831845f;
            v4u o_; o_.x = cvtpk(f_[0] * rk_ * gk8[0], f_[1] * rk_ * gk8[1]); o_.y = cvtpk(f_[2] * rk_ * gk8[2], f_[3] * rk_ * gk8[3]); o_.z = cvtpk(f_[4] * rk_ * gk8[4], f_[5] * rk_ * gk8[5]); o_.w = cvtpk(f_[6] * rk_ * gk8[6], f_[7] * rk_ * gk8[7]);
            *(LAS v4u*)(lds + ((tid >> 4) + 32 * i) * DA_STRIDE + (tid & 15) * 16) = o_; }
        if (tid < 192) { const int dl = tid - 32; lbias[tid] = (dl >= 0 && dl <= 128) ? a.biasT[(U.br * 8 + h) * 132 + dl] * 1.4426950408889634f - 11.541560327111707f : -__builtin_inff(); }
        asm volatile("" ::: "memory");
        bf16x8 qf[8];
#pragma unroll
        for (int s = 0; s < 8; ++s) qf[s] = *(const bf16x8*)(a.QKV + qrow * OD_IN + h * 128 + 8 * h2 + 16 * s);
        da_load_rows(st, a.QKV, U, 2048, tid);
        float ss = 0.f;
#pragma unroll
        for (int s = 0; s < 8; ++s)
#pragma unroll
            for (int j = 0; j < 8; ++j) { const float xq = __uint_as_float((unsigned)(unsigned short)qf[s][j] << 16); ss += xq * xq; }
        ss += __shfl_xor(ss, 32);
        const float rsl = 1.0f / sqrtf(ss * (1.0f / 128.0f) + EPS) * 1.4426950408889634f;
        LDS_BARRIER();
        bf16x8 pf[5][2]; float den = 0.f;
#pragma unroll
        for (int kbi = 0; kbi < 5; ++kbi) {
            if (zfirst && w + kbi < 4) { pf[kbi][0] = (bf16x8){0, 0, 0, 0, 0, 0, 0, 0}; pf[kbi][1] = pf[kbi][0]; continue; }
            f32x16 acc;
#pragma unroll
            for (int i = 0; i < 16; ++i) acc[i] = 0.f;
            const LAS char* kp = lds + (32 * (w + kbi) + r) * DA_STRIDE + h2 * 16;
#pragma unroll
            for (int s = 0; s < 8; ++s) { const bf16x8 av = *(const LAS bf16x8*)(kp + s * 32); acc = MFMA32(av, qf[s], acc); }
            __builtin_amdgcn_sched_barrier(0);
            const LAS float* tb = lbias + (r_l - 4 * h2);
#pragma unroll
            for (int hh = 0; hh < 2; ++hh) { float p[8];
#pragma unroll
                for (int i8 = 0; i8 < 8; ++i8) { const int i = 8 * hh + i8;
                    p[i8] = __builtin_amdgcn_exp2f(acc[i] * rsl + tb[160 - 32 * kbi - ((i & 3) + 8 * (i >> 2))]); den += p[i8]; }
                pf[kbi][hh] = pack8(p[0], p[1], p[2], p[3], p[4], p[5], p[6], p[7]);
                __builtin_amdgcn_sched_barrier(0); }
            asm volatile("" ::: "memory");
        }
        den += __shfl_xor(den, 32);
        LDS_BARRIER();
#pragma unroll
        for (int i = 0; i < 12; ++i) *(LAS v4u*)(lds + ((tid >> 4) + 32 * i) * DA_VSTRIDE + (tid & 15) * 16) = (i < 4 && zfirst) ? (v4u){0u, 0u, 0u, 0u} : st[i];
        LDS_BARRIER();
        const int un = uu + G; const bool more = un < NUNITS; const DaUnit Un = da_decode<MODE>(more ? un : uu);
        if (more) da_load_rows(st, a.QKV, Un, 1024, tid);
        LAS char* stg = lds + DA_LDS_OSTG + w * DA_OSTG_WAVE;
        float inv = 1.0f;
        if (MODE == 0) { if (h2 == 0) ((float*)(U.br == 1 ? a.DEN1 : a.DEN2))[qrow * 8 + h] = den; }
        else { inv = 1.0f / (den + a.DEN1[qrow * 8 + h] + a.DEN2[qrow * 8 + h]); if (h2 == 0) ((LAS float*)(stg + 32 * 144))[r] = inv; }
        size_t goff[4];
#pragma unroll
        for (int i = 0; i < 4; ++i) { const int id = lane + 64 * i, row = id >> 3, ch = id & 7; goff[i] = (size_t)(U.b * SEQ + (l0 + 32 * w + row) * U.dil + U.cls) * D + h * 128 + ch * 8; }
#pragma unroll
        for (int half = 0; half < 2; ++half) {
            f32x16 o[2];
            v4u n1v[4], n2v[4];
            if (MODE == 1) {
#pragma unroll
                for (int i = 0; i < 4; ++i) { n1v[i] = *(const v4u*)(a.N1 + goff[i] + 64 * half); n2v[i] = *(const v4u*)(a.N2 + goff[i] + 64 * half); } }
#pragma unroll
            for (int vb = 0; vb < 2; ++vb)
#pragma unroll
                for (int i = 0; i < 16; ++i) o[vb][i] = 0.f;
#pragma unroll
            for (int kbi = 0; kbi < 5; ++kbi)
#pragma unroll
                for (int s = 0; s < 2; ++s)
#pragma unroll
                    for (int vb = 0; vb < 2; ++vb) { const bf16x8 av = tr_frag_perm(lds, DA_VSTRIDE, lbase, 32 * (w + kbi) + 16 * s, 64 * half + 32 * vb); o[vb] = MFMA32(av, pf[kbi][s], o[vb]); }
#pragma unroll
            for (int vb = 0; vb < 2; ++vb)
#pragma unroll
                for (int g4 = 0; g4 < 4; ++g4) { v2u wv; wv.x = cvtpk(o[vb][4 * g4], o[vb][4 * g4 + 1]); wv.y = cvtpk(o[vb][4 * g4 + 2], o[vb][4 * g4 + 3]); *(LAS v2u*)(stg + r * 144 + (32 * vb + 8 * g4 + 4 * h2) * 2) = wv; }
            asm volatile("s_waitcnt lgkmcnt(0)" ::: "memory");
            if (MODE == 0) {
                bf16* N = (bf16*)(U.br == 1 ? a.N1 : a.N2) + 64 * half;
#pragma unroll
                for (int i = 0; i < 4; ++i) { const int id = lane + 64 * i; *(v4u*)(N + goff[i]) = *(const LAS v4u*)(stg + (id >> 3) * 144 + (id & 7) * 16); }
            } else {
#pragma unroll
                for (int i = 0; i < 4; ++i) { const int id = lane + 64 * i; float fo[8], f1[8], f2[8]; unpack8(*(const LAS v4u*)(stg + (id >> 3) * 144 + (id & 7) * 16), fo); unpack8(n1v[i], f1); unpack8(n2v[i], f2);
                    const float iv = ((const LAS float*)(stg + 32 * 144))[id >> 3];
                    v4u ov; ov.x = cvtpk((fo[0] + f1[0] + f2[0]) * iv, (fo[1] + f1[1] + f2[1]) * iv); ov.y = cvtpk((fo[2] + f1[2] + f2[2]) * iv, (fo[3] + f1[3] + f2[3]) * iv);
                    ov.z = cvtpk((fo[4] + f1[4] + f2[4]) * iv, (fo[5] + f1[5] + f2[5]) * iv); ov.w = cvtpk((fo[6] + f1[6] + f2[6]) * iv, (fo[7] + f1[7] + f2[7]) * iv);
                    *(v4u*)(a.O + goff[i] + 64 * half) = ov; }
            }
            asm volatile("s_waitcnt lgkmcnt(0)" ::: "memory");
        }
        LDS_BARRIER();
        if (!more) break;
        uu = un;
    }
}

constexpr int MX_STRIDE = 272, MX_TSTRIDE = 320, MX_IMG = 128 * MX_TSTRIDE;
constexpr int MX_Q = 0, MX_K = MX_IMG, MX_V = 2 * MX_IMG, MX_SCR = 3 * MX_IMG, MX_OSTG = MX_SCR + 5120;
constexpr int MX_UNUSED0 = 0;
struct MixArgs { bf16* Z; const float* lb; const float* ret_g; const float* hg_g; bf16* SBUF; float* DECA; float* DECB; };

__device__ __forceinline__ void st_chunk8(LAS char* img, int stride, int row, int c0, const float (&f)[8]) {
    v4u o; o.x = cvtpk(f[0], f[1]); o.y = cvtpk(f[2], f[3]); o.z = cvtpk(f[4], f[5]); o.w = cvtpk(f[6], f[7]); *(LAS v4u*)(img + row * stride + c0 * 2) = o; }

__device__ __forceinline__ void ret_prep_tile(LAS char* img, int stride, const bf16* zrow  , int j, int cg, const float (&sn)[16], const float (&cs)[16], float sc) {
#pragma unroll
    for (int hc = 0; hc < 2; ++hc) { float x1[8], x2[8], o1[8], o2[8];
        unpack8(*(const v4u*)(zrow + 16 * cg + 8 * hc), x1); unpack8(*(const v4u*)(zrow + 64 + 16 * cg + 8 * hc), x2);
#pragma unroll
        for (int e = 0; e < 8; ++e) { o1[e] = (x1[e] * cs[8 * hc + e] - x2[e] * sn[8 * hc + e]) * sc; o2[e] = (x1[e] * sn[8 * hc + e] + x2[e] * cs[8 * hc + e]) * sc; }
        st_chunk8(img, stride, j, 16 * cg + 8 * hc, o1); st_chunk8(img, stride, j, 64 + 16 * cg + 8 * hc, o2); }
}
__device__ __forceinline__ void copy_tile(LAS char* img, int stride, const bf16* src, int tid) {
#pragma unroll
    for (int i = 0; i < 4; ++i) { const int id = tid + 512 * i, row = id >> 4, ch = id & 15; *(LAS v4u*)(img + row * stride + ch * 16) = *(const v4u*)(src + (size_t)row * EV_IN + ch * 8); }
}
__device__ __forceinline__ void hg_gates(const bf16* zrow_f  , const float* lbh  , int tid, LAS float* scr, float (&cum)[32], float (&kk)[32]) {
    const int lane = tid & 63, hw = (tid >> 6) & 1, cg = tid >> 7;
#pragma unroll
    for (int q = 0; q < 4; ++q) { float fl[8]; unpack8(*(const v4u*)(zrow_f + 32 * cg + 8 * q), fl);
#pragma unroll
        for (int e = 0; e < 8; ++e) { const float l = lbh[32 * cg + 8 * q + e]; const float f = l + (1.0f - l) * (1.0f / (1.0f + __expf(-fl[e]))); kk[8 * q + e] = 1.0f - f; cum[8 * q + e] = __logf(fmaxf(f, 1e-6f)); } }
#pragma unroll
    for (int off = 1; off < 64; off <<= 1) {
#pragma unroll
        for (int c = 0; c < 32; ++c) { const float t = __shfl_up(cum[c], off); if (lane >= off) cum[c] += t; } }
    if (hw == 0 && lane == 63) {
#pragma unroll
        for (int c = 0; c < 32; ++c) scr[32 * cg + c] = cum[c]; }
    __syncthreads();
    if (hw == 1) {
#pragma unroll
        for (int c = 0; c < 32; ++c) cum[c] += scr[32 * cg + c]; }
    if (hw == 1 && lane == 63) {
#pragma unroll
        for (int c = 0; c < 32; ++c) scr[128 + 32 * cg + c] = cum[c]; }
    __syncthreads();
}

__device__ __forceinline__ void load_prep4(v4u (&rw)[4], const bf16* zrow_seg, int mixer, int cg) {
#pragma unroll
    for (int q = 0; q < 4; ++q) { const int col = mixer == 0 ? ((q >> 1) * 64 + 16 * cg + 8 * (q & 1)) : (32 * cg + 8 * q); rw[q] = *(const v4u*)(zrow_seg + col); }
}
__device__ __forceinline__ void load_copy4(v4u (&rw)[4], const bf16* tile, int tid) {
#pragma unroll
    for (int i = 0; i < 4; ++i) { const int id = tid + 512 * i; rw[i] = *(const v4u*)(tile + (size_t)(id >> 4) * EV_IN + (id & 15) * 8); }
}
__device__ __forceinline__ void store_copy4(LAS char* img, int stride, const v4u (&rw)[4], int tid) {
#pragma unroll
    for (int i = 0; i < 4; ++i) { const int id = tid + 512 * i; *(LAS v4u*)(img + (id >> 4) * stride + (id & 15) * 16) = rw[i]; }
}
__device__ __forceinline__ void ret_prep_raw(LAS char* img, int stride, const v4u (&rw)[4], int j, int cg, const float (&sn)[16], const float (&cs)[16], float sc) {
#pragma unroll
    for (int hc = 0; hc < 2; ++hc) { float x1[8], x2[8], o1[8], o2[8]; unpack8(rw[hc], x1); unpack8(rw[2 + hc], x2);
#pragma unroll
        for (int e = 0; e < 8; ++e) { o1[e] = (x1[e] * cs[8 * hc + e] - x2[e] * sn[8 * hc + e]) * sc; o2[e] = (x1[e] * sn[8 * hc + e] + x2[e] * cs[8 * hc + e]) * sc; }
        st_chunk8(img, stride, j, 16 * cg + 8 * hc, o1); st_chunk8(img, stride, j, 64 + 16 * cg + 8 * hc, o2); }
}
__device__ __forceinline__ void hg_gates_raw(const v4u (&rw)[4], const float* lbh, int tid, LAS float* scr, float (&cum)[32], float (&kk)[32]) {
    const int lane = tid & 63, hw = (tid >> 6) & 1, cg = tid >> 7;
#pragma unroll
    for (int q = 0; q < 4; ++q) { float fl[8]; unpack8(rw[q], fl);
#pragma unroll
        for (int e = 0; e < 8; ++e) { const float l = lbh[32 * cg + 8 * q + e]; const float f = l + (1.0f - l) * (1.0f / (1.0f + __expf(-fl[e]))); kk[8 * q + e] = 1.0f - f; cum[8 * q + e] = __logf(fmaxf(f, 1e-6f)); } }
#pragma unroll
    for (int off = 1; off < 64; off <<= 1) {
#pragma unroll
        for (int c = 0; c < 32; ++c) { const float t = __shfl_up(cum[c], off); if (lane >= off) cum[c] += t; } }
    if (hw == 0 && lane == 63) {
#pragma unroll
        for (int c = 0; c < 32; ++c) scr[32 * cg + c] = cum[c]; }
    LDS_BARRIER();
    if (hw == 1) {
#pragma unroll
        for (int c = 0; c < 32; ++c) cum[c] += scr[32 * cg + c]; }
    if (hw == 1 && lane == 63) {
#pragma unroll
        for (int c = 0; c < 32; ++c) scr[128 + 32 * cg + c] = cum[c]; }
    LDS_BARRIER();
}
struct MixU { int mixer, b, h, n; };
__device__ __forceinline__ MixU mix_decode(int u) { MixU U; const int g = __builtin_amdgcn_readfirstlane(u >> 5); U.n = __builtin_amdgcn_readfirstlane(u & 31); U.mixer = g >> 4; U.b = (g >> 2) & 3; U.h = g & 3; return U; }

__device__ __forceinline__ void mixA_phase(LAS char* lds, const MixArgs& a, int bx, int G, int tid) {
    const int lane = tid & 63, w = __builtin_amdgcn_readfirstlane(tid >> 6), r = lane & 31, h2 = lane >> 5;
    const int j = tid & 127, cg = tid >> 7;
    LAS float* scr = (LAS float*)(lds + MX_SCR);
    int u = bx; if (u >= 1024) return;
    v4u rk[4], rv[4];
    { const MixU U = mix_decode(u); const bf16* zt = a.Z + (size_t)(U.b * SEQ + 128 * U.n) * EV_IN;
      load_prep4(rk, zt + (size_t)j * EV_IN + (U.mixer == 0 ? Z_RK : Z_GF) + U.h * 128, U.mixer, cg); load_copy4(rv, zt + (U.mixer == 0 ? Z_RV : Z_GI) + U.h * 128, tid); }
    for (;;) {
        const MixU U = mix_decode(u); const int h = U.h, n = U.n;
        if (U.mixer == 0) {
            const float gamma = 1.0f - exp2f(-5.0f - (float)h), lg2 = log2f(gamma);
            float sn[16], cs[16];
#pragma unroll
            for (int e = 0; e < 16; ++e) { const float inv = exp2f(-(float)(16 * cg + e) * (13.287712379549449f / 64.0f)); rope_sincos((float)(128 * n + j) * inv, sn[e], cs[e]); }
            ret_prep_raw(lds + MX_K, MX_TSTRIDE, rk, j, cg, sn, cs, 0.08838834764831845f * exp2f((float)(127 - j) * lg2));
            if (tid < 128) { a.DECA[(size_t)u * 128 + tid] = exp2f(128.0f * lg2); a.DECB[(size_t)u * 128 + tid] = gamma; }
        } else {
            float cum[32], kk[32];
            hg_gates_raw(rk, a.lb + h * 128, tid, scr, cum, kk);
#pragma unroll
            for (int q = 0; q < 4; ++q) { float o[8];
#pragma unroll
                for (int e = 0; e < 8; ++e) o[e] = kk[8 * q + e] * __expf(scr[128 + 32 * cg + 8 * q + e] - cum[8 * q + e]);
                st_chunk8(lds + MX_K, MX_TSTRIDE, j, 32 * cg + 8 * q, o); }
            if (tid < 128) { a.DECA[(size_t)u * 128 + tid] = __expf(scr[128 + tid]); a.DECB[(size_t)u * 128 + tid] = __expf(scr[tid]); }
        }
        store_copy4(lds + MX_V, MX_TSTRIDE, rv, tid);
        LDS_BARRIER();
        const int un = u + G; const bool more = un < 1024;
        if (more) { const MixU Un = mix_decode(un); const bf16* zt = a.Z + (size_t)(Un.b * SEQ + 128 * Un.n) * EV_IN;
            load_prep4(rk, zt + (size_t)j * EV_IN + (Un.mixer == 0 ? Z_RK : Z_GF) + Un.h * 128, Un.mixer, cg); load_copy4(rv, zt + (Un.mixer == 0 ? Z_RV : Z_GI) + Un.h * 128, tid); }
        const int lbn = tr_lane_base_nat(lane, MX_TSTRIDE); const int kbk = w >> 1, vb0 = 2 * (w & 1);
        f32x16 acc[2];
#pragma unroll
        for (int t = 0; t < 2; ++t)
#pragma unroll
            for (int i = 0; i < 16; ++i) acc[t][i] = 0.f;
#pragma unroll
        for (int s_ = 0; s_ < 8; ++s_) { const bf16x8 av = tr_frag_nat(lds + MX_K, MX_TSTRIDE, lbn, 16 * s_, 32 * kbk);
#pragma unroll
            for (int t = 0; t < 2; ++t) { const bf16x8 bv = tr_frag_nat(lds + MX_V, MX_TSTRIDE, lbn, 16 * s_, 32 * (vb0 + t)); acc[t] = MFMA32(av, bv, acc[t]); } }
        bf16* sb = a.SBUF + (size_t)u * 16384;
#pragma unroll
        for (int t = 0; t < 2; ++t)
#pragma unroll
            for (int g4 = 0; g4 < 4; ++g4) { v2u wv; wv.x = cvtpk(acc[t][4 * g4], acc[t][4 * g4 + 1]); wv.y = cvtpk(acc[t][4 * g4 + 2], acc[t][4 * g4 + 3]);
                *(v2u*)(sb + ((((((vb0 + t) * 8 + 2 * kbk + (g4 >> 1)) * 2 + (g4 & 1)) * 32 + r) * 8) + 4 * h2)) = wv; }
        LDS_BARRIER();
        if (!more) break;
        u = un;
    }
}

__device__ __forceinline__ void mixA_unit(LAS char* lds, const MixArgs& a, int u, int tid) {
    const int lane = tid & 63, w = __builtin_amdgcn_readfirstlane(tid >> 6), r = lane & 31, h2 = lane >> 5;
    const int g = u >> 5, n = u & 31, mixer = g >> 4, b = (g >> 2) & 3, h = g & 3;
    const int j = tid & 127, cg = tid >> 7;
    const bf16* zt = a.Z + (size_t)(b * SEQ + 128 * n) * EV_IN;
    LAS float* scr = (LAS float*)(lds + MX_SCR);
    if (mixer == 0) {
        const float gamma = 1.0f - exp2f(-5.0f - (float)h), lg2 = log2f(gamma);
        float sn[16], cs[16];
#pragma unroll
        for (int e = 0; e < 16; ++e) { const float inv = exp2f(-(float)(16 * cg + e) * (13.287712379549449f / 64.0f)); rope_sincos((float)(128 * n + j) * inv, sn[e], cs[e]); }
        ret_prep_tile(lds + MX_K, MX_TSTRIDE, zt + (size_t)j * EV_IN + Z_RK + h * 128, j, cg, sn, cs, 0.08838834764831845f * exp2f((float)(127 - j) * lg2));
        copy_tile(lds + MX_V, MX_TSTRIDE, zt + Z_RV + h * 128, tid);
        if (tid < 128) { a.DECA[(size_t)u * 128 + tid] = exp2f(128.0f * lg2); a.DECB[(size_t)u * 128 + tid] = gamma; }
    } else {
        float cum[32], kk[32];
        hg_gates(zt + (size_t)j * EV_IN + Z_GF + h * 128, a.lb + h * 128, tid, scr, cum, kk);
#pragma unroll
        for (int q = 0; q < 4; ++q) { float o[8];
#pragma unroll
            for (int e = 0; e < 8; ++e) o[e] = kk[8 * q + e] * __expf(scr[128 + 32 * cg + 8 * q + e] - cum[8 * q + e]);
            st_chunk8(lds + MX_K, MX_TSTRIDE, j, 32 * cg + 8 * q, o); }
        copy_tile(lds + MX_V, MX_TSTRIDE, zt + Z_GI + h * 128, tid);
        if (tid < 128) { a.DECA[(size_t)u * 128 + tid] = __expf(scr[128 + tid]); a.DECB[(size_t)u * 128 + tid] = __expf(scr[tid]); }
    }
    __syncthreads();
    const int lbn = tr_lane_base_nat(lane, MX_TSTRIDE); const int kbk = w >> 1, vb0 = 2 * (w & 1);
    f32x16 acc[2];
#pragma unroll
    for (int t = 0; t < 2; ++t)
#pragma unroll
        for (int i = 0; i < 16; ++i) acc[t][i] = 0.f;
#pragma unroll
    for (int s = 0; s < 8; ++s) { const bf16x8 av = tr_frag_nat(lds + MX_K, MX_TSTRIDE, lbn, 16 * s, 32 * kbk);
#pragma unroll
        for (int t = 0; t < 2; ++t) { const bf16x8 bv = tr_frag_nat(lds + MX_V, MX_TSTRIDE, lbn, 16 * s, 32 * (vb0 + t)); acc[t] = MFMA32(av, bv, acc[t]); } }
    bf16* sb = a.SBUF + (size_t)u * 16384;
#pragma unroll
    for (int t = 0; t < 2; ++t)
#pragma unroll
        for (int g4 = 0; g4 < 4; ++g4) { v2u wv; wv.x = cvtpk(acc[t][4 * g4], acc[t][4 * g4 + 1]); wv.y = cvtpk(acc[t][4 * g4 + 2], acc[t][4 * g4 + 3]);
            *(v2u*)(sb + ((((((vb0 + t) * 8 + 2 * kbk + (g4 >> 1)) * 2 + (g4 & 1)) * 32 + r) * 8) + 4 * h2)) = wv; }
    __syncthreads();
}

__device__ __forceinline__ void mix_scan(const MixArgs& a, int gtid, int nthreads, bool dry = false) {
    for (int e = gtid; e < 32 * 4096; e += nthreads) { const int g = e >> 12, el = e & 4095, dk4 = 4 * ((el >> 7) & 7) + 2 * ((el >> 6) & 1) + (el & 1);
        bf16* sp = a.SBUF + (size_t)(g * 32) * 16384 + (size_t)el * 4; const float* da = a.DECA + (size_t)(g * 32) * 128 + 4 * dk4; const float* db = a.DECB + (size_t)(g * 32) * 128 + 4 * dk4;
        f32x4 S = (f32x4){0.f, 0.f, 0.f, 0.f};
#pragma unroll 8
        for (int n = 0; n < 32; ++n) { const v2u kv = *(const v2u*)(sp + (size_t)n * 16384); const f32x4 A = *(const f32x4*)(da + n * 128), Bv = *(const f32x4*)(db + n * 128);
            const f32x4 so = S * Bv; v2u wv; wv.x = cvtpk(so[0], so[1]); wv.y = cvtpk(so[2], so[3]); if (!dry) *(v2u*)(sp + (size_t)n * 16384) = wv;
            S[0] = A[0] * S[0] + __uint_as_float(kv.x << 16); S[1] = A[1] * S[1] + __uint_as_float(kv.x & 0xffff0000u); S[2] = A[2] * S[2] + __uint_as_float(kv.y << 16); S[3] = A[3] * S[3] + __uint_as_float(kv.y & 0xffff0000u); }
    }
}

__device__ __forceinline__ void mixC_unit(LAS char* lds, const MixArgs& a, int u, int tid, bool dry = false) {
    const int lane = tid & 63, w = __builtin_amdgcn_readfirstlane(tid >> 6), r = lane & 31, h2 = lane >> 5;
    const int g = u >> 5, n = u & 31, mixer = g >> 4, b = (g >> 2) & 3, h = g & 3;
    const int j = tid & 127, cg = tid >> 7;
    bf16* zt = a.Z + (size_t)(b * SEQ + 128 * n) * EV_IN;
    LAS float* scr = (LAS float*)(lds + MX_SCR);
    if (mixer == 0) {
        const float gamma = 1.0f - exp2f(-5.0f - (float)h), lg2 = log2f(gamma);
        float sn[16], cs[16];
#pragma unroll
        for (int e = 0; e < 16; ++e) { const float inv = exp2f(-(float)(16 * cg + e) * (13.287712379549449f / 64.0f)); rope_sincos((float)(128 * n + j) * inv, sn[e], cs[e]); }
        ret_prep_tile(lds + MX_Q, MX_STRIDE, zt + (size_t)j * EV_IN + Z_RQ + h * 128, j, cg, sn, cs, exp2f((float)j * lg2));
        ret_prep_tile(lds + MX_K, MX_STRIDE, zt + (size_t)j * EV_IN + Z_RK + h * 128, j, cg, sn, cs, 0.08838834764831845f * exp2f(-(float)j * lg2));
        copy_tile(lds + MX_V, MX_TSTRIDE, zt + Z_RV + h * 128, tid);
    } else {
        float cum[32], kk[32];
        hg_gates(zt + (size_t)j * EV_IN + Z_GF + h * 128, a.lb + h * 128, tid, scr, cum, kk);
#pragma unroll
        for (int q = 0; q < 4; ++q) { float qv[8], oq[8], ok[8]; unpack8(*(const v4u*)(zt + (size_t)j * EV_IN + Z_GQ + h * 128 + 32 * cg + 8 * q), qv);
#pragma unroll
            for (int e = 0; e < 8; ++e) { const float d = cum[8 * q + e] - scr[32 * cg + 8 * q + e]; oq[e] = qv[e] * __expf(d); ok[e] = kk[8 * q + e] * __expf(-d); }
            st_chunk8(lds + MX_Q, MX_STRIDE, j, 32 * cg + 8 * q, oq); st_chunk8(lds + MX_K, MX_STRIDE, j, 32 * cg + 8 * q, ok); }
        copy_tile(lds + MX_V, MX_TSTRIDE, zt + Z_GI + h * 128, tid);
    }
    __syncthreads();
    const int vb = w >> 1; const int lbp = tr_lane_base(lane, MX_TSTRIDE);
    const bf16* sb = a.SBUF + (size_t)u * 16384 + (size_t)((vb * 16 + h2) * 32 + r) * 8;
    bf16x8 sf[8];
#pragma unroll
    for (int s = 0; s < 8; ++s) sf[s] = *(const bf16x8*)(sb + s * 512);
    f32x16 o[2]; float s1[2], s2[2];
    const float* rg_ = a.ret_g; const float* hg_ = a.hg_g; const float* gn = (mixer == 0 ? rg_ : hg_) + h * 128 + 32 * vb + 4 * h2;
    v4u gwv[4];
#pragma unroll
    for (int t = 0; t < 2; ++t) { const int ib = (w & 1) ? (1 + t) : (3 * t);
#pragma unroll
        for (int i = 0; i < 2; ++i) { const int id = lane + 64 * i; gwv[2 * t + i] = *(const v4u*)(zt + (size_t)(32 * ib + (id >> 2)) * EV_IN + (mixer == 0 ? Z_RG : Z_GG) + h * 128 + 32 * vb + 8 * (id & 3)); } }
#pragma unroll
    for (int t = 0; t < 2; ++t) {
        const int ib = (w & 1) ? (1 + t) : (3 * t);
        bf16x8 qf[8];
#pragma unroll
        for (int s = 0; s < 8; ++s) qf[s] = *(const LAS bf16x8*)(lds + MX_Q + (32 * ib + r) * MX_STRIDE + h2 * 16 + s * 32);
#pragma unroll
        for (int i = 0; i < 16; ++i) o[t][i] = 0.f;
#pragma unroll
        for (int s = 0; s < 8; ++s) o[t] = MFMA32(sf[s], qf[s], o[t]);
        for (int jb = 0; jb <= ib; ++jb) {
            f32x16 acc;
#pragma unroll
            for (int i = 0; i < 16; ++i) acc[i] = 0.f;
            const LAS char* kp = lds + MX_K + (32 * jb + r) * MX_STRIDE + h2 * 16;
#pragma unroll
            for (int s = 0; s < 8; ++s) { const bf16x8 av = *(const LAS bf16x8*)(kp + s * 32); acc = MFMA32(av, qf[s], acc); }
            if (jb == ib) {
#pragma unroll
                for (int i = 0; i < 16; ++i) { const int c = (i & 3) + 8 * (i >> 2) + 4 * h2; if (c > r) acc[i] = 0.f; } }
            const bf16x8 p0 = pack8(acc[0], acc[1], acc[2], acc[3], acc[4], acc[5], acc[6], acc[7]), p1 = pack8(acc[8], acc[9], acc[10], acc[11], acc[12], acc[13], acc[14], acc[15]);
            const bf16x8 v0 = tr_frag_perm(lds + MX_V, MX_TSTRIDE, lbp, 32 * jb, 32 * vb), v1 = tr_frag_perm(lds + MX_V, MX_TSTRIDE, lbp, 32 * jb + 16, 32 * vb);
            o[t] = MFMA32(v0, p0, o[t]); o[t] = MFMA32(v1, p1, o[t]);
        }
        float a1 = 0.f, a2 = 0.f;
#pragma unroll
        for (int i = 0; i < 16; ++i) { a1 += o[t][i]; a2 += o[t][i] * o[t][i]; }
        a1 += __shfl_xor(a1, 32); a2 += __shfl_xor(a2, 32); s1[t] = a1; s2[t] = a2;
        if (h2 == 0) { scr[256 + (vb * 128 + 32 * ib + r) * 2] = a1; scr[256 + (vb * 128 + 32 * ib + r) * 2 + 1] = a2; }
    }
    LDS_BARRIER();
#pragma unroll
    for (int t = 0; t < 2; ++t) {
        const int ib = (w & 1) ? (1 + t) : (3 * t); const int tok = 32 * ib + r;
        float t1 = 0.f, t2 = 0.f;
#pragma unroll
        for (int v = 0; v < 4; ++v) { t1 += scr[256 + (v * 128 + tok) * 2]; t2 += scr[256 + (v * 128 + tok) * 2 + 1]; }
        float mu = 0.f, rstd;
        if (mixer == 0) { mu = t1 * (1.0f / 128.0f); rstd = 1.0f / sqrtf(fmaxf(t2 * (1.0f / 128.0f) - mu * mu, 0.f) + EPS); } else rstd = 1.0f / sqrtf(t2 * (1.0f / 128.0f) + EPS);
        bf16* zr = zt + (size_t)tok * EV_IN;
        (void)zr;
        LAS char* tile = lds + MX_OSTG + w * 2560;
#pragma unroll
        for (int i = 0; i < 2; ++i) { const int id = lane + 64 * i; *(LAS v4u*)(tile + (id >> 2) * 80 + (id & 3) * 16) = gwv[2 * t + i]; }
        asm volatile("s_waitcnt lgkmcnt(0)" ::: "memory");
#pragma unroll
        for (int g4 = 0; g4 < 4; ++g4) { const v2u gw = *(const LAS v2u*)(tile + r * 80 + (8 * g4 + 4 * h2) * 2); const f32x4 gv = *(const f32x4*)(gn + 8 * g4);
            const float ga[4] = {__uint_as_float(gw.x << 16), __uint_as_float(gw.x & 0xffff0000u), __uint_as_float(gw.y << 16), __uint_as_float(gw.y & 0xffff0000u)}; float y[4];
#pragma unroll
            for (int e = 0; e < 4; ++e) { y[e] = (o[t][4 * g4 + e] - mu) * rstd * gv[e] * (ga[e] / (1.0f + __expf(-ga[e]))); }
            v2u wv; wv.x = cvtpk(y[0], y[1]); wv.y = cvtpk(y[2], y[3]); *(LAS v2u*)(tile + r * 80 + (8 * g4 + 4 * h2) * 2) = wv; }
        asm volatile("s_waitcnt lgkmcnt(0)" ::: "memory");
#pragma unroll
        for (int i = 0; i < 2; ++i) { const int id = lane + 64 * i; const v4u yv = *(const LAS v4u*)(tile + (id >> 2) * 80 + (id & 3) * 16);
            if (!dry) *(v4u*)(zt + (size_t)(32 * ib + (id >> 2)) * EV_IN + (mixer == 0 ? Z_RQ : Z_GQ) + h * 128 + 32 * vb + 8 * (id & 3)) = yv; }
        asm volatile("s_waitcnt lgkmcnt(0)" ::: "memory");
    }
    __syncthreads();
}


__device__ __forceinline__ float gelu_tanh(float x) { const float u = 0.7978845608028654f * (x + 0.044715f * x * x * x); const float t = 1.0f - 2.0f / (1.0f + __expf(2.0f * u)); return 0.5f * x * (1.0f + t); }
__device__ __forceinline__ void ffn_ew(const bf16* GU, const float* cw, const float* cb, bf16* H, int rows, int gtid, int nthreads) {
    for (int idx = gtid; idx < rows * (DFF / 8); idx += nthreads) {
        const int row = idx / (DFF / 8), c0 = (idx % (DFF / 8)) * 8, t = row % SEQ;
        float g0[8], g1[8], g2[8], u[8];
        unpack8(*(const v4u*)(GU + (size_t)row * (2 * DFF) + c0), g2); unpack8(*(const v4u*)(GU + (size_t)row * (2 * DFF) + DFF + c0), u);
        if (t >= 1) unpack8(*(const v4u*)(GU + (size_t)(row - 1) * (2 * DFF) + c0), g1); else { for (int i = 0; i < 8; ++i) g1[i] = 0.f; }
        if (t >= 2) unpack8(*(const v4u*)(GU + (size_t)(row - 2) * (2 * DFF) + c0), g0); else { for (int i = 0; i < 8; ++i) g0[i] = 0.f; }
        float r[8];
#pragma unroll
        for (int i = 0; i < 8; ++i) { const float y = cw[c0 + i] * g0[i] + cw[DFF + c0 + i] * g1[i] + cw[2 * DFF + c0 + i] * g2[i] + cb[c0 + i]; r[i] = gelu_tanh(y) * u[i]; }
        v4u o; o.x = cvtpk(r[0], r[1]); o.y = cvtpk(r[2], r[3]); o.z = cvtpk(r[4], r[5]); o.w = cvtpk(r[6], r[7]);
        *(v4u*)(H + (size_t)row * DFF + c0) = o;
    }
}

constexpr int LDS_BYTES = 163840;
constexpr int LDSCTL_OFF = LDS_BYTES - 512;
constexpr int CW_BAR = 4096;
constexpr size_t CTL_ZERO_BYTES = 1 * MiB;
#define XB_TMO      128
#define XB_XCNT(j)  (256  + 64 * (j))
#define XB_XSUB(j)  (1280 + 64 * (j))
#define XB_XGEN(j)  (2304 + 64 * (j))
#define XB_TOP      3328
#define XB_TOPGEN   3392
#define XCD_BAR_WORDS 3456
#define XB_SPIN_CAP (1u << 18)

__device__ __forceinline__ unsigned xb_ld(unsigned* p)              { return __hip_atomic_load(p, __ATOMIC_RELAXED, __HIP_MEMORY_SCOPE_AGENT); }
__device__ __forceinline__ unsigned xb_add(unsigned* p, unsigned v) { return __hip_atomic_fetch_add(p, v, __ATOMIC_RELAXED, __HIP_MEMORY_SCOPE_AGENT); }
__device__ __forceinline__ unsigned xb_xcc_id() { return (unsigned)__builtin_amdgcn_s_getreg((3 << 11) | 20) & 0xFu; }
#define XB_SPIN(cond, bar) do { unsigned _sp = 0; while (cond) { __builtin_amdgcn_s_sleep(1); \
    if ((++_sp & 255u) == 0u) { if (xb_ld(&(bar)[XB_TMO])) break; if (_sp > XB_SPIN_CAP) { atomicAdd(&(bar)[XB_TMO], 1u); break; } } } } while (0)

struct XcdBarrier {
    unsigned* bar; unsigned x;
    volatile LAS unsigned* st;
};

__device__ __forceinline__ XcdBarrier xcd_barrier_post(unsigned* bar, volatile LAS unsigned* st) {
    XcdBarrier b; b.bar = bar; b.x = xb_xcc_id(); b.st = st;
    if (threadIdx.x == 0) (void)xb_add(&bar[XB_XCNT(b.x)], 1u);
    return b;
}
__device__ __forceinline__ void xcd_barrier_complete(unsigned* bar, unsigned x, unsigned& nloc, unsigned& nx) {
    const unsigned G = gridDim.x * gridDim.y * gridDim.z;
    unsigned sum, cnt, mine, sp = 0u;
    for (;;) {
        sum = 0u; cnt = 0u; mine = 0u;
#pragma unroll
        for (unsigned j = 0; j < 16; ++j) { const unsigned c = xb_ld(&bar[XB_XCNT(j)]); sum += c; cnt += (c > 0u) ? 1u : 0u; mine = (j == x) ? c : mine; }
        if (sum == G) break;
        __builtin_amdgcn_s_sleep(1);
        if ((++sp & 255u) == 0u) { if (xb_ld(&bar[XB_TMO])) break; if (sp > XB_SPIN_CAP) { atomicAdd(&bar[XB_TMO], 1u); break; } }
    }
    nloc = mine > 0u ? mine : 1u; nx = cnt > 0u ? cnt : 1u;
}

__device__ __forceinline__ void xcd_barrier(const XcdBarrier& b) {
    asm volatile("s_waitcnt vmcnt(0)" ::: "memory");
    __syncthreads();
    if (threadIdx.x == 0) {
        unsigned* bar = b.bar;
        __builtin_amdgcn_s_waitcnt(0);
        unsigned nloc = b.st[0], nx = b.st[1];
        if (nloc == 0u) { xcd_barrier_complete(bar, b.x, nloc, nx); b.st[0] = nloc; b.st[1] = nx; }
        const unsigned old = xb_add(&bar[XB_XSUB(b.x)], 1u);
        const unsigned gen = old / nloc;
        if (old + 1u == (gen + 1u) * nloc) {
            __builtin_amdgcn_fence(__ATOMIC_RELEASE, "agent");
            asm volatile("s_waitcnt vmcnt(0)" ::: "memory");
            const unsigned og = xb_add(&bar[XB_TOP], 1u);
            const unsigned tg = og / nx;
            if (og + 1u == (tg + 1u) * nx) xb_add(&bar[XB_TOPGEN], 1u);
            else XB_SPIN(xb_ld(&bar[XB_TOPGEN]) == tg, bar);
            __builtin_amdgcn_fence(__ATOMIC_ACQUIRE, "agent");
            xb_add(&bar[XB_XGEN(b.x)], 1u);
            asm volatile("s_waitcnt vmcnt(0)" ::: "memory");
        } else {
            XB_SPIN(xb_ld(&bar[XB_XGEN(b.x)]) == gen, bar);
            __builtin_amdgcn_fence(__ATOMIC_ACQUIRE, "agent");
            asm volatile("s_waitcnt vmcnt(0)" ::: "memory");
        }
    }
    __syncthreads();
}


__device__ __forceinline__ GAS unsigned char* launder_s(unsigned char* p) { unsigned long long v = (unsigned long long)p; asm volatile("" : "+s"(v)); return (GAS unsigned char*)v; }
__device__ __forceinline__ GAS float* launder_sf(float* p) { unsigned long long v = (unsigned long long)p; asm volatile("" : "+s"(v)); return (GAS float*)v; }
struct FwdArgs { const float* in[25]; float* out; unsigned char* ws; int ph_lo, ph_hi, li, pad; };
__global__ void __launch_bounds__(512, 2) fwd(FwdArgs a) {
    extern __shared__ __attribute__((aligned(16))) unsigned char lds_raw[];
    LAS unsigned char* lds = (LAS unsigned char*)lds_raw;
    const int tid = threadIdx.x, lane = tid & 63, wave = __builtin_amdgcn_readfirstlane(tid >> 6);
    const int G = gridDim.x, bx = blockIdx.x;
    volatile LAS unsigned* MISC = (volatile LAS unsigned*)(lds + LDSCTL_OFF);
    if (tid < 64) MISC[tid] = 0u;
    __syncthreads();
#define WSP (launder_s(a.ws))
#define OUTP (launder_sf(a.out))
    XcdBarrier bar = xcd_barrier_post((unsigned*)(WSP + WS_CTL) + CW_BAR + a.li * XCD_BAR_WORDS, MISC + 8);
    int ph = 0; const int lo = a.ph_lo, hi = a.ph_hi;
#define PH_ON true) for (int rp_ = 0, nr_ = (ph >= lo && ph < hi) ? 1 + ((a.pad >> ph) & 1) : 0; rp_ < nr_; ++rp_, __syncthreads()
#define TID_L ({ int l_; asm volatile("v_mbcnt_lo_u32_b32 %0, -1, 0\n\tv_mbcnt_hi_u32_b32 %0, -1, %0" : "=v"(l_)); wave * 64 + l_; })
#define PH_END do { if (ph >= lo && ph + 1 < hi) xcd_barrier(bar); ++ph; } while (0)
#define XB ((bf16*)(WSP + WS_XB))
#define SSQP ((float*)(WSP + WS_SSQP))
#define ACT ((bf16*)(WSP + WS_ACT))

    if (PH_ON) { ProArgs pa;
#pragma unroll
        for (int i = 0; i < 25; ++i) pa.in[i] = a.in[i];
        pa.ws = (unsigned char*)WSP; pa.layer_mask = 3; pa.ffn_mode = 2;
        { const int t_ = TID_L; prologue_body(pa, bx * 8 + (t_ >> 6), G * 8, t_ & 63, (LAS float*)lds + (t_ >> 6) * 64 * 65); } }
    PH_END;

    for (int l = 0; l < 2; ++l) {
        if (PH_ON) {
            { pg8::Gemm g{XB, (const bf16*)(WSP + (l ? WS_ODIN : WS_EVIN)), M, l ? OD_IN : EV_IN, D, D}; pg8::EpiBf16S E{ACT, SSQP, l ? OD_IN : EV_IN, M, EPS, 0};
              pg8::StaticOrder S; S.init(g.M, g.N, G, bx); pg8::gemm_phase<pg8::EpiBf16S, pg8::StaticOrder, true, true>(lds, g, S, E, TID_L); }
        }
        PH_END;
        const bf16* mixo; int mixo_ld;
        if (l == 0) {
            MixArgs ma{ACT, (const float*)(WSP + WS_LB), a.in[4], a.in[5], (bf16*)OUTP, (float*)(WSP + WS_DECA), (float*)(WSP + WS_DECB)};
            if (PH_ON) mixA_phase((LAS char*)lds, ma, bx, G, TID_L);
            PH_END;
            if (PH_ON) {
                if (bx < 64 && G > 64) { const int lm = bx >> 5;
                    pg8::Gemm g{(const bf16*)(WSP + (lm ? WS_MEMH1 : WS_MEMH0)), (const bf16*)(WSP + (lm ? WS_XKV1 : WS_XKV0)), MM, 2 * D, D, D}; pg8::EpiBf16S E{(bf16*)(WSP + (lm ? WS_MKV1 : WS_MKV0)), nullptr, 2 * D, M, EPS, 0};
                    pg8::StaticOrder S; S.init(g.M, g.N, G, bx & 31); pg8::gemm_phase<pg8::EpiBf16S, pg8::StaticOrder, true, true>(lds, g, S, E, TID_L); }
                else mix_scan(ma, (bx - 64) * 512 + TID_L, (G - 64) * 512, rp_ + 1 < nr_);
            }
            PH_END;
            if (PH_ON) { for (int u = bx; u < 1024; u += G) mixC_unit((LAS char*)lds, ma, u, TID_L, rp_ + 1 < nr_); }
            PH_END;
            mixo = ACT; mixo_ld = EV_IN;
        } else {
            bf16* O = (bf16*)(WSP + WS_ACT + 96 * MiB);
            DaArgs da; da.QKV = ACT; da.biasT = (const float*)(WSP + WS_BIAST); da.gkq = (const float*)(WSP + WS_GOD); da.N0 = (bf16*)(WSP + WS_N2); da.DEN0 = (float*)(WSP + WS_DEN23);
            da.N1 = (const bf16*)(WSP + WS_N2); da.DEN1 = (const float*)(WSP + WS_DEN23); da.N2 = (const bf16*)OUTP; da.DEN2 = (const float*)(WSP + WS_DEN23) + (size_t)M * 8; da.O = O; da.br0 = 1; da.nbr = 2; da.mode = 0; da.pad = 0;
            if (PH_ON) dattn_phase<0>((LAS char*)lds, da, bx, G, TID_L);
            PH_END;
            if (PH_ON) dattn_phase<1>((LAS char*)lds, da, bx, G, TID_L);
            PH_END;
            mixo = O; mixo_ld = D;
        }
        if (PH_ON) { pg8::Gemm g{mixo, (const bf16*)(WSP + (l ? WS_ODOUT : WS_EVOUT)), M, D, D, mixo_ld}; pg8::EpiResid E{l ? (const float*)nullptr : a.in[0], nullptr, XB, SSQP, D, M};
            pg8::StaticOrder S; S.init(g.M, g.N, G, bx); pg8::gemm_phase<pg8::EpiResid, pg8::StaticOrder, false, true>(lds, g, S, E, TID_L); }
        PH_END;
        { bf16* O = (bf16*)(WSP + WS_ACT + 32 * MiB);
          if (PH_ON) { pg8::Gemm g{XB, (const bf16*)(WSP + (l ? WS_XQ1 : WS_XQ0)), M, D, D, D}; EpiXattn E{(const bf16*)(WSP + (l ? WS_MKV1 : WS_MKV0)), (const float*)(WSP + WS_GXA) + l * 256, O};
              pg8::StaticOrder S; S.init(g.M, g.N, G, bx); pg8::gemm_phase<EpiXattn, pg8::StaticOrder, false, true>(lds, g, S, E, TID_L);
              pg8::StaticOrder S2; S2.init(M, D, G, bx); pg8::Unit uq; if (S2.next(0, uq)) xattn_unit<true>((LAS char*)lds, nullptr, (const bf16*)(WSP + (l ? WS_MKV1 : WS_MKV0)), (const float*)(WSP + WS_GXA) + l * 256, O, uq.pm * 4 + uq.pn, TID_L); }
          PH_END;
          if (PH_ON) { pg8::Gemm g{O, (const bf16*)(WSP + (l ? WS_XO1 : WS_XO0)), M, D, D, D}; pg8::EpiResid E{nullptr, nullptr, XB, SSQP, D, M};
              pg8::StaticOrder S; S.init(g.M, g.N, G, bx); pg8::gemm_phase<pg8::EpiResid, pg8::StaticOrder, false, true>(lds, g, S, E, TID_L); }
          PH_END; }
        { bf16* H = ACT;
          if (PH_ON) { pg8::Gemm g{XB, (const bf16*)(WSP + (l ? WS_FIN1 : WS_FIN0)), 68 * 256, 2 * DFF, D, D}; pg8::EpiFfn E{H, SSQP, a.in[22] + (size_t)l * 3 * DFF, a.in[23] + (size_t)l * DFF, M, EPS};
              pg8::FfnOrder S; S.init(g.M, g.N, G, bx); pg8::gemm_phase<pg8::EpiFfn, pg8::FfnOrder, true, true>(lds, g, S, E, TID_L); }
          PH_END;
          if (PH_ON) { pg8::Gemm g{H, (const bf16*)(WSP + (l ? WS_FOUT1 : WS_FOUT0)), M, D, DFF, DFF}; pg8::EpiResid E{nullptr, l ? (float*)OUTP : (float*)nullptr, XB, SSQP, D, M};
              pg8::StaticOrder S; S.init(g.M, g.N, G, bx); pg8::gemm_phase<pg8::EpiResid, pg8::StaticOrder, false, true>(lds, g, S, E, TID_L); }
          PH_END; }
    }
#undef PH_ON
#undef PH_END
#undef TID_L
#undef WSP
#undef OUTP
#undef XB
#undef SSQP
#undef ACT
}
constexpr int N_PHASES = 1 + 9 + 8;

#ifndef PROBE_MASK
#define PROBE_MASK 0
#endif
#ifndef MK_PER_PHASE
#define MK_PER_PHASE 0
#endif
extern "C" void kernel_launch(void* const* d_in, const int* in_sizes, int n_in, void* d_out, int out_size, void* d_ws, size_t ws_size, hipStream_t stream) {
    static int inited = 0;
    if (!inited) {
        if (n_in != 25 || out_size != M * D || ws_size < WS_END) { fprintf(stderr, "kernel_launch: unexpected shapes (n_in %d, out %d, ws %zu)\n", n_in, out_size, ws_size); inited = -1; return; }
        if (hipFuncSetAttribute((const void*)fwd, hipFuncAttributeMaxDynamicSharedMemorySize, LDS_BYTES) != hipSuccess) { fprintf(stderr, "kernel_launch: hipFuncSetAttribute failed\n"); inited = -1; return; }
        inited = 1;
    }
    if (inited < 0) return;
    if (hipMemsetAsync((char*)d_ws + WS_CTL, 0, CTL_ZERO_BYTES, stream) != hipSuccess) return;
    FwdArgs fa{}; for (int i = 0; i < 25; ++i) fa.in[i] = (const float*)d_in[i]; fa.out = (float*)d_out; fa.ws = (unsigned char*)d_ws; fa.pad = PROBE_MASK;
#if MK_PER_PHASE
    for (int p = 0; p < N_PHASES; ++p) { fa.ph_lo = p; fa.ph_hi = p + 1; fa.li = 0; hipLaunchKernelGGL(fwd, dim3(256), dim3(512), LDS_BYTES, stream, fa); }
#else
    fa.ph_lo = 0; fa.ph_hi = N_PHASES; fa.li = 0; hipLaunchKernelGGL(fwd, dim3(256), dim3(512), LDS_BYTES, stream, fa);
#endif
}
```

```cpp
#include <hip/hip_runtime.h>
#include <cstdio>
#include <cstdint>
namespace pg8 {
#define PG8_LAS __attribute__((address_space(3)))
typedef unsigned short bf16_t;
typedef short bf16x8 __attribute__((ext_vector_type(8)));
typedef float f32x4 __attribute__((ext_vector_type(4)));
typedef unsigned u32x4 __attribute__((ext_vector_type(4)));
constexpr int BM = 256, BK = 64, HALF = 128, HTB = HALF * BK * 2  , STAGE_BYTES = 8 * HTB, NXCD = 8, WGM = 8;
constexpr int SSQ_LDS = STAGE_BYTES + 4096, CW_LDS = STAGE_BYTES + 8192;

__host__ __device__ __forceinline__ int lds_byte(int r, int c) { const int st = (r >> 4) * 2 + (c >> 5), rr = r & 15, cc = c & 31, ob = rr * 64 + cc * 2; return st * 1024 + (ob ^ (((ob >> 9) & 1) << 5)); }
__host__ __device__ __forceinline__ void stage_rc(int b, int& R, int& C) { const int st = b / 1024, sb = b % 1024, swz = sb ^ (((sb >> 9) & 1) << 5); R = (st >> 1) * 16 + swz / 64; C = (st & 1) * 32 + (swz % 64) / 2; }
__host__ __device__ __forceinline__ int perm32(int rho) { const int n = rho >> 4, i = rho & 15; return 8 * (i >> 2) + 4 * n + (i & 3); }

struct Unit { int pm, pn; };
struct Gemm { const bf16_t* A; const bf16_t* Bt; int M, N, K, lda; };

struct StaticOrder {
    int nM, nN, nwg, G, c, wgm;
    __host__ __device__ __forceinline__ void init(int M, int N, int G_, int c_, int wgm_ = 4) { nM = M / BM; nN = N / BM; nwg = nM * nN; G = G_; c = c_; wgm = wgm_; }
    __host__ __device__ __forceinline__ bool next(int i, Unit& u) const {
        const long L = (long)i * G + c; if (L >= nwg) return false;
        int wgid = (int)L; { const int q = nwg / NXCD, r = nwg % NXCD, xcd = wgid % NXCD, off = wgid / NXCD; wgid = (xcd < r ? xcd * (q + 1) : r * (q + 1) + (xcd - r) * q) + off; }
        const int nig = wgm * nN, gid = wgid / nig, fm = gid * wgm, gsz = (nM - fm) < wgm ? (nM - fm) : wgm;
        u.pm = fm + ((wgid % nig) % gsz); u.pn = (wgid % nig) / gsz; return true;
    }
    __device__ __forceinline__ void a_ready(const Unit&) const {}
    __device__ __forceinline__ void done(const Unit&) const {}
    __device__ __forceinline__ int arow(const Unit& u) const { return u.pm * BM; }
};
struct FfnOrder : StaticOrder {
    __device__ __forceinline__ int arow(const Unit& u) const { return (u.pm / 17) * 4096 + 254 * (u.pm % 17) - 2; }
};

__device__ __forceinline__ unsigned cvt_pk_bf16(float lo, float hi) { unsigned r; asm volatile("v_cvt_pk_bf16_f32 %0, %1, %2" : "=v"(r) : "v"(lo), "v"(hi)); return r; }
typedef float f32x2 __attribute__((ext_vector_type(2)));
struct EpiBf16S {
    static constexpr int PERM = 3; static constexpr bool AFTER_DRAIN = false;
    bf16_t* O; const float* ssqp; int ldc; int Mtot; float eps; int pad;
    __device__ __forceinline__ void preload(PG8_LAS unsigned char* lds, const Unit& u, int wr, int wc, int lane) const {
        if (!ssqp) return;
#pragma unroll
        for (int ai = 0; ai < 2; ++ai) __builtin_amdgcn_global_load_lds((const unsigned*)(ssqp + (size_t)wc * Mtot + u.pm * BM + ai * HALF + wr * 64 + lane), (PG8_LAS unsigned*)(lds + SSQ_LDS + (((wr * 2 + ai) * 4 + wc) * 64) * 4), 4, 0, 0);
    }
    __device__ __forceinline__ void preload_unit(PG8_LAS unsigned char*, const Unit&, int, int, int) const {}
    __device__ __forceinline__ void operator()(f32x4 (&acc)[2][2][4][2], const Unit& u, int wr, int wc, int fr, int fq, PG8_LAS unsigned char* lds) const {
        const int row0 = u.pm * BM + wr * 64 + fr; const int col0 = u.pn * BM + wc * 64 + 8 * fq;
        const PG8_LAS float* sl = (const PG8_LAS float*)(lds + SSQ_LDS);
#pragma unroll
        for (int ai = 0; ai < 2; ++ai)
#pragma unroll
            for (int m = 0; m < 4; ++m) { const int row = row0 + ai * HALF + m * 16; float rs = 1.f;
                if (ssqp) { const PG8_LAS float* sp = sl + ((wr * 2 + ai) * 4) * 64 + m * 16 + fr; const float s = (sp[0] + sp[64]) + (sp[128] + sp[192]); rs = 1.0f / sqrtf(s * (1.0f / 1024.0f) + eps); }
                bf16_t* rowp = O + (size_t)row * ldc + col0;
#pragma unroll
                for (int bj = 0; bj < 2; ++bj) { const f32x4 v0 = acc[ai][bj][m][0] * rs, v1 = acc[ai][bj][m][1] * rs;
                    u32x4 w; w.x = cvt_pk_bf16(v0[0], v0[1]); w.y = cvt_pk_bf16(v0[2], v0[3]); w.z = cvt_pk_bf16(v1[0], v1[1]); w.w = cvt_pk_bf16(v1[2], v1[3]);
                    *(u32x4*)(rowp + bj * 32) = w; } }
    }
};

__device__ __forceinline__ float gelu_tanh_f(float x) { const float u = 0.7978845608028654f * (x + 0.044715f * x * x * x); const float t = 1.0f - 2.0f / (1.0f + __expf(2.0f * u)); return 0.5f * x * (1.0f + t); }
struct EpiFfn {
    static constexpr int PERM = 1; static constexpr bool AFTER_DRAIN = false;
    bf16_t* H; const float* ssqp; const float* cw; const float* cb; int Mtot; float eps;
    __device__ __forceinline__ void preload(PG8_LAS unsigned char* lds, const Unit& u, int wr, int wc, int lane) const {
        const int rowb = (u.pm / 17) * 4096 + 254 * (u.pm % 17) - 2;
#pragma unroll
        for (int ai = 0; ai < 2; ++ai) { const int row = rowb + ai * HALF + wr * 64 + lane; const int rc = row < 0 ? 0 : (row >= Mtot ? Mtot - 1 : row);
            __builtin_amdgcn_global_load_lds((const unsigned*)(ssqp + (size_t)wc * Mtot + rc), (PG8_LAS unsigned*)(lds + SSQ_LDS + (((wr * 2 + ai) * 4 + wc) * 64) * 4), 4, 0, 0); }
    }
    __device__ __forceinline__ void preload_unit(PG8_LAS unsigned char* lds, const Unit& u, int wr, int wc, int lane) const {
        const float* src = (wc < 3 ? cw + (size_t)wc * 2816 : cb) + u.pn * 128 + 64 * wr + lane;
        __builtin_amdgcn_global_load_lds((const unsigned*)src, (PG8_LAS unsigned*)(lds + CW_LDS + (wc * 128 + 64 * wr) * 4), 4, 0, 0);
    }
    __device__ __forceinline__ void operator()(f32x4 (&acc)[2][2][4][2], const Unit& u, int wr, int wc, int fr, int fq, PG8_LAS unsigned char* lds) const {
        constexpr int DFF_ = 2816;
        const int b = u.pm / 17, t = u.pm % 17, pos0 = 254 * t - 2, rowb = b * 4096 + pos0;
        const int colh = u.pn * 128 + wc * 32 + 8 * fq, lane = fq * 16 + fr;
        PG8_LAS float* halo = (PG8_LAS float*)(lds + STAGE_BYTES);
#pragma unroll
        for (int ai = 0; ai < 2; ++ai)
#pragma unroll
            for (int m = 0; m < 4; ++m) { const int rl = ai * HALF + wr * 64 + m * 16 + fr; const PG8_LAS float* sp = (const PG8_LAS float*)(lds + SSQ_LDS) + ((wr * 2 + ai) * 4) * 64 + m * 16 + fr;
                const float sq = (sp[0] + sp[64]) + (sp[128] + sp[192]); const float rs = 1.0f / sqrtf(sq * (1.0f / 1024.0f) + eps); const bool pad = (pos0 + rl) < 0;
#pragma unroll
                for (int n = 0; n < 2; ++n) {
#pragma unroll
                    for (int e = 0; e < 4; ++e) { acc[ai][0][m][n][e] = pad ? 0.f : acc[ai][0][m][n][e] * rs; acc[ai][1][m][n][e] *= rs; } } }
#pragma unroll
        for (int ai = 0; ai < 2; ++ai) if (fr >= 14) { PG8_LAS float* hp = halo + ((((2 * ai + wr) * 4 + wc) * 4 + fq) * 2 + (fr - 14)) * 8;
            *(PG8_LAS f32x4*)hp = acc[ai][0][3][0]; *(PG8_LAS f32x4*)(hp + 4) = acc[ai][0][3][1]; }
        asm volatile("s_waitcnt lgkmcnt(0)" ::: "memory"); __builtin_amdgcn_s_barrier(); asm volatile("" ::: "memory");
        typedef unsigned u32x2e __attribute__((ext_vector_type(2)));
#define DPPF(x, ctrl) __builtin_bit_cast(float, __builtin_amdgcn_update_dpp(0, __builtin_bit_cast(int, (x)), (ctrl), 0xf, 0xf, true))
        u32x2e hold[2][4];
#pragma unroll
        for (int n = 0; n < 2; ++n) {
            const PG8_LAS float* cwl = (const PG8_LAS float*)(lds + CW_LDS) + wc * 32 + 8 * fq + 4 * n;
            const f32x4 w0 = *(const PG8_LAS f32x4*)cwl, w1 = *(const PG8_LAS f32x4*)(cwl + 128), w2 = *(const PG8_LAS f32x4*)(cwl + 256), bb = *(const PG8_LAS f32x4*)(cwl + 384);
#pragma unroll
            for (int ai = 0; ai < 2; ++ai) {
                const int blk = 2 * ai + wr; f32x4 R1p = (f32x4){0.f, 0.f, 0.f, 0.f}, R2p = (f32x4){0.f, 0.f, 0.f, 0.f};
                if (blk >= 1) { const PG8_LAS float* hp = halo + ((((blk - 1) * 4 + wc) * 4 + fq) * 2) * 8 + 4 * n; const f32x4 h62 = *(const PG8_LAS f32x4*)hp, h63 = *(const PG8_LAS f32x4*)(hp + 8);
                    const f32x4 z4 = (f32x4){0.f, 0.f, 0.f, 0.f}; R1p = fr == 0 ? h63 : z4; R2p = fr == 0 ? h62 : (fr == 1 ? h63 : z4); }
#pragma unroll
                for (int m = 0; m < 4; ++m) { const int rl = ai * HALF + wr * 64 + m * 16 + fr; const bool ok = (rl >= 2) && (pos0 + rl < 4096);
                    float hv[4];
#pragma unroll
                    for (int e = 0; e < 4; ++e) { const float v = acc[ai][0][m][n][e];
                        const float p1 = DPPF(v, 0x111) + R1p[e], p2 = DPPF(v, 0x112) + R2p[e]; R1p[e] = DPPF(v, 0x10F); R2p[e] = DPPF(v, 0x10E);
                        const float y = w0[e] * p2 + (w1[e] * p1 + (w2[e] * v + bb[e]));
                        const float tq = y * (-2.302208198f + -0.10294324f * (y * y));
                        const float sg = __builtin_amdgcn_rcpf(1.0f + __builtin_amdgcn_exp2f(tq));
                        hv[e] = (y * acc[ai][1][m][n][e]) * sg; }
                    u32x2e w; w.x = cvt_pk_bf16(hv[0], hv[1]); w.y = cvt_pk_bf16(hv[2], hv[3]);
                    if (n == 0) hold[ai][m] = w;
                    else if (ok) { u32x4 w4; w4.x = hold[ai][m].x; w4.y = hold[ai][m].y; w4.z = w.x; w4.w = w.y; *(u32x4*)(H + (size_t)(rowb + rl) * DFF_ + colh) = w4; } }
            }
        }
#undef DPPF
        asm volatile("s_waitcnt lgkmcnt(0)" ::: "memory"); __builtin_amdgcn_s_barrier(); asm volatile("" ::: "memory");
    }
};
struct EpiResid {
    static constexpr int PERM = 1; static constexpr bool AFTER_DRAIN = true;
    struct Pre { int unused; };
    const float* base; float* out; bf16_t* xb; float* ssqp; int ldc; int Mtot;
    __device__ __forceinline__ void init(f32x4 (&acc)[2][2][4][2], const Unit& u, int wr, int wc, int fr, int fq) const {
        const int col0 = u.pn * BM + wc * 32 + 8 * fq;
#pragma unroll
        for (int ai = 0; ai < 2; ++ai)
#pragma unroll
            for (int m = 0; m < 4; ++m) { const size_t off = (size_t)(u.pm * BM + ai * HALF + wr * 64 + m * 16 + fr) * ldc + col0;
#pragma unroll
                for (int bj = 0; bj < 2; ++bj) {
                    if (base) { acc[ai][bj][m][0] = *(const f32x4*)(base + off + bj * HALF); acc[ai][bj][m][1] = *(const f32x4*)(base + off + bj * HALF + 4); }
                    else { const u32x4 w = *(const u32x4*)(xb + off + bj * HALF);
                        acc[ai][bj][m][0] = (f32x4){__uint_as_float(w.x << 16), __uint_as_float(w.x & 0xffff0000u), __uint_as_float(w.y << 16), __uint_as_float(w.y & 0xffff0000u)};
                        acc[ai][bj][m][1] = (f32x4){__uint_as_float(w.z << 16), __uint_as_float(w.z & 0xffff0000u), __uint_as_float(w.w << 16), __uint_as_float(w.w & 0xffff0000u)}; } } }
    }
    __device__ __forceinline__ void fused(f32x4 (&acc)[2][2][4][2], const Unit& u, int wr, int wc, int fr, int fq, PG8_LAS unsigned char* lds, int wid, int lane) const {
        PG8_LAS float* P = (PG8_LAS float*)lds;
        const int col0 = u.pn * BM + wc * 32 + 8 * fq;
#pragma unroll
        for (int ai = 0; ai < 2; ++ai)
#pragma unroll
            for (int m = 0; m < 4; ++m) { const int r = ai * HALF + wr * 64 + m * 16 + fr; const size_t off = (size_t)(u.pm * BM + r) * ldc + col0; float s = 0.f;
#pragma unroll
                for (int bj = 0; bj < 2; ++bj) { const f32x4 o0 = acc[ai][bj][m][0], o1 = acc[ai][bj][m][1];
                    if (out) { *(f32x4*)(out + off + bj * HALF) = o0; *(f32x4*)(out + off + bj * HALF + 4) = o1; }
                    u32x4 w; w.x = cvt_pk_bf16(o0[0], o0[1]); w.y = cvt_pk_bf16(o0[2], o0[3]); w.z = cvt_pk_bf16(o1[0], o1[1]); w.w = cvt_pk_bf16(o1[2], o1[3]); *(u32x4*)(xb + off + bj * HALF) = w;
                    s += ((o0[0] * o0[0] + o0[1] * o0[1]) + (o0[2] * o0[2] + o0[3] * o0[3])) + ((o1[0] * o1[0] + o1[1] * o1[1]) + (o1[2] * o1[2] + o1[3] * o1[3])); }
                s += __shfl_xor(s, 16); s += __shfl_xor(s, 32);
                if (fq == 0) P[r * 4 + wc] = s;
                if (m & 1) asm volatile("" ::: "memory"); }
        asm volatile("s_waitcnt lgkmcnt(0)" ::: "memory"); __builtin_amdgcn_s_barrier(); asm volatile("" ::: "memory");
        if (lane < 32) { const int row = wid * 32 + lane; ssqp[(size_t)u.pn * Mtot + u.pm * BM + row] = (P[row * 4 + 0] + P[row * 4 + 1]) + (P[row * 4 + 2] + P[row * 4 + 3]); }
        asm volatile("s_waitcnt lgkmcnt(0)" ::: "memory"); __builtin_amdgcn_s_barrier(); asm volatile("" ::: "memory");
    }
};

template <class Epi, class Sched, bool ALIGN_EPI = false, bool SP2 = false>
__device__ __forceinline__ void gemm_phase(PG8_LAS unsigned char* lds, const Gemm g, const Sched& S, const Epi& E, int tid_in) {
    int tid_l = tid_in; asm volatile("" : "+v"(tid_l));
    const int tid = tid_l, wid = __builtin_amdgcn_readfirstlane(tid >> 6), lane = tid & 63, wr = wid >> 2, wc = wid & 3, fr = lane & 15, fq = lane >> 4;
    const int K = g.K, nt = K / BK;
    unsigned voffA[2], voffB[2];
#pragma unroll
    for (int i = 0; i < 2; ++i) { int R, C; stage_rc(tid * 16 + i * 8192, R, C); const int Rb = (int)Epi::PERM == 3 ? (64 * (R >> 5) + perm32(R & 31)) : ((int)Epi::PERM == 1 ? ((R & ~31) + perm32(R & 31)) : R);
        voffA[i] = (unsigned)(R * g.lda + C) * 2u; voffB[i] = (unsigned)(Rb * K + C) * 2u; }
    const size_t kstep = (size_t)(BK * 2);
    const size_t hstepA = (size_t)HALF * g.lda * 2, hstepB = (size_t)((int)Epi::PERM == 3 ? 32 : HALF) * K * 2;
    const size_t tstepB = (size_t)BM * K * 2;
    const unsigned ldsw = (unsigned)wid * 1024u;
    const int aoff = lds_byte(wr * 64 + fr, fq * 8), boff = lds_byte(wc * 32 + fr, fq * 8);
#define PG8_SA(b, h) (((b) * 2 + (h)) * HTB)
#define PG8_SB(b, h) ((4 + (b) * 2 + (h)) * HTB)
#define PG8_STAGE(bufoff, gbase, voff) do { _Pragma("unroll") for (int _i = 0; _i < 2; ++_i) \
        __builtin_amdgcn_global_load_lds((const unsigned*)((const char*)(gbase) + (voff)[_i]), (PG8_LAS unsigned*)(lds + (bufoff) + ldsw + _i * 8192), 16, 0, 0); } while (0)
#define PG8_LDA(dst, b, h) do { _Pragma("unroll") for (int m = 0; m < 4; ++m) _Pragma("unroll") for (int k = 0; k < 2; ++k) dst[m][k] = *(const PG8_LAS bf16x8*)(lds + PG8_SA(b, h) + aoff + m * 2048 + k * 1024); } while (0)
#define PG8_LDB(dst, b, h) do { _Pragma("unroll") for (int n = 0; n < 2; ++n) _Pragma("unroll") for (int k = 0; k < 2; ++k) dst[n][k] = *(const PG8_LAS bf16x8*)(lds + PG8_SB(b, h) + boff + n * 2048 + k * 1024); } while (0)
#define PG8_MMA(ai, bj, At, Bt) do { __builtin_amdgcn_s_setprio(1); _Pragma("unroll") for (int m = 0; m < 4; ++m) _Pragma("unroll") for (int n = 0; n < 2; ++n) _Pragma("unroll") for (int k = 0; k < 2; ++k) \
        acc[ai][bj][m][n] = __builtin_amdgcn_mfma_f32_16x16x32_bf16(Bt[n][k], At[m][k], acc[ai][bj][m][n], 0, 0, 0); __builtin_amdgcn_s_setprio(0); } while (0)
#define PG8_WAIT_V(n) asm volatile("s_waitcnt vmcnt(" #n ")" ::: "memory")
#define PG8_WAIT_L(n) asm volatile("s_waitcnt lgkmcnt(" #n ")" ::: "memory")
#define PG8_BAR __builtin_amdgcn_s_barrier()
#define PG8_SCHED __builtin_amdgcn_sched_barrier(0)
    Unit cur, nxt; int ui = 0;
    if (!S.next(0, cur)) return;
    f32x4 acc[2][2][4][2];
#pragma unroll
    for (int a = 0; a < 2; ++a)
#pragma unroll
        for (int b = 0; b < 2; ++b)
#pragma unroll
            for (int m = 0; m < 4; ++m)
#pragma unroll
                for (int n = 0; n < 2; ++n) acc[a][b][m][n] = (f32x4){0.f, 0.f, 0.f, 0.f};
    if constexpr (Epi::AFTER_DRAIN) E.init(acc, cur, wr, wc, fr, fq);
    bf16x8 At[4][2], B0[2][2], B1[2][2];
    const char* cA = (const char*)g.A + (ptrdiff_t)S.arow(cur) * (ptrdiff_t)(g.lda * 2); const char* cB = (const char*)g.Bt + (size_t)cur.pn * tstepB;
    S.a_ready(cur);
    if constexpr (!Epi::AFTER_DRAIN) E.preload_unit(lds, cur, wr, wc, lane);
    if constexpr (SP2) {
        PG8_STAGE(PG8_SB(0, 0), cB, voffB); PG8_STAGE(PG8_SB(0, 1), cB + hstepB, voffB); PG8_STAGE(PG8_SA(0, 0), cA, voffA); PG8_STAGE(PG8_SA(0, 1), cA + hstepA, voffA);
        if (wr == 1) PG8_BAR;
        PG8_WAIT_V(2); PG8_BAR;
        PG8_STAGE(PG8_SB(1, 0), cB + kstep, voffB); PG8_STAGE(PG8_SA(1, 0), cA + kstep, voffA); PG8_STAGE(PG8_SB(1, 1), cB + hstepB + kstep, voffB);
        PG8_WAIT_V(6); PG8_BAR;
        if constexpr (Epi::AFTER_DRAIN) {
#pragma unroll
            for (int a_ = 0; a_ < 2; ++a_)
#pragma unroll
                for (int b_ = 0; b_ < 2; ++b_) asm volatile("" : "+v"(acc[a_][b_][0][0]), "+v"(acc[a_][b_][0][1]), "+v"(acc[a_][b_][1][0]), "+v"(acc[a_][b_][1][1]), "+v"(acc[a_][b_][2][0]), "+v"(acc[a_][b_][2][1]), "+v"(acc[a_][b_][3][0]), "+v"(acc[a_][b_][3][1]));
        }
    } else {
        PG8_STAGE(PG8_SB(0, 0), cB, voffB); PG8_STAGE(PG8_SA(0, 0), cA, voffA); PG8_STAGE(PG8_SB(0, 1), cB + hstepB, voffB); PG8_STAGE(PG8_SA(0, 1), cA + hstepA, voffA);
        if (wr == 1) PG8_BAR;
        PG8_WAIT_V(4); PG8_BAR;
        PG8_STAGE(PG8_SB(1, 0), cB + kstep, voffB); PG8_STAGE(PG8_SA(1, 0), cA + kstep, voffA); PG8_STAGE(PG8_SB(1, 1), cB + hstepB + kstep, voffB);
        PG8_WAIT_V(6); PG8_BAR;
    }
    for (;;) {
        const bool has_next = S.next(ui + 1, nxt);
        const char* nA = has_next ? (const char*)g.A + (ptrdiff_t)S.arow(nxt) * (ptrdiff_t)(g.lda * 2) : cA; const char* nB = has_next ? (const char*)g.Bt + (size_t)nxt.pn * tstepB : cB;
        for (int t = 0; t < nt; t += 2) {
            const bool last = (t == nt - 2);
            const char* a1 = cA + (size_t)(t + 1) * kstep;
            const char* a2 = last ? nA : cA + (size_t)(t + 2) * kstep; const char* b2 = last ? nB : cB + (size_t)(t + 2) * kstep;
            const char* a3 = a2 + kstep; const char* b3 = b2 + kstep;
            if (last && has_next) S.a_ready(nxt);
            if constexpr (!Epi::AFTER_DRAIN) { if (last) E.preload(lds, cur, wr, wc, lane); }
            if constexpr (SP2) {
            PG8_LDB(B0, 0, 0); PG8_LDB(B1, 0, 1); PG8_SCHED; PG8_LDA(At, 0, 0); PG8_STAGE(PG8_SA(1, 1), a1 + hstepA, voffA);
            PG8_WAIT_V(8); PG8_WAIT_L(0); PG8_BAR; PG8_MMA(0, 0, At, B0); PG8_MMA(0, 1, At, B1); PG8_BAR; PG8_SCHED;
            PG8_LDA(At, 0, 1); PG8_STAGE(PG8_SB(0, 0), b2, voffB); PG8_STAGE(PG8_SB(0, 1), b2 + hstepB, voffB); PG8_STAGE(PG8_SA(0, 0), a2, voffA);
            PG8_WAIT_V(8); PG8_WAIT_L(0); PG8_BAR; PG8_MMA(1, 0, At, B0); PG8_MMA(1, 1, At, B1); PG8_BAR; PG8_SCHED;
            PG8_LDB(B0, 1, 0); PG8_LDB(B1, 1, 1); PG8_SCHED; PG8_LDA(At, 1, 0); PG8_STAGE(PG8_SA(0, 1), a2 + hstepA, voffA);
            PG8_WAIT_V(8); PG8_WAIT_L(0); PG8_BAR; PG8_MMA(0, 0, At, B0); PG8_MMA(0, 1, At, B1); PG8_BAR; PG8_SCHED;
            PG8_LDA(At, 1, 1); PG8_STAGE(PG8_SB(1, 0), b3, voffB); PG8_STAGE(PG8_SB(1, 1), b3 + hstepB, voffB); PG8_STAGE(PG8_SA(1, 0), a3, voffA);
            PG8_WAIT_V(8); PG8_WAIT_L(0); PG8_BAR; PG8_MMA(1, 0, At, B0); PG8_MMA(1, 1, At, B1); PG8_BAR; PG8_SCHED;
            } else {
            PG8_LDB(B0, 0, 0); PG8_SCHED; PG8_LDA(At, 0, 0); PG8_STAGE(PG8_SA(1, 1), a1 + hstepA, voffA);
            PG8_WAIT_L(8); PG8_BAR; PG8_WAIT_L(0); PG8_MMA(0, 0, At, B0); PG8_BAR; PG8_SCHED;
            PG8_LDB(B1, 0, 1); PG8_STAGE(PG8_SB(0, 0), b2, voffB);
            PG8_BAR; PG8_WAIT_L(0); PG8_MMA(0, 1, At, B1); PG8_BAR;
            PG8_LDA(At, 0, 1); PG8_STAGE(PG8_SA(0, 0), a2, voffA);
            PG8_BAR; PG8_WAIT_L(0); PG8_MMA(1, 0, At, B0); PG8_BAR; PG8_SCHED;
            PG8_STAGE(PG8_SB(0, 1), b2 + hstepB, voffB);
            PG8_WAIT_V(6); PG8_BAR; PG8_MMA(1, 1, At, B1); PG8_BAR;
            PG8_LDB(B0, 1, 0); PG8_SCHED; PG8_LDA(At, 1, 0); PG8_STAGE(PG8_SA(0, 1), a2 + hstepA, voffA);
            PG8_WAIT_L(8); PG8_BAR; PG8_WAIT_L(0); PG8_MMA(0, 0, At, B0); PG8_BAR; PG8_SCHED;
            PG8_LDB(B1, 1, 1); PG8_STAGE(PG8_SB(1, 0), b3, voffB);
            PG8_BAR; PG8_WAIT_L(0); PG8_MMA(0, 1, At, B1); PG8_BAR;
            PG8_LDA(At, 1, 1); PG8_STAGE(PG8_SA(1, 0), a3, voffA);
            PG8_BAR; PG8_WAIT_L(0); PG8_MMA(1, 0, At, B0); PG8_BAR; PG8_SCHED;
            PG8_STAGE(PG8_SB(1, 1), b3 + hstepB, voffB);
            PG8_WAIT_V(6); PG8_BAR; PG8_MMA(1, 1, At, B1); PG8_BAR;
            }
        }
        if constexpr (ALIGN_EPI) { if (wr == 0) PG8_BAR; }
        if constexpr (!Epi::AFTER_DRAIN) { E(acc, cur, wr, wc, fr, fq, lds); S.done(cur); if (has_next) E.preload_unit(lds, nxt, wr, wc, lane); }
        if (!has_next) break;
#pragma unroll
        for (int a = 0; a < 2; ++a)
#pragma unroll
            for (int b = 0; b < 2; ++b)
#pragma unroll
                for (int m = 0; m < 4; ++m)
#pragma unroll
                    for (int n = 0; n < 2; ++n) acc[a][b][m][n] = (f32x4){0.f, 0.f, 0.f, 0.f};
        cur = nxt; cA = nA; cB = nB; ++ui;
        if constexpr (ALIGN_EPI) { if (wr == 1) PG8_BAR; }
    }
    PG8_WAIT_V(0);
    if constexpr (!ALIGN_EPI) { if (wr == 0) PG8_BAR; }
    PG8_BAR;
    if constexpr (Epi::AFTER_DRAIN) { E.fused(acc, cur, wr, wc, fr, fq, lds, wid, lane); S.done(cur); }
#undef PG8_SA
#undef PG8_SB
#undef PG8_STAGE
#undef PG8_LDA
#undef PG8_LDB
#undef PG8_MMA
#undef PG8_WAIT_V
#undef PG8_WAIT_L
#undef PG8_BAR
#undef PG8_SCHED
}
}


#define GAS __attribute__((address_space(1)))
#define LAS __attribute__((address_space(3)))
typedef unsigned short bf16;
typedef unsigned v4u __attribute__((ext_vector_type(4)));
typedef unsigned v2u __attribute__((ext_vector_type(2)));
typedef float f32x4 __attribute__((ext_vector_type(4)));
constexpr int BATCH = 4, SEQ = 4096, D = 1024, M = BATCH * SEQ, NMEM = 256, MM = BATCH * NMEM, DFF = 2816;
constexpr int EV_IN = 4096, OD_IN = 3072;
constexpr float EPS = 1e-6f;
constexpr int Z_RQ = 0, Z_GQ = 512, Z_RK = 1024, Z_RV = 1536, Z_RG = 2048, Z_GF = 2560, Z_GI = 3072, Z_GG = 3584;

constexpr size_t MiB = 1u << 20;
constexpr size_t WS_CTL = 0;
constexpr size_t WS_EVIN = 1 * MiB, WS_EVOUT = 9 * MiB, WS_XQ0 = 11 * MiB, WS_XKV0 = 13 * MiB, WS_XO0 = 17 * MiB, WS_FIN0 = 19 * MiB, WS_FOUT0 = 30 * MiB;
constexpr size_t WS_ODIN = 36 * MiB, WS_ODOUT = 42 * MiB, WS_XQ1 = 44 * MiB, WS_XKV1 = 46 * MiB, WS_XO1 = 50 * MiB, WS_FIN1 = 52 * MiB, WS_FOUT1 = 63 * MiB;
constexpr size_t WS_XB = 69 * MiB;
constexpr size_t WS_MKV0 = 101 * MiB, WS_MKV1 = 105 * MiB;
constexpr size_t WS_MEMH0 = 109 * MiB, WS_MEMH1 = 111 * MiB;
constexpr size_t WS_SSQP = 113 * MiB;
constexpr size_t WS_LB = 113 * MiB + 512 * 1024;
constexpr size_t WS_BIAST = 113 * MiB + 516 * 1024;
constexpr size_t WS_GXA = 113 * MiB + 600 * 1024, WS_GOD = 113 * MiB + 604 * 1024;
constexpr size_t WS_DEN23 = 114 * MiB;
constexpr size_t WS_N2 = 1 * MiB;
constexpr size_t WS_ACT = 115 * MiB;
constexpr size_t WS_DECA = 243 * MiB, WS_DECB = 243 * MiB + 512 * 1024;
constexpr size_t WS_END = 256 * MiB;

__device__ __forceinline__ float bf2f(bf16 u) { return __uint_as_float((unsigned)u << 16); }
__device__ __forceinline__ unsigned f2bf(float f) { unsigned u = __builtin_bit_cast(unsigned, f); return (u + 0x7fffu + ((u >> 16) & 1u)) >> 16; }
__device__ __forceinline__ unsigned pk2(float lo, float hi) { return f2bf(lo) | (f2bf(hi) << 16); }
__device__ __forceinline__ float wave_sum(float v) {
#pragma unroll
    for (int o = 1; o < 64; o <<= 1) v += __shfl_xor(v, o);
    return v;
}
__device__ __forceinline__ float wave_max(float v) {
#pragma unroll
    for (int o = 1; o < 64; o <<= 1) v = fmaxf(v, __shfl_xor(v, o));
    return v;
}
__device__ __forceinline__ void unpack8(const v4u w, float (&f)[8]) {
    f[0] = __uint_as_float(w.x << 16); f[1] = __uint_as_float(w.x & 0xffff0000u); f[2] = __uint_as_float(w.y << 16); f[3] = __uint_as_float(w.y & 0xffff0000u);
    f[4] = __uint_as_float(w.z << 16); f[5] = __uint_as_float(w.z & 0xffff0000u); f[6] = __uint_as_float(w.w << 16); f[7] = __uint_as_float(w.w & 0xffff0000u);
}
__device__ __forceinline__ void rope_sincos(float a, float& s, float& c) {
    const float n = rintf(a * 0.15915494309189535f);
    float r = fmaf(-n, 6.2831854820251465f, a); r = fmaf(-n, -1.7484555e-7f, r);
    const float rev = r * 0.15915494309189535f;
    s = __builtin_amdgcn_sinf(rev); c = __builtin_amdgcn_cosf(rev);
}

__device__ __forceinline__ int dst_row_map(int mode, int n0) {
    if (mode == 1) { const int seg = n0 >> 9, within = n0 & 511; const int dseg = (seg == 0) ? 0 : (seg == 4 ? 1 : (seg < 4 ? seg + 1 : seg)); return dseg * 512 + within; }
    if (mode == 2) { return n0 < DFF ? (n0 >> 7) * 256 + (n0 & 127) : ((n0 - DFF) >> 7) * 256 + 128 + ((n0 - DFF) & 127); }
    return n0;
}
__device__ __forceinline__ void transpose_item(const float* W, int K, int N, const float* g, bf16* WT, int mode, LAS float* scr, int item, int lane) {
    const int nblk = N / 64, kb = item / nblk, nb = item % nblk, k0 = 64 * kb, n0 = 64 * nb, lr = lane >> 4, lc = lane & 15;
    f32x4 v[16];
#pragma unroll
    for (int i = 0; i < 16; ++i) v[i] = *(const f32x4*)(W + (size_t)(k0 + 4 * i + lr) * N + n0 + 4 * lc);
#pragma unroll
    for (int i = 0; i < 16; ++i) { const int kk = 4 * i + lr; const float gg = g ? g[k0 + kk] : 1.0f; LAS float* p = scr + kk * 65 + 4 * lc; p[0] = v[i][0] * gg; p[1] = v[i][1] * gg; p[2] = v[i][2] * gg; p[3] = v[i][3] * gg; }
    asm volatile("s_waitcnt lgkmcnt(0)" ::: "memory");
    const int c = lane & 7; const int d0 = dst_row_map(mode, n0);
#pragma unroll
    for (int j = 0; j < 8; ++j) { const int n = (lane >> 3) + 8 * j; const LAS float* sp = scr + (8 * c) * 65 + n;
        v4u o; o.x = pk2(sp[0 * 65], sp[1 * 65]); o.y = pk2(sp[2 * 65], sp[3 * 65]); o.z = pk2(sp[4 * 65], sp[5 * 65]); o.w = pk2(sp[6 * 65], sp[7 * 65]);
        *(v4u*)(WT + (size_t)(d0 + n) * K + k0 + 8 * c) = o; }
    asm volatile("s_waitcnt lgkmcnt(0)" ::: "memory");
}
struct ProArgs { const float* in[25]; unsigned char* ws; int layer_mask; int ffn_mode; };
#define PICK_JOB(Wp_, K__, N__, gp_, dst_, mode_) if (!found) { const int ni_ = ((K__) / 64) * ((N__) / 64); if (r < ni_) { W_ = (Wp_); K_ = (K__); N_ = (N__); g_ = (gp_); d_ = (dst_); m_ = (mode_); found = true; } else r -= ni_; }
__device__ __forceinline__ void prologue_body(const ProArgs& a, int gw, int NGW, int lane, LAS float* scr) {
    unsigned char* ws = a.ws;
    const float* x = a.in[0]; const float* mem = a.in[1];
    if (a.layer_mask & 1) {
        constexpr int NITEMS_ALL = 2 * ((D / 64) * (D / 64) * 3 + (D / 64) * (2 * D / 64) + (D / 64) * (2 * DFF / 64) + (DFF / 64) * (D / 64)) + (D / 64) * (EV_IN / 64) + (D / 64) * (OD_IN / 64) + (D / 64) * (D / 64) * 0;
        for (int it = gw; it < NITEMS_ALL; it += NGW) {
            int r = it; bool found = false; const float* W_ = nullptr; const float* g_ = nullptr; int K_ = 0, N_ = 0, m_ = 0; size_t d_ = 0;
            PICK_JOB(a.in[3], D, EV_IN, a.in[2], WS_EVIN, 1)
            PICK_JOB(a.in[21], D, 2 * DFF, a.in[20], WS_FIN0, a.ffn_mode)
            PICK_JOB(a.in[21] + (size_t)D * 2 * DFF, D, 2 * DFF, a.in[20] + D, WS_FIN1, a.ffn_mode)
            PICK_JOB(a.in[8], D, OD_IN, a.in[2] + D, WS_ODIN, 0)
            PICK_JOB(a.in[24], DFF, D, (const float*)nullptr, WS_FOUT0, 0)
            PICK_JOB(a.in[24] + (size_t)DFF * D, DFF, D, (const float*)nullptr, WS_FOUT1, 0)
            PICK_JOB(a.in[16], D, 2 * D, (const float*)nullptr, WS_XKV0, 0)
            PICK_JOB(a.in[16] + (size_t)D * 2 * D, D, 2 * D, (const float*)nullptr, WS_XKV1, 0)
            PICK_JOB(a.in[7], D, D, (const float*)nullptr, WS_EVOUT, 0)
            PICK_JOB(a.in[12], D, D, (const float*)nullptr, WS_ODOUT, 0)
            PICK_JOB(a.in[15], D, D, a.in[13], WS_XQ0, 0)
            PICK_JOB(a.in[15] + (size_t)D * D, D, D, a.in[13] + D, WS_XQ1, 0)
            PICK_JOB(a.in[19], D, D, (const float*)nullptr, WS_XO0, 0)
            PICK_JOB(a.in[19] + (size_t)D * D, D, D, (const float*)nullptr, WS_XO1, 0)
            if (found) transpose_item(W_, K_, N_, g_, (bf16*)(ws + d_), m_, scr, r, lane);
        }
        for (int m = 2 * gw; m < M; m += 2 * NGW) {
            const f32x4* xr = (const f32x4*)(x + (size_t)m * D) + lane; v2u* o8 = (v2u*)((bf16*)(ws + WS_XB) + (size_t)m * D) + lane; float* sp = (float*)(ws + WS_SSQP);
            f32x4 v[8];
#pragma unroll
            for (int j = 0; j < 8; ++j) v[j] = xr[64 * j];
#pragma unroll
            for (int j = 0; j < 8; ++j) { v2u w; w.x = pk2(v[j][0], v[j][1]); w.y = pk2(v[j][2], v[j][3]); o8[64 * j] = w;
                const float s2 = wave_sum((v[j][0] * v[j][0] + v[j][1] * v[j][1]) + (v[j][2] * v[j][2] + v[j][3] * v[j][3])); if (lane == 0) sp[(size_t)(j & 3) * M + m + (j >> 2)] = s2; }
        }
        for (int r = gw; r < 2 * MM; r += NGW) { const int l = r / MM, m = r % MM;
            const f32x4* xr = (const f32x4*)(mem + (size_t)m * D) + lane; const f32x4* gr = (const f32x4*)(a.in[14] + (size_t)l * D) + lane;
            f32x4 v[4]; float s = 0.f;
#pragma unroll
            for (int j = 0; j < 4; ++j) { v[j] = xr[64 * j]; s += (v[j][0] * v[j][0] + v[j][1] * v[j][1]) + (v[j][2] * v[j][2] + v[j][3] * v[j][3]); }
            const float rs = 1.0f / sqrtf(wave_sum(s) * (1.0f / D) + EPS);
            v2u* o8 = (v2u*)((bf16*)(ws + (l ? WS_MEMH1 : WS_MEMH0)) + (size_t)m * D) + lane;
#pragma unroll
            for (int j = 0; j < 4; ++j) { const f32x4 g = gr[64 * j]; v2u w; w.x = pk2(v[j][0] * rs * g[0], v[j][1] * rs * g[1]); w.y = pk2(v[j][2] * rs * g[2], v[j][3] * rs * g[3]); o8[64 * j] = w; }
        }
        if (gw == 0) {
            const float* lg = a.in[6]; float* lb = (float*)(ws + WS_LB);
            for (int c = lane; c < 512; c += 64) { const float a0 = lg[c], a1 = lg[512 + c], a2 = lg[1024 + c]; const float mx = fmaxf(a0, fmaxf(a1, a2));
                const float e0 = expf(a0 - mx), e1 = expf(a1 - mx), e2 = expf(a2 - mx); lb[c] = e0 / (e0 + e1 + e2); }
        }
        if (gw == 2) {
            float* gx = (float*)(ws + WS_GXA); float* go = (float*)(ws + WS_GOD);
            for (int i = lane; i < 512; i += 64) gx[i] = a.in[18][i] * a.in[17][i];
            for (int i = lane; i < 128; i += 64) go[i] = a.in[10][i] * a.in[9][i];
        }
        if (gw == 1) {
            const float* rb = a.in[11]; float* bt = (float*)(ws + WS_BIAST);
            for (int i = lane; i < 3 * 8 * 132; i += 64) { const int br = i / (8 * 132), h = (i / 132) % 8, dl = i % 132; const int d = dl * (1 << (2 * br));
                int bucket; if (d < 16) bucket = d; else { const float lr = logf((float)d / 16.0f) / 4.852030263919617f; int lg2 = 16 + (int)(lr * 16.0f); bucket = lg2 < 31 ? lg2 : 31; }
                bt[i] = (dl <= 128) ? rb[bucket * 8 + h] : 0.f; }
        }
    }
}


typedef short bf16x8 __attribute__((ext_vector_type(8)));
typedef short s16x4 __attribute__((ext_vector_type(4)));
typedef float f32x16 __attribute__((ext_vector_type(16)));
typedef float f32x2_t __attribute__((ext_vector_type(2))); typedef __bf16 bf16x2_t __attribute__((ext_vector_type(2)));
typedef short v4i16_t __attribute__((ext_vector_type(4)));
#define MFMA32(a, b, c) __builtin_amdgcn_mfma_f32_32x32x16_bf16((a), (b), (c), 0, 0, 0)
__device__ __forceinline__ unsigned cvtpk(float lo, float hi) { f32x2_t v = {lo, hi}; bf16x2_t b = __builtin_convertvector(v, bf16x2_t); return __builtin_bit_cast(unsigned, b); }
__device__ __forceinline__ bf16x8 pack8(float a0, float a1, float a2, float a3, float a4, float a5, float a6, float a7) {
    v4u p; p.x = cvtpk(a0, a1); p.y = cvtpk(a2, a3); p.z = cvtpk(a4, a5); p.w = cvtpk(a6, a7); return __builtin_bit_cast(bf16x8, p); }
__device__ __forceinline__ s16x4 vtr(const LAS char* p) { return __builtin_bit_cast(s16x4, __builtin_amdgcn_ds_read_tr16_b64_v4i16((LAS v4i16_t*)p)); }
__device__ __forceinline__ int tr_lane_base(int lane, int stride) { const int g = lane >> 4, i = lane & 15, q = i >> 2, p = i & 3, h2 = g >> 1; return (4 * h2 + q) * stride + (16 * (g & 1) + 4 * p) * 2; }
__device__ __forceinline__ bf16x8 tr_frag_perm(const LAS char* img, int stride, int lbase, int k0, int n0) {
    const LAS char* p = img + lbase + k0 * stride + n0 * 2;
    const s16x4 lo = vtr(p), hi = vtr(p + 8 * stride);
    return (bf16x8){lo[0], lo[1], lo[2], lo[3], hi[0], hi[1], hi[2], hi[3]};
}
__device__ __forceinline__ int tr_lane_base_nat(int lane, int stride) { const int g = lane >> 4, i = lane & 15, q = i >> 2, p = i & 3, h2 = g >> 1; return (8 * h2 + q) * stride + (16 * (g & 1) + 4 * p) * 2; }
__device__ __forceinline__ bf16x8 tr_frag_nat(const LAS char* img, int stride, int lbase, int k0, int n0) {
    const LAS char* p = img + lbase + k0 * stride + n0 * 2;
    const s16x4 lo = vtr(p), hi = vtr(p + 4 * stride);
    return (bf16x8){lo[0], lo[1], lo[2], lo[3], hi[0], hi[1], hi[2], hi[3]};
}

#define LDS_BARRIER() do { asm volatile("s_waitcnt lgkmcnt(0)" ::: "memory"); __builtin_amdgcn_s_barrier(); asm volatile("" ::: "memory"); } while (0)
constexpr int XA_STRIDE = 528, XA_VSTRIDE = 528;
constexpr int XA_LDS = 256 * XA_STRIDE;
template <bool Q_IN_LDS> __device__ __forceinline__ void xattn_unit(LAS char* lds, const bf16* __restrict__ Q, const bf16* __restrict__ MKV, const float* __restrict__ gkq, bf16* __restrict__ O, int unit, int tid) {
    const int lane = tid & 63, w = __builtin_amdgcn_readfirstlane(tid >> 6), r = lane & 31, h2 = lane >> 5;
    const int rb = unit >> 2, h = unit & 3, row0 = rb * 256, b = row0 / SEQ;
    const bf16* Kg = MKV + (size_t)(b * NMEM) * 2048 + h * 256; const bf16* Vg = Kg + 1024;
    v4u st[16];
#pragma unroll
    for (int i = 0; i < 16; ++i) { const int id = tid + 512 * i; st[i] = *(const v4u*)(Kg + (size_t)(id >> 5) * 2048 + (id & 31) * 8); }
    const size_t qoff = (size_t)(row0 + 32 * w + r) * D + h * 256;
    bf16x8 qf[16];
    if (Q_IN_LDS) {
#pragma unroll
        for (int s = 0; s < 16; ++s) qf[s] = *(const LAS bf16x8*)(lds + (32 * w + r) * XA_STRIDE + h2 * 16 + s * 32);
        asm volatile("s_waitcnt lgkmcnt(0)" ::: "memory"); __builtin_amdgcn_s_barrier(); asm volatile("" ::: "memory");
    } else {
#pragma unroll
        for (int s = 0; s < 16; ++s) qf[s] = *(const bf16x8*)(Q + qoff + 8 * h2 + 16 * s);
    }
    { float gk8[8];
#pragma unroll
      for (int e = 0; e < 8; ++e) gk8[e] = gkq[(tid & 31) * 8 + e];
#pragma unroll
      for (int i = 0; i < 16; ++i) { const int id = tid + 512 * i; float f[8]; unpack8(st[i], f);
          float sq = (f[0] * f[0] + f[1] * f[1]) + (f[2] * f[2] + f[3] * f[3]) + (f[4] * f[4] + f[5] * f[5]) + (f[6] * f[6] + f[7] * f[7]);
          sq += __shfl_xor(sq, 1); sq += __shfl_xor(sq, 2); sq += __shfl_xor(sq, 4); sq += __shfl_xor(sq, 8); sq += __shfl_xor(sq, 16);
          const float rk = 1.0f / sqrtf(sq * (1.0f / 256.0f) + EPS) * 0.0625f;
          v4u o; o.x = cvtpk(f[0] * rk * gk8[0], f[1] * rk * gk8[1]); o.y = cvtpk(f[2] * rk * gk8[2], f[3] * rk * gk8[3]); o.z = cvtpk(f[4] * rk * gk8[4], f[5] * rk * gk8[5]); o.w = cvtpk(f[6] * rk * gk8[6], f[7] * rk * gk8[7]);
          *(LAS v4u*)(lds + (id >> 5) * XA_STRIDE + (id & 31) * 16) = o; } }
    float ss = 0.f;
#pragma unroll
    for (int s = 0; s < 16; ++s)
#pragma unroll
        for (int j = 0; j < 8; ++j) { const float x = __uint_as_float((unsigned)(unsigned short)qf[s][j] << 16); ss += x * x; }
    ss += __shfl_xor(ss, 32);
    const float rsl = 1.0f / sqrtf(ss * (1.0f / 256.0f) + EPS) * 1.4426950408889634f;
    asm volatile("" ::: "memory");
#pragma unroll
    for (int i = 0; i < 8; ++i) { const int id = tid + 512 * i; st[i] = *(const v4u*)(Vg + (size_t)(id >> 5) * 2048 + (id & 31) * 8); }
    LDS_BARRIER();
    bf16x8 pf[8][2]; float den = 0.f;
#pragma unroll
    for (int kb = 0; kb < 8; ++kb) {
        f32x16 acc;
#pragma unroll
        for (int i = 0; i < 16; ++i) acc[i] = 0.f;
        const LAS char* kp = lds + (32 * kb + r) * XA_STRIDE + h2 * 16;
#pragma unroll
        for (int s = 0; s < 16; ++s) { const bf16x8 a = *(const LAS bf16x8*)(kp + s * 32); acc = MFMA32(a, qf[s], acc); }
        float p[16];
#pragma unroll
        for (int i = 0; i < 16; ++i) { p[i] = __builtin_amdgcn_exp2f(acc[i] * rsl - 11.541560327111707f); den += p[i]; }
        pf[kb][0] = pack8(p[0], p[1], p[2], p[3], p[4], p[5], p[6], p[7]); pf[kb][1] = pack8(p[8], p[9], p[10], p[11], p[12], p[13], p[14], p[15]);
    }
    den += __shfl_xor(den, 32);
    const float inv = 1.0f / den;
    LDS_BARRIER();
#pragma unroll
    for (int i = 8; i < 16; ++i) { const int id = tid + 512 * i; st[i] = *(const v4u*)(Vg + (size_t)(id >> 5) * 2048 + (id & 31) * 8); }
#pragma unroll
    for (int i = 0; i < 16; ++i) { const int id = tid + 512 * i; *(LAS v4u*)(lds + (id >> 5) * XA_VSTRIDE + (id & 31) * 16) = st[i]; }
    LDS_BARRIER();
    const int lbase = tr_lane_base(lane, XA_VSTRIDE);
#pragma unroll
    for (int half = 0; half < 2; ++half) {
        f32x16 o[4];
#pragma unroll
        for (int vb = 0; vb < 4; ++vb)
#pragma unroll
            for (int i = 0; i < 16; ++i) o[vb][i] = 0.f;
#pragma unroll
        for (int kb = 0; kb < 8; ++kb)
#pragma unroll
            for (int s = 0; s < 2; ++s)
#pragma unroll
                for (int vb = 0; vb < 4; ++vb) { const bf16x8 a = tr_frag_perm(lds, XA_VSTRIDE, lbase, 32 * kb + 16 * s, 128 * half + 32 * vb); o[vb] = MFMA32(a, pf[kb][s], o[vb]); }
        LAS char* tile = lds + 256 * XA_VSTRIDE + w * 2560;
#pragma unroll
        for (int vb = 0; vb < 4; ++vb) {
#pragma unroll
            for (int g4 = 0; g4 < 4; ++g4) { v2u wv; wv.x = cvtpk(o[vb][4 * g4] * inv, o[vb][4 * g4 + 1] * inv); wv.y = cvtpk(o[vb][4 * g4 + 2] * inv, o[vb][4 * g4 + 3] * inv);
                *(LAS v2u*)(tile + r * 80 + (8 * g4 + 4 * h2) * 2) = wv; }
            asm volatile("s_waitcnt lgkmcnt(0)" ::: "memory");
#pragma unroll
            for (int i = 0; i < 2; ++i) { const int id = lane + 64 * i; *(v4u*)(O + (size_t)(row0 + 32 * w + (id >> 2)) * D + h * 256 + 128 * half + 32 * vb + 8 * (id & 3)) = *(const LAS v4u*)(tile + (id >> 2) * 80 + (id & 3) * 16); }
            asm volatile("s_waitcnt lgkmcnt(0)" ::: "memory");
        }
    }
    __syncthreads();
}


struct EpiXattn {
    static constexpr int PERM = 1; static constexpr bool AFTER_DRAIN = true;
    struct Pre { int unused; };
    const bf16* MKV; const float* gkq; bf16* O;
    __device__ __forceinline__ void init(f32x4 (&)[2][2][4][2], const pg8::Unit&, int, int, int, int) const {}
    __device__ __forceinline__ void fused(f32x4 (&acc)[2][2][4][2], const pg8::Unit& u, int wr, int wc, int fr, int fq, LAS unsigned char* lds, int wid, int lane) const {
#pragma unroll
        for (int ai = 0; ai < 2; ++ai)
#pragma unroll
            for (int m = 0; m < 4; ++m) { const int row = ai * 128 + wr * 64 + m * 16 + fr;
#pragma unroll
                for (int bj = 0; bj < 2; ++bj) { const f32x4 v0 = acc[ai][bj][m][0], v1 = acc[ai][bj][m][1];
                    v4u o; o.x = cvtpk(v0[0], v0[1]); o.y = cvtpk(v0[2], v0[3]); o.z = cvtpk(v1[0], v1[1]); o.w = cvtpk(v1[2], v1[3]);
                    *(LAS v4u*)(lds + row * XA_STRIDE + (bj * 128 + wc * 32 + 8 * fq) * 2) = o; } }
        asm volatile("s_waitcnt lgkmcnt(0)" ::: "memory"); __builtin_amdgcn_s_barrier(); asm volatile("" ::: "memory");
    }
};

constexpr int DA_STRIDE = 272, DA_VSTRIDE = 320, DA_LDS_BIAS = 384 * DA_VSTRIDE, DA_LDS_OSTG = DA_LDS_BIAS + 768, DA_OSTG_WAVE = 32 * 144 + 128;
static_assert(DA_LDS_OSTG + 8 * DA_OSTG_WAVE <= 163840 - 512, "dilated attention LDS map");
constexpr int DA_UNUSED0 = 0;
struct DaArgs { const bf16* QKV; const float* biasT; const float* gkq; bf16* N0; float* DEN0; const bf16* N1; const float* DEN1; const bf16* N2; const float* DEN2; bf16* O; int br0; int nbr; int mode; int pad; };
struct DaUnit { int br, b, h, dil, cls, l0; };
template <int MODE> __device__ __forceinline__ DaUnit da_decode(int uu) {
    DaUnit U; U.br = MODE == 0 ? __builtin_amdgcn_readfirstlane(1 + (uu >> 9)) : 0; const int rem = __builtin_amdgcn_readfirstlane(uu & 511), x = rem & 15; U.b = rem >> 7; U.h = (rem >> 4) & 7; U.dil = 1 << (2 * U.br);
    U.cls = U.br == 0 ? 0 : (U.br == 1 ? (x & 3) : x); U.l0 = 256 * (U.br == 0 ? x : (U.br == 1 ? (x >> 2) : 0)); return U; }
__device__ __forceinline__ void da_load_rows(v4u (&st)[12], const bf16* QKV, const DaUnit& U, int col, int tid) {
    const bf16* base = QKV + (size_t)(U.b * SEQ) * OD_IN + U.h * 128 + col + (tid & 15) * 8;
#pragma unroll
    for (int i = 0; i < 12; ++i) { const int ki = (tid >> 4) + 32 * i, lk = U.l0 - 128 + ki, lkc = lk < 0 ? 0 : lk; st[i] = *(const v4u*)(base + (size_t)(lkc * U.dil + U.cls) * OD_IN); }
}
template <int MODE> __device__ __forceinline__ void dattn_phase(LAS char* lds, const DaArgs& a, int bx, int G, int tid) {
    constexpr int NUNITS = MODE == 0 ? 1024 : 512;
    const int lane = tid & 63, w = __builtin_amdgcn_readfirstlane(tid >> 6), r = lane & 31, h2 = lane >> 5;
    int uu = (G == 256) ? (((bx & 7) << 5) | (bx >> 3)) : bx; if (uu >= NUNITS) return;
    v4u st[12];
    { const DaUnit U0 = da_decode<MODE>(uu); da_load_rows(st, a.QKV, U0, 1024, tid); }
    LAS float* lbias = (LAS float*)(lds + DA_LDS_BIAS);
    const int lbase = tr_lane_base(lane, DA_VSTRIDE);
    for (;;) {
        const DaUnit U = da_decode<MODE>(uu);
        const int l0 = U.l0, h = U.h; const bool zfirst = (l0 == 0);
        int r_l = r; asm volatile("" : "+v"(r_l));
        float gk8[8];
#pragma unroll
        for (int e = 0; e < 8; ++e) gk8[e] = a.gkq[(tid & 15) * 8 + e];
        const size_t qrow = (size_t)(U.b * SEQ + (l0 + 32 * w + r) * U.dil + U.cls);
#pragma unroll
        for (int i = 0; i < 12; ++i) { float f_[8]; unpack8((i < 4 && zfirst) ? (v4u){0u, 0u, 0u, 0u} : st[i], f_);
            float sq_ = (f_[0] * f_[0] + f_[1] * f_[1]) + (f_[2] * f_[2] + f_[3] * f_[3]) + (f_[4] * f_[4] + f_[5] * f_[5]) + (f_[6] * f_[6] + f_[7] * f_[7]);
            sq_ += __shfl_xor(sq_, 1); sq_ += __shfl_xor(sq_, 2); sq_ += __shfl_xor(sq_, 4); sq_ += __shfl_xor(sq_, 8);
            const float rk_ = 1.0f / sqrtf(sq_ * (1.0f / 128.0f) + EPS) * 0.08838834764831845f;
            v4u o_; o_.x = cvtpk(f_[0] * rk_ * gk8[0], f_[1] * rk_ * gk8[1]); o_.y = cvtpk(f_[2] * rk_ * gk8[2], f_[3] * rk_ * gk8[3]); o_.z = cvtpk(f_[4] * rk_ * gk8[4], f_[5] * rk_ * gk8[5]); o_.w = cvtpk(f_[6] * rk_ * gk8[6], f_[7] * rk_ * gk8[7]);
            *(LAS v4u*)(lds + ((tid >> 4) + 32 * i) * DA_STRIDE + (tid & 15) * 16) = o_; }
        if (tid < 192) { const int dl = tid - 32; lbias[tid] = (dl >= 0 && dl <= 128) ? a.biasT[(U.br * 8 + h) * 132 + dl] * 1.4426950408889634f - 11.541560327111707f : -__builtin_inff(); }
        asm volatile("" ::: "memory");
        bf16x8 qf[8];
#pragma unroll
        for (int s = 0; s < 8; ++s) qf[s] = *(const bf16x8*)(a.QKV + qrow * OD_IN + h * 128 + 8 * h2 + 16 * s);
        da_load_rows(st, a.QKV, U, 2048, tid);
        float ss = 0.f;
#pragma unroll
        for (int s = 0; s < 8; ++s)
#pragma unroll
            for (int j = 0; j < 8; ++j) { const float xq = __uint_as_float((unsigned)(unsigned short)qf[s][j] << 16); ss += xq * xq; }
        ss += __shfl_xor(ss, 32);
        const float rsl = 1.0f / sqrtf(ss * (1.0f / 128.0f) + EPS) * 1.4426950408889634f;
        LDS_BARRIER();
        bf16x8 pf[5][2]; float den = 0.f;
#pragma unroll
        for (int kbi = 0; kbi < 5; ++kbi) {
            if (zfirst && w + kbi < 4) { pf[kbi][0] = (bf16x8){0, 0, 0, 0, 0, 0, 0, 0}; pf[kbi][1] = pf[kbi][0]; continue; }
            f32x16 acc;
#pragma unroll
            for (int i = 0; i < 16; ++i) acc[i] = 0.f;
            const LAS char* kp = lds + (32 * (w + kbi) + r) * DA_STRIDE + h2 * 16;
#pragma unroll
            for (int s = 0; s < 8; ++s) { const bf16x8 av = *(const LAS bf16x8*)(kp + s * 32); acc = MFMA32(av, qf[s], acc); }
            __builtin_amdgcn_sched_barrier(0);
            const LAS float* tb = lbias + (r_l - 4 * h2);
#pragma unroll
            for (int hh = 0; hh < 2; ++hh) { float p[8];
#pragma unroll
                for (int i8 = 0; i8 < 8; ++i8) { const int i = 8 * hh + i8;
                    p[i8] = __builtin_amdgcn_exp2f(acc[i] * rsl + tb[160 - 32 * kbi - ((i & 3) + 8 * (i >> 2))]); den += p[i8]; }
                pf[kbi][hh] = pack8(p[0], p[1], p[2], p[3], p[4], p[5], p[6], p[7]);
                __builtin_amdgcn_sched_barrier(0); }
            asm volatile("" ::: "memory");
        }
        den += __shfl_xor(den, 32);
        LDS_BARRIER();
#pragma unroll
        for (int i = 0; i < 12; ++i) *(LAS v4u*)(lds + ((tid >> 4) + 32 * i) * DA_VSTRIDE + (tid & 15) * 16) = (i < 4 && zfirst) ? (v4u){0u, 0u, 0u, 0u} : st[i];
        LDS_BARRIER();
        const int un = uu + G; const bool more = un < NUNITS; const DaUnit Un = da_decode<MODE>(more ? un : uu);
        if (more) da_load_rows(st, a.QKV, Un, 1024, tid);
        LAS char* stg = lds + DA_LDS_OSTG + w * DA_OSTG_WAVE;
        float inv = 1.0f;
        if (MODE == 0) { if (h2 == 0) ((float*)(U.br == 1 ? a.DEN1 : a.DEN2))[qrow * 8 + h] = den; }
        else { inv = 1.0f / (den + a.DEN1[qrow * 8 + h] + a.DEN2[qrow * 8 + h]); if (h2 == 0) ((LAS float*)(stg + 32 * 144))[r] = inv; }
        size_t goff[4];
#pragma unroll
        for (int i = 0; i < 4; ++i) { const int id = lane + 64 * i, row = id >> 3, ch = id & 7; goff[i] = (size_t)(U.b * SEQ + (l0 + 32 * w + row) * U.dil + U.cls) * D + h * 128 + ch * 8; }
#pragma unroll
        for (int half = 0; half < 2; ++half) {
            f32x16 o[2];
            v4u n1v[4], n2v[4];
            if (MODE == 1) {
#pragma unroll
                for (int i = 0; i < 4; ++i) { n1v[i] = *(const v4u*)(a.N1 + goff[i] + 64 * half); n2v[i] = *(const v4u*)(a.N2 + goff[i] + 64 * half); } }
#pragma unroll
            for (int vb = 0; vb < 2; ++vb)
#pragma unroll
                for (int i = 0; i < 16; ++i) o[vb][i] = 0.f;
#pragma unroll
            for (int kbi = 0; kbi < 5; ++kbi)
#pragma unroll
                for (int s = 0; s < 2; ++s)
#pragma unroll
                    for (int vb = 0; vb < 2; ++vb) { const bf16x8 av = tr_frag_perm(lds, DA_VSTRIDE, lbase, 32 * (w + kbi) + 16 * s, 64 * half + 32 * vb); o[vb] = MFMA32(av, pf[kbi][s], o[vb]); }
#pragma unroll
            for (int vb = 0; vb < 2; ++vb)
#pragma unroll
                for (int g4 = 0; g4 < 4; ++g4) { v2u wv; wv.x = cvtpk(o[vb][4 * g4], o[vb][4 * g4 + 1]); wv.y = cvtpk(o[vb][4 * g4 + 2], o[vb][4 * g4 + 3]); *(LAS v2u*)(stg + r * 144 + (32 * vb + 8 * g4 + 4 * h2) * 2) = wv; }
            asm volatile("s_waitcnt lgkmcnt(0)" ::: "memory");
            if (MODE == 0) {
                bf16* N = (bf16*)(U.br == 1 ? a.N1 : a.N2) + 64 * half;
#pragma unroll
                for (int i = 0; i < 4; ++i) { const int id = lane + 64 * i; *(v4u*)(N + goff[i]) = *(const LAS v4u*)(stg + (id >> 3) * 144 + (id & 7) * 16); }
            } else {
#pragma unroll
                for (int i = 0; i < 4; ++i) { const int id = lane + 64 * i; float fo[8], f1[8], f2[8]; unpack8(*(const LAS v4u*)(stg + (id >> 3) * 144 + (id & 7) * 16), fo); unpack8(n1v[i], f1); unpack8(n2v[i], f2);
                    const float iv = ((const LAS float*)(stg + 32 * 144))[id >> 3];
                    v4u ov; ov.x = cvtpk((fo[0] + f1[0] + f2[0]) * iv, (fo[1] + f1[1] + f2[1]) * iv); ov.y = cvtpk((fo[2] + f1[2] + f2[2]) * iv, (fo[3] + f1[3] + f2[3]) * iv);
                    ov.z = cvtpk((fo[4] + f1[4] + f2[4]) * iv, (fo[5] + f1[5] + f2[5]) * iv); ov.w = cvtpk((fo[6] + f1[6] + f2[6]) * iv, (fo[7] + f1[7] + f2[7]) * iv);
                    *(v4u*)(a.O + goff[i] + 64 * half) = ov; }
            }
            asm volatile("s_waitcnt lgkmcnt(0)" ::: "memory");
        }
        LDS_BARRIER();
        if (!more) break;
        uu = un;
    }
}

constexpr int MX_STRIDE = 272, MX_TSTRIDE = 320, MX_IMG = 128 * MX_TSTRIDE;
constexpr int MX_Q = 0, MX_K = MX_IMG, MX_V = 2 * MX_IMG, MX_SCR = 3 * MX_IMG, MX_OSTG = MX_SCR + 5120;
constexpr int MX_UNUSED0 = 0;
struct MixArgs { bf16* Z; const float* lb; const float* ret_g; const float* hg_g; bf16* SBUF; float* DECA; float* DECB; };

__device__ __forceinline__ void st_chunk8(LAS char* img, int stride, int row, int c0, const float (&f)[8]) {
    v4u o; o.x = cvtpk(f[0], f[1]); o.y = cvtpk(f[2], f[3]); o.z = cvtpk(f[4], f[5]); o.w = cvtpk(f[6], f[7]); *(LAS v4u*)(img + row * stride + c0 * 2) = o; }

__device__ __forceinline__ void ret_prep_tile(LAS char* img, int stride, const bf16* zrow  , int j, int cg, const float (&sn)[16], const float (&cs)[16], float sc) {
#pragma unroll
    for (int hc = 0; hc < 2; ++hc) { float x1[8], x2[8], o1[8], o2[8];
        unpack8(*(const v4u*)(zrow + 16 * cg + 8 * hc), x1); unpack8(*(const v4u*)(zrow + 64 + 16 * cg + 8 * hc), x2);
#pragma unroll
        for (int e = 0; e < 8; ++e) { o1[e] = (x1[e] * cs[8 * hc + e] - x2[e] * sn[8 * hc + e]) * sc; o2[e] = (x1[e] * sn[8 * hc + e] + x2[e] * cs[8 * hc + e]) * sc; }
        st_chunk8(img, stride, j, 16 * cg + 8 * hc, o1); st_chunk8(img, stride, j, 64 + 16 * cg + 8 * hc, o2); }
}
__device__ __forceinline__ void copy_tile(LAS char* img, int stride, const bf16* src, int tid) {
#pragma unroll
    for (int i = 0; i < 4; ++i) { const int id = tid + 512 * i, row = id >> 4, ch = id & 15; *(LAS v4u*)(img + row * stride + ch * 16) = *(const v4u*)(src + (size_t)row * EV_IN + ch * 8); }
}
__device__ __forceinline__ void hg_gates(const bf16* zrow_f  , const float* lbh  , int tid, LAS float* scr, float (&cum)[32], float (&kk)[32]) {
    const int lane = tid & 63, hw = (tid >> 6) & 1, cg = tid >> 7;
#pragma unroll
    for (int q = 0; q < 4; ++q) { float fl[8]; unpack8(*(const v4u*)(zrow_f + 32 * cg + 8 * q), fl);
#pragma unroll
        for (int e = 0; e < 8; ++e) { const float l = lbh[32 * cg + 8 * q + e]; const float f = l + (1.0f - l) * (1.0f / (1.0f + __expf(-fl[e]))); kk[8 * q + e] = 1.0f - f; cum[8 * q + e] = __logf(fmaxf(f, 1e-6f)); } }
#pragma unroll
    for (int off = 1; off < 64; off <<= 1) {
#pragma unroll
        for (int c = 0; c < 32; ++c) { const float t = __shfl_up(cum[c], off); if (lane >= off) cum[c] += t; } }
    if (hw == 0 && lane == 63) {
#pragma unroll
        for (int c = 0; c < 32; ++c) scr[32 * cg + c] = cum[c]; }
    __syncthreads();
    if (hw == 1) {
#pragma unroll
        for (int c = 0; c < 32; ++c) cum[c] += scr[32 * cg + c]; }
    if (hw == 1 && lane == 63) {
#pragma unroll
        for (int c = 0; c < 32; ++c) scr[128 + 32 * cg + c] = cum[c]; }
    __syncthreads();
}

__device__ __forceinline__ void load_prep4(v4u (&rw)[4], const bf16* zrow_seg, int mixer, int cg) {
#pragma unroll
    for (int q = 0; q < 4; ++q) { const int col = mixer == 0 ? ((q >> 1) * 64 + 16 * cg + 8 * (q & 1)) : (32 * cg + 8 * q); rw[q] = *(const v4u*)(zrow_seg + col); }
}
__device__ __forceinline__ void load_copy4(v4u (&rw)[4], const bf16* tile, int tid) {
#pragma unroll
    for (int i = 0; i < 4; ++i) { const int id = tid + 512 * i; rw[i] = *(const v4u*)(tile + (size_t)(id >> 4) * EV_IN + (id & 15) * 8); }
}
__device__ __forceinline__ void store_copy4(LAS char* img, int stride, const v4u (&rw)[4], int tid) {
#pragma unroll
    for (int i = 0; i < 4; ++i) { const int id = tid + 512 * i; *(LAS v4u*)(img + (id >> 4) * stride + (id & 15) * 16) = rw[i]; }
}
__device__ __forceinline__ void ret_prep_raw(LAS char* img, int stride, const v4u (&rw)[4], int j, int cg, const float (&sn)[16], const float (&cs)[16], float sc) {
#pragma unroll
    for (int hc = 0; hc < 2; ++hc) { float x1[8], x2[8], o1[8], o2[8]; unpack8(rw[hc], x1); unpack8(rw[2 + hc], x2);
#pragma unroll
        for (int e = 0; e < 8; ++e) { o1[e] = (x1[e] * cs[8 * hc + e] - x2[e] * sn[8 * hc + e]) * sc; o2[e] = (x1[e] * sn[8 * hc + e] + x2[e] * cs[8 * hc + e]) * sc; }
        st_chunk8(img, stride, j, 16 * cg + 8 * hc, o1); st_chunk8(img, stride, j, 64 + 16 * cg + 8 * hc, o2); }
}
__device__ __forceinline__ void hg_gates_raw(const v4u (&rw)[4], const float* lbh, int tid, LAS float* scr, float (&cum)[32], float (&kk)[32]) {
    const int lane = tid & 63, hw = (tid >> 6) & 1, cg = tid >> 7;
#pragma unroll
    for (int q = 0; q < 4; ++q) { float fl[8]; unpack8(rw[q], fl);
#pragma unroll
        for (int e = 0; e < 8; ++e) { const float l = lbh[32 * cg + 8 * q + e]; const float f = l + (1.0f - l) * (1.0f / (1.0f + __expf(-fl[e]))); kk[8 * q + e] = 1.0f - f; cum[8 * q + e] = __logf(fmaxf(f, 1e-6f)); } }
#pragma unroll
    for (int off = 1; off < 64; off <<= 1) {
#pragma unroll
        for (int c = 0; c < 32; ++c) { const float t = __shfl_up(cum[c], off); if (lane >= off) cum[c] += t; } }
    if (hw == 0 && lane == 63) {
#pragma unroll
        for (int c = 0; c < 32; ++c) scr[32 * cg + c] = cum[c]; }
    LDS_BARRIER();
    if (hw == 1) {
#pragma unroll
        for (int c = 0; c < 32; ++c) cum[c] += scr[32 * cg + c]; }
    if (hw == 1 && lane == 63) {
#pragma unroll
        for (int c = 0; c < 32; ++c) scr[128 + 32 * cg + c] = cum[c]; }
    LDS_BARRIER();
}
struct MixU { int mixer, b, h, n; };
__device__ __forceinline__ MixU mix_decode(int u) { MixU U; const int g = __builtin_amdgcn_readfirstlane(u >> 5); U.n = __builtin_amdgcn_readfirstlane(u & 31); U.mixer = g >> 4; U.b = (g >> 2) & 3; U.h = g & 3; return U; }

__device__ __forceinline__ void mixA_phase(LAS char* lds, const MixArgs& a, int bx, int G, int tid) {
    const int lane = tid & 63, w = __builtin_amdgcn_readfirstlane(tid >> 6), r = lane & 31, h2 = lane >> 5;
    const int j = tid & 127, cg = tid >> 7;
    LAS float* scr = (LAS float*)(lds + MX_SCR);
    int u = bx; if (u >= 1024) return;
    v4u rk[4], rv[4];
    { const MixU U = mix_decode(u); const bf16* zt = a.Z + (size_t)(U.b * SEQ + 128 * U.n) * EV_IN;
      load_prep4(rk, zt + (size_t)j * EV_IN + (U.mixer == 0 ? Z_RK : Z_GF) + U.h * 128, U.mixer, cg); load_copy4(rv, zt + (U.mixer == 0 ? Z_RV : Z_GI) + U.h * 128, tid); }
    for (;;) {
        const MixU U = mix_decode(u); const int h = U.h, n = U.n;
        if (U.mixer == 0) {
            const float gamma = 1.0f - exp2f(-5.0f - (float)h), lg2 = log2f(gamma);
            float sn[16], cs[16];
#pragma unroll
            for (int e = 0; e < 16; ++e) { const float inv = exp2f(-(float)(16 * cg + e) * (13.287712379549449f / 64.0f)); rope_sincos((float)(128 * n + j) * inv, sn[e], cs[e]); }
            ret_prep_raw(lds + MX_K, MX_TSTRIDE, rk, j, cg, sn, cs, 0.08838834764831845f * exp2f((float)(127 - j) * lg2));
            if (tid < 128) { a.DECA[(size_t)u * 128 + tid] = exp2f(128.0f * lg2); a.DECB[(size_t)u * 128 + tid] = gamma; }
        } else {
            float cum[32], kk[32];
            hg_gates_raw(rk, a.lb + h * 128, tid, scr, cum, kk);
#pragma unroll
            for (int q = 0; q < 4; ++q) { float o[8];
#pragma unroll
                for (int e = 0; e < 8; ++e) o[e] = kk[8 * q + e] * __expf(scr[128 + 32 * cg + 8 * q + e] - cum[8 * q + e]);
                st_chunk8(lds + MX_K, MX_TSTRIDE, j, 32 * cg + 8 * q, o); }
            if (tid < 128) { a.DECA[(size_t)u * 128 + tid] = __expf(scr[128 + tid]); a.DECB[(size_t)u * 128 + tid] = __expf(scr[tid]); }
        }
        store_copy4(lds + MX_V, MX_TSTRIDE, rv, tid);
        LDS_BARRIER();
        const int un = u + G; const bool more = un < 1024;
        if (more) { const MixU Un = mix_decode(un); const bf16* zt = a.Z + (size_t)(Un.b * SEQ + 128 * Un.n) * EV_IN;
            load_prep4(rk, zt + (size_t)j * EV_IN + (Un.mixer == 0 ? Z_RK : Z_GF) + Un.h * 128, Un.mixer, cg); load_copy4(rv, zt + (Un.mixer == 0 ? Z_RV : Z_GI) + Un.h * 128, tid); }
        const int lbn = tr_lane_base_nat(lane, MX_TSTRIDE); const int kbk = w >> 1, vb0 = 2 * (w & 1);
        f32x16 acc[2];
#pragma unroll
        for (int t = 0; t < 2; ++t)
#pragma unroll
            for (int i = 0; i < 16; ++i) acc[t][i] = 0.f;
#pragma unroll
        for (int s_ = 0; s_ < 8; ++s_) { const bf16x8 av = tr_frag_nat(lds + MX_K, MX_TSTRIDE, lbn, 16 * s_, 32 * kbk);
#pragma unroll
            for (int t = 0; t < 2; ++t) { const bf16x8 bv = tr_frag_nat(lds + MX_V, MX_TSTRIDE, lbn, 16 * s_, 32 * (vb0 + t)); acc[t] = MFMA32(av, bv, acc[t]); } }
        bf16* sb = a.SBUF + (size_t)u * 16384;
#pragma unroll
        for (int t = 0; t < 2; ++t)
#pragma unroll
            for (int g4 = 0; g4 < 4; ++g4) { v2u wv; wv.x = cvtpk(acc[t][4 * g4], acc[t][4 * g4 + 1]); wv.y = cvtpk(acc[t][4 * g4 + 2], acc[t][4 * g4 + 3]);
                *(v2u*)(sb + ((((((vb0 + t) * 8 + 2 * kbk + (g4 >> 1)) * 2 + (g4 & 1)) * 32 + r) * 8) + 4 * h2)) = wv; }
        LDS_BARRIER();
        if (!more) break;
        u = un;
    }
}

__device__ __forceinline__ void mixA_unit(LAS char* lds, const MixArgs& a, int u, int tid) {
    const int lane = tid & 63, w = __builtin_amdgcn_readfirstlane(tid >> 6), r = lane & 31, h2 = lane >> 5;
    const int g = u >> 5, n = u & 31, mixer = g >> 4, b = (g >> 2) & 3, h = g & 3;
    const int j = tid & 127, cg = tid >> 7;
    const bf16* zt = a.Z + (size_t)(b * SEQ + 128 * n) * EV_IN;
    LAS float* scr = (LAS float*)(lds + MX_SCR);
    if (mixer == 0) {
        const float gamma = 1.0f - exp2f(-5.0f - (float)h), lg2 = log2f(gamma);
        float sn[16], cs[16];
#pragma unroll
        for (int e = 0; e < 16; ++e) { const float inv = exp2f(-(float)(16 * cg + e) * (13.287712379549449f / 64.0f)); rope_sincos((float)(128 * n + j) * inv, sn[e], cs[e]); }
        ret_prep_tile(lds + MX_K, MX_TSTRIDE, zt + (size_t)j * EV_IN + Z_RK + h * 128, j, cg, sn, cs, 0.08838834764831845f * exp2f((float)(127 - j) * lg2));
        copy_tile(lds + MX_V, MX_TSTRIDE, zt + Z_RV + h * 128, tid);
        if (tid < 128) { a.DECA[(size_t)u * 128 + tid] = exp2f(128.0f * lg2); a.DECB[(size_t)u * 128 + tid] = gamma; }
    } else {
        float cum[32], kk[32];
        hg_gates(zt + (size_t)j * EV_IN + Z_GF + h * 128, a.lb + h * 128, tid, scr, cum, kk);
#pragma unroll
        for (int q = 0; q < 4; ++q) { float o[8];
#pragma unroll
            for (int e = 0; e < 8; ++e) o[e] = kk[8 * q + e] * __expf(scr[128 + 32 * cg + 8 * q + e] - cum[8 * q + e]);
            st_chunk8(lds + MX_K, MX_TSTRIDE, j, 32 * cg + 8 * q, o); }
        copy_tile(lds + MX_V, MX_TSTRIDE, zt + Z_GI + h * 128, tid);
        if (tid < 128) { a.DECA[(size_t)u * 128 + tid] = __expf(scr[128 + tid]); a.DECB[(size_t)u * 128 + tid] = __expf(scr[tid]); }
    }
    __syncthreads();
    const int lbn = tr_lane_base_nat(lane, MX_TSTRIDE); const int kbk = w >> 1, vb0 = 2 * (w & 1);
    f32x16 acc[2];
#pragma unroll
    for (int t = 0; t < 2; ++t)
#pragma unroll
        for (int i = 0; i < 16; ++i) acc[t][i] = 0.f;
#pragma unroll
    for (int s = 0; s < 8; ++s) { const bf16x8 av = tr_frag_nat(lds + MX_K, MX_TSTRIDE, lbn, 16 * s, 32 * kbk);
#pragma unroll
        for (int t = 0; t < 2; ++t) { const bf16x8 bv = tr_frag_nat(lds + MX_V, MX_TSTRIDE, lbn, 16 * s, 32 * (vb0 + t)); acc[t] = MFMA32(av, bv, acc[t]); } }
    bf16* sb = a.SBUF + (size_t)u * 16384;
#pragma unroll
    for (int t = 0; t < 2; ++t)
#pragma unroll
        for (int g4 = 0; g4 < 4; ++g4) { v2u wv; wv.x = cvtpk(acc[t][4 * g4], acc[t][4 * g4 + 1]); wv.y = cvtpk(acc[t][4 * g4 + 2], acc[t][4 * g4 + 3]);
            *(v2u*)(sb + ((((((vb0 + t) * 8 + 2 * kbk + (g4 >> 1)) * 2 + (g4 & 1)) * 32 + r) * 8) + 4 * h2)) = wv; }
    __syncthreads();
}

__device__ __forceinline__ void mix_scan(const MixArgs& a, int gtid, int nthreads, bool dry = false) {
    for (int e = gtid; e < 32 * 4096; e += nthreads) { const int g = e >> 12, el = e & 4095, dk4 = 4 * ((el >> 7) & 7) + 2 * ((el >> 6) & 1) + (el & 1);
        bf16* sp = a.SBUF + (size_t)(g * 32) * 16384 + (size_t)el * 4; const float* da = a.DECA + (size_t)(g * 32) * 128 + 4 * dk4; const float* db = a.DECB + (size_t)(g * 32) * 128 + 4 * dk4;
        f32x4 S = (f32x4){0.f, 0.f, 0.f, 0.f};
#pragma unroll 8
        for (int n = 0; n < 32; ++n) { const v2u kv = *(const v2u*)(sp + (size_t)n * 16384); const f32x4 A = *(const f32x4*)(da + n * 128), Bv = *(const f32x4*)(db + n * 128);
            const f32x4 so = S * Bv; v2u wv; wv.x = cvtpk(so[0], so[1]); wv.y = cvtpk(so[2], so[3]); if (!dry) *(v2u*)(sp + (size_t)n * 16384) = wv;
            S[0] = A[0] * S[0] + __uint_as_float(kv.x << 16); S[1] = A[1] * S[1] + __uint_as_float(kv.x & 0xffff0000u); S[2] = A[2] * S[2] + __uint_as_float(kv.y << 16); S[3] = A[3] * S[3] + __uint_as_float(kv.y & 0xffff0000u); }
    }
}

__device__ __forceinline__ void mixC_unit(LAS char* lds, const MixArgs& a, int u, int tid, bool dry = false) {
    const int lane = tid & 63, w = __builtin_amdgcn_readfirstlane(tid >> 6), r = lane & 31, h2 = lane >> 5;
    const int g = u >> 5, n = u & 31, mixer = g >> 4, b = (g >> 2) & 3, h = g & 3;
    const int j = tid & 127, cg = tid >> 7;
    bf16* zt = a.Z + (size_t)(b * SEQ + 128 * n) * EV_IN;
    LAS float* scr = (LAS float*)(lds + MX_SCR);
    if (mixer == 0) {
        const float gamma = 1.0f - exp2f(-5.0f - (float)h), lg2 = log2f(gamma);
        float sn[16], cs[16];
#pragma unroll
        for (int e = 0; e < 16; ++e) { const float inv = exp2f(-(float)(16 * cg + e) * (13.287712379549449f / 64.0f)); rope_sincos((float)(128 * n + j) * inv, sn[e], cs[e]); }
        ret_prep_tile(lds + MX_Q, MX_STRIDE, zt + (size_t)j * EV_IN + Z_RQ + h * 128, j, cg, sn, cs, exp2f((float)j * lg2));
        ret_prep_tile(lds + MX_K, MX_STRIDE, zt + (size_t)j * EV_IN + Z_RK + h * 128, j, cg, sn, cs, 0.08838834764831845f * exp2f(-(float)j * lg2));
        copy_tile(lds + MX_V, MX_TSTRIDE, zt + Z_RV + h * 128, tid);
    } else {
        float cum[32], kk[32];
        hg_gates(zt + (size_t)j * EV_IN + Z_GF + h * 128, a.lb + h * 128, tid, scr, cum, kk);
#pragma unroll
        for (int q = 0; q < 4; ++q) { float qv[8], oq[8], ok[8]; unpack8(*(const v4u*)(zt + (size_t)j * EV_IN + Z_GQ + h * 128 + 32 * cg + 8 * q), qv);
#pragma unroll
            for (int e = 0; e < 8; ++e) { const float d = cum[8 * q + e] - scr[32 * cg + 8 * q + e]; oq[e] = qv[e] * __expf(d); ok[e] = kk[8 * q + e] * __expf(-d); }
            st_chunk8(lds + MX_Q, MX_STRIDE, j, 32 * cg + 8 * q, oq); st_chunk8(lds + MX_K, MX_STRIDE, j, 32 * cg + 8 * q, ok); }
        copy_tile(lds + MX_V, MX_TSTRIDE, zt + Z_GI + h * 128, tid);
    }
    __syncthreads();
    const int vb = w >> 1; const int lbp = tr_lane_base(lane, MX_TSTRIDE);
    const bf16* sb = a.SBUF + (size_t)u * 16384 + (size_t)((vb * 16 + h2) * 32 + r) * 8;
    bf16x8 sf[8];
#pragma unroll
    for (int s = 0; s < 8; ++s) sf[s] = *(const bf16x8*)(sb + s * 512);
    f32x16 o[2]; float s1[2], s2[2];
    const float* rg_ = a.ret_g; const float* hg_ = a.hg_g; const float* gn = (mixer == 0 ? rg_ : hg_) + h * 128 + 32 * vb + 4 * h2;
    v4u gwv[4];
#pragma unroll
    for (int t = 0; t < 2; ++t) { const int ib = (w & 1) ? (1 + t) : (3 * t);
#pragma unroll
        for (int i = 0; i < 2; ++i) { const int id = lane + 64 * i; gwv[2 * t + i] = *(const v4u*)(zt + (size_t)(32 * ib + (id >> 2)) * EV_IN + (mixer == 0 ? Z_RG : Z_GG) + h * 128 + 32 * vb + 8 * (id & 3)); } }
#pragma unroll
    for (int t = 0; t < 2; ++t) {
        const int ib = (w & 1) ? (1 + t) : (3 * t);
        bf16x8 qf[8];
#pragma unroll
        for (int s = 0; s < 8; ++s) qf[s] = *(const LAS bf16x8*)(lds + MX_Q + (32 * ib + r) * MX_STRIDE + h2 * 16 + s * 32);
#pragma unroll
        for (int i = 0; i < 16; ++i) o[t][i] = 0.f;
#pragma unroll
        for (int s = 0; s < 8; ++s) o[t] = MFMA32(sf[s], qf[s], o[t]);
        for (int jb = 0; jb <= ib; ++jb) {
            f32x16 acc;
#pragma unroll
            for (int i = 0; i < 16; ++i) acc[i] = 0.f;
            const LAS char* kp = lds + MX_K + (32 * jb + r) * MX_STRIDE + h2 * 16;
#pragma unroll
            for (int s = 0; s < 8; ++s) { const bf16x8 av = *(const LAS bf16x8*)(kp + s * 32); acc = MFMA32(av, qf[s], acc); }
            if (jb == ib) {
#pragma unroll
                for (int i = 0; i < 16; ++i) { const int c = (i & 3) + 8 * (i >> 2) + 4 * h2; if (c > r) acc[i] = 0.f; } }
            const bf16x8 p0 = pack8(acc[0], acc[1], acc[2], acc[3], acc[4], acc[5], acc[6], acc[7]), p1 = pack8(acc[8], acc[9], acc[10], acc[11], acc[12], acc[13], acc[14], acc[15]);
            const bf16x8 v0 = tr_frag_perm(lds + MX_V, MX_TSTRIDE, lbp, 32 * jb, 32 * vb), v1 = tr_frag_perm(lds + MX_V, MX_TSTRIDE, lbp, 32 * jb + 16, 32 * vb);
            o[t] = MFMA32(v0, p0, o[t]); o[t] = MFMA32(v1, p1, o[t]);
        }
        float a1 = 0.f, a2 = 0.f;
#pragma unroll
        for (int i = 0; i < 16; ++i) { a1 += o[t][i]; a2 += o[t][i] * o[t][i]; }
        a1 += __shfl_xor(a1, 32); a2 += __shfl_xor(a2, 32); s1[t] = a1; s2[t] = a2;
        if (h2 == 0) { scr[256 + (vb * 128 + 32 * ib + r) * 2] = a1; scr[256 + (vb * 128 + 32 * ib + r) * 2 + 1] = a2; }
    }
    LDS_BARRIER();
#pragma unroll
    for (int t = 0; t < 2; ++t) {
        const int ib = (w & 1) ? (1 + t) : (3 * t); const int tok = 32 * ib + r;
        float t1 = 0.f, t2 = 0.f;
#pragma unroll
        for (int v = 0; v < 4; ++v) { t1 += scr[256 + (v * 128 + tok) * 2]; t2 += scr[256 + (v * 128 + tok) * 2 + 1]; }
        float mu = 0.f, rstd;
        if (mixer == 0) { mu = t1 * (1.0f / 128.0f); rstd = 1.0f / sqrtf(fmaxf(t2 * (1.0f / 128.0f) - mu * mu, 0.f) + EPS); } else rstd = 1.0f / sqrtf(t2 * (1.0f / 128.0f) + EPS);
        bf16* zr = zt + (size_t)tok * EV_IN;
        (void)zr;
        LAS char* tile = lds + MX_OSTG + w * 2560;
#pragma unroll
        for (int i = 0; i < 2; ++i) { const int id = lane + 64 * i; *(LAS v4u*)(tile + (id >> 2) * 80 + (id & 3) * 16) = gwv[2 * t + i]; }
        asm volatile("s_waitcnt lgkmcnt(0)" ::: "memory");
#pragma unroll
        for (int g4 = 0; g4 < 4; ++g4) { const v2u gw = *(const LAS v2u*)(tile + r * 80 + (8 * g4 + 4 * h2) * 2); const f32x4 gv = *(const f32x4*)(gn + 8 * g4);
            const float ga[4] = {__uint_as_float(gw.x << 16), __uint_as_float(gw.x & 0xffff0000u), __uint_as_float(gw.y << 16), __uint_as_float(gw.y & 0xffff0000u)}; float y[4];
#pragma unroll
            for (int e = 0; e < 4; ++e) { y[e] = (o[t][4 * g4 + e] - mu) * rstd * gv[e] * (ga[e] / (1.0f + __expf(-ga[e]))); }
            v2u wv; wv.x = cvtpk(y[0], y[1]); wv.y = cvtpk(y[2], y[3]); *(LAS v2u*)(tile + r * 80 + (8 * g4 + 4 * h2) * 2) = wv; }
        asm volatile("s_waitcnt lgkmcnt(0)" ::: "memory");
#pragma unroll
        for (int i = 0; i < 2; ++i) { const int id = lane + 64 * i; const v4u yv = *(const LAS v4u*)(tile + (id >> 2) * 80 + (id & 3) * 16);
            if (!dry) *(v4u*)(zt + (size_t)(32 * ib + (id >> 2)) * EV_IN + (mixer == 0 ? Z_RQ : Z_GQ) + h * 128 + 32 * vb + 8 * (id & 3)) = yv; }
        asm volatile("s_waitcnt lgkmcnt(0)" ::: "memory");
    }
    __syncthreads();
}


__device__ __forceinline__ float gelu_tanh(float x) { const float u = 0.7978845608028654f * (x + 0.044715f * x * x * x); const float t = 1.0f - 2.0f / (1.0f + __expf(2.0f * u)); return 0.5f * x * (1.0f + t); }
__device__ __forceinline__ void ffn_ew(const bf16* GU, const float* cw, const float* cb, bf16* H, int rows, int gtid, int nthreads) {
    for (int idx = gtid; idx < rows * (DFF / 8); idx += nthreads) {
        const int row = idx / (DFF / 8), c0 = (idx % (DFF / 8)) * 8, t = row % SEQ;
        float g0[8], g1[8], g2[8], u[8];
        unpack8(*(const v4u*)(GU + (size_t)row * (2 * DFF) + c0), g2); unpack8(*(const v4u*)(GU + (size_t)row * (2 * DFF) + DFF + c0), u);
        if (t >= 1) unpack8(*(const v4u*)(GU + (size_t)(row - 1) * (2 * DFF) + c0), g1); else { for (int i = 0; i < 8; ++i) g1[i] = 0.f; }
        if (t >= 2) unpack8(*(const v4u*)(GU + (size_t)(row - 2) * (2 * DFF) + c0), g0); else { for (int i = 0; i < 8; ++i) g0[i] = 0.f; }
        float r[8];
#pragma unroll
        for (int i = 0; i < 8; ++i) { const float y = cw[c0 + i] * g0[i] + cw[DFF + c0 + i] * g1[i] + cw[2 * DFF + c0 + i] * g2[i] + cb[c0 + i]; r[i] = gelu_tanh(y) * u[i]; }
        v4u o; o.x = cvtpk(r[0], r[1]); o.y = cvtpk(r[2], r[3]); o.z = cvtpk(r[4], r[5]); o.w = cvtpk(r[6], r[7]);
        *(v4u*)(H + (size_t)row * DFF + c0) = o;
    }
}

constexpr int LDS_BYTES = 163840;
constexpr int LDSCTL_OFF = LDS_BYTES - 512;
constexpr int CW_BAR = 4096;
constexpr size_t CTL_ZERO_BYTES = 1 * MiB;
#define XB_TMO      128
#define XB_XCNT(j)  (256  + 64 * (j))
#define XB_XSUB(j)  (1280 + 64 * (j))
#define XB_XGEN(j)  (2304 + 64 * (j))
#define XB_TOP      3328
#define XB_TOPGEN   3392
#define XCD_BAR_WORDS 3456
#define XB_SPIN_CAP (1u << 18)

__device__ __forceinline__ unsigned xb_ld(unsigned* p)              { return __hip_atomic_load(p, __ATOMIC_RELAXED, __HIP_MEMORY_SCOPE_AGENT); }
__device__ __forceinline__ unsigned xb_add(unsigned* p, unsigned v) { return __hip_atomic_fetch_add(p, v, __ATOMIC_RELAXED, __HIP_MEMORY_SCOPE_AGENT); }
__device__ __forceinline__ unsigned xb_xcc_id() { return (unsigned)__builtin_amdgcn_s_getreg((3 << 11) | 20) & 0xFu; }
#define XB_SPIN(cond, bar) do { unsigned _sp = 0; while (cond) { __builtin_amdgcn_s_sleep(1); \
    if ((++_sp & 255u) == 0u) { if (xb_ld(&(bar)[XB_TMO])) break; if (_sp > XB_SPIN_CAP) { atomicAdd(&(bar)[XB_TMO], 1u); break; } } } } while (0)

struct XcdBarrier {
    unsigned* bar; unsigned x;
    volatile LAS unsigned* st;
};

__device__ __forceinline__ XcdBarrier xcd_barrier_post(unsigned* bar, volatile LAS unsigned* st) {
    XcdBarrier b; b.bar = bar; b.x = xb_xcc_id(); b.st = st;
    if (threadIdx.x == 0) (void)xb_add(&bar[XB_XCNT(b.x)], 1u);
    return b;
}
__device__ __forceinline__ void xcd_barrier_complete(unsigned* bar, unsigned x, unsigned& nloc, unsigned& nx) {
    const unsigned G = gridDim.x * gridDim.y * gridDim.z;
    unsigned sum, cnt, mine, sp = 0u;
    for (;;) {
        sum = 0u; cnt = 0u; mine = 0u;
#pragma unroll
        for (unsigned j = 0; j < 16; ++j) { const unsigned c = xb_ld(&bar[XB_XCNT(j)]); sum += c; cnt += (c > 0u) ? 1u : 0u; mine = (j == x) ? c : mine; }
        if (sum == G) break;
        __builtin_amdgcn_s_sleep(1);
        if ((++sp & 255u) == 0u) { if (xb_ld(&bar[XB_TMO])) break; if (sp > XB_SPIN_CAP) { atomicAdd(&bar[XB_TMO], 1u); break; } }
    }
    nloc = mine > 0u ? mine : 1u; nx = cnt > 0u ? cnt : 1u;
}

__device__ __forceinline__ void xcd_barrier(const XcdBarrier& b) {
    asm volatile("s_waitcnt vmcnt(0)" ::: "memory");
    __syncthreads();
    if (threadIdx.x == 0) {
        unsigned* bar = b.bar;
        __builtin_amdgcn_s_waitcnt(0);
        unsigned nloc = b.st[0], nx = b.st[1];
        if (nloc == 0u) { xcd_barrier_complete(bar, b.x, nloc, nx); b.st[0] = nloc; b.st[1] = nx; }
        const unsigned old = xb_add(&bar[XB_XSUB(b.x)], 1u);
        const unsigned gen = old / nloc;
        if (old + 1u == (gen + 1u) * nloc) {
            __builtin_amdgcn_fence(__ATOMIC_RELEASE, "agent");
            asm volatile("s_waitcnt vmcnt(0)" ::: "memory");
            const unsigned og = xb_add(&bar[XB_TOP], 1u);
            const unsigned tg = og / nx;
            if (og + 1u == (tg + 1u) * nx) xb_add(&bar[XB_TOPGEN], 1u);
            else XB_SPIN(xb_ld(&bar[XB_TOPGEN]) == tg, bar);
            __builtin_amdgcn_fence(__ATOMIC_ACQUIRE, "agent");
            xb_add(&bar[XB_XGEN(b.x)], 1u);
            asm volatile("s_waitcnt vmcnt(0)" ::: "memory");
        } else {
            XB_SPIN(xb_ld(&bar[XB_XGEN(b.x)]) == gen, bar);
            __builtin_amdgcn_fence(__ATOMIC_ACQUIRE, "agent");
            asm volatile("s_waitcnt vmcnt(0)" ::: "memory");
        }
    }
    __syncthreads();
}


__device__ __forceinline__ GAS unsigned char* launder_s(unsigned char* p) { unsigned long long v = (unsigned long long)p; asm volatile("" : "+s"(v)); return (GAS unsigned char*)v; }
__device__ __forceinline__ GAS float* launder_sf(float* p) { unsigned long long v = (unsigned long long)p; asm volatile("" : "+s"(v)); return (GAS float*)v; }
struct FwdArgs { const float* in[25]; float* out; unsigned char* ws; int ph_lo, ph_hi, li, pad; };
__global__ void __launch_bounds__(512, 2) fwd(FwdArgs a) {
    extern __shared__ __attribute__((aligned(16))) unsigned char lds_raw[];
    LAS unsigned char* lds = (LAS unsigned char*)lds_raw;
    const int tid = threadIdx.x, lane = tid & 63, wave = __builtin_amdgcn_readfirstlane(tid >> 6);
    const int G = gridDim.x, bx = blockIdx.x;
    volatile LAS unsigned* MISC = (volatile LAS unsigned*)(lds + LDSCTL_OFF);
    if (tid < 64) MISC[tid] = 0u;
    __syncthreads();
#define WSP (launder_s(a.ws))
#define OUTP (launder_sf(a.out))
    XcdBarrier bar = xcd_barrier_post((unsigned*)(WSP + WS_CTL) + CW_BAR + a.li * XCD_BAR_WORDS, MISC + 8);
    int ph = 0; const int lo = a.ph_lo, hi = a.ph_hi;
#define PH_ON true) for (int rp_ = 0, nr_ = (ph >= lo && ph < hi) ? 1 + ((a.pad >> ph) & 1) : 0; rp_ < nr_; ++rp_, __syncthreads()
#define TID_L ({ int l_; asm volatile("v_mbcnt_lo_u32_b32 %0, -1, 0\n\tv_mbcnt_hi_u32_b32 %0, -1, %0" : "=v"(l_)); wave * 64 + l_; })
#define PH_END do { if (ph >= lo && ph + 1 < hi) xcd_barrier(bar); ++ph; } while (0)
#define XB ((bf16*)(WSP + WS_XB))
#define SSQP ((float*)(WSP + WS_SSQP))
#define ACT ((bf16*)(WSP + WS_ACT))

    if (PH_ON) { ProArgs pa;
#pragma unroll
        for (int i = 0; i < 25; ++i) pa.in[i] = a.in[i];
        pa.ws = (unsigned char*)WSP; pa.layer_mask = 3; pa.ffn_mode = 2;
        { const int t_ = TID_L; prologue_body(pa, bx * 8 + (t_ >> 6), G * 8, t_ & 63, (LAS float*)lds + (t_ >> 6) * 64 * 65); } }
    PH_END;

    for (int l = 0; l < 2; ++l) {
        if (PH_ON) {
            { pg8::Gemm g{XB, (const bf16*)(WSP + (l ? WS_ODIN : WS_EVIN)), M, l ? OD_IN : EV_IN, D, D}; pg8::EpiBf16S E{ACT, SSQP, l ? OD_IN : EV_IN, M, EPS, 0};
              pg8::StaticOrder S; S.init(g.M, g.N, G, bx); pg8::gemm_phase<pg8::EpiBf16S, pg8::StaticOrder, true, true>(lds, g, S, E, TID_L); }
        }
        PH_END;
        const bf16* mixo; int mixo_ld;
        if (l == 0) {
            MixArgs ma{ACT, (const float*)(WSP + WS_LB), a.in[4], a.in[5], (bf16*)OUTP, (float*)(WSP + WS_DECA), (float*)(WSP + WS_DECB)};
            if (PH_ON) mixA_phase((LAS char*)lds, ma, bx, G, TID_L);
            PH_END;
            if (PH_ON) {
                if (bx < 64 && G > 64) { const int lm = bx >> 5;
                    pg8::Gemm g{(const bf16*)(WSP + (lm ? WS_MEMH1 : WS_MEMH0)), (const bf16*)(WSP + (lm ? WS_XKV1 : WS_XKV0)), MM, 2 * D, D, D}; pg8::EpiBf16S E{(bf16*)(WSP + (lm ? WS_MKV1 : WS_MKV0)), nullptr, 2 * D, M, EPS, 0};
                    pg8::StaticOrder S; S.init(g.M, g.N, G, bx & 31); pg8::gemm_phase<pg8::EpiBf16S, pg8::StaticOrder, true, true>(lds, g, S, E, TID_L); }
                else mix_scan(ma, (bx - 64) * 512 + TID_L, (G - 64) * 512, rp_ + 1 < nr_);
            }
            PH_END;
            if (PH_ON) { for (int u = bx; u < 1024; u += G) mixC_unit((LAS char*)lds, ma, u, TID_L, rp_ + 1 < nr_); }
            PH_END;
            mixo = ACT; mixo_ld = EV_IN;
        } else {
            bf16* O = (bf16*)(WSP + WS_ACT + 96 * MiB);
            DaArgs da; da.QKV = ACT; da.biasT = (const float*)(WSP + WS_BIAST); da.gkq = (const float*)(WSP + WS_GOD); da.N0 = (bf16*)(WSP + WS_N2); da.DEN0 = (float*)(WSP + WS_DEN23);
            da.N1 = (const bf16*)(WSP + WS_N2); da.DEN1 = (const float*)(WSP + WS_DEN23); da.N2 = (const bf16*)OUTP; da.DEN2 = (const float*)(WSP + WS_DEN23) + (size_t)M * 8; da.O = O; da.br0 = 1; da.nbr = 2; da.mode = 0; da.pad = 0;
            if (PH_ON) dattn_phase<0>((LAS char*)lds, da, bx, G, TID_L);
            PH_END;
            if (PH_ON) dattn_phase<1>((LAS char*)lds, da, bx, G, TID_L);
            PH_END;
            mixo = O; mixo_ld = D;
        }
        if (PH_ON) { pg8::Gemm g{mixo, (const bf16*)(WSP + (l ? WS_ODOUT : WS_EVOUT)), M, D, D, mixo_ld}; pg8::EpiResid E{l ? (const float*)nullptr : a.in[0], nullptr, XB, SSQP, D, M};
            pg8::StaticOrder S; S.init(g.M, g.N, G, bx); pg8::gemm_phase<pg8::EpiResid, pg8::StaticOrder, false, true>(lds, g, S, E, TID_L); }
        PH_END;
        { bf16* O = (bf16*)(WSP + WS_ACT + 32 * MiB);
          if (PH_ON) { pg8::Gemm g{XB, (const bf16*)(WSP + (l ? WS_XQ1 : WS_XQ0)), M, D, D, D}; EpiXattn E{(const bf16*)(WSP + (l ? WS_MKV1 : WS_MKV0)), (const float*)(WSP + WS_GXA) + l * 256, O};
              pg8::StaticOrder S; S.init(g.M, g.N, G, bx); pg8::gemm_phase<EpiXattn, pg8::StaticOrder, false, true>(lds, g, S, E, TID_L);
              pg8::StaticOrder S2; S2.init(M, D, G, bx); pg8::Unit uq; if (S2.next(0, uq)) xattn_unit<true>((LAS char*)lds, nullptr, (const bf16*)(WSP + (l ? WS_MKV1 : WS_MKV0)), (const float*)(WSP + WS_GXA) + l * 256, O, uq.pm * 4 + uq.pn, TID_L); }
          PH_END;
          if (PH_ON) { pg8::Gemm g{O, (const bf16*)(WSP + (l ? WS_XO1 : WS_XO0)), M, D, D, D}; pg8::EpiResid E{nullptr, nullptr, XB, SSQP, D, M};
              pg8::StaticOrder S; S.init(g.M, g.N, G, bx); pg8::gemm_phase<pg8::EpiResid, pg8::StaticOrder, false, true>(lds, g, S, E, TID_L); }
          PH_END; }
        { bf16* H = ACT;
          if (PH_ON) { pg8::Gemm g{XB, (const bf16*)(WSP + (l ? WS_FIN1 : WS_FIN0)), 68 * 256, 2 * DFF, D, D}; pg8::EpiFfn E{H, SSQP, a.in[22] + (size_t)l * 3 * DFF, a.in[23] + (size_t)l * DFF, M, EPS};
              pg8::FfnOrder S; S.init(g.M, g.N, G, bx); pg8::gemm_phase<pg8::EpiFfn, pg8::FfnOrder, true, true>(lds, g, S, E, TID_L); }
          PH_END;
          if (PH_ON) { pg8::Gemm g{H, (const bf16*)(WSP + (l ? WS_FOUT1 : WS_FOUT0)), M, D, DFF, DFF}; pg8::EpiResid E{nullptr, l ? (float*)OUTP : (float*)nullptr, XB, SSQP, D, M};
              pg8::StaticOrder S; S.init(g.M, g.N, G, bx); pg8::gemm_phase<pg8::EpiResid, pg8::StaticOrder, false, true>(lds, g, S, E, TID_L); }
          PH_END; }
    }
#undef PH_ON
#undef PH_END
#undef TID_L
#undef WSP
#undef OUTP
#undef XB
#undef SSQP
#undef ACT
}
constexpr int N_PHASES = 1 + 9 + 8;

#ifndef PROBE_MASK
#define PROBE_MASK 0
#endif
#ifndef MK_PER_PHASE
#define MK_PER_PHASE 0
#endif
extern "C" void kernel_launch(void* const* d_in, const int* in_sizes, int n_in, void* d_out, int out_size, void* d_ws, size_t ws_size, hipStream_t stream) {
    static int inited = 0;
    if (!inited) {
        if (n_in != 25 || out_size != M * D || ws_size < WS_END) { fprintf(stderr, "kernel_launch: unexpected shapes (n_in %d, out %d, ws %zu)\n", n_in, out_size, ws_size); inited = -1; return; }
        if (hipFuncSetAttribute((const void*)fwd, hipFuncAttributeMaxDynamicSharedMemorySize, LDS_BYTES) != hipSuccess) { fprintf(stderr, "kernel_launch: hipFuncSetAttribute failed\n"); inited = -1; return; }
        inited = 1;
    }
    if (inited < 0) return;
    if (hipMemsetAsync((char*)d_ws + WS_CTL, 0, CTL_ZERO_BYTES, stream) != hipSuccess) return;
    FwdArgs fa{}; for (int i = 0; i < 25; ++i) fa.in[i] = (const float*)d_in[i]; fa.out = (float*)d_out; fa.ws = (unsigned char*)d_ws; fa.pad = PROBE_MASK;
#if MK_PER_PHASE
    for (int p = 0; p < N_PHASES; ++p) { fa.ph_lo = p; fa.ph_hi = p + 1; fa.li = 0; hipLaunchKernelGGL(fwd, dim3(256), dim3(512), LDS_BYTES, stream, fa); }
#else
    fa.ph_lo = 0; fa.ph_hi = N_PHASES; fa.li = 0; hipLaunchKernelGGL(fwd, dim3(256), dim3(512), LDS_BYTES, stream, fa);
#endif
}
```

```cpp
#include <hip/hip_runtime.h>
#include <cstdio>
#include <cstdint>
namespace pg8 {
#define PG8_LAS __attribute__((address_space(3)))
typedef unsigned short bf16_t;
typedef short bf16x8 __attribute__((ext_vector_type(8)));
typedef float f32x4 __attribute__((ext_vector_type(4)));
typedef unsigned u32x4 __attribute__((ext_vector_type(4)));
constexpr int BM = 256, BK = 64, HALF = 128, HTB = HALF * BK * 2  , STAGE_BYTES = 8 * HTB, NXCD = 8, WGM = 8;
constexpr int SSQ_LDS = STAGE_BYTES + 4096, CW_LDS = STAGE_BYTES + 8192;

__host__ __device__ __forceinline__ int lds_byte(int r, int c) { const int st = (r >> 4) * 2 + (c >> 5), rr = r & 15, cc = c & 31, ob = rr * 64 + cc * 2; return st * 1024 + (ob ^ (((ob >> 9) & 1) << 5)); }
__host__ __device__ __forceinline__ void stage_rc(int b, int& R, int& C) { const int st = b / 1024, sb = b % 1024, swz = sb ^ (((sb >> 9) & 1) << 5); R = (st >> 1) * 16 + swz / 64; C = (st & 1) * 32 + (swz % 64) / 2; }
__host__ __device__ __forceinline__ int perm32(int rho) { const int n = rho >> 4, i = rho & 15; return 8 * (i >> 2) + 4 * n + (i & 3); }

struct Unit { int pm, pn; };
struct Gemm { const bf16_t* A; const bf16_t* Bt; int M, N, K, lda; };

struct StaticOrder {
    int nM, nN, nwg, G, c, wgm;
    __host__ __device__ __forceinline__ void init(int M, int N, int G_, int c_, int wgm_ = 4) { nM = M / BM; nN = N / BM; nwg = nM * nN; G = G_; c = c_; wgm = wgm_; }
    __host__ __device__ __forceinline__ bool next(int i, Unit& u) const {
        const long L = (long)i * G + c; if (L >= nwg) return false;
        int wgid = (int)L; { const int q = nwg / NXCD, r = nwg % NXCD, xcd = wgid % NXCD, off = wgid / NXCD; wgid = (xcd < r ? xcd * (q + 1) : r * (q + 1) + (xcd - r) * q) + off; }
        const int nig = wgm * nN, gid = wgid / nig, fm = gid * wgm, gsz = (nM - fm) < wgm ? (nM - fm) : wgm;
        u.pm = fm + ((wgid % nig) % gsz); u.pn = (wgid % nig) / gsz; return true;
    }
    __device__ __forceinline__ void a_ready(const Unit&) const {}
    __device__ __forceinline__ void done(const Unit&) const {}
    __device__ __forceinline__ int arow(const Unit& u) const { return u.pm * BM; }
};
struct FfnOrder : StaticOrder {
    __device__ __forceinline__ int arow(const Unit& u) const { return (u.pm / 17) * 4096 + 254 * (u.pm % 17) - 2; }
};

__device__ __forceinline__ unsigned cvt_pk_bf16(float lo, float hi) { unsigned r; asm volatile("v_cvt_pk_bf16_f32 %0, %1, %2" : "=v"(r) : "v"(lo), "v"(hi)); return r; }
typedef float f32x2 __attribute__((ext_vector_type(2)));
struct EpiBf16S {
    static constexpr int PERM = 3; static constexpr bool AFTER_DRAIN = false;
    bf16_t* O; const float* ssqp; int ldc; int Mtot; float eps; int pad;
    __device__ __forceinline__ void preload(PG8_LAS unsigned char* lds, const Unit& u, int wr, int wc, int lane) const {
        if (!ssqp) return;
#pragma unroll
        for (int ai = 0; ai < 2; ++ai) __builtin_amdgcn_global_load_lds((const unsigned*)(ssqp + (size_t)wc * Mtot + u.pm * BM + ai * HALF + wr * 64 + lane), (PG8_LAS unsigned*)(lds + SSQ_LDS + (((wr * 2 + ai) * 4 + wc) * 64) * 4), 4, 0, 0);
    }
    __device__ __forceinline__ void preload_unit(PG8_LAS unsigned char*, const Unit&, int, int, int) const {}
    __device__ __forceinline__ void operator()(f32x4 (&acc)[2][2][4][2], const Unit& u, int wr, int wc, int fr, int fq, PG8_LAS unsigned char* lds) const {
        const int row0 = u.pm * BM + wr * 64 + fr; const int col0 = u.pn * BM + wc * 64 + 8 * fq;
        const PG8_LAS float* sl = (const PG8_LAS float*)(lds + SSQ_LDS);
#pragma unroll
        for (int ai = 0; ai < 2; ++ai)
#pragma unroll
            for (int m = 0; m < 4; ++m) { const int row = row0 + ai * HALF + m * 16; float rs = 1.f;
                if (ssqp) { const PG8_LAS float* sp = sl + ((wr * 2 + ai) * 4) * 64 + m * 16 + fr; const float s = (sp[0] + sp[64]) + (sp[128] + sp[192]); rs = 1.0f / sqrtf(s * (1.0f / 1024.0f) + eps); }
                bf16_t* rowp = O + (size_t)row * ldc + col0;
#pragma unroll
                for (int bj = 0; bj < 2; ++bj) { const f32x4 v0 = acc[ai][bj][m][0] * rs, v1 = acc[ai][bj][m][1] * rs;
                    u32x4 w; w.x = cvt_pk_bf16(v0[0], v0[1]); w.y = cvt_pk_bf16(v0[2], v0[3]); w.z = cvt_pk_bf16(v1[0], v1[1]); w.w = cvt_pk_bf16(v1[2], v1[3]);
                    *(u32x4*)(rowp + bj * 32) = w; } }
    }
};

__device__ __forceinline__ float gelu_tanh_f(float x) { const float u = 0.7978845608028654f * (x + 0.044715f * x * x * x); const float t = 1.0f - 2.0f / (1.0f + __expf(2.0f * u)); return 0.5f * x * (1.0f + t); }
struct EpiFfn {
    static constexpr int PERM = 1; static constexpr bool AFTER_DRAIN = false;
    bf16_t* H; const float* ssqp; const float* cw; const float* cb; int Mtot; float eps;
    __device__ __forceinline__ void preload(PG8_LAS unsigned char* lds, const Unit& u, int wr, int wc, int lane) const {
        const int rowb = (u.pm / 17) * 4096 + 254 * (u.pm % 17) - 2;
#pragma unroll
        for (int ai = 0; ai < 2; ++ai) { const int row = rowb + ai * HALF + wr * 64 + lane; const int rc = row < 0 ? 0 : (row >= Mtot ? Mtot - 1 : row);
            __builtin_amdgcn_global_load_lds((const unsigned*)(ssqp + (size_t)wc * Mtot + rc), (PG8_LAS unsigned*)(lds + SSQ_LDS + (((wr * 2 + ai) * 4 + wc) * 64) * 4), 4, 0, 0); }
    }
    __device__ __forceinline__ void preload_unit(PG8_LAS unsigned char* lds, const Unit& u, int wr, int wc, int lane) const {
        const float* src = (wc < 3 ? cw + (size_t)wc * 2816 : cb) + u.pn * 128 + 64 * wr + lane;
        __builtin_amdgcn_global_load_lds((const unsigned*)src, (PG8_LAS unsigned*)(lds + CW_LDS + (wc * 128 + 64 * wr) * 4), 4, 0, 0);
    }
    __device__ __forceinline__ void operator()(f32x4 (&acc)[2][2][4][2], const Unit& u, int wr, int wc, int fr, int fq, PG8_LAS unsigned char* lds) const {
        constexpr int DFF_ = 2816;
        const int b = u.pm / 17, t = u.pm % 17, pos0 = 254 * t - 2, rowb = b * 4096 + pos0;
        const int colh = u.pn * 128 + wc * 32 + 8 * fq, lane = fq * 16 + fr;
        PG8_LAS float* halo = (PG8_LAS float*)(lds + STAGE_BYTES);
#pragma unroll
        for (int ai = 0; ai < 2; ++ai)
#pragma unroll
            for (int m = 0; m < 4; ++m) { const int rl = ai * HALF + wr * 64 + m * 16 + fr; const PG8_LAS float* sp = (const PG8_LAS float*)(lds + SSQ_LDS) + ((wr * 2 + ai) * 4) * 64 + m * 16 + fr;
                const float sq = (sp[0] + sp[64]) + (sp[128] + sp[192]); const float rs = 1.0f / sqrtf(sq * (1.0f / 1024.0f) + eps); const bool pad = (pos0 + rl) < 0;
#pragma unroll
                for (int n = 0; n < 2; ++n) {
#pragma unroll
                    for (int e = 0; e < 4; ++e) { acc[ai][0][m][n][e] = pad ? 0.f : acc[ai][0][m][n][e] * rs; acc[ai][1][m][n][e] *= rs; } } }
#pragma unroll
        for (int ai = 0; ai < 2; ++ai) if (fr >= 14) { PG8_LAS float* hp = halo + ((((2 * ai + wr) * 4 + wc) * 4 + fq) * 2 + (fr - 14)) * 8;
            *(PG8_LAS f32x4*)hp = acc[ai][0][3][0]; *(PG8_LAS f32x4*)(hp + 4) = acc[ai][0][3][1]; }
        asm volatile("s_waitcnt lgkmcnt(0)" ::: "memory"); __builtin_amdgcn_s_barrier(); asm volatile("" ::: "memory");
        typedef unsigned u32x2e __attribute__((ext_vector_type(2)));
#define DPPF(x, ctrl) __builtin_bit_cast(float, __builtin_amdgcn_update_dpp(0, __builtin_bit_cast(int, (x)), (ctrl), 0xf, 0xf, true))
        u32x2e hold[2][4];
#pragma unroll
        for (int n = 0; n < 2; ++n) {
            const PG8_LAS float* cwl = (const PG8_LAS float*)(lds + CW_LDS) + wc * 32 + 8 * fq + 4 * n;
            const f32x4 w0 = *(const PG8_LAS f32x4*)cwl, w1 = *(const PG8_LAS f32x4*)(cwl + 128), w2 = *(const PG8_LAS f32x4*)(cwl + 256), bb = *(const PG8_LAS f32x4*)(cwl + 384);
#pragma unroll
            for (int ai = 0; ai < 2; ++ai) {
                const int blk = 2 * ai + wr; f32x4 R1p = (f32x4){0.f, 0.f, 0.f, 0.f}, R2p = (f32x4){0.f, 0.f, 0.f, 0.f};
                if (blk >= 1) { const PG8_LAS float* hp = halo + ((((blk - 1) * 4 + wc) * 4 + fq) * 2) * 8 + 4 * n; const f32x4 h62 = *(const PG8_LAS f32x4*)hp, h63 = *(const PG8_LAS f32x4*)(hp + 8);
                    const f32x4 z4 = (f32x4){0.f, 0.f, 0.f, 0.f}; R1p = fr == 0 ? h63 : z4; R2p = fr == 0 ? h62 : (fr == 1 ? h63 : z4); }
#pragma unroll
                for (int m = 0; m < 4; ++m) { const int rl = ai * HALF + wr * 64 + m * 16 + fr; const bool ok = (rl >= 2) && (pos0 + rl < 4096);
                    float hv[4];
#pragma unroll
                    for (int e = 0; e < 4; ++e) { const float v = acc[ai][0][m][n][e];
                        const float p1 = DPPF(v, 0x111) + R1p[e], p2 = DPPF(v, 0x112) + R2p[e]; R1p[e] = DPPF(v, 0x10F); R2p[e] = DPPF(v, 0x10E);
                        const float y = w0[e] * p2 + (w1[e] * p1 + (w2[e] * v + bb[e]));
                        const float tq = y * (-2.302208198f + -0.10294324f * (y * y));
                        const float sg = __builtin_amdgcn_rcpf(1.0f + __builtin_amdgcn_exp2f(tq));
                        hv[e] = (y * acc[ai][1][m][n][e]) * sg; }
                    u32x2e w; w.x = cvt_pk_bf16(hv[0], hv[1]); w.y = cvt_pk_bf16(hv[2], hv[3]);
                    if (n == 0) hold[ai][m] = w;
                    else if (ok) { u32x4 w4; w4.x = hold[ai][m].x; w4.y = hold[ai][m].y; w4.z = w.x; w4.w = w.y; *(u32x4*)(H + (size_t)(rowb + rl) * DFF_ + colh) = w4; } }
            }
        }
#undef DPPF
        asm volatile("s_waitcnt lgkmcnt(0)" ::: "memory"); __builtin_amdgcn_s_barrier(); asm volatile("" ::: "memory");
    }
};
struct EpiResid {
    static constexpr int PERM = 1; static constexpr bool AFTER_DRAIN = true;
    struct Pre { int unused; };
    const float* base; float* out; bf16_t* xb; float* ssqp; int ldc; int Mtot;
    __device__ __forceinline__ void init(f32x4 (&acc)[2][2][4][2], const Unit& u, int wr, int wc, int fr, int fq) const {
        const int col0 = u.pn * BM + wc * 32 + 8 * fq;
#pragma unroll
        for (int ai = 0; ai < 2; ++ai)
#pragma unroll
            for (int m = 0; m < 4; ++m) { const size_t off = (size_t)(u.pm * BM + ai * HALF + wr * 64 + m * 16 + fr) * ldc + col0;
#pragma unroll
                for (int bj = 0; bj < 2; ++bj) {
                    if (base) { acc[ai][bj][m][0] = __builtin_nontemporal_load((const f32x4*)(base + off + bj * HALF)); acc[ai][bj][m][1] = __builtin_nontemporal_load((const f32x4*)(base + off + bj * HALF + 4)); }
                    else { const u32x4 w = *(const u32x4*)(xb + off + bj * HALF);
                        acc[ai][bj][m][0] = (f32x4){__uint_as_float(w.x << 16), __uint_as_float(w.x & 0xffff0000u), __uint_as_float(w.y << 16), __uint_as_float(w.y & 0xffff0000u)};
                        acc[ai][bj][m][1] = (f32x4){__uint_as_float(w.z << 16), __uint_as_float(w.z & 0xffff0000u), __uint_as_float(w.w << 16), __uint_as_float(w.w & 0xffff0000u)}; } } }
    }
    __device__ __forceinline__ void fused(f32x4 (&acc)[2][2][4][2], const Unit& u, int wr, int wc, int fr, int fq, PG8_LAS unsigned char* lds, int wid, int lane) const {
        PG8_LAS float* P = (PG8_LAS float*)lds;
        const int col0 = u.pn * BM + wc * 32 + 8 * fq;
#pragma unroll
        for (int ai = 0; ai < 2; ++ai)
#pragma unroll
            for (int m = 0; m < 4; ++m) { const int r = ai * HALF + wr * 64 + m * 16 + fr; const size_t off = (size_t)(u.pm * BM + r) * ldc + col0; float s = 0.f;
#pragma unroll
                for (int bj = 0; bj < 2; ++bj) { const f32x4 o0 = acc[ai][bj][m][0], o1 = acc[ai][bj][m][1];
                    if (out) { __builtin_nontemporal_store(o0, (f32x4*)(out + off + bj * HALF)); __builtin_nontemporal_store(o1, (f32x4*)(out + off + bj * HALF + 4)); }
                    u32x4 w; w.x = cvt_pk_bf16(o0[0], o0[1]); w.y = cvt_pk_bf16(o0[2], o0[3]); w.z = cvt_pk_bf16(o1[0], o1[1]); w.w = cvt_pk_bf16(o1[2], o1[3]); *(u32x4*)(xb + off + bj * HALF) = w;
                    s += ((o0[0] * o0[0] + o0[1] * o0[1]) + (o0[2] * o0[2] + o0[3] * o0[3])) + ((o1[0] * o1[0] + o1[1] * o1[1]) + (o1[2] * o1[2] + o1[3] * o1[3])); }
                s += __shfl_xor(s, 16); s += __shfl_xor(s, 32);
                if (fq == 0) P[r * 4 + wc] = s;
                if (m & 1) asm volatile("" ::: "memory"); }
        asm volatile("s_waitcnt lgkmcnt(0)" ::: "memory"); __builtin_amdgcn_s_barrier(); asm volatile("" ::: "memory");
        if (lane < 32) { const int row = wid * 32 + lane; ssqp[(size_t)u.pn * Mtot + u.pm * BM + row] = (P[row * 4 + 0] + P[row * 4 + 1]) + (P[row * 4 + 2] + P[row * 4 + 3]); }
        asm volatile("s_waitcnt lgkmcnt(0)" ::: "memory"); __builtin_amdgcn_s_barrier(); asm volatile("" ::: "memory");
    }
};

template <class Epi, class Sched, bool ALIGN_EPI = false, bool SP2 = false>
__device__ __forceinline__ void gemm_phase(PG8_LAS unsigned char* lds, const Gemm g, const Sched& S, const Epi& E, int tid_in) {
    int tid_l = tid_in; asm volatile("" : "+v"(tid_l));
    const int tid = tid_l, wid = __builtin_amdgcn_readfirstlane(tid >> 6), lane = tid & 63, wr = wid >> 2, wc = wid & 3, fr = lane & 15, fq = lane >> 4;
    const int K = g.K, nt = K / BK;
    unsigned voffA[2], voffB[2];
#pragma unroll
    for (int i = 0; i < 2; ++i) { int R, C; stage_rc(tid * 16 + i * 8192, R, C); const int Rb = (int)Epi::PERM == 3 ? (64 * (R >> 5) + perm32(R & 31)) : ((int)Epi::PERM == 1 ? ((R & ~31) + perm32(R & 31)) : R);
        voffA[i] = (unsigned)(R * g.lda + C) * 2u; voffB[i] = (unsigned)(Rb * K + C) * 2u; }
    const size_t kstep = (size_t)(BK * 2);
    const size_t hstepA = (size_t)HALF * g.lda * 2, hstepB = (size_t)((int)Epi::PERM == 3 ? 32 : HALF) * K * 2;
    const size_t tstepB = (size_t)BM * K * 2;
    const unsigned ldsw = (unsigned)wid * 1024u;
    const int aoff = lds_byte(wr * 64 + fr, fq * 8), boff = lds_byte(wc * 32 + fr, fq * 8);
#define PG8_SA(b, h) (((b) * 2 + (h)) * HTB)
#define PG8_SB(b, h) ((4 + (b) * 2 + (h)) * HTB)
#define PG8_STAGE(bufoff, gbase, voff) do { _Pragma("unroll") for (int _i = 0; _i < 2; ++_i) \
        __builtin_amdgcn_global_load_lds((const unsigned*)((const char*)(gbase) + (voff)[_i]), (PG8_LAS unsigned*)(lds + (bufoff) + ldsw + _i * 8192), 16, 0, 0); } while (0)
#define PG8_LDA(dst, b, h) do { _Pragma("unroll") for (int m = 0; m < 4; ++m) _Pragma("unroll") for (int k = 0; k < 2; ++k) dst[m][k] = *(const PG8_LAS bf16x8*)(lds + PG8_SA(b, h) + aoff + m * 2048 + k * 1024); } while (0)
#define PG8_LDB(dst, b, h) do { _Pragma("unroll") for (int n = 0; n < 2; ++n) _Pragma("unroll") for (int k = 0; k < 2; ++k) dst[n][k] = *(const PG8_LAS bf16x8*)(lds + PG8_SB(b, h) + boff + n * 2048 + k * 1024); } while (0)
#define PG8_MMA(ai, bj, At, Bt) do { __builtin_amdgcn_s_setprio(1); _Pragma("unroll") for (int m = 0; m < 4; ++m) _Pragma("unroll") for (int n = 0; n < 2; ++n) _Pragma("unroll") for (int k = 0; k < 2; ++k) \
        acc[ai][bj][m][n] = __builtin_amdgcn_mfma_f32_16x16x32_bf16(Bt[n][k], At[m][k], acc[ai][bj][m][n], 0, 0, 0); __builtin_amdgcn_s_setprio(0); } while (0)
#define PG8_WAIT_V(n) asm volatile("s_waitcnt vmcnt(" #n ")" ::: "memory")
#define PG8_WAIT_L(n) asm volatile("s_waitcnt lgkmcnt(" #n ")" ::: "memory")
#define PG8_BAR __builtin_amdgcn_s_barrier()
#define PG8_SCHED __builtin_amdgcn_sched_barrier(0)
    Unit cur, nxt; int ui = 0;
    if (!S.next(0, cur)) return;
    f32x4 acc[2][2][4][2];
#pragma unroll
    for (int a = 0; a < 2; ++a)
#pragma unroll
        for (int b = 0; b < 2; ++b)
#pragma unroll
            for (int m = 0; m < 4; ++m)
#pragma unroll
                for (int n = 0; n < 2; ++n) acc[a][b][m][n] = (f32x4){0.f, 0.f, 0.f, 0.f};
    if constexpr (Epi::AFTER_DRAIN) E.init(acc, cur, wr, wc, fr, fq);
    bf16x8 At[4][2], B0[2][2], B1[2][2];
    const char* cA = (const char*)g.A + (ptrdiff_t)S.arow(cur) * (ptrdiff_t)(g.lda * 2); const char* cB = (const char*)g.Bt + (size_t)cur.pn * tstepB;
    S.a_ready(cur);
    if constexpr (!Epi::AFTER_DRAIN) E.preload_unit(lds, cur, wr, wc, lane);
    if constexpr (SP2) {
        PG8_STAGE(PG8_SB(0, 0), cB, voffB); PG8_STAGE(PG8_SB(0, 1), cB + hstepB, voffB); PG8_STAGE(PG8_SA(0, 0), cA, voffA); PG8_STAGE(PG8_SA(0, 1), cA + hstepA, voffA);
        if (wr == 1) PG8_BAR;
        PG8_WAIT_V(2); PG8_BAR;
        PG8_STAGE(PG8_SB(1, 0), cB + kstep, voffB); PG8_STAGE(PG8_SA(1, 0), cA + kstep, voffA); PG8_STAGE(PG8_SB(1, 1), cB + hstepB + kstep, voffB);
        PG8_WAIT_V(6); PG8_BAR;
        if constexpr (Epi::AFTER_DRAIN) {
#pragma unroll
            for (int a_ = 0; a_ < 2; ++a_)
#pragma unroll
                for (int b_ = 0; b_ < 2; ++b_) asm volatile("" : "+v"(acc[a_][b_][0][0]), "+v"(acc[a_][b_][0][1]), "+v"(acc[a_][b_][1][0]), "+v"(acc[a_][b_][1][1]), "+v"(acc[a_][b_][2][0]), "+v"(acc[a_][b_][2][1]), "+v"(acc[a_][b_][3][0]), "+v"(acc[a_][b_][3][1]));
        }
    } else {
        PG8_STAGE(PG8_SB(0, 0), cB, voffB); PG8_STAGE(PG8_SA(0, 0), cA, voffA); PG8_STAGE(PG8_SB(0, 1), cB + hstepB, voffB); PG8_STAGE(PG8_SA(0, 1), cA + hstepA, voffA);
        if (wr == 1) PG8_BAR;
        PG8_WAIT_V(4); PG8_BAR;
        PG8_STAGE(PG8_SB(1, 0), cB + kstep, voffB); PG8_STAGE(PG8_SA(1, 0), cA + kstep, voffA); PG8_STAGE(PG8_SB(1, 1), cB + hstepB + kstep, voffB);
        PG8_WAIT_V(6); PG8_BAR;
    }
    for (;;) {
        const bool has_next = S.next(ui + 1, nxt);
        const char* nA = has_next ? (const char*)g.A + (ptrdiff_t)S.arow(nxt) * (ptrdiff_t)(g.lda * 2) : cA; const char* nB = has_next ? (const char*)g.Bt + (size_t)nxt.pn * tstepB : cB;
        for (int t = 0; t < nt; t += 2) {
            const bool last = (t == nt - 2);
            const char* a1 = cA + (size_t)(t + 1) * kstep;
            const char* a2 = last ? nA : cA + (size_t)(t + 2) * kstep; const char* b2 = last ? nB : cB + (size_t)(t + 2) * kstep;
            const char* a3 = a2 + kstep; const char* b3 = b2 + kstep;
            if (last && has_next) S.a_ready(nxt);
            if constexpr (!Epi::AFTER_DRAIN) { if (last) E.preload(lds, cur, wr, wc, lane); }
            if constexpr (SP2) {
            PG8_LDB(B0, 0, 0); PG8_LDB(B1, 0, 1); PG8_SCHED; PG8_LDA(At, 0, 0); PG8_STAGE(PG8_SA(1, 1), a1 + hstepA, voffA);
            PG8_WAIT_V(8); PG8_WAIT_L(0); PG8_BAR; PG8_MMA(0, 0, At, B0); PG8_MMA(0, 1, At, B1); PG8_BAR; PG8_SCHED;
            PG8_LDA(At, 0, 1); PG8_STAGE(PG8_SB(0, 0), b2, voffB); PG8_STAGE(PG8_SB(0, 1), b2 + hstepB, voffB); PG8_STAGE(PG8_SA(0, 0), a2, voffA);
            PG8_WAIT_V(8); PG8_WAIT_L(0); PG8_BAR; PG8_MMA(1, 0, At, B0); PG8_MMA(1, 1, At, B1); PG8_BAR; PG8_SCHED;
            PG8_LDB(B0, 1, 0); PG8_LDB(B1, 1, 1); PG8_SCHED; PG8_LDA(At, 1, 0); PG8_STAGE(PG8_SA(0, 1), a2 + hstepA, voffA);
            PG8_WAIT_V(8); PG8_WAIT_L(0); PG8_BAR; PG8_MMA(0, 0, At, B0); PG8_MMA(0, 1, At, B1); PG8_BAR; PG8_SCHED;
            PG8_LDA(At, 1, 1); PG8_STAGE(PG8_SB(1, 0), b3, voffB); PG8_STAGE(PG8_SB(1, 1), b3 + hstepB, voffB); PG8_STAGE(PG8_SA(1, 0), a3, voffA);
            PG8_WAIT_V(8); PG8_WAIT_L(0); PG8_BAR; PG8_MMA(1, 0, At, B0); PG8_MMA(1, 1, At, B1); PG8_BAR; PG8_SCHED;
            } else {
            PG8_LDB(B0, 0, 0); PG8_SCHED; PG8_LDA(At, 0, 0); PG8_STAGE(PG8_SA(1, 1), a1 + hstepA, voffA);
            PG8_WAIT_L(8); PG8_BAR; PG8_WAIT_L(0); PG8_MMA(0, 0, At, B0); PG8_BAR; PG8_SCHED;
            PG8_LDB(B1, 0, 1); PG8_STAGE(PG8_SB(0, 0), b2, voffB);
            PG8_BAR; PG8_WAIT_L(0); PG8_MMA(0, 1, At, B1); PG8_BAR;
            PG8_LDA(At, 0, 1); PG8_STAGE(PG8_SA(0, 0), a2, voffA);
            PG8_BAR; PG8_WAIT_L(0); PG8_MMA(1, 0, At, B0); PG8_BAR; PG8_SCHED;
            PG8_STAGE(PG8_SB(0, 1), b2 + hstepB, voffB);
            PG8_WAIT_V(6); PG8_BAR; PG8_MMA(1, 1, At, B1); PG8_BAR;
            PG8_LDB(B0, 1, 0); PG8_SCHED; PG8_LDA(At, 1, 0); PG8_STAGE(PG8_SA(0, 1), a2 + hstepA, voffA);
            PG8_WAIT_L(8); PG8_BAR; PG8_WAIT_L(0); PG8_MMA(0, 0, At, B0); PG8_BAR; PG8_SCHED;
            PG8_LDB(B1, 1, 1); PG8_STAGE(PG8_SB(1, 0), b3, voffB);
            PG8_BAR; PG8_WAIT_L(0); PG8_MMA(0, 1, At, B1); PG8_BAR;
            PG8_LDA(At, 1, 1); PG8_STAGE(PG8_SA(1, 0), a3, voffA);
            PG8_BAR; PG8_WAIT_L(0); PG8_MMA(1, 0, At, B0); PG8_BAR; PG8_SCHED;
            PG8_STAGE(PG8_SB(1, 1), b3 + hstepB, voffB);
            PG8_WAIT_V(6); PG8_BAR; PG8_MMA(1, 1, At, B1); PG8_BAR;
            }
        }
        if constexpr (ALIGN_EPI) { if (wr == 0) PG8_BAR; }
        if constexpr (!Epi::AFTER_DRAIN) { E(acc, cur, wr, wc, fr, fq, lds); S.done(cur); if (has_next) E.preload_unit(lds, nxt, wr, wc, lane); }
        if (!has_next) break;
#pragma unroll
        for (int a = 0; a < 2; ++a)
#pragma unroll
            for (int b = 0; b < 2; ++b)
#pragma unroll
                for (int m = 0; m < 4; ++m)
#pragma unroll
                    for (int n = 0; n < 2; ++n) acc[a][b][m][n] = (f32x4){0.f, 0.f, 0.f, 0.f};
        cur = nxt; cA = nA; cB = nB; ++ui;
        if constexpr (ALIGN_EPI) { if (wr == 1) PG8_BAR; }
    }
    PG8_WAIT_V(0);
    if constexpr (!ALIGN_EPI) { if (wr == 0) PG8_BAR; }
    PG8_BAR;
    if constexpr (Epi::AFTER_DRAIN) { E.fused(acc, cur, wr, wc, fr, fq, lds, wid, lane); S.done(cur); }
#undef PG8_SA
#undef PG8_SB
#undef PG8_STAGE
#undef PG8_LDA
#undef PG8_LDB
#undef PG8_MMA
#undef PG8_WAIT_V
#undef PG8_WAIT_L
#undef PG8_BAR
#undef PG8_SCHED
}
}


#define GAS __attribute__((address_space(1)))
#define LAS __attribute__((address_space(3)))
typedef unsigned short bf16;
typedef unsigned v4u __attribute__((ext_vector_type(4)));
typedef unsigned v2u __attribute__((ext_vector_type(2)));
typedef float f32x4 __attribute__((ext_vector_type(4)));
constexpr int BATCH = 4, SEQ = 4096, D = 1024, M = BATCH * SEQ, NMEM = 256, MM = BATCH * NMEM, DFF = 2816;
constexpr int EV_IN = 4096, OD_IN = 3072;
constexpr float EPS = 1e-6f;
constexpr int Z_RQ = 0, Z_GQ = 512, Z_RK = 1024, Z_RV = 1536, Z_RG = 2048, Z_GF = 2560, Z_GI = 3072, Z_GG = 3584;

constexpr size_t MiB = 1u << 20;
constexpr size_t WS_CTL = 0;
constexpr size_t WS_EVIN = 1 * MiB, WS_EVOUT = 9 * MiB, WS_XQ0 = 11 * MiB, WS_XKV0 = 13 * MiB, WS_XO0 = 17 * MiB, WS_FIN0 = 19 * MiB, WS_FOUT0 = 30 * MiB;
constexpr size_t WS_ODIN = 36 * MiB, WS_ODOUT = 42 * MiB, WS_XQ1 = 44 * MiB, WS_XKV1 = 46 * MiB, WS_XO1 = 50 * MiB, WS_FIN1 = 52 * MiB, WS_FOUT1 = 63 * MiB;
constexpr size_t WS_XB = 69 * MiB;
constexpr size_t WS_MKV0 = 101 * MiB, WS_MKV1 = 105 * MiB;
constexpr size_t WS_MEMH0 = 109 * MiB, WS_MEMH1 = 111 * MiB;
constexpr size_t WS_SSQP = 113 * MiB;
constexpr size_t WS_LB = 113 * MiB + 512 * 1024;
constexpr size_t WS_BIAST = 113 * MiB + 516 * 1024;
constexpr size_t WS_GXA = 113 * MiB + 600 * 1024, WS_GOD = 113 * MiB + 604 * 1024;
constexpr size_t WS_DEN23 = 114 * MiB;
constexpr size_t WS_N2 = 1 * MiB;
constexpr size_t WS_ACT = 115 * MiB;
constexpr size_t WS_DECA = 243 * MiB, WS_DECB = 243 * MiB + 512 * 1024;
constexpr size_t WS_END = 256 * MiB;

__device__ __forceinline__ float bf2f(bf16 u) { return __uint_as_float((unsigned)u << 16); }
__device__ __forceinline__ unsigned f2bf(float f) { unsigned u = __builtin_bit_cast(unsigned, f); return (u + 0x7fffu + ((u >> 16) & 1u)) >> 16; }
__device__ __forceinline__ unsigned pk2(float lo, float hi) { return f2bf(lo) | (f2bf(hi) << 16); }
__device__ __forceinline__ float wave_sum(float v) {
#pragma unroll
    for (int o = 1; o < 64; o <<= 1) v += __shfl_xor(v, o);
    return v;
}
__device__ __forceinline__ float wave_max(float v) {
#pragma unroll
    for (int o = 1; o < 64; o <<= 1) v = fmaxf(v, __shfl_xor(v, o));
    return v;
}
__device__ __forceinline__ void unpack8(const v4u w, float (&f)[8]) {
    f[0] = __uint_as_float(w.x << 16); f[1] = __uint_as_float(w.x & 0xffff0000u); f[2] = __uint_as_float(w.y << 16); f[3] = __uint_as_float(w.y & 0xffff0000u);
    f[4] = __uint_as_float(w.z << 16); f[5] = __uint_as_float(w.z & 0xffff0000u); f[6] = __uint_as_float(w.w << 16); f[7] = __uint_as_float(w.w & 0xffff0000u);
}
__device__ __forceinline__ void rope_sincos(float a, float& s, float& c) {
    const float n = rintf(a * 0.15915494309189535f);
    float r = fmaf(-n, 6.2831854820251465f, a); r = fmaf(-n, -1.7484555e-7f, r);
    const float rev = r * 0.15915494309189535f;
    s = __builtin_amdgcn_sinf(rev); c = __builtin_amdgcn_cosf(rev);
}

__device__ __forceinline__ int dst_row_map(int mode, int n0) {
    if (mode == 1) { const int seg = n0 >> 9, within = n0 & 511; const int dseg = (seg == 0) ? 0 : (seg == 4 ? 1 : (seg < 4 ? seg + 1 : seg)); return dseg * 512 + within; }
    if (mode == 2) { return n0 < DFF ? (n0 >> 7) * 256 + (n0 & 127) : ((n0 - DFF) >> 7) * 256 + 128 + ((n0 - DFF) & 127); }
    return n0;
}
__device__ __forceinline__ void transpose_item(const float* W, int K, int N, const float* g, bf16* WT, int mode, LAS float* scr, int item, int lane) {
    const int nblk = N / 64, kb = item / nblk, nb = item % nblk, k0 = 64 * kb, n0 = 64 * nb, lr = lane >> 4, lc = lane & 15;
    f32x4 v[16];
#pragma unroll
    for (int i = 0; i < 16; ++i) v[i] = __builtin_nontemporal_load((const f32x4*)(W + (size_t)(k0 + 4 * i + lr) * N + n0 + 4 * lc));
#pragma unroll
    for (int i = 0; i < 16; ++i) { const int kk = 4 * i + lr; const float gg = g ? g[k0 + kk] : 1.0f; LAS float* p = scr + kk * 65 + 4 * lc; p[0] = v[i][0] * gg; p[1] = v[i][1] * gg; p[2] = v[i][2] * gg; p[3] = v[i][3] * gg; }
    asm volatile("s_waitcnt lgkmcnt(0)" ::: "memory");
    const int c = lane & 7; const int d0 = dst_row_map(mode, n0);
#pragma unroll
    for (int j = 0; j < 8; ++j) { const int n = (lane >> 3) + 8 * j; const LAS float* sp = scr + (8 * c) * 65 + n;
        v4u o; o.x = pk2(sp[0 * 65], sp[1 * 65]); o.y = pk2(sp[2 * 65], sp[3 * 65]); o.z = pk2(sp[4 * 65], sp[5 * 65]); o.w = pk2(sp[6 * 65], sp[7 * 65]);
        *(v4u*)(WT + (size_t)(d0 + n) * K + k0 + 8 * c) = o; }
    asm volatile("s_waitcnt lgkmcnt(0)" ::: "memory");
}
struct ProArgs { const float* in[25]; unsigned char* ws; int layer_mask; int ffn_mode; };
#define PICK_JOB(Wp_, K__, N__, gp_, dst_, mode_) if (!found) { const int ni_ = ((K__) / 64) * ((N__) / 64); if (r < ni_) { W_ = (Wp_); K_ = (K__); N_ = (N__); g_ = (gp_); d_ = (dst_); m_ = (mode_); found = true; } else r -= ni_; }
__device__ __forceinline__ void prologue_body(const ProArgs& a, int gw, int NGW, int lane, LAS float* scr) {
    unsigned char* ws = a.ws;
    const float* x = a.in[0]; const float* mem = a.in[1];
    if (a.layer_mask & 1) {
        constexpr int NITEMS_ALL = 2 * ((D / 64) * (D / 64) * 3 + (D / 64) * (2 * D / 64) + (D / 64) * (2 * DFF / 64) + (DFF / 64) * (D / 64)) + (D / 64) * (EV_IN / 64) + (D / 64) * (OD_IN / 64) + (D / 64) * (D / 64) * 0;
        for (int it = gw; it < NITEMS_ALL; it += NGW) {
            int r = it; bool found = false; const float* W_ = nullptr; const float* g_ = nullptr; int K_ = 0, N_ = 0, m_ = 0; size_t d_ = 0;
            PICK_JOB(a.in[3], D, EV_IN, a.in[2], WS_EVIN, 1)
            PICK_JOB(a.in[21], D, 2 * DFF, a.in[20], WS_FIN0, a.ffn_mode)
            PICK_JOB(a.in[21] + (size_t)D * 2 * DFF, D, 2 * DFF, a.in[20] + D, WS_FIN1, a.ffn_mode)
            PICK_JOB(a.in[8], D, OD_IN, a.in[2] + D, WS_ODIN, 0)
            PICK_JOB(a.in[24], DFF, D, (const float*)nullptr, WS_FOUT0, 0)
            PICK_JOB(a.in[24] + (size_t)DFF * D, DFF, D, (const float*)nullptr, WS_FOUT1, 0)
            PICK_JOB(a.in[16], D, 2 * D, (const float*)nullptr, WS_XKV0, 0)
            PICK_JOB(a.in[16] + (size_t)D * 2 * D, D, 2 * D, (const float*)nullptr, WS_XKV1, 0)
            PICK_JOB(a.in[7], D, D, (const float*)nullptr, WS_EVOUT, 0)
            PICK_JOB(a.in[12], D, D, (const float*)nullptr, WS_ODOUT, 0)
            PICK_JOB(a.in[15], D, D, a.in[13], WS_XQ0, 0)
            PICK_JOB(a.in[15] + (size_t)D * D, D, D, a.in[13] + D, WS_XQ1, 0)
            PICK_JOB(a.in[19], D, D, (const float*)nullptr, WS_XO0, 0)
            PICK_JOB(a.in[19] + (size_t)D * D, D, D, (const float*)nullptr, WS_XO1, 0)
            if (found) transpose_item(W_, K_, N_, g_, (bf16*)(ws + d_), m_, scr, r, lane);
        }
        for (int m = 2 * gw; m < M; m += 2 * NGW) {
            const f32x4* xr = (const f32x4*)(x + (size_t)m * D) + lane; v2u* o8 = (v2u*)((bf16*)(ws + WS_XB) + (size_t)m * D) + lane; float* sp = (float*)(ws + WS_SSQP);
            f32x4 v[8];
#pragma unroll
            for (int j = 0; j < 8; ++j) v[j] = __builtin_nontemporal_load(xr + 64 * j);
#pragma unroll
            for (int j = 0; j < 8; ++j) { v2u w; w.x = pk2(v[j][0], v[j][1]); w.y = pk2(v[j][2], v[j][3]); o8[64 * j] = w;
                const float s2 = wave_sum((v[j][0] * v[j][0] + v[j][1] * v[j][1]) + (v[j][2] * v[j][2] + v[j][3] * v[j][3])); if (lane == 0) sp[(size_t)(j & 3) * M + m + (j >> 2)] = s2; }
        }
        for (int r = gw; r < 2 * MM; r += NGW) { const int l = r / MM, m = r % MM;
            const f32x4* xr = (const f32x4*)(mem + (size_t)m * D) + lane; const f32x4* gr = (const f32x4*)(a.in[14] + (size_t)l * D) + lane;
            f32x4 v[4]; float s = 0.f;
#pragma unroll
            for (int j = 0; j < 4; ++j) { v[j] = xr[64 * j]; s += (v[j][0] * v[j][0] + v[j][1] * v[j][1]) + (v[j][2] * v[j][2] + v[j][3] * v[j][3]); }
            const float rs = 1.0f / sqrtf(wave_sum(s) * (1.0f / D) + EPS);
            v2u* o8 = (v2u*)((bf16*)(ws + (l ? WS_MEMH1 : WS_MEMH0)) + (size_t)m * D) + lane;
#pragma unroll
            for (int j = 0; j < 4; ++j) { const f32x4 g = gr[64 * j]; v2u w; w.x = pk2(v[j][0] * rs * g[0], v[j][1] * rs * g[1]); w.y = pk2(v[j][2] * rs * g[2], v[j][3] * rs * g[3]); o8[64 * j] = w; }
        }
        if (gw == 0) {
            const float* lg = a.in[6]; float* lb = (float*)(ws + WS_LB);
            for (int c = lane; c < 512; c += 64) { const float a0 = lg[c], a1 = lg[512 + c], a2 = lg[1024 + c]; const float mx = fmaxf(a0, fmaxf(a1, a2));
                const float e0 = expf(a0 - mx), e1 = expf(a1 - mx), e2 = expf(a2 - mx); lb[c] = e0 / (e0 + e1 + e2); }
        }
        if (gw == 2) {
            float* gx = (float*)(ws + WS_GXA); float* go = (float*)(ws + WS_GOD);
            for (int i = lane; i < 512; i += 64) gx[i] = a.in[18][i] * a.in[17][i];
            for (int i = lane; i < 128; i += 64) go[i] = a.in[10][i] * a.in[9][i];
        }
        if (gw == 1) {
            const float* rb = a.in[11]; float* bt = (float*)(ws + WS_BIAST);
            for (int i = lane; i < 3 * 8 * 132; i += 64) { const int br = i / (8 * 132), h = (i / 132) % 8, dl = i % 132; const int d = dl * (1 << (2 * br));
                int bucket; if (d < 16) bucket = d; else { const float lr = logf((float)d / 16.0f) / 4.852030263919617f; int lg2 = 16 + (int)(lr * 16.0f); bucket = lg2 < 31 ? lg2 : 31; }
                bt[i] = (dl <= 128) ? rb[bucket * 8 + h] : 0.f; }
        }
    }
}


typedef short bf16x8 __attribute__((ext_vector_type(8)));
typedef short s16x4 __attribute__((ext_vector_type(4)));
typedef float f32x16 __attribute__((ext_vector_type(16)));
typedef float f32x2_t __attribute__((ext_vector_type(2))); typedef __bf16 bf16x2_t __attribute__((ext_vector_type(2)));
typedef short v4i16_t __attribute__((ext_vector_type(4)));
#define MFMA32(a, b, c) __builtin_amdgcn_mfma_f32_32x32x16_bf16((a), (b), (c), 0, 0, 0)
__device__ __forceinline__ unsigned cvtpk(float lo, float hi) { f32x2_t v = {lo, hi}; bf16x2_t b = __builtin_convertvector(v, bf16x2_t); return __builtin_bit_cast(unsigned, b); }
__device__ __forceinline__ bf16x8 pack8(float a0, float a1, float a2, float a3, float a4, float a5, float a6, float a7) {
    v4u p; p.x = cvtpk(a0, a1); p.y = cvtpk(a2, a3); p.z = cvtpk(a4, a5); p.w = cvtpk(a6, a7); return __builtin_bit_cast(bf16x8, p); }
__device__ __forceinline__ s16x4 vtr(const LAS char* p) { return __builtin_bit_cast(s16x4, __builtin_amdgcn_ds_read_tr16_b64_v4i16((LAS v4i16_t*)p)); }
__device__ __forceinline__ int tr_lane_base(int lane, int stride) { const int g = lane >> 4, i = lane & 15, q = i >> 2, p = i & 3, h2 = g >> 1; return (4 * h2 + q) * stride + (16 * (g & 1) + 4 * p) * 2; }
__device__ __forceinline__ bf16x8 tr_frag_perm(const LAS char* img, int stride, int lbase, int k0, int n0) {
    const LAS char* p = img + lbase + k0 * stride + n0 * 2;
    const s16x4 lo = vtr(p), hi = vtr(p + 8 * stride);
    return (bf16x8){lo[0], lo[1], lo[2], lo[3], hi[0], hi[1], hi[2], hi[3]};
}
__device__ __forceinline__ int tr_lane_base_nat(int lane, int stride) { const int g = lane >> 4, i = lane & 15, q = i >> 2, p = i & 3, h2 = g >> 1; return (8 * h2 + q) * stride + (16 * (g & 1) + 4 * p) * 2; }
__device__ __forceinline__ bf16x8 tr_frag_nat(const LAS char* img, int stride, int lbase, int k0, int n0) {
    const LAS char* p = img + lbase + k0 * stride + n0 * 2;
    const s16x4 lo = vtr(p), hi = vtr(p + 4 * stride);
    return (bf16x8){lo[0], lo[1], lo[2], lo[3], hi[0], hi[1], hi[2], hi[3]};
}

#define LDS_BARRIER() do { asm volatile("s_waitcnt lgkmcnt(0)" ::: "memory"); __builtin_amdgcn_s_barrier(); asm volatile("" ::: "memory"); } while (0)
constexpr int XA_STRIDE = 528, XA_VSTRIDE = 528;
constexpr int XA_LDS = 256 * XA_STRIDE;
template <bool Q_IN_LDS> __device__ __forceinline__ void xattn_unit(LAS char* lds, const bf16* __restrict__ Q, const bf16* __restrict__ MKV, const float* __restrict__ gkq, bf16* __restrict__ O, int unit, int tid) {
    const int lane = tid & 63, w = __builtin_amdgcn_readfirstlane(tid >> 6), r = lane & 31, h2 = lane >> 5;
    const int rb = unit >> 2, h = unit & 3, row0 = rb * 256, b = row0 / SEQ;
    const bf16* Kg = MKV + (size_t)(b * NMEM) * 2048 + h * 256; const bf16* Vg = Kg + 1024;
    v4u st[16];
#pragma unroll
    for (int i = 0; i < 16; ++i) { const int id = tid + 512 * i; st[i] = *(const v4u*)(Kg + (size_t)(id >> 5) * 2048 + (id & 31) * 8); }
    const size_t qoff = (size_t)(row0 + 32 * w + r) * D + h * 256;
    bf16x8 qf[16];
    if (Q_IN_LDS) {
#pragma unroll
        for (int s = 0; s < 16; ++s) qf[s] = *(const LAS bf16x8*)(lds + (32 * w + r) * XA_STRIDE + h2 * 16 + s * 32);
        asm volatile("s_waitcnt lgkmcnt(0)" ::: "memory"); __builtin_amdgcn_s_barrier(); asm volatile("" ::: "memory");
    } else {
#pragma unroll
        for (int s = 0; s < 16; ++s) qf[s] = *(const bf16x8*)(Q + qoff + 8 * h2 + 16 * s);
    }
    { float gk8[8];
#pragma unroll
      for (int e = 0; e < 8; ++e) gk8[e] = gkq[(tid & 31) * 8 + e];
#pragma unroll
      for (int i = 0; i < 16; ++i) { const int id = tid + 512 * i; float f[8]; unpack8(st[i], f);
          float sq = (f[0] * f[0] + f[1] * f[1]) + (f[2] * f[2] + f[3] * f[3]) + (f[4] * f[4] + f[5] * f[5]) + (f[6] * f[6] + f[7] * f[7]);
          sq += __shfl_xor(sq, 1); sq += __shfl_xor(sq, 2); sq += __shfl_xor(sq, 4); sq += __shfl_xor(sq, 8); sq += __shfl_xor(sq, 16);
          const float rk = 1.0f / sqrtf(sq * (1.0f / 256.0f) + EPS) * 0.0625f;
          v4u o; o.x = cvtpk(f[0] * rk * gk8[0], f[1] * rk * gk8[1]); o.y = cvtpk(f[2] * rk * gk8[2], f[3] * rk * gk8[3]); o.z = cvtpk(f[4] * rk * gk8[4], f[5] * rk * gk8[5]); o.w = cvtpk(f[6] * rk * gk8[6], f[7] * rk * gk8[7]);
          *(LAS v4u*)(lds + (id >> 5) * XA_STRIDE + (id & 31) * 16) = o; } }
    float ss = 0.f;
#pragma unroll
    for (int s = 0; s < 16; ++s)
#pragma unroll
        for (int j = 0; j < 8; ++j) { const float x = __uint_as_float((unsigned)(unsigned short)qf[s][j] << 16); ss += x * x; }
    ss += __shfl_xor(ss, 32);
    const float rsl = 1.0f / sqrtf(ss * (1.0f / 256.0f) + EPS) * 1.4426950408889634f;
    asm volatile("" ::: "memory");
#pragma unroll
    for (int i = 0; i < 8; ++i) { const int id = tid + 512 * i; st[i] = *(const v4u*)(Vg + (size_t)(id >> 5) * 2048 + (id & 31) * 8); }
    LDS_BARRIER();
    bf16x8 pf[8][2]; float den = 0.f;
#pragma unroll
    for (int kb = 0; kb < 8; ++kb) {
        f32x16 acc;
#pragma unroll
        for (int i = 0; i < 16; ++i) acc[i] = 0.f;
        const LAS char* kp = lds + (32 * kb + r) * XA_STRIDE + h2 * 16;
#pragma unroll
        for (int s = 0; s < 16; ++s) { const bf16x8 a = *(const LAS bf16x8*)(kp + s * 32); acc = MFMA32(a, qf[s], acc); }
        float p[16];
#pragma unroll
        for (int i = 0; i < 16; ++i) { p[i] = __builtin_amdgcn_exp2f(acc[i] * rsl - 11.541560327111707f); den += p[i]; }
        pf[kb][0] = pack8(p[0], p[1], p[2], p[3], p[4], p[5], p[6], p[7]); pf[kb][1] = pack8(p[8], p[9], p[10], p[11], p[12], p[13], p[14], p[15]);
    }
    den += __shfl_xor(den, 32);
    const float inv = 1.0f / den;
    LDS_BARRIER();
#pragma unroll
    for (int i = 8; i < 16; ++i) { const int id = tid + 512 * i; st[i] = *(const v4u*)(Vg + (size_t)(id >> 5) * 2048 + (id & 31) * 8); }
#pragma unroll
    for (int i = 0; i < 16; ++i) { const int id = tid + 512 * i; *(LAS v4u*)(lds + (id >> 5) * XA_VSTRIDE + (id & 31) * 16) = st[i]; }
    LDS_BARRIER();
    const int lbase = tr_lane_base(lane, XA_VSTRIDE);
#pragma unroll
    for (int half = 0; half < 2; ++half) {
        f32x16 o[4];
#pragma unroll
        for (int vb = 0; vb < 4; ++vb)
#pragma unroll
            for (int i = 0; i < 16; ++i) o[vb][i] = 0.f;
#pragma unroll
        for (int kb = 0; kb < 8; ++kb)
#pragma unroll
            for (int s = 0; s < 2; ++s)
#pragma unroll
                for (int vb = 0; vb < 4; ++vb) { const bf16x8 a = tr_frag_perm(lds, XA_VSTRIDE, lbase, 32 * kb + 16 * s, 128 * half + 32 * vb); o[vb] = MFMA32(a, pf[kb][s], o[vb]); }
        LAS char* tile = lds + 256 * XA_VSTRIDE + w * 2560;
#pragma unroll
        for (int vb = 0; vb < 4; ++vb) {
#pragma unroll
            for (int g4 = 0; g4 < 4; ++g4) { v2u wv; wv.x = cvtpk(o[vb][4 * g4] * inv, o[vb][4 * g4 + 1] * inv); wv.y = cvtpk(o[vb][4 * g4 + 2] * inv, o[vb][4 * g4 + 3] * inv);
                *(LAS v2u*)(tile + r * 80 + (8 * g4 + 4 * h2) * 2) = wv; }
            asm volatile("s_waitcnt lgkmcnt(0)" ::: "memory");
#pragma unroll
            for (int i = 0; i < 2; ++i) { const int id = lane + 64 * i; *(v4u*)(O + (size_t)(row0 + 32 * w + (id >> 2)) * D + h * 256 + 128 * half + 32 * vb + 8 * (id & 3)) = *(const LAS v4u*)(tile + (id >> 2) * 80 + (id & 3) * 16); }
            asm volatile("s_waitcnt lgkmcnt(0)" ::: "memory");
        }
    }
    __syncthreads();
}


struct EpiXattn {
    static constexpr int PERM = 1; static constexpr bool AFTER_DRAIN = true;
    struct Pre { int unused; };
    const bf16* MKV; const float* gkq; bf16* O;
    __device__ __forceinline__ void init(f32x4 (&)[2][2][4][2], const pg8::Unit&, int, int, int, int) const {}
    __device__ __forceinline__ void fused(f32x4 (&acc)[2][2][4][2], const pg8::Unit& u, int wr, int wc, int fr, int fq, LAS unsigned char* lds, int wid, int lane) const {
#pragma unroll
        for (int ai = 0; ai < 2; ++ai)
#pragma unroll
            for (int m = 0; m < 4; ++m) { const int row = ai * 128 + wr * 64 + m * 16 + fr;
#pragma unroll
                for (int bj = 0; bj < 2; ++bj) { const f32x4 v0 = acc[ai][bj][m][0], v1 = acc[ai][bj][m][1];
                    v4u o; o.x = cvtpk(v0[0], v0[1]); o.y = cvtpk(v0[2], v0[3]); o.z = cvtpk(v1[0], v1[1]); o.w = cvtpk(v1[2], v1[3]);
                    *(LAS v4u*)(lds + row * XA_STRIDE + (bj * 128 + wc * 32 + 8 * fq) * 2) = o; } }
        asm volatile("s_waitcnt lgkmcnt(0)" ::: "memory"); __builtin_amdgcn_s_barrier(); asm volatile("" ::: "memory");
    }
};

constexpr int DA_STRIDE = 272, DA_VSTRIDE = 320, DA_LDS_BIAS = 384 * DA_VSTRIDE, DA_LDS_OSTG = DA_LDS_BIAS + 768, DA_OSTG_WAVE = 32 * 144 + 128;
static_assert(DA_LDS_OSTG + 8 * DA_OSTG_WAVE <= 163840 - 512, "dilated attention LDS map");
constexpr int DA_UNUSED0 = 0;
struct DaArgs { const bf16* QKV; const float* biasT; const float* gkq; bf16* N0; float* DEN0; const bf16* N1; const float* DEN1; const bf16* N2; const float* DEN2; bf16* O; int br0; int nbr; int mode; int pad; };
struct DaUnit { int br, b, h, dil, cls, l0; };
template <int MODE> __device__ __forceinline__ DaUnit da_decode(int uu) {
    DaUnit U; U.br = MODE == 0 ? __builtin_amdgcn_readfirstlane(1 + (uu >> 9)) : 0; const int rem = __builtin_amdgcn_readfirstlane(uu & 511), x = rem & 15; U.b = rem >> 7; U.h = (rem >> 4) & 7; U.dil = 1 << (2 * U.br);
    U.cls = U.br == 0 ? 0 : (U.br == 1 ? (x & 3) : x); U.l0 = 256 * (U.br == 0 ? x : (U.br == 1 ? (x >> 2) : 0)); return U; }
__device__ __forceinline__ void da_load_rows(v4u (&st)[12], const bf16* QKV, const DaUnit& U, int col, int tid) {
    const bf16* base = QKV + (size_t)(U.b * SEQ) * OD_IN + U.h * 128 + col + (tid & 15) * 8;
#pragma unroll
    for (int i = 0; i < 12; ++i) { const int ki = (tid >> 4) + 32 * i, lk = U.l0 - 128 + ki, lkc = lk < 0 ? 0 : lk; st[i] = *(const v4u*)(base + (size_t)(lkc * U.dil + U.cls) * OD_IN); }
}
template <int MODE> __device__ __forceinline__ void dattn_phase(LAS char* lds, const DaArgs& a, int bx, int G, int tid) {
    constexpr int NUNITS = MODE == 0 ? 1024 : 512;
    const int lane = tid & 63, w = __builtin_amdgcn_readfirstlane(tid >> 6), r = lane & 31, h2 = lane >> 5;
    int uu = (G == 256) ? (((bx & 7) << 5) | (bx >> 3)) : bx; if (uu >= NUNITS) return;
    v4u st[12];
    { const DaUnit U0 = da_decode<MODE>(uu); da_load_rows(st, a.QKV, U0, 1024, tid); }
    LAS float* lbias = (LAS float*)(lds + DA_LDS_BIAS);
    const int lbase = tr_lane_base(lane, DA_VSTRIDE);
    for (;;) {
        const DaUnit U = da_decode<MODE>(uu);
        const int l0 = U.l0, h = U.h; const bool zfirst = (l0 == 0);
        int r_l = r; asm volatile("" : "+v"(r_l));
        float gk8[8];
#pragma unroll
        for (int e = 0; e < 8; ++e) gk8[e] = a.gkq[(tid & 15) * 8 + e];
        const size_t qrow = (size_t)(U.b * SEQ + (l0 + 32 * w + r) * U.dil + U.cls);
#pragma unroll
        for (int i = 0; i < 12; ++i) { float f_[8]; unpack8((i < 4 && zfirst) ? (v4u){0u, 0u, 0u, 0u} : st[i], f_);
            float sq_ = (f_[0] * f_[0] + f_[1] * f_[1]) + (f_[2] * f_[2] + f_[3] * f_[3]) + (f_[4] * f_[4] + f_[5] * f_[5]) + (f_[6] * f_[6] + f_[7] * f_[7]);
            sq_ += __shfl_xor(sq_, 1); sq_ += __shfl_xor(sq_, 2); sq_ += __shfl_xor(sq_, 4); sq_ += __shfl_xor(sq_, 8);
            const float rk_ = 1.0f / sqrtf(sq_ * (1.0f / 128.0f) + EPS) * 0.08838834764831845f;
            v4u o_; o_.x = cvtpk(f_[0] * rk_ * gk8[0], f_[1] * rk_ * gk8[1]); o_.y = cvtpk(f_[2] * rk_ * gk8[2], f_[3] * rk_ * gk8[3]); o_.z = cvtpk(f_[4] * rk_ * gk8[4], f_[5] * rk_ * gk8[5]); o_.w = cvtpk(f_[6] * rk_ * gk8[6], f_[7] * rk_ * gk8[7]);
            *(LAS v4u*)(lds + ((tid >> 4) + 32 * i) * DA_STRIDE + (tid & 15) * 16) = o_; }
        if (tid < 192) { const int dl = tid - 32; lbias[tid] = (dl >= 0 && dl <= 128) ? a.biasT[(U.br * 8 + h) * 132 + dl] * 1.4426950408889634f - 11.541560327111707f : -__builtin_inff(); }
        asm volatile("" ::: "memory");
        bf16x8 qf[8];
#pragma unroll
        for (int s = 0; s < 8; ++s) qf[s] = *(const bf16x8*)(a.QKV + qrow * OD_IN + h * 128 + 8 * h2 + 16 * s);
        da_load_rows(st, a.QKV, U, 2048, tid);
        float ss = 0.f;
#pragma unroll
        for (int s = 0; s < 8; ++s)
#pragma unroll
            for (int j = 0; j < 8; ++j) { const float xq = __uint_as_float((unsigned)(unsigned short)qf[s][j] << 16); ss += xq * xq; }
        ss += __shfl_xor(ss, 32);
        const float rsl = 1.0f / sqrtf(ss * (1.0f / 128.0f) + EPS) * 1.4426950408889634f;
        LDS_BARRIER();
        bf16x8 pf[5][2]; float den = 0.f;
#pragma unroll
        for (int kbi = 0; kbi < 5; ++kbi) {
            if (zfirst && w + kbi < 4) { pf[kbi][0] = (bf16x8){0, 0, 0, 0, 0, 0, 0, 0}; pf[kbi][1] = pf[kbi][0]; continue; }
            f32x16 acc;
#pragma unroll
            for (int i = 0; i < 16; ++i) acc[i] = 0.f;
            const LAS char* kp = lds + (32 * (w + kbi) + r) * DA_STRIDE + h2 * 16;
#pragma unroll
            for (int s = 0; s < 8; ++s) { const bf16x8 av = *(const LAS bf16x8*)(kp + s * 32); acc = MFMA32(av, qf[s], acc); }
            __builtin_amdgcn_sched_barrier(0);
            const LAS float* tb = lbias + (r_l - 4 * h2);
#pragma unroll
            for (int hh = 0; hh < 2; ++hh) { float p[8];
#pragma unroll
                for (int i8 = 0; i8 < 8; ++i8) { const int i = 8 * hh + i8;
                    p[i8] = __builtin_amdgcn_exp2f(acc[i] * rsl + tb[160 - 32 * kbi - ((i & 3) + 8 * (i >> 2))]); den += p[i8]; }
                pf[kbi][hh] = pack8(p[0], p[1], p[2], p[3], p[4], p[5], p[6], p[7]);
                __builtin_amdgcn_sched_barrier(0); }
            asm volatile("" ::: "memory");
        }
        den += __shfl_xor(den, 32);
        LDS_BARRIER();
#pragma unroll
        for (int i = 0; i < 12; ++i) *(LAS v4u*)(lds + ((tid >> 4) + 32 * i) * DA_VSTRIDE + (tid & 15) * 16) = (i < 4 && zfirst) ? (v4u){0u, 0u, 0u, 0u} : st[i];
        LDS_BARRIER();
        const int un = uu + G; const bool more = un < NUNITS; const DaUnit Un = da_decode<MODE>(more ? un : uu);
        if (more) da_load_rows(st, a.QKV, Un, 1024, tid);
        LAS char* stg = lds + DA_LDS_OSTG + w * DA_OSTG_WAVE;
        float inv = 1.0f;
        if (MODE == 0) { if (h2 == 0) ((float*)(U.br == 1 ? a.DEN1 : a.DEN2))[qrow * 8 + h] = den; }
        else { inv = 1.0f / (den + a.DEN1[qrow * 8 + h] + a.DEN2[qrow * 8 + h]); if (h2 == 0) ((LAS float*)(stg + 32 * 144))[r] = inv; }
        size_t goff[4];
#pragma unroll
        for (int i = 0; i < 4; ++i) { const int id = lane + 64 * i, row = id >> 3, ch = id & 7; goff[i] = (size_t)(U.b * SEQ + (l0 + 32 * w + row) * U.dil + U.cls) * D + h * 128 + ch * 8; }
#pragma unroll
        for (int half = 0; half < 2; ++half) {
            f32x16 o[2];
            v4u n1v[4], n2v[4];
            if (MODE == 1) {
#pragma unroll
                for (int i = 0; i < 4; ++i) { n1v[i] = *(const v4u*)(a.N1 + goff[i] + 64 * half); n2v[i] = *(const v4u*)(a.N2 + goff[i] + 64 * half); } }
#pragma unroll
            for (int vb = 0; vb < 2; ++vb)
#pragma unroll
                for (int i = 0; i < 16; ++i) o[vb][i] = 0.f;
#pragma unroll
            for (int kbi = 0; kbi < 5; ++kbi)
#pragma unroll
                for (int s = 0; s < 2; ++s)
#pragma unroll
                    for (int vb = 0; vb < 2; ++vb) { const bf16x8 av = tr_frag_perm(lds, DA_VSTRIDE, lbase, 32 * (w + kbi) + 16 * s, 64 * half + 32 * vb); o[vb] = MFMA32(av, pf[kbi][s], o[vb]); }
#pragma unroll
            for (int vb = 0; vb < 2; ++vb)
#pragma unroll
                for (int g4 = 0; g4 < 4; ++g4) { v2u wv; wv.x = cvtpk(o[vb][4 * g4], o[vb][4 * g4 + 1]); wv.y = cvtpk(o[vb][4 * g4 + 2], o[vb][4 * g4 + 3]); *(LAS v2u*)(stg + r * 144 + (32 * vb + 8 * g4 + 4 * h2) * 2) = wv; }
            asm volatile("s_waitcnt lgkmcnt(0)" ::: "memory");
            if (MODE == 0) {
                bf16* N = (bf16*)(U.br == 1 ? a.N1 : a.N2) + 64 * half;
#pragma unroll
                for (int i = 0; i < 4; ++i) { const int id = lane + 64 * i; *(v4u*)(N + goff[i]) = *(const LAS v4u*)(stg + (id >> 3) * 144 + (id & 7) * 16); }
            } else {
#pragma unroll
                for (int i = 0; i < 4; ++i) { const int id = lane + 64 * i; float fo[8], f1[8], f2[8]; unpack8(*(const LAS v4u*)(stg + (id >> 3) * 144 + (id & 7) * 16), fo); unpack8(n1v[i], f1); unpack8(n2v[i], f2);
                    const float iv = ((const LAS float*)(stg + 32 * 144))[id >> 3];
                    v4u ov; ov.x = cvtpk((fo[0] + f1[0] + f2[0]) * iv, (fo[1] + f1[1] + f2[1]) * iv); ov.y = cvtpk((fo[2] + f1[2] + f2[2]) * iv, (fo[3] + f1[3] + f2[3]) * iv);
                    ov.z = cvtpk((fo[4] + f1[4] + f2[4]) * iv, (fo[5] + f1[5] + f2[5]) * iv); ov.w = cvtpk((fo[6] + f1[6] + f2[6]) * iv, (fo[7] + f1[7] + f2[7]) * iv);
                    *(v4u*)(a.O + goff[i] + 64 * half) = ov; }
            }
            asm volatile("s_waitcnt lgkmcnt(0)" ::: "memory");
        }
        LDS_BARRIER();
        if (!more) break;
        uu = un;
    }
}

constexpr int MX_STRIDE = 272, MX_TSTRIDE = 320, MX_IMG = 128 * MX_TSTRIDE;
constexpr int MX_Q = 0, MX_K = MX_IMG, MX_V = 2 * MX_IMG, MX_SCR = 3 * MX_IMG, MX_OSTG = MX_SCR + 5120;
constexpr int MX_UNUSED0 = 0;
struct MixArgs { bf16* Z; const float* lb; const float* ret_g; const float* hg_g; bf16* SBUF; float* DECA; float* DECB; };

__device__ __forceinline__ void st_chunk8(LAS char* img, int stride, int row, int c0, const float (&f)[8]) {
    v4u o; o.x = cvtpk(f[0], f[1]); o.y = cvtpk(f[2], f[3]); o.z = cvtpk(f[4], f[5]); o.w = cvtpk(f[6], f[7]); *(LAS v4u*)(img + row * stride + c0 * 2) = o; }

__device__ __forceinline__ void ret_prep_tile(LAS char* img, int stride, const bf16* zrow  , int j, int cg, const float (&sn)[16], const float (&cs)[16], float sc) {
#pragma unroll
    for (int hc = 0; hc < 2; ++hc) { float x1[8], x2[8], o1[8], o2[8];
        unpack8(*(const v4u*)(zrow + 16 * cg + 8 * hc), x1); unpack8(*(const v4u*)(zrow + 64 + 16 * cg + 8 * hc), x2);
#pragma unroll
        for (int e = 0; e < 8; ++e) { o1[e] = (x1[e] * cs[8 * hc + e] - x2[e] * sn[8 * hc + e]) * sc; o2[e] = (x1[e] * sn[8 * hc + e] + x2[e] * cs[8 * hc + e]) * sc; }
        st_chunk8(img, stride, j, 16 * cg + 8 * hc, o1); st_chunk8(img, stride, j, 64 + 16 * cg + 8 * hc, o2); }
}
__device__ __forceinline__ void copy_tile(LAS char* img, int stride, const bf16* src, int tid) {
#pragma unroll
    for (int i = 0; i < 4; ++i) { const int id = tid + 512 * i, row = id >> 4, ch = id & 15; *(LAS v4u*)(img + row * stride + ch * 16) = *(const v4u*)(src + (size_t)row * EV_IN + ch * 8); }
}
__device__ __forceinline__ void hg_gates(const bf16* zrow_f  , const float* lbh  , int tid, LAS float* scr, float (&cum)[32], float (&kk)[32]) {
    const int lane = tid & 63, hw = (tid >> 6) & 1, cg = tid >> 7;
#pragma unroll
    for (int q = 0; q < 4; ++q) { float fl[8]; unpack8(*(const v4u*)(zrow_f + 32 * cg + 8 * q), fl);
#pragma unroll
        for (int e = 0; e < 8; ++e) { const float l = lbh[32 * cg + 8 * q + e]; const float f = l + (1.0f - l) * (1.0f / (1.0f + __expf(-fl[e]))); kk[8 * q + e] = 1.0f - f; cum[8 * q + e] = __logf(fmaxf(f, 1e-6f)); } }
#pragma unroll
    for (int off = 1; off < 64; off <<= 1) {
#pragma unroll
        for (int c = 0; c < 32; ++c) { const float t = __shfl_up(cum[c], off); if (lane >= off) cum[c] += t; } }
    if (hw == 0 && lane == 63) {
#pragma unroll
        for (int c = 0; c < 32; ++c) scr[32 * cg + c] = cum[c]; }
    __syncthreads();
    if (hw == 1) {
#pragma unroll
        for (int c = 0; c < 32; ++c) cum[c] += scr[32 * cg + c]; }
    if (hw == 1 && lane == 63) {
#pragma unroll
        for (int c = 0; c < 32; ++c) scr[128 + 32 * cg + c] = cum[c]; }
    __syncthreads();
}

__device__ __forceinline__ void load_prep4(v4u (&rw)[4], const bf16* zrow_seg, int mixer, int cg) {
#pragma unroll
    for (int q = 0; q < 4; ++q) { const int col = mixer == 0 ? ((q >> 1) * 64 + 16 * cg + 8 * (q & 1)) : (32 * cg + 8 * q); rw[q] = *(const v4u*)(zrow_seg + col); }
}
__device__ __forceinline__ void load_copy4(v4u (&rw)[4], const bf16* tile, int tid) {
#pragma unroll
    for (int i = 0; i < 4; ++i) { const int id = tid + 512 * i; rw[i] = *(const v4u*)(tile + (size_t)(id >> 4) * EV_IN + (id & 15) * 8); }
}
__device__ __forceinline__ void store_copy4(LAS char* img, int stride, const v4u (&rw)[4], int tid) {
#pragma unroll
    for (int i = 0; i < 4; ++i) { const int id = tid + 512 * i; *(LAS v4u*)(img + (id >> 4) * stride + (id & 15) * 16) = rw[i]; }
}
__device__ __forceinline__ void ret_prep_raw(LAS char* img, int stride, const v4u (&rw)[4], int j, int cg, const float (&sn)[16], const float (&cs)[16], float sc) {
#pragma unroll
    for (int hc = 0; hc < 2; ++hc) { float x1[8], x2[8], o1[8], o2[8]; unpack8(rw[hc], x1); unpack8(rw[2 + hc], x2);
#pragma unroll
        for (int e = 0; e < 8; ++e) { o1[e] = (x1[e] * cs[8 * hc + e] - x2[e] * sn[8 * hc + e]) * sc; o2[e] = (x1[e] * sn[8 * hc + e] + x2[e] * cs[8 * hc + e]) * sc; }
        st_chunk8(img, stride, j, 16 * cg + 8 * hc, o1); st_chunk8(img, stride, j, 64 + 16 * cg + 8 * hc, o2); }
}
__device__ __forceinline__ void hg_gates_raw(const v4u (&rw)[4], const float* lbh, int tid, LAS float* scr, float (&cum)[32], float (&kk)[32]) {
    const int lane = tid & 63, hw = (tid >> 6) & 1, cg = tid >> 7;
#pragma unroll
    for (int q = 0; q < 4; ++q) { float fl[8]; unpack8(rw[q], fl);
#pragma unroll
        for (int e = 0; e < 8; ++e) { const float l = lbh[32 * cg + 8 * q + e]; const float f = l + (1.0f - l) * (1.0f / (1.0f + __expf(-fl[e]))); kk[8 * q + e] = 1.0f - f; cum[8 * q + e] = __logf(fmaxf(f, 1e-6f)); } }
#pragma unroll
    for (int off = 1; off < 64; off <<= 1) {
#pragma unroll
        for (int c = 0; c < 32; ++c) { const float t = __shfl_up(cum[c], off); if (lane >= off) cum[c] += t; } }
    if (hw == 0 && lane == 63) {
#pragma unroll
        for (int c = 0; c < 32; ++c) scr[32 * cg + c] = cum[c]; }
    LDS_BARRIER();
    if (hw == 1) {
#pragma unroll
        for (int c = 0; c < 32; ++c) cum[c] += scr[32 * cg + c]; }
    if (hw == 1 && lane == 63) {
#pragma unroll
        for (int c = 0; c < 32; ++c) scr[128 + 32 * cg + c] = cum[c]; }
    LDS_BARRIER();
}
struct MixU { int mixer, b, h, n; };
__device__ __forceinline__ MixU mix_decode(int u) { MixU U; const int g = __builtin_amdgcn_readfirstlane(u >> 5); U.n = __builtin_amdgcn_readfirstlane(u & 31); U.mixer = g >> 4; U.b = (g >> 2) & 3; U.h = g & 3; return U; }

__device__ __forceinline__ void mixA_phase(LAS char* lds, const MixArgs& a, int bx, int G, int tid) {
    const int lane = tid & 63, w = __builtin_amdgcn_readfirstlane(tid >> 6), r = lane & 31, h2 = lane >> 5;
    const int j = tid & 127, cg = tid >> 7;
    LAS float* scr = (LAS float*)(lds + MX_SCR);
    int u = bx; if (u >= 1024) return;
    v4u rk[4], rv[4];
    { const MixU U = mix_decode(u); const bf16* zt = a.Z + (size_t)(U.b * SEQ + 128 * U.n) * EV_IN;
      load_prep4(rk, zt + (size_t)j * EV_IN + (U.mixer == 0 ? Z_RK : Z_GF) + U.h * 128, U.mixer, cg); load_copy4(rv, zt + (U.mixer == 0 ? Z_RV : Z_GI) + U.h * 128, tid); }
    for (;;) {
        const MixU U = mix_decode(u); const int h = U.h, n = U.n;
        if (U.mixer == 0) {
            const float gamma = 1.0f - exp2f(-5.0f - (float)h), lg2 = log2f(gamma);
            float sn[16], cs[16];
#pragma unroll
            for (int e = 0; e < 16; ++e) { const float inv = exp2f(-(float)(16 * cg + e) * (13.287712379549449f / 64.0f)); rope_sincos((float)(128 * n + j) * inv, sn[e], cs[e]); }
            ret_prep_raw(lds + MX_K, MX_TSTRIDE, rk, j, cg, sn, cs, 0.08838834764831845f * exp2f((float)(127 - j) * lg2));
            if (tid < 128) { a.DECA[(size_t)u * 128 + tid] = exp2f(128.0f * lg2); a.DECB[(size_t)u * 128 + tid] = gamma; }
        } else {
            float cum[32], kk[32];
            hg_gates_raw(rk, a.lb + h * 128, tid, scr, cum, kk);
#pragma unroll
            for (int q = 0; q < 4; ++q) { float o[8];
#pragma unroll
                for (int e = 0; e < 8; ++e) o[e] = kk[8 * q + e] * __expf(scr[128 + 32 * cg + 8 * q + e] - cum[8 * q + e]);
                st_chunk8(lds + MX_K, MX_TSTRIDE, j, 32 * cg + 8 * q, o); }
            if (tid < 128) { a.DECA[(size_t)u * 128 + tid] = __expf(scr[128 + tid]); a.DECB[(size_t)u * 128 + tid] = __expf(scr[tid]); }
        }
        store_copy4(lds + MX_V, MX_TSTRIDE, rv, tid);
        LDS_BARRIER();
        const int un = u + G; const bool more = un < 1024;
        if (more) { const MixU Un = mix_decode(un); const bf16* zt = a.Z + (size_t)(Un.b * SEQ + 128 * Un.n) * EV_IN;
            load_prep4(rk, zt + (size_t)j * EV_IN + (Un.mixer == 0 ? Z_RK : Z_GF) + Un.h * 128, Un.mixer, cg); load_copy4(rv, zt + (Un.mixer == 0 ? Z_RV : Z_GI) + Un.h * 128, tid); }
        const int lbn = tr_lane_base_nat(lane, MX_TSTRIDE); const int kbk = w >> 1, vb0 = 2 * (w & 1);
        f32x16 acc[2];
#pragma unroll
        for (int t = 0; t < 2; ++t)
#pragma unroll
            for (int i = 0; i < 16; ++i) acc[t][i] = 0.f;
#pragma unroll
        for (int s_ = 0; s_ < 8; ++s_) { const bf16x8 av = tr_frag_nat(lds + MX_K, MX_TSTRIDE, lbn, 16 * s_, 32 * kbk);
#pragma unroll
            for (int t = 0; t < 2; ++t) { const bf16x8 bv = tr_frag_nat(lds + MX_V, MX_TSTRIDE, lbn, 16 * s_, 32 * (vb0 + t)); acc[t] = MFMA32(av, bv, acc[t]); } }
        bf16* sb = a.SBUF + (size_t)u * 16384;
#pragma unroll
        for (int t = 0; t < 2; ++t)
#pragma unroll
            for (int g4 = 0; g4 < 4; ++g4) { v2u wv; wv.x = cvtpk(acc[t][4 * g4], acc[t][4 * g4 + 1]); wv.y = cvtpk(acc[t][4 * g4 + 2], acc[t][4 * g4 + 3]);
                *(v2u*)(sb + ((((((vb0 + t) * 8 + 2 * kbk + (g4 >> 1)) * 2 + (g4 & 1)) * 32 + r) * 8) + 4 * h2)) = wv; }
        LDS_BARRIER();
        if (!more) break;
        u = un;
    }
}

__device__ __forceinline__ void mixA_unit(LAS char* lds, const MixArgs& a, int u, int tid) {
    const int lane = tid & 63, w = __builtin_amdgcn_readfirstlane(tid >> 6), r = lane & 31, h2 = lane >> 5;
    const int g = u >> 5, n = u & 31, mixer = g >> 4, b = (g >> 2) & 3, h = g & 3;
    const int j = tid & 127, cg = tid >> 7;
    const bf16* zt = a.Z + (size_t)(b * SEQ + 128 * n) * EV_IN;
    LAS float* scr = (LAS float*)(lds + MX_SCR);
    if (mixer == 0) {
        const float gamma = 1.0f - exp2f(-5.0f - (float)h), lg2 = log2f(gamma);
        float sn[16], cs[16];
#pragma unroll
        for (int e = 0; e < 16; ++e) { const float inv = exp2f(-(float)(16 * cg + e) * (13.287712379549449f / 64.0f)); rope_sincos((float)(128 * n + j) * inv, sn[e], cs[e]); }
        ret_prep_tile(lds + MX_K, MX_TSTRIDE, zt + (size_t)j * EV_IN + Z_RK + h * 128, j, cg, sn, cs, 0.08838834764831845f * exp2f((float)(127 - j) * lg2));
        copy_tile(lds + MX_V, MX_TSTRIDE, zt + Z_RV + h * 128, tid);
        if (tid < 128) { a.DECA[(size_t)u * 128 + tid] = exp2f(128.0f * lg2); a.DECB[(size_t)u * 128 + tid] = gamma; }
    } else {
        float cum[32], kk[32];
        hg_gates(zt + (size_t)j * EV_IN + Z_GF + h * 128, a.lb + h * 128, tid, scr, cum, kk);
#pragma unroll
        for (int q = 0; q < 4; ++q) { float o[8];
#pragma unroll
            for (int e = 0; e < 8; ++e) o[e] = kk[8 * q + e] * __expf(scr[128 + 32 * cg + 8 * q + e] - cum[8 * q + e]);
            st_chunk8(lds + MX_K, MX_TSTRIDE, j, 32 * cg + 8 * q, o); }
        copy_tile(lds + MX_V, MX_TSTRIDE, zt + Z_GI + h * 128, tid);
        if (tid < 128) { a.DECA[(size_t)u * 128 + tid] = __expf(scr[128 + tid]); a.DECB[(size_t)u * 128 + tid] = __expf(scr[tid]); }
    }
    __syncthreads();
    const int lbn = tr_lane_base_nat(lane, MX_TSTRIDE); const int kbk = w >> 1, vb0 = 2 * (w & 1);
    f32x16 acc[2];
#pragma unroll
    for (int t = 0; t < 2; ++t)
#pragma unroll
        for (int i = 0; i < 16; ++i) acc[t][i] = 0.f;
#pragma unroll
    for (int s = 0; s < 8; ++s) { const bf16x8 av = tr_frag_nat(lds + MX_K, MX_TSTRIDE, lbn, 16 * s, 32 * kbk);
#pragma unroll
        for (int t = 0; t < 2; ++t) { const bf16x8 bv = tr_frag_nat(lds + MX_V, MX_TSTRIDE, lbn, 16 * s, 32 * (vb0 + t)); acc[t] = MFMA32(av, bv, acc[t]); } }
    bf16* sb = a.SBUF + (size_t)u * 16384;
#pragma unroll
    for (int t = 0; t < 2; ++t)
#pragma unroll
        for (int g4 = 0; g4 < 4; ++g4) { v2u wv; wv.x = cvtpk(acc[t][4 * g4], acc[t][4 * g4 + 1]); wv.y = cvtpk(acc[t][4 * g4 + 2], acc[t][4 * g4 + 3]);
            *(v2u*)(sb + ((((((vb0 + t) * 8 + 2 * kbk + (g4 >> 1)) * 2 + (g4 & 1)) * 32 + r) * 8) + 4 * h2)) = wv; }
    __syncthreads();
}

__device__ __forceinline__ void mix_scan(const MixArgs& a, int gtid, int nthreads, bool dry = false) {
    for (int e = gtid; e < 32 * 4096; e += nthreads) { const int g = e >> 12, el = e & 4095, dk4 = 4 * ((el >> 7) & 7) + 2 * ((el >> 6) & 1) + (el & 1);
        bf16* sp = a.SBUF + (size_t)(g * 32) * 16384 + (size_t)el * 4; const float* da = a.DECA + (size_t)(g * 32) * 128 + 4 * dk4; const float* db = a.DECB + (size_t)(g * 32) * 128 + 4 * dk4;
        f32x4 S = (f32x4){0.f, 0.f, 0.f, 0.f};
#pragma unroll 8
        for (int n = 0; n < 32; ++n) { const v2u kv = *(const v2u*)(sp + (size_t)n * 16384); const f32x4 A = *(const f32x4*)(da + n * 128), Bv = *(const f32x4*)(db + n * 128);
            const f32x4 so = S * Bv; v2u wv; wv.x = cvtpk(so[0], so[1]); wv.y = cvtpk(so[2], so[3]); if (!dry) *(v2u*)(sp + (size_t)n * 16384) = wv;
            S[0] = A[0] * S[0] + __uint_as_float(kv.x << 16); S[1] = A[1] * S[1] + __uint_as_float(kv.x & 0xffff0000u); S[2] = A[2] * S[2] + __uint_as_float(kv.y << 16); S[3] = A[3] * S[3] + __uint_as_float(kv.y & 0xffff0000u); }
    }
}

__device__ __forceinline__ void mixC_unit(LAS char* lds, const MixArgs& a, int u, int tid, bool dry = false) {
    const int lane = tid & 63, w = __builtin_amdgcn_readfirstlane(tid >> 6), r = lane & 31, h2 = lane >> 5;
    const int g = u >> 5, n = u & 31, mixer = g >> 4, b = (g >> 2) & 3, h = g & 3;
    const int j = tid & 127, cg = tid >> 7;
    bf16* zt = a.Z + (size_t)(b * SEQ + 128 * n) * EV_IN;
    LAS float* scr = (LAS float*)(lds + MX_SCR);
    if (mixer == 0) {
        const float gamma = 1.0f - exp2f(-5.0f - (float)h), lg2 = log2f(gamma);
        float sn[16], cs[16];
#pragma unroll
        for (int e = 0; e < 16; ++e) { const float inv = exp2f(-(float)(16 * cg + e) * (13.287712379549449f / 64.0f)); rope_sincos((float)(128 * n + j) * inv, sn[e], cs[e]); }
        ret_prep_tile(lds + MX_Q, MX_STRIDE, zt + (size_t)j * EV_IN + Z_RQ + h * 128, j, cg, sn, cs, exp2f((float)j * lg2));
        ret_prep_tile(lds + MX_K, MX_STRIDE, zt + (size_t)j * EV_IN + Z_RK + h * 128, j, cg, sn, cs, 0.08838834764831845f * exp2f(-(float)j * lg2));
        copy_tile(lds + MX_V, MX_TSTRIDE, zt + Z_RV + h * 128, tid);
    } else {
        float cum[32], kk[32];
        hg_gates(zt + (size_t)j * EV_IN + Z_GF + h * 128, a.lb + h * 128, tid, scr, cum, kk);
#pragma unroll
        for (int q = 0; q < 4; ++q) { float qv[8], oq[8], ok[8]; unpack8(*(const v4u*)(zt + (size_t)j * EV_IN + Z_GQ + h * 128 + 32 * cg + 8 * q), qv);
#pragma unroll
            for (int e = 0; e < 8; ++e) { const float d = cum[8 * q + e] - scr[32 * cg + 8 * q + e]; oq[e] = qv[e] * __expf(d); ok[e] = kk[8 * q + e] * __expf(-d); }
            st_chunk8(lds + MX_Q, MX_STRIDE, j, 32 * cg + 8 * q, oq); st_chunk8(lds + MX_K, MX_STRIDE, j, 32 * cg + 8 * q, ok); }
        copy_tile(lds + MX_V, MX_TSTRIDE, zt + Z_GI + h * 128, tid);
    }
    __syncthreads();
    const int vb = w >> 1; const int lbp = tr_lane_base(lane, MX_TSTRIDE);
    const bf16* sb = a.SBUF + (size_t)u * 16384 + (size_t)((vb * 16 + h2) * 32 + r) * 8;
    bf16x8 sf[8];
#pragma unroll
    for (int s = 0; s < 8; ++s) sf[s] = *(const bf16x8*)(sb + s * 512);
    f32x16 o[2]; float s1[2], s2[2];
    const float* rg_ = a.ret_g; const float* hg_ = a.hg_g; const float* gn = (mixer == 0 ? rg_ : hg_) + h * 128 + 32 * vb + 4 * h2;
    v4u gwv[4];
#pragma unroll
    for (int t = 0; t < 2; ++t) { const int ib = (w & 1) ? (1 + t) : (3 * t);
#pragma unroll
        for (int i = 0; i < 2; ++i) { const int id = lane + 64 * i; gwv[2 * t + i] = *(const v4u*)(zt + (size_t)(32 * ib + (id >> 2)) * EV_IN + (mixer == 0 ? Z_RG : Z_GG) + h * 128 + 32 * vb + 8 * (id & 3)); } }
#pragma unroll
    for (int t = 0; t < 2; ++t) {
        const int ib = (w & 1) ? (1 + t) : (3 * t);
        bf16x8 qf[8];
#pragma unroll
        for (int s = 0; s < 8; ++s) qf[s] = *(const LAS bf16x8*)(lds + MX_Q + (32 * ib + r) * MX_STRIDE + h2 * 16 + s * 32);
#pragma unroll
        for (int i = 0; i < 16; ++i) o[t][i] = 0.f;
#pragma unroll
        for (int s = 0; s < 8; ++s) o[t] = MFMA32(sf[s], qf[s], o[t]);
        for (int jb = 0; jb <= ib; ++jb) {
            f32x16 acc;
#pragma unroll
            for (int i = 0; i < 16; ++i) acc[i] = 0.f;
            const LAS char* kp = lds + MX_K + (32 * jb + r) * MX_STRIDE + h2 * 16;
#pragma unroll
            for (int s = 0; s < 8; ++s) { const bf16x8 av = *(const LAS bf16x8*)(kp + s * 32); acc = MFMA32(av, qf[s], acc); }
            if (jb == ib) {
#pragma unroll
                for (int i = 0; i < 16; ++i) { const int c = (i & 3) + 8 * (i >> 2) + 4 * h2; if (c > r) acc[i] = 0.f; } }
            const bf16x8 p0 = pack8(acc[0], acc[1], acc[2], acc[3], acc[4], acc[5], acc[6], acc[7]), p1 = pack8(acc[8], acc[9], acc[10], acc[11], acc[12], acc[13], acc[14], acc[15]);
            const bf16x8 v0 = tr_frag_perm(lds + MX_V, MX_TSTRIDE, lbp, 32 * jb, 32 * vb), v1 = tr_frag_perm(lds + MX_V, MX_TSTRIDE, lbp, 32 * jb + 16, 32 * vb);
            o[t] = MFMA32(v0, p0, o[t]); o[t] = MFMA32(v1, p1, o[t]);
        }
        float a1 = 0.f, a2 = 0.f;
#pragma unroll
        for (int i = 0; i < 16; ++i) { a1 += o[t][i]; a2 += o[t][i] * o[t][i]; }
        a1 += __shfl_xor(a1, 32); a2 += __shfl_xor(a2, 32); s1[t] = a1; s2[t] = a2;
        if (h2 == 0) { scr[256 + (vb * 128 + 32 * ib + r) * 2] = a1; scr[256 + (vb * 128 + 32 * ib + r) * 2 + 1] = a2; }
    }
    LDS_BARRIER();
#pragma unroll
    for (int t = 0; t < 2; ++t) {
        const int ib = (w & 1) ? (1 + t) : (3 * t); const int tok = 32 * ib + r;
        float t1 = 0.f, t2 = 0.f;
#pragma unroll
        for (int v = 0; v < 4; ++v) { t1 += scr[256 + (v * 128 + tok) * 2]; t2 += scr[256 + (v * 128 + tok) * 2 + 1]; }
        float mu = 0.f, rstd;
        if (mixer == 0) { mu = t1 * (1.0f / 128.0f); rstd = 1.0f / sqrtf(fmaxf(t2 * (1.0f / 128.0f) - mu * mu, 0.f) + EPS); } else rstd = 1.0f / sqrtf(t2 * (1.0f / 128.0f) + EPS);
        bf16* zr = zt + (size_t)tok * EV_IN;
        (void)zr;
        LAS char* tile = lds + MX_OSTG + w * 2560;
#pragma unroll
        for (int i = 0; i < 2; ++i) { const int id = lane + 64 * i; *(LAS v4u*)(tile + (id >> 2) * 80 + (id & 3) * 16) = gwv[2 * t + i]; }
        asm volatile("s_waitcnt lgkmcnt(0)" ::: "memory");
#pragma unroll
        for (int g4 = 0; g4 < 4; ++g4) { const v2u gw = *(const LAS v2u*)(tile + r * 80 + (8 * g4 + 4 * h2) * 2); const f32x4 gv = *(const f32x4*)(gn + 8 * g4);
            const float ga[4] = {__uint_as_float(gw.x << 16), __uint_as_float(gw.x & 0xffff0000u), __uint_as_float(gw.y << 16), __uint_as_float(gw.y & 0xffff0000u)}; float y[4];
#pragma unroll
            for (int e = 0; e < 4; ++e) { y[e] = (o[t][4 * g4 + e] - mu) * rstd * gv[e] * (ga[e] / (1.0f + __expf(-ga[e]))); }
            v2u wv; wv.x = cvtpk(y[0], y[1]); wv.y = cvtpk(y[2], y[3]); *(LAS v2u*)(tile + r * 80 + (8 * g4 + 4 * h2) * 2) = wv; }
        asm volatile("s_waitcnt lgkmcnt(0)" ::: "memory");
#pragma unroll
        for (int i = 0; i < 2; ++i) { const int id = lane + 64 * i; const v4u yv = *(const LAS v4u*)(tile + (id >> 2) * 80 + (id & 3) * 16);
            if (!dry) *(v4u*)(zt + (size_t)(32 * ib + (id >> 2)) * EV_IN + (mixer == 0 ? Z_RQ : Z_GQ) + h * 128 + 32 * vb + 8 * (id & 3)) = yv; }
        asm volatile("s_waitcnt lgkmcnt(0)" ::: "memory");
    }
    __syncthreads();
}


__device__ __forceinline__ float gelu_tanh(float x) { const float u = 0.7978845608028654f * (x + 0.044715f * x * x * x); const float t = 1.0f - 2.0f / (1.0f + __expf(2.0f * u)); return 0.5f * x * (1.0f + t); }
__device__ __forceinline__ void ffn_ew(const bf16* GU, const float* cw, const float* cb, bf16* H, int rows, int gtid, int nthreads) {
    for (int idx = gtid; idx < rows * (DFF / 8); idx += nthreads) {
        const int row = idx / (DFF / 8), c0 = (idx % (DFF / 8)) * 8, t = row % SEQ;
        float g0[8], g1[8], g2[8], u[8];
        unpack8(*(const v4u*)(GU + (size_t)row * (2 * DFF) + c0), g2); unpack8(*(const v4u*)(GU + (size_t)row * (2 * DFF) + DFF + c0), u);
        if (t >= 1) unpack8(*(const v4u*)(GU + (size_t)(row - 1) * (2 * DFF) + c0), g1); else { for (int i = 0; i < 8; ++i) g1[i] = 0.f; }
        if (t >= 2) unpack8(*(const v4u*)(GU + (size_t)(row - 2) * (2 * DFF) + c0), g0); else { for (int i = 0; i < 8; ++i) g0[i] = 0.f; }
        float r[8];
#pragma unroll
        for (int i = 0; i < 8; ++i) { const float y = cw[c0 + i] * g0[i] + cw[DFF + c0 + i] * g1[i] + cw[2 * DFF + c0 + i] * g2[i] + cb[c0 + i]; r[i] = gelu_tanh(y) * u[i]; }
        v4u o; o.x = cvtpk(r[0], r[1]); o.y = cvtpk(r[2], r[3]); o.z = cvtpk(r[4], r[5]); o.w = cvtpk(r[6], r[7]);
        *(v4u*)(H + (size_t)row * DFF + c0) = o;
    }
}

constexpr int LDS_BYTES = 163840;
constexpr int LDSCTL_OFF = LDS_BYTES - 512;
constexpr int CW_BAR = 4096;
constexpr size_t CTL_ZERO_BYTES = 1 * MiB;
#define XB_TMO      128
#define XB_XCNT(j)  (256  + 64 * (j))
#define XB_XSUB(j)  (1280 + 64 * (j))
#define XB_XGEN(j)  (2304 + 64 * (j))
#define XB_TOP      3328
#define XB_TOPGEN   3392
#define XCD_BAR_WORDS 3456
#define XB_SPIN_CAP (1u << 18)

__device__ __forceinline__ unsigned xb_ld(unsigned* p)              { return __hip_atomic_load(p, __ATOMIC_RELAXED, __HIP_MEMORY_SCOPE_AGENT); }
__device__ __forceinline__ unsigned xb_add(unsigned* p, unsigned v) { return __hip_atomic_fetch_add(p, v, __ATOMIC_RELAXED, __HIP_MEMORY_SCOPE_AGENT); }
__device__ __forceinline__ unsigned xb_xcc_id() { return (unsigned)__builtin_amdgcn_s_getreg((3 << 11) | 20) & 0xFu; }
#define XB_SPIN(cond, bar) do { unsigned _sp = 0; while (cond) { __builtin_amdgcn_s_sleep(1); \
    if ((++_sp & 255u) == 0u) { if (xb_ld(&(bar)[XB_TMO])) break; if (_sp > XB_SPIN_CAP) { atomicAdd(&(bar)[XB_TMO], 1u); break; } } } } while (0)

struct XcdBarrier {
    unsigned* bar; unsigned x;
    volatile LAS unsigned* st;
};

__device__ __forceinline__ XcdBarrier xcd_barrier_post(unsigned* bar, volatile LAS unsigned* st) {
    XcdBarrier b; b.bar = bar; b.x = xb_xcc_id(); b.st = st;
    if (threadIdx.x == 0) (void)xb_add(&bar[XB_XCNT(b.x)], 1u);
    return b;
}
__device__ __forceinline__ void xcd_barrier_complete(unsigned* bar, unsigned x, unsigned& nloc, unsigned& nx) {
    const unsigned G = gridDim.x * gridDim.y * gridDim.z;
    unsigned sum, cnt, mine, sp = 0u;
    for (;;) {
        sum = 0u; cnt = 0u; mine = 0u;
#pragma unroll
        for (unsigned j = 0; j < 16; ++j) { const unsigned c = xb_ld(&bar[XB_XCNT(j)]); sum += c; cnt += (c > 0u) ? 1u : 0u; mine = (j == x) ? c : mine; }
        if (sum == G) break;
        __builtin_amdgcn_s_sleep(1);
        if ((++sp & 255u) == 0u) { if (xb_ld(&bar[XB_TMO])) break; if (sp > XB_SPIN_CAP) { atomicAdd(&bar[XB_TMO], 1u); break; } }
    }
    nloc = mine > 0u ? mine : 1u; nx = cnt > 0u ? cnt : 1u;
}

__device__ __forceinline__ void xcd_barrier(const XcdBarrier& b) {
    asm volatile("s_waitcnt vmcnt(0)" ::: "memory");
    __syncthreads();
    if (threadIdx.x == 0) {
        unsigned* bar = b.bar;
        __builtin_amdgcn_s_waitcnt(0);
        unsigned nloc = b.st[0], nx = b.st[1];
        if (nloc == 0u) { xcd_barrier_complete(bar, b.x, nloc, nx); b.st[0] = nloc; b.st[1] = nx; }
        const unsigned old = xb_add(&bar[XB_XSUB(b.x)], 1u);
        const unsigned gen = old / nloc;
        if (old + 1u == (gen + 1u) * nloc) {
            __builtin_amdgcn_fence(__ATOMIC_RELEASE, "agent");
            asm volatile("s_waitcnt vmcnt(0)" ::: "memory");
            const unsigned og = xb_add(&bar[XB_TOP], 1u);
            const unsigned tg = og / nx;
            if (og + 1u == (tg + 1u) * nx) xb_add(&bar[XB_TOPGEN], 1u);
            else XB_SPIN(xb_ld(&bar[XB_TOPGEN]) == tg, bar);
            __builtin_amdgcn_fence(__ATOMIC_ACQUIRE, "agent");
            xb_add(&bar[XB_XGEN(b.x)], 1u);
            asm volatile("s_waitcnt vmcnt(0)" ::: "memory");
        } else {
            XB_SPIN(xb_ld(&bar[XB_XGEN(b.x)]) == gen, bar);
            __builtin_amdgcn_fence(__ATOMIC_ACQUIRE, "agent");
            asm volatile("s_waitcnt vmcnt(0)" ::: "memory");
        }
    }
    __syncthreads();
}


__device__ __forceinline__ GAS unsigned char* launder_s(unsigned char* p) { unsigned long long v = (unsigned long long)p; asm volatile("" : "+s"(v)); return (GAS unsigned char*)v; }
__device__ __forceinline__ GAS float* launder_sf(float* p) { unsigned long long v = (unsigned long long)p; asm volatile("" : "+s"(v)); return (GAS float*)v; }
struct FwdArgs { const float* in[25]; float* out; unsigned char* ws; int ph_lo, ph_hi, li, pad; };
__global__ void __launch_bounds__(512, 2) fwd(FwdArgs a) {
    extern __shared__ __attribute__((aligned(16))) unsigned char lds_raw[];
    LAS unsigned char* lds = (LAS unsigned char*)lds_raw;
    const int tid = threadIdx.x, lane = tid & 63, wave = __builtin_amdgcn_readfirstlane(tid >> 6);
    const int G = gridDim.x, bx = blockIdx.x;
    volatile LAS unsigned* MISC = (volatile LAS unsigned*)(lds + LDSCTL_OFF);
    if (tid < 64) MISC[tid] = 0u;
    __syncthreads();
#define WSP (launder_s(a.ws))
#define OUTP (launder_sf(a.out))
    XcdBarrier bar = xcd_barrier_post((unsigned*)(WSP + WS_CTL) + CW_BAR + a.li * XCD_BAR_WORDS, MISC + 8);
    int ph = 0; const int lo = a.ph_lo, hi = a.ph_hi;
#define PH_ON true) for (int rp_ = 0, nr_ = (ph >= lo && ph < hi) ? 1 + ((a.pad >> ph) & 1) : 0; rp_ < nr_; ++rp_, __syncthreads()
#define TID_L ({ int l_; asm volatile("v_mbcnt_lo_u32_b32 %0, -1, 0\n\tv_mbcnt_hi_u32_b32 %0, -1, %0" : "=v"(l_)); wave * 64 + l_; })
#define PH_END do { if (ph >= lo && ph + 1 < hi) xcd_barrier(bar); ++ph; } while (0)
#define XB ((bf16*)(WSP + WS_XB))
#define SSQP ((float*)(WSP + WS_SSQP))
#define ACT ((bf16*)(WSP + WS_ACT))

    if (PH_ON) { ProArgs pa;
#pragma unroll
        for (int i = 0; i < 25; ++i) pa.in[i] = a.in[i];
        pa.ws = (unsigned char*)WSP; pa.layer_mask = 3; pa.ffn_mode = 2;
        { const int t_ = TID_L; prologue_body(pa, bx * 8 + (t_ >> 6), G * 8, t_ & 63, (LAS float*)lds + (t_ >> 6) * 64 * 65); } }
    PH_END;

    for (int l = 0; l < 2; ++l) {
        if (PH_ON) {
            { pg8::Gemm g{XB, (const bf16*)(WSP + (l ? WS_ODIN : WS_EVIN)), M, l ? OD_IN : EV_IN, D, D}; pg8::EpiBf16S E{ACT, SSQP, l ? OD_IN : EV_IN, M, EPS, 0};
              pg8::StaticOrder S; S.init(g.M, g.N, G, bx); pg8::gemm_phase<pg8::EpiBf16S, pg8::StaticOrder, true, true>(lds, g, S, E, TID_L); }
        }
        PH_END;
        const bf16* mixo; int mixo_ld;
        if (l == 0) {
            MixArgs ma{ACT, (const float*)(WSP + WS_LB), a.in[4], a.in[5], (bf16*)OUTP, (float*)(WSP + WS_DECA), (float*)(WSP + WS_DECB)};
            if (PH_ON) mixA_phase((LAS char*)lds, ma, bx, G, TID_L);
            PH_END;
            if (PH_ON) {
                if (bx < 64 && G > 64) { const int lm = bx >> 5;
                    pg8::Gemm g{(const bf16*)(WSP + (lm ? WS_MEMH1 : WS_MEMH0)), (const bf16*)(WSP + (lm ? WS_XKV1 : WS_XKV0)), MM, 2 * D, D, D}; pg8::EpiBf16S E{(bf16*)(WSP + (lm ? WS_MKV1 : WS_MKV0)), nullptr, 2 * D, M, EPS, 0};
                    pg8::StaticOrder S; S.init(g.M, g.N, G, bx & 31); pg8::gemm_phase<pg8::EpiBf16S, pg8::StaticOrder, true, true>(lds, g, S, E, TID_L); }
                else mix_scan(ma, (bx - 64) * 512 + TID_L, (G - 64) * 512, rp_ + 1 < nr_);
            }
            PH_END;
            if (PH_ON) { for (int u = bx; u < 1024; u += G) mixC_unit((LAS char*)lds, ma, u, TID_L, rp_ + 1 < nr_); }
            PH_END;
            mixo = ACT; mixo_ld = EV_IN;
        } else {
            bf16* O = (bf16*)(WSP + WS_ACT + 96 * MiB);
            DaArgs da; da.QKV = ACT; da.biasT = (const float*)(WSP + WS_BIAST); da.gkq = (const float*)(WSP + WS_GOD); da.N0 = (bf16*)(WSP + WS_N2); da.DEN0 = (float*)(WSP + WS_DEN23);
            da.N1 = (const bf16*)(WSP + WS_N2); da.DEN1 = (const float*)(WSP + WS_DEN23); da.N2 = (const bf16*)OUTP; da.DEN2 = (const float*)(WSP + WS_DEN23) + (size_t)M * 8; da.O = O; da.br0 = 1; da.nbr = 2; da.mode = 0; da.pad = 0;
            if (PH_ON) dattn_phase<0>((LAS char*)lds, da, bx, G, TID_L);
            PH_END;
            if (PH_ON) dattn_phase<1>((LAS char*)lds, da, bx, G, TID_L);
            PH_END;
            mixo = O; mixo_ld = D;
        }
        if (PH_ON) { pg8::Gemm g{mixo, (const bf16*)(WSP + (l ? WS_ODOUT : WS_EVOUT)), M, D, D, mixo_ld}; pg8::EpiResid E{l ? (const float*)nullptr : a.in[0], nullptr, XB, SSQP, D, M};
            pg8::StaticOrder S; S.init(g.M, g.N, G, bx); pg8::gemm_phase<pg8::EpiResid, pg8::StaticOrder, false, true>(lds, g, S, E, TID_L); }
        PH_END;
        { bf16* O = (bf16*)(WSP + WS_ACT + 32 * MiB);
          if (PH_ON) { pg8::Gemm g{XB, (const bf16*)(WSP + (l ? WS_XQ1 : WS_XQ0)), M, D, D, D}; EpiXattn E{(const bf16*)(WSP + (l ? WS_MKV1 : WS_MKV0)), (const float*)(WSP + WS_GXA) + l * 256, O};
              pg8::StaticOrder S; S.init(g.M, g.N, G, bx); pg8::gemm_phase<EpiXattn, pg8::StaticOrder, false, true>(lds, g, S, E, TID_L);
              pg8::StaticOrder S2; S2.init(M, D, G, bx); pg8::Unit uq; if (S2.next(0, uq)) xattn_unit<true>((LAS char*)lds, nullptr, (const bf16*)(WSP + (l ? WS_MKV1 : WS_MKV0)), (const float*)(WSP + WS_GXA) + l * 256, O, uq.pm * 4 + uq.pn, TID_L); }
          PH_END;
          if (PH_ON) { pg8::Gemm g{O, (const bf16*)(WSP + (l ? WS_XO1 : WS_XO0)), M, D, D, D}; pg8::EpiResid E{nullptr, nullptr, XB, SSQP, D, M};
              pg8::StaticOrder S; S.init(g.M, g.N, G, bx); pg8::gemm_phase<pg8::EpiResid, pg8::StaticOrder, false, true>(lds, g, S, E, TID_L); }
          PH_END; }
        { bf16* H = ACT;
          if (PH_ON) { pg8::Gemm g{XB, (const bf16*)(WSP + (l ? WS_FIN1 : WS_FIN0)), 68 * 256, 2 * DFF, D, D}; pg8::EpiFfn E{H, SSQP, a.in[22] + (size_t)l * 3 * DFF, a.in[23] + (size_t)l * DFF, M, EPS};
              pg8::FfnOrder S; S.init(g.M, g.N, G, bx); pg8::gemm_phase<pg8::EpiFfn, pg8::FfnOrder, true, true>(lds, g, S, E, TID_L); }
          PH_END;
          if (PH_ON) { pg8::Gemm g{H, (const bf16*)(WSP + (l ? WS_FOUT1 : WS_FOUT0)), M, D, DFF, DFF}; pg8::EpiResid E{nullptr, l ? (float*)OUTP : (float*)nullptr, XB, SSQP, D, M};
              pg8::StaticOrder S; S.init(g.M, g.N, G, bx); pg8::gemm_phase<pg8::EpiResid, pg8::StaticOrder, false, true>(lds, g, S, E, TID_L); }
          PH_END; }
    }
#undef PH_ON
#undef PH_END
#undef TID_L
#undef WSP
#undef OUTP
#undef XB
#undef SSQP
#undef ACT
}
constexpr int N_PHASES = 1 + 9 + 8;

#ifndef PROBE_MASK
#define PROBE_MASK 0
#endif
#ifndef MK_PER_PHASE
#define MK_PER_PHASE 0
#endif
extern "C" void kernel_launch(void* const* d_in, const int* in_sizes, int n_in, void* d_out, int out_size, void* d_ws, size_t ws_size, hipStream_t stream) {
    static int inited = 0;
    if (!inited) {
        if (n_in != 25 || out_size != M * D || ws_size < WS_END) { fprintf(stderr, "kernel_launch: unexpected shapes (n_in %d, out %d, ws %zu)\n", n_in, out_size, ws_size); inited = -1; return; }
        if (hipFuncSetAttribute((const void*)fwd, hipFuncAttributeMaxDynamicSharedMemorySize, LDS_BYTES) != hipSuccess) { fprintf(stderr, "kernel_launch: hipFuncSetAttribute failed\n"); inited = -1; return; }
        inited = 1;
    }
    if (inited < 0) return;
    if (hipMemsetAsync((char*)d_ws + WS_CTL, 0, CTL_ZERO_BYTES, stream) != hipSuccess) return;
    FwdArgs fa{}; for (int i = 0; i < 25; ++i) fa.in[i] = (const float*)d_in[i]; fa.out = (float*)d_out; fa.ws = (unsigned char*)d_ws; fa.pad = PROBE_MASK;
#if MK_PER_PHASE
    for (int p = 0; p < N_PHASES; ++p) { fa.ph_lo = p; fa.ph_hi = p + 1; fa.li = 0; hipLaunchKernelGGL(fwd, dim3(256), dim3(512), LDS_BYTES, stream, fa); }
#else
    fa.ph_lo = 0; fa.ph_hi = N_PHASES; fa.li = 0; hipLaunchKernelGGL(fwd, dim3(256), dim3(512), LDS_BYTES, stream, fa);
#endif
}
```

```cpp
#include <hip/hip_runtime.h>
#include <cstdio>
#include <cstdint>
namespace pg8 {
#define PG8_LAS __attribute__((address_space(3)))
typedef unsigned short bf16_t;
typedef short bf16x8 __attribute__((ext_vector_type(8)));
typedef float f32x4 __attribute__((ext_vector_type(4)));
typedef unsigned u32x4 __attribute__((ext_vector_type(4)));
constexpr int BM = 256, BK = 64, HALF = 128, HTB = HALF * BK * 2  , STAGE_BYTES = 8 * HTB, NXCD = 8, WGM = 8;
constexpr int SSQ_LDS = STAGE_BYTES + 4096, CW_LDS = STAGE_BYTES + 8192;

__host__ __device__ __forceinline__ int lds_byte(int r, int c) { const int st = (r >> 4) * 2 + (c >> 5), rr = r & 15, cc = c & 31, ob = rr * 64 + cc * 2; return st * 1024 + (ob ^ (((ob >> 9) & 1) << 5)); }
__host__ __device__ __forceinline__ void stage_rc(int b, int& R, int& C) { const int st = b / 1024, sb = b % 1024, swz = sb ^ (((sb >> 9) & 1) << 5); R = (st >> 1) * 16 + swz / 64; C = (st & 1) * 32 + (swz % 64) / 2; }
__host__ __device__ __forceinline__ int perm32(int rho) { const int n = rho >> 4, i = rho & 15; return 8 * (i >> 2) + 4 * n + (i & 3); }

struct Unit { int pm, pn; };
struct Gemm { const bf16_t* A; const bf16_t* Bt; int M, N, K, lda; };

struct StaticOrder {
    int nM, nN, nwg, G, c, wgm;
    __host__ __device__ __forceinline__ void init(int M, int N, int G_, int c_, int wgm_ = 4) { nM = M / BM; nN = N / BM; nwg = nM * nN; G = G_; c = c_; wgm = wgm_; }
    __host__ __device__ __forceinline__ bool next(int i, Unit& u) const {
        const long L = (long)i * G + c; if (L >= nwg) return false;
        int wgid = (int)L; { const int q = nwg / NXCD, r = nwg % NXCD, xcd = wgid % NXCD, off = wgid / NXCD; wgid = (xcd < r ? xcd * (q + 1) : r * (q + 1) + (xcd - r) * q) + off; }
        const int nig = wgm * nN, gid = wgid / nig, fm = gid * wgm, gsz = (nM - fm) < wgm ? (nM - fm) : wgm;
        u.pm = fm + ((wgid % nig) % gsz); u.pn = (wgid % nig) / gsz; return true;
    }
    __device__ __forceinline__ void a_ready(const Unit&) const {}
    __device__ __forceinline__ void done(const Unit&) const {}
    __device__ __forceinline__ int arow(const Unit& u) const { return u.pm * BM; }
};
struct FfnOrder : StaticOrder {
    __device__ __forceinline__ int arow(const Unit& u) const { return (u.pm / 17) * 4096 + 254 * (u.pm % 17) - 2; }
};

__device__ __forceinline__ unsigned cvt_pk_bf16(float lo, float hi) { unsigned r; asm volatile("v_cvt_pk_bf16_f32 %0, %1, %2" : "=v"(r) : "v"(lo), "v"(hi)); return r; }
typedef float f32x2 __attribute__((ext_vector_type(2)));
struct EpiBf16S {
    static constexpr int PERM = 3; static constexpr bool AFTER_DRAIN = false;
    bf16_t* O; const float* ssqp; int ldc; int Mtot; float eps; int pad;
    __device__ __forceinline__ void preload(PG8_LAS unsigned char* lds, const Unit& u, int wr, int wc, int lane) const {
        if (!ssqp) return;
#pragma unroll
        for (int ai = 0; ai < 2; ++ai) __builtin_amdgcn_global_load_lds((const unsigned*)(ssqp + (size_t)wc * Mtot + u.pm * BM + ai * HALF + wr * 64 + lane), (PG8_LAS unsigned*)(lds + SSQ_LDS + (((wr * 2 + ai) * 4 + wc) * 64) * 4), 4, 0, 0);
    }
    __device__ __forceinline__ void preload_unit(PG8_LAS unsigned char*, const Unit&, int, int, int) const {}
    __device__ __forceinline__ void operator()(f32x4 (&acc)[2][2][4][2], const Unit& u, int wr, int wc, int fr, int fq, PG8_LAS unsigned char* lds) const {
        const int row0 = u.pm * BM + wr * 64 + fr; const int col0 = u.pn * BM + wc * 64 + 8 * fq;
        const PG8_LAS float* sl = (const PG8_LAS float*)(lds + SSQ_LDS);
#pragma unroll
        for (int ai = 0; ai < 2; ++ai)
#pragma unroll
            for (int m = 0; m < 4; ++m) { const int row = row0 + ai * HALF + m * 16; float rs = 1.f;
                if (ssqp) { const PG8_LAS float* sp = sl + ((wr * 2 + ai) * 4) * 64 + m * 16 + fr; const float s = (sp[0] + sp[64]) + (sp[128] + sp[192]); rs = 1.0f / sqrtf(s * (1.0f / 1024.0f) + eps); }
                bf16_t* rowp = O + (size_t)row * ldc + col0;
#pragma unroll
                for (int bj = 0; bj < 2; ++bj) { const f32x4 v0 = acc[ai][bj][m][0] * rs, v1 = acc[ai][bj][m][1] * rs;
                    u32x4 w; w.x = cvt_pk_bf16(v0[0], v0[1]); w.y = cvt_pk_bf16(v0[2], v0[3]); w.z = cvt_pk_bf16(v1[0], v1[1]); w.w = cvt_pk_bf16(v1[2], v1[3]);
                    *(u32x4*)(rowp + bj * 32) = w; } }
    }
};

__device__ __forceinline__ float gelu_tanh_f(float x) { const float u = 0.7978845608028654f * (x + 0.044715f * x * x * x); const float t = 1.0f - 2.0f / (1.0f + __expf(2.0f * u)); return 0.5f * x * (1.0f + t); }
struct EpiFfn {
    static constexpr int PERM = 1; static constexpr bool AFTER_DRAIN = false;
    bf16_t* H; const float* ssqp; const float* cw; const float* cb; int Mtot; float eps;
    __device__ __forceinline__ void preload(PG8_LAS unsigned char* lds, const Unit& u, int wr, int wc, int lane) const {
        const int rowb = (u.pm / 17) * 4096 + 254 * (u.pm % 17) - 2;
#pragma unroll
        for (int ai = 0; ai < 2; ++ai) { const int row = rowb + ai * HALF + wr * 64 + lane; const int rc = row < 0 ? 0 : (row >= Mtot ? Mtot - 1 : row);
            __builtin_amdgcn_global_load_lds((const unsigned*)(ssqp + (size_t)wc * Mtot + rc), (PG8_LAS unsigned*)(lds + SSQ_LDS + (((wr * 2 + ai) * 4 + wc) * 64) * 4), 4, 0, 0); }
    }
    __device__ __forceinline__ void preload_unit(PG8_LAS unsigned char* lds, const Unit& u, int wr, int wc, int lane) const {
        const float* src = (wc < 3 ? cw + (size_t)wc * 2816 : cb) + u.pn * 128 + 64 * wr + lane;
        __builtin_amdgcn_global_load_lds((const unsigned*)src, (PG8_LAS unsigned*)(lds + CW_LDS + (wc * 128 + 64 * wr) * 4), 4, 0, 0);
    }
    __device__ __forceinline__ void operator()(f32x4 (&acc)[2][2][4][2], const Unit& u, int wr, int wc, int fr, int fq, PG8_LAS unsigned char* lds) const {
        constexpr int DFF_ = 2816;
        const int b = u.pm / 17, t = u.pm % 17, pos0 = 254 * t - 2, rowb = b * 4096 + pos0;
        const int colh = u.pn * 128 + wc * 32 + 8 * fq, lane = fq * 16 + fr;
        PG8_LAS float* halo = (PG8_LAS float*)(lds + STAGE_BYTES);
#pragma unroll
        for (int ai = 0; ai < 2; ++ai)
#pragma unroll
            for (int m = 0; m < 4; ++m) { const int rl = ai * HALF + wr * 64 + m * 16 + fr; const PG8_LAS float* sp = (const PG8_LAS float*)(lds + SSQ_LDS) + ((wr * 2 + ai) * 4) * 64 + m * 16 + fr;
                const float sq = (sp[0] + sp[64]) + (sp[128] + sp[192]); const float rs = 1.0f / sqrtf(sq * (1.0f / 1024.0f) + eps); const bool pad = (pos0 + rl) < 0;
#pragma unroll
                for (int n = 0; n < 2; ++n) {
#pragma unroll
                    for (int e = 0; e < 4; ++e) { acc[ai][0][m][n][e] = pad ? 0.f : acc[ai][0][m][n][e] * rs; acc[ai][1][m][n][e] *= rs; } } }
#pragma unroll
        for (int ai = 0; ai < 2; ++ai) if (fr >= 14) { PG8_LAS float* hp = halo + ((((2 * ai + wr) * 4 + wc) * 4 + fq) * 2 + (fr - 14)) * 8;
            *(PG8_LAS f32x4*)hp = acc[ai][0][3][0]; *(PG8_LAS f32x4*)(hp + 4) = acc[ai][0][3][1]; }
        asm volatile("s_waitcnt lgkmcnt(0)" ::: "memory"); __builtin_amdgcn_s_barrier(); asm volatile("" ::: "memory");
        typedef unsigned u32x2e __attribute__((ext_vector_type(2)));
#define DPPF(x, ctrl) __builtin_bit_cast(float, __builtin_amdgcn_update_dpp(0, __builtin_bit_cast(int, (x)), (ctrl), 0xf, 0xf, true))
        u32x2e hold[2][4];
#pragma unroll
        for (int n = 0; n < 2; ++n) {
            const PG8_LAS float* cwl = (const PG8_LAS float*)(lds + CW_LDS) + wc * 32 + 8 * fq + 4 * n;
            const f32x4 w0 = *(const PG8_LAS f32x4*)cwl, w1 = *(const PG8_LAS f32x4*)(cwl + 128), w2 = *(const PG8_LAS f32x4*)(cwl + 256), bb = *(const PG8_LAS f32x4*)(cwl + 384);
#pragma unroll
            for (int ai = 0; ai < 2; ++ai) {
                const int blk = 2 * ai + wr; f32x4 R1p = (f32x4){0.f, 0.f, 0.f, 0.f}, R2p = (f32x4){0.f, 0.f, 0.f, 0.f};
                if (blk >= 1) { const PG8_LAS float* hp = halo + ((((blk - 1) * 4 + wc) * 4 + fq) * 2) * 8 + 4 * n; const f32x4 h62 = *(const PG8_LAS f32x4*)hp, h63 = *(const PG8_LAS f32x4*)(hp + 8);
                    const f32x4 z4 = (f32x4){0.f, 0.f, 0.f, 0.f}; R1p = fr == 0 ? h63 : z4; R2p = fr == 0 ? h62 : (fr == 1 ? h63 : z4); }
#pragma unroll
                for (int m = 0; m < 4; ++m) { const int rl = ai * HALF + wr * 64 + m * 16 + fr; const bool ok = (rl >= 2) && (pos0 + rl < 4096);
                    float hv[4];
#pragma unroll
                    for (int e = 0; e < 4; ++e) { const float v = acc[ai][0][m][n][e];
                        const float p1 = DPPF(v, 0x111) + R1p[e], p2 = DPPF(v, 0x112) + R2p[e]; R1p[e] = DPPF(v, 0x10F); R2p[e] = DPPF(v, 0x10E);
                        const float y = w0[e] * p2 + (w1[e] * p1 + (w2[e] * v + bb[e]));
                        const float tq = y * (-2.302208198f + -0.10294324f * (y * y));
                        const float sg = __builtin_amdgcn_rcpf(1.0f + __builtin_amdgcn_exp2f(tq));
                        hv[e] = (y * acc[ai][1][m][n][e]) * sg; }
                    u32x2e w; w.x = cvt_pk_bf16(hv[0], hv[1]); w.y = cvt_pk_bf16(hv[2], hv[3]);
                    if (n == 0) hold[ai][m] = w;
                    else if (ok) { u32x4 w4; w4.x = hold[ai][m].x; w4.y = hold[ai][m].y; w4.z = w.x; w4.w = w.y; *(u32x4*)(H + (size_t)(rowb + rl) * DFF_ + colh) = w4; } }
            }
        }
#undef DPPF
        asm volatile("s_waitcnt lgkmcnt(0)" ::: "memory"); __builtin_amdgcn_s_barrier(); asm volatile("" ::: "memory");
    }
};
struct EpiResid {
    static constexpr int PERM = 1; static constexpr bool AFTER_DRAIN = true;
    struct Pre { int unused; };
    const float* base; float* out; bf16_t* xb; float* ssqp; int ldc; int Mtot;
    __device__ __forceinline__ void init(f32x4 (&acc)[2][2][4][2], const Unit& u, int wr, int wc, int fr, int fq) const {
        const int col0 = u.pn * BM + wc * 32 + 8 * fq;
#pragma unroll
        for (int ai = 0; ai < 2; ++ai)
#pragma unroll
            for (int m = 0; m < 4; ++m) { const size_t off = (size_t)(u.pm * BM + ai * HALF + wr * 64 + m * 16 + fr) * ldc + col0;
#pragma unroll
                for (int bj = 0; bj < 2; ++bj) {
                    if (base) { acc[ai][bj][m][0] = __builtin_nontemporal_load((const f32x4*)(base + off + bj * HALF)); acc[ai][bj][m][1] = __builtin_nontemporal_load((const f32x4*)(base + off + bj * HALF + 4)); }
                    else { const u32x4 w = __builtin_nontemporal_load((const u32x4*)(xb + off + bj * HALF));
                        acc[ai][bj][m][0] = (f32x4){__uint_as_float(w.x << 16), __uint_as_float(w.x & 0xffff0000u), __uint_as_float(w.y << 16), __uint_as_float(w.y & 0xffff0000u)};
                        acc[ai][bj][m][1] = (f32x4){__uint_as_float(w.z << 16), __uint_as_float(w.z & 0xffff0000u), __uint_as_float(w.w << 16), __uint_as_float(w.w & 0xffff0000u)}; } } }
    }
    __device__ __forceinline__ void fused(f32x4 (&acc)[2][2][4][2], const Unit& u, int wr, int wc, int fr, int fq, PG8_LAS unsigned char* lds, int wid, int lane) const {
        PG8_LAS float* P = (PG8_LAS float*)lds;
        const int col0 = u.pn * BM + wc * 32 + 8 * fq;
#pragma unroll
        for (int ai = 0; ai < 2; ++ai)
#pragma unroll
            for (int m = 0; m < 4; ++m) { const int r = ai * HALF + wr * 64 + m * 16 + fr; const size_t off = (size_t)(u.pm * BM + r) * ldc + col0; float s = 0.f;
#pragma unroll
                for (int bj = 0; bj < 2; ++bj) { const f32x4 o0 = acc[ai][bj][m][0], o1 = acc[ai][bj][m][1];
                    if (out) { __builtin_nontemporal_store(o0, (f32x4*)(out + off + bj * HALF)); __builtin_nontemporal_store(o1, (f32x4*)(out + off + bj * HALF + 4)); }
                    u32x4 w; w.x = cvt_pk_bf16(o0[0], o0[1]); w.y = cvt_pk_bf16(o0[2], o0[3]); w.z = cvt_pk_bf16(o1[0], o1[1]); w.w = cvt_pk_bf16(o1[2], o1[3]); *(u32x4*)(xb + off + bj * HALF) = w;
                    s += ((o0[0] * o0[0] + o0[1] * o0[1]) + (o0[2] * o0[2] + o0[3] * o0[3])) + ((o1[0] * o1[0] + o1[1] * o1[1]) + (o1[2] * o1[2] + o1[3] * o1[3])); }
                s += __shfl_xor(s, 16); s += __shfl_xor(s, 32);
                if (fq == 0) P[r * 4 + wc] = s;
                if (m & 1) asm volatile("" ::: "memory"); }
        asm volatile("s_waitcnt lgkmcnt(0)" ::: "memory"); __builtin_amdgcn_s_barrier(); asm volatile("" ::: "memory");
        if (lane < 32) { const int row = wid * 32 + lane; ssqp[(size_t)u.pn * Mtot + u.pm * BM + row] = (P[row * 4 + 0] + P[row * 4 + 1]) + (P[row * 4 + 2] + P[row * 4 + 3]); }
        asm volatile("s_waitcnt lgkmcnt(0)" ::: "memory"); __builtin_amdgcn_s_barrier(); asm volatile("" ::: "memory");
    }
};

template <class Epi, class Sched, bool ALIGN_EPI = false, bool SP2 = false>
__device__ __forceinline__ void gemm_phase(PG8_LAS unsigned char* lds, const Gemm g, const Sched& S, const Epi& E, int tid_in) {
    int tid_l = tid_in; asm volatile("" : "+v"(tid_l));
    const int tid = tid_l, wid = __builtin_amdgcn_readfirstlane(tid >> 6), lane = tid & 63, wr = wid >> 2, wc = wid & 3, fr = lane & 15, fq = lane >> 4;
    const int K = g.K, nt = K / BK;
    unsigned voffA[2], voffB[2];
#pragma unroll
    for (int i = 0; i < 2; ++i) { int R, C; stage_rc(tid * 16 + i * 8192, R, C); const int Rb = (int)Epi::PERM == 3 ? (64 * (R >> 5) + perm32(R & 31)) : ((int)Epi::PERM == 1 ? ((R & ~31) + perm32(R & 31)) : R);
        voffA[i] = (unsigned)(R * g.lda + C) * 2u; voffB[i] = (unsigned)(Rb * K + C) * 2u; }
    const size_t kstep = (size_t)(BK * 2);
    const size_t hstepA = (size_t)HALF * g.lda * 2, hstepB = (size_t)((int)Epi::PERM == 3 ? 32 : HALF) * K * 2;
    const size_t tstepB = (size_t)BM * K * 2;
    const unsigned ldsw = (unsigned)wid * 1024u;
    const int aoff = lds_byte(wr * 64 + fr, fq * 8), boff = lds_byte(wc * 32 + fr, fq * 8);
#define PG8_SA(b, h) (((b) * 2 + (h)) * HTB)
#define PG8_SB(b, h) ((4 + (b) * 2 + (h)) * HTB)
#define PG8_STAGE(bufoff, gbase, voff) do { _Pragma("unroll") for (int _i = 0; _i < 2; ++_i) \
        __builtin_amdgcn_global_load_lds((const unsigned*)((const char*)(gbase) + (voff)[_i]), (PG8_LAS unsigned*)(lds + (bufoff) + ldsw + _i * 8192), 16, 0, 0); } while (0)
#define PG8_LDA(dst, b, h) do { _Pragma("unroll") for (int m = 0; m < 4; ++m) _Pragma("unroll") for (int k = 0; k < 2; ++k) dst[m][k] = *(const PG8_LAS bf16x8*)(lds + PG8_SA(b, h) + aoff + m * 2048 + k * 1024); } while (0)
#define PG8_LDB(dst, b, h) do { _Pragma("unroll") for (int n = 0; n < 2; ++n) _Pragma("unroll") for (int k = 0; k < 2; ++k) dst[n][k] = *(const PG8_LAS bf16x8*)(lds + PG8_SB(b, h) + boff + n * 2048 + k * 1024); } while (0)
#define PG8_MMA(ai, bj, At, Bt) do { __builtin_amdgcn_s_setprio(1); _Pragma("unroll") for (int m = 0; m < 4; ++m) _Pragma("unroll") for (int n = 0; n < 2; ++n) _Pragma("unroll") for (int k = 0; k < 2; ++k) \
        acc[ai][bj][m][n] = __builtin_amdgcn_mfma_f32_16x16x32_bf16(Bt[n][k], At[m][k], acc[ai][bj][m][n], 0, 0, 0); __builtin_amdgcn_s_setprio(0); } while (0)
#define PG8_WAIT_V(n) asm volatile("s_waitcnt vmcnt(" #n ")" ::: "memory")
#define PG8_WAIT_L(n) asm volatile("s_waitcnt lgkmcnt(" #n ")" ::: "memory")
#define PG8_BAR __builtin_amdgcn_s_barrier()
#define PG8_SCHED __builtin_amdgcn_sched_barrier(0)
    Unit cur, nxt; int ui = 0;
    if (!S.next(0, cur)) return;
    f32x4 acc[2][2][4][2];
#pragma unroll
    for (int a = 0; a < 2; ++a)
#pragma unroll
        for (int b = 0; b < 2; ++b)
#pragma unroll
            for (int m = 0; m < 4; ++m)
#pragma unroll
                for (int n = 0; n < 2; ++n) acc[a][b][m][n] = (f32x4){0.f, 0.f, 0.f, 0.f};
    if constexpr (Epi::AFTER_DRAIN) E.init(acc, cur, wr, wc, fr, fq);
    bf16x8 At[4][2], B0[2][2], B1[2][2];
    const char* cA = (const char*)g.A + (ptrdiff_t)S.arow(cur) * (ptrdiff_t)(g.lda * 2); const char* cB = (const char*)g.Bt + (size_t)cur.pn * tstepB;
    S.a_ready(cur);
    if constexpr (!Epi::AFTER_DRAIN) E.preload_unit(lds, cur, wr, wc, lane);
    if constexpr (SP2) {
        PG8_STAGE(PG8_SB(0, 0), cB, voffB); PG8_STAGE(PG8_SB(0, 1), cB + hstepB, voffB); PG8_STAGE(PG8_SA(0, 0), cA, voffA); PG8_STAGE(PG8_SA(0, 1), cA + hstepA, voffA);
        if (wr == 1) PG8_BAR;
        PG8_WAIT_V(2); PG8_BAR;
        PG8_STAGE(PG8_SB(1, 0), cB + kstep, voffB); PG8_STAGE(PG8_SA(1, 0), cA + kstep, voffA); PG8_STAGE(PG8_SB(1, 1), cB + hstepB + kstep, voffB);
        PG8_WAIT_V(6); PG8_BAR;
        if constexpr (Epi::AFTER_DRAIN) {
#pragma unroll
            for (int a_ = 0; a_ < 2; ++a_)
#pragma unroll
                for (int b_ = 0; b_ < 2; ++b_) asm volatile("" : "+v"(acc[a_][b_][0][0]), "+v"(acc[a_][b_][0][1]), "+v"(acc[a_][b_][1][0]), "+v"(acc[a_][b_][1][1]), "+v"(acc[a_][b_][2][0]), "+v"(acc[a_][b_][2][1]), "+v"(acc[a_][b_][3][0]), "+v"(acc[a_][b_][3][1]));
        }
    } else {
        PG8_STAGE(PG8_SB(0, 0), cB, voffB); PG8_STAGE(PG8_SA(0, 0), cA, voffA); PG8_STAGE(PG8_SB(0, 1), cB + hstepB, voffB); PG8_STAGE(PG8_SA(0, 1), cA + hstepA, voffA);
        if (wr == 1) PG8_BAR;
        PG8_WAIT_V(4); PG8_BAR;
        PG8_STAGE(PG8_SB(1, 0), cB + kstep, voffB); PG8_STAGE(PG8_SA(1, 0), cA + kstep, voffA); PG8_STAGE(PG8_SB(1, 1), cB + hstepB + kstep, voffB);
        PG8_WAIT_V(6); PG8_BAR;
    }
    for (;;) {
        const bool has_next = S.next(ui + 1, nxt);
        const char* nA = has_next ? (const char*)g.A + (ptrdiff_t)S.arow(nxt) * (ptrdiff_t)(g.lda * 2) : cA; const char* nB = has_next ? (const char*)g.Bt + (size_t)nxt.pn * tstepB : cB;
        for (int t = 0; t < nt; t += 2) {
            const bool last = (t == nt - 2);
            const char* a1 = cA + (size_t)(t + 1) * kstep;
            const char* a2 = last ? nA : cA + (size_t)(t + 2) * kstep; const char* b2 = last ? nB : cB + (size_t)(t + 2) * kstep;
            const char* a3 = a2 + kstep; const char* b3 = b2 + kstep;
            if (last && has_next) S.a_ready(nxt);
            if constexpr (!Epi::AFTER_DRAIN) { if (last) E.preload(lds, cur, wr, wc, lane); }
            if constexpr (SP2) {
            PG8_LDB(B0, 0, 0); PG8_LDB(B1, 0, 1); PG8_SCHED; PG8_LDA(At, 0, 0); PG8_STAGE(PG8_SA(1, 1), a1 + hstepA, voffA);
            PG8_WAIT_V(8); PG8_WAIT_L(0); PG8_BAR; PG8_MMA(0, 0, At, B0); PG8_MMA(0, 1, At, B1); PG8_BAR; PG8_SCHED;
            PG8_LDA(At, 0, 1); PG8_STAGE(PG8_SB(0, 0), b2, voffB); PG8_STAGE(PG8_SB(0, 1), b2 + hstepB, voffB); PG8_STAGE(PG8_SA(0, 0), a2, voffA);
            PG8_WAIT_V(8); PG8_WAIT_L(0); PG8_BAR; PG8_MMA(1, 0, At, B0); PG8_MMA(1, 1, At, B1); PG8_BAR; PG8_SCHED;
            PG8_LDB(B0, 1, 0); PG8_LDB(B1, 1, 1); PG8_SCHED; PG8_LDA(At, 1, 0); PG8_STAGE(PG8_SA(0, 1), a2 + hstepA, voffA);
            PG8_WAIT_V(8); PG8_WAIT_L(0); PG8_BAR; PG8_MMA(0, 0, At, B0); PG8_MMA(0, 1, At, B1); PG8_BAR; PG8_SCHED;
            PG8_LDA(At, 1, 1); PG8_STAGE(PG8_SB(1, 0), b3, voffB); PG8_STAGE(PG8_SB(1, 1), b3 + hstepB, voffB); PG8_STAGE(PG8_SA(1, 0), a3, voffA);
            PG8_WAIT_V(8); PG8_WAIT_L(0); PG8_BAR; PG8_MMA(1, 0, At, B0); PG8_MMA(1, 1, At, B1); PG8_BAR; PG8_SCHED;
            } else {
            PG8_LDB(B0, 0, 0); PG8_SCHED; PG8_LDA(At, 0, 0); PG8_STAGE(PG8_SA(1, 1), a1 + hstepA, voffA);
            PG8_WAIT_L(8); PG8_BAR; PG8_WAIT_L(0); PG8_MMA(0, 0, At, B0); PG8_BAR; PG8_SCHED;
            PG8_LDB(B1, 0, 1); PG8_STAGE(PG8_SB(0, 0), b2, voffB);
            PG8_BAR; PG8_WAIT_L(0); PG8_MMA(0, 1, At, B1); PG8_BAR;
            PG8_LDA(At, 0, 1); PG8_STAGE(PG8_SA(0, 0), a2, voffA);
            PG8_BAR; PG8_WAIT_L(0); PG8_MMA(1, 0, At, B0); PG8_BAR; PG8_SCHED;
            PG8_STAGE(PG8_SB(0, 1), b2 + hstepB, voffB);
            PG8_WAIT_V(6); PG8_BAR; PG8_MMA(1, 1, At, B1); PG8_BAR;
            PG8_LDB(B0, 1, 0); PG8_SCHED; PG8_LDA(At, 1, 0); PG8_STAGE(PG8_SA(0, 1), a2 + hstepA, voffA);
            PG8_WAIT_L(8); PG8_BAR; PG8_WAIT_L(0); PG8_MMA(0, 0, At, B0); PG8_BAR; PG8_SCHED;
            PG8_LDB(B1, 1, 1); PG8_STAGE(PG8_SB(1, 0), b3, voffB);
            PG8_BAR; PG8_WAIT_L(0); PG8_MMA(0, 1, At, B1); PG8_BAR;
            PG8_LDA(At, 1, 1); PG8_STAGE(PG8_SA(1, 0), a3, voffA);
            PG8_BAR; PG8_WAIT_L(0); PG8_MMA(1, 0, At, B0); PG8_BAR; PG8_SCHED;
            PG8_STAGE(PG8_SB(1, 1), b3 + hstepB, voffB);
            PG8_WAIT_V(6); PG8_BAR; PG8_MMA(1, 1, At, B1); PG8_BAR;
            }
        }
        if constexpr (ALIGN_EPI) { if (wr == 0) PG8_BAR; }
        if constexpr (!Epi::AFTER_DRAIN) { E(acc, cur, wr, wc, fr, fq, lds); S.done(cur); if (has_next) E.preload_unit(lds, nxt, wr, wc, lane); }
        if (!has_next) break;
#pragma unroll
        for (int a = 0; a < 2; ++a)
#pragma unroll
            for (int b = 0; b < 2; ++b)
#pragma unroll
                for (int m = 0; m < 4; ++m)
#pragma unroll
                    for (int n = 0; n < 2; ++n) acc[a][b][m][n] = (f32x4){0.f, 0.f, 0.f, 0.f};
        cur = nxt; cA = nA; cB = nB; ++ui;
        if constexpr (ALIGN_EPI) { if (wr == 1) PG8_BAR; }
    }
    PG8_WAIT_V(0);
    if constexpr (!ALIGN_EPI) { if (wr == 0) PG8_BAR; }
    PG8_BAR;
    if constexpr (Epi::AFTER_DRAIN) { E.fused(acc, cur, wr, wc, fr, fq, lds, wid, lane); S.done(cur); }
#undef PG8_SA
#undef PG8_SB
#undef PG8_STAGE
#undef PG8_LDA
#undef PG8_LDB
#undef PG8_MMA
#undef PG8_WAIT_V
#undef PG8_WAIT_L
#undef PG8_BAR
#undef PG8_SCHED
}
}


#define GAS __attribute__((address_space(1)))
#define LAS __attribute__((address_space(3)))
typedef unsigned short bf16;
typedef unsigned v4u __attribute__((ext_vector_type(4)));
typedef unsigned v2u __attribute__((ext_vector_type(2)));
typedef float f32x4 __attribute__((ext_vector_type(4)));
constexpr int BATCH = 4, SEQ = 4096, D = 1024, M = BATCH * SEQ, NMEM = 256, MM = BATCH * NMEM, DFF = 2816;
constexpr int EV_IN = 4096, OD_IN = 3072;
constexpr float EPS = 1e-6f;
constexpr int Z_RQ = 0, Z_GQ = 512, Z_RK = 1024, Z_RV = 1536, Z_RG = 2048, Z_GF = 2560, Z_GI = 3072, Z_GG = 3584;

constexpr size_t MiB = 1u << 20;
constexpr size_t WS_CTL = 0;
constexpr size_t WS_EVIN = 1 * MiB, WS_EVOUT = 9 * MiB, WS_XQ0 = 11 * MiB, WS_XKV0 = 13 * MiB, WS_XO0 = 17 * MiB, WS_FIN0 = 19 * MiB, WS_FOUT0 = 30 * MiB;
constexpr size_t WS_ODIN = 36 * MiB, WS_ODOUT = 42 * MiB, WS_XQ1 = 44 * MiB, WS_XKV1 = 46 * MiB, WS_XO1 = 50 * MiB, WS_FIN1 = 52 * MiB, WS_FOUT1 = 63 * MiB;
constexpr size_t WS_XB = 69 * MiB;
constexpr size_t WS_MKV0 = 101 * MiB, WS_MKV1 = 105 * MiB;
constexpr size_t WS_MEMH0 = 109 * MiB, WS_MEMH1 = 111 * MiB;
constexpr size_t WS_SSQP = 113 * MiB;
constexpr size_t WS_LB = 113 * MiB + 512 * 1024;
constexpr size_t WS_BIAST = 113 * MiB + 516 * 1024;
constexpr size_t WS_GXA = 113 * MiB + 600 * 1024, WS_GOD = 113 * MiB + 604 * 1024;
constexpr size_t WS_DEN23 = 114 * MiB;
constexpr size_t WS_N2 = 1 * MiB;
constexpr size_t WS_ACT = 115 * MiB;
constexpr size_t WS_DECA = 243 * MiB, WS_DECB = 243 * MiB + 512 * 1024;
constexpr size_t WS_END = 256 * MiB;

__device__ __forceinline__ float bf2f(bf16 u) { return __uint_as_float((unsigned)u << 16); }
__device__ __forceinline__ unsigned f2bf(float f) { unsigned u = __builtin_bit_cast(unsigned, f); return (u + 0x7fffu + ((u >> 16) & 1u)) >> 16; }
__device__ __forceinline__ unsigned pk2(float lo, float hi) { return f2bf(lo) | (f2bf(hi) << 16); }
__device__ __forceinline__ float wave_sum(float v) {
#pragma unroll
    for (int o = 1; o < 64; o <<= 1) v += __shfl_xor(v, o);
    return v;
}
__device__ __forceinline__ float wave_max(float v) {
#pragma unroll
    for (int o = 1; o < 64; o <<= 1) v = fmaxf(v, __shfl_xor(v, o));
    return v;
}
__device__ __forceinline__ void unpack8(const v4u w, float (&f)[8]) {
    f[0] = __uint_as_float(w.x << 16); f[1] = __uint_as_float(w.x & 0xffff0000u); f[2] = __uint_as_float(w.y << 16); f[3] = __uint_as_float(w.y & 0xffff0000u);
    f[4] = __uint_as_float(w.z << 16); f[5] = __uint_as_float(w.z & 0xffff0000u); f[6] = __uint_as_float(w.w << 16); f[7] = __uint_as_float(w.w & 0xffff0000u);
}
__device__ __forceinline__ void rope_sincos(float a, float& s, float& c) {
    const float n = rintf(a * 0.15915494309189535f);
    float r = fmaf(-n, 6.2831854820251465f, a); r = fmaf(-n, -1.7484555e-7f, r);
    const float rev = r * 0.15915494309189535f;
    s = __builtin_amdgcn_sinf(rev); c = __builtin_amdgcn_cosf(rev);
}

__device__ __forceinline__ int dst_row_map(int mode, int n0) {
    if (mode == 1) { const int seg = n0 >> 9, within = n0 & 511; const int dseg = (seg == 0) ? 0 : (seg == 4 ? 1 : (seg < 4 ? seg + 1 : seg)); return dseg * 512 + within; }
    if (mode == 2) { return n0 < DFF ? (n0 >> 7) * 256 + (n0 & 127) : ((n0 - DFF) >> 7) * 256 + 128 + ((n0 - DFF) & 127); }
    return n0;
}
__device__ __forceinline__ void transpose_item(const float* W, int K, int N, const float* g, bf16* WT, int mode, LAS float* scr, int item, int lane) {
    const int nblk = N / 64, kb = item / nblk, nb = item % nblk, k0 = 64 * kb, n0 = 64 * nb, lr = lane >> 4, lc = lane & 15;
    f32x4 v[16];
#pragma unroll
    for (int i = 0; i < 16; ++i) v[i] = __builtin_nontemporal_load((const f32x4*)(W + (size_t)(k0 + 4 * i + lr) * N + n0 + 4 * lc));
#pragma unroll
    for (int i = 0; i < 16; ++i) { const int kk = 4 * i + lr; const float gg = g ? g[k0 + kk] : 1.0f; LAS float* p = scr + kk * 65 + 4 * lc; p[0] = v[i][0] * gg; p[1] = v[i][1] * gg; p[2] = v[i][2] * gg; p[3] = v[i][3] * gg; }
    asm volatile("s_waitcnt lgkmcnt(0)" ::: "memory");
    const int c = lane & 7; const int d0 = dst_row_map(mode, n0);
#pragma unroll
    for (int j = 0; j < 8; ++j) { const int n = (lane >> 3) + 8 * j; const LAS float* sp = scr + (8 * c) * 65 + n;
        v4u o; o.x = pk2(sp[0 * 65], sp[1 * 65]); o.y = pk2(sp[2 * 65], sp[3 * 65]); o.z = pk2(sp[4 * 65], sp[5 * 65]); o.w = pk2(sp[6 * 65], sp[7 * 65]);
        *(v4u*)(WT + (size_t)(d0 + n) * K + k0 + 8 * c) = o; }
    asm volatile("s_waitcnt lgkmcnt(0)" ::: "memory");
}
struct ProArgs { const float* in[25]; unsigned char* ws; int layer_mask; int ffn_mode; };
#define PICK_JOB(Wp_, K__, N__, gp_, dst_, mode_) if (!found) { const int ni_ = ((K__) / 64) * ((N__) / 64); if (r < ni_) { W_ = (Wp_); K_ = (K__); N_ = (N__); g_ = (gp_); d_ = (dst_); m_ = (mode_); found = true; } else r -= ni_; }
__device__ __forceinline__ void prologue_body(const ProArgs& a, int gw, int NGW, int lane, LAS float* scr) {
    unsigned char* ws = a.ws;
    const float* x = a.in[0]; const float* mem = a.in[1];
    if (a.layer_mask & 1) {
        constexpr int NITEMS_ALL = 2 * ((D / 64) * (D / 64) * 3 + (D / 64) * (2 * D / 64) + (D / 64) * (2 * DFF / 64) + (DFF / 64) * (D / 64)) + (D / 64) * (EV_IN / 64) + (D / 64) * (OD_IN / 64) + (D / 64) * (D / 64) * 0;
        for (int it = gw; it < NITEMS_ALL; it += NGW) {
            int r = it; bool found = false; const float* W_ = nullptr; const float* g_ = nullptr; int K_ = 0, N_ = 0, m_ = 0; size_t d_ = 0;
            PICK_JOB(a.in[3], D, EV_IN, a.in[2], WS_EVIN, 1)
            PICK_JOB(a.in[21], D, 2 * DFF, a.in[20], WS_FIN0, a.ffn_mode)
            PICK_JOB(a.in[21] + (size_t)D * 2 * DFF, D, 2 * DFF, a.in[20] + D, WS_FIN1, a.ffn_mode)
            PICK_JOB(a.in[8], D, OD_IN, a.in[2] + D, WS_ODIN, 0)
            PICK_JOB(a.in[24], DFF, D, (const float*)nullptr, WS_FOUT0, 0)
            PICK_JOB(a.in[24] + (size_t)DFF * D, DFF, D, (const float*)nullptr, WS_FOUT1, 0)
            PICK_JOB(a.in[16], D, 2 * D, (const float*)nullptr, WS_XKV0, 0)
            PICK_JOB(a.in[16] + (size_t)D * 2 * D, D, 2 * D, (const float*)nullptr, WS_XKV1, 0)
            PICK_JOB(a.in[7], D, D, (const float*)nullptr, WS_EVOUT, 0)
            PICK_JOB(a.in[12], D, D, (const float*)nullptr, WS_ODOUT, 0)
            PICK_JOB(a.in[15], D, D, a.in[13], WS_XQ0, 0)
            PICK_JOB(a.in[15] + (size_t)D * D, D, D, a.in[13] + D, WS_XQ1, 0)
            PICK_JOB(a.in[19], D, D, (const float*)nullptr, WS_XO0, 0)
            PICK_JOB(a.in[19] + (size_t)D * D, D, D, (const float*)nullptr, WS_XO1, 0)
            if (found) transpose_item(W_, K_, N_, g_, (bf16*)(ws + d_), m_, scr, r, lane);
        }
        for (int m = 2 * gw; m < M; m += 2 * NGW) {
            const f32x4* xr = (const f32x4*)(x + (size_t)m * D) + lane; v2u* o8 = (v2u*)((bf16*)(ws + WS_XB) + (size_t)m * D) + lane; float* sp = (float*)(ws + WS_SSQP);
            f32x4 v[8];
#pragma unroll
            for (int j = 0; j < 8; ++j) v[j] = __builtin_nontemporal_load(xr + 64 * j);
#pragma unroll
            for (int j = 0; j < 8; ++j) { v2u w; w.x = pk2(v[j][0], v[j][1]); w.y = pk2(v[j][2], v[j][3]); o8[64 * j] = w;
                const float s2 = wave_sum((v[j][0] * v[j][0] + v[j][1] * v[j][1]) + (v[j][2] * v[j][2] + v[j][3] * v[j][3])); if (lane == 0) sp[(size_t)(j & 3) * M + m + (j >> 2)] = s2; }
        }
        for (int r = gw; r < 2 * MM; r += NGW) { const int l = r / MM, m = r % MM;
            const f32x4* xr = (const f32x4*)(mem + (size_t)m * D) + lane; const f32x4* gr = (const f32x4*)(a.in[14] + (size_t)l * D) + lane;
            f32x4 v[4]; float s = 0.f;
#pragma unroll
            for (int j = 0; j < 4; ++j) { v[j] = xr[64 * j]; s += (v[j][0] * v[j][0] + v[j][1] * v[j][1]) + (v[j][2] * v[j][2] + v[j][3] * v[j][3]); }
            const float rs = 1.0f / sqrtf(wave_sum(s) * (1.0f / D) + EPS);
            v2u* o8 = (v2u*)((bf16*)(ws + (l ? WS_MEMH1 : WS_MEMH0)) + (size_t)m * D) + lane;
#pragma unroll
            for (int j = 0; j < 4; ++j) { const f32x4 g = gr[64 * j]; v2u w; w.x = pk2(v[j][0] * rs * g[0], v[j][1] * rs * g[1]); w.y = pk2(v[j][2] * rs * g[2], v[j][3] * rs * g[3]); o8[64 * j] = w; }
        }
        if (gw == 0) {
            const float* lg = a.in[6]; float* lb = (float*)(ws + WS_LB);
            for (int c = lane; c < 512; c += 64) { const float a0 = lg[c], a1 = lg[512 + c], a2 = lg[1024 + c]; const float mx = fmaxf(a0, fmaxf(a1, a2));
                const float e0 = expf(a0 - mx), e1 = expf(a1 - mx), e2 = expf(a2 - mx); lb[c] = e0 / (e0 + e1 + e2); }
        }
        if (gw == 2) {
            float* gx = (float*)(ws + WS_GXA); float* go = (float*)(ws + WS_GOD);
            for (int i = lane; i < 512; i += 64) gx[i] = a.in[18][i] * a.in[17][i];
            for (int i = lane; i < 128; i += 64) go[i] = a.in[10][i] * a.in[9][i];
        }
        if (gw == 1) {
            const float* rb = a.in[11]; float* bt = (float*)(ws + WS_BIAST);
            for (int i = lane; i < 3 * 8 * 132; i += 64) { const int br = i / (8 * 132), h = (i / 132) % 8, dl = i % 132; const int d = dl * (1 << (2 * br));
                int bucket; if (d < 16) bucket = d; else { const float lr = logf((float)d / 16.0f) / 4.852030263919617f; int lg2 = 16 + (int)(lr * 16.0f); bucket = lg2 < 31 ? lg2 : 31; }
                bt[i] = (dl <= 128) ? rb[bucket * 8 + h] : 0.f; }
        }
    }
}


typedef short bf16x8 __attribute__((ext_vector_type(8)));
typedef short s16x4 __attribute__((ext_vector_type(4)));
typedef float f32x16 __attribute__((ext_vector_type(16)));
typedef float f32x2_t __attribute__((ext_vector_type(2))); typedef __bf16 bf16x2_t __attribute__((ext_vector_type(2)));
typedef short v4i16_t __attribute__((ext_vector_type(4)));
#define MFMA32(a, b, c) __builtin_amdgcn_mfma_f32_32x32x16_bf16((a), (b), (c), 0, 0, 0)
__device__ __forceinline__ unsigned cvtpk(float lo, float hi) { f32x2_t v = {lo, hi}; bf16x2_t b = __builtin_convertvector(v, bf16x2_t); return __builtin_bit_cast(unsigned, b); }
__device__ __forceinline__ bf16x8 pack8(float a0, float a1, float a2, float a3, float a4, float a5, float a6, float a7) {
    v4u p; p.x = cvtpk(a0, a1); p.y = cvtpk(a2, a3); p.z = cvtpk(a4, a5); p.w = cvtpk(a6, a7); return __builtin_bit_cast(bf16x8, p); }
__device__ __forceinline__ s16x4 vtr(const LAS char* p) { return __builtin_bit_cast(s16x4, __builtin_amdgcn_ds_read_tr16_b64_v4i16((LAS v4i16_t*)p)); }
__device__ __forceinline__ int tr_lane_base(int lane, int stride) { const int g = lane >> 4, i = lane & 15, q = i >> 2, p = i & 3, h2 = g >> 1; return (4 * h2 + q) * stride + (16 * (g & 1) + 4 * p) * 2; }
__device__ __forceinline__ bf16x8 tr_frag_perm(const LAS char* img, int stride, int lbase, int k0, int n0) {
    const LAS char* p = img + lbase + k0 * stride + n0 * 2;
    const s16x4 lo = vtr(p), hi = vtr(p + 8 * stride);
    return (bf16x8){lo[0], lo[1], lo[2], lo[3], hi[0], hi[1], hi[2], hi[3]};
}
__device__ __forceinline__ int tr_lane_base_nat(int lane, int stride) { const int g = lane >> 4, i = lane & 15, q = i >> 2, p = i & 3, h2 = g >> 1; return (8 * h2 + q) * stride + (16 * (g & 1) + 4 * p) * 2; }
__device__ __forceinline__ bf16x8 tr_frag_nat(const LAS char* img, int stride, int lbase, int k0, int n0) {
    const LAS char* p = img + lbase + k0 * stride + n0 * 2;
    const s16x4 lo = vtr(p), hi = vtr(p + 4 * stride);
    return (bf16x8){lo[0], lo[1], lo[2], lo[3], hi[0], hi[1], hi[2], hi[3]};
}

#define LDS_BARRIER() do { asm volatile("s_waitcnt lgkmcnt(0)" ::: "memory"); __builtin_amdgcn_s_barrier(); asm volatile("" ::: "memory"); } while (0)
constexpr int XA_STRIDE = 528, XA_VSTRIDE = 528;
constexpr int XA_LDS = 256 * XA_STRIDE;
template <bool Q_IN_LDS> __device__ __forceinline__ void xattn_unit(LAS char* lds, const bf16* __restrict__ Q, const bf16* __restrict__ MKV, const float* __restrict__ gkq, bf16* __restrict__ O, int unit, int tid) {
    const int lane = tid & 63, w = __builtin_amdgcn_readfirstlane(tid >> 6), r = lane & 31, h2 = lane >> 5;
    const int rb = unit >> 2, h = unit & 3, row0 = rb * 256, b = row0 / SEQ;
    const bf16* Kg = MKV + (size_t)(b * NMEM) * 2048 + h * 256; const bf16* Vg = Kg + 1024;
    v4u st[16];
#pragma unroll
    for (int i = 0; i < 16; ++i) { const int id = tid + 512 * i; st[i] = *(const v4u*)(Kg + (size_t)(id >> 5) * 2048 + (id & 31) * 8); }
    const size_t qoff = (size_t)(row0 + 32 * w + r) * D + h * 256;
    bf16x8 qf[16];
    if (Q_IN_LDS) {
#pragma unroll
        for (int s = 0; s < 16; ++s) qf[s] = *(const LAS bf16x8*)(lds + (32 * w + r) * XA_STRIDE + h2 * 16 + s * 32);
        asm volatile("s_waitcnt lgkmcnt(0)" ::: "memory"); __builtin_amdgcn_s_barrier(); asm volatile("" ::: "memory");
    } else {
#pragma unroll
        for (int s = 0; s < 16; ++s) qf[s] = *(const bf16x8*)(Q + qoff + 8 * h2 + 16 * s);
    }
    { float gk8[8];
#pragma unroll
      for (int e = 0; e < 8; ++e) gk8[e] = gkq[(tid & 31) * 8 + e];
#pragma unroll
      for (int i = 0; i < 16; ++i) { const int id = tid + 512 * i; float f[8]; unpack8(st[i], f);
          float sq = (f[0] * f[0] + f[1] * f[1]) + (f[2] * f[2] + f[3] * f[3]) + (f[4] * f[4] + f[5] * f[5]) + (f[6] * f[6] + f[7] * f[7]);
          sq += __shfl_xor(sq, 1); sq += __shfl_xor(sq, 2); sq += __shfl_xor(sq, 4); sq += __shfl_xor(sq, 8); sq += __shfl_xor(sq, 16);
          const float rk = 1.0f / sqrtf(sq * (1.0f / 256.0f) + EPS) * 0.0625f;
          v4u o; o.x = cvtpk(f[0] * rk * gk8[0], f[1] * rk * gk8[1]); o.y = cvtpk(f[2] * rk * gk8[2], f[3] * rk * gk8[3]); o.z = cvtpk(f[4] * rk * gk8[4], f[5] * rk * gk8[5]); o.w = cvtpk(f[6] * rk * gk8[6], f[7] * rk * gk8[7]);
          *(LAS v4u*)(lds + (id >> 5) * XA_STRIDE + (id & 31) * 16) = o; } }
    float ss = 0.f;
#pragma unroll
    for (int s = 0; s < 16; ++s)
#pragma unroll
        for (int j = 0; j < 8; ++j) { const float x = __uint_as_float((unsigned)(unsigned short)qf[s][j] << 16); ss += x * x; }
    ss += __shfl_xor(ss, 32);
    const float rsl = 1.0f / sqrtf(ss * (1.0f / 256.0f) + EPS) * 1.4426950408889634f;
    asm volatile("" ::: "memory");
#pragma unroll
    for (int i = 0; i < 8; ++i) { const int id = tid + 512 * i; st[i] = *(const v4u*)(Vg + (size_t)(id >> 5) * 2048 + (id & 31) * 8); }
    LDS_BARRIER();
    bf16x8 pf[8][2]; float den = 0.f;
#pragma unroll
    for (int kb = 0; kb < 8; ++kb) {
        f32x16 acc;
#pragma unroll
        for (int i = 0; i < 16; ++i) acc[i] = 0.f;
        const LAS char* kp = lds + (32 * kb + r) * XA_STRIDE + h2 * 16;
#pragma unroll
        for (int s = 0; s < 16; ++s) { const bf16x8 a = *(const LAS bf16x8*)(kp + s * 32); acc = MFMA32(a, qf[s], acc); }
        float p[16];
#pragma unroll
        for (int i = 0; i < 16; ++i) { p[i] = __builtin_amdgcn_exp2f(acc[i] * rsl - 11.541560327111707f); den += p[i]; }
        pf[kb][0] = pack8(p[0], p[1], p[2], p[3], p[4], p[5], p[6], p[7]); pf[kb][1] = pack8(p[8], p[9], p[10], p[11], p[12], p[13], p[14], p[15]);
    }
    den += __shfl_xor(den, 32);
    const float inv = 1.0f / den;
    LDS_BARRIER();
#pragma unroll
    for (int i = 8; i < 16; ++i) { const int id = tid + 512 * i; st[i] = *(const v4u*)(Vg + (size_t)(id >> 5) * 2048 + (id & 31) * 8); }
#pragma unroll
    for (int i = 0; i < 16; ++i) { const int id = tid + 512 * i; *(LAS v4u*)(lds + (id >> 5) * XA_VSTRIDE + (id & 31) * 16) = st[i]; }
    LDS_BARRIER();
    const int lbase = tr_lane_base(lane, XA_VSTRIDE);
#pragma unroll
    for (int half = 0; half < 2; ++half) {
        f32x16 o[4];
#pragma unroll
        for (int vb = 0; vb < 4; ++vb)
#pragma unroll
            for (int i = 0; i < 16; ++i) o[vb][i] = 0.f;
#pragma unroll
        for (int kb = 0; kb < 8; ++kb)
#pragma unroll
            for (int s = 0; s < 2; ++s)
#pragma unroll
                for (int vb = 0; vb < 4; ++vb) { const bf16x8 a = tr_frag_perm(lds, XA_VSTRIDE, lbase, 32 * kb + 16 * s, 128 * half + 32 * vb); o[vb] = MFMA32(a, pf[kb][s], o[vb]); }
        LAS char* tile = lds + 256 * XA_VSTRIDE + w * 2560;
#pragma unroll
        for (int vb = 0; vb < 4; ++vb) {
#pragma unroll
            for (int g4 = 0; g4 < 4; ++g4) { v2u wv; wv.x = cvtpk(o[vb][4 * g4] * inv, o[vb][4 * g4 + 1] * inv); wv.y = cvtpk(o[vb][4 * g4 + 2] * inv, o[vb][4 * g4 + 3] * inv);
                *(LAS v2u*)(tile + r * 80 + (8 * g4 + 4 * h2) * 2) = wv; }
            asm volatile("s_waitcnt lgkmcnt(0)" ::: "memory");
#pragma unroll
            for (int i = 0; i < 2; ++i) { const int id = lane + 64 * i; *(v4u*)(O + (size_t)(row0 + 32 * w + (id >> 2)) * D + h * 256 + 128 * half + 32 * vb + 8 * (id & 3)) = *(const LAS v4u*)(tile + (id >> 2) * 80 + (id & 3) * 16); }
            asm volatile("s_waitcnt lgkmcnt(0)" ::: "memory");
        }
    }
    __syncthreads();
}


struct EpiXattn {
    static constexpr int PERM = 1; static constexpr bool AFTER_DRAIN = true;
    struct Pre { int unused; };
    const bf16* MKV; const float* gkq; bf16* O;
    __device__ __forceinline__ void init(f32x4 (&)[2][2][4][2], const pg8::Unit&, int, int, int, int) const {}
    __device__ __forceinline__ void fused(f32x4 (&acc)[2][2][4][2], const pg8::Unit& u, int wr, int wc, int fr, int fq, LAS unsigned char* lds, int wid, int lane) const {
#pragma unroll
        for (int ai = 0; ai < 2; ++ai)
#pragma unroll
            for (int m = 0; m < 4; ++m) { const int row = ai * 128 + wr * 64 + m * 16 + fr;
#pragma unroll
                for (int bj = 0; bj < 2; ++bj) { const f32x4 v0 = acc[ai][bj][m][0], v1 = acc[ai][bj][m][1];
                    v4u o; o.x = cvtpk(v0[0], v0[1]); o.y = cvtpk(v0[2], v0[3]); o.z = cvtpk(v1[0], v1[1]); o.w = cvtpk(v1[2], v1[3]);
                    *(LAS v4u*)(lds + row * XA_STRIDE + (bj * 128 + wc * 32 + 8 * fq) * 2) = o; } }
        asm volatile("s_waitcnt lgkmcnt(0)" ::: "memory"); __builtin_amdgcn_s_barrier(); asm volatile("" ::: "memory");
    }
};

constexpr int DA_STRIDE = 272, DA_VSTRIDE = 320, DA_LDS_BIAS = 384 * DA_VSTRIDE, DA_LDS_OSTG = DA_LDS_BIAS + 768, DA_OSTG_WAVE = 32 * 144 + 128;
static_assert(DA_LDS_OSTG + 8 * DA_OSTG_WAVE <= 163840 - 512, "dilated attention LDS map");
constexpr int DA_UNUSED0 = 0;
struct DaArgs { const bf16* QKV; const float* biasT; const float* gkq; bf16* N0; float* DEN0; const bf16* N1; const float* DEN1; const bf16* N2; const float* DEN2; bf16* O; int br0; int nbr; int mode; int pad; };
struct DaUnit { int br, b, h, dil, cls, l0; };
template <int MODE> __device__ __forceinline__ DaUnit da_decode(int uu) {
    DaUnit U; U.br = MODE == 0 ? __builtin_amdgcn_readfirstlane(1 + (uu >> 9)) : 0; const int rem = __builtin_amdgcn_readfirstlane(uu & 511), x = rem & 15; U.b = rem >> 7; U.h = (rem >> 4) & 7; U.dil = 1 << (2 * U.br);
    U.cls = U.br == 0 ? 0 : (U.br == 1 ? (x & 3) : x); U.l0 = 256 * (U.br == 0 ? x : (U.br == 1 ? (x >> 2) : 0)); return U; }
__device__ __forceinline__ void da_load_rows(v4u (&st)[12], const bf16* QKV, const DaUnit& U, int col, int tid) {
    const bf16* base = QKV + (size_t)(U.b * SEQ) * OD_IN + U.h * 128 + col + (tid & 15) * 8;
#pragma unroll
    for (int i = 0; i < 12; ++i) { const int ki = (tid >> 4) + 32 * i, lk = U.l0 - 128 + ki, lkc = lk < 0 ? 0 : lk; st[i] = *(const v4u*)(base + (size_t)(lkc * U.dil + U.cls) * OD_IN); }
}
template <int MODE> __device__ __forceinline__ void dattn_phase(LAS char* lds, const DaArgs& a, int bx, int G, int tid) {
    constexpr int NUNITS = MODE == 0 ? 1024 : 512;
    const int lane = tid & 63, w = __builtin_amdgcn_readfirstlane(tid >> 6), r = lane & 31, h2 = lane >> 5;
    int uu = (G == 256) ? (((bx & 7) << 5) | (bx >> 3)) : bx; if (uu >= NUNITS) return;
    v4u st[12];
    { const DaUnit U0 = da_decode<MODE>(uu); da_load_rows(st, a.QKV, U0, 1024, tid); }
    LAS float* lbias = (LAS float*)(lds + DA_LDS_BIAS);
    const int lbase = tr_lane_base(lane, DA_VSTRIDE);
    for (;;) {
        const DaUnit U = da_decode<MODE>(uu);
        const int l0 = U.l0, h = U.h; const bool zfirst = (l0 == 0);
        int r_l = r; asm volatile("" : "+v"(r_l));
        float gk8[8];
#pragma unroll
        for (int e = 0; e < 8; ++e) gk8[e] = a.gkq[(tid & 15) * 8 + e];
        const size_t qrow = (size_t)(U.b * SEQ + (l0 + 32 * w + r) * U.dil + U.cls);
#pragma unroll
        for (int i = 0; i < 12; ++i) { float f_[8]; unpack8((i < 4 && zfirst) ? (v4u){0u, 0u, 0u, 0u} : st[i], f_);
            float sq_ = (f_[0] * f_[0] + f_[1] * f_[1]) + (f_[2] * f_[2] + f_[3] * f_[3]) + (f_[4] * f_[4] + f_[5] * f_[5]) + (f_[6] * f_[6] + f_[7] * f_[7]);
            sq_ += __shfl_xor(sq_, 1); sq_ += __shfl_xor(sq_, 2); sq_ += __shfl_xor(sq_, 4); sq_ += __shfl_xor(sq_, 8);
            const float rk_ = 1.0f / sqrtf(sq_ * (1.0f / 128.0f) + EPS) * 0.08838834764831845f;
            v4u o_; o_.x = cvtpk(f_[0] * rk_ * gk8[0], f_[1] * rk_ * gk8[1]); o_.y = cvtpk(f_[2] * rk_ * gk8[2], f_[3] * rk_ * gk8[3]); o_.z = cvtpk(f_[4] * rk_ * gk8[4], f_[5] * rk_ * gk8[5]); o_.w = cvtpk(f_[6] * rk_ * gk8[6], f_[7] * rk_ * gk8[7]);
            *(LAS v4u*)(lds + ((tid >> 4) + 32 * i) * DA_STRIDE + (tid & 15) * 16) = o_; }
        if (tid < 192) { const int dl = tid - 32; lbias[tid] = (dl >= 0 && dl <= 128) ? a.biasT[(U.br * 8 + h) * 132 + dl] * 1.4426950408889634f - 11.541560327111707f : -__builtin_inff(); }
        asm volatile("" ::: "memory");
        bf16x8 qf[8];
#pragma unroll
        for (int s = 0; s < 8; ++s) qf[s] = *(const bf16x8*)(a.QKV + qrow * OD_IN + h * 128 + 8 * h2 + 16 * s);
        da_load_rows(st, a.QKV, U, 2048, tid);
        float ss = 0.f;
#pragma unroll
        for (int s = 0; s < 8; ++s)
#pragma unroll
            for (int j = 0; j < 8; ++j) { const float xq = __uint_as_float((unsigned)(unsigned short)qf[s][j] << 16); ss += xq * xq; }
        ss += __shfl_xor(ss, 32);
        const float rsl = 1.0f / sqrtf(ss * (1.0f / 128.0f) + EPS) * 1.4426950408889634f;
        LDS_BARRIER();
        bf16x8 pf[5][2]; float den = 0.f;
#pragma unroll
        for (int kbi = 0; kbi < 5; ++kbi) {
            if (zfirst && w + kbi < 4) { pf[kbi][0] = (bf16x8){0, 0, 0, 0, 0, 0, 0, 0}; pf[kbi][1] = pf[kbi][0]; continue; }
            f32x16 acc;
#pragma unroll
            for (int i = 0; i < 16; ++i) acc[i] = 0.f;
            const LAS char* kp = lds + (32 * (w + kbi) + r) * DA_STRIDE + h2 * 16;
#pragma unroll
            for (int s = 0; s < 8; ++s) { const bf16x8 av = *(const LAS bf16x8*)(kp + s * 32); acc = MFMA32(av, qf[s], acc); }
            __builtin_amdgcn_sched_barrier(0);
            const LAS float* tb = lbias + (r_l - 4 * h2);
#pragma unroll
            for (int hh = 0; hh < 2; ++hh) { float p[8];
#pragma unroll
                for (int i8 = 0; i8 < 8; ++i8) { const int i = 8 * hh + i8;
                    p[i8] = __builtin_amdgcn_exp2f(acc[i] * rsl + tb[160 - 32 * kbi - ((i & 3) + 8 * (i >> 2))]); den += p[i8]; }
                pf[kbi][hh] = pack8(p[0], p[1], p[2], p[3], p[4], p[5], p[6], p[7]);
                __builtin_amdgcn_sched_barrier(0); }
            asm volatile("" ::: "memory");
        }
        den += __shfl_xor(den, 32);
        LDS_BARRIER();
#pragma unroll
        for (int i = 0; i < 12; ++i) *(LAS v4u*)(lds + ((tid >> 4) + 32 * i) * DA_VSTRIDE + (tid & 15) * 16) = (i < 4 && zfirst) ? (v4u){0u, 0u, 0u, 0u} : st[i];
        LDS_BARRIER();
        const int un = uu + G; const bool more = un < NUNITS; const DaUnit Un = da_decode<MODE>(more ? un : uu);
        if (more) da_load_rows(st, a.QKV, Un, 1024, tid);
        LAS char* stg = lds + DA_LDS_OSTG + w * DA_OSTG_WAVE;
        float inv = 1.0f;
        if (MODE == 0) { if (h2 == 0) ((float*)(U.br == 1 ? a.DEN1 : a.DEN2))[qrow * 8 + h] = den; }
        else { inv = 1.0f / (den + a.DEN1[qrow * 8 + h] + a.DEN2[qrow * 8 + h]); if (h2 == 0) ((LAS float*)(stg + 32 * 144))[r] = inv; }
        size_t goff[4];
#pragma unroll
        for (int i = 0; i < 4; ++i) { const int id = lane + 64 * i, row = id >> 3, ch = id & 7; goff[i] = (size_t)(U.b * SEQ + (l0 + 32 * w + row) * U.dil + U.cls) * D + h * 128 + ch * 8; }
#pragma unroll
        for (int half = 0; half < 2; ++half) {
            f32x16 o[2];
            v4u n1v[4], n2v[4];
            if (MODE == 1) {
#pragma unroll
                for (int i = 0; i < 4; ++i) { n1v[i] = *(const v4u*)(a.N1 + goff[i] + 64 * half); n2v[i] = *(const v4u*)(a.N2 + goff[i] + 64 * half); } }
#pragma unroll
            for (int vb = 0; vb < 2; ++vb)
#pragma unroll
                for (int i = 0; i < 16; ++i) o[vb][i] = 0.f;
#pragma unroll
            for (int kbi = 0; kbi < 5; ++kbi)
#pragma unroll
                for (int s = 0; s < 2; ++s)
#pragma unroll
                    for (int vb = 0; vb < 2; ++vb) { const bf16x8 av = tr_frag_perm(lds, DA_VSTRIDE, lbase, 32 * (w + kbi) + 16 * s, 64 * half + 32 * vb); o[vb] = MFMA32(av, pf[kbi][s], o[vb]); }
#pragma unroll
            for (int vb = 0; vb < 2; ++vb)
#pragma unroll
                for (int g4 = 0; g4 < 4; ++g4) { v2u wv; wv.x = cvtpk(o[vb][4 * g4], o[vb][4 * g4 + 1]); wv.y = cvtpk(o[vb][4 * g4 + 2], o[vb][4 * g4 + 3]); *(LAS v2u*)(stg + r * 144 + (32 * vb + 8 * g4 + 4 * h2) * 2) = wv; }
            asm volatile("s_waitcnt lgkmcnt(0)" ::: "memory");
            if (MODE == 0) {
                bf16* N = (bf16*)(U.br == 1 ? a.N1 : a.N2) + 64 * half;
#pragma unroll
                for (int i = 0; i < 4; ++i) { const int id = lane + 64 * i; *(v4u*)(N + goff[i]) = *(const LAS v4u*)(stg + (id >> 3) * 144 + (id & 7) * 16); }
            } else {
#pragma unroll
                for (int i = 0; i < 4; ++i) { const int id = lane + 64 * i; float fo[8], f1[8], f2[8]; unpack8(*(const LAS v4u*)(stg + (id >> 3) * 144 + (id & 7) * 16), fo); unpack8(n1v[i], f1); unpack8(n2v[i], f2);
                    const float iv = ((const LAS float*)(stg + 32 * 144))[id >> 3];
                    v4u ov; ov.x = cvtpk((fo[0] + f1[0] + f2[0]) * iv, (fo[1] + f1[1] + f2[1]) * iv); ov.y = cvtpk((fo[2] + f1[2] + f2[2]) * iv, (fo[3] + f1[3] + f2[3]) * iv);
                    ov.z = cvtpk((fo[4] + f1[4] + f2[4]) * iv, (fo[5] + f1[5] + f2[5]) * iv); ov.w = cvtpk((fo[6] + f1[6] + f2[6]) * iv, (fo[7] + f1[7] + f2[7]) * iv);
                    *(v4u*)(a.O + goff[i] + 64 * half) = ov; }
            }
            asm volatile("s_waitcnt lgkmcnt(0)" ::: "memory");
        }
        LDS_BARRIER();
        if (!more) break;
        uu = un;
    }
}

constexpr int MX_STRIDE = 272, MX_TSTRIDE = 320, MX_IMG = 128 * MX_TSTRIDE;
constexpr int MX_Q = 0, MX_K = MX_IMG, MX_V = 2 * MX_IMG, MX_SCR = 3 * MX_IMG, MX_OSTG = MX_SCR + 5120;
constexpr int MX_UNUSED0 = 0;
struct MixArgs { bf16* Z; const float* lb; const float* ret_g; const float* hg_g; bf16* SBUF; float* DECA; float* DECB; };

__device__ __forceinline__ void st_chunk8(LAS char* img, int stride, int row, int c0, const float (&f)[8]) {
    v4u o; o.x = cvtpk(f[0], f[1]); o.y = cvtpk(f[2], f[3]); o.z = cvtpk(f[4], f[5]); o.w = cvtpk(f[6], f[7]); *(LAS v4u*)(img + row * stride + c0 * 2) = o; }

__device__ __forceinline__ void ret_prep_tile(LAS char* img, int stride, const bf16* zrow  , int j, int cg, const float (&sn)[16], const float (&cs)[16], float sc) {
#pragma unroll
    for (int hc = 0; hc < 2; ++hc) { float x1[8], x2[8], o1[8], o2[8];
        unpack8(*(const v4u*)(zrow + 16 * cg + 8 * hc), x1); unpack8(*(const v4u*)(zrow + 64 + 16 * cg + 8 * hc), x2);
#pragma unroll
        for (int e = 0; e < 8; ++e) { o1[e] = (x1[e] * cs[8 * hc + e] - x2[e] * sn[8 * hc + e]) * sc; o2[e] = (x1[e] * sn[8 * hc + e] + x2[e] * cs[8 * hc + e]) * sc; }
        st_chunk8(img, stride, j, 16 * cg + 8 * hc, o1); st_chunk8(img, stride, j, 64 + 16 * cg + 8 * hc, o2); }
}
__device__ __forceinline__ void copy_tile(LAS char* img, int stride, const bf16* src, int tid) {
#pragma unroll
    for (int i = 0; i < 4; ++i) { const int id = tid + 512 * i, row = id >> 4, ch = id & 15; *(LAS v4u*)(img + row * stride + ch * 16) = *(const v4u*)(src + (size_t)row * EV_IN + ch * 8); }
}
__device__ __forceinline__ void hg_gates(const bf16* zrow_f  , const float* lbh  , int tid, LAS float* scr, float (&cum)[32], float (&kk)[32]) {
    const int lane = tid & 63, hw = (tid >> 6) & 1, cg = tid >> 7;
#pragma unroll
    for (int q = 0; q < 4; ++q) { float fl[8]; unpack8(*(const v4u*)(zrow_f + 32 * cg + 8 * q), fl);
#pragma unroll
        for (int e = 0; e < 8; ++e) { const float l = lbh[32 * cg + 8 * q + e]; const float f = l + (1.0f - l) * (1.0f / (1.0f + __expf(-fl[e]))); kk[8 * q + e] = 1.0f - f; cum[8 * q + e] = __logf(fmaxf(f, 1e-6f)); } }
#pragma unroll
    for (int off = 1; off < 64; off <<= 1) {
#pragma unroll
        for (int c = 0; c < 32; ++c) { const float t = __shfl_up(cum[c], off); if (lane >= off) cum[c] += t; } }
    if (hw == 0 && lane == 63) {
#pragma unroll
        for (int c = 0; c < 32; ++c) scr[32 * cg + c] = cum[c]; }
    __syncthreads();
    if (hw == 1) {
#pragma unroll
        for (int c = 0; c < 32; ++c) cum[c] += scr[32 * cg + c]; }
    if (hw == 1 && lane == 63) {
#pragma unroll
        for (int c = 0; c < 32; ++c) scr[128 + 32 * cg + c] = cum[c]; }
    __syncthreads();
}

__device__ __forceinline__ void load_prep4(v4u (&rw)[4], const bf16* zrow_seg, int mixer, int cg) {
#pragma unroll
    for (int q = 0; q < 4; ++q) { const int col = mixer == 0 ? ((q >> 1) * 64 + 16 * cg + 8 * (q & 1)) : (32 * cg + 8 * q); rw[q] = *(const v4u*)(zrow_seg + col); }
}
__device__ __forceinline__ void load_copy4(v4u (&rw)[4], const bf16* tile, int tid) {
#pragma unroll
    for (int i = 0; i < 4; ++i) { const int id = tid + 512 * i; rw[i] = *(const v4u*)(tile + (size_t)(id >> 4) * EV_IN + (id & 15) * 8); }
}
__device__ __forceinline__ void store_copy4(LAS char* img, int stride, const v4u (&rw)[4], int tid) {
#pragma unroll
    for (int i = 0; i < 4; ++i) { const int id = tid + 512 * i; *(LAS v4u*)(img + (id >> 4) * stride + (id & 15) * 16) = rw[i]; }
}
__device__ __forceinline__ void ret_prep_raw(LAS char* img, int stride, const v4u (&rw)[4], int j, int cg, const float (&sn)[16], const float (&cs)[16], float sc) {
#pragma unroll
    for (int hc = 0; hc < 2; ++hc) { float x1[8], x2[8], o1[8], o2[8]; unpack8(rw[hc], x1); unpack8(rw[2 + hc], x2);
#pragma unroll
        for (int e = 0; e < 8; ++e) { o1[e] = (x1[e] * cs[8 * hc + e] - x2[e] * sn[8 * hc + e]) * sc; o2[e] = (x1[e] * sn[8 * hc + e] + x2[e] * cs[8 * hc + e]) * sc; }
        st_chunk8(img, stride, j, 16 * cg + 8 * hc, o1); st_chunk8(img, stride, j, 64 + 16 * cg + 8 * hc, o2); }
}
__device__ __forceinline__ void hg_gates_raw(const v4u (&rw)[4], const float* lbh, int tid, LAS float* scr, float (&cum)[32], float (&kk)[32]) {
    const int lane = tid & 63, hw = (tid >> 6) & 1, cg = tid >> 7;
#pragma unroll
    for (int q = 0; q < 4; ++q) { float fl[8]; unpack8(rw[q], fl);
#pragma unroll
        for (int e = 0; e < 8; ++e) { const float l = lbh[32 * cg + 8 * q + e]; const float f = l + (1.0f - l) * (1.0f / (1.0f + __expf(-fl[e]))); kk[8 * q + e] = 1.0f - f; cum[8 * q + e] = __logf(fmaxf(f, 1e-6f)); } }
#pragma unroll
    for (int off = 1; off < 64; off <<= 1) {
#pragma unroll
        for (int c = 0; c < 32; ++c) { const float t = __shfl_up(cum[c], off); if (lane >= off) cum[c] += t; } }
    if (hw == 0 && lane == 63) {
#pragma unroll
        for (int c = 0; c < 32; ++c) scr[32 * cg + c] = cum[c]; }
    LDS_BARRIER();
    if (hw == 1) {
#pragma unroll
        for (int c = 0; c < 32; ++c) cum[c] += scr[32 * cg + c]; }
    if (hw == 1 && lane == 63) {
#pragma unroll
        for (int c = 0; c < 32; ++c) scr[128 + 32 * cg + c] = cum[c]; }
    LDS_BARRIER();
}
struct MixU { int mixer, b, h, n; };
__device__ __forceinline__ MixU mix_decode(int u) { MixU U; const int g = __builtin_amdgcn_readfirstlane(u >> 5); U.n = __builtin_amdgcn_readfirstlane(u & 31); U.mixer = g >> 4; U.b = (g >> 2) & 3; U.h = g & 3; return U; }

__device__ __forceinline__ void mixA_phase(LAS char* lds, const MixArgs& a, int bx, int G, int tid) {
    const int lane = tid & 63, w = __builtin_amdgcn_readfirstlane(tid >> 6), r = lane & 31, h2 = lane >> 5;
    const int j = tid & 127, cg = tid >> 7;
    LAS float* scr = (LAS float*)(lds + MX_SCR);
    int u = bx; if (u >= 1024) return;
    v4u rk[4], rv[4];
    { const MixU U = mix_decode(u); const bf16* zt = a.Z + (size_t)(U.b * SEQ + 128 * U.n) * EV_IN;
      load_prep4(rk, zt + (size_t)j * EV_IN + (U.mixer == 0 ? Z_RK : Z_GF) + U.h * 128, U.mixer, cg); load_copy4(rv, zt + (U.mixer == 0 ? Z_RV : Z_GI) + U.h * 128, tid); }
    for (;;) {
        const MixU U = mix_decode(u); const int h = U.h, n = U.n;
        if (U.mixer == 0) {
            const float gamma = 1.0f - exp2f(-5.0f - (float)h), lg2 = log2f(gamma);
            float sn[16], cs[16];
#pragma unroll
            for (int e = 0; e < 16; ++e) { const float inv = exp2f(-(float)(16 * cg + e) * (13.287712379549449f / 64.0f)); rope_sincos((float)(128 * n + j) * inv, sn[e], cs[e]); }
            ret_prep_raw(lds + MX_K, MX_TSTRIDE, rk, j, cg, sn, cs, 0.08838834764831845f * exp2f((float)(127 - j) * lg2));
            if (tid < 128) { a.DECA[(size_t)u * 128 + tid] = exp2f(128.0f * lg2); a.DECB[(size_t)u * 128 + tid] = gamma; }
        } else {
            float cum[32], kk[32];
            hg_gates_raw(rk, a.lb + h * 128, tid, scr, cum, kk);
#pragma unroll
            for (int q = 0; q < 4; ++q) { float o[8];
#pragma unroll
                for (int e = 0; e < 8; ++e) o[e] = kk[8 * q + e] * __expf(scr[128 + 32 * cg + 8 * q + e] - cum[8 * q + e]);
                st_chunk8(lds + MX_K, MX_TSTRIDE, j, 32 * cg + 8 * q, o); }
            if (tid < 128) { a.DECA[(size_t)u * 128 + tid] = __expf(scr[128 + tid]); a.DECB[(size_t)u * 128 + tid] = __expf(scr[tid]); }
        }
        store_copy4(lds + MX_V, MX_TSTRIDE, rv, tid);
        LDS_BARRIER();
        const int un = u + G; const bool more = un < 1024;
        if (more) { const MixU Un = mix_decode(un); const bf16* zt = a.Z + (size_t)(Un.b * SEQ + 128 * Un.n) * EV_IN;
            load_prep4(rk, zt + (size_t)j * EV_IN + (Un.mixer == 0 ? Z_RK : Z_GF) + Un.h * 128, Un.mixer, cg); load_copy4(rv, zt + (Un.mixer == 0 ? Z_RV : Z_GI) + Un.h * 128, tid); }
        const int lbn = tr_lane_base_nat(lane, MX_TSTRIDE); const int kbk = w >> 1, vb0 = 2 * (w & 1);
        f32x16 acc[2];
#pragma unroll
        for (int t = 0; t < 2; ++t)
#pragma unroll
            for (int i = 0; i < 16; ++i) acc[t][i] = 0.f;
#pragma unroll
        for (int s_ = 0; s_ < 8; ++s_) { const bf16x8 av = tr_frag_nat(lds + MX_K, MX_TSTRIDE, lbn, 16 * s_, 32 * kbk);
#pragma unroll
            for (int t = 0; t < 2; ++t) { const bf16x8 bv = tr_frag_nat(lds + MX_V, MX_TSTRIDE, lbn, 16 * s_, 32 * (vb0 + t)); acc[t] = MFMA32(av, bv, acc[t]); } }
        bf16* sb = a.SBUF + (size_t)u * 16384;
#pragma unroll
        for (int t = 0; t < 2; ++t)
#pragma unroll
            for (int g4 = 0; g4 < 4; ++g4) { v2u wv; wv.x = cvtpk(acc[t][4 * g4], acc[t][4 * g4 + 1]); wv.y = cvtpk(acc[t][4 * g4 + 2], acc[t][4 * g4 + 3]);
                *(v2u*)(sb + ((((((vb0 + t) * 8 + 2 * kbk + (g4 >> 1)) * 2 + (g4 & 1)) * 32 + r) * 8) + 4 * h2)) = wv; }
        LDS_BARRIER();
        if (!more) break;
        u = un;
    }
}

__device__ __forceinline__ void mixA_unit(LAS char* lds, const MixArgs& a, int u, int tid) {
    const int lane = tid & 63, w = __builtin_amdgcn_readfirstlane(tid >> 6), r = lane & 31, h2 = lane >> 5;
    const int g = u >> 5, n = u & 31, mixer = g >> 4, b = (g >> 2) & 3, h = g & 3;
    const int j = tid & 127, cg = tid >> 7;
    const bf16* zt = a.Z + (size_t)(b * SEQ + 128 * n) * EV_IN;
    LAS float* scr = (LAS float*)(lds + MX_SCR);
    if (mixer == 0) {
        const float gamma = 1.0f - exp2f(-5.0f - (float)h), lg2 = log2f(gamma);
        float sn[16], cs[16];
#pragma unroll
        for (int e = 0; e < 16; ++e) { const float inv = exp2f(-(float)(16 * cg + e) * (13.287712379549449f / 64.0f)); rope_sincos((float)(128 * n + j) * inv, sn[e], cs[e]); }
        ret_prep_tile(lds + MX_K, MX_TSTRIDE, zt + (size_t)j * EV_IN + Z_RK + h * 128, j, cg, sn, cs, 0.08838834764831845f * exp2f((float)(127 - j) * lg2));
        copy_tile(lds + MX_V, MX_TSTRIDE, zt + Z_RV + h * 128, tid);
        if (tid < 128) { a.DECA[(size_t)u * 128 + tid] = exp2f(128.0f * lg2); a.DECB[(size_t)u * 128 + tid] = gamma; }
    } else {
        float cum[32], kk[32];
        hg_gates(zt + (size_t)j * EV_IN + Z_GF + h * 128, a.lb + h * 128, tid, scr, cum, kk);
#pragma unroll
        for (int q = 0; q < 4; ++q) { float o[8];
#pragma unroll
            for (int e = 0; e < 8; ++e) o[e] = kk[8 * q + e] * __expf(scr[128 + 32 * cg + 8 * q + e] - cum[8 * q + e]);
            st_chunk8(lds + MX_K, MX_TSTRIDE, j, 32 * cg + 8 * q, o); }
        copy_tile(lds + MX_V, MX_TSTRIDE, zt + Z_GI + h * 128, tid);
        if (tid < 128) { a.DECA[(size_t)u * 128 + tid] = __expf(scr[128 + tid]); a.DECB[(size_t)u * 128 + tid] = __expf(scr[tid]); }
    }
    __syncthreads();
    const int lbn = tr_lane_base_nat(lane, MX_TSTRIDE); const int kbk = w >> 1, vb0 = 2 * (w & 1);
    f32x16 acc[2];
#pragma unroll
    for (int t = 0; t < 2; ++t)
#pragma unroll
        for (int i = 0; i < 16; ++i) acc[t][i] = 0.f;
#pragma unroll
    for (int s = 0; s < 8; ++s) { const bf16x8 av = tr_frag_nat(lds + MX_K, MX_TSTRIDE, lbn, 16 * s, 32 * kbk);
#pragma unroll
        for (int t = 0; t < 2; ++t) { const bf16x8 bv = tr_frag_nat(lds + MX_V, MX_TSTRIDE, lbn, 16 * s, 32 * (vb0 + t)); acc[t] = MFMA32(av, bv, acc[t]); } }
    bf16* sb = a.SBUF + (size_t)u * 16384;
#pragma unroll
    for (int t = 0; t < 2; ++t)
#pragma unroll
        for (int g4 = 0; g4 < 4; ++g4) { v2u wv; wv.x = cvtpk(acc[t][4 * g4], acc[t][4 * g4 + 1]); wv.y = cvtpk(acc[t][4 * g4 + 2], acc[t][4 * g4 + 3]);
            *(v2u*)(sb + ((((((vb0 + t) * 8 + 2 * kbk + (g4 >> 1)) * 2 + (g4 & 1)) * 32 + r) * 8) + 4 * h2)) = wv; }
    __syncthreads();
}

__device__ __forceinline__ void mix_scan(const MixArgs& a, int gtid, int nthreads, bool dry = false) {
    for (int e = gtid; e < 32 * 4096; e += nthreads) { const int g = e >> 12, el = e & 4095, dk4 = 4 * ((el >> 7) & 7) + 2 * ((el >> 6) & 1) + (el & 1);
        bf16* sp = a.SBUF + (size_t)(g * 32) * 16384 + (size_t)el * 4; const float* da = a.DECA + (size_t)(g * 32) * 128 + 4 * dk4; const float* db = a.DECB + (size_t)(g * 32) * 128 + 4 * dk4;
        f32x4 S = (f32x4){0.f, 0.f, 0.f, 0.f};
#pragma unroll 8
        for (int n = 0; n < 32; ++n) { const v2u kv = *(const v2u*)(sp + (size_t)n * 16384); const f32x4 A = *(const f32x4*)(da + n * 128), Bv = *(const f32x4*)(db + n * 128);
            const f32x4 so = S * Bv; v2u wv; wv.x = cvtpk(so[0], so[1]); wv.y = cvtpk(so[2], so[3]); if (!dry) *(v2u*)(sp + (size_t)n * 16384) = wv;
            S[0] = A[0] * S[0] + __uint_as_float(kv.x << 16); S[1] = A[1] * S[1] + __uint_as_float(kv.x & 0xffff0000u); S[2] = A[2] * S[2] + __uint_as_float(kv.y << 16); S[3] = A[3] * S[3] + __uint_as_float(kv.y & 0xffff0000u); }
    }
}

__device__ __forceinline__ void mixC_unit(LAS char* lds, const MixArgs& a, int u, int tid, bool dry = false) {
    const int lane = tid & 63, w = __builtin_amdgcn_readfirstlane(tid >> 6), r = lane & 31, h2 = lane >> 5;
    const int g = u >> 5, n = u & 31, mixer = g >> 4, b = (g >> 2) & 3, h = g & 3;
    const int j = tid & 127, cg = tid >> 7;
    bf16* zt = a.Z + (size_t)(b * SEQ + 128 * n) * EV_IN;
    LAS float* scr = (LAS float*)(lds + MX_SCR);
    if (mixer == 0) {
        const float gamma = 1.0f - exp2f(-5.0f - (float)h), lg2 = log2f(gamma);
        float sn[16], cs[16];
#pragma unroll
        for (int e = 0; e < 16; ++e) { const float inv = exp2f(-(float)(16 * cg + e) * (13.287712379549449f / 64.0f)); rope_sincos((float)(128 * n + j) * inv, sn[e], cs[e]); }
        ret_prep_tile(lds + MX_Q, MX_STRIDE, zt + (size_t)j * EV_IN + Z_RQ + h * 128, j, cg, sn, cs, exp2f((float)j * lg2));
        ret_prep_tile(lds + MX_K, MX_STRIDE, zt + (size_t)j * EV_IN + Z_RK + h * 128, j, cg, sn, cs, 0.08838834764831845f * exp2f(-(float)j * lg2));
        copy_tile(lds + MX_V, MX_TSTRIDE, zt + Z_RV + h * 128, tid);
    } else {
        float cum[32], kk[32];
        hg_gates(zt + (size_t)j * EV_IN + Z_GF + h * 128, a.lb + h * 128, tid, scr, cum, kk);
#pragma unroll
        for (int q = 0; q < 4; ++q) { float qv[8], oq[8], ok[8]; unpack8(*(const v4u*)(zt + (size_t)j * EV_IN + Z_GQ + h * 128 + 32 * cg + 8 * q), qv);
#pragma unroll
            for (int e = 0; e < 8; ++e) { const float d = cum[8 * q + e] - scr[32 * cg + 8 * q + e]; oq[e] = qv[e] * __expf(d); ok[e] = kk[8 * q + e] * __expf(-d); }
            st_chunk8(lds + MX_Q, MX_STRIDE, j, 32 * cg + 8 * q, oq); st_chunk8(lds + MX_K, MX_STRIDE, j, 32 * cg + 8 * q, ok); }
        copy_tile(lds + MX_V, MX_TSTRIDE, zt + Z_GI + h * 128, tid);
    }
    __syncthreads();
    const int vb = w >> 1; const int lbp = tr_lane_base(lane, MX_TSTRIDE);
    const bf16* sb = a.SBUF + (size_t)u * 16384 + (size_t)((vb * 16 + h2) * 32 + r) * 8;
    bf16x8 sf[8];
#pragma unroll
    for (int s = 0; s < 8; ++s) sf[s] = *(const bf16x8*)(sb + s * 512);
    f32x16 o[2]; float s1[2], s2[2];
    const float* rg_ = a.ret_g; const float* hg_ = a.hg_g; const float* gn = (mixer == 0 ? rg_ : hg_) + h * 128 + 32 * vb + 4 * h2;
    v4u gwv[4];
#pragma unroll
    for (int t = 0; t < 2; ++t) { const int ib = (w & 1) ? (1 + t) : (3 * t);
#pragma unroll
        for (int i = 0; i < 2; ++i) { const int id = lane + 64 * i; gwv[2 * t + i] = *(const v4u*)(zt + (size_t)(32 * ib + (id >> 2)) * EV_IN + (mixer == 0 ? Z_RG : Z_GG) + h * 128 + 32 * vb + 8 * (id & 3)); } }
#pragma unroll
    for (int t = 0; t < 2; ++t) {
        const int ib = (w & 1) ? (1 + t) : (3 * t);
        bf16x8 qf[8];
#pragma unroll
        for (int s = 0; s < 8; ++s) qf[s] = *(const LAS bf16x8*)(lds + MX_Q + (32 * ib + r) * MX_STRIDE + h2 * 16 + s * 32);
#pragma unroll
        for (int i = 0; i < 16; ++i) o[t][i] = 0.f;
#pragma unroll
        for (int s = 0; s < 8; ++s) o[t] = MFMA32(sf[s], qf[s], o[t]);
        for (int jb = 0; jb <= ib; ++jb) {
            f32x16 acc;
#pragma unroll
            for (int i = 0; i < 16; ++i) acc[i] = 0.f;
            const LAS char* kp = lds + MX_K + (32 * jb + r) * MX_STRIDE + h2 * 16;
#pragma unroll
            for (int s = 0; s < 8; ++s) { const bf16x8 av = *(const LAS bf16x8*)(kp + s * 32); acc = MFMA32(av, qf[s], acc); }
            if (jb == ib) {
#pragma unroll
                for (int i = 0; i < 16; ++i) { const int c = (i & 3) + 8 * (i >> 2) + 4 * h2; if (c > r) acc[i] = 0.f; } }
            const bf16x8 p0 = pack8(acc[0], acc[1], acc[2], acc[3], acc[4], acc[5], acc[6], acc[7]), p1 = pack8(acc[8], acc[9], acc[10], acc[11], acc[12], acc[13], acc[14], acc[15]);
            const bf16x8 v0 = tr_frag_perm(lds + MX_V, MX_TSTRIDE, lbp, 32 * jb, 32 * vb), v1 = tr_frag_perm(lds + MX_V, MX_TSTRIDE, lbp, 32 * jb + 16, 32 * vb);
            o[t] = MFMA32(v0, p0, o[t]); o[t] = MFMA32(v1, p1, o[t]);
        }
        float a1 = 0.f, a2 = 0.f;
#pragma unroll
        for (int i = 0; i < 16; ++i) { a1 += o[t][i]; a2 += o[t][i] * o[t][i]; }
        a1 += __shfl_xor(a1, 32); a2 += __shfl_xor(a2, 32); s1[t] = a1; s2[t] = a2;
        if (h2 == 0) { scr[256 + (vb * 128 + 32 * ib + r) * 2] = a1; scr[256 + (vb * 128 + 32 * ib + r) * 2 + 1] = a2; }
    }
    LDS_BARRIER();
#pragma unroll
    for (int t = 0; t < 2; ++t) {
        const int ib = (w & 1) ? (1 + t) : (3 * t); const int tok = 32 * ib + r;
        float t1 = 0.f, t2 = 0.f;
#pragma unroll
        for (int v = 0; v < 4; ++v) { t1 += scr[256 + (v * 128 + tok) * 2]; t2 += scr[256 + (v * 128 + tok) * 2 + 1]; }
        float mu = 0.f, rstd;
        if (mixer == 0) { mu = t1 * (1.0f / 128.0f); rstd = 1.0f / sqrtf(fmaxf(t2 * (1.0f / 128.0f) - mu * mu, 0.f) + EPS); } else rstd = 1.0f / sqrtf(t2 * (1.0f / 128.0f) + EPS);
        bf16* zr = zt + (size_t)tok * EV_IN;
        (void)zr;
        LAS char* tile = lds + MX_OSTG + w * 2560;
#pragma unroll
        for (int i = 0; i < 2; ++i) { const int id = lane + 64 * i; *(LAS v4u*)(tile + (id >> 2) * 80 + (id & 3) * 16) = gwv[2 * t + i]; }
        asm volatile("s_waitcnt lgkmcnt(0)" ::: "memory");
#pragma unroll
        for (int g4 = 0; g4 < 4; ++g4) { const v2u gw = *(const LAS v2u*)(tile + r * 80 + (8 * g4 + 4 * h2) * 2); const f32x4 gv = *(const f32x4*)(gn + 8 * g4);
            const float ga[4] = {__uint_as_float(gw.x << 16), __uint_as_float(gw.x & 0xffff0000u), __uint_as_float(gw.y << 16), __uint_as_float(gw.y & 0xffff0000u)}; float y[4];
#pragma unroll
            for (int e = 0; e < 4; ++e) { y[e] = (o[t][4 * g4 + e] - mu) * rstd * gv[e] * (ga[e] / (1.0f + __expf(-ga[e]))); }
            v2u wv; wv.x = cvtpk(y[0], y[1]); wv.y = cvtpk(y[2], y[3]); *(LAS v2u*)(tile + r * 80 + (8 * g4 + 4 * h2) * 2) = wv; }
        asm volatile("s_waitcnt lgkmcnt(0)" ::: "memory");
#pragma unroll
        for (int i = 0; i < 2; ++i) { const int id = lane + 64 * i; const v4u yv = *(const LAS v4u*)(tile + (id >> 2) * 80 + (id & 3) * 16);
            if (!dry) *(v4u*)(zt + (size_t)(32 * ib + (id >> 2)) * EV_IN + (mixer == 0 ? Z_RQ : Z_GQ) + h * 128 + 32 * vb + 8 * (id & 3)) = yv; }
        asm volatile("s_waitcnt lgkmcnt(0)" ::: "memory");
    }
    __syncthreads();
}


__device__ __forceinline__ float gelu_tanh(float x) { const float u = 0.7978845608028654f * (x + 0.044715f * x * x * x); const float t = 1.0f - 2.0f / (1.0f + __expf(2.0f * u)); return 0.5f * x * (1.0f + t); }
__device__ __forceinline__ void ffn_ew(const bf16* GU, const float* cw, const float* cb, bf16* H, int rows, int gtid, int nthreads) {
    for (int idx = gtid; idx < rows * (DFF / 8); idx += nthreads) {
        const int row = idx / (DFF / 8), c0 = (idx % (DFF / 8)) * 8, t = row % SEQ;
        float g0[8], g1[8], g2[8], u[8];
        unpack8(*(const v4u*)(GU + (size_t)row * (2 * DFF) + c0), g2); unpack8(*(const v4u*)(GU + (size_t)row * (2 * DFF) + DFF + c0), u);
        if (t >= 1) unpack8(*(const v4u*)(GU + (size_t)(row - 1) * (2 * DFF) + c0), g1); else { for (int i = 0; i < 8; ++i) g1[i] = 0.f; }
        if (t >= 2) unpack8(*(const v4u*)(GU + (size_t)(row - 2) * (2 * DFF) + c0), g0); else { for (int i = 0; i < 8; ++i) g0[i] = 0.f; }
        float r[8];
#pragma unroll
        for (int i = 0; i < 8; ++i) { const float y = cw[c0 + i] * g0[i] + cw[DFF + c0 + i] * g1[i] + cw[2 * DFF + c0 + i] * g2[i] + cb[c0 + i]; r[i] = gelu_tanh(y) * u[i]; }
        v4u o; o.x = cvtpk(r[0], r[1]); o.y = cvtpk(r[2], r[3]); o.z = cvtpk(r[4], r[5]); o.w = cvtpk(r[6], r[7]);
        *(v4u*)(H + (size_t)row * DFF + c0) = o;
    }
}

constexpr int LDS_BYTES = 163840;
constexpr int LDSCTL_OFF = LDS_BYTES - 512;
constexpr int CW_BAR = 4096;
constexpr size_t CTL_ZERO_BYTES = 1 * MiB;
#define XB_TMO      128
#define XB_XCNT(j)  (256  + 64 * (j))
#define XB_XSUB(j)  (1280 + 64 * (j))
#define XB_XGEN(j)  (2304 + 64 * (j))
#define XB_TOP      3328
#define XB_TOPGEN   3392
#define XCD_BAR_WORDS 3456
#define XB_SPIN_CAP (1u << 18)

__device__ __forceinline__ unsigned xb_ld(unsigned* p)              { return __hip_atomic_load(p, __ATOMIC_RELAXED, __HIP_MEMORY_SCOPE_AGENT); }
__device__ __forceinline__ unsigned xb_add(unsigned* p, unsigned v) { return __hip_atomic_fetch_add(p, v, __ATOMIC_RELAXED, __HIP_MEMORY_SCOPE_AGENT); }
__device__ __forceinline__ unsigned xb_xcc_id() { return (unsigned)__builtin_amdgcn_s_getreg((3 << 11) | 20) & 0xFu; }
#define XB_SPIN(cond, bar) do { unsigned _sp = 0; while (cond) { __builtin_amdgcn_s_sleep(1); \
    if ((++_sp & 255u) == 0u) { if (xb_ld(&(bar)[XB_TMO])) break; if (_sp > XB_SPIN_CAP) { atomicAdd(&(bar)[XB_TMO], 1u); break; } } } } while (0)

struct XcdBarrier {
    unsigned* bar; unsigned x;
    volatile LAS unsigned* st;
};

__device__ __forceinline__ XcdBarrier xcd_barrier_post(unsigned* bar, volatile LAS unsigned* st) {
    XcdBarrier b; b.bar = bar; b.x = xb_xcc_id(); b.st = st;
    if (threadIdx.x == 0) (void)xb_add(&bar[XB_XCNT(b.x)], 1u);
    return b;
}
__device__ __forceinline__ void xcd_barrier_complete(unsigned* bar, unsigned x, unsigned& nloc, unsigned& nx) {
    const unsigned G = gridDim.x * gridDim.y * gridDim.z;
    unsigned sum, cnt, mine, sp = 0u;
    for (;;) {
        sum = 0u; cnt = 0u; mine = 0u;
#pragma unroll
        for (unsigned j = 0; j < 16; ++j) { const unsigned c = xb_ld(&bar[XB_XCNT(j)]); sum += c; cnt += (c > 0u) ? 1u : 0u; mine = (j == x) ? c : mine; }
        if (sum == G) break;
        __builtin_amdgcn_s_sleep(1);
        if ((++sp & 255u) == 0u) { if (xb_ld(&bar[XB_TMO])) break; if (sp > XB_SPIN_CAP) { atomicAdd(&bar[XB_TMO], 1u); break; } }
    }
    nloc = mine > 0u ? mine : 1u; nx = cnt > 0u ? cnt : 1u;
}

__device__ __forceinline__ void xcd_barrier(const XcdBarrier& b) {
    asm volatile("s_waitcnt vmcnt(0)" ::: "memory");
    __syncthreads();
    if (threadIdx.x == 0) {
        unsigned* bar = b.bar;
        __builtin_amdgcn_s_waitcnt(0);
        unsigned nloc = b.st[0], nx = b.st[1];
        if (nloc == 0u) { xcd_barrier_complete(bar, b.x, nloc, nx); b.st[0] = nloc; b.st[1] = nx; }
        const unsigned old = xb_add(&bar[XB_XSUB(b.x)], 1u);
        const unsigned gen = old / nloc;
        if (old + 1u == (gen + 1u) * nloc) {
            __builtin_amdgcn_fence(__ATOMIC_RELEASE, "agent");
            asm volatile("s_waitcnt vmcnt(0)" ::: "memory");
            const unsigned og = xb_add(&bar[XB_TOP], 1u);
            const unsigned tg = og / nx;
            if (og + 1u == (tg + 1u) * nx) xb_add(&bar[XB_TOPGEN], 1u);
            else XB_SPIN(xb_ld(&bar[XB_TOPGEN]) == tg, bar);
            __builtin_amdgcn_fence(__ATOMIC_ACQUIRE, "agent");
            xb_add(&bar[XB_XGEN(b.x)], 1u);
            asm volatile("s_waitcnt vmcnt(0)" ::: "memory");
        } else {
            XB_SPIN(xb_ld(&bar[XB_XGEN(b.x)]) == gen, bar);
            __builtin_amdgcn_fence(__ATOMIC_ACQUIRE, "agent");
            asm volatile("s_waitcnt vmcnt(0)" ::: "memory");
        }
    }
    __syncthreads();
}


__device__ __forceinline__ GAS unsigned char* launder_s(unsigned char* p) { unsigned long long v = (unsigned long long)p; asm volatile("" : "+s"(v)); return (GAS unsigned char*)v; }
__device__ __forceinline__ GAS float* launder_sf(float* p) { unsigned long long v = (unsigned long long)p; asm volatile("" : "+s"(v)); return (GAS float*)v; }
struct FwdArgs { const float* in[25]; float* out; unsigned char* ws; int ph_lo, ph_hi, li, pad; };
__global__ void __launch_bounds__(512, 2) fwd(FwdArgs a) {
    extern __shared__ __attribute__((aligned(16))) unsigned char lds_raw[];
    LAS unsigned char* lds = (LAS unsigned char*)lds_raw;
    const int tid = threadIdx.x, lane = tid & 63, wave = __builtin_amdgcn_readfirstlane(tid >> 6);
    const int G = gridDim.x, bx = blockIdx.x;
    volatile LAS unsigned* MISC = (volatile LAS unsigned*)(lds + LDSCTL_OFF);
    if (tid < 64) MISC[tid] = 0u;
    __syncthreads();
#define WSP (launder_s(a.ws))
#define OUTP (launder_sf(a.out))
    XcdBarrier bar = xcd_barrier_post((unsigned*)(WSP + WS_CTL) + CW_BAR + a.li * XCD_BAR_WORDS, MISC + 8);
    int ph = 0; const int lo = a.ph_lo, hi = a.ph_hi;
#define PH_ON true) for (int rp_ = 0, nr_ = (ph >= lo && ph < hi) ? 1 + ((a.pad >> ph) & 1) : 0; rp_ < nr_; ++rp_, __syncthreads()
#define TID_L ({ int l_; asm volatile("v_mbcnt_lo_u32_b32 %0, -1, 0\n\tv_mbcnt_hi_u32_b32 %0, -1, %0" : "=v"(l_)); wave * 64 + l_; })
#define PH_END do { if (ph >= lo && ph + 1 < hi) xcd_barrier(bar); ++ph; } while (0)
#define XB ((bf16*)(WSP + WS_XB))
#define SSQP ((float*)(WSP + WS_SSQP))
#define ACT ((bf16*)(WSP + WS_ACT))

    if (PH_ON) { ProArgs pa;
#pragma unroll
        for (int i = 0; i < 25; ++i) pa.in[i] = a.in[i];
        pa.ws = (unsigned char*)WSP; pa.layer_mask = 3; pa.ffn_mode = 2;
        { const int t_ = TID_L; prologue_body(pa, bx * 8 + (t_ >> 6), G * 8, t_ & 63, (LAS float*)lds + (t_ >> 6) * 64 * 65); } }
    PH_END;

    for (int l = 0; l < 2; ++l) {
        if (PH_ON) {
            { pg8::Gemm g{XB, (const bf16*)(WSP + (l ? WS_ODIN : WS_EVIN)), M, l ? OD_IN : EV_IN, D, D}; pg8::EpiBf16S E{ACT, SSQP, l ? OD_IN : EV_IN, M, EPS, 0};
              pg8::StaticOrder S; S.init(g.M, g.N, G, bx); pg8::gemm_phase<pg8::EpiBf16S, pg8::StaticOrder, true, true>(lds, g, S, E, TID_L); }
        }
        PH_END;
        const bf16* mixo; int mixo_ld;
        if (l == 0) {
            MixArgs ma{ACT, (const float*)(WSP + WS_LB), a.in[4], a.in[5], (bf16*)OUTP, (float*)(WSP + WS_DECA), (float*)(WSP + WS_DECB)};
            if (PH_ON) mixA_phase((LAS char*)lds, ma, bx, G, TID_L);
            PH_END;
            if (PH_ON) {
                if (bx < 64 && G > 64) { const int lm = bx >> 5;
                    pg8::Gemm g{(const bf16*)(WSP + (lm ? WS_MEMH1 : WS_MEMH0)), (const bf16*)(WSP + (lm ? WS_XKV1 : WS_XKV0)), MM, 2 * D, D, D}; pg8::EpiBf16S E{(bf16*)(WSP + (lm ? WS_MKV1 : WS_MKV0)), nullptr, 2 * D, M, EPS, 0};
                    pg8::StaticOrder S; S.init(g.M, g.N, G, bx & 31); pg8::gemm_phase<pg8::EpiBf16S, pg8::StaticOrder, true, true>(lds, g, S, E, TID_L); }
                else mix_scan(ma, (bx - 64) * 512 + TID_L, (G - 64) * 512, rp_ + 1 < nr_);
            }
            PH_END;
            if (PH_ON) { for (int u = bx; u < 1024; u += G) mixC_unit((LAS char*)lds, ma, u, TID_L, rp_ + 1 < nr_); }
            PH_END;
            mixo = ACT; mixo_ld = EV_IN;
        } else {
            bf16* O = (bf16*)(WSP + WS_ACT + 96 * MiB);
            DaArgs da; da.QKV = ACT; da.biasT = (const float*)(WSP + WS_BIAST); da.gkq = (const float*)(WSP + WS_GOD); da.N0 = (bf16*)(WSP + WS_N2); da.DEN0 = (float*)(WSP + WS_DEN23);
            da.N1 = (const bf16*)(WSP + WS_N2); da.DEN1 = (const float*)(WSP + WS_DEN23); da.N2 = (const bf16*)OUTP; da.DEN2 = (const float*)(WSP + WS_DEN23) + (size_t)M * 8; da.O = O; da.br0 = 1; da.nbr = 2; da.mode = 0; da.pad = 0;
            if (PH_ON) dattn_phase<0>((LAS char*)lds, da, bx, G, TID_L);
            PH_END;
            if (PH_ON) dattn_phase<1>((LAS char*)lds, da, bx, G, TID_L);
            PH_END;
            mixo = O; mixo_ld = D;
        }
        if (PH_ON) { pg8::Gemm g{mixo, (const bf16*)(WSP + (l ? WS_ODOUT : WS_EVOUT)), M, D, D, mixo_ld}; pg8::EpiResid E{l ? (const float*)nullptr : a.in[0], nullptr, XB, SSQP, D, M};
            pg8::StaticOrder S; S.init(g.M, g.N, G, bx); pg8::gemm_phase<pg8::EpiResid, pg8::StaticOrder, false, true>(lds, g, S, E, TID_L); }
        PH_END;
        { bf16* O = (bf16*)(WSP + WS_ACT + 32 * MiB);
          if (PH_ON) { pg8::Gemm g{XB, (const bf16*)(WSP + (l ? WS_XQ1 : WS_XQ0)), M, D, D, D}; EpiXattn E{(const bf16*)(WSP + (l ? WS_MKV1 : WS_MKV0)), (const float*)(WSP + WS_GXA) + l * 256, O};
              pg8::StaticOrder S; S.init(g.M, g.N, G, bx); pg8::gemm_phase<EpiXattn, pg8::StaticOrder, false, true>(lds, g, S, E, TID_L);
              pg8::StaticOrder S2; S2.init(M, D, G, bx); pg8::Unit uq; if (S2.next(0, uq)) xattn_unit<true>((LAS char*)lds, nullptr, (const bf16*)(WSP + (l ? WS_MKV1 : WS_MKV0)), (const float*)(WSP + WS_GXA) + l * 256, O, uq.pm * 4 + uq.pn, TID_L); }
          PH_END;
          if (PH_ON) { pg8::Gemm g{O, (const bf16*)(WSP + (l ? WS_XO1 : WS_XO0)), M, D, D, D}; pg8::EpiResid E{nullptr, nullptr, XB, SSQP, D, M};
              pg8::StaticOrder S; S.init(g.M, g.N, G, bx); pg8::gemm_phase<pg8::EpiResid, pg8::StaticOrder, false, true>(lds, g, S, E, TID_L); }
          PH_END; }
        { bf16* H = ACT;
          if (PH_ON) { pg8::Gemm g{XB, (const bf16*)(WSP + (l ? WS_FIN1 : WS_FIN0)), 68 * 256, 2 * DFF, D, D}; pg8::EpiFfn E{H, SSQP, a.in[22] + (size_t)l * 3 * DFF, a.in[23] + (size_t)l * DFF, M, EPS};
              pg8::FfnOrder S; S.init(g.M, g.N, G, bx); pg8::gemm_phase<pg8::EpiFfn, pg8::FfnOrder, true, true>(lds, g, S, E, TID_L); }
          PH_END;
          if (PH_ON) { pg8::Gemm g{H, (const bf16*)(WSP + (l ? WS_FOUT1 : WS_FOUT0)), M, D, DFF, DFF}; pg8::EpiResid E{nullptr, l ? (float*)OUTP : (float*)nullptr, XB, SSQP, D, M};
              pg8::StaticOrder S; S.init(g.M, g.N, G, bx); pg8::gemm_phase<pg8::EpiResid, pg8::StaticOrder, false, true>(lds, g, S, E, TID_L); }
          PH_END; }
    }
#undef PH_ON
#undef PH_END
#undef TID_L
#undef WSP
#undef OUTP
#undef XB
#undef SSQP
#undef ACT
}
constexpr int N_PHASES = 1 + 9 + 8;

#ifndef PROBE_MASK
#define PROBE_MASK 0
#endif
#ifndef MK_PER_PHASE
#define MK_PER_PHASE 0
#endif
extern "C" void kernel_launch(void* const* d_in, const int* in_sizes, int n_in, void* d_out, int out_size, void* d_ws, size_t ws_size, hipStream_t stream) {
    static int inited = 0;
    if (!inited) {
        if (n_in != 25 || out_size != M * D || ws_size < WS_END) { fprintf(stderr, "kernel_launch: unexpected shapes (n_in %d, out %d, ws %zu)\n", n_in, out_size, ws_size); inited = -1; return; }
        if (hipFuncSetAttribute((const void*)fwd, hipFuncAttributeMaxDynamicSharedMemorySize, LDS_BYTES) != hipSuccess) { fprintf(stderr, "kernel_launch: hipFuncSetAttribute failed\n"); inited = -1; return; }
        inited = 1;
    }
    if (inited < 0) return;
    if (hipMemsetAsync((char*)d_ws + WS_CTL, 0, CTL_ZERO_BYTES, stream) != hipSuccess) return;
    FwdArgs fa{}; for (int i = 0; i < 25; ++i) fa.in[i] = (const float*)d_in[i]; fa.out = (float*)d_out; fa.ws = (unsigned char*)d_ws; fa.pad = PROBE_MASK;
#if MK_PER_PHASE
    for (int p = 0; p < N_PHASES; ++p) { fa.ph_lo = p; fa.ph_hi = p + 1; fa.li = 0; hipLaunchKernelGGL(fwd, dim3(256), dim3(512), LDS_BYTES, stream, fa); }
#else
    fa.ph_lo = 0; fa.ph_hi = N_PHASES; fa.li = 0; hipLaunchKernelGGL(fwd, dim3(256), dim3(512), LDS_BYTES, stream, fa);
#endif
}
```

```cpp
#include <hip/hip_runtime.h>
#include <cstdio>
#include <cstdint>
namespace pg8 {
#define PG8_LAS __attribute__((address_space(3)))
typedef unsigned short bf16_t;
typedef short bf16x8 __attribute__((ext_vector_type(8)));
typedef float f32x4 __attribute__((ext_vector_type(4)));
typedef unsigned u32x4 __attribute__((ext_vector_type(4)));
constexpr int BM = 256, BK = 64, HALF = 128, HTB = HALF * BK * 2  , STAGE_BYTES = 8 * HTB, NXCD = 8, WGM = 8;
constexpr int SSQ_LDS = STAGE_BYTES + 4096, CW_LDS = STAGE_BYTES + 8192;

__host__ __device__ __forceinline__ int lds_byte(int r, int c) { const int st = (r >> 4) * 2 + (c >> 5), rr = r & 15, cc = c & 31, ob = rr * 64 + cc * 2; return st * 1024 + (ob ^ (((ob >> 9) & 1) << 5)); }
__host__ __device__ __forceinline__ void stage_rc(int b, int& R, int& C) { const int st = b / 1024, sb = b % 1024, swz = sb ^ (((sb >> 9) & 1) << 5); R = (st >> 1) * 16 + swz / 64; C = (st & 1) * 32 + (swz % 64) / 2; }
__host__ __device__ __forceinline__ int perm32(int rho) { const int n = rho >> 4, i = rho & 15; return 8 * (i >> 2) + 4 * n + (i & 3); }

struct Unit { int pm, pn; };
struct Gemm { const bf16_t* A; const bf16_t* Bt; int M, N, K, lda; };

struct StaticOrder {
    int nM, nN, nwg, G, c, wgm;
    __host__ __device__ __forceinline__ void init(int M, int N, int G_, int c_, int wgm_ = 4) { nM = M / BM; nN = N / BM; nwg = nM * nN; G = G_; c = c_; wgm = wgm_; }
    __host__ __device__ __forceinline__ bool next(int i, Unit& u) const {
        const long L = (long)i * G + c; if (L >= nwg) return false;
        int wgid = (int)L; { const int q = nwg / NXCD, r = nwg % NXCD, xcd = wgid % NXCD, off = wgid / NXCD; wgid = (xcd < r ? xcd * (q + 1) : r * (q + 1) + (xcd - r) * q) + off; }
        const int nig = wgm * nN, gid = wgid / nig, fm = gid * wgm, gsz = (nM - fm) < wgm ? (nM - fm) : wgm;
        u.pm = fm + ((wgid % nig) % gsz); u.pn = (wgid % nig) / gsz; return true;
    }
    __device__ __forceinline__ void a_ready(const Unit&) const {}
    __device__ __forceinline__ void done(const Unit&) const {}
    __device__ __forceinline__ int arow(const Unit& u) const { return u.pm * BM; }
};
struct FfnOrder : StaticOrder {
    __device__ __forceinline__ int arow(const Unit& u) const { return (u.pm / 17) * 4096 + 254 * (u.pm % 17) - 2; }
};

__device__ __forceinline__ unsigned cvt_pk_bf16(float lo, float hi) { unsigned r; asm volatile("v_cvt_pk_bf16_f32 %0, %1, %2" : "=v"(r) : "v"(lo), "v"(hi)); return r; }
typedef float f32x2 __attribute__((ext_vector_type(2)));
struct EpiBf16S {
    static constexpr int PERM = 3; static constexpr bool AFTER_DRAIN = false;
    bf16_t* O; const float* ssqp; int ldc; int Mtot; float eps; int pad;
    __device__ __forceinline__ void preload(PG8_LAS unsigned char* lds, const Unit& u, int wr, int wc, int lane) const {
        if (!ssqp) return;
#pragma unroll
        for (int ai = 0; ai < 2; ++ai) __builtin_amdgcn_global_load_lds((const unsigned*)(ssqp + (size_t)wc * Mtot + u.pm * BM + ai * HALF + wr * 64 + lane), (PG8_LAS unsigned*)(lds + SSQ_LDS + (((wr * 2 + ai) * 4 + wc) * 64) * 4), 4, 0, 0);
    }
    __device__ __forceinline__ void preload_unit(PG8_LAS unsigned char*, const Unit&, int, int, int) const {}
    __device__ __forceinline__ void operator()(f32x4 (&acc)[2][2][4][2], const Unit& u, int wr, int wc, int fr, int fq, PG8_LAS unsigned char* lds) const {
        const int row0 = u.pm * BM + wr * 64 + fr; const int col0 = u.pn * BM + wc * 64 + 8 * fq;
        const PG8_LAS float* sl = (const PG8_LAS float*)(lds + SSQ_LDS);
#pragma unroll
        for (int ai = 0; ai < 2; ++ai)
#pragma unroll
            for (int m = 0; m < 4; ++m) { const int row = row0 + ai * HALF + m * 16; float rs = 1.f;
                if (ssqp) { const PG8_LAS float* sp = sl + ((wr * 2 + ai) * 4) * 64 + m * 16 + fr; const float s = (sp[0] + sp[64]) + (sp[128] + sp[192]); rs = __builtin_amdgcn_rsqf(s * (1.0f / 1024.0f) + eps); }
                bf16_t* rowp = O + (size_t)row * ldc + col0;
#pragma unroll
                for (int bj = 0; bj < 2; ++bj) { const f32x4 v0 = acc[ai][bj][m][0] * rs, v1 = acc[ai][bj][m][1] * rs;
                    u32x4 w; w.x = cvt_pk_bf16(v0[0], v0[1]); w.y = cvt_pk_bf16(v0[2], v0[3]); w.z = cvt_pk_bf16(v1[0], v1[1]); w.w = cvt_pk_bf16(v1[2], v1[3]);
                    *(u32x4*)(rowp + bj * 32) = w; } }
    }
};

__device__ __forceinline__ float gelu_tanh_f(float x) { const float u = 0.7978845608028654f * (x + 0.044715f * x * x * x); const float t = 1.0f - 2.0f / (1.0f + __expf(2.0f * u)); return 0.5f * x * (1.0f + t); }
struct EpiFfn {
    static constexpr int PERM = 1; static constexpr bool AFTER_DRAIN = false;
    bf16_t* H; const float* ssqp; const float* cw; const float* cb; int Mtot; float eps;
    __device__ __forceinline__ void preload(PG8_LAS unsigned char* lds, const Unit& u, int wr, int wc, int lane) const {
        const int rowb = (u.pm / 17) * 4096 + 254 * (u.pm % 17) - 2;
#pragma unroll
        for (int ai = 0; ai < 2; ++ai) { const int row = rowb + ai * HALF + wr * 64 + lane; const int rc = row < 0 ? 0 : (row >= Mtot ? Mtot - 1 : row);
            __builtin_amdgcn_global_load_lds((const unsigned*)(ssqp + (size_t)wc * Mtot + rc), (PG8_LAS unsigned*)(lds + SSQ_LDS + (((wr * 2 + ai) * 4 + wc) * 64) * 4), 4, 0, 0); }
    }
    __device__ __forceinline__ void preload_unit(PG8_LAS unsigned char* lds, const Unit& u, int wr, int wc, int lane) const {
        const float* src = (wc < 3 ? cw + (size_t)wc * 2816 : cb) + u.pn * 128 + 64 * wr + lane;
        __builtin_amdgcn_global_load_lds((const unsigned*)src, (PG8_LAS unsigned*)(lds + CW_LDS + (wc * 128 + 64 * wr) * 4), 4, 0, 0);
    }
    __device__ __forceinline__ void operator()(f32x4 (&acc)[2][2][4][2], const Unit& u, int wr, int wc, int fr, int fq, PG8_LAS unsigned char* lds) const {
        constexpr int DFF_ = 2816;
        const int b = u.pm / 17, t = u.pm % 17, pos0 = 254 * t - 2, rowb = b * 4096 + pos0;
        const int colh = u.pn * 128 + wc * 32 + 8 * fq, lane = fq * 16 + fr;
        PG8_LAS float* halo = (PG8_LAS float*)(lds + STAGE_BYTES);
#pragma unroll
        for (int ai = 0; ai < 2; ++ai)
#pragma unroll
            for (int m = 0; m < 4; ++m) { const int rl = ai * HALF + wr * 64 + m * 16 + fr; const PG8_LAS float* sp = (const PG8_LAS float*)(lds + SSQ_LDS) + ((wr * 2 + ai) * 4) * 64 + m * 16 + fr;
                const float sq = (sp[0] + sp[64]) + (sp[128] + sp[192]); const float rs = __builtin_amdgcn_rsqf(sq * (1.0f / 1024.0f) + eps); const bool pad = (pos0 + rl) < 0;
#pragma unroll
                for (int n = 0; n < 2; ++n) {
#pragma unroll
                    for (int e = 0; e < 4; ++e) { acc[ai][0][m][n][e] = pad ? 0.f : acc[ai][0][m][n][e] * rs; acc[ai][1][m][n][e] *= rs; } } }
#pragma unroll
        for (int ai = 0; ai < 2; ++ai) if (fr >= 14) { PG8_LAS float* hp = halo + ((((2 * ai + wr) * 4 + wc) * 4 + fq) * 2 + (fr - 14)) * 8;
            *(PG8_LAS f32x4*)hp = acc[ai][0][3][0]; *(PG8_LAS f32x4*)(hp + 4) = acc[ai][0][3][1]; }
        asm volatile("s_waitcnt lgkmcnt(0)" ::: "memory"); __builtin_amdgcn_s_barrier(); asm volatile("" ::: "memory");
        typedef unsigned u32x2e __attribute__((ext_vector_type(2)));
#define DPPF(x, ctrl) __builtin_bit_cast(float, __builtin_amdgcn_update_dpp(0, __builtin_bit_cast(int, (x)), (ctrl), 0xf, 0xf, true))
        u32x2e hold[2][4];
#pragma unroll
        for (int n = 0; n < 2; ++n) {
            const PG8_LAS float* cwl = (const PG8_LAS float*)(lds + CW_LDS) + wc * 32 + 8 * fq + 4 * n;
            const f32x4 w0 = *(const PG8_LAS f32x4*)cwl, w1 = *(const PG8_LAS f32x4*)(cwl + 128), w2 = *(const PG8_LAS f32x4*)(cwl + 256), bb = *(const PG8_LAS f32x4*)(cwl + 384);
#pragma unroll
            for (int ai = 0; ai < 2; ++ai) {
                const int blk = 2 * ai + wr; f32x4 R1p = (f32x4){0.f, 0.f, 0.f, 0.f}, R2p = (f32x4){0.f, 0.f, 0.f, 0.f};
                if (blk >= 1) { const PG8_LAS float* hp = halo + ((((blk - 1) * 4 + wc) * 4 + fq) * 2) * 8 + 4 * n; const f32x4 h62 = *(const PG8_LAS f32x4*)hp, h63 = *(const PG8_LAS f32x4*)(hp + 8);
                    const f32x4 z4 = (f32x4){0.f, 0.f, 0.f, 0.f}; R1p = fr == 0 ? h63 : z4; R2p = fr == 0 ? h62 : (fr == 1 ? h63 : z4); }
#pragma unroll
                for (int m = 0; m < 4; ++m) { const int rl = ai * HALF + wr * 64 + m * 16 + fr; const bool ok = (rl >= 2) && (pos0 + rl < 4096);
                    float hv[4];
#pragma unroll
                    for (int e = 0; e < 4; ++e) { const float v = acc[ai][0][m][n][e];
                        const float p1 = DPPF(v, 0x111) + R1p[e], p2 = DPPF(v, 0x112) + R2p[e]; R1p[e] = DPPF(v, 0x10F); R2p[e] = DPPF(v, 0x10E);
                        const float y = w0[e] * p2 + (w1[e] * p1 + (w2[e] * v + bb[e]));
                        const float tq = y * (-2.302208198f + -0.10294324f * (y * y));
                        const float sg = __builtin_amdgcn_rcpf(1.0f + __builtin_amdgcn_exp2f(tq));
                        hv[e] = (y * acc[ai][1][m][n][e]) * sg; }
                    u32x2e w; w.x = cvt_pk_bf16(hv[0], hv[1]); w.y = cvt_pk_bf16(hv[2], hv[3]);
                    if (n == 0) hold[ai][m] = w;
                    else if (ok) { u32x4 w4; w4.x = hold[ai][m].x; w4.y = hold[ai][m].y; w4.z = w.x; w4.w = w.y; *(u32x4*)(H + (size_t)(rowb + rl) * DFF_ + colh) = w4; } }
            }
        }
#undef DPPF
        asm volatile("s_waitcnt lgkmcnt(0)" ::: "memory"); __builtin_amdgcn_s_barrier(); asm volatile("" ::: "memory");
    }
};
struct EpiResid {
    static constexpr int PERM = 1; static constexpr bool AFTER_DRAIN = true;
    struct Pre { int unused; };
    const float* base; float* out; bf16_t* xb; float* ssqp; int ldc; int Mtot;
    __device__ __forceinline__ void init(f32x4 (&acc)[2][2][4][2], const Unit& u, int wr, int wc, int fr, int fq) const {
        const int col0 = u.pn * BM + wc * 32 + 8 * fq;
#pragma unroll
        for (int ai = 0; ai < 2; ++ai)
#pragma unroll
            for (int m = 0; m < 4; ++m) { const size_t off = (size_t)(u.pm * BM + ai * HALF + wr * 64 + m * 16 + fr) * ldc + col0;
#pragma unroll
                for (int bj = 0; bj < 2; ++bj) {
                    if (base) { acc[ai][bj][m][0] = __builtin_nontemporal_load((const f32x4*)(base + off + bj * HALF)); acc[ai][bj][m][1] = __builtin_nontemporal_load((const f32x4*)(base + off + bj * HALF + 4)); }
                    else { const u32x4 w = __builtin_nontemporal_load((const u32x4*)(xb + off + bj * HALF));
                        acc[ai][bj][m][0] = (f32x4){__uint_as_float(w.x << 16), __uint_as_float(w.x & 0xffff0000u), __uint_as_float(w.y << 16), __uint_as_float(w.y & 0xffff0000u)};
                        acc[ai][bj][m][1] = (f32x4){__uint_as_float(w.z << 16), __uint_as_float(w.z & 0xffff0000u), __uint_as_float(w.w << 16), __uint_as_float(w.w & 0xffff0000u)}; } } }
    }
    __device__ __forceinline__ void fused(f32x4 (&acc)[2][2][4][2], const Unit& u, int wr, int wc, int fr, int fq, PG8_LAS unsigned char* lds, int wid, int lane) const {
        PG8_LAS float* P = (PG8_LAS float*)lds;
        const int col0 = u.pn * BM + wc * 32 + 8 * fq;
#pragma unroll
        for (int ai = 0; ai < 2; ++ai)
#pragma unroll
            for (int m = 0; m < 4; ++m) { const int r = ai * HALF + wr * 64 + m * 16 + fr; const size_t off = (size_t)(u.pm * BM + r) * ldc + col0; float s = 0.f;
#pragma unroll
                for (int bj = 0; bj < 2; ++bj) { const f32x4 o0 = acc[ai][bj][m][0], o1 = acc[ai][bj][m][1];
                    if (out) { __builtin_nontemporal_store(o0, (f32x4*)(out + off + bj * HALF)); __builtin_nontemporal_store(o1, (f32x4*)(out + off + bj * HALF + 4)); }
                    u32x4 w; w.x = cvt_pk_bf16(o0[0], o0[1]); w.y = cvt_pk_bf16(o0[2], o0[3]); w.z = cvt_pk_bf16(o1[0], o1[1]); w.w = cvt_pk_bf16(o1[2], o1[3]); *(u32x4*)(xb + off + bj * HALF) = w;
                    s += ((o0[0] * o0[0] + o0[1] * o0[1]) + (o0[2] * o0[2] + o0[3] * o0[3])) + ((o1[0] * o1[0] + o1[1] * o1[1]) + (o1[2] * o1[2] + o1[3] * o1[3])); }
                s += __shfl_xor(s, 16); s += __shfl_xor(s, 32);
                if (fq == 0) P[r * 4 + wc] = s;
                if (m & 1) asm volatile("" ::: "memory"); }
        asm volatile("s_waitcnt lgkmcnt(0)" ::: "memory"); __builtin_amdgcn_s_barrier(); asm volatile("" ::: "memory");
        if (lane < 32) { const int row = wid * 32 + lane; ssqp[(size_t)u.pn * Mtot + u.pm * BM + row] = (P[row * 4 + 0] + P[row * 4 + 1]) + (P[row * 4 + 2] + P[row * 4 + 3]); }
        asm volatile("s_waitcnt lgkmcnt(0)" ::: "memory"); __builtin_amdgcn_s_barrier(); asm volatile("" ::: "memory");
    }
};

template <class Epi, class Sched, bool ALIGN_EPI = false, bool SP2 = false>
__device__ __forceinline__ void gemm_phase(PG8_LAS unsigned char* lds, const Gemm g, const Sched& S, const Epi& E, int tid_in) {
    int tid_l = tid_in; asm volatile("" : "+v"(tid_l));
    const int tid = tid_l, wid = __builtin_amdgcn_readfirstlane(tid >> 6), lane = tid & 63, wr = wid >> 2, wc = wid & 3, fr = lane & 15, fq = lane >> 4;
    const int K = g.K, nt = K / BK;
    unsigned voffA[2], voffB[2];
#pragma unroll
    for (int i = 0; i < 2; ++i) { int R, C; stage_rc(tid * 16 + i * 8192, R, C); const int Rb = (int)Epi::PERM == 3 ? (64 * (R >> 5) + perm32(R & 31)) : ((int)Epi::PERM == 1 ? ((R & ~31) + perm32(R & 31)) : R);
        voffA[i] = (unsigned)(R * g.lda + C) * 2u; voffB[i] = (unsigned)(Rb * K + C) * 2u; }
    const size_t kstep = (size_t)(BK * 2);
    const size_t hstepA = (size_t)HALF * g.lda * 2, hstepB = (size_t)((int)Epi::PERM == 3 ? 32 : HALF) * K * 2;
    const size_t tstepB = (size_t)BM * K * 2;
    const unsigned ldsw = (unsigned)wid * 1024u;
    const int aoff = lds_byte(wr * 64 + fr, fq * 8), boff = lds_byte(wc * 32 + fr, fq * 8);
#define PG8_SA(b, h) (((b) * 2 + (h)) * HTB)
#define PG8_SB(b, h) ((4 + (b) * 2 + (h)) * HTB)
#define PG8_STAGE(bufoff, gbase, voff) do { _Pragma("unroll") for (int _i = 0; _i < 2; ++_i) \
        __builtin_amdgcn_global_load_lds((const unsigned*)((const char*)(gbase) + (voff)[_i]), (PG8_LAS unsigned*)(lds + (bufoff) + ldsw + _i * 8192), 16, 0, 0); } while (0)
#define PG8_LDA(dst, b, h) do { _Pragma("unroll") for (int m = 0; m < 4; ++m) _Pragma("unroll") for (int k = 0; k < 2; ++k) dst[m][k] = *(const PG8_LAS bf16x8*)(lds + PG8_SA(b, h) + aoff + m * 2048 + k * 1024); } while (0)
#define PG8_LDB(dst, b, h) do { _Pragma("unroll") for (int n = 0; n < 2; ++n) _Pragma("unroll") for (int k = 0; k < 2; ++k) dst[n][k] = *(const PG8_LAS bf16x8*)(lds + PG8_SB(b, h) + boff + n * 2048 + k * 1024); } while (0)
#define PG8_MMA(ai, bj, At, Bt) do { __builtin_amdgcn_s_setprio(1); _Pragma("unroll") for (int m = 0; m < 4; ++m) _Pragma("unroll") for (int n = 0; n < 2; ++n) _Pragma("unroll") for (int k = 0; k < 2; ++k) \
        acc[ai][bj][m][n] = __builtin_amdgcn_mfma_f32_16x16x32_bf16(Bt[n][k], At[m][k], acc[ai][bj][m][n], 0, 0, 0); __builtin_amdgcn_s_setprio(0); } while (0)
#define PG8_WAIT_V(n) asm volatile("s_waitcnt vmcnt(" #n ")" ::: "memory")
#define PG8_WAIT_L(n) asm volatile("s_waitcnt lgkmcnt(" #n ")" ::: "memory")
#define PG8_BAR __builtin_amdgcn_s_barrier()
#define PG8_SCHED __builtin_amdgcn_sched_barrier(0)
    Unit cur, nxt; int ui = 0;
    if (!S.next(0, cur)) return;
    f32x4 acc[2][2][4][2];
#pragma unroll
    for (int a = 0; a < 2; ++a)
#pragma unroll
        for (int b = 0; b < 2; ++b)
#pragma unroll
            for (int m = 0; m < 4; ++m)
#pragma unroll
                for (int n = 0; n < 2; ++n) acc[a][b][m][n] = (f32x4){0.f, 0.f, 0.f, 0.f};
    if constexpr (Epi::AFTER_DRAIN) E.init(acc, cur, wr, wc, fr, fq);
    bf16x8 At[4][2], B0[2][2], B1[2][2];
    const char* cA = (const char*)g.A + (ptrdiff_t)S.arow(cur) * (ptrdiff_t)(g.lda * 2); const char* cB = (const char*)g.Bt + (size_t)cur.pn * tstepB;
    S.a_ready(cur);
    if constexpr (!Epi::AFTER_DRAIN) E.preload_unit(lds, cur, wr, wc, lane);
    if constexpr (SP2) {
        PG8_STAGE(PG8_SB(0, 0), cB, voffB); PG8_STAGE(PG8_SB(0, 1), cB + hstepB, voffB); PG8_STAGE(PG8_SA(0, 0), cA, voffA); PG8_STAGE(PG8_SA(0, 1), cA + hstepA, voffA);
        if (wr == 1) PG8_BAR;
        PG8_WAIT_V(2); PG8_BAR;
        PG8_STAGE(PG8_SB(1, 0), cB + kstep, voffB); PG8_STAGE(PG8_SA(1, 0), cA + kstep, voffA); PG8_STAGE(PG8_SB(1, 1), cB + hstepB + kstep, voffB);
        PG8_WAIT_V(6); PG8_BAR;
        if constexpr (Epi::AFTER_DRAIN) {
#pragma unroll
            for (int a_ = 0; a_ < 2; ++a_)
#pragma unroll
                for (int b_ = 0; b_ < 2; ++b_) asm volatile("" : "+v"(acc[a_][b_][0][0]), "+v"(acc[a_][b_][0][1]), "+v"(acc[a_][b_][1][0]), "+v"(acc[a_][b_][1][1]), "+v"(acc[a_][b_][2][0]), "+v"(acc[a_][b_][2][1]), "+v"(acc[a_][b_][3][0]), "+v"(acc[a_][b_][3][1]));
        }
    } else {
        PG8_STAGE(PG8_SB(0, 0), cB, voffB); PG8_STAGE(PG8_SA(0, 0), cA, voffA); PG8_STAGE(PG8_SB(0, 1), cB + hstepB, voffB); PG8_STAGE(PG8_SA(0, 1), cA + hstepA, voffA);
        if (wr == 1) PG8_BAR;
        PG8_WAIT_V(4); PG8_BAR;
        PG8_STAGE(PG8_SB(1, 0), cB + kstep, voffB); PG8_STAGE(PG8_SA(1, 0), cA + kstep, voffA); PG8_STAGE(PG8_SB(1, 1), cB + hstepB + kstep, voffB);
        PG8_WAIT_V(6); PG8_BAR;
    }
    for (;;) {
        const bool has_next = S.next(ui + 1, nxt);
        const char* nA = has_next ? (const char*)g.A + (ptrdiff_t)S.arow(nxt) * (ptrdiff_t)(g.lda * 2) : cA; const char* nB = has_next ? (const char*)g.Bt + (size_t)nxt.pn * tstepB : cB;
        for (int t = 0; t < nt; t += 2) {
            const bool last = (t == nt - 2);
            const char* a1 = cA + (size_t)(t + 1) * kstep;
            const char* a2 = last ? nA : cA + (size_t)(t + 2) * kstep; const char* b2 = last ? nB : cB + (size_t)(t + 2) * kstep;
            const char* a3 = a2 + kstep; const char* b3 = b2 + kstep;
            if (last && has_next) S.a_ready(nxt);
            if constexpr (!Epi::AFTER_DRAIN) { if (last) E.preload(lds, cur, wr, wc, lane); }
            if constexpr (SP2) {
            PG8_LDB(B0, 0, 0); PG8_LDB(B1, 0, 1); PG8_SCHED; PG8_LDA(At, 0, 0); PG8_STAGE(PG8_SA(1, 1), a1 + hstepA, voffA);
            PG8_WAIT_V(8); PG8_WAIT_L(0); PG8_BAR; PG8_MMA(0, 0, At, B0); PG8_MMA(0, 1, At, B1); PG8_BAR; PG8_SCHED;
            PG8_LDA(At, 0, 1); PG8_STAGE(PG8_SB(0, 0), b2, voffB); PG8_STAGE(PG8_SB(0, 1), b2 + hstepB, voffB); PG8_STAGE(PG8_SA(0, 0), a2, voffA);
            PG8_WAIT_V(8); PG8_WAIT_L(0); PG8_BAR; PG8_MMA(1, 0, At, B0); PG8_MMA(1, 1, At, B1); PG8_BAR; PG8_SCHED;
            PG8_LDB(B0, 1, 0); PG8_LDB(B1, 1, 1); PG8_SCHED; PG8_LDA(At, 1, 0); PG8_STAGE(PG8_SA(0, 1), a2 + hstepA, voffA);
            PG8_WAIT_V(8); PG8_WAIT_L(0); PG8_BAR; PG8_MMA(0, 0, At, B0); PG8_MMA(0, 1, At, B1); PG8_BAR; PG8_SCHED;
            PG8_LDA(At, 1, 1); PG8_STAGE(PG8_SB(1, 0), b3, voffB); PG8_STAGE(PG8_SB(1, 1), b3 + hstepB, voffB); PG8_STAGE(PG8_SA(1, 0), a3, voffA);
            PG8_WAIT_V(8); PG8_WAIT_L(0); PG8_BAR; PG8_MMA(1, 0, At, B0); PG8_MMA(1, 1, At, B1); PG8_BAR; PG8_SCHED;
            } else {
            PG8_LDB(B0, 0, 0); PG8_SCHED; PG8_LDA(At, 0, 0); PG8_STAGE(PG8_SA(1, 1), a1 + hstepA, voffA);
            PG8_WAIT_L(8); PG8_BAR; PG8_WAIT_L(0); PG8_MMA(0, 0, At, B0); PG8_BAR; PG8_SCHED;
            PG8_LDB(B1, 0, 1); PG8_STAGE(PG8_SB(0, 0), b2, voffB);
            PG8_BAR; PG8_WAIT_L(0); PG8_MMA(0, 1, At, B1); PG8_BAR;
            PG8_LDA(At, 0, 1); PG8_STAGE(PG8_SA(0, 0), a2, voffA);
            PG8_BAR; PG8_WAIT_L(0); PG8_MMA(1, 0, At, B0); PG8_BAR; PG8_SCHED;
            PG8_STAGE(PG8_SB(0, 1), b2 + hstepB, voffB);
            PG8_WAIT_V(6); PG8_BAR; PG8_MMA(1, 1, At, B1); PG8_BAR;
            PG8_LDB(B0, 1, 0); PG8_SCHED; PG8_LDA(At, 1, 0); PG8_STAGE(PG8_SA(0, 1), a2 + hstepA, voffA);
            PG8_WAIT_L(8); PG8_BAR; PG8_WAIT_L(0); PG8_MMA(0, 0, At, B0); PG8_BAR; PG8_SCHED;
            PG8_LDB(B1, 1, 1); PG8_STAGE(PG8_SB(1, 0), b3, voffB);
            PG8_BAR; PG8_WAIT_L(0); PG8_MMA(0, 1, At, B1); PG8_BAR;
            PG8_LDA(At, 1, 1); PG8_STAGE(PG8_SA(1, 0), a3, voffA);
            PG8_BAR; PG8_WAIT_L(0); PG8_MMA(1, 0, At, B0); PG8_BAR; PG8_SCHED;
            PG8_STAGE(PG8_SB(1, 1), b3 + hstepB, voffB);
            PG8_WAIT_V(6); PG8_BAR; PG8_MMA(1, 1, At, B1); PG8_BAR;
            }
        }
        if constexpr (ALIGN_EPI) { if (wr == 0) PG8_BAR; }
        if constexpr (!Epi::AFTER_DRAIN) { E(acc, cur, wr, wc, fr, fq, lds); S.done(cur); if (has_next) E.preload_unit(lds, nxt, wr, wc, lane); }
        if (!has_next) break;
#pragma unroll
        for (int a = 0; a < 2; ++a)
#pragma unroll
            for (int b = 0; b < 2; ++b)
#pragma unroll
                for (int m = 0; m < 4; ++m)
#pragma unroll
                    for (int n = 0; n < 2; ++n) acc[a][b][m][n] = (f32x4){0.f, 0.f, 0.f, 0.f};
        cur = nxt; cA = nA; cB = nB; ++ui;
        if constexpr (ALIGN_EPI) { if (wr == 1) PG8_BAR; }
    }
    PG8_WAIT_V(0);
    if constexpr (!ALIGN_EPI) { if (wr == 0) PG8_BAR; }
    PG8_BAR;
    if constexpr (Epi::AFTER_DRAIN) { E.fused(acc, cur, wr, wc, fr, fq, lds, wid, lane); S.done(cur); }
#undef PG8_SA
#undef PG8_SB
#undef PG8_STAGE
#undef PG8_LDA
#undef PG8_LDB
#undef PG8_MMA
#undef PG8_WAIT_V
#undef PG8_WAIT_L
#undef PG8_BAR
#undef PG8_SCHED
}
}


#define GAS __attribute__((address_space(1)))
#define LAS __attribute__((address_space(3)))
typedef unsigned short bf16;
typedef unsigned v4u __attribute__((ext_vector_type(4)));
typedef unsigned v2u __attribute__((ext_vector_type(2)));
typedef float f32x4 __attribute__((ext_vector_type(4)));
constexpr int BATCH = 4, SEQ = 4096, D = 1024, M = BATCH * SEQ, NMEM = 256, MM = BATCH * NMEM, DFF = 2816;
constexpr int EV_IN = 4096, OD_IN = 3072;
constexpr float EPS = 1e-6f;
constexpr int Z_RQ = 0, Z_GQ = 512, Z_RK = 1024, Z_RV = 1536, Z_RG = 2048, Z_GF = 2560, Z_GI = 3072, Z_GG = 3584;

constexpr size_t MiB = 1u << 20;
constexpr size_t WS_CTL = 0;
constexpr size_t WS_EVIN = 1 * MiB, WS_EVOUT = 9 * MiB, WS_XQ0 = 11 * MiB, WS_XKV0 = 13 * MiB, WS_XO0 = 17 * MiB, WS_FIN0 = 19 * MiB, WS_FOUT0 = 30 * MiB;
constexpr size_t WS_ODIN = 36 * MiB, WS_ODOUT = 42 * MiB, WS_XQ1 = 44 * MiB, WS_XKV1 = 46 * MiB, WS_XO1 = 50 * MiB, WS_FIN1 = 52 * MiB, WS_FOUT1 = 63 * MiB;
constexpr size_t WS_XB = 69 * MiB;
constexpr size_t WS_MKV0 = 101 * MiB, WS_MKV1 = 105 * MiB;
constexpr size_t WS_MEMH0 = 109 * MiB, WS_MEMH1 = 111 * MiB;
constexpr size_t WS_SSQP = 113 * MiB;
constexpr size_t WS_LB = 113 * MiB + 512 * 1024;
constexpr size_t WS_BIAST = 113 * MiB + 516 * 1024;
constexpr size_t WS_GXA = 113 * MiB + 600 * 1024, WS_GOD = 113 * MiB + 604 * 1024;
constexpr size_t WS_DEN23 = 114 * MiB;
constexpr size_t WS_N2 = 1 * MiB;
constexpr size_t WS_ACT = 115 * MiB;
constexpr size_t WS_DECA = 243 * MiB, WS_DECB = 243 * MiB + 512 * 1024;
constexpr size_t WS_END = 256 * MiB;

__device__ __forceinline__ float bf2f(bf16 u) { return __uint_as_float((unsigned)u << 16); }
__device__ __forceinline__ unsigned f2bf(float f) { unsigned u = __builtin_bit_cast(unsigned, f); return (u + 0x7fffu + ((u >> 16) & 1u)) >> 16; }
typedef float f32x2_pk __attribute__((ext_vector_type(2))); typedef __bf16 bf16x2_pk __attribute__((ext_vector_type(2)));
__device__ __forceinline__ unsigned pk2(float lo, float hi) { f32x2_pk v = {lo, hi}; bf16x2_pk b = __builtin_convertvector(v, bf16x2_pk); return __builtin_bit_cast(unsigned, b); }
__device__ __forceinline__ float wave_sum(float v) {
#pragma unroll
    for (int o = 1; o < 64; o <<= 1) v += __shfl_xor(v, o);
    return v;
}
__device__ __forceinline__ float wave_max(float v) {
#pragma unroll
    for (int o = 1; o < 64; o <<= 1) v = fmaxf(v, __shfl_xor(v, o));
    return v;
}
__device__ __forceinline__ void unpack8(const v4u w, float (&f)[8]) {
    f[0] = __uint_as_float(w.x << 16); f[1] = __uint_as_float(w.x & 0xffff0000u); f[2] = __uint_as_float(w.y << 16); f[3] = __uint_as_float(w.y & 0xffff0000u);
    f[4] = __uint_as_float(w.z << 16); f[5] = __uint_as_float(w.z & 0xffff0000u); f[6] = __uint_as_float(w.w << 16); f[7] = __uint_as_float(w.w & 0xffff0000u);
}
__device__ __forceinline__ void rope_sincos(float a, float& s, float& c) {
    const float n = rintf(a * 0.15915494309189535f);
    float r = fmaf(-n, 6.2831854820251465f, a); r = fmaf(-n, -1.7484555e-7f, r);
    const float rev = r * 0.15915494309189535f;
    s = __builtin_amdgcn_sinf(rev); c = __builtin_amdgcn_cosf(rev);
}

__device__ __forceinline__ int dst_row_map(int mode, int n0) {
    if (mode == 1) { const int seg = n0 >> 9, within = n0 & 511; const int dseg = (seg == 0) ? 0 : (seg == 4 ? 1 : (seg < 4 ? seg + 1 : seg)); return dseg * 512 + within; }
    if (mode == 2) { return n0 < DFF ? (n0 >> 7) * 256 + (n0 & 127) : ((n0 - DFF) >> 7) * 256 + 128 + ((n0 - DFF) & 127); }
    return n0;
}
__device__ __forceinline__ void transpose_item(const float* W, int K, int N, const float* g, bf16* WT, int mode, LAS float* scr, int item, int lane) {
    const int nblk = N / 64, kb = item / nblk, nb = item % nblk, k0 = 64 * kb, n0 = 64 * nb, lr = lane >> 4, lc = lane & 15;
    f32x4 v[16];
#pragma unroll
    for (int i = 0; i < 16; ++i) v[i] = __builtin_nontemporal_load((const f32x4*)(W + (size_t)(k0 + 4 * i + lr) * N + n0 + 4 * lc));
#pragma unroll
    for (int i = 0; i < 16; ++i) { const int kk = 4 * i + lr; const float gg = g ? g[k0 + kk] : 1.0f; LAS float* p = scr + kk * 65 + 4 * lc; p[0] = v[i][0] * gg; p[1] = v[i][1] * gg; p[2] = v[i][2] * gg; p[3] = v[i][3] * gg; }
    asm volatile("s_waitcnt lgkmcnt(0)" ::: "memory");
    const int c = lane & 7; const int d0 = dst_row_map(mode, n0);
#pragma unroll
    for (int j = 0; j < 8; ++j) { const int n = (lane >> 3) + 8 * j; const LAS float* sp = scr + (8 * c) * 65 + n;
        v4u o; o.x = pk2(sp[0 * 65], sp[1 * 65]); o.y = pk2(sp[2 * 65], sp[3 * 65]); o.z = pk2(sp[4 * 65], sp[5 * 65]); o.w = pk2(sp[6 * 65], sp[7 * 65]);
        *(v4u*)(WT + (size_t)(d0 + n) * K + k0 + 8 * c) = o; }
    asm volatile("s_waitcnt lgkmcnt(0)" ::: "memory");
}
struct ProArgs { const float* in[25]; unsigned char* ws; int layer_mask; int ffn_mode; };
#define PICK_JOB(Wp_, K__, N__, gp_, dst_, mode_) if (!found) { const int ni_ = ((K__) / 64) * ((N__) / 64); if (r < ni_) { W_ = (Wp_); K_ = (K__); N_ = (N__); g_ = (gp_); d_ = (dst_); m_ = (mode_); found = true; } else r -= ni_; }
__device__ __forceinline__ void prologue_body(const ProArgs& a, int gw, int NGW, int lane, LAS float* scr) {
    unsigned char* ws = a.ws;
    const float* x = a.in[0]; const float* mem = a.in[1];
    if (a.layer_mask & 1) {
        constexpr int NITEMS_ALL = 2 * ((D / 64) * (D / 64) * 3 + (D / 64) * (2 * D / 64) + (D / 64) * (2 * DFF / 64) + (DFF / 64) * (D / 64)) + (D / 64) * (EV_IN / 64) + (D / 64) * (OD_IN / 64) + (D / 64) * (D / 64) * 0;
        for (int it = gw; it < NITEMS_ALL; it += NGW) {
            int r = it; bool found = false; const float* W_ = nullptr; const float* g_ = nullptr; int K_ = 0, N_ = 0, m_ = 0; size_t d_ = 0;
            PICK_JOB(a.in[3], D, EV_IN, a.in[2], WS_EVIN, 1)
            PICK_JOB(a.in[21], D, 2 * DFF, a.in[20], WS_FIN0, a.ffn_mode)
            PICK_JOB(a.in[21] + (size_t)D * 2 * DFF, D, 2 * DFF, a.in[20] + D, WS_FIN1, a.ffn_mode)
            PICK_JOB(a.in[8], D, OD_IN, a.in[2] + D, WS_ODIN, 0)
            PICK_JOB(a.in[24], DFF, D, (const float*)nullptr, WS_FOUT0, 0)
            PICK_JOB(a.in[24] + (size_t)DFF * D, DFF, D, (const float*)nullptr, WS_FOUT1, 0)
            PICK_JOB(a.in[16], D, 2 * D, (const float*)nullptr, WS_XKV0, 0)
            PICK_JOB(a.in[16] + (size_t)D * 2 * D, D, 2 * D, (const float*)nullptr, WS_XKV1, 0)
            PICK_JOB(a.in[7], D, D, (const float*)nullptr, WS_EVOUT, 0)
            PICK_JOB(a.in[12], D, D, (const float*)nullptr, WS_ODOUT, 0)
            PICK_JOB(a.in[15], D, D, a.in[13], WS_XQ0, 0)
            PICK_JOB(a.in[15] + (size_t)D * D, D, D, a.in[13] + D, WS_XQ1, 0)
            PICK_JOB(a.in[19], D, D, (const float*)nullptr, WS_XO0, 0)
            PICK_JOB(a.in[19] + (size_t)D * D, D, D, (const float*)nullptr, WS_XO1, 0)
            if (found) transpose_item(W_, K_, N_, g_, (bf16*)(ws + d_), m_, scr, r, lane);
        }
        for (int m = 2 * gw; m < M; m += 2 * NGW) {
            const f32x4* xr = (const f32x4*)(x + (size_t)m * D) + lane; v2u* o8 = (v2u*)((bf16*)(ws + WS_XB) + (size_t)m * D) + lane; float* sp = (float*)(ws + WS_SSQP);
            f32x4 v[8];
#pragma unroll
            for (int j = 0; j < 8; ++j) v[j] = __builtin_nontemporal_load(xr + 64 * j);
#pragma unroll
            for (int j = 0; j < 8; ++j) { v2u w; w.x = pk2(v[j][0], v[j][1]); w.y = pk2(v[j][2], v[j][3]); o8[64 * j] = w;
                const float s2 = wave_sum((v[j][0] * v[j][0] + v[j][1] * v[j][1]) + (v[j][2] * v[j][2] + v[j][3] * v[j][3])); if (lane == 0) sp[(size_t)(j & 3) * M + m + (j >> 2)] = s2; }
        }
        for (int r = gw; r < 2 * MM; r += NGW) { const int l = r / MM, m = r % MM;
            const f32x4* xr = (const f32x4*)(mem + (size_t)m * D) + lane; const f32x4* gr = (const f32x4*)(a.in[14] + (size_t)l * D) + lane;
            f32x4 v[4]; float s = 0.f;
#pragma unroll
            for (int j = 0; j < 4; ++j) { v[j] = xr[64 * j]; s += (v[j][0] * v[j][0] + v[j][1] * v[j][1]) + (v[j][2] * v[j][2] + v[j][3] * v[j][3]); }
            const float rs = 1.0f / sqrtf(wave_sum(s) * (1.0f / D) + EPS);
            v2u* o8 = (v2u*)((bf16*)(ws + (l ? WS_MEMH1 : WS_MEMH0)) + (size_t)m * D) + lane;
#pragma unroll
            for (int j = 0; j < 4; ++j) { const f32x4 g = gr[64 * j]; v2u w; w.x = pk2(v[j][0] * rs * g[0], v[j][1] * rs * g[1]); w.y = pk2(v[j][2] * rs * g[2], v[j][3] * rs * g[3]); o8[64 * j] = w; }
        }
        if (gw == 0) {
            const float* lg = a.in[6]; float* lb = (float*)(ws + WS_LB);
            for (int c = lane; c < 512; c += 64) { const float a0 = lg[c], a1 = lg[512 + c], a2 = lg[1024 + c]; const float mx = fmaxf(a0, fmaxf(a1, a2));
                const float e0 = expf(a0 - mx), e1 = expf(a1 - mx), e2 = expf(a2 - mx); lb[c] = e0 / (e0 + e1 + e2); }
        }
        if (gw == 2) {
            float* gx = (float*)(ws + WS_GXA); float* go = (float*)(ws + WS_GOD);
            for (int i = lane; i < 512; i += 64) gx[i] = a.in[18][i] * a.in[17][i];
            for (int i = lane; i < 128; i += 64) go[i] = a.in[10][i] * a.in[9][i];
        }
        if (gw == 1) {
            const float* rb = a.in[11]; float* bt = (float*)(ws + WS_BIAST);
            for (int i = lane; i < 3 * 8 * 132; i += 64) { const int br = i / (8 * 132), h = (i / 132) % 8, dl = i % 132; const int d = dl * (1 << (2 * br));
                int bucket; if (d < 16) bucket = d; else { const float lr = logf((float)d / 16.0f) / 4.852030263919617f; int lg2 = 16 + (int)(lr * 16.0f); bucket = lg2 < 31 ? lg2 : 31; }
                bt[i] = (dl <= 128) ? rb[bucket * 8 + h] : 0.f; }
        }
    }
}


typedef short bf16x8 __attribute__((ext_vector_type(8)));
typedef short s16x4 __attribute__((ext_vector_type(4)));
typedef float f32x16 __attribute__((ext_vector_type(16)));
typedef float f32x2_t __attribute__((ext_vector_type(2))); typedef __bf16 bf16x2_t __attribute__((ext_vector_type(2)));
typedef short v4i16_t __attribute__((ext_vector_type(4)));
#define MFMA32(a, b, c) __builtin_amdgcn_mfma_f32_32x32x16_bf16((a), (b), (c), 0, 0, 0)
__device__ __forceinline__ unsigned cvtpk(float lo, float hi) { f32x2_t v = {lo, hi}; bf16x2_t b = __builtin_convertvector(v, bf16x2_t); return __builtin_bit_cast(unsigned, b); }
__device__ __forceinline__ bf16x8 pack8(float a0, float a1, float a2, float a3, float a4, float a5, float a6, float a7) {
    v4u p; p.x = cvtpk(a0, a1); p.y = cvtpk(a2, a3); p.z = cvtpk(a4, a5); p.w = cvtpk(a6, a7); return __builtin_bit_cast(bf16x8, p); }
__device__ __forceinline__ s16x4 vtr(const LAS char* p) { return __builtin_bit_cast(s16x4, __builtin_amdgcn_ds_read_tr16_b64_v4i16((LAS v4i16_t*)p)); }
__device__ __forceinline__ int tr_lane_base(int lane, int stride) { const int g = lane >> 4, i = lane & 15, q = i >> 2, p = i & 3, h2 = g >> 1; return (4 * h2 + q) * stride + (16 * (g & 1) + 4 * p) * 2; }
__device__ __forceinline__ bf16x8 tr_frag_perm(const LAS char* img, int stride, int lbase, int k0, int n0) {
    const LAS char* p = img + lbase + k0 * stride + n0 * 2;
    const s16x4 lo = vtr(p), hi = vtr(p + 8 * stride);
    return (bf16x8){lo[0], lo[1], lo[2], lo[3], hi[0], hi[1], hi[2], hi[3]};
}
__device__ __forceinline__ int tr_lane_base_nat(int lane, int stride) { const int g = lane >> 4, i = lane & 15, q = i >> 2, p = i & 3, h2 = g >> 1; return (8 * h2 + q) * stride + (16 * (g & 1) + 4 * p) * 2; }
__device__ __forceinline__ bf16x8 tr_frag_nat(const LAS char* img, int stride, int lbase, int k0, int n0) {
    const LAS char* p = img + lbase + k0 * stride + n0 * 2;
    const s16x4 lo = vtr(p), hi = vtr(p + 4 * stride);
    return (bf16x8){lo[0], lo[1], lo[2], lo[3], hi[0], hi[1], hi[2], hi[3]};
}

#define LDS_BARRIER() do { asm volatile("s_waitcnt lgkmcnt(0)" ::: "memory"); __builtin_amdgcn_s_barrier(); asm volatile("" ::: "memory"); } while (0)
__device__ __forceinline__ float row16_allsum(float v) {
#define R16_DPP(x, ctrl) __builtin_bit_cast(float, __builtin_amdgcn_update_dpp(0, __builtin_bit_cast(int, (x)), (ctrl), 0xf, 0xf, false))
    v += R16_DPP(v, 0x128); v += R16_DPP(v, 0x124); v += R16_DPP(v, 0x122); v += R16_DPP(v, 0x121);
#undef R16_DPP
    return v;
}
constexpr int XA_STRIDE = 528, XA_VSTRIDE = 528;
constexpr int XA_LDS = 256 * XA_STRIDE;
template <bool Q_IN_LDS> __device__ __forceinline__ void xattn_unit(LAS char* lds, const bf16* __restrict__ Q, const bf16* __restrict__ MKV, const float* __restrict__ gkq, bf16* __restrict__ O, int unit, int tid) {
    const int lane = tid & 63, w = __builtin_amdgcn_readfirstlane(tid >> 6), r = lane & 31, h2 = lane >> 5;
    const int rb = unit >> 2, h = unit & 3, row0 = rb * 256, b = row0 / SEQ;
    const bf16* Kg = MKV + (size_t)(b * NMEM) * 2048 + h * 256; const bf16* Vg = Kg + 1024;
    v4u st[16];
#pragma unroll
    for (int i = 0; i < 16; ++i) { const int id = tid + 512 * i; st[i] = *(const v4u*)(Kg + (size_t)(id >> 5) * 2048 + (id & 31) * 8); }
    const size_t qoff = (size_t)(row0 + 32 * w + r) * D + h * 256;
    bf16x8 qf[16];
    if (Q_IN_LDS) {
#pragma unroll
        for (int s = 0; s < 16; ++s) qf[s] = *(const LAS bf16x8*)(lds + (32 * w + r) * XA_STRIDE + h2 * 16 + s * 32);
        asm volatile("s_waitcnt lgkmcnt(0)" ::: "memory"); __builtin_amdgcn_s_barrier(); asm volatile("" ::: "memory");
    } else {
#pragma unroll
        for (int s = 0; s < 16; ++s) qf[s] = *(const bf16x8*)(Q + qoff + 8 * h2 + 16 * s);
    }
    { float gk8[8];
#pragma unroll
      for (int e = 0; e < 8; ++e) gk8[e] = gkq[(tid & 31) * 8 + e];
#pragma unroll
      for (int i = 0; i < 16; ++i) { const int id = tid + 512 * i; float f[8]; unpack8(st[i], f);
          float sq = (f[0] * f[0] + f[1] * f[1]) + (f[2] * f[2] + f[3] * f[3]) + (f[4] * f[4] + f[5] * f[5]) + (f[6] * f[6] + f[7] * f[7]);
          sq = row16_allsum(sq); sq += __shfl_xor(sq, 16);
          const float rk = __builtin_amdgcn_rsqf(sq * (1.0f / 256.0f) + EPS) * 0.0625f;
          v4u o; o.x = cvtpk(f[0] * rk * gk8[0], f[1] * rk * gk8[1]); o.y = cvtpk(f[2] * rk * gk8[2], f[3] * rk * gk8[3]); o.z = cvtpk(f[4] * rk * gk8[4], f[5] * rk * gk8[5]); o.w = cvtpk(f[6] * rk * gk8[6], f[7] * rk * gk8[7]);
          *(LAS v4u*)(lds + (id >> 5) * XA_STRIDE + (id & 31) * 16) = o; } }
    float ss = 0.f;
#pragma unroll
    for (int s = 0; s < 16; ++s)
#pragma unroll
        for (int j = 0; j < 8; ++j) { const float x = __uint_as_float((unsigned)(unsigned short)qf[s][j] << 16); ss += x * x; }
    ss += __shfl_xor(ss, 32);
    const float rsl = __builtin_amdgcn_rsqf(ss * (1.0f / 256.0f) + EPS) * 1.4426950408889634f;
    asm volatile("" ::: "memory");
#pragma unroll
    for (int i = 0; i < 8; ++i) { const int id = tid + 512 * i; st[i] = *(const v4u*)(Vg + (size_t)(id >> 5) * 2048 + (id & 31) * 8); }
    LDS_BARRIER();
    bf16x8 pf[8][2]; float den = 0.f;
#pragma unroll
    for (int kb = 0; kb < 8; ++kb) {
        f32x16 acc;
#pragma unroll
        for (int i = 0; i < 16; ++i) acc[i] = 0.f;
        const LAS char* kp = lds + (32 * kb + r) * XA_STRIDE + h2 * 16;
#pragma unroll
        for (int s = 0; s < 16; ++s) { const bf16x8 a = *(const LAS bf16x8*)(kp + s * 32); acc = MFMA32(a, qf[s], acc); }
        float p[16];
#pragma unroll
        for (int i = 0; i < 16; ++i) { p[i] = __builtin_amdgcn_exp2f(acc[i] * rsl - 11.541560327111707f); den += p[i]; }
        pf[kb][0] = pack8(p[0], p[1], p[2], p[3], p[4], p[5], p[6], p[7]); pf[kb][1] = pack8(p[8], p[9], p[10], p[11], p[12], p[13], p[14], p[15]);
    }
    den += __shfl_xor(den, 32);
    const float inv = 1.0f / den;
    LDS_BARRIER();
#pragma unroll
    for (int i = 8; i < 16; ++i) { const int id = tid + 512 * i; st[i] = *(const v4u*)(Vg + (size_t)(id >> 5) * 2048 + (id & 31) * 8); }
#pragma unroll
    for (int i = 0; i < 16; ++i) { const int id = tid + 512 * i; *(LAS v4u*)(lds + (id >> 5) * XA_VSTRIDE + (id & 31) * 16) = st[i]; }
    LDS_BARRIER();
    const int lbase = tr_lane_base(lane, XA_VSTRIDE);
#pragma unroll
    for (int half = 0; half < 2; ++half) {
        f32x16 o[4];
#pragma unroll
        for (int vb = 0; vb < 4; ++vb)
#pragma unroll
            for (int i = 0; i < 16; ++i) o[vb][i] = 0.f;
#pragma unroll
        for (int kb = 0; kb < 8; ++kb)
#pragma unroll
            for (int s = 0; s < 2; ++s)
#pragma unroll
                for (int vb = 0; vb < 4; ++vb) { const bf16x8 a = tr_frag_perm(lds, XA_VSTRIDE, lbase, 32 * kb + 16 * s, 128 * half + 32 * vb); o[vb] = MFMA32(a, pf[kb][s], o[vb]); }
        LAS char* tile = lds + 256 * XA_VSTRIDE + w * 2560;
#pragma unroll
        for (int vb = 0; vb < 4; ++vb) {
#pragma unroll
            for (int g4 = 0; g4 < 4; ++g4) { v2u wv; wv.x = cvtpk(o[vb][4 * g4] * inv, o[vb][4 * g4 + 1] * inv); wv.y = cvtpk(o[vb][4 * g4 + 2] * inv, o[vb][4 * g4 + 3] * inv);
                *(LAS v2u*)(tile + r * 80 + (8 * g4 + 4 * h2) * 2) = wv; }
            asm volatile("s_waitcnt lgkmcnt(0)" ::: "memory");
#pragma unroll
            for (int i = 0; i < 2; ++i) { const int id = lane + 64 * i; *(v4u*)(O + (size_t)(row0 + 32 * w + (id >> 2)) * D + h * 256 + 128 * half + 32 * vb + 8 * (id & 3)) = *(const LAS v4u*)(tile + (id >> 2) * 80 + (id & 3) * 16); }
            asm volatile("s_waitcnt lgkmcnt(0)" ::: "memory");
        }
    }
    __syncthreads();
}


struct EpiXattn {
    static constexpr int PERM = 1; static constexpr bool AFTER_DRAIN = true;
    struct Pre { int unused; };
    const bf16* MKV; const float* gkq; bf16* O;
    __device__ __forceinline__ void init(f32x4 (&)[2][2][4][2], const pg8::Unit&, int, int, int, int) const {}
    __device__ __forceinline__ void fused(f32x4 (&acc)[2][2][4][2], const pg8::Unit& u, int wr, int wc, int fr, int fq, LAS unsigned char* lds, int wid, int lane) const {
#pragma unroll
        for (int ai = 0; ai < 2; ++ai)
#pragma unroll
            for (int m = 0; m < 4; ++m) { const int row = ai * 128 + wr * 64 + m * 16 + fr;
#pragma unroll
                for (int bj = 0; bj < 2; ++bj) { const f32x4 v0 = acc[ai][bj][m][0], v1 = acc[ai][bj][m][1];
                    v4u o; o.x = cvtpk(v0[0], v0[1]); o.y = cvtpk(v0[2], v0[3]); o.z = cvtpk(v1[0], v1[1]); o.w = cvtpk(v1[2], v1[3]);
                    *(LAS v4u*)(lds + row * XA_STRIDE + (bj * 128 + wc * 32 + 8 * fq) * 2) = o; } }
        asm volatile("s_waitcnt lgkmcnt(0)" ::: "memory"); __builtin_amdgcn_s_barrier(); asm volatile("" ::: "memory");
    }
};

constexpr int DA_STRIDE = 272, DA_VSTRIDE = 320, DA_LDS_BIAS = 384 * DA_VSTRIDE, DA_LDS_OSTG = DA_LDS_BIAS + 768, DA_OSTG_WAVE = 32 * 144 + 128;
static_assert(DA_LDS_OSTG + 8 * DA_OSTG_WAVE <= 163840 - 512, "dilated attention LDS map");
constexpr int DA_UNUSED0 = 0;
struct DaArgs { const bf16* QKV; const float* biasT; const float* gkq; bf16* N0; float* DEN0; const bf16* N1; const float* DEN1; const bf16* N2; const float* DEN2; bf16* O; int br0; int nbr; int mode; int pad; };
struct DaUnit { int br, b, h, dil, cls, l0; };
template <int MODE> __device__ __forceinline__ DaUnit da_decode(int uu) {
    DaUnit U; U.br = MODE == 0 ? __builtin_amdgcn_readfirstlane(1 + (uu >> 9)) : 0; const int rem = __builtin_amdgcn_readfirstlane(uu & 511), x = rem & 15; U.b = rem >> 7; U.h = (rem >> 4) & 7; U.dil = 1 << (2 * U.br);
    U.cls = U.br == 0 ? 0 : (U.br == 1 ? (x & 3) : x); U.l0 = 256 * (U.br == 0 ? x : (U.br == 1 ? (x >> 2) : 0)); return U; }
__device__ __forceinline__ void da_load_rows(v4u (&st)[12], const bf16* QKV, const DaUnit& U, int col, int tid) {
    const bf16* base = QKV + (size_t)(U.b * SEQ) * OD_IN + U.h * 128 + col + (tid & 15) * 8;
#pragma unroll
    for (int i = 0; i < 12; ++i) { const int ki = (tid >> 4) + 32 * i, lk = U.l0 - 128 + ki, lkc = lk < 0 ? 0 : lk; st[i] = *(const v4u*)(base + (size_t)(lkc * U.dil + U.cls) * OD_IN); }
}
template <int MODE> __device__ __forceinline__ void dattn_phase(LAS char* lds, const DaArgs& a, int bx, int G, int tid) {
    constexpr int NUNITS = MODE == 0 ? 1024 : 512;
    const int lane = tid & 63, w = __builtin_amdgcn_readfirstlane(tid >> 6), r = lane & 31, h2 = lane >> 5;
    int uu = (G == 256) ? (((bx & 7) << 5) | (bx >> 3)) : bx; if (uu >= NUNITS) return;
    v4u st[12];
    { const DaUnit U0 = da_decode<MODE>(uu); da_load_rows(st, a.QKV, U0, 1024, tid); }
    LAS float* lbias = (LAS float*)(lds + DA_LDS_BIAS);
    const int lbase = tr_lane_base(lane, DA_VSTRIDE);
    for (;;) {
        const DaUnit U = da_decode<MODE>(uu);
        const int l0 = U.l0, h = U.h; const bool zfirst = (l0 == 0);
        int r_l = r; asm volatile("" : "+v"(r_l));
        float gk8[8];
#pragma unroll
        for (int e = 0; e < 8; ++e) gk8[e] = a.gkq[(tid & 15) * 8 + e];
        const size_t qrow = (size_t)(U.b * SEQ + (l0 + 32 * w + r) * U.dil + U.cls);
#pragma unroll
        for (int i = 0; i < 12; ++i) { float f_[8]; unpack8((i < 4 && zfirst) ? (v4u){0u, 0u, 0u, 0u} : st[i], f_);
            float sq_ = (f_[0] * f_[0] + f_[1] * f_[1]) + (f_[2] * f_[2] + f_[3] * f_[3]) + (f_[4] * f_[4] + f_[5] * f_[5]) + (f_[6] * f_[6] + f_[7] * f_[7]);
            sq_ = row16_allsum(sq_);
            const float rk_ = __builtin_amdgcn_rsqf(sq_ * (1.0f / 128.0f) + EPS) * 0.08838834764831845f;
            v4u o_; o_.x = cvtpk(f_[0] * rk_ * gk8[0], f_[1] * rk_ * gk8[1]); o_.y = cvtpk(f_[2] * rk_ * gk8[2], f_[3] * rk_ * gk8[3]); o_.z = cvtpk(f_[4] * rk_ * gk8[4], f_[5] * rk_ * gk8[5]); o_.w = cvtpk(f_[6] * rk_ * gk8[6], f_[7] * rk_ * gk8[7]);
            *(LAS v4u*)(lds + ((tid >> 4) + 32 * i) * DA_STRIDE + (tid & 15) * 16) = o_; }
        if (tid < 192) { const int dl = tid - 32; lbias[tid] = (dl >= 0 && dl <= 128) ? a.biasT[(U.br * 8 + h) * 132 + dl] * 1.4426950408889634f - 11.541560327111707f : -__builtin_inff(); }
        asm volatile("" ::: "memory");
        bf16x8 qf[8];
#pragma unroll
        for (int s = 0; s < 8; ++s) qf[s] = *(const bf16x8*)(a.QKV + qrow * OD_IN + h * 128 + 8 * h2 + 16 * s);
        da_load_rows(st, a.QKV, U, 2048, tid);
        float ss = 0.f;
#pragma unroll
        for (int s = 0; s < 8; ++s)
#pragma unroll
            for (int j = 0; j < 8; ++j) { const float xq = __uint_as_float((unsigned)(unsigned short)qf[s][j] << 16); ss += xq * xq; }
        ss += __shfl_xor(ss, 32);
        const float rsl = __builtin_amdgcn_rsqf(ss * (1.0f / 128.0f) + EPS) * 1.4426950408889634f;
        LDS_BARRIER();
        bf16x8 pf[5][2]; float den = 0.f;
#pragma unroll
        for (int kbi = 0; kbi < 5; ++kbi) {
            if (zfirst && w + kbi < 4) { pf[kbi][0] = (bf16x8){0, 0, 0, 0, 0, 0, 0, 0}; pf[kbi][1] = pf[kbi][0]; continue; }
            f32x16 acc;
#pragma unroll
            for (int i = 0; i < 16; ++i) acc[i] = 0.f;
            const LAS char* kp = lds + (32 * (w + kbi) + r) * DA_STRIDE + h2 * 16;
#pragma unroll
            for (int s = 0; s < 8; ++s) { const bf16x8 av = *(const LAS bf16x8*)(kp + s * 32); acc = MFMA32(av, qf[s], acc); }
            __builtin_amdgcn_sched_barrier(0);
            const LAS float* tb = lbias + (r_l - 4 * h2);
#pragma unroll
            for (int hh = 0; hh < 2; ++hh) { float p[8];
#pragma unroll
                for (int i8 = 0; i8 < 8; ++i8) { const int i = 8 * hh + i8;
                    p[i8] = __builtin_amdgcn_exp2f(acc[i] * rsl + tb[160 - 32 * kbi - ((i & 3) + 8 * (i >> 2))]); den += p[i8]; }
                pf[kbi][hh] = pack8(p[0], p[1], p[2], p[3], p[4], p[5], p[6], p[7]);
                __builtin_amdgcn_sched_barrier(0); }
            asm volatile("" ::: "memory");
        }
        den += __shfl_xor(den, 32);
        LDS_BARRIER();
#pragma unroll
        for (int i = 0; i < 12; ++i) *(LAS v4u*)(lds + ((tid >> 4) + 32 * i) * DA_VSTRIDE + (tid & 15) * 16) = (i < 4 && zfirst) ? (v4u){0u, 0u, 0u, 0u} : st[i];
        LDS_BARRIER();
        const int un = uu + G; const bool more = un < NUNITS; const DaUnit Un = da_decode<MODE>(more ? un : uu);
        if (more) da_load_rows(st, a.QKV, Un, 1024, tid);
        LAS char* stg = lds + DA_LDS_OSTG + w * DA_OSTG_WAVE;
        float inv = 1.0f;
        if (MODE == 0) { if (h2 == 0) ((float*)(U.br == 1 ? a.DEN1 : a.DEN2))[qrow * 8 + h] = den; }
        else { inv = 1.0f / (den + a.DEN1[qrow * 8 + h] + a.DEN2[qrow * 8 + h]); if (h2 == 0) ((LAS float*)(stg + 32 * 144))[r] = inv; }
        size_t goff[4];
#pragma unroll
        for (int i = 0; i < 4; ++i) { const int id = lane + 64 * i, row = id >> 3, ch = id & 7; goff[i] = (size_t)(U.b * SEQ + (l0 + 32 * w + row) * U.dil + U.cls) * D + h * 128 + ch * 8; }
#pragma unroll
        for (int half = 0; half < 2; ++half) {
            f32x16 o[2];
            v4u n1v[4], n2v[4];
            if (MODE == 1) {
#pragma unroll
                for (int i = 0; i < 4; ++i) { n1v[i] = *(const v4u*)(a.N1 + goff[i] + 64 * half); n2v[i] = *(const v4u*)(a.N2 + goff[i] + 64 * half); } }
#pragma unroll
            for (int vb = 0; vb < 2; ++vb)
#pragma unroll
                for (int i = 0; i < 16; ++i) o[vb][i] = 0.f;
#pragma unroll
            for (int kbi = 0; kbi < 5; ++kbi)
#pragma unroll
                for (int s = 0; s < 2; ++s)
#pragma unroll
                    for (int vb = 0; vb < 2; ++vb) { const bf16x8 av = tr_frag_perm(lds, DA_VSTRIDE, lbase, 32 * (w + kbi) + 16 * s, 64 * half + 32 * vb); o[vb] = MFMA32(av, pf[kbi][s], o[vb]); }
#pragma unroll
            for (int vb = 0; vb < 2; ++vb)
#pragma unroll
                for (int g4 = 0; g4 < 4; ++g4) { v2u wv; wv.x = cvtpk(o[vb][4 * g4], o[vb][4 * g4 + 1]); wv.y = cvtpk(o[vb][4 * g4 + 2], o[vb][4 * g4 + 3]); *(LAS v2u*)(stg + r * 144 + (32 * vb + 8 * g4 + 4 * h2) * 2) = wv; }
            asm volatile("s_waitcnt lgkmcnt(0)" ::: "memory");
            if (MODE == 0) {
                bf16* N = (bf16*)(U.br == 1 ? a.N1 : a.N2) + 64 * half;
#pragma unroll
                for (int i = 0; i < 4; ++i) { const int id = lane + 64 * i; *(v4u*)(N + goff[i]) = *(const LAS v4u*)(stg + (id >> 3) * 144 + (id & 7) * 16); }
            } else {
#pragma unroll
                for (int i = 0; i < 4; ++i) { const int id = lane + 64 * i; float fo[8], f1[8], f2[8]; unpack8(*(const LAS v4u*)(stg + (id >> 3) * 144 + (id & 7) * 16), fo); unpack8(n1v[i], f1); unpack8(n2v[i], f2);
                    const float iv = ((const LAS float*)(stg + 32 * 144))[id >> 3];
                    v4u ov; ov.x = cvtpk((fo[0] + f1[0] + f2[0]) * iv, (fo[1] + f1[1] + f2[1]) * iv); ov.y = cvtpk((fo[2] + f1[2] + f2[2]) * iv, (fo[3] + f1[3] + f2[3]) * iv);
                    ov.z = cvtpk((fo[4] + f1[4] + f2[4]) * iv, (fo[5] + f1[5] + f2[5]) * iv); ov.w = cvtpk((fo[6] + f1[6] + f2[6]) * iv, (fo[7] + f1[7] + f2[7]) * iv);
                    *(v4u*)(a.O + goff[i] + 64 * half) = ov; }
            }
            asm volatile("s_waitcnt lgkmcnt(0)" ::: "memory");
        }
        LDS_BARRIER();
        if (!more) break;
        uu = un;
    }
}

constexpr int MX_STRIDE = 272, MX_TSTRIDE = 320, MX_IMG = 128 * MX_TSTRIDE;
constexpr int MX_Q = 0, MX_K = MX_IMG, MX_V = 2 * MX_IMG, MX_SCR = 3 * MX_IMG, MX_OSTG = MX_SCR + 5120;
constexpr int MX_UNUSED0 = 0;
struct MixArgs { bf16* Z; const float* lb; const float* ret_g; const float* hg_g; bf16* SBUF; float* DECA; float* DECB; };

__device__ __forceinline__ void st_chunk8(LAS char* img, int stride, int row, int c0, const float (&f)[8]) {
    v4u o; o.x = cvtpk(f[0], f[1]); o.y = cvtpk(f[2], f[3]); o.z = cvtpk(f[4], f[5]); o.w = cvtpk(f[6], f[7]); *(LAS v4u*)(img + row * stride + c0 * 2) = o; }

__device__ __forceinline__ void ret_prep_tile(LAS char* img, int stride, const bf16* zrow  , int j, int cg, const float (&sn)[16], const float (&cs)[16], float sc) {
#pragma unroll
    for (int hc = 0; hc < 2; ++hc) { float x1[8], x2[8], o1[8], o2[8];
        unpack8(*(const v4u*)(zrow + 16 * cg + 8 * hc), x1); unpack8(*(const v4u*)(zrow + 64 + 16 * cg + 8 * hc), x2);
#pragma unroll
        for (int e = 0; e < 8; ++e) { o1[e] = (x1[e] * cs[8 * hc + e] - x2[e] * sn[8 * hc + e]) * sc; o2[e] = (x1[e] * sn[8 * hc + e] + x2[e] * cs[8 * hc + e]) * sc; }
        st_chunk8(img, stride, j, 16 * cg + 8 * hc, o1); st_chunk8(img, stride, j, 64 + 16 * cg + 8 * hc, o2); }
}
__device__ __forceinline__ void copy_tile(LAS char* img, int stride, const bf16* src, int tid) {
#pragma unroll
    for (int i = 0; i < 4; ++i) { const int id = tid + 512 * i, row = id >> 4, ch = id & 15; *(LAS v4u*)(img + row * stride + ch * 16) = *(const v4u*)(src + (size_t)row * EV_IN + ch * 8); }
}
__device__ __forceinline__ float wave_incl_scan(float v) {
#define WIS_DPP(x, ctrl, rmask, bc) __builtin_bit_cast(float, __builtin_amdgcn_update_dpp(0, __builtin_bit_cast(int, (x)), (ctrl), (rmask), 0xf, (bc)))
    v += WIS_DPP(v, 0x111, 0xf, true); v += WIS_DPP(v, 0x112, 0xf, true); v += WIS_DPP(v, 0x114, 0xf, true); v += WIS_DPP(v, 0x118, 0xf, true);
    v += WIS_DPP(v, 0x142, 0xa, false);
    v += WIS_DPP(v, 0x143, 0xc, false);
#undef WIS_DPP
    return v;
}
__device__ __forceinline__ void hg_gates(const bf16* zrow_f  , const float* lbh  , int tid, LAS float* scr, float (&cum)[32], float (&kk)[32]) {
    const int lane = tid & 63, hw = (tid >> 6) & 1, cg = tid >> 7;
#pragma unroll
    for (int q = 0; q < 4; ++q) { float fl[8]; unpack8(*(const v4u*)(zrow_f + 32 * cg + 8 * q), fl);
#pragma unroll
        for (int e = 0; e < 8; ++e) { const float l = lbh[32 * cg + 8 * q + e]; const float f = l + (1.0f - l) * __builtin_amdgcn_rcpf(1.0f + __expf(-fl[e])); kk[8 * q + e] = 1.0f - f; cum[8 * q + e] = __logf(fmaxf(f, 1e-6f)); } }
#pragma unroll
    for (int c = 0; c < 32; ++c) cum[c] = wave_incl_scan(cum[c]);
    if (hw == 0 && lane == 63) {
#pragma unroll
        for (int c = 0; c < 32; ++c) scr[32 * cg + c] = cum[c]; }
    __syncthreads();
    if (hw == 1) {
#pragma unroll
        for (int c = 0; c < 32; ++c) cum[c] += scr[32 * cg + c]; }
    if (hw == 1 && lane == 63) {
#pragma unroll
        for (int c = 0; c < 32; ++c) scr[128 + 32 * cg + c] = cum[c]; }
    __syncthreads();
}

__device__ __forceinline__ void load_prep4(v4u (&rw)[4], const bf16* zrow_seg, int mixer, int cg) {
#pragma unroll
    for (int q = 0; q < 4; ++q) { const int col = mixer == 0 ? ((q >> 1) * 64 + 16 * cg + 8 * (q & 1)) : (32 * cg + 8 * q); rw[q] = *(const v4u*)(zrow_seg + col); }
}
__device__ __forceinline__ void load_copy4(v4u (&rw)[4], const bf16* tile, int tid) {
#pragma unroll
    for (int i = 0; i < 4; ++i) { const int id = tid + 512 * i; rw[i] = *(const v4u*)(tile + (size_t)(id >> 4) * EV_IN + (id & 15) * 8); }
}
__device__ __forceinline__ void store_copy4(LAS char* img, int stride, const v4u (&rw)[4], int tid) {
#pragma unroll
    for (int i = 0; i < 4; ++i) { const int id = tid + 512 * i; *(LAS v4u*)(img + (id >> 4) * stride + (id & 15) * 16) = rw[i]; }
}
__device__ __forceinline__ void ret_prep_raw(LAS char* img, int stride, const v4u (&rw)[4], int j, int cg, const float (&sn)[16], const float (&cs)[16], float sc) {
#pragma unroll
    for (int hc = 0; hc < 2; ++hc) { float x1[8], x2[8], o1[8], o2[8]; unpack8(rw[hc], x1); unpack8(rw[2 + hc], x2);
#pragma unroll
        for (int e = 0; e < 8; ++e) { o1[e] = (x1[e] * cs[8 * hc + e] - x2[e] * sn[8 * hc + e]) * sc; o2[e] = (x1[e] * sn[8 * hc + e] + x2[e] * cs[8 * hc + e]) * sc; }
        st_chunk8(img, stride, j, 16 * cg + 8 * hc, o1); st_chunk8(img, stride, j, 64 + 16 * cg + 8 * hc, o2); }
}
__device__ __forceinline__ void hg_gates_raw(const v4u (&rw)[4], const float* lbh, int tid, LAS float* scr, float (&cum)[32], float (&kk)[32]) {
    const int lane = tid & 63, hw = (tid >> 6) & 1, cg = tid >> 7;
#pragma unroll
    for (int q = 0; q < 4; ++q) { float fl[8]; unpack8(rw[q], fl);
#pragma unroll
        for (int e = 0; e < 8; ++e) { const float l = lbh[32 * cg + 8 * q + e]; const float f = l + (1.0f - l) * __builtin_amdgcn_rcpf(1.0f + __expf(-fl[e])); kk[8 * q + e] = 1.0f - f; cum[8 * q + e] = __logf(fmaxf(f, 1e-6f)); } }
#pragma unroll
    for (int c = 0; c < 32; ++c) cum[c] = wave_incl_scan(cum[c]);
    if (hw == 0 && lane == 63) {
#pragma unroll
        for (int c = 0; c < 32; ++c) scr[32 * cg + c] = cum[c]; }
    LDS_BARRIER();
    if (hw == 1) {
#pragma unroll
        for (int c = 0; c < 32; ++c) cum[c] += scr[32 * cg + c]; }
    if (hw == 1 && lane == 63) {
#pragma unroll
        for (int c = 0; c < 32; ++c) scr[128 + 32 * cg + c] = cum[c]; }
    LDS_BARRIER();
}
struct MixU { int mixer, b, h, n; };
__device__ __forceinline__ MixU mix_decode(int u) { MixU U; const int g = __builtin_amdgcn_readfirstlane(u >> 5); U.n = __builtin_amdgcn_readfirstlane(u & 31); U.mixer = g >> 4; U.b = (g >> 2) & 3; U.h = g & 3; return U; }

__device__ __forceinline__ void mixA_phase(LAS char* lds, const MixArgs& a, int bx, int G, int tid) {
    const int lane = tid & 63, w = __builtin_amdgcn_readfirstlane(tid >> 6), r = lane & 31, h2 = lane >> 5;
    const int j = tid & 127, cg = tid >> 7;
    LAS float* scr = (LAS float*)(lds + MX_SCR);
    int u = bx; if (u >= 1024) return;
    v4u rk[4], rv[4];
    { const MixU U = mix_decode(u); const bf16* zt = a.Z + (size_t)(U.b * SEQ + 128 * U.n) * EV_IN;
      load_prep4(rk, zt + (size_t)j * EV_IN + (U.mixer == 0 ? Z_RK : Z_GF) + U.h * 128, U.mixer, cg); load_copy4(rv, zt + (U.mixer == 0 ? Z_RV : Z_GI) + U.h * 128, tid); }
    for (;;) {
        const MixU U = mix_decode(u); const int h = U.h, n = U.n;
        if (U.mixer == 0) {
            const float gamma = 1.0f - __builtin_amdgcn_exp2f(-5.0f - (float)h), lg2 = log2f(gamma);
            float sn[16], cs[16];
#pragma unroll
            for (int e = 0; e < 16; ++e) { const float inv = __builtin_amdgcn_exp2f(-(float)(16 * cg + e) * (13.287712379549449f / 64.0f)); rope_sincos((float)(128 * n + j) * inv, sn[e], cs[e]); }
            ret_prep_raw(lds + MX_K, MX_TSTRIDE, rk, j, cg, sn, cs, 0.08838834764831845f * __builtin_amdgcn_exp2f((float)(127 - j) * lg2));
            if (tid < 128) { a.DECA[(size_t)u * 128 + tid] = __builtin_amdgcn_exp2f(128.0f * lg2); a.DECB[(size_t)u * 128 + tid] = gamma; }
        } else {
            float cum[32], kk[32];
            hg_gates_raw(rk, a.lb + h * 128, tid, scr, cum, kk);
#pragma unroll
            for (int q = 0; q < 4; ++q) { float o[8];
#pragma unroll
                for (int e = 0; e < 8; ++e) o[e] = kk[8 * q + e] * __expf(scr[128 + 32 * cg + 8 * q + e] - cum[8 * q + e]);
                st_chunk8(lds + MX_K, MX_TSTRIDE, j, 32 * cg + 8 * q, o); }
            if (tid < 128) { a.DECA[(size_t)u * 128 + tid] = __expf(scr[128 + tid]); a.DECB[(size_t)u * 128 + tid] = __expf(scr[tid]); }
        }
        store_copy4(lds + MX_V, MX_TSTRIDE, rv, tid);
        LDS_BARRIER();
        const int un = u + G; const bool more = un < 1024;
        if (more) { const MixU Un = mix_decode(un); const bf16* zt = a.Z + (size_t)(Un.b * SEQ + 128 * Un.n) * EV_IN;
            load_prep4(rk, zt + (size_t)j * EV_IN + (Un.mixer == 0 ? Z_RK : Z_GF) + Un.h * 128, Un.mixer, cg); load_copy4(rv, zt + (Un.mixer == 0 ? Z_RV : Z_GI) + Un.h * 128, tid); }
        const int lbn = tr_lane_base_nat(lane, MX_TSTRIDE); const int kbk = w >> 1, vb0 = 2 * (w & 1);
        f32x16 acc[2];
#pragma unroll
        for (int t = 0; t < 2; ++t)
#pragma unroll
            for (int i = 0; i < 16; ++i) acc[t][i] = 0.f;
#pragma unroll
        for (int s_ = 0; s_ < 8; ++s_) { const bf16x8 av = tr_frag_nat(lds + MX_K, MX_TSTRIDE, lbn, 16 * s_, 32 * kbk);
#pragma unroll
            for (int t = 0; t < 2; ++t) { const bf16x8 bv = tr_frag_nat(lds + MX_V, MX_TSTRIDE, lbn, 16 * s_, 32 * (vb0 + t)); acc[t] = MFMA32(av, bv, acc[t]); } }
        bf16* sb = a.SBUF + (size_t)u * 16384;
#pragma unroll
        for (int t = 0; t < 2; ++t)
#pragma unroll
            for (int g4 = 0; g4 < 4; ++g4) { v2u wv; wv.x = cvtpk(acc[t][4 * g4], acc[t][4 * g4 + 1]); wv.y = cvtpk(acc[t][4 * g4 + 2], acc[t][4 * g4 + 3]);
                *(v2u*)(sb + ((((((vb0 + t) * 8 + 2 * kbk + (g4 >> 1)) * 2 + (g4 & 1)) * 32 + r) * 8) + 4 * h2)) = wv; }
        LDS_BARRIER();
        if (!more) break;
        u = un;
    }
}

__device__ __forceinline__ void mixA_unit(LAS char* lds, const MixArgs& a, int u, int tid) {
    const int lane = tid & 63, w = __builtin_amdgcn_readfirstlane(tid >> 6), r = lane & 31, h2 = lane >> 5;
    const int g = u >> 5, n = u & 31, mixer = g >> 4, b = (g >> 2) & 3, h = g & 3;
    const int j = tid & 127, cg = tid >> 7;
    const bf16* zt = a.Z + (size_t)(b * SEQ + 128 * n) * EV_IN;
    LAS float* scr = (LAS float*)(lds + MX_SCR);
    if (mixer == 0) {
        const float gamma = 1.0f - __builtin_amdgcn_exp2f(-5.0f - (float)h), lg2 = log2f(gamma);
        float sn[16], cs[16];
#pragma unroll
        for (int e = 0; e < 16; ++e) { const float inv = __builtin_amdgcn_exp2f(-(float)(16 * cg + e) * (13.287712379549449f / 64.0f)); rope_sincos((float)(128 * n + j) * inv, sn[e], cs[e]); }
        ret_prep_tile(lds + MX_K, MX_TSTRIDE, zt + (size_t)j * EV_IN + Z_RK + h * 128, j, cg, sn, cs, 0.08838834764831845f * __builtin_amdgcn_exp2f((float)(127 - j) * lg2));
        copy_tile(lds + MX_V, MX_TSTRIDE, zt + Z_RV + h * 128, tid);
        if (tid < 128) { a.DECA[(size_t)u * 128 + tid] = __builtin_amdgcn_exp2f(128.0f * lg2); a.DECB[(size_t)u * 128 + tid] = gamma; }
    } else {
        float cum[32], kk[32];
        hg_gates(zt + (size_t)j * EV_IN + Z_GF + h * 128, a.lb + h * 128, tid, scr, cum, kk);
#pragma unroll
        for (int q = 0; q < 4; ++q) { float o[8];
#pragma unroll
            for (int e = 0; e < 8; ++e) o[e] = kk[8 * q + e] * __expf(scr[128 + 32 * cg + 8 * q + e] - cum[8 * q + e]);
            st_chunk8(lds + MX_K, MX_TSTRIDE, j, 32 * cg + 8 * q, o); }
        copy_tile(lds + MX_V, MX_TSTRIDE, zt + Z_GI + h * 128, tid);
        if (tid < 128) { a.DECA[(size_t)u * 128 + tid] = __expf(scr[128 + tid]); a.DECB[(size_t)u * 128 + tid] = __expf(scr[tid]); }
    }
    __syncthreads();
    const int lbn = tr_lane_base_nat(lane, MX_TSTRIDE); const int kbk = w >> 1, vb0 = 2 * (w & 1);
    f32x16 acc[2];
#pragma unroll
    for (int t = 0; t < 2; ++t)
#pragma unroll
        for (int i = 0; i < 16; ++i) acc[t][i] = 0.f;
#pragma unroll
    for (int s = 0; s < 8; ++s) { const bf16x8 av = tr_frag_nat(lds + MX_K, MX_TSTRIDE, lbn, 16 * s, 32 * kbk);
#pragma unroll
        for (int t = 0; t < 2; ++t) { const bf16x8 bv = tr_frag_nat(lds + MX_V, MX_TSTRIDE, lbn, 16 * s, 32 * (vb0 + t)); acc[t] = MFMA32(av, bv, acc[t]); } }
    bf16* sb = a.SBUF + (size_t)u * 16384;
#pragma unroll
    for (int t = 0; t < 2; ++t)
#pragma unroll
        for (int g4 = 0; g4 < 4; ++g4) { v2u wv; wv.x = cvtpk(acc[t][4 * g4], acc[t][4 * g4 + 1]); wv.y = cvtpk(acc[t][4 * g4 + 2], acc[t][4 * g4 + 3]);
            *(v2u*)(sb + ((((((vb0 + t) * 8 + 2 * kbk + (g4 >> 1)) * 2 + (g4 & 1)) * 32 + r) * 8) + 4 * h2)) = wv; }
    __syncthreads();
}

__device__ __forceinline__ void mix_scan(const MixArgs& a, int gtid, int nthreads, bool dry = false) {
    for (int e = gtid; e < 32 * 4096; e += nthreads) { const int g = e >> 12, el = e & 4095, dk4 = 4 * ((el >> 7) & 7) + 2 * ((el >> 6) & 1) + (el & 1);
        bf16* sp = a.SBUF + (size_t)(g * 32) * 16384 + (size_t)el * 4; const float* da = a.DECA + (size_t)(g * 32) * 128 + 4 * dk4; const float* db = a.DECB + (size_t)(g * 32) * 128 + 4 * dk4;
        f32x4 S = (f32x4){0.f, 0.f, 0.f, 0.f};
#pragma unroll 8
        for (int n = 0; n < 32; ++n) { const v2u kv = *(const v2u*)(sp + (size_t)n * 16384); const f32x4 A = *(const f32x4*)(da + n * 128), Bv = *(const f32x4*)(db + n * 128);
            const f32x4 so = S * Bv; v2u wv; wv.x = cvtpk(so[0], so[1]); wv.y = cvtpk(so[2], so[3]); if (!dry) *(v2u*)(sp + (size_t)n * 16384) = wv;
            S[0] = A[0] * S[0] + __uint_as_float(kv.x << 16); S[1] = A[1] * S[1] + __uint_as_float(kv.x & 0xffff0000u); S[2] = A[2] * S[2] + __uint_as_float(kv.y << 16); S[3] = A[3] * S[3] + __uint_as_float(kv.y & 0xffff0000u); }
    }
}

__device__ __forceinline__ void mixC_unit(LAS char* lds, const MixArgs& a, int u, int tid, bool dry = false) {
    const int lane = tid & 63, w = __builtin_amdgcn_readfirstlane(tid >> 6), r = lane & 31, h2 = lane >> 5;
    const int g = u >> 5, n = u & 31, mixer = g >> 4, b = (g >> 2) & 3, h = g & 3;
    const int j = tid & 127, cg = tid >> 7;
    bf16* zt = a.Z + (size_t)(b * SEQ + 128 * n) * EV_IN;
    LAS float* scr = (LAS float*)(lds + MX_SCR);
    if (mixer == 0) {
        const float gamma = 1.0f - __builtin_amdgcn_exp2f(-5.0f - (float)h), lg2 = log2f(gamma);
        float sn[16], cs[16];
#pragma unroll
        for (int e = 0; e < 16; ++e) { const float inv = __builtin_amdgcn_exp2f(-(float)(16 * cg + e) * (13.287712379549449f / 64.0f)); rope_sincos((float)(128 * n + j) * inv, sn[e], cs[e]); }
        ret_prep_tile(lds + MX_Q, MX_STRIDE, zt + (size_t)j * EV_IN + Z_RQ + h * 128, j, cg, sn, cs, __builtin_amdgcn_exp2f((float)j * lg2));
        ret_prep_tile(lds + MX_K, MX_STRIDE, zt + (size_t)j * EV_IN + Z_RK + h * 128, j, cg, sn, cs, 0.08838834764831845f * __builtin_amdgcn_exp2f(-(float)j * lg2));
        copy_tile(lds + MX_V, MX_TSTRIDE, zt + Z_RV + h * 128, tid);
    } else {
        float cum[32], kk[32];
        hg_gates(zt + (size_t)j * EV_IN + Z_GF + h * 128, a.lb + h * 128, tid, scr, cum, kk);
#pragma unroll
        for (int q = 0; q < 4; ++q) { float qv[8], oq[8], ok[8]; unpack8(*(const v4u*)(zt + (size_t)j * EV_IN + Z_GQ + h * 128 + 32 * cg + 8 * q), qv);
#pragma unroll
            for (int e = 0; e < 8; ++e) { const float d = cum[8 * q + e] - scr[32 * cg + 8 * q + e]; oq[e] = qv[e] * __expf(d); ok[e] = kk[8 * q + e] * __expf(-d); }
            st_chunk8(lds + MX_Q, MX_STRIDE, j, 32 * cg + 8 * q, oq); st_chunk8(lds + MX_K, MX_STRIDE, j, 32 * cg + 8 * q, ok); }
        copy_tile(lds + MX_V, MX_TSTRIDE, zt + Z_GI + h * 128, tid);
    }
    __syncthreads();
    const int vb = w >> 1; const int lbp = tr_lane_base(lane, MX_TSTRIDE);
    const bf16* sb = a.SBUF + (size_t)u * 16384 + (size_t)((vb * 16 + h2) * 32 + r) * 8;
    bf16x8 sf[8];
#pragma unroll
    for (int s = 0; s < 8; ++s) sf[s] = *(const bf16x8*)(sb + s * 512);
    f32x16 o[2]; float s1[2], s2[2];
    const float* rg_ = a.ret_g; const float* hg_ = a.hg_g; const float* gn = (mixer == 0 ? rg_ : hg_) + h * 128 + 32 * vb + 4 * h2;
    v4u gwv[4];
#pragma unroll
    for (int t = 0; t < 2; ++t) { const int ib = (w & 1) ? (1 + t) : (3 * t);
#pragma unroll
        for (int i = 0; i < 2; ++i) { const int id = lane + 64 * i; gwv[2 * t + i] = *(const v4u*)(zt + (size_t)(32 * ib + (id >> 2)) * EV_IN + (mixer == 0 ? Z_RG : Z_GG) + h * 128 + 32 * vb + 8 * (id & 3)); } }
#pragma unroll
    for (int t = 0; t < 2; ++t) {
        const int ib = (w & 1) ? (1 + t) : (3 * t);
        bf16x8 qf[8];
#pragma unroll
        for (int s = 0; s < 8; ++s) qf[s] = *(const LAS bf16x8*)(lds + MX_Q + (32 * ib + r) * MX_STRIDE + h2 * 16 + s * 32);
#pragma unroll
        for (int i = 0; i < 16; ++i) o[t][i] = 0.f;
#pragma unroll
        for (int s = 0; s < 8; ++s) o[t] = MFMA32(sf[s], qf[s], o[t]);
        for (int jb = 0; jb <= ib; ++jb) {
            f32x16 acc;
#pragma unroll
            for (int i = 0; i < 16; ++i) acc[i] = 0.f;
            const LAS char* kp = lds + MX_K + (32 * jb + r) * MX_STRIDE + h2 * 16;
#pragma unroll
            for (int s = 0; s < 8; ++s) { const bf16x8 av = *(const LAS bf16x8*)(kp + s * 32); acc = MFMA32(av, qf[s], acc); }
            if (jb == ib) {
#pragma unroll
                for (int i = 0; i < 16; ++i) { const int c = (i & 3) + 8 * (i >> 2) + 4 * h2; if (c > r) acc[i] = 0.f; } }
            const bf16x8 p0 = pack8(acc[0], acc[1], acc[2], acc[3], acc[4], acc[5], acc[6], acc[7]), p1 = pack8(acc[8], acc[9], acc[10], acc[11], acc[12], acc[13], acc[14], acc[15]);
            const bf16x8 v0 = tr_frag_perm(lds + MX_V, MX_TSTRIDE, lbp, 32 * jb, 32 * vb), v1 = tr_frag_perm(lds + MX_V, MX_TSTRIDE, lbp, 32 * jb + 16, 32 * vb);
            o[t] = MFMA32(v0, p0, o[t]); o[t] = MFMA32(v1, p1, o[t]);
        }
        float a1 = 0.f, a2 = 0.f;
#pragma unroll
        for (int i = 0; i < 16; ++i) { a1 += o[t][i]; a2 += o[t][i] * o[t][i]; }
        a1 += __shfl_xor(a1, 32); a2 += __shfl_xor(a2, 32); s1[t] = a1; s2[t] = a2;
        if (h2 == 0) { scr[256 + (vb * 128 + 32 * ib + r) * 2] = a1; scr[256 + (vb * 128 + 32 * ib + r) * 2 + 1] = a2; }
    }
    LDS_BARRIER();
#pragma unroll
    for (int t = 0; t < 2; ++t) {
        const int ib = (w & 1) ? (1 + t) : (3 * t); const int tok = 32 * ib + r;
        float t1 = 0.f, t2 = 0.f;
#pragma unroll
        for (int v = 0; v < 4; ++v) { t1 += scr[256 + (v * 128 + tok) * 2]; t2 += scr[256 + (v * 128 + tok) * 2 + 1]; }
        float mu = 0.f, rstd;
        if (mixer == 0) { mu = t1 * (1.0f / 128.0f); rstd = __builtin_amdgcn_rsqf(fmaxf(t2 * (1.0f / 128.0f) - mu * mu, 0.f) + EPS); } else rstd = __builtin_amdgcn_rsqf(t2 * (1.0f / 128.0f) + EPS);
        bf16* zr = zt + (size_t)tok * EV_IN;
        (void)zr;
        LAS char* tile = lds + MX_OSTG + w * 2560;
#pragma unroll
        for (int i = 0; i < 2; ++i) { const int id = lane + 64 * i; *(LAS v4u*)(tile + (id >> 2) * 80 + (id & 3) * 16) = gwv[2 * t + i]; }
        asm volatile("s_waitcnt lgkmcnt(0)" ::: "memory");
#pragma unroll
        for (int g4 = 0; g4 < 4; ++g4) { const v2u gw = *(const LAS v2u*)(tile + r * 80 + (8 * g4 + 4 * h2) * 2); const f32x4 gv = *(const f32x4*)(gn + 8 * g4);
            const float ga[4] = {__uint_as_float(gw.x << 16), __uint_as_float(gw.x & 0xffff0000u), __uint_as_float(gw.y << 16), __uint_as_float(gw.y & 0xffff0000u)}; float y[4];
#pragma unroll
            for (int e = 0; e < 4; ++e) { y[e] = (o[t][4 * g4 + e] - mu) * rstd * gv[e] * (ga[e] * __builtin_amdgcn_rcpf(1.0f + __expf(-ga[e]))); }
            v2u wv; wv.x = cvtpk(y[0], y[1]); wv.y = cvtpk(y[2], y[3]); *(LAS v2u*)(tile + r * 80 + (8 * g4 + 4 * h2) * 2) = wv; }
        asm volatile("s_waitcnt lgkmcnt(0)" ::: "memory");
#pragma unroll
        for (int i = 0; i < 2; ++i) { const int id = lane + 64 * i; const v4u yv = *(const LAS v4u*)(tile + (id >> 2) * 80 + (id & 3) * 16);
            if (!dry) *(v4u*)(zt + (size_t)(32 * ib + (id >> 2)) * EV_IN + (mixer == 0 ? Z_RQ : Z_GQ) + h * 128 + 32 * vb + 8 * (id & 3)) = yv; }
        asm volatile("s_waitcnt lgkmcnt(0)" ::: "memory");
    }
    __syncthreads();
}


__device__ __forceinline__ float gelu_tanh(float x) { const float u = 0.7978845608028654f * (x + 0.044715f * x * x * x); const float t = 1.0f - 2.0f / (1.0f + __expf(2.0f * u)); return 0.5f * x * (1.0f + t); }
__device__ __forceinline__ void ffn_ew(const bf16* GU, const float* cw, const float* cb, bf16* H, int rows, int gtid, int nthreads) {
    for (int idx = gtid; idx < rows * (DFF / 8); idx += nthreads) {
        const int row = idx / (DFF / 8), c0 = (idx % (DFF / 8)) * 8, t = row % SEQ;
        float g0[8], g1[8], g2[8], u[8];
        unpack8(*(const v4u*)(GU + (size_t)row * (2 * DFF) + c0), g2); unpack8(*(const v4u*)(GU + (size_t)row * (2 * DFF) + DFF + c0), u);
        if (t >= 1) unpack8(*(const v4u*)(GU + (size_t)(row - 1) * (2 * DFF) + c0), g1); else { for (int i = 0; i < 8; ++i) g1[i] = 0.f; }
        if (t >= 2) unpack8(*(const v4u*)(GU + (size_t)(row - 2) * (2 * DFF) + c0), g0); else { for (int i = 0; i < 8; ++i) g0[i] = 0.f; }
        float r[8];
#pragma unroll
        for (int i = 0; i < 8; ++i) { const float y = cw[c0 + i] * g0[i] + cw[DFF + c0 + i] * g1[i] + cw[2 * DFF + c0 + i] * g2[i] + cb[c0 + i]; r[i] = gelu_tanh(y) * u[i]; }
        v4u o; o.x = cvtpk(r[0], r[1]); o.y = cvtpk(r[2], r[3]); o.z = cvtpk(r[4], r[5]); o.w = cvtpk(r[6], r[7]);
        *(v4u*)(H + (size_t)row * DFF + c0) = o;
    }
}

constexpr int LDS_BYTES = 163840;
constexpr int LDSCTL_OFF = LDS_BYTES - 512;
constexpr int CW_BAR = 4096;
constexpr size_t CTL_ZERO_BYTES = 1 * MiB;
#define XB_TMO      128
#define XB_XCNT(j)  (256  + 64 * (j))
#define XB_XSUB(j)  (1280 + 64 * (j))
#define XB_XGEN(j)  (2304 + 64 * (j))
#define XB_TOP      3328
#define XB_TOPGEN   3392
#define XCD_BAR_WORDS 3456
#define XB_SPIN_CAP (1u << 18)

__device__ __forceinline__ unsigned xb_ld(unsigned* p)              { return __hip_atomic_load(p, __ATOMIC_RELAXED, __HIP_MEMORY_SCOPE_AGENT); }
__device__ __forceinline__ unsigned xb_add(unsigned* p, unsigned v) { return __hip_atomic_fetch_add(p, v, __ATOMIC_RELAXED, __HIP_MEMORY_SCOPE_AGENT); }
__device__ __forceinline__ unsigned xb_xcc_id() { return (unsigned)__builtin_amdgcn_s_getreg((3 << 11) | 20) & 0xFu; }
#define XB_SPIN(cond, bar) do { unsigned _sp = 0; while (cond) { __builtin_amdgcn_s_sleep(1); \
    if ((++_sp & 255u) == 0u) { if (xb_ld(&(bar)[XB_TMO])) break; if (_sp > XB_SPIN_CAP) { atomicAdd(&(bar)[XB_TMO], 1u); break; } } } } while (0)

struct XcdBarrier {
    unsigned* bar; unsigned x;
    volatile LAS unsigned* st;
};

__device__ __forceinline__ XcdBarrier xcd_barrier_post(unsigned* bar, volatile LAS unsigned* st) {
    XcdBarrier b; b.bar = bar; b.x = xb_xcc_id(); b.st = st;
    if (threadIdx.x == 0) (void)xb_add(&bar[XB_XCNT(b.x)], 1u);
    return b;
}
__device__ __forceinline__ void xcd_barrier_complete(unsigned* bar, unsigned x, unsigned& nloc, unsigned& nx) {
    const unsigned G = gridDim.x * gridDim.y * gridDim.z;
    unsigned sum, cnt, mine, sp = 0u;
    for (;;) {
        sum = 0u; cnt = 0u; mine = 0u;
#pragma unroll
        for (unsigned j = 0; j < 16; ++j) { const unsigned c = xb_ld(&bar[XB_XCNT(j)]); sum += c; cnt += (c > 0u) ? 1u : 0u; mine = (j == x) ? c : mine; }
        if (sum == G) break;
        __builtin_amdgcn_s_sleep(1);
        if ((++sp & 255u) == 0u) { if (xb_ld(&bar[XB_TMO])) break; if (sp > XB_SPIN_CAP) { atomicAdd(&bar[XB_TMO], 1u); break; } }
    }
    nloc = mine > 0u ? mine : 1u; nx = cnt > 0u ? cnt : 1u;
}

__device__ __forceinline__ void xcd_barrier(const XcdBarrier& b) {
    asm volatile("s_waitcnt vmcnt(0)" ::: "memory");
    __syncthreads();
    if (threadIdx.x == 0) {
        unsigned* bar = b.bar;
        __builtin_amdgcn_s_waitcnt(0);
        unsigned nloc = b.st[0], nx = b.st[1];
        if (nloc == 0u) { xcd_barrier_complete(bar, b.x, nloc, nx); b.st[0] = nloc; b.st[1] = nx; }
        const unsigned old = xb_add(&bar[XB_XSUB(b.x)], 1u);
        const unsigned gen = old / nloc;
        if (old + 1u == (gen + 1u) * nloc) {
            __builtin_amdgcn_fence(__ATOMIC_RELEASE, "agent");
            asm volatile("s_waitcnt vmcnt(0)" ::: "memory");
            const unsigned og = xb_add(&bar[XB_TOP], 1u);
            const unsigned tg = og / nx;
            if (og + 1u == (tg + 1u) * nx) xb_add(&bar[XB_TOPGEN], 1u);
            else XB_SPIN(xb_ld(&bar[XB_TOPGEN]) == tg, bar);
            __builtin_amdgcn_fence(__ATOMIC_ACQUIRE, "agent");
            xb_add(&bar[XB_XGEN(b.x)], 1u);
            asm volatile("s_waitcnt vmcnt(0)" ::: "memory");
        } else {
            XB_SPIN(xb_ld(&bar[XB_XGEN(b.x)]) == gen, bar);
            __builtin_amdgcn_fence(__ATOMIC_ACQUIRE, "agent");
            asm volatile("s_waitcnt vmcnt(0)" ::: "memory");
        }
    }
    __syncthreads();
}


__device__ __forceinline__ GAS unsigned char* launder_s(unsigned char* p) { unsigned long long v = (unsigned long long)p; asm volatile("" : "+s"(v)); return (GAS unsigned char*)v; }
__device__ __forceinline__ GAS float* launder_sf(float* p) { unsigned long long v = (unsigned long long)p; asm volatile("" : "+s"(v)); return (GAS float*)v; }
struct FwdArgs { const float* in[25]; float* out; unsigned char* ws; int ph_lo, ph_hi, li, pad; };
__global__ void __launch_bounds__(512, 2) fwd(FwdArgs a) {
    extern __shared__ __attribute__((aligned(16))) unsigned char lds_raw[];
    LAS unsigned char* lds = (LAS unsigned char*)lds_raw;
    const int tid = threadIdx.x, lane = tid & 63, wave = __builtin_amdgcn_readfirstlane(tid >> 6);
    const int G = gridDim.x, bx = blockIdx.x;
    volatile LAS unsigned* MISC = (volatile LAS unsigned*)(lds + LDSCTL_OFF);
    if (tid < 64) MISC[tid] = 0u;
    __syncthreads();
#define WSP (launder_s(a.ws))
#define OUTP (launder_sf(a.out))
    XcdBarrier bar = xcd_barrier_post((unsigned*)(WSP + WS_CTL) + CW_BAR + a.li * XCD_BAR_WORDS, MISC + 8);
    int ph = 0; const int lo = a.ph_lo, hi = a.ph_hi;
#define PH_ON true) for (int rp_ = 0, nr_ = (ph >= lo && ph < hi) ? 1 + ((a.pad >> ph) & 1) : 0; rp_ < nr_; ++rp_, __syncthreads()
#define TID_L ({ int l_; asm volatile("v_mbcnt_lo_u32_b32 %0, -1, 0\n\tv_mbcnt_hi_u32_b32 %0, -1, %0" : "=v"(l_)); wave * 64 + l_; })
#define PH_END do { if (ph >= lo && ph + 1 < hi) xcd_barrier(bar); ++ph; } while (0)
#define XB ((bf16*)(WSP + WS_XB))
#define SSQP ((float*)(WSP + WS_SSQP))
#define ACT ((bf16*)(WSP + WS_ACT))

    if (PH_ON) { ProArgs pa;
#pragma unroll
        for (int i = 0; i < 25; ++i) pa.in[i] = a.in[i];
        pa.ws = (unsigned char*)WSP; pa.layer_mask = 3; pa.ffn_mode = 2;
        { const int t_ = TID_L; prologue_body(pa, bx * 8 + (t_ >> 6), G * 8, t_ & 63, (LAS float*)lds + (t_ >> 6) * 64 * 65); } }
    PH_END;

    for (int l = 0; l < 2; ++l) {
        if (PH_ON) {
            { pg8::Gemm g{XB, (const bf16*)(WSP + (l ? WS_ODIN : WS_EVIN)), M, l ? OD_IN : EV_IN, D, D}; pg8::EpiBf16S E{ACT, SSQP, l ? OD_IN : EV_IN, M, EPS, 0};
              pg8::StaticOrder S; S.init(g.M, g.N, G, bx); pg8::gemm_phase<pg8::EpiBf16S, pg8::StaticOrder, true, true>(lds, g, S, E, TID_L); }
        }
        PH_END;
        const bf16* mixo; int mixo_ld;
        if (l == 0) {
            MixArgs ma{ACT, (const float*)(WSP + WS_LB), a.in[4], a.in[5], (bf16*)OUTP, (float*)(WSP + WS_DECA), (float*)(WSP + WS_DECB)};
            if (PH_ON) mixA_phase((LAS char*)lds, ma, bx, G, TID_L);
            PH_END;
            if (PH_ON) {
                if (bx < 64 && G > 64) { const int lm = bx >> 5;
                    pg8::Gemm g{(const bf16*)(WSP + (lm ? WS_MEMH1 : WS_MEMH0)), (const bf16*)(WSP + (lm ? WS_XKV1 : WS_XKV0)), MM, 2 * D, D, D}; pg8::EpiBf16S E{(bf16*)(WSP + (lm ? WS_MKV1 : WS_MKV0)), nullptr, 2 * D, M, EPS, 0};
                    pg8::StaticOrder S; S.init(g.M, g.N, G, bx & 31); pg8::gemm_phase<pg8::EpiBf16S, pg8::StaticOrder, true, true>(lds, g, S, E, TID_L); }
                else mix_scan(ma, (bx - 64) * 512 + TID_L, (G - 64) * 512, rp_ + 1 < nr_);
            }
            PH_END;
            if (PH_ON) { for (int u = bx; u < 1024; u += G) mixC_unit((LAS char*)lds, ma, u, TID_L, rp_ + 1 < nr_); }
            PH_END;
            mixo = ACT; mixo_ld = EV_IN;
        } else {
            bf16* O = (bf16*)(WSP + WS_ACT + 96 * MiB);
            DaArgs da; da.QKV = ACT; da.biasT = (const float*)(WSP + WS_BIAST); da.gkq = (const float*)(WSP + WS_GOD); da.N0 = (bf16*)(WSP + WS_N2); da.DEN0 = (float*)(WSP + WS_DEN23);
            da.N1 = (const bf16*)(WSP + WS_N2); da.DEN1 = (const float*)(WSP + WS_DEN23); da.N2 = (const bf16*)OUTP; da.DEN2 = (const float*)(WSP + WS_DEN23) + (size_t)M * 8; da.O = O; da.br0 = 1; da.nbr = 2; da.mode = 0; da.pad = 0;
            if (PH_ON) dattn_phase<0>((LAS char*)lds, da, bx, G, TID_L);
            PH_END;
            if (PH_ON) dattn_phase<1>((LAS char*)lds, da, bx, G, TID_L);
            PH_END;
            mixo = O; mixo_ld = D;
        }
        if (PH_ON) { pg8::Gemm g{mixo, (const bf16*)(WSP + (l ? WS_ODOUT : WS_EVOUT)), M, D, D, mixo_ld}; pg8::EpiResid E{l ? (const float*)nullptr : a.in[0], nullptr, XB, SSQP, D, M};
            pg8::StaticOrder S; S.init(g.M, g.N, G, bx); pg8::gemm_phase<pg8::EpiResid, pg8::StaticOrder, false, true>(lds, g, S, E, TID_L); }
        PH_END;
        { bf16* O = (bf16*)(WSP + WS_ACT + 32 * MiB);
          if (PH_ON) { pg8::Gemm g{XB, (const bf16*)(WSP + (l ? WS_XQ1 : WS_XQ0)), M, D, D, D}; EpiXattn E{(const bf16*)(WSP + (l ? WS_MKV1 : WS_MKV0)), (const float*)(WSP + WS_GXA) + l * 256, O};
              pg8::StaticOrder S; S.init(g.M, g.N, G, bx); pg8::gemm_phase<EpiXattn, pg8::StaticOrder, false, true>(lds, g, S, E, TID_L);
              pg8::StaticOrder S2; S2.init(M, D, G, bx); pg8::Unit uq; if (S2.next(0, uq)) xattn_unit<true>((LAS char*)lds, nullptr, (const bf16*)(WSP + (l ? WS_MKV1 : WS_MKV0)), (const float*)(WSP + WS_GXA) + l * 256, O, uq.pm * 4 + uq.pn, TID_L); }
          PH_END;
          if (PH_ON) { pg8::Gemm g{O, (const bf16*)(WSP + (l ? WS_XO1 : WS_XO0)), M, D, D, D}; pg8::EpiResid E{nullptr, nullptr, XB, SSQP, D, M};
              pg8::StaticOrder S; S.init(g.M, g.N, G, bx); pg8::gemm_phase<pg8::EpiResid, pg8::StaticOrder, false, true>(lds, g, S, E, TID_L); }
          PH_END; }
        { bf16* H = ACT;
          if (PH_ON) { pg8::Gemm g{XB, (const bf16*)(WSP + (l ? WS_FIN1 : WS_FIN0)), 68 * 256, 2 * DFF, D, D}; pg8::EpiFfn E{H, SSQP, a.in[22] + (size_t)l * 3 * DFF, a.in[23] + (size_t)l * DFF, M, EPS};
              pg8::FfnOrder S; S.init(g.M, g.N, G, bx); pg8::gemm_phase<pg8::EpiFfn, pg8::FfnOrder, true, true>(lds, g, S, E, TID_L); }
          PH_END;
          if (PH_ON) { pg8::Gemm g{H, (const bf16*)(WSP + (l ? WS_FOUT1 : WS_FOUT0)), M, D, DFF, DFF}; pg8::EpiResid E{nullptr, l ? (float*)OUTP : (float*)nullptr, XB, SSQP, D, M};
              pg8::StaticOrder S; S.init(g.M, g.N, G, bx); pg8::gemm_phase<pg8::EpiResid, pg8::StaticOrder, false, true>(lds, g, S, E, TID_L); }
          PH_END; }
    }
#undef PH_ON
#undef PH_END
#undef TID_L
#undef WSP
#undef OUTP
#undef XB
#undef SSQP
#undef ACT
}
constexpr int N_PHASES = 1 + 9 + 8;

#ifndef PROBE_MASK
#define PROBE_MASK 0
#endif
#ifndef MK_PER_PHASE
#define MK_PER_PHASE 0
#endif
extern "C" void kernel_launch(void* const* d_in, const int* in_sizes, int n_in, void* d_out, int out_size, void* d_ws, size_t ws_size, hipStream_t stream) {
    static int inited = 0;
    if (!inited) {
        if (n_in != 25 || out_size != M * D || ws_size < WS_END) { fprintf(stderr, "kernel_launch: unexpected shapes (n_in %d, out %d, ws %zu)\n", n_in, out_size, ws_size); inited = -1; return; }
        if (hipFuncSetAttribute((const void*)fwd, hipFuncAttributeMaxDynamicSharedMemorySize, LDS_BYTES) != hipSuccess) { fprintf(stderr, "kernel_launch: hipFuncSetAttribute failed\n"); inited = -1; return; }
        inited = 1;
    }
    if (inited < 0) return;
    if (hipMemsetAsync((char*)d_ws + WS_CTL, 0, CTL_ZERO_BYTES, stream) != hipSuccess) return;
    FwdArgs fa{}; for (int i = 0; i < 25; ++i) fa.in[i] = (const float*)d_in[i]; fa.out = (float*)d_out; fa.ws = (unsigned char*)d_ws; fa.pad = PROBE_MASK;
#if MK_PER_PHASE
    for (int p = 0; p < N_PHASES; ++p) { fa.ph_lo = p; fa.ph_hi = p + 1; fa.li = 0; hipLaunchKernelGGL(fwd, dim3(256), dim3(512), LDS_BYTES, stream, fa); }
#else
    fa.ph_lo = 0; fa.ph_hi = N_PHASES; fa.li = 0; hipLaunchKernelGGL(fwd, dim3(256), dim3(512), LDS_BYTES, stream, fa);
#endif
}
```

```cpp
#include <hip/hip_runtime.h>
#include <cstdio>
#include <cstdint>
namespace pg8 {
#define PG8_LAS __attribute__((address_space(3)))
typedef unsigned short bf16_t;
typedef short bf16x8 __attribute__((ext_vector_type(8)));
typedef float f32x4 __attribute__((ext_vector_type(4)));
typedef unsigned u32x4 __attribute__((ext_vector_type(4)));
constexpr int BM = 256, BK = 64, HALF = 128, HTB = HALF * BK * 2  , STAGE_BYTES = 8 * HTB, NXCD = 8, WGM = 8;
constexpr int SSQ_LDS = STAGE_BYTES + 4096, CW_LDS = STAGE_BYTES + 8192;

__host__ __device__ __forceinline__ int lds_byte(int r, int c) { const int st = (r >> 4) * 2 + (c >> 5), rr = r & 15, cc = c & 31, ob = rr * 64 + cc * 2; return st * 1024 + (ob ^ (((ob >> 9) & 1) << 5)); }
__host__ __device__ __forceinline__ void stage_rc(int b, int& R, int& C) { const int st = b / 1024, sb = b % 1024, swz = sb ^ (((sb >> 9) & 1) << 5); R = (st >> 1) * 16 + swz / 64; C = (st & 1) * 32 + (swz % 64) / 2; }
__host__ __device__ __forceinline__ int perm32(int rho) { const int n = rho >> 4, i = rho & 15; return 8 * (i >> 2) + 4 * n + (i & 3); }

struct Unit { int pm, pn; };
struct Gemm { const bf16_t* A; const bf16_t* Bt; int M, N, K, lda; size_t kblk = 256; };

struct StaticOrder {
    int nM, nN, nwg, G, c, wgm;
    __host__ __device__ __forceinline__ void init(int M, int N, int G_, int c_, int wgm_ = 4) { nM = M / BM; nN = N / BM; nwg = nM * nN; G = G_; c = c_; wgm = wgm_; }
    __host__ __device__ __forceinline__ bool next(int i, Unit& u) const {
        const long L = (long)i * G + c; if (L >= nwg) return false;
        int wgid = (int)L; { const int q = nwg / NXCD, r = nwg % NXCD, xcd = wgid % NXCD, off = wgid / NXCD; wgid = (xcd < r ? xcd * (q + 1) : r * (q + 1) + (xcd - r) * q) + off; }
        const int nig = wgm * nN, gid = wgid / nig, fm = gid * wgm, gsz = (nM - fm) < wgm ? (nM - fm) : wgm;
        u.pm = fm + ((wgid % nig) % gsz); u.pn = (wgid % nig) / gsz; return true;
    }
    __device__ __forceinline__ void a_ready(const Unit&) const {}
    __device__ __forceinline__ void done(const Unit&) const {}
    __device__ __forceinline__ int arow(const Unit& u) const { return u.pm * BM; }
};
struct FfnOrder : StaticOrder {
    __device__ __forceinline__ int arow(const Unit& u) const { return (u.pm / 17) * 4096 + 254 * (u.pm % 17) - 2; }
};

__device__ __forceinline__ unsigned cvt_pk_bf16(float lo, float hi) { unsigned r; asm volatile("v_cvt_pk_bf16_f32 %0, %1, %2" : "=v"(r) : "v"(lo), "v"(hi)); return r; }
typedef float f32x2 __attribute__((ext_vector_type(2)));
struct EpiBf16S {
    static constexpr int PERM = 3; static constexpr bool AFTER_DRAIN = false;
    bf16_t* O; const float* ssqp; int ldc; int Mtot; float eps; int pad;
    __device__ __forceinline__ void preload(PG8_LAS unsigned char* lds, const Unit& u, int wr, int wc, int lane) const {
        if (!ssqp) return;
#pragma unroll
        for (int ai = 0; ai < 2; ++ai) __builtin_amdgcn_global_load_lds((const unsigned*)(ssqp + (size_t)wc * Mtot + u.pm * BM + ai * HALF + wr * 64 + lane), (PG8_LAS unsigned*)(lds + SSQ_LDS + (((wr * 2 + ai) * 4 + wc) * 64) * 4), 4, 0, 0);
    }
    __device__ __forceinline__ void preload_unit(PG8_LAS unsigned char*, const Unit&, int, int, int) const {}
    __device__ __forceinline__ void operator()(f32x4 (&acc)[2][2][4][2], const Unit& u, int wr, int wc, int fr, int fq, PG8_LAS unsigned char* lds) const {
        const int row0 = u.pm * BM + wr * 64 + fr; const int col0 = u.pn * BM + wc * 64 + 8 * fq;
        const PG8_LAS float* sl = (const PG8_LAS float*)(lds + SSQ_LDS);
#pragma unroll
        for (int ai = 0; ai < 2; ++ai)
#pragma unroll
            for (int m = 0; m < 4; ++m) { const int row = row0 + ai * HALF + m * 16; float rs = 1.f;
                if (ssqp) { const PG8_LAS float* sp = sl + ((wr * 2 + ai) * 4) * 64 + m * 16 + fr; const float s = (sp[0] + sp[64]) + (sp[128] + sp[192]); rs = __builtin_amdgcn_rsqf(s * (1.0f / 1024.0f) + eps); }
                bf16_t* rowp = pad ? O + (size_t)(col0 >> 7) * ((size_t)Mtot * 128) + (size_t)row * 128 + (col0 & 127) : O + (size_t)row * ldc + col0;
#pragma unroll
                for (int bj = 0; bj < 2; ++bj) { const f32x4 v0 = acc[ai][bj][m][0] * rs, v1 = acc[ai][bj][m][1] * rs;
                    u32x4 w; w.x = cvt_pk_bf16(v0[0], v0[1]); w.y = cvt_pk_bf16(v0[2], v0[3]); w.z = cvt_pk_bf16(v1[0], v1[1]); w.w = cvt_pk_bf16(v1[2], v1[3]);
                    *(u32x4*)(rowp + bj * 32) = w; } }
    }
};

struct EpiQKn {
    static constexpr int PERM = 3; static constexpr bool AFTER_DRAIN = false;
    bf16_t* O; const float* ssqp; const float* G; int ldc; int Mtot; float eps; int pad;
    __device__ __forceinline__ void preload(PG8_LAS unsigned char* lds, const Unit& u, int wr, int wc, int lane) const {
#pragma unroll
        for (int ai = 0; ai < 2; ++ai) __builtin_amdgcn_global_load_lds((const unsigned*)(ssqp + (size_t)wc * Mtot + u.pm * BM + ai * HALF + wr * 64 + lane), (PG8_LAS unsigned*)(lds + SSQ_LDS + (((wr * 2 + ai) * 4 + wc) * 64) * 4), 4, 0, 0);
    }
    __device__ __forceinline__ void preload_unit(PG8_LAS unsigned char*, const Unit&, int, int, int) const {}
    __device__ __forceinline__ void operator()(f32x4 (&acc)[2][2][4][2], const Unit& u, int wr, int wc, int fr, int fq, PG8_LAS unsigned char* lds) const {
        const int row0 = u.pm * BM + wr * 64 + fr; const int col0 = u.pn * BM + wc * 64 + 8 * fq;
        const PG8_LAS float* sl = (const PG8_LAS float*)(lds + SSQ_LDS);
        PG8_LAS float* P = (PG8_LAS float*)(lds + STAGE_BYTES);
        const int kind = u.pn >> 2;
        float sc[2][4];
#pragma unroll
        for (int ai = 0; ai < 2; ++ai)
#pragma unroll
            for (int m = 0; m < 4; ++m) { const PG8_LAS float* sp = sl + ((wr * 2 + ai) * 4) * 64 + m * 16 + fr; const float s = (sp[0] + sp[64]) + (sp[128] + sp[192]); sc[ai][m] = __builtin_amdgcn_rsqf(s * (1.0f / 1024.0f) + eps); }
        if (kind < 2) {
            float hs[2][4];
#pragma unroll
            for (int ai = 0; ai < 2; ++ai)
#pragma unroll
                for (int m = 0; m < 4; ++m) { float q = 0.f;
#pragma unroll
                    for (int bj = 0; bj < 2; ++bj)
#pragma unroll
                        for (int n = 0; n < 2; ++n) { const f32x4 v = acc[ai][bj][m][n]; q += (v[0] * v[0] + v[1] * v[1]) + (v[2] * v[2] + v[3] * v[3]); }
                    q += __shfl_xor(q, 16); q += __shfl_xor(q, 32); hs[ai][m] = q;
                    if (fq == 0) P[(ai * HALF + wr * 64 + m * 16 + fr) * 4 + wc] = q; }
            asm volatile("s_waitcnt lgkmcnt(0)" ::: "memory"); __builtin_amdgcn_s_barrier(); asm volatile("" ::: "memory");
#pragma unroll
            for (int ai = 0; ai < 2; ++ai)
#pragma unroll
                for (int m = 0; m < 4; ++m) { const float tot = hs[ai][m] + P[(ai * HALF + wr * 64 + m * 16 + fr) * 4 + (wc ^ 1)]; const float rx = sc[ai][m];
                    sc[ai][m] = rx * __builtin_amdgcn_rsqf(rx * rx * tot * (1.0f / 128.0f) + eps); }
        }
        f32x4 g[2][2];
#pragma unroll
        for (int bj = 0; bj < 2; ++bj)
#pragma unroll
            for (int n = 0; n < 2; ++n) { if (kind == 0) g[bj][n] = *(const f32x4*)(G + ((wc & 1) * 64 + 8 * fq + 32 * bj + 4 * n)); else g[bj][n] = (f32x4){1.f, 1.f, 1.f, 1.f}; }
#pragma unroll
        for (int ai = 0; ai < 2; ++ai)
#pragma unroll
            for (int m = 0; m < 4; ++m) { const int row = row0 + ai * HALF + m * 16; const float rs = sc[ai][m];
                bf16_t* rowp = O + (size_t)kind * ((size_t)Mtot * 1024) + ((size_t)((u.pm >> 4) * 8 + ((col0 & 1023) >> 7)) * 4096 + (row & 4095)) * 128 + (col0 & 127);
#pragma unroll
                for (int bj = 0; bj < 2; ++bj) { f32x4 v0 = acc[ai][bj][m][0] * rs, v1 = acc[ai][bj][m][1] * rs; if (kind == 0) { v0 *= g[bj][0]; v1 *= g[bj][1]; }
                    u32x4 w; w.x = cvt_pk_bf16(v0[0], v0[1]); w.y = cvt_pk_bf16(v0[2], v0[3]); w.z = cvt_pk_bf16(v1[0], v1[1]); w.w = cvt_pk_bf16(v1[2], v1[3]);
                    *(u32x4*)(rowp + bj * 32) = w; } }
        if (kind < 2) { asm volatile("s_waitcnt lgkmcnt(0)" ::: "memory"); __builtin_amdgcn_s_barrier(); asm volatile("" ::: "memory"); }
    }
};

struct EpiKVn {
    static constexpr int PERM = 3; static constexpr bool AFTER_DRAIN = false;
    bf16_t* O; const float* G; int ldc; float eps;
    __device__ __forceinline__ void preload(PG8_LAS unsigned char*, const Unit&, int, int, int) const {}
    __device__ __forceinline__ void preload_unit(PG8_LAS unsigned char*, const Unit&, int, int, int) const {}
    __device__ __forceinline__ void operator()(f32x4 (&acc)[2][2][4][2], const Unit& u, int wr, int wc, int fr, int fq, PG8_LAS unsigned char* lds) const {
        const int row0 = u.pm * BM + wr * 64 + fr; const int col0 = u.pn * BM + wc * 64 + 8 * fq;
        PG8_LAS float* P = (PG8_LAS float*)(lds + STAGE_BYTES);
        const bool isk = u.pn < 4;
        float sc[2][4];
#pragma unroll
        for (int ai = 0; ai < 2; ++ai)
#pragma unroll
            for (int m = 0; m < 4; ++m) sc[ai][m] = 1.f;
        if (isk) {
#pragma unroll
            for (int ai = 0; ai < 2; ++ai)
#pragma unroll
                for (int m = 0; m < 4; ++m) { float q = 0.f;
#pragma unroll
                    for (int bj = 0; bj < 2; ++bj)
#pragma unroll
                        for (int n = 0; n < 2; ++n) { const f32x4 v = acc[ai][bj][m][n]; q += (v[0] * v[0] + v[1] * v[1]) + (v[2] * v[2] + v[3] * v[3]); }
                    q += __shfl_xor(q, 16); q += __shfl_xor(q, 32);
                    if (fq == 0) P[(ai * HALF + wr * 64 + m * 16 + fr) * 4 + wc] = q; }
            asm volatile("s_waitcnt lgkmcnt(0)" ::: "memory"); __builtin_amdgcn_s_barrier(); asm volatile("" ::: "memory");
#pragma unroll
            for (int ai = 0; ai < 2; ++ai)
#pragma unroll
                for (int m = 0; m < 4; ++m) { const f32x4 t4 = *(const PG8_LAS f32x4*)(P + (ai * HALF + wr * 64 + m * 16 + fr) * 4); sc[ai][m] = __builtin_amdgcn_rsqf(((t4[0] + t4[1]) + (t4[2] + t4[3])) * (1.0f / 256.0f) + eps) * 0.0625f; }
        }
        f32x4 g[2][2];
#pragma unroll
        for (int bj = 0; bj < 2; ++bj)
#pragma unroll
            for (int n = 0; n < 2; ++n) { if (isk) g[bj][n] = *(const f32x4*)(G + (wc * 64 + 8 * fq + 32 * bj + 4 * n)); else g[bj][n] = (f32x4){1.f, 1.f, 1.f, 1.f}; }
#pragma unroll
        for (int ai = 0; ai < 2; ++ai)
#pragma unroll
            for (int m = 0; m < 4; ++m) { const int row = row0 + ai * HALF + m * 16; const float rs = sc[ai][m];
                bf16_t* rowp = O + (size_t)row * ldc + col0;
#pragma unroll
                for (int bj = 0; bj < 2; ++bj) { f32x4 v0 = acc[ai][bj][m][0], v1 = acc[ai][bj][m][1]; if (isk) { v0 = v0 * rs * g[bj][0]; v1 = v1 * rs * g[bj][1]; }
                    u32x4 w; w.x = cvt_pk_bf16(v0[0], v0[1]); w.y = cvt_pk_bf16(v0[2], v0[3]); w.z = cvt_pk_bf16(v1[0], v1[1]); w.w = cvt_pk_bf16(v1[2], v1[3]);
                    *(u32x4*)(rowp + bj * 32) = w; } }
        if (isk) { asm volatile("s_waitcnt lgkmcnt(0)" ::: "memory"); __builtin_amdgcn_s_barrier(); asm volatile("" ::: "memory"); }
    }
};

__device__ __forceinline__ float gelu_tanh_f(float x) { const float u = 0.7978845608028654f * (x + 0.044715f * x * x * x); const float t = 1.0f - 2.0f / (1.0f + __expf(2.0f * u)); return 0.5f * x * (1.0f + t); }
struct EpiFfn {
    static constexpr int PERM = 1; static constexpr bool AFTER_DRAIN = false;
    bf16_t* H; const float* ssqp; const float* cw; const float* cb; int Mtot; float eps;
    __device__ __forceinline__ void preload(PG8_LAS unsigned char* lds, const Unit& u, int wr, int wc, int lane) const {
        const int rowb = (u.pm / 17) * 4096 + 254 * (u.pm % 17) - 2;
#pragma unroll
        for (int ai = 0; ai < 2; ++ai) { const int row = rowb + ai * HALF + wr * 64 + lane; const int rc = row < 0 ? 0 : (row >= Mtot ? Mtot - 1 : row);
            __builtin_amdgcn_global_load_lds((const unsigned*)(ssqp + (size_t)wc * Mtot + rc), (PG8_LAS unsigned*)(lds + SSQ_LDS + (((wr * 2 + ai) * 4 + wc) * 64) * 4), 4, 0, 0); }
    }
    __device__ __forceinline__ void preload_unit(PG8_LAS unsigned char* lds, const Unit& u, int wr, int wc, int lane) const {
        const float* src = (wc < 3 ? cw + (size_t)wc * 2816 : cb) + u.pn * 128 + 64 * wr + lane;
        __builtin_amdgcn_global_load_lds((const unsigned*)src, (PG8_LAS unsigned*)(lds + CW_LDS + (wc * 128 + 64 * wr) * 4), 4, 0, 0);
    }
    __device__ __forceinline__ void operator()(f32x4 (&acc)[2][2][4][2], const Unit& u, int wr, int wc, int fr, int fq, PG8_LAS unsigned char* lds) const {
        constexpr int DFF_ = 2816;
        const int b = u.pm / 17, t = u.pm % 17, pos0 = 254 * t - 2, rowb = b * 4096 + pos0;
        const int colh = u.pn * 128 + wc * 32 + 8 * fq, lane = fq * 16 + fr;
        PG8_LAS float* halo = (PG8_LAS float*)(lds + STAGE_BYTES);
        float irs[2][4];
#pragma unroll
        for (int ai = 0; ai < 2; ++ai)
#pragma unroll
            for (int m = 0; m < 4; ++m) { const int rl = ai * HALF + wr * 64 + m * 16 + fr; const PG8_LAS float* sp = (const PG8_LAS float*)(lds + SSQ_LDS) + ((wr * 2 + ai) * 4) * 64 + m * 16 + fr;
                const float sq = (sp[0] + sp[64]) + (sp[128] + sp[192]); const float xx = sq * (1.0f / 1024.0f) + eps; const float rs = __builtin_amdgcn_rsqf(xx); irs[ai][m] = xx * rs;
                const bool pad = (pos0 + rl) < 0; const float rsg = pad ? 0.f : rs;
#pragma unroll
                for (int n = 0; n < 2; ++n) {
#pragma unroll
                    for (int e = 0; e < 4; ++e) acc[ai][0][m][n][e] *= rsg; } }
#pragma unroll
        for (int ai = 0; ai < 2; ++ai) if (fr >= 14) { PG8_LAS float* hp = halo + ((((2 * ai + wr) * 4 + wc) * 4 + fq) * 2 + (fr - 14)) * 8;
            *(PG8_LAS f32x4*)hp = acc[ai][0][3][0]; *(PG8_LAS f32x4*)(hp + 4) = acc[ai][0][3][1]; }
        asm volatile("s_waitcnt lgkmcnt(0)" ::: "memory"); __builtin_amdgcn_s_barrier(); asm volatile("" ::: "memory");
        typedef unsigned u32x2e __attribute__((ext_vector_type(2)));
#define DPPF(x, ctrl) __builtin_bit_cast(float, __builtin_amdgcn_update_dpp(0, __builtin_bit_cast(int, (x)), (ctrl), 0xf, 0xf, true))
        u32x2e hold[2][4];
#pragma unroll
        for (int n = 0; n < 2; ++n) {
            const PG8_LAS float* cwl = (const PG8_LAS float*)(lds + CW_LDS) + wc * 32 + 8 * fq + 4 * n;
            const f32x4 w0 = *(const PG8_LAS f32x4*)cwl, w1 = *(const PG8_LAS f32x4*)(cwl + 128), w2 = *(const PG8_LAS f32x4*)(cwl + 256), bb = *(const PG8_LAS f32x4*)(cwl + 384);
#pragma unroll
            for (int ai = 0; ai < 2; ++ai) {
                const int blk = 2 * ai + wr; f32x4 hprev = (f32x4){0.f, 0.f, 0.f, 0.f};
                if (blk >= 1) { const PG8_LAS float* hp = halo + ((((blk - 1) * 4 + wc) * 4 + fq) * 2) * 8 + 4 * n; const f32x4 h62 = *(const PG8_LAS f32x4*)hp, h63 = *(const PG8_LAS f32x4*)(hp + 8);
                    hprev = fr == 15 ? h63 : h62; }
#pragma unroll
                for (int m = 0; m < 4; ++m) { const int rl = ai * HALF + wr * 64 + m * 16 + fr; const bool ok = (rl >= 2) && (pos0 + rl < 4096);
                    float hv[4];
#pragma unroll
                    for (int h = 0; h < 2; ++h) {
                        const f32x2 v2 = (f32x2){acc[ai][0][m][n][2 * h], acc[ai][0][m][n][2 * h + 1]};
                        const f32x2 vp2 = m > 0 ? (f32x2){acc[ai][0][m > 0 ? m - 1 : 0][n][2 * h], acc[ai][0][m > 0 ? m - 1 : 0][n][2 * h + 1]} : (f32x2){hprev[2 * h], hprev[2 * h + 1]};
                        const f32x2 p1 = (f32x2){DPPF(fr == 15 ? vp2[0] : v2[0], 0x121), DPPF(fr == 15 ? vp2[1] : v2[1], 0x121)}, p2 = (f32x2){DPPF(fr >= 14 ? vp2[0] : v2[0], 0x122), DPPF(fr >= 14 ? vp2[1] : v2[1], 0x122)};
                        const f32x2 w0h = (f32x2){w0[2 * h], w0[2 * h + 1]}, w1h = (f32x2){w1[2 * h], w1[2 * h + 1]}, w2h = (f32x2){w2[2 * h], w2[2 * h + 1]}, bbh = (f32x2){bb[2 * h], bb[2 * h + 1]};
                        const f32x2 y = w0h * p2 + (w1h * p1 + (w2h * v2 + bbh));
                        const f32x2 tq = y * (-2.302208198f + -0.10294324f * (y * y));
                        const f32x2 ex = (f32x2){__builtin_amdgcn_exp2f(tq[0]), __builtin_amdgcn_exp2f(tq[1])};
                        const f32x2 dn = ex * irs[ai][m] + irs[ai][m];
                        const f32x2 sg = (f32x2){__builtin_amdgcn_rcpf(dn[0]), __builtin_amdgcn_rcpf(dn[1])};
                        const f32x2 up2 = (f32x2){acc[ai][1][m][n][2 * h], acc[ai][1][m][n][2 * h + 1]};
                        const f32x2 hh = (y * up2) * sg; hv[2 * h] = hh[0]; hv[2 * h + 1] = hh[1]; }
                    u32x2e w; w.x = cvt_pk_bf16(hv[0], hv[1]); w.y = cvt_pk_bf16(hv[2], hv[3]);
                    if (n == 0) hold[ai][m] = w;
                    else if (ok) { u32x4 w4; w4.x = hold[ai][m].x; w4.y = hold[ai][m].y; w4.z = w.x; w4.w = w.y; *(u32x4*)(H + (size_t)u.pn * ((size_t)Mtot * 128) + (size_t)(rowb + rl) * 128 + (wc * 32 + 8 * fq)) = w4; } }
            }
        }
#undef DPPF
        asm volatile("s_waitcnt lgkmcnt(0)" ::: "memory"); __builtin_amdgcn_s_barrier(); asm volatile("" ::: "memory");
    }
};
struct EpiResid {
    static constexpr int PERM = 1; static constexpr bool AFTER_DRAIN = true;
    struct Pre { int unused; };
    const float* base; float* out; bf16_t* xb; float* ssqp; int ldc; int Mtot;
    __device__ __forceinline__ void init(f32x4 (&acc)[2][2][4][2], const Unit& u, int wr, int wc, int fr, int fq) const {
        const int col0 = u.pn * BM + wc * 32 + 8 * fq;
#pragma unroll
        for (int ai = 0; ai < 2; ++ai)
#pragma unroll
            for (int m = 0; m < 4; ++m) { const size_t off = (size_t)(u.pm * BM + ai * HALF + wr * 64 + m * 16 + fr) * ldc + col0;
#pragma unroll
                for (int bj = 0; bj < 2; ++bj) {
                    if (base) { acc[ai][bj][m][0] = __builtin_nontemporal_load((const f32x4*)(base + off + bj * HALF)); acc[ai][bj][m][1] = __builtin_nontemporal_load((const f32x4*)(base + off + bj * HALF + 4)); }
                    else { const u32x4 w = __builtin_nontemporal_load((const u32x4*)(xb + off + bj * HALF));
                        acc[ai][bj][m][0] = (f32x4){__uint_as_float(w.x << 16), __uint_as_float(w.x & 0xffff0000u), __uint_as_float(w.y << 16), __uint_as_float(w.y & 0xffff0000u)};
                        acc[ai][bj][m][1] = (f32x4){__uint_as_float(w.z << 16), __uint_as_float(w.z & 0xffff0000u), __uint_as_float(w.w << 16), __uint_as_float(w.w & 0xffff0000u)}; } } }
    }
    __device__ __forceinline__ void fused(f32x4 (&acc)[2][2][4][2], const Unit& u, int wr, int wc, int fr, int fq, PG8_LAS unsigned char* lds, int wid, int lane) const {
        PG8_LAS float* P = (PG8_LAS float*)lds;
        const int col0 = u.pn * BM + wc * 32 + 8 * fq;
        if (out) {
#pragma unroll
            for (int ai = 0; ai < 2; ++ai)
#pragma unroll
                for (int m = 0; m < 4; ++m) { const size_t off = (size_t)(u.pm * BM + ai * HALF + wr * 64 + m * 16 + fr) * ldc + col0;
#pragma unroll
                    for (int bj = 0; bj < 2; ++bj) { __builtin_nontemporal_store(acc[ai][bj][m][0], (f32x4*)(out + off + bj * HALF)); __builtin_nontemporal_store(acc[ai][bj][m][1], (f32x4*)(out + off + bj * HALF + 4)); } }
            return;
        }
#pragma unroll
        for (int ai = 0; ai < 2; ++ai)
#pragma unroll
            for (int m = 0; m < 4; ++m) { const int r = ai * HALF + wr * 64 + m * 16 + fr; const size_t off = (size_t)(u.pm * BM + r) * ldc + col0; float s = 0.f;
#pragma unroll
                for (int bj = 0; bj < 2; ++bj) { const f32x4 o0 = acc[ai][bj][m][0], o1 = acc[ai][bj][m][1];
                    u32x4 w; w.x = cvt_pk_bf16(o0[0], o0[1]); w.y = cvt_pk_bf16(o0[2], o0[3]); w.z = cvt_pk_bf16(o1[0], o1[1]); w.w = cvt_pk_bf16(o1[2], o1[3]); *(u32x4*)(xb + off + bj * HALF) = w;
                    s += ((o0[0] * o0[0] + o0[1] * o0[1]) + (o0[2] * o0[2] + o0[3] * o0[3])) + ((o1[0] * o1[0] + o1[1] * o1[1]) + (o1[2] * o1[2] + o1[3] * o1[3])); }
                s += __shfl_xor(s, 16); s += __shfl_xor(s, 32);
                if (fq == 0) P[r * 4 + wc] = s;
                if (m & 1) asm volatile("" ::: "memory"); }
        asm volatile("s_waitcnt lgkmcnt(0)" ::: "memory"); __builtin_amdgcn_s_barrier(); asm volatile("" ::: "memory");
        if (lane < 32) { const int row = wid * 32 + lane; ssqp[(size_t)u.pn * Mtot + u.pm * BM + row] = (P[row * 4 + 0] + P[row * 4 + 1]) + (P[row * 4 + 2] + P[row * 4 + 3]); }
        asm volatile("s_waitcnt lgkmcnt(0)" ::: "memory"); __builtin_amdgcn_s_barrier(); asm volatile("" ::: "memory");
    }
};

template <class Epi, class Sched, bool ALIGN_EPI = false, bool SP2 = false>
__device__ __forceinline__ void gemm_phase(PG8_LAS unsigned char* lds, const Gemm g, const Sched& S, const Epi& E, int tid_in) {
    int tid_l = tid_in; asm volatile("" : "+v"(tid_l));
    const int tid = tid_l, wid = __builtin_amdgcn_readfirstlane(tid >> 6), lane = tid & 63, wr = wid >> 2, wc = wid & 3, fr = lane & 15, fq = lane >> 4;
    const int K = g.K, nt = K / BK;
    unsigned voffA[2], voffB[2];
#pragma unroll
    for (int i = 0; i < 2; ++i) { int R, C; stage_rc(tid * 16 + i * 8192, R, C); const int Rb = (int)Epi::PERM == 3 ? (64 * (R >> 5) + perm32(R & 31)) : ((int)Epi::PERM == 1 ? ((R & ~31) + perm32(R & 31)) : R);
        voffA[i] = (unsigned)(R * g.lda + C) * 2u; voffB[i] = (unsigned)(Rb * K + C) * 2u; }
    const size_t kstep = (size_t)(BK * 2);
    const size_t hstepA = (size_t)HALF * g.lda * 2, hstepB = (size_t)((int)Epi::PERM == 3 ? 32 : HALF) * K * 2;
    const size_t tstepB = (size_t)BM * K * 2;
    const unsigned ldsw = (unsigned)wid * 1024u;
    const int aoff = lds_byte(wr * 64 + fr, fq * 8), boff = lds_byte(wc * 32 + fr, fq * 8);
#define PG8_SA(b, h) (((b) * 2 + (h)) * HTB)
#define PG8_SB(b, h) ((4 + (b) * 2 + (h)) * HTB)
#define PG8_STAGE(bufoff, gbase, voff) do { _Pragma("unroll") for (int _i = 0; _i < 2; ++_i) \
        __builtin_amdgcn_global_load_lds((const unsigned*)((const char*)(gbase) + (voff)[_i]), (PG8_LAS unsigned*)(lds + (bufoff) + ldsw + _i * 8192), 16, 0, 0); } while (0)
#define PG8_LDA(dst, b, h) do { _Pragma("unroll") for (int m = 0; m < 4; ++m) _Pragma("unroll") for (int k = 0; k < 2; ++k) dst[m][k] = *(const PG8_LAS bf16x8*)(lds + PG8_SA(b, h) + aoff + m * 2048 + k * 1024); } while (0)
#define PG8_LDB(dst, b, h) do { _Pragma("unroll") for (int n = 0; n < 2; ++n) _Pragma("unroll") for (int k = 0; k < 2; ++k) dst[n][k] = *(const PG8_LAS bf16x8*)(lds + PG8_SB(b, h) + boff + n * 2048 + k * 1024); } while (0)
#define PG8_MMA(ai, bj, At, Bt) do { __builtin_amdgcn_s_setprio(1); _Pragma("unroll") for (int m = 0; m < 4; ++m) _Pragma("unroll") for (int n = 0; n < 2; ++n) _Pragma("unroll") for (int k = 0; k < 2; ++k) \
        acc[ai][bj][m][n] = __builtin_amdgcn_mfma_f32_16x16x32_bf16(Bt[n][k], At[m][k], acc[ai][bj][m][n], 0, 0, 0); __builtin_amdgcn_s_setprio(0); } while (0)
#define PG8_WAIT_V(n) asm volatile("s_waitcnt vmcnt(" #n ")" ::: "memory")
#define PG8_WAIT_L(n) asm volatile("s_waitcnt lgkmcnt(" #n ")" ::: "memory")
#define PG8_BAR __builtin_amdgcn_s_barrier()
#define PG8_SCHED __builtin_amdgcn_sched_barrier(0)
    Unit cur, nxt; int ui = 0;
    if (!S.next(0, cur)) return;
    f32x4 acc[2][2][4][2];
#pragma unroll
    for (int a = 0; a < 2; ++a)
#pragma unroll
        for (int b = 0; b < 2; ++b)
#pragma unroll
            for (int m = 0; m < 4; ++m)
#pragma unroll
                for (int n = 0; n < 2; ++n) acc[a][b][m][n] = (f32x4){0.f, 0.f, 0.f, 0.f};
    if constexpr (Epi::AFTER_DRAIN) E.init(acc, cur, wr, wc, fr, fq);
    bf16x8 At[4][2], B0[2][2], B1[2][2];
    const char* cA = (const char*)g.A + (ptrdiff_t)S.arow(cur) * (ptrdiff_t)(g.lda * 2); const char* cB = (const char*)g.Bt + (size_t)cur.pn * tstepB;
    S.a_ready(cur);
    if constexpr (!Epi::AFTER_DRAIN) E.preload_unit(lds, cur, wr, wc, lane);
    if constexpr (SP2) {
        PG8_STAGE(PG8_SB(0, 0), cB, voffB); PG8_STAGE(PG8_SB(0, 1), cB + hstepB, voffB); PG8_STAGE(PG8_SA(0, 0), cA, voffA); PG8_STAGE(PG8_SA(0, 1), cA + hstepA, voffA);
        if (wr == 1) PG8_BAR;
        PG8_WAIT_V(2); PG8_BAR;
        PG8_STAGE(PG8_SB(1, 0), cB + kstep, voffB); PG8_STAGE(PG8_SA(1, 0), cA + kstep, voffA); PG8_STAGE(PG8_SB(1, 1), cB + hstepB + kstep, voffB);
        PG8_WAIT_V(6); PG8_BAR;
        if constexpr (Epi::AFTER_DRAIN) {
#pragma unroll
            for (int a_ = 0; a_ < 2; ++a_)
#pragma unroll
                for (int b_ = 0; b_ < 2; ++b_) asm volatile("" : "+v"(acc[a_][b_][0][0]), "+v"(acc[a_][b_][0][1]), "+v"(acc[a_][b_][1][0]), "+v"(acc[a_][b_][1][1]), "+v"(acc[a_][b_][2][0]), "+v"(acc[a_][b_][2][1]), "+v"(acc[a_][b_][3][0]), "+v"(acc[a_][b_][3][1]));
        }
    } else {
        PG8_STAGE(PG8_SB(0, 0), cB, voffB); PG8_STAGE(PG8_SA(0, 0), cA, voffA); PG8_STAGE(PG8_SB(0, 1), cB + hstepB, voffB); PG8_STAGE(PG8_SA(0, 1), cA + hstepA, voffA);
        if (wr == 1) PG8_BAR;
        PG8_WAIT_V(4); PG8_BAR;
        PG8_STAGE(PG8_SB(1, 0), cB + kstep, voffB); PG8_STAGE(PG8_SA(1, 0), cA + kstep, voffA); PG8_STAGE(PG8_SB(1, 1), cB + hstepB + kstep, voffB);
        PG8_WAIT_V(6); PG8_BAR;
    }
    for (;;) {
        const bool has_next = S.next(ui + 1, nxt);
        const char* nA = has_next ? (const char*)g.A + (ptrdiff_t)S.arow(nxt) * (ptrdiff_t)(g.lda * 2) : cA; const char* nB = has_next ? (const char*)g.Bt + (size_t)nxt.pn * tstepB : cB;
        for (int t = 0; t < nt; t += 2) {
            const bool last = (t == nt - 2);
            const char* a1 = cA + (size_t)(t >> 1) * g.kblk + kstep;
            const char* a2 = last ? nA : cA + (size_t)((t >> 1) + 1) * g.kblk; const char* b2 = last ? nB : cB + (size_t)(t + 2) * kstep;
            const char* a3 = a2 + kstep; const char* b3 = b2 + kstep;
            if (last && has_next) S.a_ready(nxt);
            if constexpr (!Epi::AFTER_DRAIN) { if (last) E.preload(lds, cur, wr, wc, lane); }
            if constexpr (SP2) {
            PG8_LDB(B0, 0, 0); PG8_LDB(B1, 0, 1); PG8_SCHED; PG8_LDA(At, 0, 0); PG8_STAGE(PG8_SA(1, 1), a1 + hstepA, voffA);
            PG8_WAIT_V(8); PG8_WAIT_L(0); PG8_BAR; PG8_MMA(0, 0, At, B0); PG8_MMA(0, 1, At, B1); PG8_BAR; PG8_SCHED;
            PG8_LDA(At, 0, 1); PG8_STAGE(PG8_SB(0, 0), b2, voffB); PG8_STAGE(PG8_SB(0, 1), b2 + hstepB, voffB); PG8_STAGE(PG8_SA(0, 0), a2, voffA);
            PG8_WAIT_V(8); PG8_WAIT_L(0); PG8_BAR; PG8_MMA(1, 0, At, B0); PG8_MMA(1, 1, At, B1); PG8_BAR; PG8_SCHED;
            PG8_LDB(B0, 1, 0); PG8_LDB(B1, 1, 1); PG8_SCHED; PG8_LDA(At, 1, 0); PG8_STAGE(PG8_SA(0, 1), a2 + hstepA, voffA);
            PG8_WAIT_V(8); PG8_WAIT_L(0); PG8_BAR; PG8_MMA(0, 0, At, B0); PG8_MMA(0, 1, At, B1); PG8_BAR; PG8_SCHED;
            PG8_LDA(At, 1, 1);
            if (!(last && !has_next)) { PG8_STAGE(PG8_SB(1, 0), b3, voffB); PG8_STAGE(PG8_SB(1, 1), b3 + hstepB, voffB); PG8_STAGE(PG8_SA(1, 0), a3, voffA); PG8_WAIT_V(8); }
            PG8_WAIT_L(0); PG8_BAR; PG8_MMA(1, 0, At, B0); PG8_MMA(1, 1, At, B1); PG8_BAR; PG8_SCHED;
            } else {
            PG8_LDB(B0, 0, 0); PG8_SCHED; PG8_LDA(At, 0, 0); PG8_STAGE(PG8_SA(1, 1), a1 + hstepA, voffA);
            PG8_WAIT_L(8); PG8_BAR; PG8_WAIT_L(0); PG8_MMA(0, 0, At, B0); PG8_BAR; PG8_SCHED;
            PG8_LDB(B1, 0, 1); PG8_STAGE(PG8_SB(0, 0), b2, voffB);
            PG8_BAR; PG8_WAIT_L(0); PG8_MMA(0, 1, At, B1); PG8_BAR;
            PG8_LDA(At, 0, 1); PG8_STAGE(PG8_SA(0, 0), a2, voffA);
            PG8_BAR; PG8_WAIT_L(0); PG8_MMA(1, 0, At, B0); PG8_BAR; PG8_SCHED;
            PG8_STAGE(PG8_SB(0, 1), b2 + hstepB, voffB);
            PG8_WAIT_V(6); PG8_BAR; PG8_MMA(1, 1, At, B1); PG8_BAR;
            PG8_LDB(B0, 1, 0); PG8_SCHED; PG8_LDA(At, 1, 0); PG8_STAGE(PG8_SA(0, 1), a2 + hstepA, voffA);
            PG8_WAIT_L(8); PG8_BAR; PG8_WAIT_L(0); PG8_MMA(0, 0, At, B0); PG8_BAR; PG8_SCHED;
            PG8_LDB(B1, 1, 1); PG8_STAGE(PG8_SB(1, 0), b3, voffB);
            PG8_BAR; PG8_WAIT_L(0); PG8_MMA(0, 1, At, B1); PG8_BAR;
            PG8_LDA(At, 1, 1); PG8_STAGE(PG8_SA(1, 0), a3, voffA);
            PG8_BAR; PG8_WAIT_L(0); PG8_MMA(1, 0, At, B0); PG8_BAR; PG8_SCHED;
            PG8_STAGE(PG8_SB(1, 1), b3 + hstepB, voffB);
            PG8_WAIT_V(6); PG8_BAR; PG8_MMA(1, 1, At, B1); PG8_BAR;
            }
        }
        if constexpr (ALIGN_EPI) { if (wr == 0) PG8_BAR; }
        if constexpr (!Epi::AFTER_DRAIN) { E(acc, cur, wr, wc, fr, fq, lds); S.done(cur); if (has_next) E.preload_unit(lds, nxt, wr, wc, lane); }
        if (!has_next) break;
#pragma unroll
        for (int a = 0; a < 2; ++a)
#pragma unroll
            for (int b = 0; b < 2; ++b)
#pragma unroll
                for (int m = 0; m < 4; ++m)
#pragma unroll
                    for (int n = 0; n < 2; ++n) acc[a][b][m][n] = (f32x4){0.f, 0.f, 0.f, 0.f};
        cur = nxt; cA = nA; cB = nB; ++ui;
        if constexpr (ALIGN_EPI) { if (wr == 1) PG8_BAR; }
    }
    PG8_WAIT_V(0);
    if constexpr (!ALIGN_EPI) { if (wr == 0) PG8_BAR; }
    PG8_BAR;
    if constexpr (Epi::AFTER_DRAIN) { E.fused(acc, cur, wr, wc, fr, fq, lds, wid, lane); S.done(cur); }
#undef PG8_SA
#undef PG8_SB
#undef PG8_STAGE
#undef PG8_LDA
#undef PG8_LDB
#undef PG8_MMA
#undef PG8_WAIT_V
#undef PG8_WAIT_L
#undef PG8_BAR
#undef PG8_SCHED
}
}


#define GAS __attribute__((address_space(1)))
#define LAS __attribute__((address_space(3)))
typedef unsigned short bf16;
typedef unsigned v4u __attribute__((ext_vector_type(4)));
typedef unsigned v2u __attribute__((ext_vector_type(2)));
typedef float f32x4 __attribute__((ext_vector_type(4)));
constexpr int BATCH = 4, SEQ = 4096, D = 1024, M = BATCH * SEQ, NMEM = 256, MM = BATCH * NMEM, DFF = 2816;
constexpr int EV_IN = 4096, OD_IN = 3072;
constexpr int PRO_EARLY_ITEMS = (1024 / 64) * (EV_IN / 64) + 2 * (1024 / 64) * (2048 / 64);
constexpr int PRO_MID_ITEMS = PRO_EARLY_ITEMS + (1024 / 64) * (OD_IN / 64) + 3 * (1024 / 64) * (1024 / 64);
constexpr int PRO_ALL_ITEMS = 2 * ((1024 / 64) * (1024 / 64) * 3 + (1024 / 64) * (2048 / 64) + (1024 / 64) * (2 * 2816 / 64) + (2816 / 64) * (1024 / 64)) + (1024 / 64) * (EV_IN / 64) + (1024 / 64) * (OD_IN / 64);
constexpr float EPS = 1e-6f;
constexpr int Z_RQ = 0, Z_GQ = 512, Z_RK = 1024, Z_RV = 1536, Z_RG = 2048, Z_GF = 2560, Z_GI = 3072, Z_GG = 3584;
constexpr int ZP = 128;
#define ZB(col) ((size_t)((col) >> 7) * ((size_t)M * 128))

constexpr size_t MiB = 1u << 20;
constexpr size_t WS_CTL = 0;
constexpr size_t WS_EVIN = 1 * MiB, WS_EVOUT = 9 * MiB, WS_XQ0 = 11 * MiB, WS_XKV0 = 13 * MiB, WS_XO0 = 17 * MiB, WS_FIN0 = 19 * MiB, WS_FOUT0 = 30 * MiB;
constexpr size_t WS_ODIN = 36 * MiB, WS_ODOUT = 42 * MiB, WS_XQ1 = 44 * MiB, WS_XKV1 = 46 * MiB, WS_XO1 = 50 * MiB, WS_FIN1 = 52 * MiB, WS_FOUT1 = 63 * MiB;
constexpr size_t WS_XB = 69 * MiB;
constexpr size_t WS_MKV0 = 101 * MiB, WS_MKV1 = 105 * MiB;
constexpr size_t WS_MEMH0 = 109 * MiB, WS_MEMH1 = 111 * MiB;
constexpr size_t WS_SSQP = 113 * MiB;
constexpr size_t WS_LB = 113 * MiB + 512 * 1024;
constexpr size_t WS_BIAST = 113 * MiB + 516 * 1024;
constexpr size_t WS_GXA = 113 * MiB + 600 * 1024, WS_GOD = 113 * MiB + 604 * 1024;
constexpr size_t WS_DEN23 = 114 * MiB;
constexpr size_t WS_N2 = 1 * MiB;
constexpr size_t WS_ACT = 115 * MiB;
constexpr size_t WS_DECA = 243 * MiB, WS_DECB = 243 * MiB + 512 * 1024;
constexpr size_t WS_END = 256 * MiB;

__device__ __forceinline__ float bf2f(bf16 u) { return __uint_as_float((unsigned)u << 16); }
__device__ __forceinline__ unsigned f2bf(float f) { unsigned u = __builtin_bit_cast(unsigned, f); return (u + 0x7fffu + ((u >> 16) & 1u)) >> 16; }
typedef float f32x2_pk __attribute__((ext_vector_type(2))); typedef __bf16 bf16x2_pk __attribute__((ext_vector_type(2)));
__device__ __forceinline__ unsigned pk2(float lo, float hi) { f32x2_pk v = {lo, hi}; bf16x2_pk b = __builtin_convertvector(v, bf16x2_pk); return __builtin_bit_cast(unsigned, b); }
__device__ __forceinline__ float wave_sum(float v) {
#pragma unroll
    for (int o = 1; o < 64; o <<= 1) v += __shfl_xor(v, o);
    return v;
}
__device__ __forceinline__ float wave_max(float v) {
#pragma unroll
    for (int o = 1; o < 64; o <<= 1) v = fmaxf(v, __shfl_xor(v, o));
    return v;
}
__device__ __forceinline__ void unpack8(const v4u w, float (&f)[8]) {
    f[0] = __uint_as_float(w.x << 16); f[1] = __uint_as_float(w.x & 0xffff0000u); f[2] = __uint_as_float(w.y << 16); f[3] = __uint_as_float(w.y & 0xffff0000u);
    f[4] = __uint_as_float(w.z << 16); f[5] = __uint_as_float(w.z & 0xffff0000u); f[6] = __uint_as_float(w.w << 16); f[7] = __uint_as_float(w.w & 0xffff0000u);
}
__device__ __forceinline__ void rope_sincos(float a, float& s, float& c) {
    const float n = rintf(a * 0.15915494309189535f);
    float r = fmaf(-n, 6.2831854820251465f, a); r = fmaf(-n, -1.7484555e-7f, r);
    const float rev = r * 0.15915494309189535f;
    s = __builtin_amdgcn_sinf(rev); c = __builtin_amdgcn_cosf(rev);
}

__device__ __forceinline__ int dst_row_map(int mode, int n0) {
    if (mode == 1) { const int seg = n0 >> 9, within = n0 & 511; const int dseg = (seg == 0) ? 0 : (seg == 4 ? 1 : (seg < 4 ? seg + 1 : seg)); return dseg * 512 + within; }
    if (mode == 2) { return n0 < DFF ? (n0 >> 7) * 256 + (n0 & 127) : ((n0 - DFF) >> 7) * 256 + 128 + ((n0 - DFF) & 127); }
    return n0;
}
__device__ __forceinline__ void transpose_item(const float* W, int K, int N, const float* g, bf16* WT, int mode, LAS float* scr, int item, int lane) {
    const int nblk = N / 64, kb = item / nblk, nb = item % nblk, k0 = 64 * kb, n0 = 64 * nb, lr = lane >> 4, lc = lane & 15;
    f32x4 v[16];
#pragma unroll
    for (int i = 0; i < 16; ++i) v[i] = __builtin_nontemporal_load((const f32x4*)(W + (size_t)(k0 + 4 * i + lr) * N + n0 + 4 * lc));
#pragma unroll
    for (int i = 0; i < 16; ++i) { const int kk = 4 * i + lr; const float gg = g ? g[k0 + kk] : 1.0f; LAS float* p = scr + kk * 65 + 4 * lc; p[0] = v[i][0] * gg; p[1] = v[i][1] * gg; p[2] = v[i][2] * gg; p[3] = v[i][3] * gg; }
    asm volatile("s_waitcnt lgkmcnt(0)" ::: "memory");
    const int c = lane & 7; const int d0 = dst_row_map(mode, n0);
#pragma unroll
    for (int j = 0; j < 8; ++j) { const int n = (lane >> 3) + 8 * j; const LAS float* sp = scr + (8 * c) * 65 + n;
        v4u o; o.x = pk2(sp[0 * 65], sp[1 * 65]); o.y = pk2(sp[2 * 65], sp[3 * 65]); o.z = pk2(sp[4 * 65], sp[5 * 65]); o.w = pk2(sp[6 * 65], sp[7 * 65]);
        *(v4u*)(WT + (size_t)(d0 + n) * K + k0 + 8 * c) = o; }
    asm volatile("s_waitcnt lgkmcnt(0)" ::: "memory");
}
struct ProArgs { const float* in[25]; unsigned char* ws; int layer_mask; int ffn_mode; int it_lo, it_hi; };
#define PICK_JOB(Wp_, K__, N__, gp_, dst_, mode_) if (!found) { const int ni_ = ((K__) / 64) * ((N__) / 64); if (r < ni_) { W_ = (Wp_); K_ = (K__); N_ = (N__); g_ = (gp_); d_ = (dst_); m_ = (mode_); found = true; } else r -= ni_; }
struct TJob { const float* W; const float* g; bf16* WT; int K, N, mode, item; };
__device__ __forceinline__ void ti_load(const TJob& J, int lane, f32x4 (&v)[16], f32x4 (&g8)[2]) {
    const int nblk = J.N / 64, kb = J.item / nblk, nb = J.item % nblk, k0 = 64 * kb, n0 = 64 * nb, lr = lane >> 4, lc = lane & 15;
#pragma unroll
    for (int i = 0; i < 16; ++i) v[i] = __builtin_nontemporal_load((const f32x4*)(J.W + (size_t)(k0 + 4 * i + lr) * J.N + n0 + 4 * lc));
    if (J.g) { g8[0] = *(const f32x4*)(J.g + k0 + 8 * (lane & 7)); g8[1] = *(const f32x4*)(J.g + k0 + 8 * (lane & 7) + 4); } else { g8[0] = (f32x4){1.f, 1.f, 1.f, 1.f}; g8[1] = g8[0]; }
}
__device__ __forceinline__ void ti_finish(const TJob& J, int lane, const f32x4 (&v)[16], const f32x4 (&g8)[2], LAS float* scr) {
    const int nblk = J.N / 64, kb = J.item / nblk, nb = J.item % nblk, k0 = 64 * kb, n0 = 64 * nb, lr = lane >> 4, lc = lane & 15;
#pragma unroll
    for (int i = 0; i < 16; ++i) { const int kk = 4 * i + lr; LAS float* p = scr + kk * 65 + 4 * lc; p[0] = v[i][0]; p[1] = v[i][1]; p[2] = v[i][2]; p[3] = v[i][3]; }
    asm volatile("s_waitcnt lgkmcnt(0)" ::: "memory");
    const int c = lane & 7; const int d0 = dst_row_map(J.mode, n0);
#pragma unroll
    for (int j = 0; j < 8; ++j) { const int n = (lane >> 3) + 8 * j; const LAS float* sp = scr + (8 * c) * 65 + n;
        v4u o; o.x = pk2(sp[0 * 65] * g8[0][0], sp[1 * 65] * g8[0][1]); o.y = pk2(sp[2 * 65] * g8[0][2], sp[3 * 65] * g8[0][3]); o.z = pk2(sp[4 * 65] * g8[1][0], sp[5 * 65] * g8[1][1]); o.w = pk2(sp[6 * 65] * g8[1][2], sp[7 * 65] * g8[1][3]);
        *(v4u*)(J.WT + (size_t)(d0 + n) * J.K + k0 + 8 * c) = o; }
    asm volatile("s_waitcnt lgkmcnt(0)" ::: "memory");
}
__device__ __forceinline__ bool pro_pick(const ProArgs& a, int it, TJob& J) {
    int r = it; bool found = false; const float* W_ = nullptr; const float* g_ = nullptr; int K_ = 0, N_ = 0, m_ = 0; size_t d_ = 0;
    PICK_JOB(a.in[3], D, EV_IN, a.in[2], WS_EVIN, 1)
    PICK_JOB(a.in[16], D, 2 * D, (const float*)nullptr, WS_XKV0, 0)
    PICK_JOB(a.in[16] + (size_t)D * 2 * D, D, 2 * D, (const float*)nullptr, WS_XKV1, 0)
    PICK_JOB(a.in[8], D, OD_IN, a.in[2] + D, WS_ODIN, 0)
    PICK_JOB(a.in[12], D, D, (const float*)nullptr, WS_ODOUT, 0)
    PICK_JOB(a.in[15] + (size_t)D * D, D, D, a.in[13] + D, WS_XQ1, 0)
    PICK_JOB(a.in[19] + (size_t)D * D, D, D, (const float*)nullptr, WS_XO1, 0)
    PICK_JOB(a.in[24], DFF, D, (const float*)nullptr, WS_FOUT0, 0)
    PICK_JOB(a.in[21], D, 2 * DFF, a.in[20], WS_FIN0, a.ffn_mode)
    PICK_JOB(a.in[21] + (size_t)D * 2 * DFF, D, 2 * DFF, a.in[20] + D, WS_FIN1, a.ffn_mode)
    PICK_JOB(a.in[24] + (size_t)DFF * D, DFF, D, (const float*)nullptr, WS_FOUT1, 0)
    PICK_JOB(a.in[7], D, D, (const float*)nullptr, WS_EVOUT, 0)
    PICK_JOB(a.in[15], D, D, a.in[13], WS_XQ0, 0)
    PICK_JOB(a.in[19], D, D, (const float*)nullptr, WS_XO0, 0)
    J.W = W_; J.g = g_; J.WT = (bf16*)(a.ws + d_); J.K = K_; J.N = N_; J.mode = m_; J.item = r; return found;
}
__device__ __forceinline__ void prologue_body(const ProArgs& a, int gw_in, int NGW, int lane, LAS float* scr) {
    const int gw = __builtin_amdgcn_readfirstlane(gw_in);
    unsigned char* ws = a.ws;
    const float* x = a.in[0]; const float* mem = a.in[1];
    {
        int it = a.it_lo + gw;
        if (it < a.it_hi) {
            TJob J0, J1; f32x4 v0[16], v1[16], ga[2], gb[2];
            pro_pick(a, it, J0); ti_load(J0, lane, v0, ga);
            for (;;) {
                const int itn = it + NGW; bool has = itn < a.it_hi;
                if (has) { pro_pick(a, itn, J1); ti_load(J1, lane, v1, gb); }
                ti_finish(J0, lane, v0, ga, scr);
                if (!has) break;
                it = itn + NGW; has = it < a.it_hi;
                if (has) { pro_pick(a, it, J0); ti_load(J0, lane, v0, ga); }
                ti_finish(J1, lane, v1, gb, scr);
                if (!has) break;
            }
        }
    }
    if (a.layer_mask & 1) {
        for (int m = 2 * gw; m < M; m += 2 * NGW) {
            const f32x4* xr = (const f32x4*)(x + (size_t)m * D) + lane; v2u* o8 = (v2u*)((bf16*)(ws + WS_XB) + (size_t)m * D) + lane; float* sp = (float*)(ws + WS_SSQP);
            f32x4 v[8];
#pragma unroll
            for (int j = 0; j < 8; ++j) v[j] = __builtin_nontemporal_load(xr + 64 * j);
#pragma unroll
            for (int j = 0; j < 8; ++j) { v2u w; w.x = pk2(v[j][0], v[j][1]); w.y = pk2(v[j][2], v[j][3]); o8[64 * j] = w;
                const float s2 = wave_sum((v[j][0] * v[j][0] + v[j][1] * v[j][1]) + (v[j][2] * v[j][2] + v[j][3] * v[j][3])); if (lane == 0) sp[(size_t)(j & 3) * M + m + (j >> 2)] = s2; }
        }
        for (int r = gw; r < 2 * MM; r += NGW) { const int l = r / MM, m = r % MM;
            const f32x4* xr = (const f32x4*)(mem + (size_t)m * D) + lane; const f32x4* gr = (const f32x4*)(a.in[14] + (size_t)l * D) + lane;
            f32x4 v[4]; float s = 0.f;
#pragma unroll
            for (int j = 0; j < 4; ++j) { v[j] = xr[64 * j]; s += (v[j][0] * v[j][0] + v[j][1] * v[j][1]) + (v[j][2] * v[j][2] + v[j][3] * v[j][3]); }
            const float rs = 1.0f / sqrtf(wave_sum(s) * (1.0f / D) + EPS);
            v2u* o8 = (v2u*)((bf16*)(ws + (l ? WS_MEMH1 : WS_MEMH0)) + (size_t)m * D) + lane;
#pragma unroll
            for (int j = 0; j < 4; ++j) { const f32x4 g = gr[64 * j]; v2u w; w.x = pk2(v[j][0] * rs * g[0], v[j][1] * rs * g[1]); w.y = pk2(v[j][2] * rs * g[2], v[j][3] * rs * g[3]); o8[64 * j] = w; }
        }
        if (gw == 0) {
            const float* lg = a.in[6]; float* lb = (float*)(ws + WS_LB);
            for (int c = lane; c < 512; c += 64) { const float a0 = lg[c], a1 = lg[512 + c], a2 = lg[1024 + c]; const float mx = fmaxf(a0, fmaxf(a1, a2));
                const float e0 = expf(a0 - mx), e1 = expf(a1 - mx), e2 = expf(a2 - mx); lb[c] = e0 / (e0 + e1 + e2); }
        }
        if (gw == 2) {
            float* gx = (float*)(ws + WS_GXA); float* go = (float*)(ws + WS_GOD);
            for (int i = lane; i < 512; i += 64) gx[i] = a.in[18][i] * a.in[17][i];
            for (int i = lane; i < 128; i += 64) go[i] = a.in[10][i] * a.in[9][i] * (0.08838834764831845f * 1.4426950408889634f);
        }
        if (gw == 1) {
            const float* rb = a.in[11]; float* bt = (float*)(ws + WS_BIAST);
            for (int i = lane; i < 3 * 8 * 132; i += 64) { const int br = i / (8 * 132), h = (i / 132) % 8, dl = i % 132; const int d = dl * (1 << (2 * br));
                int bucket; if (d < 16) bucket = d; else { const float lr = logf((float)d / 16.0f) / 4.852030263919617f; int lg2 = 16 + (int)(lr * 16.0f); bucket = lg2 < 31 ? lg2 : 31; }
                bt[i] = (dl <= 128) ? rb[bucket * 8 + h] : 0.f; }
        }
    }
}


typedef short bf16x8 __attribute__((ext_vector_type(8)));
typedef short s16x4 __attribute__((ext_vector_type(4)));
typedef float f32x16 __attribute__((ext_vector_type(16)));
typedef float f32x2_t __attribute__((ext_vector_type(2))); typedef __bf16 bf16x2_t __attribute__((ext_vector_type(2)));
typedef short v4i16_t __attribute__((ext_vector_type(4)));
typedef float v2f __attribute__((ext_vector_type(2)));
#define MFMA32(a, b, c) __builtin_amdgcn_mfma_f32_32x32x16_bf16((a), (b), (c), 0, 0, 0)
__device__ __forceinline__ unsigned cvtpk(float lo, float hi) { f32x2_t v = {lo, hi}; bf16x2_t b = __builtin_convertvector(v, bf16x2_t); return __builtin_bit_cast(unsigned, b); }
__device__ __forceinline__ bf16x8 pack8(float a0, float a1, float a2, float a3, float a4, float a5, float a6, float a7) {
    v4u p; p.x = cvtpk(a0, a1); p.y = cvtpk(a2, a3); p.z = cvtpk(a4, a5); p.w = cvtpk(a6, a7); return __builtin_bit_cast(bf16x8, p); }
__device__ __forceinline__ s16x4 vtr(const LAS char* p) { return __builtin_bit_cast(s16x4, __builtin_amdgcn_ds_read_tr16_b64_v4i16((LAS v4i16_t*)p)); }
__device__ __forceinline__ int tr_lane_base(int lane, int stride) { const int g = lane >> 4, i = lane & 15, q = i >> 2, p = i & 3, h2 = g >> 1; return (4 * h2 + q) * stride + (16 * (g & 1) + 4 * p) * 2; }
__device__ __forceinline__ bf16x8 tr_frag_perm(const LAS char* img, int stride, int lbase, int k0, int n0) {
    const LAS char* p = img + lbase + k0 * stride + n0 * 2;
    const s16x4 lo = vtr(p), hi = vtr(p + 8 * stride);
    return (bf16x8){lo[0], lo[1], lo[2], lo[3], hi[0], hi[1], hi[2], hi[3]};
}
__device__ __forceinline__ int tr_lane_base_nat(int lane, int stride) { const int g = lane >> 4, i = lane & 15, q = i >> 2, p = i & 3, h2 = g >> 1; return (8 * h2 + q) * stride + (16 * (g & 1) + 4 * p) * 2; }
__device__ __forceinline__ bf16x8 tr_frag_nat(const LAS char* img, int stride, int lbase, int k0, int n0) {
    const LAS char* p = img + lbase + k0 * stride + n0 * 2;
    const s16x4 lo = vtr(p), hi = vtr(p + 4 * stride);
    return (bf16x8){lo[0], lo[1], lo[2], lo[3], hi[0], hi[1], hi[2], hi[3]};
}

#define LDS_BARRIER() do { asm volatile("s_waitcnt lgkmcnt(0)" ::: "memory"); __builtin_amdgcn_s_barrier(); asm volatile("" ::: "memory"); } while (0)
__device__ __forceinline__ float row16_allsum(float v) {
#define R16_DPP(x, ctrl) __builtin_bit_cast(float, __builtin_amdgcn_update_dpp(0, __builtin_bit_cast(int, (x)), (ctrl), 0xf, 0xf, false))
    v += R16_DPP(v, 0x128); v += R16_DPP(v, 0x124); v += R16_DPP(v, 0x122); v += R16_DPP(v, 0x121);
#undef R16_DPP
    return v;
}
constexpr int XA_STRIDE = 528, XA_VSTRIDE = 528;
constexpr int XA_LDS = 256 * XA_STRIDE;
template <bool Q_IN_LDS> __device__ __forceinline__ void xattn_unit(LAS char* lds, const bf16* __restrict__ Q, const bf16* __restrict__ MKV, const float* __restrict__ gkq, bf16* __restrict__ O, int unit, int tid) {
    const int lane = tid & 63, w = __builtin_amdgcn_readfirstlane(tid >> 6), r = lane & 31, h2 = lane >> 5;
    const int rb = unit >> 2, h = unit & 3, row0 = rb * 256, b = row0 / SEQ;
    const bf16* Kg = MKV + (size_t)(b * NMEM) * 2048 + h * 256; const bf16* Vg = Kg + 1024;
    v4u st[16];
#pragma unroll
    for (int i = 0; i < 16; ++i) st[i] = *(const v4u*)(Kg + i * 32768 + ((tid >> 5) * 2048 + (tid & 31) * 8));
    const size_t qoff = (size_t)(row0 + 32 * w + r) * D + h * 256;
    bf16x8 qf[16];
    if (Q_IN_LDS) {
#pragma unroll
        for (int s = 0; s < 16; ++s) qf[s] = *(const LAS bf16x8*)(lds + (32 * w + r) * XA_STRIDE + h2 * 16 + s * 32);
        asm volatile("s_waitcnt lgkmcnt(0)" ::: "memory"); __builtin_amdgcn_s_barrier(); asm volatile("" ::: "memory");
    } else {
#pragma unroll
        for (int s = 0; s < 16; ++s) qf[s] = *(const bf16x8*)(Q + qoff + 8 * h2 + 16 * s);
    }
#pragma unroll
    for (int i = 0; i < 16; ++i) { const int id = tid + 512 * i; *(LAS v4u*)(lds + (id >> 5) * XA_STRIDE + (id & 31) * 16) = st[i]; }
    float ss = 0.f;
#pragma unroll
    for (int s = 0; s < 16; ++s)
#pragma unroll
        for (int j = 0; j < 8; ++j) { const float x = __uint_as_float((unsigned)(unsigned short)qf[s][j] << 16); ss += x * x; }
    ss += __shfl_xor(ss, 32);
    const float rsl = __builtin_amdgcn_rsqf(ss * (1.0f / 256.0f) + EPS) * 1.4426950408889634f;
    asm volatile("" ::: "memory");
#pragma unroll
    for (int i = 0; i < 8; ++i) st[i] = *(const v4u*)(Vg + i * 32768 + ((tid >> 5) * 2048 + (tid & 31) * 8));
    LDS_BARRIER();
    bf16x8 pf[8][2]; float den = 0.f;
    { f32x16 accA, accB; bf16x8 fb[4];
      const LAS char* kp0 = lds + r * XA_STRIDE + h2 * 16;
#define XA_RD(q) do { const LAS char* ap_ = kp0 + ((q) >> 4) * (32 * XA_STRIDE); asm volatile("ds_read_b128 %0, %1 offset:%2" : "=v"(fb[(q) & 3]) : "v"(ap_), "n"(((q) & 15) * 32)); } while (0)
      XA_RD(0); XA_RD(1); XA_RD(2);
#pragma unroll
      for (int kb = 0; kb < 9; ++kb) {
          float p[16];
#pragma unroll
          for (int s = 0; s < 16; ++s) {
              const int q = kb * 16 + s;
              if (kb < 8) {
                  if (q + 3 < 128) XA_RD(q + 3);
                  if (q + 3 < 128) asm volatile("s_waitcnt lgkmcnt(3)" : "+v"(fb[q & 3])); else if (q + 2 < 128) asm volatile("s_waitcnt lgkmcnt(2)" : "+v"(fb[q & 3])); else if (q + 1 < 128) asm volatile("s_waitcnt lgkmcnt(1)" : "+v"(fb[q & 3])); else asm volatile("s_waitcnt lgkmcnt(0)" : "+v"(fb[q & 3]));
                  if (kb & 1) { if (s == 0) { for (int i = 0; i < 16; ++i) accB[i] = 0.f; } accB = MFMA32(fb[q & 3], qf[s], accB); }
                  else        { if (s == 0) { for (int i = 0; i < 16; ++i) accA[i] = 0.f; } accA = MFMA32(fb[q & 3], qf[s], accA); }
              }
              if (kb > 0) { const float av = (kb & 1) ? accA[s] : accB[s]; p[s] = __builtin_amdgcn_exp2f(av * rsl - 11.541560327111707f); den += p[s]; }
          }
          if (kb > 0) { pf[kb - 1][0] = pack8(p[0], p[1], p[2], p[3], p[4], p[5], p[6], p[7]); pf[kb - 1][1] = pack8(p[8], p[9], p[10], p[11], p[12], p[13], p[14], p[15]); }
      }
#undef XA_RD
    }
    den += __shfl_xor(den, 32);
    const float inv = __builtin_amdgcn_rcpf(den);
    LDS_BARRIER();
    int tv = tid; asm volatile("" : "+v"(tv));
#pragma unroll
    for (int i = 8; i < 16; ++i) st[i] = *(const v4u*)(Vg + i * 32768 + ((tv >> 5) * 2048 + (tv & 31) * 8));
#pragma unroll
    for (int i = 0; i < 16; ++i) { const int id = tv + 512 * i; *(LAS v4u*)(lds + (id >> 5) * XA_VSTRIDE + (id & 31) * 16) = st[i]; }
    LDS_BARRIER();
    const int lbase = tr_lane_base(lane, XA_VSTRIDE);
#pragma unroll
    for (int half = 0; half < 2; ++half) {
        f32x16 o[4];
#pragma unroll
        for (int vb = 0; vb < 4; ++vb)
#pragma unroll
            for (int i = 0; i < 16; ++i) o[vb][i] = 0.f;
        { s16x4 tl[4], th[4];
#define XA_TR(q) do { const LAS char* ap_ = lds + lbase + ((q) >> 3) * (32 * XA_VSTRIDE) + 256 * half; \
            asm volatile("ds_read_b64_tr_b16 %0, %2 offset:%3\n\tds_read_b64_tr_b16 %1, %2 offset:%4" : "=&v"(tl[(q) & 3]), "=&v"(th[(q) & 3]) : "v"(ap_), "n"((((q) >> 2) & 1) * 16 * XA_VSTRIDE + ((q) & 3) * 64), "n"((((q) >> 2) & 1) * 16 * XA_VSTRIDE + ((q) & 3) * 64 + 8 * XA_VSTRIDE)); } while (0)
          XA_TR(0); XA_TR(1); XA_TR(2);
#pragma unroll
          for (int q = 0; q < 64; ++q) {
              if (q + 3 < 64) XA_TR(q + 3);
              if (q + 3 < 64) asm volatile("s_waitcnt lgkmcnt(6)" : "+v"(tl[q & 3]), "+v"(th[q & 3])); else if (q + 2 < 64) asm volatile("s_waitcnt lgkmcnt(4)" : "+v"(tl[q & 3]), "+v"(th[q & 3]));
              else if (q + 1 < 64) asm volatile("s_waitcnt lgkmcnt(2)" : "+v"(tl[q & 3]), "+v"(th[q & 3])); else asm volatile("s_waitcnt lgkmcnt(0)" : "+v"(tl[q & 3]), "+v"(th[q & 3]));
              const s16x4 lo = tl[q & 3], hi = th[q & 3]; const bf16x8 a = (bf16x8){lo[0], lo[1], lo[2], lo[3], hi[0], hi[1], hi[2], hi[3]};
              o[q & 3] = MFMA32(a, pf[q >> 3][(q >> 2) & 1], o[q & 3]);
          }
#undef XA_TR
        }
        LAS char* tile = lds + 256 * XA_VSTRIDE + w * 2560;
#pragma unroll
        for (int vb = 0; vb < 4; ++vb) {
#pragma unroll
            for (int g4 = 0; g4 < 4; ++g4) { v2u wv; wv.x = cvtpk(o[vb][4 * g4] * inv, o[vb][4 * g4 + 1] * inv); wv.y = cvtpk(o[vb][4 * g4 + 2] * inv, o[vb][4 * g4 + 3] * inv);
                *(LAS v2u*)(tile + r * 80 + (8 * g4 + 4 * h2) * 2) = wv; }
            asm volatile("s_waitcnt lgkmcnt(0)" ::: "memory");
#pragma unroll
            for (int i = 0; i < 2; ++i) { const int id = lane + 64 * i; *(v4u*)(O + (size_t)(row0 + 32 * w + (id >> 2)) * D + h * 256 + 128 * half + 32 * vb + 8 * (id & 3)) = *(const LAS v4u*)(tile + (id >> 2) * 80 + (id & 3) * 16); }
            asm volatile("s_waitcnt lgkmcnt(0)" ::: "memory");
        }
    }
    __syncthreads();
}


struct EpiXattn {
    static constexpr int PERM = 1; static constexpr bool AFTER_DRAIN = true;
    struct Pre { int unused; };
    const bf16* MKV; const float* gkq; bf16* O;
    __device__ __forceinline__ void init(f32x4 (&)[2][2][4][2], const pg8::Unit&, int, int, int, int) const {}
    __device__ __forceinline__ void fused(f32x4 (&acc)[2][2][4][2], const pg8::Unit& u, int wr, int wc, int fr, int fq, LAS unsigned char* lds, int wid, int lane) const {
#pragma unroll
        for (int ai = 0; ai < 2; ++ai)
#pragma unroll
            for (int m = 0; m < 4; ++m) { const int row = ai * 128 + wr * 64 + m * 16 + fr;
#pragma unroll
                for (int bj = 0; bj < 2; ++bj) { const f32x4 v0 = acc[ai][bj][m][0], v1 = acc[ai][bj][m][1];
                    v4u o; o.x = cvtpk(v0[0], v0[1]); o.y = cvtpk(v0[2], v0[3]); o.z = cvtpk(v1[0], v1[1]); o.w = cvtpk(v1[2], v1[3]);
                    *(LAS v4u*)(lds + row * XA_STRIDE + (bj * 128 + wc * 32 + 8 * fq) * 2) = o; } }
        asm volatile("s_waitcnt lgkmcnt(0)" ::: "memory"); __builtin_amdgcn_s_barrier(); asm volatile("" ::: "memory");
    }
};

constexpr int DA_STRIDE = 272, DA_VSTRIDE = 320, DA_LDS_BIAS = 384 * DA_VSTRIDE, DA_LDS_GK = DA_LDS_BIAS + 768, DA_LDS_OSTG = DA_LDS_GK + 512, DA_OSTG_WAVE = 32 * 144 + 128;
static_assert(DA_LDS_OSTG + 8 * DA_OSTG_WAVE <= 163840 - 512, "dilated attention LDS map");
constexpr int DA_UNUSED0 = 0;
struct DaArgs { const bf16* QKV; const float* biasT; const float* gkq; bf16* N0; float* DEN0; const bf16* N1; const float* DEN1; const bf16* N2; const float* DEN2; bf16* O; int br0; int nbr; int mode; int pad; };
struct DaUnit { int br, b, h, dil, cls, l0; };
template <int MODE> __device__ __forceinline__ DaUnit da_decode(int uu) {
    DaUnit U; U.br = MODE == 0 ? __builtin_amdgcn_readfirstlane(1 + ((uu >> 4) & 1)) : 0; const int rem = __builtin_amdgcn_readfirstlane(MODE == 0 ? (((uu >> 5) << 4) | (uu & 15)) : ((((uu >> 5) & 7) >> 1) * 128 + ((((uu >> 8) * 32 + (uu & 31)) >> 3) << 4) + ((((uu >> 5) & 1) << 3) | (uu & 7)))), x = rem & 15;     U.b = rem >> 7; U.h = (rem >> 4) & 7; U.dil = 1 << (2 * U.br);
    U.cls = U.br == 0 ? 0 : (U.br == 1 ? (x & 3) : x); U.l0 = 256 * (U.br == 0 ? x : (U.br == 1 ? (x >> 2) : 0)); return U; }
__device__ __forceinline__ void da_load_rows(v4u (&st)[12], const bf16* QKV, const DaUnit& U, int col, int tid) {
    const bf16* base = QKV + (size_t)(col >> 10) * ((size_t)M * 1024) + (size_t)((U.b * 8 + U.h) * SEQ) * 128 + (tid & 15) * 8;
#pragma unroll
    for (int i = 0; i < 12; ++i) { const int ki = (tid >> 4) + 32 * i, lk = U.l0 - 128 + ki, lkc = lk < 0 ? 0 : lk; st[i] = *(const v4u*)(base + (size_t)(lkc * U.dil + U.cls) * 128); }
}
template <int MODE> __device__ __forceinline__ void dattn_phase(LAS char* lds, const DaArgs& a, int bx, int G, int tid) {
    constexpr int NUNITS = MODE == 0 ? 1024 : 512;
    const int lane = tid & 63, w = __builtin_amdgcn_readfirstlane(tid >> 6), r = lane & 31, h2 = lane >> 5;
    int uu = (G == 256) ? (((bx & 7) << 5) | (bx >> 3)) : bx; if (uu >= NUNITS) return;
    v4u st[12];
    LAS float* lbias = (LAS float*)(lds + DA_LDS_BIAS);
    float bnext;
    { const DaUnit U0 = da_decode<MODE>(uu); da_load_rows(st, a.QKV, U0, 1024, tid);
      const int dl0 = tid - 32; bnext = (tid < 192 && dl0 >= 0 && dl0 <= 128) ? a.biasT[(U0.br * 8 + U0.h) * 132 + dl0] : 0.f; }
    bf16x8 qf[8];
    if (MODE == 0) { const DaUnit U0 = da_decode<MODE>(uu); const size_t qrow0 = (size_t)(U0.b * SEQ + (U0.l0 + 32 * w + r) * U0.dil + U0.cls);
#pragma unroll
      for (int s = 0; s < 8; ++s) qf[s] = *(const bf16x8*)(a.QKV + (qrow0 + (size_t)(U0.b * 8 + U0.h - U0.b) * SEQ) * 128 + 8 * h2 + 16 * s); }

    const int lbase = tr_lane_base(lane, DA_VSTRIDE);
    for (;;) {
        const DaUnit U = da_decode<MODE>(uu);
        const int l0 = U.l0, h = U.h; const bool zfirst = (l0 == 0);
        int r_l = r; asm volatile("" : "+v"(r_l));
        const size_t qrow = (size_t)(U.b * SEQ + (l0 + 32 * w + r) * U.dil + U.cls);
#pragma unroll
        for (int i = 0; i < 12; ++i) *(LAS v4u*)(lds + ((tid >> 4) + 32 * i) * DA_STRIDE + (tid & 15) * 16) = (i < 4 && zfirst) ? (v4u){0u, 0u, 0u, 0u} : st[i];
        if (tid < 192) { const int dl = tid - 32; lbias[tid] = (dl >= 0 && dl <= 128) ? bnext * 1.4426950408889634f - 11.541560327111707f : -__builtin_inff(); }
        asm volatile("" ::: "memory");
        if (MODE == 1) {
#pragma unroll
            for (int s = 0; s < 8; ++s) qf[s] = *(const bf16x8*)(a.QKV + (qrow + (size_t)(U.b * 8 + h - U.b) * SEQ) * 128 + 8 * h2 + 16 * s); }
        da_load_rows(st, a.QKV, U, 2048, tid);
        LDS_BARRIER();
        bf16x8 pf[5][2]; float den = 0.f;
#pragma unroll
        for (int kbi = 0; kbi < 5; ++kbi) {
            if (zfirst && w + kbi < 4) { pf[kbi][0] = (bf16x8){0, 0, 0, 0, 0, 0, 0, 0}; pf[kbi][1] = pf[kbi][0]; continue; }
            f32x16 acc;
#pragma unroll
            for (int i = 0; i < 16; ++i) acc[i] = 0.f;
            const LAS char* kp = lds + (32 * (w + kbi) + r) * DA_STRIDE + h2 * 16;
            const LAS float* tb = lbias + (r_l - 4 * h2);
            v2f tbv[8]; bf16x8 fb[4];
#pragma unroll
            for (int i2 = 0; i2 < 8; ++i2) { const int i = 2 * i2; asm volatile("ds_read2_b32 %0, %1 offset0:%2 offset1:%3" : "=v"(tbv[i2]) : "v"(tb), "n"(160 - 32 * kbi - ((i & 3) + 8 * (i >> 2))), "n"(160 - 32 * kbi - ((i & 3) + 8 * (i >> 2)) - 1)); }
#define DA_RD(q) asm volatile("ds_read_b128 %0, %1 offset:%2" : "=v"(fb[(q) & 3]) : "v"(kp), "n"((q) * 32))
            DA_RD(0); DA_RD(1); DA_RD(2);
#pragma unroll
            for (int s = 0; s < 8; ++s) {
                if (s + 3 < 8) DA_RD(s + 3);
                if (s + 3 < 8) asm volatile("s_waitcnt lgkmcnt(3)" : "+v"(fb[s & 3])); else if (s + 2 < 8) asm volatile("s_waitcnt lgkmcnt(2)" : "+v"(fb[s & 3])); else if (s + 1 < 8) asm volatile("s_waitcnt lgkmcnt(1)" : "+v"(fb[s & 3]));
                else asm volatile("s_waitcnt lgkmcnt(0)" : "+v"(fb[s & 3]), "+v"(tbv[0]), "+v"(tbv[1]), "+v"(tbv[2]), "+v"(tbv[3]), "+v"(tbv[4]), "+v"(tbv[5]), "+v"(tbv[6]), "+v"(tbv[7]));
                acc = MFMA32(fb[s & 3], qf[s], acc);
            }
#undef DA_RD
#pragma unroll
            for (int hh = 0; hh < 2; ++hh) { float p[8];
#pragma unroll
                for (int i8 = 0; i8 < 8; ++i8) { const int i = 8 * hh + i8;
                    p[i8] = __builtin_amdgcn_exp2f(acc[i] + tbv[i >> 1][i & 1]); den += p[i8]; }
                pf[kbi][hh] = pack8(p[0], p[1], p[2], p[3], p[4], p[5], p[6], p[7]); }
            asm volatile("" ::: "memory");
        }
        den += __shfl_xor(den, 32);
        float d12 = 0.f; if (MODE == 1) d12 = a.DEN1[qrow * 8 + h] + a.DEN2[qrow * 8 + h];
        LDS_BARRIER();
#pragma unroll
        for (int i = 0; i < 12; ++i) *(LAS v4u*)(lds + ((tid >> 4) + 32 * i) * DA_VSTRIDE + (tid & 15) * 16) = (i < 4 && zfirst) ? (v4u){0u, 0u, 0u, 0u} : st[i];
        LDS_BARRIER();
        size_t goff[4];
#pragma unroll
        for (int i = 0; i < 4; ++i) { const int id = lane + 64 * i, row = id >> 3, ch = id & 7; goff[i] = (size_t)(U.b * SEQ + (l0 + 32 * w + row) * U.dil + U.cls) * D + h * 128 + ch * 8; }
        v4u n1v[4], n2v[4];
        if (MODE == 1) {
#pragma unroll
            for (int i = 0; i < 4; ++i) { n1v[i] = *(const v4u*)(a.N1 + goff[i]); n2v[i] = *(const v4u*)(a.N2 + goff[i]); } }
        const int un = uu + G; const bool more = un < NUNITS; const DaUnit Un = da_decode<MODE>(more ? un : uu);
        if (more) { da_load_rows(st, a.QKV, Un, 1024, tid); const int dln = tid - 32; bnext = (tid < 192 && dln >= 0 && dln <= 128) ? a.biasT[(Un.br * 8 + Un.h) * 132 + dln] : 0.f;
            if (MODE == 0) { const size_t qrown = (size_t)(Un.b * SEQ + (Un.l0 + 32 * w + r_l) * Un.dil + Un.cls);
#pragma unroll
                for (int s = 0; s < 8; ++s) qf[s] = *(const bf16x8*)(a.QKV + (qrown + (size_t)(Un.b * 8 + Un.h - Un.b) * SEQ) * 128 + 8 * h2 + 16 * s); } }
        LAS char* stg = lds + DA_LDS_OSTG + w * DA_OSTG_WAVE;
        float inv = 1.0f;
        if (MODE == 0) { if (h2 == 0) ((float*)(U.br == 1 ? a.DEN1 : a.DEN2))[qrow * 8 + h] = den; }
        else { inv = __builtin_amdgcn_rcpf(den + d12); if (h2 == 0) ((LAS float*)(stg + 32 * 144))[r] = inv; }
#pragma unroll
        for (int half = 0; half < 2; ++half) {
            f32x16 o[2];
            if (MODE == 1 && half == 1) {
#pragma unroll
                for (int i = 0; i < 4; ++i) { n1v[i] = *(const v4u*)(a.N1 + goff[i] + 64); n2v[i] = *(const v4u*)(a.N2 + goff[i] + 64); } }
#pragma unroll
            for (int vb = 0; vb < 2; ++vb)
#pragma unroll
                for (int i = 0; i < 16; ++i) o[vb][i] = 0.f;
            { s16x4 tl[4], th[4];
              const LAS char* vp = lds + lbase + (32 * w) * DA_VSTRIDE + 128 * half;
#define DA_TR(q) asm volatile("ds_read_b64_tr_b16 %0, %2 offset:%3\n\tds_read_b64_tr_b16 %1, %2 offset:%4" : "=&v"(tl[(q) & 3]), "=&v"(th[(q) & 3]) : "v"(vp), "n"((((q) >> 2) * 32 + (((q) >> 1) & 1) * 16) * DA_VSTRIDE + ((q) & 1) * 64), \
                  "n"((((q) >> 2) * 32 + (((q) >> 1) & 1) * 16 + 8) * DA_VSTRIDE + ((q) & 1) * 64))
              DA_TR(0); DA_TR(1); DA_TR(2);
#pragma unroll
              for (int q = 0; q < 20; ++q) {
                  if (q + 3 < 20) DA_TR(q + 3);
                  if (q + 3 < 20) asm volatile("s_waitcnt lgkmcnt(6)" : "+v"(tl[q & 3]), "+v"(th[q & 3])); else if (q + 2 < 20) asm volatile("s_waitcnt lgkmcnt(4)" : "+v"(tl[q & 3]), "+v"(th[q & 3]));
                  else if (q + 1 < 20) asm volatile("s_waitcnt lgkmcnt(2)" : "+v"(tl[q & 3]), "+v"(th[q & 3])); else asm volatile("s_waitcnt lgkmcnt(0)" : "+v"(tl[q & 3]), "+v"(th[q & 3]));
                  const s16x4 lo = tl[q & 3], hi = th[q & 3]; const bf16x8 av = (bf16x8){lo[0], lo[1], lo[2], lo[3], hi[0], hi[1], hi[2], hi[3]};
                  o[q & 1] = MFMA32(av, pf[q >> 2][(q >> 1) & 1], o[q & 1]);
              }
#undef DA_TR
            }
#pragma unroll
            for (int vb = 0; vb < 2; ++vb)
#pragma unroll
                for (int g4 = 0; g4 < 4; ++g4) { v2u wv; wv.x = cvtpk(o[vb][4 * g4], o[vb][4 * g4 + 1]); wv.y = cvtpk(o[vb][4 * g4 + 2], o[vb][4 * g4 + 3]); *(LAS v2u*)(stg + r * 144 + (32 * vb + 8 * g4 + 4 * h2) * 2) = wv; }
            asm volatile("s_waitcnt lgkmcnt(0)" ::: "memory");
            if (MODE == 0) {
                bf16* N = (bf16*)(U.br == 1 ? a.N1 : a.N2) + 64 * half;
#pragma unroll
                for (int i = 0; i < 4; ++i) { const int id = lane + 64 * i; *(v4u*)(N + goff[i]) = *(const LAS v4u*)(stg + (id >> 3) * 144 + (id & 7) * 16); }
            } else {
#pragma unroll
                for (int i = 0; i < 4; ++i) { const int id = lane + 64 * i; float fo[8], f1[8], f2[8]; unpack8(*(const LAS v4u*)(stg + (id >> 3) * 144 + (id & 7) * 16), fo); unpack8(n1v[i], f1); unpack8(n2v[i], f2);
                    const float iv = ((const LAS float*)(stg + 32 * 144))[id >> 3];
                    v4u ov; ov.x = cvtpk((fo[0] + f1[0] + f2[0]) * iv, (fo[1] + f1[1] + f2[1]) * iv); ov.y = cvtpk((fo[2] + f1[2] + f2[2]) * iv, (fo[3] + f1[3] + f2[3]) * iv);
                    ov.z = cvtpk((fo[4] + f1[4] + f2[4]) * iv, (fo[5] + f1[5] + f2[5]) * iv); ov.w = cvtpk((fo[6] + f1[6] + f2[6]) * iv, (fo[7] + f1[7] + f2[7]) * iv);
                    *(v4u*)(a.O + goff[i] + 64 * half) = ov; }
            }
            asm volatile("s_waitcnt lgkmcnt(0)" ::: "memory");
        }
        LDS_BARRIER();
        if (!more) break;
        uu = un;
    }
}

constexpr int MX_STRIDE = 272, MX_TSTRIDE = 320, MX_IMG = 128 * MX_TSTRIDE;
constexpr int MX_Q = 0, MX_K = MX_IMG, MX_V = 2 * MX_IMG, MX_SCR = 3 * MX_IMG, MX_OSTG = MX_SCR + 5120;
constexpr int MX_LB = MX_OSTG + 8 * 2560;
static_assert(MX_LB + 2048 <= 163840 - 512, "mixer LDS map");
constexpr int MX_UNUSED0 = 0;
struct MixArgs { bf16* Z; const float* lb; const float* ret_g; const float* hg_g; bf16* SBUF; float* DECA; float* DECB; };

__device__ __forceinline__ void st_chunk8(LAS char* img, int stride, int row, int c0, const float (&f)[8]) {
    v4u o; o.x = cvtpk(f[0], f[1]); o.y = cvtpk(f[2], f[3]); o.z = cvtpk(f[4], f[5]); o.w = cvtpk(f[6], f[7]); *(LAS v4u*)(img + row * stride + c0 * 2) = o; }

__device__ __forceinline__ void ret_prep_tile(LAS char* img, int stride, const bf16* zrow  , int j, int cg, const float (&sn)[16], const float (&cs)[16], float sc) {
#pragma unroll
    for (int hc = 0; hc < 2; ++hc) { float x1[8], x2[8], o1[8], o2[8];
        unpack8(*(const v4u*)(zrow + 16 * cg + 8 * hc), x1); unpack8(*(const v4u*)(zrow + 64 + 16 * cg + 8 * hc), x2);
#pragma unroll
        for (int e = 0; e < 8; ++e) { o1[e] = (x1[e] * cs[8 * hc + e] - x2[e] * sn[8 * hc + e]) * sc; o2[e] = (x1[e] * sn[8 * hc + e] + x2[e] * cs[8 * hc + e]) * sc; }
        st_chunk8(img, stride, j, 16 * cg + 8 * hc, o1); st_chunk8(img, stride, j, 64 + 16 * cg + 8 * hc, o2); }
}
__device__ __forceinline__ void copy_tile(LAS char* img, int stride, const bf16* src, int tid) {
#pragma unroll
    for (int i = 0; i < 4; ++i) { const int id = tid + 512 * i, row = id >> 4, ch = id & 15; *(LAS v4u*)(img + row * stride + ch * 16) = *(const v4u*)(src + (size_t)row * ZP + ch * 8); }
}
__device__ __forceinline__ float wave_incl_scan(float v) {
#define WIS_DPP(x, ctrl, rmask, bc) __builtin_bit_cast(float, __builtin_amdgcn_update_dpp(0, __builtin_bit_cast(int, (x)), (ctrl), (rmask), 0xf, (bc)))
    v += WIS_DPP(v, 0x111, 0xf, true); v += WIS_DPP(v, 0x112, 0xf, true); v += WIS_DPP(v, 0x114, 0xf, true); v += WIS_DPP(v, 0x118, 0xf, true);
    v += WIS_DPP(v, 0x142, 0xa, false);
    v += WIS_DPP(v, 0x143, 0xc, false);
#undef WIS_DPP
    return v;
}
__device__ __forceinline__ void hg_gates(const bf16* zrow_f  , const float* lbh  , int tid, LAS float* scr, float (&cum)[32], float (&kk)[32]) {
    const int lane = tid & 63, hw = (tid >> 6) & 1, cg = tid >> 7;
#pragma unroll
    for (int q = 0; q < 4; ++q) { float fl[8]; unpack8(*(const v4u*)(zrow_f + 32 * cg + 8 * q), fl);
#pragma unroll
        for (int e = 0; e < 8; ++e) { const float l = lbh[32 * cg + 8 * q + e]; const float f = l + (1.0f - l) * __builtin_amdgcn_rcpf(1.0f + __expf(-fl[e])); kk[8 * q + e] = 1.0f - f; cum[8 * q + e] = __builtin_amdgcn_logf(fmaxf(f, 1e-6f));     } }
#pragma unroll
    for (int c = 0; c < 32; ++c) cum[c] = wave_incl_scan(cum[c]);
    if (hw == 0 && lane == 63) {
#pragma unroll
        for (int c = 0; c < 32; ++c) scr[32 * cg + c] = cum[c]; }
    __syncthreads();
    if (hw == 1) {
#pragma unroll
        for (int c = 0; c < 32; ++c) cum[c] += scr[32 * cg + c]; }
    if (hw == 1 && lane == 63) {
#pragma unroll
        for (int c = 0; c < 32; ++c) scr[128 + 32 * cg + c] = cum[c]; }
    __syncthreads();
}

__device__ __forceinline__ void load_prep4(v4u (&rw)[4], const bf16* zrow_seg, int mixer, int cg) {
#pragma unroll
    for (int q = 0; q < 4; ++q) { const int col = mixer == 0 ? ((q >> 1) * 64 + 16 * cg + 8 * (q & 1)) : (32 * cg + 8 * q); rw[q] = *(const v4u*)(zrow_seg + col); }
}
__device__ __forceinline__ void load_copy4(v4u (&rw)[4], const bf16* tile, int tid) {
#pragma unroll
    for (int i = 0; i < 4; ++i) { const int id = tid + 512 * i; rw[i] = __builtin_nontemporal_load((const v4u*)(tile + (size_t)(id >> 4) * ZP + (id & 15) * 8)); }
}
__device__ __forceinline__ void store_copy4(LAS char* img, int stride, const v4u (&rw)[4], int tid) {
#pragma unroll
    for (int i = 0; i < 4; ++i) { const int id = tid + 512 * i; *(LAS v4u*)(img + (id >> 4) * stride + (id & 15) * 16) = rw[i]; }
}
__device__ __forceinline__ void ret_prep_raw(LAS char* img, int stride, const v4u (&rw)[4], int j, int cg, const float (&sn)[16], const float (&cs)[16], float sc) {
#pragma unroll
    for (int hc = 0; hc < 2; ++hc) { float x1[8], x2[8], o1[8], o2[8]; unpack8(rw[hc], x1); unpack8(rw[2 + hc], x2);
#pragma unroll
        for (int e = 0; e < 8; ++e) { o1[e] = (x1[e] * cs[8 * hc + e] - x2[e] * sn[8 * hc + e]) * sc; o2[e] = (x1[e] * sn[8 * hc + e] + x2[e] * cs[8 * hc + e]) * sc; }
        st_chunk8(img, stride, j, 16 * cg + 8 * hc, o1); st_chunk8(img, stride, j, 64 + 16 * cg + 8 * hc, o2); }
}
template <typename LBP> __device__ __forceinline__ void hg_gates_raw(const v4u (&rw)[4], LBP lbh, int tid, LAS float* scr, float (&cum)[32], float (&kk)[32]) {
    const int lane = tid & 63, hw = (tid >> 6) & 1, cg = tid >> 7;
#pragma unroll
    for (int q = 0; q < 4; ++q) { float fl[8]; unpack8(rw[q], fl);
#pragma unroll
        for (int e = 0; e < 8; ++e) { const float l = lbh[32 * cg + 8 * q + e]; const float f = l + (1.0f - l) * __builtin_amdgcn_rcpf(1.0f + __expf(-fl[e])); kk[8 * q + e] = 1.0f - f; cum[8 * q + e] = __builtin_amdgcn_logf(fmaxf(f, 1e-6f));     } }
#pragma unroll
    for (int c8 = 0; c8 < 32; c8 += 8) asm volatile("" : "+v"(cum[c8]), "+v"(cum[c8 + 1]), "+v"(cum[c8 + 2]), "+v"(cum[c8 + 3]), "+v"(cum[c8 + 4]), "+v"(cum[c8 + 5]), "+v"(cum[c8 + 6]), "+v"(cum[c8 + 7]));
#define HG_SCAN_STEP(ctrl) _Pragma("unroll") for (int c = 0; c < 32; ++c) asm volatile("v_add_f32_dpp %0, %0, %0 " ctrl : "+v"(cum[c]))
    HG_SCAN_STEP("row_shr:1 row_mask:0xf bank_mask:0xf bound_ctrl:1"); HG_SCAN_STEP("row_shr:2 row_mask:0xf bank_mask:0xf bound_ctrl:1"); HG_SCAN_STEP("row_shr:4 row_mask:0xf bank_mask:0xf bound_ctrl:1"); HG_SCAN_STEP("row_shr:8 row_mask:0xf bank_mask:0xf bound_ctrl:1");
    HG_SCAN_STEP("row_bcast:15 row_mask:0xa bank_mask:0xf"); HG_SCAN_STEP("row_bcast:31 row_mask:0xc bank_mask:0xf");
#undef HG_SCAN_STEP
    if (hw == 0 && lane == 63) {
#pragma unroll
        for (int c = 0; c < 32; ++c) scr[32 * cg + c] = cum[c]; }
    LDS_BARRIER();
    if (hw == 1) {
#pragma unroll
        for (int c = 0; c < 32; ++c) cum[c] += scr[32 * cg + c]; }
    if (hw == 1 && lane == 63) {
#pragma unroll
        for (int c = 0; c < 32; ++c) scr[128 + 32 * cg + c] = cum[c]; }
    LDS_BARRIER();
}
struct MixU { int mixer, b, h, n; };
__device__ __forceinline__ MixU mix_decode(int u) { MixU U; const int g = __builtin_amdgcn_readfirstlane(u >> 5); U.n = __builtin_amdgcn_readfirstlane(u & 31); U.mixer = g >> 4; U.b = (g >> 2) & 3; U.h = g & 3; return U; }

__device__ __forceinline__ void mixA_phase(LAS char* lds, const MixArgs& a, int bx, int G, int tid) {
    const int lane = tid & 63, w = __builtin_amdgcn_readfirstlane(tid >> 6), r = lane & 31, h2 = lane >> 5;
    const int j = tid & 127, cg = tid >> 7;
    LAS float* scr = (LAS float*)(lds + MX_SCR);
    int u = bx; if (u >= 1024) return;
    ((LAS float*)(lds + MX_LB))[tid] = a.lb[tid]; LDS_BARRIER();
    v4u rk[4], rv[4];
    { const MixU U = mix_decode(u); const bf16* zt = a.Z + (size_t)(U.b * SEQ + 128 * U.n) * ZP;
      load_prep4(rk, zt + (size_t)j * ZP + ZB((U.mixer == 0 ? Z_RK : Z_GF) + U.h * 128), U.mixer, cg); load_copy4(rv, zt + ZB((U.mixer == 0 ? Z_RV : Z_GI) + U.h * 128), tid); }
    for (;;) {
        const MixU U = mix_decode(u); const int h = U.h, n = U.n;
        if (U.mixer == 0) {
            const float gamma = 1.0f - __builtin_amdgcn_exp2f(-5.0f - (float)h), lg2 = log2f(gamma);
            float sn[16], cs[16];
#pragma unroll
            for (int e = 0; e < 16; ++e) { const float inv = __builtin_amdgcn_exp2f(-(float)(16 * cg + e) * (13.287712379549449f / 64.0f)); rope_sincos((float)(128 * n + j) * inv, sn[e], cs[e]); }
            ret_prep_raw(lds + MX_K, MX_TSTRIDE, rk, j, cg, sn, cs, 0.08838834764831845f * __builtin_amdgcn_exp2f((float)(127 - j) * lg2));
            if (tid < 128) { a.DECA[(size_t)u * 128 + tid] = __builtin_amdgcn_exp2f(128.0f * lg2); a.DECB[(size_t)u * 128 + tid] = gamma; }
        } else {
            float cum[32], kk[32];
            hg_gates_raw(rk, (const LAS float*)(lds + MX_LB) + h * 128, tid, scr, cum, kk);
#pragma unroll
            for (int q = 0; q < 4; ++q) { float o[8];
#pragma unroll
                for (int e = 0; e < 8; ++e) o[e] = kk[8 * q + e] * __builtin_amdgcn_exp2f(scr[128 + 32 * cg + 8 * q + e] - cum[8 * q + e]);
                st_chunk8(lds + MX_K, MX_TSTRIDE, j, 32 * cg + 8 * q, o); }
            if (tid < 128) { a.DECA[(size_t)u * 128 + tid] = __builtin_amdgcn_exp2f(scr[128 + tid]); a.DECB[(size_t)u * 128 + tid] = __builtin_amdgcn_exp2f(scr[tid]); }
        }
        store_copy4(lds + MX_V, MX_TSTRIDE, rv, tid);
        LDS_BARRIER();
        const int un = u + G; const bool more = un < 1024;
        if (more) { const MixU Un = mix_decode(un); const bf16* zt = a.Z + (size_t)(Un.b * SEQ + 128 * Un.n) * ZP;
            load_prep4(rk, zt + (size_t)j * ZP + ZB((Un.mixer == 0 ? Z_RK : Z_GF) + Un.h * 128), Un.mixer, cg); load_copy4(rv, zt + ZB((Un.mixer == 0 ? Z_RV : Z_GI) + Un.h * 128), tid); }
        const int lbn = tr_lane_base_nat(lane, MX_TSTRIDE); const int kbk = w >> 1, vb0 = 2 * (w & 1);
        f32x16 acc[2];
#pragma unroll
        for (int t = 0; t < 2; ++t)
#pragma unroll
            for (int i = 0; i < 16; ++i) acc[t][i] = 0.f;
        {
          const LAS char* pk = lds + MX_K + lbn + 64 * kbk; const LAS char* pv = lds + MX_V + lbn + 64 * vb0;
          s16x4 al[2], ah[2], bl[2][2], bh[2][2];
#define MA_TR(lo_, hi_, ptr_, off_) asm volatile("ds_read_b64_tr_b16 %0, %2 offset:%3\n\tds_read_b64_tr_b16 %1, %2 offset:%4" : "=&v"(lo_), "=&v"(hi_) : "v"(ptr_), "n"(off_), "n"((off_) + 4 * MX_TSTRIDE))
#define MA_RD(q) do { MA_TR(al[(q) & 1], ah[(q) & 1], pk, (q) * 16 * MX_TSTRIDE); MA_TR(bl[(q) & 1][0], bh[(q) & 1][0], pv, (q) * 16 * MX_TSTRIDE); MA_TR(bl[(q) & 1][1], bh[(q) & 1][1], pv, (q) * 16 * MX_TSTRIDE + 64); } while (0)
          MA_RD(0);
#pragma unroll
          for (int q = 0; q < 8; ++q) {
              if (q + 1 < 8) MA_RD(q + 1);
              if (q + 1 < 8) asm volatile("s_waitcnt lgkmcnt(8)" : "+v"(al[q & 1]), "+v"(ah[q & 1]), "+v"(bl[q & 1][0]), "+v"(bh[q & 1][0])); else asm volatile("s_waitcnt lgkmcnt(2)" : "+v"(al[q & 1]), "+v"(ah[q & 1]), "+v"(bl[q & 1][0]), "+v"(bh[q & 1][0]));
              const bf16x8 av = (bf16x8){al[q & 1][0], al[q & 1][1], al[q & 1][2], al[q & 1][3], ah[q & 1][0], ah[q & 1][1], ah[q & 1][2], ah[q & 1][3]};
              const bf16x8 b0 = (bf16x8){bl[q & 1][0][0], bl[q & 1][0][1], bl[q & 1][0][2], bl[q & 1][0][3], bh[q & 1][0][0], bh[q & 1][0][1], bh[q & 1][0][2], bh[q & 1][0][3]};
              acc[0] = MFMA32(av, b0, acc[0]);
              if (q + 1 < 8) asm volatile("s_waitcnt lgkmcnt(6)" : "+v"(bl[q & 1][1]), "+v"(bh[q & 1][1])); else asm volatile("s_waitcnt lgkmcnt(0)" : "+v"(bl[q & 1][1]), "+v"(bh[q & 1][1]));
              const bf16x8 b1 = (bf16x8){bl[q & 1][1][0], bl[q & 1][1][1], bl[q & 1][1][2], bl[q & 1][1][3], bh[q & 1][1][0], bh[q & 1][1][1], bh[q & 1][1][2], bh[q & 1][1][3]};
              acc[1] = MFMA32(av, b1, acc[1]);
          }
#undef MA_RD
#undef MA_TR
        }
        bf16* sb = a.SBUF + (size_t)u * 16384;
#pragma unroll
        for (int t = 0; t < 2; ++t)
#pragma unroll
            for (int g4 = 0; g4 < 4; ++g4) { v2u wv; wv.x = cvtpk(acc[t][4 * g4], acc[t][4 * g4 + 1]); wv.y = cvtpk(acc[t][4 * g4 + 2], acc[t][4 * g4 + 3]);
                *(v2u*)(sb + ((((((vb0 + t) * 8 + 2 * kbk + (g4 >> 1)) * 2 + (g4 & 1)) * 32 + r) * 8) + 4 * h2)) = wv; }
        LDS_BARRIER();
        if (!more) break;
        u = un;
    }
}

__device__ __forceinline__ void mix_scan(const MixArgs& a, int gtid, int nthreads, bool dry = false) {
    for (int e = gtid; e < 32 * 4096; e += nthreads) { const int g = e >> 12, el = e & 4095, dk4 = 4 * ((el >> 7) & 7) + 2 * ((el >> 6) & 1) + (el & 1);
        bf16* sp = a.SBUF + (size_t)(g * 32) * 16384 + (size_t)el * 4; const float* da = a.DECA + (size_t)(g * 32) * 128 + 4 * dk4; const float* db = a.DECB + (size_t)(g * 32) * 128 + 4 * dk4;
        f32x4 S = (f32x4){0.f, 0.f, 0.f, 0.f};
#pragma unroll 8
        for (int n = 0; n < 32; ++n) { const v2u kv = __builtin_nontemporal_load((const v2u*)(sp + (size_t)n * 16384)); const f32x4 A = *(const f32x4*)(da + n * 128), Bv = *(const f32x4*)(db + n * 128);
            const f32x4 so = S * Bv; v2u wv; wv.x = cvtpk(so[0], so[1]); wv.y = cvtpk(so[2], so[3]); if (!dry) *(v2u*)(sp + (size_t)n * 16384) = wv;
            S[0] = A[0] * S[0] + __uint_as_float(kv.x << 16); S[1] = A[1] * S[1] + __uint_as_float(kv.x & 0xffff0000u); S[2] = A[2] * S[2] + __uint_as_float(kv.y << 16); S[3] = A[3] * S[3] + __uint_as_float(kv.y & 0xffff0000u); }
    }
}

__device__ __forceinline__ int mixc_map(int v, int G) {
    if (G != 256) return v;
    const int bxv = v & 255, r = v >> 8, xcd = bxv & 7, idx = r * 32 + (bxv >> 3), mixer = idx >> 6, h = (idx >> 4) & 3, n = (xcd & 1) * 16 + (idx & 15), b = xcd >> 1;
    return ((mixer * 16 + b * 4 + h) << 5) | n;
}
__device__ __forceinline__ void mixC_phase(LAS char* lds, const MixArgs& a, int bx, int G, int tid0, bool dry = false) {
    const int w = __builtin_amdgcn_readfirstlane(tid0 >> 6);
    LAS float* scr = (LAS float*)(lds + MX_SCR);
    int vu = bx; if (vu >= 1024) return;
    int u = mixc_map(vu, G);
    ((LAS float*)(lds + MX_LB))[tid0] = a.lb[tid0]; LDS_BARRIER();
    v4u rq[4], rk[4];
    { const int tid = tid0, j = tid & 127, cg = tid >> 7; const MixU U = mix_decode(u); const bf16* zt = a.Z + (size_t)(U.b * SEQ + 128 * U.n) * ZP;
      load_prep4(rq, zt + (size_t)j * ZP + ZB((U.mixer == 0 ? Z_RQ : Z_GQ) + U.h * 128), U.mixer, cg); load_prep4(rk, zt + (size_t)j * ZP + ZB((U.mixer == 0 ? Z_RK : Z_GF) + U.h * 128), U.mixer, cg); }
    const int vb = w >> 1;
    for (;;) {
        int tid = tid0; asm volatile("" : "+v"(tid));
        const int lane = tid & 63, r = lane & 31, h2 = lane >> 5, j = tid & 127, cg = tid >> 7; const int lbp = tr_lane_base(lane, MX_TSTRIDE);
        const MixU U = mix_decode(u); const int h = U.h, n = U.n, mixer = U.mixer;
        bf16* zt = a.Z + (size_t)(U.b * SEQ + 128 * n) * ZP;
        const bf16* sb = a.SBUF + (size_t)u * 16384 + (size_t)((vb * 16 + h2) * 32 + r) * 8;
        v4u rv[4]; load_copy4(rv, zt + ZB((mixer == 0 ? Z_RV : Z_GI) + h * 128), tid);
        bf16x8 sf[8];
#pragma unroll
        for (int s = 0; s < 8; ++s) sf[s] = *(const bf16x8*)(sb + s * 512);
        if (mixer == 0) {
            const float gamma = 1.0f - __builtin_amdgcn_exp2f(-5.0f - (float)h), lg2 = log2f(gamma);
            float sn[16], cs[16];
#pragma unroll
            for (int e = 0; e < 16; ++e) { const float inv = __builtin_amdgcn_exp2f(-(float)(16 * cg + e) * (13.287712379549449f / 64.0f)); rope_sincos((float)(128 * n + j) * inv, sn[e], cs[e]); }
            ret_prep_raw(lds + MX_Q, MX_STRIDE, rq, j, cg, sn, cs, __builtin_amdgcn_exp2f((float)j * lg2));
            ret_prep_raw(lds + MX_K, MX_STRIDE, rk, j, cg, sn, cs, 0.08838834764831845f * __builtin_amdgcn_exp2f(-(float)j * lg2));
        } else {
            float cum[32], kk[32];
            hg_gates_raw(rk, (const LAS float*)(lds + MX_LB) + h * 128, tid, scr, cum, kk);
#pragma unroll
            for (int q = 0; q < 4; ++q) { float qv[8], oq[8], ok[8]; unpack8(rq[q], qv);
#pragma unroll
                for (int e = 0; e < 8; ++e) { const float d = cum[8 * q + e] - scr[32 * cg + 8 * q + e]; oq[e] = qv[e] * __builtin_amdgcn_exp2f(d); ok[e] = kk[8 * q + e] * __builtin_amdgcn_exp2f(-d); }
                st_chunk8(lds + MX_Q, MX_STRIDE, j, 32 * cg + 8 * q, oq); st_chunk8(lds + MX_K, MX_STRIDE, j, 32 * cg + 8 * q, ok); }
        }
        store_copy4(lds + MX_V, MX_TSTRIDE, rv, tid);
        v4u gwv[4];
#pragma unroll
        for (int t = 0; t < 2; ++t) { const int ib = (w & 1) ? (1 + t) : (3 * t);
#pragma unroll
            for (int i = 0; i < 2; ++i) { const int id = lane + 64 * i; gwv[2 * t + i] = *(const v4u*)(zt + (size_t)(32 * ib + (id >> 2)) * ZP + ZB((mixer == 0 ? Z_RG : Z_GG) + h * 128) + 32 * vb + 8 * (id & 3)); } }
        LDS_BARRIER();
        const int vn = vu + G; const bool more = vn < 1024; const int un = mixc_map(more ? vn : vu, G);
        if (more) { const MixU Un = mix_decode(un); const bf16* ztn = a.Z + (size_t)(Un.b * SEQ + 128 * Un.n) * ZP;
            load_prep4(rq, ztn + (size_t)j * ZP + ZB((Un.mixer == 0 ? Z_RQ : Z_GQ) + Un.h * 128), Un.mixer, cg); load_prep4(rk, ztn + (size_t)j * ZP + ZB((Un.mixer == 0 ? Z_RK : Z_GF) + Un.h * 128), Un.mixer, cg); }
        f32x16 o[2];
        const float* rg_ = a.ret_g; const float* hg_ = a.hg_g; const float* gn = (mixer == 0 ? rg_ : hg_) + h * 128 + 32 * vb + 4 * h2;
        f32x4 gvv[4];
#pragma unroll
        for (int g4 = 0; g4 < 4; ++g4) gvv[g4] = *(const f32x4*)(gn + 8 * g4);
#pragma unroll
        for (int t = 0; t < 2; ++t) {
            const int ib = (w & 1) ? (1 + t) : (3 * t);
#pragma unroll
            for (int i = 0; i < 16; ++i) o[t][i] = 0.f;
#pragma unroll
            for (int s = 0; s < 8; ++s) { const bf16x8 qv_ = *(const LAS bf16x8*)(lds + MX_Q + (32 * ib + r) * MX_STRIDE + h2 * 16 + s * 32); o[t] = MFMA32(sf[s], qv_, o[t]); }
        }
#pragma unroll
        for (int t = 0; t < 2; ++t) {
            const int ib = (w & 1) ? (1 + t) : (3 * t);
            bf16x8 qf[8];
#pragma unroll
            for (int s = 0; s < 8; ++s) qf[s] = *(const LAS bf16x8*)(lds + MX_Q + (32 * ib + r) * MX_STRIDE + h2 * 16 + s * 32);
            for (int jb = 0; jb <= ib; ++jb) {
                f32x16 acc;
#pragma unroll
                for (int i = 0; i < 16; ++i) acc[i] = 0.f;
                const LAS char* kp = lds + MX_K + (32 * jb + r) * MX_STRIDE + h2 * 16;
                const LAS char* vp = lds + MX_V + lbp + (32 * jb) * MX_TSTRIDE + 64 * vb;
                s16x4 vl[2], vh[2]; bf16x8 fb[4];
                asm volatile("ds_read_b64_tr_b16 %0, %2 offset:%3\n\tds_read_b64_tr_b16 %1, %2 offset:%4" : "=&v"(vl[0]), "=&v"(vh[0]) : "v"(vp), "n"(0), "n"(8 * MX_TSTRIDE));
                asm volatile("ds_read_b64_tr_b16 %0, %2 offset:%3\n\tds_read_b64_tr_b16 %1, %2 offset:%4" : "=&v"(vl[1]), "=&v"(vh[1]) : "v"(vp), "n"(16 * MX_TSTRIDE), "n"(24 * MX_TSTRIDE));
#define MX_RD(q) asm volatile("ds_read_b128 %0, %1 offset:%2" : "=v"(fb[(q) & 3]) : "v"(kp), "n"((q) * 32))
                MX_RD(0); MX_RD(1); MX_RD(2);
#pragma unroll
                for (int s = 0; s < 8; ++s) {
                    if (s + 3 < 8) MX_RD(s + 3);
                    if (s + 3 < 8) asm volatile("s_waitcnt lgkmcnt(3)" : "+v"(fb[s & 3])); else if (s + 2 < 8) asm volatile("s_waitcnt lgkmcnt(2)" : "+v"(fb[s & 3])); else if (s + 1 < 8) asm volatile("s_waitcnt lgkmcnt(1)" : "+v"(fb[s & 3]));
                    else asm volatile("s_waitcnt lgkmcnt(0)" : "+v"(fb[s & 3]), "+v"(vl[0]), "+v"(vh[0]), "+v"(vl[1]), "+v"(vh[1]));
                    acc = MFMA32(fb[s & 3], qf[s], acc);
                }
#undef MX_RD
                if (jb == ib) {
#pragma unroll
                    for (int i = 0; i < 16; ++i) { const int c = (i & 3) + 8 * (i >> 2) + 4 * h2; if (c > r) acc[i] = 0.f; } }
                const bf16x8 p0 = pack8(acc[0], acc[1], acc[2], acc[3], acc[4], acc[5], acc[6], acc[7]), p1 = pack8(acc[8], acc[9], acc[10], acc[11], acc[12], acc[13], acc[14], acc[15]);
                const bf16x8 v0 = (bf16x8){vl[0][0], vl[0][1], vl[0][2], vl[0][3], vh[0][0], vh[0][1], vh[0][2], vh[0][3]}, v1 = (bf16x8){vl[1][0], vl[1][1], vl[1][2], vl[1][3], vh[1][0], vh[1][1], vh[1][2], vh[1][3]};
                o[t] = MFMA32(v0, p0, o[t]); o[t] = MFMA32(v1, p1, o[t]);
            }
            float a1 = 0.f, a2 = 0.f;
#pragma unroll
            for (int i = 0; i < 16; ++i) { a1 += o[t][i]; a2 += o[t][i] * o[t][i]; }
            a1 += __shfl_xor(a1, 32); a2 += __shfl_xor(a2, 32);
            if (h2 == 0) { scr[256 + (vb * 128 + 32 * ib + r) * 2] = a1; scr[256 + (vb * 128 + 32 * ib + r) * 2 + 1] = a2; }
        }
        LDS_BARRIER();
#pragma unroll
        for (int t = 0; t < 2; ++t) {
            const int ib = (w & 1) ? (1 + t) : (3 * t); const int tok = 32 * ib + r;
            float t1 = 0.f, t2 = 0.f;
#pragma unroll
            for (int v = 0; v < 4; ++v) { t1 += scr[256 + (v * 128 + tok) * 2]; t2 += scr[256 + (v * 128 + tok) * 2 + 1]; }
            float mu = 0.f, rstd;
            if (mixer == 0) { mu = t1 * (1.0f / 128.0f); rstd = __builtin_amdgcn_rsqf(fmaxf(t2 * (1.0f / 128.0f) - mu * mu, 0.f) + EPS); } else rstd = __builtin_amdgcn_rsqf(t2 * (1.0f / 128.0f) + EPS);
            LAS char* tile = lds + MX_OSTG + w * 2560;
#pragma unroll
            for (int i = 0; i < 2; ++i) { const int id = lane + 64 * i; *(LAS v4u*)(tile + (id >> 2) * 80 + (id & 3) * 16) = gwv[2 * t + i]; }
            asm volatile("s_waitcnt lgkmcnt(0)" ::: "memory");
#pragma unroll
            for (int g4 = 0; g4 < 4; ++g4) { const v2u gw = *(const LAS v2u*)(tile + r * 80 + (8 * g4 + 4 * h2) * 2); const f32x4 gv = gvv[g4];
                const float ga[4] = {__uint_as_float(gw.x << 16), __uint_as_float(gw.x & 0xffff0000u), __uint_as_float(gw.y << 16), __uint_as_float(gw.y & 0xffff0000u)}; float y[4];
#pragma unroll
                for (int e = 0; e < 4; ++e) { y[e] = (o[t][4 * g4 + e] - mu) * rstd * gv[e] * (ga[e] * __builtin_amdgcn_rcpf(1.0f + __expf(-ga[e]))); }
                v2u wv; wv.x = cvtpk(y[0], y[1]); wv.y = cvtpk(y[2], y[3]); *(LAS v2u*)(tile + r * 80 + (8 * g4 + 4 * h2) * 2) = wv; }
            asm volatile("s_waitcnt lgkmcnt(0)" ::: "memory");
#pragma unroll
            for (int i = 0; i < 2; ++i) { const int id = lane + 64 * i; const v4u yv = *(const LAS v4u*)(tile + (id >> 2) * 80 + (id & 3) * 16);
                if (!dry) *(v4u*)(zt + (size_t)(32 * ib + (id >> 2)) * ZP + ZB((mixer == 0 ? Z_RQ : Z_GQ) + h * 128) + 32 * vb + 8 * (id & 3)) = yv; }
            asm volatile("s_waitcnt lgkmcnt(0)" ::: "memory");
        }
        LDS_BARRIER();
        if (!more) break;
        vu = vn; u = un;
    }
}


__device__ __forceinline__ float gelu_tanh(float x) { const float u = 0.7978845608028654f * (x + 0.044715f * x * x * x); const float t = 1.0f - 2.0f / (1.0f + __expf(2.0f * u)); return 0.5f * x * (1.0f + t); }
__device__ __forceinline__ void ffn_ew(const bf16* GU, const float* cw, const float* cb, bf16* H, int rows, int gtid, int nthreads) {
    for (int idx = gtid; idx < rows * (DFF / 8); idx += nthreads) {
        const int row = idx / (DFF / 8), c0 = (idx % (DFF / 8)) * 8, t = row % SEQ;
        float g0[8], g1[8], g2[8], u[8];
        unpack8(*(const v4u*)(GU + (size_t)row * (2 * DFF) + c0), g2); unpack8(*(const v4u*)(GU + (size_t)row * (2 * DFF) + DFF + c0), u);
        if (t >= 1) unpack8(*(const v4u*)(GU + (size_t)(row - 1) * (2 * DFF) + c0), g1); else { for (int i = 0; i < 8; ++i) g1[i] = 0.f; }
        if (t >= 2) unpack8(*(const v4u*)(GU + (size_t)(row - 2) * (2 * DFF) + c0), g0); else { for (int i = 0; i < 8; ++i) g0[i] = 0.f; }
        float r[8];
#pragma unroll
        for (int i = 0; i < 8; ++i) { const float y = cw[c0 + i] * g0[i] + cw[DFF + c0 + i] * g1[i] + cw[2 * DFF + c0 + i] * g2[i] + cb[c0 + i]; r[i] = gelu_tanh(y) * u[i]; }
        v4u o; o.x = cvtpk(r[0], r[1]); o.y = cvtpk(r[2], r[3]); o.z = cvtpk(r[4], r[5]); o.w = cvtpk(r[6], r[7]);
        *(v4u*)(H + (size_t)row * DFF + c0) = o;
    }
}

constexpr int LDS_BYTES = 163840;
constexpr int LDSCTL_OFF = LDS_BYTES - 512;
constexpr int CW_BAR = 4096;
constexpr size_t CTL_ZERO_BYTES = 64 * 1024;
#define XB_TMO      128
#define XB_XCNT(j)  (256  + 64 * (j))
#define XB_XSUB(j)  (1280 + 64 * (j))
#define XB_XGEN(j)  (2304 + 64 * (j))
#define XB_TOP      3328
#define XB_TOPGEN   3392
#define XCD_BAR_WORDS 3456
#define XB_SPIN_CAP (1u << 18)

__device__ __forceinline__ unsigned xb_ld(unsigned* p)              { return __hip_atomic_load(p, __ATOMIC_RELAXED, __HIP_MEMORY_SCOPE_AGENT); }
__device__ __forceinline__ unsigned xb_add(unsigned* p, unsigned v) { return __hip_atomic_fetch_add(p, v, __ATOMIC_RELAXED, __HIP_MEMORY_SCOPE_AGENT); }
__device__ __forceinline__ unsigned xb_xcc_id() { return (unsigned)__builtin_amdgcn_s_getreg((3 << 11) | 20) & 0xFu; }
#define XB_SPIN(cond, bar) do { unsigned _sp = 0; while (cond) { __builtin_amdgcn_s_sleep(1); \
    if ((++_sp & 255u) == 0u) { if (xb_ld(&(bar)[XB_TMO])) break; if (_sp > XB_SPIN_CAP) { atomicAdd(&(bar)[XB_TMO], 1u); break; } } } } while (0)

struct XcdBarrier {
    unsigned* bar; unsigned x;
    volatile LAS unsigned* st;
};

__device__ __forceinline__ XcdBarrier xcd_barrier_post(unsigned* bar, volatile LAS unsigned* st) {
    XcdBarrier b; b.bar = bar; b.x = xb_xcc_id(); b.st = st;
    if (threadIdx.x == 0) (void)xb_add(&bar[XB_XCNT(b.x)], 1u);
    return b;
}
__device__ __forceinline__ void xcd_barrier_complete(unsigned* bar, unsigned x, unsigned& nloc, unsigned& nx) {
    const unsigned G = gridDim.x * gridDim.y * gridDim.z;
    unsigned sum, cnt, mine, sp = 0u;
    for (;;) {
        sum = 0u; cnt = 0u; mine = 0u;
#pragma unroll
        for (unsigned j = 0; j < 16; ++j) { const unsigned c = xb_ld(&bar[XB_XCNT(j)]); sum += c; cnt += (c > 0u) ? 1u : 0u; mine = (j == x) ? c : mine; }
        if (sum == G) break;
        __builtin_amdgcn_s_sleep(1);
        if ((++sp & 255u) == 0u) { if (xb_ld(&bar[XB_TMO])) break; if (sp > XB_SPIN_CAP) { atomicAdd(&bar[XB_TMO], 1u); break; } }
    }
    nloc = mine > 0u ? mine : 1u; nx = cnt > 0u ? cnt : 1u;
}

__device__ __forceinline__ void xcd_barrier(const XcdBarrier& b) {
    asm volatile("s_waitcnt vmcnt(0)" ::: "memory");
    __syncthreads();
    if (threadIdx.x == 0) {
        unsigned* bar = b.bar;
        __builtin_amdgcn_s_waitcnt(0);
        unsigned nloc = b.st[0], nx = b.st[1];
        if (nloc == 0u) { xcd_barrier_complete(bar, b.x, nloc, nx); b.st[0] = nloc; b.st[1] = nx; }
        const unsigned old = xb_add(&bar[XB_XSUB(b.x)], 1u);
        const unsigned gen = old / nloc;
        if (old + 1u == (gen + 1u) * nloc) {
            __builtin_amdgcn_fence(__ATOMIC_RELEASE, "agent");
            asm volatile("s_waitcnt vmcnt(0)" ::: "memory");
            const unsigned og = xb_add(&bar[XB_TOP], 1u);
            const unsigned tg = og / nx;
            if (og + 1u == (tg + 1u) * nx) xb_add(&bar[XB_TOPGEN], 1u);
            else XB_SPIN(xb_ld(&bar[XB_TOPGEN]) == tg, bar);
            __builtin_amdgcn_fence(__ATOMIC_ACQUIRE, "agent");
            xb_add(&bar[XB_XGEN(b.x)], 1u);
            asm volatile("s_waitcnt vmcnt(0)" ::: "memory");
        } else {
            XB_SPIN(xb_ld(&bar[XB_XGEN(b.x)]) == gen, bar);
            __builtin_amdgcn_fence(__ATOMIC_ACQUIRE, "agent");
            asm volatile("s_waitcnt vmcnt(0)" ::: "memory");
        }
    }
    __syncthreads();
}


__device__ __forceinline__ GAS unsigned char* launder_s(unsigned char* p) { unsigned long long v = (unsigned long long)p; asm volatile("" : "+s"(v)); return (GAS unsigned char*)v; }
__device__ __forceinline__ GAS float* launder_sf(float* p) { unsigned long long v = (unsigned long long)p; asm volatile("" : "+s"(v)); return (GAS float*)v; }
struct FwdArgs { const float* in[25]; float* out; unsigned char* ws; int ph_lo, ph_hi, li, pad; };
__global__ void __launch_bounds__(512, 2) fwd(FwdArgs a) {
    extern __shared__ __attribute__((aligned(16))) unsigned char lds_raw[];
    LAS unsigned char* lds = (LAS unsigned char*)lds_raw;
    const int tid = threadIdx.x, lane = tid & 63, wave = __builtin_amdgcn_readfirstlane(tid >> 6);
    const int G = gridDim.x, bx = blockIdx.x;
    volatile LAS unsigned* MISC = (volatile LAS unsigned*)(lds + LDSCTL_OFF);
    if (tid < 64) MISC[tid] = 0u;
    __syncthreads();
#define WSP (launder_s(a.ws))
#define OUTP (launder_sf(a.out))
    XcdBarrier bar = xcd_barrier_post((unsigned*)(WSP + WS_CTL) + CW_BAR + a.li * XCD_BAR_WORDS, MISC + 8);
    int ph = 0; const int lo = a.ph_lo, hi = a.ph_hi;
#define PH_ON true) for (int rp_ = 0, nr_ = (ph >= lo && ph < hi) ? 1 + ((a.pad >> ph) & 1) : 0; rp_ < nr_; ++rp_, __syncthreads()
#define TID_L ({ int l_; asm volatile("v_mbcnt_lo_u32_b32 %0, -1, 0\n\tv_mbcnt_hi_u32_b32 %0, -1, %0" : "=v"(l_)); wave * 64 + l_; })
#define PH_END do { if (ph >= lo && ph + 1 < hi) xcd_barrier(bar); ++ph; } while (0)
#define XB ((bf16*)(WSP + WS_XB))
#define SSQP ((float*)(WSP + WS_SSQP))
#define ACT ((bf16*)(WSP + WS_ACT))

    if (PH_ON) { ProArgs pa;
#pragma unroll
        for (int i = 0; i < 25; ++i) pa.in[i] = a.in[i];
        pa.ws = (unsigned char*)WSP; pa.layer_mask = 1; pa.ffn_mode = 2; pa.it_lo = 0; pa.it_hi = (G == 256) ? PRO_EARLY_ITEMS : PRO_ALL_ITEMS;
        { const int t_ = TID_L; prologue_body(pa, bx * 8 + (t_ >> 6), G * 8, t_ & 63, (LAS float*)lds + (t_ >> 6) * 64 * 65); } }
    PH_END;

    for (int l = 0; l < 2; ++l) {
        if (PH_ON) {
            if (l == 0) { pg8::Gemm g{XB, (const bf16*)(WSP + WS_EVIN), M, EV_IN, D, D}; pg8::EpiBf16S E{ACT, SSQP, EV_IN, M, EPS, 1};
              pg8::StaticOrder S; S.init(g.M, g.N, G, bx); pg8::gemm_phase<pg8::EpiBf16S, pg8::StaticOrder, true, true>(lds, g, S, E, TID_L); }
            else { pg8::Gemm g{XB, (const bf16*)(WSP + WS_ODIN), M, OD_IN, D, D}; pg8::EpiQKn E{ACT, SSQP, (const float*)(WSP + WS_GOD), OD_IN, M, EPS, 0};
              pg8::StaticOrder S; S.init(g.M, g.N, G, bx); pg8::gemm_phase<pg8::EpiQKn, pg8::StaticOrder, true, true>(lds, g, S, E, TID_L); }
        }
        PH_END;
        const bf16* mixo; int mixo_ld;
        if (l == 0) {
            MixArgs ma{ACT, (const float*)(WSP + WS_LB), a.in[4], a.in[5], (bf16*)OUTP, (float*)(WSP + WS_DECA), (float*)(WSP + WS_DECB)};
            if (PH_ON) mixA_phase((LAS char*)lds, ma, bx, G, TID_L);
            PH_END;
            if (PH_ON) {
                if (bx < 64 && G > 64) { const int lm = bx >> 5;
                    pg8::Gemm g{(const bf16*)(WSP + (lm ? WS_MEMH1 : WS_MEMH0)), (const bf16*)(WSP + (lm ? WS_XKV1 : WS_XKV0)), MM, 2 * D, D, D}; pg8::EpiKVn E{(bf16*)(WSP + (lm ? WS_MKV1 : WS_MKV0)), (const float*)(WSP + WS_GXA) + lm * 256, 2 * D, EPS};
                    pg8::StaticOrder S; S.init(g.M, g.N, G, bx & 31); pg8::gemm_phase<pg8::EpiKVn, pg8::StaticOrder, true, true>(lds, g, S, E, TID_L); }
                else if (G == 256 && bx >= 192) { ProArgs pb;
#pragma unroll
                    for (int i = 0; i < 25; ++i) pb.in[i] = a.in[i];
                    pb.ws = (unsigned char*)WSP; pb.layer_mask = 0; pb.ffn_mode = 2; pb.it_lo = PRO_MID_ITEMS; pb.it_hi = PRO_ALL_ITEMS;
                    { const int t_ = TID_L; prologue_body(pb, (bx - 192) * 8 + (t_ >> 6), 64 * 8, t_ & 63, (LAS float*)lds + (t_ >> 6) * 64 * 65); } }
                else { const int nsc = (G == 256) ? 128 : G - 64; mix_scan(ma, (bx - 64) * 512 + TID_L, nsc * 512, rp_ + 1 < nr_); }
            }
            PH_END;
            if (PH_ON) mixC_phase((LAS char*)lds, ma, bx, G, TID_L, rp_ + 1 < nr_);
            PH_END;
            mixo = ACT; mixo_ld = 128;
        } else {
            bf16* O = (bf16*)(WSP + WS_ACT + 96 * MiB);
            DaArgs da; da.QKV = ACT; da.biasT = (const float*)(WSP + WS_BIAST); da.gkq = (const float*)(WSP + WS_GOD); da.N0 = (bf16*)(WSP + WS_N2); da.DEN0 = (float*)(WSP + WS_DEN23);
            da.N1 = (const bf16*)(WSP + WS_N2); da.DEN1 = (const float*)(WSP + WS_DEN23); da.N2 = (const bf16*)OUTP; da.DEN2 = (const float*)(WSP + WS_DEN23) + (size_t)M * 8; da.O = O; da.br0 = 1; da.nbr = 2; da.mode = 0; da.pad = 0;
            if (PH_ON) dattn_phase<0>((LAS char*)lds, da, bx, G, TID_L);
            PH_END;
            if (PH_ON) dattn_phase<1>((LAS char*)lds, da, bx, G, TID_L);
            PH_END;
            mixo = O; mixo_ld = D;
        }
        if (PH_ON) { pg8::Gemm g{mixo, (const bf16*)(WSP + (l ? WS_ODOUT : WS_EVOUT)), M, D, D, mixo_ld, l ? (size_t)256 : (size_t)M * 256}; pg8::EpiResid E{nullptr, nullptr, XB, SSQP, D, M};
            pg8::StaticOrder S; S.init(g.M, g.N, G, bx); pg8::gemm_phase<pg8::EpiResid, pg8::StaticOrder, false, true>(lds, g, S, E, TID_L); }
        PH_END;
        { bf16* O = (bf16*)(WSP + WS_ACT + 32 * MiB);
          if (PH_ON) { pg8::Gemm g{XB, (const bf16*)(WSP + (l ? WS_XQ1 : WS_XQ0)), M, D, D, D}; EpiXattn E{(const bf16*)(WSP + (l ? WS_MKV1 : WS_MKV0)), (const float*)(WSP + WS_GXA) + l * 256, O};
              pg8::StaticOrder S; S.init(g.M, g.N, G, bx); pg8::gemm_phase<EpiXattn, pg8::StaticOrder, false, true>(lds, g, S, E, TID_L);
              pg8::StaticOrder S2; S2.init(M, D, G, bx); pg8::Unit uq; if (S2.next(0, uq)) xattn_unit<true>((LAS char*)lds, nullptr, (const bf16*)(WSP + (l ? WS_MKV1 : WS_MKV0)), (const float*)(WSP + WS_GXA) + l * 256, O, uq.pm * 4 + uq.pn, TID_L); }
          PH_END;
          if (PH_ON) { pg8::Gemm g{O, (const bf16*)(WSP + (l ? WS_XO1 : WS_XO0)), M, D, D, D}; pg8::EpiResid E{nullptr, nullptr, XB, SSQP, D, M};
              pg8::StaticOrder S; S.init(g.M, g.N, G, bx); pg8::gemm_phase<pg8::EpiResid, pg8::StaticOrder, false, true>(lds, g, S, E, TID_L); }
          PH_END; }
        { bf16* H = ACT;
          if (PH_ON) { pg8::Gemm g{XB, (const bf16*)(WSP + (l ? WS_FIN1 : WS_FIN0)), 68 * 256, 2 * DFF, D, D}; pg8::EpiFfn E{H, SSQP, a.in[22] + (size_t)l * 3 * DFF, a.in[23] + (size_t)l * DFF, M, EPS};
              pg8::FfnOrder S; S.init(g.M, g.N, G, bx); pg8::gemm_phase<pg8::EpiFfn, pg8::FfnOrder, true, true>(lds, g, S, E, TID_L);
              if (l == 0 && G == 256 && bx >= 216) { ProArgs pc;
#pragma unroll
                  for (int i = 0; i < 25; ++i) pc.in[i] = a.in[i];
                  pc.ws = (unsigned char*)WSP; pc.layer_mask = 0; pc.ffn_mode = 2; pc.it_lo = PRO_EARLY_ITEMS; pc.it_hi = PRO_MID_ITEMS;
                  __syncthreads();
                  { const int t_ = TID_L; prologue_body(pc, (bx - 216) * 8 + (t_ >> 6), 40 * 8, t_ & 63, (LAS float*)lds + (t_ >> 6) * 64 * 65); } } }
          PH_END;
          if (PH_ON) { pg8::Gemm g{H, (const bf16*)(WSP + (l ? WS_FOUT1 : WS_FOUT0)), M, D, DFF, 128, (size_t)M * 256}; pg8::EpiResid E{nullptr, l ? (float*)OUTP : (float*)nullptr, XB, SSQP, D, M};
              pg8::StaticOrder S; S.init(g.M, g.N, G, bx); pg8::gemm_phase<pg8::EpiResid, pg8::StaticOrder, false, true>(lds, g, S, E, TID_L); }
          PH_END; }
    }
#undef PH_ON
#undef PH_END
#undef TID_L
#undef WSP
#undef OUTP
#undef XB
#undef SSQP
#undef ACT
}
constexpr int N_PHASES = 1 + 9 + 8;

#ifndef PROBE_MASK
#define PROBE_MASK 0
#endif
#ifndef MK_PER_PHASE
#define MK_PER_PHASE 0
#endif
extern "C" void kernel_launch(void* const* d_in, const int* in_sizes, int n_in, void* d_out, int out_size, void* d_ws, size_t ws_size, hipStream_t stream) {
    static int inited = 0;
    if (!inited) {
        if (n_in != 25 || out_size != M * D || ws_size < WS_END) { fprintf(stderr, "kernel_launch: unexpected shapes (n_in %d, out %d, ws %zu)\n", n_in, out_size, ws_size); inited = -1; return; }
        if (hipFuncSetAttribute((const void*)fwd, hipFuncAttributeMaxDynamicSharedMemorySize, LDS_BYTES) != hipSuccess) { fprintf(stderr, "kernel_launch: hipFuncSetAttribute failed\n"); inited = -1; return; }
        inited = 1;
    }
    if (inited < 0) return;
    if (hipMemsetAsync((char*)d_ws + WS_CTL, 0, CTL_ZERO_BYTES, stream) != hipSuccess) return;
    FwdArgs fa{}; for (int i = 0; i < 25; ++i) fa.in[i] = (const float*)d_in[i]; fa.out = (float*)d_out; fa.ws = (unsigned char*)d_ws; fa.pad = PROBE_MASK;
#if MK_PER_PHASE
    for (int p = 0; p < N_PHASES; ++p) { fa.ph_lo = p; fa.ph_hi = p + 1; fa.li = 0; hipLaunchKernelGGL(fwd, dim3(256), dim3(512), LDS_BYTES, stream, fa); }
#else
    fa.ph_lo = 0; fa.ph_hi = N_PHASES; fa.li = 0; hipLaunchKernelGGL(fwd, dim3(256), dim3(512), LDS_BYTES, stream, fa);
#endif
}
```
